# Optimizing an MI355X kernel written in HIP

```python
import math
import jax, jax.numpy as jnp
from jax import lax
import numpy as np

D_MODEL = 1024
BATCH = 4
SEQ = 4096
DEPTH = 1

N_META = 16
ROPE_THETA = 500000.0
NORM_EPS = 1e-5

DA_HEADS = 8
DA_HEAD_DIM = 64
DA_V_DIM = 2 * DA_HEAD_DIM
DA_QK_WIDTH = DA_HEADS * 2 * DA_HEAD_DIM
DA_WIDTH = DA_HEADS * DA_V_DIM
DA_ROT_DIM = DA_HEAD_DIM // 4
Q_BLOCK = 128

GLA_HEADS = 4
GLA_KEY_DIM = D_MODEL // 2
GLA_VAL_DIM = D_MODEL
GLA_DK = GLA_KEY_DIM // GLA_HEADS
GLA_DV = GLA_VAL_DIM // GLA_HEADS
GLA_GATE_RANK = 16
GLA_GATE_NORMALIZER = 16.0
GLA_CHUNK = 64

IN_SPLITS = (DA_QK_WIDTH, DA_QK_WIDTH, DA_WIDTH, DA_WIDTH,
             GLA_KEY_DIM, GLA_KEY_DIM, GLA_VAL_DIM, GLA_VAL_DIM,
             GLA_GATE_RANK,
             D_MODEL, D_MODEL)
W_IN_COLS = 4 * 1024 + 512 + 512 + 1024 + 1024 + 16 + 2 * 1024

kernel_name = "hybrid_diffattn_gla_gated_block"


def rms_norm(x, w, eps=NORM_EPS):
    xf = x.astype(jnp.float32)
    y = xf * lax.rsqrt(jnp.mean(xf * xf, axis=-1, keepdims=True) + eps)
    return (y * w.astype(jnp.float32)).astype(x.dtype)


def partial_rope(x, pos):
    half = DA_ROT_DIM // 2
    inv_freq = ROPE_THETA ** (-jnp.arange(half, dtype=jnp.float32) / half)
    ang = pos.astype(jnp.float32)[:, None] * inv_freq[None, :]
    cos, sin = jnp.cos(ang), jnp.sin(ang)
    xr = x[..., :DA_ROT_DIM].astype(jnp.float32)
    x1, x2 = xr[..., :half], xr[..., half:]
    rot = jnp.concatenate([x1 * cos - x2 * sin, x2 * cos + x1 * sin], axis=-1).astype(x.dtype)
    return jnp.concatenate([rot, x[..., DA_ROT_DIM:]], axis=-1)


def diff_attn_block(q1, q2, q_pos, k1, k2, v, k_pos, lam):
    scale = DA_HEAD_DIM ** -0.5
    mask = k_pos[None, :] <= q_pos[:, None]

    def probs(q, k):
        s = jnp.einsum("bhqd,bhkd->bhqk", q, k).astype(jnp.float32) * scale
        return jax.nn.softmax(jnp.where(mask, s, -jnp.inf), axis=-1)

    p = probs(q1, k1) - lam * probs(q2, k2)
    return jnp.einsum("bhqk,bhkv->bhqv", p.astype(v.dtype), v)


def diff_attention(q1, q2, k1, k2, v, pos, lam):
    B, H, L, d = q1.shape
    S = L - N_META
    nb = S // Q_BLOCK
    o_meta = diff_attn_block(q1[:, :, :N_META], q2[:, :, :N_META], pos[:N_META],
                             k1[:, :, :N_META], k2[:, :, :N_META], v[:, :, :N_META],
                             pos[:N_META], lam)

    def blocks(t):
        return t[:, :, N_META:].reshape(B, H, nb, Q_BLOCK, t.shape[-1]).transpose(2, 0, 1, 3, 4)

    pos_b = pos[N_META:].reshape(nb, Q_BLOCK)
    o_real = lax.map(lambda a: diff_attn_block(a[0], a[1], a[2], k1, k2, v, pos, lam),
                     (blocks(q1), blocks(q2), pos_b))
    o_real = o_real.transpose(1, 2, 0, 3, 4).reshape(B, H, S, v.shape[-1])
    return jnp.concatenate([o_meta, o_real], axis=2)


def gla_chunk(state, q, k, v, lg):
    f32 = jnp.float32
    C = q.shape[2]
    qf = q.astype(f32) * (GLA_DK ** -0.5)
    kf, vf = k.astype(f32), v.astype(f32)
    b = jnp.cumsum(lg.astype(f32), axis=2)
    causal = jnp.tril(jnp.ones((C, C), dtype=bool))[None, None, :, :, None]
    decay = jnp.exp(jnp.where(causal, b[:, :, :, None, :] - b[:, :, None, :, :], -jnp.inf))
    a = jnp.einsum("bhtc,bhjc,bhtjc->bhtj", qf, kf, decay)
    o = (jnp.einsum("bhtj,bhjv->bhtv", a, vf)
         + jnp.einsum("bhtc,bhcv->bhtv", qf * jnp.exp(b), state))
    b_last = b[:, :, -1]
    new_state = (jnp.exp(b_last)[..., None] * state
                 + jnp.einsum("bhjc,bhjv->bhcv", kf * jnp.exp(b_last[:, :, None, :] - b), vf))
    return new_state, o.astype(v.dtype)


def gla(q, k, v, lg):
    B, H, L, _ = q.shape
    S = L - N_META
    nc = S // GLA_CHUNK
    s0 = jnp.zeros((B, H, GLA_DK, GLA_DV), jnp.float32)
    s1, o_meta = gla_chunk(s0, q[:, :, :N_META], k[:, :, :N_META], v[:, :, :N_META], lg[:, :, :N_META])

    def chunks(t):
        return t[:, :, N_META:].reshape(B, H, nc, GLA_CHUNK, t.shape[-1]).transpose(2, 0, 1, 3, 4)

    _, o_real = lax.scan(lambda st, xs: gla_chunk(st, *xs), s1,
                         (chunks(q), chunks(k), chunks(v), chunks(lg)))
    o_real = o_real.transpose(1, 2, 0, 3, 4).reshape(B, H, S, GLA_DV)
    return jnp.concatenate([o_meta, o_real], axis=2)


def hybrid_layer(h, pos, lam_init, norm_w, w_in, lam_q1, lam_k1, lam_q2, lam_k2, da_subln_w,
                 gla_gate_w2, gla_gate_b, gla_norm_w, w_branch_a, w_branch_b, w_out):
    B, L, _ = h.shape
    u = rms_norm(h, norm_w)
    proj = u @ w_in
    (a_q, a_k, a_v, a_z, g_q, g_k, g_v, g_z, g_lr, gate_a, gate_b) = jnp.split(
        proj, list(np.cumsum(IN_SPLITS)[:-1]), axis=-1)

    qa = a_q.reshape(B, L, DA_HEADS, 2, DA_HEAD_DIM).transpose(3, 0, 2, 1, 4)
    ka = a_k.reshape(B, L, DA_HEADS, 2, DA_HEAD_DIM).transpose(3, 0, 2, 1, 4)
    va = a_v.reshape(B, L, DA_HEADS, DA_V_DIM).transpose(0, 2, 1, 3)
    q1, q2 = partial_rope(qa[0], pos), partial_rope(qa[1], pos)
    k1, k2 = partial_rope(ka[0], pos), partial_rope(ka[1], pos)
    lam = (jnp.exp(jnp.sum(lam_q1.astype(jnp.float32) * lam_k1.astype(jnp.float32)))
           - jnp.exp(jnp.sum(lam_q2.astype(jnp.float32) * lam_k2.astype(jnp.float32)))
           + lam_init)
    o_a = diff_attention(q1, q2, k1, k2, va, pos, lam)
    o_a = rms_norm(o_a, da_subln_w) * (1.0 - lam_init)
    o_a = o_a.transpose(0, 2, 1, 3).reshape(B, L, DA_WIDTH) * jax.nn.silu(a_z)
    y_a = o_a @ w_branch_a

    qb = g_q.reshape(B, L, GLA_HEADS, GLA_DK).transpose(0, 2, 1, 3)
    kb = g_k.reshape(B, L, GLA_HEADS, GLA_DK).transpose(0, 2, 1, 3)
    vb = g_v.reshape(B, L, GLA_HEADS, GLA_DV).transpose(0, 2, 1, 3)
    gk = (g_lr @ gla_gate_w2 + gla_gate_b).astype(jnp.float32)
    lg = (jax.nn.log_sigmoid(gk) / GLA_GATE_NORMALIZER).reshape(B, L, GLA_HEADS, GLA_DK).transpose(0, 2, 1, 3)
    o_b = rms_norm(gla(qb, kb, vb, lg), gla_norm_w)
    o_b = o_b.transpose(0, 2, 1, 3).reshape(B, L, GLA_VAL_DIM) * jax.nn.silu(g_z)
    y_b = o_b @ w_branch_b

    merged = jax.nn.sigmoid(gate_a) * y_a + jax.nn.sigmoid(gate_b) * y_b
    return h + merged @ w_out


def setup_inputs(seed: int = 0) -> dict:
    key = jax.random.key(seed)
    ks = jax.random.split(key, 17)
    f32 = jnp.float32
    n = lambda k, shape, s: jax.random.normal(k, shape, f32) * s
    return {
        "x": n(ks[0], (BATCH, SEQ, D_MODEL), 1.0),
        "meta_tokens": n(ks[1], (N_META, D_MODEL), 1.0),
        "norm_w": 1.0 + n(ks[2], (DEPTH, D_MODEL), 0.02),
        "w_in": n(ks[3], (DEPTH, D_MODEL, W_IN_COLS), D_MODEL ** -0.5),
        "lam_q1": n(ks[4], (DEPTH, DA_HEAD_DIM), 0.1),
        "lam_k1": n(ks[5], (DEPTH, DA_HEAD_DIM), 0.1),
        "lam_q2": n(ks[6], (DEPTH, DA_HEAD_DIM), 0.1),
        "lam_k2": n(ks[7], (DEPTH, DA_HEAD_DIM), 0.1),
        "da_subln_w": 1.0 + n(ks[8], (DEPTH, DA_V_DIM), 0.02),
        "gla_gate_w2": n(ks[9], (DEPTH, GLA_GATE_RANK, GLA_KEY_DIM), GLA_GATE_RANK ** -0.5),
        "gla_gate_b": n(ks[10], (DEPTH, GLA_KEY_DIM), 0.01),
        "gla_norm_w": 1.0 + n(ks[11], (DEPTH, GLA_DV), 0.02),
        "w_branch_a": n(ks[12], (DEPTH, DA_WIDTH, D_MODEL), DA_WIDTH ** -0.5),
        "w_branch_b": n(ks[13], (DEPTH, GLA_VAL_DIM, D_MODEL), GLA_VAL_DIM ** -0.5),
        "w_out": n(ks[14], (DEPTH, D_MODEL, D_MODEL), D_MODEL ** -0.5),
        "final_norm_w": 1.0 + n(ks[15], (D_MODEL,), 0.02),
    }


def reference(x, meta_tokens, norm_w, w_in, lam_q1, lam_k1, lam_q2, lam_k2, da_subln_w,
              gla_gate_w2, gla_gate_b, gla_norm_w, w_branch_a, w_branch_b, w_out, final_norm_w):
    B, S, D = x.shape
    meta = jnp.broadcast_to(meta_tokens.astype(x.dtype)[None], (B, N_META, D))
    h = jnp.concatenate([meta, x], axis=1)
    pos = jnp.arange(N_META + S, dtype=jnp.int32)
    for layer in range(DEPTH):
        lam_init = 0.8 - 0.6 * math.exp(-0.3 * layer)
        h = hybrid_layer(h, pos, lam_init, norm_w[layer], w_in[layer], lam_q1[layer], lam_k1[layer],
                         lam_q2[layer], lam_k2[layer], da_subln_w[layer], gla_gate_w2[layer],
                         gla_gate_b[layer], gla_norm_w[layer], w_branch_a[layer], w_branch_b[layer],
                         w_out[layer])
    return rms_norm(h, final_norm_w)[:, N_META:]
```

```cpp
#include <hip/hip_runtime.h>
#include <hip/hip_cooperative_groups.h>
#include <cstdio>
#include <cstdint>
namespace cg = cooperative_groups;

#ifndef MULTI_LAUNCH
#define MULTI_LAUNCH 0
#endif

typedef unsigned short bf16_t;
typedef short bf16x8 __attribute__((ext_vector_type(8)));
typedef float f32x4 __attribute__((ext_vector_type(4)));
typedef float f32x2 __attribute__((ext_vector_type(2)));
typedef float f32x16 __attribute__((ext_vector_type(16)));
typedef unsigned u32x4 __attribute__((ext_vector_type(4)));
typedef unsigned u32x2 __attribute__((ext_vector_type(2)));
typedef __bf16 bfv2 __attribute__((ext_vector_type(2)));

#define DI __device__ __forceinline__
#define MFMA32(a, b, c) __builtin_amdgcn_mfma_f32_32x32x16_bf16((a), (b), (c), 0, 0, 0)
#define MFMA16(a, b, c) __builtin_amdgcn_mfma_f32_16x16x32_bf16((a), (b), (c), 0, 0, 0)

DI unsigned pk2(float a, float b) { f32x2 v = {a, b}; return __builtin_bit_cast(unsigned, __builtin_convertvector(v, bfv2)); }
DI float bf2f(bf16_t v) { return __uint_as_float(((unsigned)v) << 16); }
DI float bflo(unsigned u) { return __uint_as_float(u << 16); }
DI float bfhi(unsigned u) { return __uint_as_float(u & 0xffff0000u); }
DI bf16_t f2bf(float a) { return (bf16_t)(pk2(a, 0.f) & 0xffffu); }
DI float wave_sum(float v) {
#pragma unroll
    for (int o = 32; o; o >>= 1) v += __shfl_xor(v, o);
    return v;
}
DI float sigmoidf_(float z) { return 1.f / (1.f + __expf(-z)); }
DI float siluf_(float z) { return z / (1.f + __expf(-z)); }

constexpr int D = 1024, NB = 4, SEQ = 4096, MROWS = NB * SEQ;
constexpr int NIN = 9232, NINP = 9344;
constexpr float EPS = 1e-5f;

constexpr size_t SZ_ACT = (size_t)MROWS * 1024 * 2;
constexpr size_t OFF_WIN_T = 0;
constexpr size_t OFF_WA_T = OFF_WIN_T + (size_t)NINP * 1024 * 2;
constexpr size_t OFF_WB_T = OFF_WA_T + 2097152;
constexpr size_t OFF_WO_T = OFF_WB_T + 2097152;
constexpr size_t OFF_AK = OFF_WO_T + 2097152;
constexpr size_t OFF_AVT = OFF_AK + SZ_ACT;
constexpr size_t OFF_AZ = OFF_AVT + SZ_ACT;
constexpr size_t OFF_GVT = OFF_AZ + SZ_ACT;
constexpr size_t OFF_GZ = OFF_GVT + SZ_ACT;
constexpr size_t OFF_GA = OFF_GZ + SZ_ACT;
constexpr size_t OFF_GB = OFF_GA + SZ_ACT;
constexpr size_t OFF_GLR = OFF_GB + SZ_ACT;
constexpr size_t OFF_RSTD = OFF_GLR + (size_t)MROWS * 16 * 2;
constexpr size_t OFF_ROPE = OFF_RSTD + 65792;
constexpr size_t OFF_AKM = OFF_ROPE + 263168;
constexpr size_t OFF_AVTM = OFF_AKM + 131072;
constexpr size_t OFF_GVTM = OFF_AVTM + 131072;
constexpr size_t OFF_GKM = OFF_GVTM + 131072;
constexpr size_t OFF_GLRM = OFF_GKM + 16384;
constexpr size_t OFF_KTM = OFF_GLRM + 512;
constexpr size_t OFF_KTTM = OFF_KTM + 65536;
constexpr size_t OFF_DEC = OFF_KTTM + 65536;
constexpr size_t OFF_DECM = OFF_DEC + 524288;
constexpr size_t OFF_SSQB = OFF_DECM + 2048;
constexpr size_t OFF_SSQH = OFF_SSQB + 4194304;
constexpr size_t OFF_CTR = OFF_SSQH + 1048576;
constexpr size_t WS_END = OFF_CTR + 256;
static_assert(WS_END <= 268435456ull, "workspace over 256 MiB");
constexpr size_t DO_AQ = 0, DO_GQ = SZ_ACT, DO_GK = SZ_ACT + SZ_ACT / 2;

constexpr int G_ROWB = 144;
constexpr int G_SW = 128 * G_ROWB, G_SX = 256 * G_ROWB, G_STAGE = G_SW + G_SX;
constexpr int LDS_SCALE = 2 * G_STAGE;
constexpr int LDS_ITEM = LDS_SCALE + 4096;
constexpr int LDS_BYTES = LDS_ITEM + 64;

struct Params {
    const float *x, *meta, *norm_w, *w_in, *lq1, *lk1, *lq2, *lk2, *subln_w, *gate_w2, *gate_b, *gla_norm_w, *wa, *wb, *wo, *final_w;
    float* out;
    unsigned char* ws;
    int phase_lo, phase_hi;
};

template <int MODE>
DI void p0_transpose_item(const Params& p, int item, float* tile) {
    const int tid = threadIdx.x;
    const float* W = MODE == 0 ? p.w_in : MODE == 1 ? p.wa : MODE == 2 ? p.wb : p.wo;
    const int ldw = MODE == 0 ? NIN : 1024;
    const int nbc = MODE == 0 ? NINP / 64 : 16;
    bf16_t* WT = (bf16_t*)(p.ws + (MODE == 0 ? OFF_WIN_T : MODE == 1 ? OFF_WA_T : MODE == 2 ? OFF_WB_T : OFF_WO_T));
    const int kb = item / nbc, nb = item % nbc, k0 = kb * 64, n0 = nb * 64;
#pragma unroll
    for (int i = 0; i < 8; ++i) {
        const int kk = (tid >> 6) + 8 * i, nn = tid & 63, n = n0 + nn, k = k0 + kk;
        int src = n;
        if (MODE == 0) { src = n < 7168 ? n : (n < 9216 ? n + 16 : (n < 9232 ? n - 2048 : -1)); }
        float sc = 1.f;
        if (MODE == 0) sc = p.norm_w[k];
        if (MODE == 1) sc = 0.8f * p.subln_w[k & 127];
        if (MODE == 2) sc = p.gla_norm_w[k & 255];
        float v = 0.f;
        if (src >= 0) v = W[(size_t)k * ldw + src] * sc;
        tile[kk * 65 + nn] = v;
    }
    __syncthreads();
    {
        const int nn = tid >> 3, c = tid & 7;
        const float* s = tile + (8 * c) * 65 + nn;
        u32x4 o;
        o.x = pk2(s[0 * 65], s[1 * 65]); o.y = pk2(s[2 * 65], s[3 * 65]); o.z = pk2(s[4 * 65], s[5 * 65]); o.w = pk2(s[6 * 65], s[7 * 65]);
        *(u32x4*)(WT + (size_t)(n0 + nn) * 1024 + k0 + 8 * c) = o;
    }
    __syncthreads();
}

DI void phase0(const Params& p, unsigned char* lds) {
    const int tid = threadIdx.x, lane = tid & 63, wave = tid >> 6;
    float* tile = (float*)lds;
    constexpr int I_WIN = 16 * (NINP / 64), I_SQ = 256;
    constexpr int I_T = I_WIN + 3 * I_SQ;
    constexpr int I_RSTD = (MROWS + 16 + 7) / 8;
    constexpr int I_ROPE = (4112 * 8 + 511) / 512;
    constexpr int I_ZERO = 393216 / 8192;
    constexpr int I_ALL = I_T + I_RSTD + I_ROPE + I_ZERO;
    if (blockIdx.x == 0 && tid == 0) { *(unsigned*)(p.ws + OFF_CTR) = 0u; }
    for (int it = blockIdx.x; it < I_ALL; it += gridDim.x) {
        int r = it;
        if (r < I_WIN) { p0_transpose_item<0>(p, r, tile); continue; } r -= I_WIN;
        if (r < I_SQ) { p0_transpose_item<1>(p, r, tile); continue; } r -= I_SQ;
        if (r < I_SQ) { p0_transpose_item<2>(p, r, tile); continue; } r -= I_SQ;
        if (r < I_SQ) { p0_transpose_item<3>(p, r, tile); continue; } r -= I_SQ;
        if (r < I_RSTD) {
            const int row = r * 8 + wave;
            if (row < MROWS + 16) {
                const float* src = row < MROWS ? p.x + (size_t)row * 1024 : p.meta + (size_t)(row - MROWS) * 1024;
                const f32x4* xr = (const f32x4*)src + lane;
                float s = 0.f;
#pragma unroll
                for (int j = 0; j < 4; ++j) { const f32x4 v = xr[64 * j]; s += (v.x * v.x + v.y * v.y) + (v.z * v.z + v.w * v.w); }
                s = wave_sum(s);
                if (lane == 0) ((float*)(p.ws + OFF_RSTD))[row] = 1.0f / sqrtf(s * (1.0f / 1024.0f) + EPS);
            }
            continue;
        }
        r -= I_RSTD;
        if (r < I_ROPE) {
            const int e = r * 512 + tid;
            if (e < 4112 * 8) {
                const int pos = e >> 3, i = e & 7;
                const float inv = powf(500000.0f, -(float)i / 8.0f);
                const float ang = (float)pos * inv;
                float* t = (float*)(p.ws + OFF_ROPE) + (size_t)e * 2;
                t[0] = cosf(ang); t[1] = sinf(ang);
            }
            continue;
        }
        r -= I_ROPE;
        { u32x4 z = {0u, 0u, 0u, 0u}; *(u32x4*)(p.ws + OFF_AKM + (size_t)r * 8192 + tid * 16) = z; }
    }
}

template <int XMODE, bool HS>
DI void gemm_tile(f32x16 (&acc)[2][2], const bf16_t* __restrict__ Wt, const void* __restrict__ Xv, int xvalid, unsigned char* lds, const float (&hs)[2][3]) {
    const int tid = threadIdx.x, lane = tid & 63, wave = tid >> 6, l31 = lane & 31, h = lane >> 5;
    const int wn = wave & 1, wm = wave >> 1;
    u32x4 wreg[2];
    u32x4 xreg[4];
    f32x4 xf[8];
#define G_LOAD(kt_)                                                                                                  \
    {                                                                                                                \
        const int k0_ = (kt_) * 64;                                                                                  \
        _Pragma("unroll") for (int i = 0; i < 2; ++i) { const int pi = tid + 512 * i, row = pi >> 3, c = pi & 7;      \
            wreg[i] = *(const u32x4*)(Wt + (size_t)row * 1024 + k0_ + c * 8); }                                      \
        if (XMODE == 1) {                                                                                            \
            _Pragma("unroll") for (int i = 0; i < 8; ++i) { const int pi = tid + 512 * i, row = pi >> 4, c4 = pi & 15; \
                const int rr = row < xvalid ? row : 0;                                                               \
                xf[i] = *(const f32x4*)((const float*)Xv + (size_t)rr * 1024 + k0_ + c4 * 4); }                      \
        } else {                                                                                                     \
            _Pragma("unroll") for (int i = 0; i < 4; ++i) { const int pi = tid + 512 * i, row = pi >> 3, c = pi & 7;  \
                xreg[i] = *(const u32x4*)((const bf16_t*)Xv + (size_t)row * 1024 + k0_ + c * 8); }                   \
        }                                                                                                            \
    }
#define G_STORE(kt_, buf_)                                                                                           \
    {                                                                                                                \
        unsigned char* sW_ = lds + (buf_) * G_STAGE; unsigned char* sX_ = sW_ + G_SW;                                \
        _Pragma("unroll") for (int i = 0; i < 2; ++i) { const int pi = tid + 512 * i, row = pi >> 3, c = pi & 7;      \
            *(u32x4*)(sW_ + row * G_ROWB + c * 16) = wreg[i]; }                                                      \
        if (XMODE == 1) {                                                                                            \
            _Pragma("unroll") for (int i = 0; i < 8; ++i) { const int pi = tid + 512 * i, row = pi >> 4, c4 = pi & 15; \
                u32x2 v_; v_.x = pk2(xf[i].x, xf[i].y); v_.y = pk2(xf[i].z, xf[i].w);                                \
                *(u32x2*)(sX_ + row * G_ROWB + c4 * 8) = v_; }                                                       \
        } else {                                                                                                     \
            _Pragma("unroll") for (int i = 0; i < 4; ++i) { const int pi = tid + 512 * i, row = pi >> 3, c = pi & 7;  \
                *(u32x4*)(sX_ + row * G_ROWB + c * 16) = xreg[i]; }                                                  \
        }                                                                                                            \
    }
    G_LOAD(0);
    G_STORE(0, 0);
    __syncthreads();
    for (int kt = 0; kt < 16; ++kt) {
        if (kt + 1 < 16) G_LOAD(kt + 1);
        if (HS) {
            if (kt == 4 || kt == 8 || kt == 12) {
                const float s0 = kt == 4 ? hs[0][0] : (kt == 8 ? hs[0][1] : hs[0][2]);
                const float s1 = kt == 4 ? hs[1][0] : (kt == 8 ? hs[1][1] : hs[1][2]);
#pragma unroll
                for (int i = 0; i < 16; ++i) { acc[0][0][i] *= s0; acc[1][0][i] *= s0; acc[0][1][i] *= s1; acc[1][1][i] *= s1; }
            }
        }
        {
            const unsigned char* sW = lds + (kt & 1) * G_STAGE + (wn * 64 + l31) * G_ROWB + h * 16;
            const unsigned char* sX = lds + (kt & 1) * G_STAGE + G_SW + (wm * 64 + l31) * G_ROWB + h * 16;
#pragma unroll
            for (int ks = 0; ks < 4; ++ks) {
                const bf16x8 w0 = *(const bf16x8*)(sW + ks * 32), w1 = *(const bf16x8*)(sW + 32 * G_ROWB + ks * 32);
                const bf16x8 x0 = *(const bf16x8*)(sX + ks * 32), x1 = *(const bf16x8*)(sX + 32 * G_ROWB + ks * 32);
                acc[0][0] = MFMA32(w0, x0, acc[0][0]); acc[0][1] = MFMA32(w0, x1, acc[0][1]);
                acc[1][0] = MFMA32(w1, x0, acc[1][0]); acc[1][1] = MFMA32(w1, x1, acc[1][1]);
            }
        }
        if (kt + 1 < 16) G_STORE(kt + 1, (kt + 1) & 1);
        __syncthreads();
    }
#undef G_LOAD
#undef G_STORE
}

DI void zero_acc(f32x16 (&acc)[2][2]) {
#pragma unroll
    for (int a = 0; a < 2; ++a)
#pragma unroll
        for (int b = 0; b < 2; ++b)
#pragma unroll
            for (int i = 0; i < 16; ++i) acc[a][b][i] = 0.f;
}

DI void p1_epilogue(const Params& p, f32x16 (&acc)[2][2], int mt, int nt) {
    const int tid = threadIdx.x, lane = tid & 63, wave = tid >> 6, l31 = lane & 31, h = lane >> 5;
    const int wn = wave & 1, wm = wave >> 1;
    const bool meta = (mt == 64);
    int split, nc0;
    if (nt < 8) { split = 0; nc0 = nt * 128; }
    else if (nt < 16) { split = 1; nc0 = (nt - 8) * 128; }
    else if (nt < 24) { split = 2; nc0 = (nt - 16) * 128; }
    else if (nt < 32) { split = 3; nc0 = (nt - 24) * 128; }
    else if (nt < 36) { split = 4; nc0 = (nt - 32) * 128; }
    else if (nt < 40) { split = 5; nc0 = (nt - 36) * 128; }
    else if (nt < 48) { split = 6; nc0 = (nt - 40) * 128; }
    else if (nt < 56) { split = 7; nc0 = (nt - 48) * 128; }
    else if (nt < 64) { split = 9; nc0 = (nt - 56) * 128; }
    else if (nt < 72) { split = 10; nc0 = (nt - 64) * 128; }
    else { split = 8; nc0 = 0; }
    const float* rstd = (const float*)(p.ws + OFF_RSTD);
    const float* rope = (const float*)(p.ws + OFF_ROPE);
    unsigned char* ws = p.ws;
    unsigned char* dout = (unsigned char*)p.out;
#pragma unroll
    for (int im = 0; im < 2; ++im) {
        const int lr = wm * 64 + im * 32 + l31;
        const int tok = meta ? MROWS + (lr & 15) : mt * 256 + lr;
        const bool rvalid = !meta || lr < 16;
        const float rs = rstd[tok];
        const int pos = meta ? (lr & 15) : 16 + (tok & 4095);
        const int b = (tok >> 12) & 3, s = tok & 4095;
#pragma unroll
        for (int in = 0; in < 2; ++in) {
            const int nb = nc0 + wn * 64 + in * 32;
            float v[16];
#pragma unroll
            for (int i = 0; i < 16; ++i) v[i] = acc[in][im][i] * rs;
            if (split <= 1 && (nb & 63) == 0) {
                const float* cs = rope + ((size_t)pos * 8 + 4 * h) * 2;
#pragma unroll
                for (int i = 0; i < 4; ++i) {
                    const float c = cs[2 * i], sn = cs[2 * i + 1];
                    const float x1 = v[i], x2 = v[i + 4];
                    v[i] = x1 * c - x2 * sn; v[i + 4] = x2 * c + x1 * sn;
                }
            }
            if (!rvalid) continue;
            if (split == 2 || split == 6) {
                const int hshift = split == 2 ? 7 : 8;
                const int nheads = split == 2 ? 8 : 4;
                const int dvn = 1 << hshift;
                bf16_t* base = (bf16_t*)(ws + (split == 2 ? OFF_AVT : OFF_GVT));
                bf16_t* basem = (bf16_t*)(ws + (split == 2 ? OFF_AVTM : OFF_GVTM));
#pragma unroll
                for (int i = 0; i < 16; ++i) {
                    const int n = nb + (i & 3) + 8 * (i >> 2) + 4 * h;
                    const int hd = n >> hshift, dv = n & (dvn - 1);
                    const bf16_t val = f2bf(v[i]);
                    if (meta) basem[(size_t)(hd * dvn + dv) * 64 + 48 + lr] = val;
                    else base[((size_t)(b * nheads + hd) * dvn + dv) * 4096 + s] = val;
                }
            } else {
                bf16_t* dst; int ld; int row = tok;
                bool skip = false;
                switch (split) {
                    case 0: dst = (bf16_t*)(dout + DO_AQ); ld = 1024; skip = meta; break;
                    case 1: if (meta) { dst = (bf16_t*)(ws + OFF_AKM); row = 48 + lr; } else dst = (bf16_t*)(ws + OFF_AK); ld = 1024; break;
                    case 3: dst = (bf16_t*)(ws + OFF_AZ); ld = 1024; skip = meta; break;
                    case 4: dst = (bf16_t*)(dout + DO_GQ); ld = 512; skip = meta; break;
                    case 5: if (meta) { dst = (bf16_t*)(ws + OFF_GKM); row = lr; } else dst = (bf16_t*)(dout + DO_GK); ld = 512; break;
                    case 7: dst = (bf16_t*)(ws + OFF_GZ); ld = 1024; skip = meta; break;
                    case 9: dst = (bf16_t*)(ws + OFF_GA); ld = 1024; skip = meta; break;
                    case 10: dst = (bf16_t*)(ws + OFF_GB); ld = 1024; skip = meta; break;
                    default: if (meta) { dst = (bf16_t*)(ws + OFF_GLRM); row = lr; } else dst = (bf16_t*)(ws + OFF_GLR); ld = 16; skip = (wn != 0 || in != 0); break;
                }
                if (skip) continue;
#pragma unroll
                for (int g = 0; g < 4; ++g) {
                    if (split == 8 && g >= 2) continue;
                    u32x2 o; o.x = pk2(v[4 * g], v[4 * g + 1]); o.y = pk2(v[4 * g + 2], v[4 * g + 3]);
                    *(u32x2*)(dst + (size_t)row * ld + nb + 8 * g + 4 * h) = o;
                }
            }
        }
    }
}

DI void phase1(const Params& p, unsigned char* lds) {
    constexpr int NT = 73;
    constexpr int MAIN = 64 * NT, TOTAL = MAIN + NT;
    const bf16_t* wt = (const bf16_t*)(p.ws + OFF_WIN_T);
    for (int id = blockIdx.x; id < TOTAL; id += gridDim.x) {
        int mt, nt;
        if (id < MAIN) { const int g = id / (16 * NT), rem = id % (16 * NT); nt = rem >> 4; mt = g * 16 + (rem & 15); }
        else { mt = 64; nt = id - MAIN; }
        if (mt == 64) {
            const bool need = (nt >= 8 && nt < 24) || (nt >= 36 && nt < 48) || nt == 72;
            if (!need) continue;
        }
        f32x16 acc[2][2];
        zero_acc(acc);
        const float* X = mt == 64 ? p.meta : p.x + (size_t)mt * 256 * 1024;
        const float hs0[2][3] = {{1.f, 1.f, 1.f}, {1.f, 1.f, 1.f}};
        gemm_tile<1, false>(acc, wt + (size_t)nt * 128 * 1024, X, mt == 64 ? 16 : 256, lds, hs0);
        p1_epilogue(p, acc, mt, nt);
    }
}

DI void phase15(const Params& p, unsigned char* lds) {
    const int tid = threadIdx.x, col = tid;
    float w2[16];
#pragma unroll
    for (int j = 0; j < 16; ++j) w2[j] = p.gate_w2[j * 512 + col];
    const float bias = p.gate_b[col];
    unsigned char* ws = p.ws;
    unsigned char* dout = (unsigned char*)p.out;
    for (int item = blockIdx.x; item < 257; item += gridDim.x) {
        const bool meta = item == 256;
        const int b = item >> 6, c = item & 63;
        const size_t row0 = (size_t)b * 4096 + c * 64;
        const bf16_t* glr = meta ? (const bf16_t*)(ws + OFF_GLRM) : (const bf16_t*)(ws + OFF_GLR) + row0 * 16;
        const int nrows = meta ? 16 : 64;
        bf16_t* qp = (bf16_t*)(dout + DO_GQ) + row0 * 512 + col;
        const bf16_t* kin = meta ? (const bf16_t*)(ws + OFF_GKM) + col : (const bf16_t*)(dout + DO_GK) + row0 * 512 + col;
        bf16_t* kout = meta ? (bf16_t*)(ws + OFF_KTM) + 48 * 512 + col : (bf16_t*)(dout + DO_GK) + row0 * 512 + col;
        bf16_t* ktt = meta ? (bf16_t*)(ws + OFF_KTTM) + (size_t)col * 64 + 48 : (bf16_t*)(ws + OFF_WIN_T) + ((size_t)b * 512 + col) * 4096 + c * 64;
        float bsum = 0.f;
        for (int r0 = 0; r0 < nrows; r0 += 8) {
            float kt8[8];
#pragma unroll
            for (int rr = 0; rr < 8; ++rr) {
                const int r = r0 + rr;
                const u32x4* g4 = (const u32x4*)(glr + r * 16);
                const u32x4 ga = g4[0], gb = g4[1];
                float gk = bias;
                gk += bflo(ga.x) * w2[0] + bfhi(ga.x) * w2[1] + bflo(ga.y) * w2[2] + bfhi(ga.y) * w2[3];
                gk += bflo(ga.z) * w2[4] + bfhi(ga.z) * w2[5] + bflo(ga.w) * w2[6] + bfhi(ga.w) * w2[7];
                gk += bflo(gb.x) * w2[8] + bfhi(gb.x) * w2[9] + bflo(gb.y) * w2[10] + bfhi(gb.y) * w2[11];
                gk += bflo(gb.z) * w2[12] + bfhi(gb.z) * w2[13] + bflo(gb.w) * w2[14] + bfhi(gb.w) * w2[15];
                const float lg = (fminf(gk, 0.f) - log1pf(expf(-fabsf(gk)))) * (1.0f / 16.0f);
                bsum += lg;
                const float kv = bf2f(kin[(size_t)r * 512]);
                const float kt = kv * expf(-bsum);
                kt8[rr] = kt;
                kout[(size_t)r * 512] = f2bf(kt);
                if (!meta) {
                    const float qv = bf2f(qp[(size_t)r * 512]);
                    qp[(size_t)r * 512] = f2bf(qv * 0.08838834764831845f * expf(bsum));
                }
            }
            u32x4 o; o.x = pk2(kt8[0], kt8[1]); o.y = pk2(kt8[2], kt8[3]); o.z = pk2(kt8[4], kt8[5]); o.w = pk2(kt8[6], kt8[7]);
            *(u32x4*)(ktt + r0) = o;
        }
        if (meta) {
            ((float*)(ws + OFF_DECM))[col] = expf(bsum);
            bf16_t* km = (bf16_t*)(ws + OFF_KTM);
            for (int r = 0; r < 48; ++r) km[r * 512 + col] = 0;
            u32x4 z = {0u, 0u, 0u, 0u};
            u32x4* kz = (u32x4*)((bf16_t*)(ws + OFF_KTTM) + (size_t)col * 64);
#pragma unroll
            for (int j = 0; j < 6; ++j) kz[j] = z;
        } else {
            ((float*)(ws + OFF_DEC))[((size_t)b * 64 + c) * 512 + col] = expf(bsum);
        }
    }
}

constexpr int A_KROWB = 272, A_VROWB = 136, A_KB = 64 * A_KROWB, A_VB = 128 * A_VROWB, A_STAGE = A_KB + A_VB;
DI void attn_item(const Params& p, unsigned char* lds, int b, int hd, int qb) {
    const int tid = threadIdx.x, lane = tid & 63, wave = tid >> 6, l31 = lane & 31, h = lane >> 5;
    const int sub = wave >> 2, rt = wave & 3;
    const bf16_t* aq = (const bf16_t*)((unsigned char*)p.out + DO_AQ);
    const bf16_t* ak = (const bf16_t*)(p.ws + OFF_AK);
    const bf16_t* avT = (const bf16_t*)(p.ws + OFF_AVT);
    const bf16_t* akm = (const bf16_t*)(p.ws + OFF_AKM);
    const bf16_t* avTm = (const bf16_t*)(p.ws + OFF_AVTM);
    bf16_t* az = (bf16_t*)(p.ws + OFF_AZ);
    const int qs = qb * 128 + rt * 32 + l31;
    const size_t grow = (size_t)b * 4096 + qs;
    bf16x8 qf[4];
#pragma unroll
    for (int ks = 0; ks < 4; ++ks) qf[ks] = *(const bf16x8*)(aq + grow * 1024 + hd * 128 + sub * 64 + ks * 16 + 8 * h);
    f32x16 O[4];
#pragma unroll
    for (int d = 0; d < 4; ++d)
#pragma unroll
        for (int i = 0; i < 16; ++i) O[d][i] = 0.f;
    float m = -INFINITY, l = 0.f;
    const int T = 2 * qb + 3;
    const float SC = 0.125f * 1.4426950408889634f;
    u32x4 kreg[2], vreg[2];
    const int krow_ = tid >> 4, kc_ = tid & 15, vdv_ = tid >> 3, vc_ = tid & 7;
    const bf16_t* kp = ak + ((size_t)b * 4096 + krow_) * 1024 + hd * 128 + kc_ * 8;
    const bf16_t* vp_ = avT + ((size_t)(b * 8 + hd) * 128 + vdv_) * 4096 + vc_ * 8;
#define A_LOAD_META()                                                                                                         \
    {                                                                                                                         \
        const bf16_t* km_ = akm + (size_t)krow_ * 1024 + hd * 128 + kc_ * 8;                                                  \
        kreg[0] = *(const u32x4*)km_; kreg[1] = *(const u32x4*)(km_ + 32 * 1024);                                             \
        const bf16_t* vm_ = avTm + (size_t)(hd * 128 + vdv_) * 64 + vc_ * 8;                                                  \
        vreg[0] = *(const u32x4*)vm_; vreg[1] = *(const u32x4*)(vm_ + 64 * 64);                                               \
    }
#define A_LOADK_REAL() { kreg[0] = *(const u32x4*)kp; kreg[1] = *(const u32x4*)(kp + 32 * 1024); kp += 64 * 1024; }
#define A_LOADV_REAL() { vreg[0] = *(const u32x4*)vp_; vreg[1] = *(const u32x4*)(vp_ + (size_t)64 * 4096); vp_ += 64; }
#define A_STOREK(buf_)                                                                                                        \
    {                                                                                                                         \
        unsigned char* sK_ = lds + (buf_) * A_STAGE;                                                                          \
        _Pragma("unroll") for (int i = 0; i < 2; ++i) { const int pi = tid + 512 * i, row = pi >> 4, c = pi & 15;              \
            *(u32x4*)(sK_ + row * A_KROWB + c * 16) = kreg[i]; }                                                              \
    }
#define A_STOREV(buf_)                                                                                                        \
    {                                                                                                                         \
        unsigned char* sV_ = lds + (buf_) * A_STAGE + A_KB;                                                                   \
        _Pragma("unroll") for (int i = 0; i < 2; ++i) { const int pi = tid + 512 * i, dv = pi >> 3, c = pi & 7;                \
            unsigned char* d_ = sV_ + dv * A_VROWB + c * 16; u32x2 a_, b_; a_.x = vreg[i].x; a_.y = vreg[i].y; b_.x = vreg[i].z; b_.y = vreg[i].w; \
            *(u32x2*)d_ = a_; *(u32x2*)(d_ + 8) = b_; }                                                                       \
    }
    A_LOAD_META();
    A_STOREK(0);
    A_STOREV(0);
    __syncthreads();
    for (int tt = 0; tt < T; ++tt) {
        if (tt + 1 < T) A_LOADK_REAL();
        {
            const unsigned char* sK = lds + (tt & 1) * A_STAGE;
            const unsigned char* sV = sK + A_KB;
            f32x16 st[2];
#pragma unroll
            for (int k2 = 0; k2 < 2; ++k2)
#pragma unroll
                for (int i = 0; i < 16; ++i) st[k2][i] = 0.f;
#pragma unroll
            for (int k2 = 0; k2 < 2; ++k2)
#pragma unroll
                for (int ks = 0; ks < 4; ++ks) {
                    const bf16x8 kf = *(const bf16x8*)(sK + (k2 * 32 + l31) * A_KROWB + (sub * 64 + ks * 16 + 8 * h) * 2);
                    st[k2] = MFMA32(kf, qf[ks], st[k2]);
                }
            __builtin_amdgcn_sched_barrier(0);
            if (tt + 1 < T) { A_STOREK((tt + 1) & 1); A_LOADV_REAL(); }
            if (tt == 0) {
#pragma unroll
                for (int i = 0; i < 16; ++i) { st[0][i] = -INFINITY; if (i < 8) st[1][i] = -INFINITY; }
            } else if (tt >= 2 * qb + 1) {
                const int kbase = (tt - 1) * 64 + 4 * h;
#pragma unroll
                for (int k2 = 0; k2 < 2; ++k2)
#pragma unroll
                    for (int i = 0; i < 16; ++i) {
                        const int key = kbase + k2 * 32 + (i & 3) + 8 * (i >> 2);
                        if (key > qs) st[k2][i] = -INFINITY;
                    }
            }
            float mx = -INFINITY;
#pragma unroll
            for (int k2 = 0; k2 < 2; ++k2)
#pragma unroll
                for (int i = 0; i < 16; ++i) mx = fmaxf(mx, st[k2][i]);
            mx = fmaxf(mx, __shfl_xor(mx, 32));
            const float mnew = fmaxf(m, mx);
            const float alpha = __builtin_amdgcn_exp2f((m - mnew) * SC);
            const float mc = mnew * SC;
            m = mnew;
            float ps = 0.f;
#pragma unroll
            for (int k2 = 0; k2 < 2; ++k2)
#pragma unroll
                for (int i = 0; i < 16; ++i) { const float pv = __builtin_amdgcn_exp2f(st[k2][i] * SC - mc); st[k2][i] = pv; ps += pv; }
            l = l * alpha + ps;
#pragma unroll
            for (int d = 0; d < 4; ++d)
#pragma unroll
                for (int i = 0; i < 16; ++i) O[d][i] *= alpha;
            bf16x8 pb[4];
#pragma unroll
            for (int k4 = 0; k4 < 4; ++k4) {
                const int k2 = k4 >> 1, o8 = 8 * (k4 & 1);
                u32x4 pk;
                pk.x = pk2(st[k2][o8 + 0], st[k2][o8 + 1]); pk.y = pk2(st[k2][o8 + 2], st[k2][o8 + 3]);
                pk.z = pk2(st[k2][o8 + 4], st[k2][o8 + 5]); pk.w = pk2(st[k2][o8 + 6], st[k2][o8 + 7]);
                pb[k4] = __builtin_bit_cast(bf16x8, pk);
            }
#pragma unroll
            for (int d = 0; d < 4; ++d)
#pragma unroll
                for (int k4 = 0; k4 < 4; ++k4) {
                    const unsigned char* vp = sV + (d * 32 + l31) * A_VROWB + (k4 * 16 + 4 * h) * 2;
                    const u32x2 lo = *(const u32x2*)vp, hi = *(const u32x2*)(vp + 16);
                    u32x4 vv; vv.x = lo.x; vv.y = lo.y; vv.z = hi.x; vv.w = hi.y;
                    O[d] = MFMA32(__builtin_bit_cast(bf16x8, vv), pb[k4], O[d]);
                    if (k4 == 3) __builtin_amdgcn_sched_barrier(0);
                }
        }
        if (tt + 1 < T) A_STOREV((tt + 1) & 1);
        __syncthreads();
    }
#undef A_LOAD_META
#undef A_LOADK_REAL
#undef A_LOADV_REAL
#undef A_STOREK
#undef A_STOREV
    float lam;
    {
        const float a_ = wave_sum(p.lq1[lane] * p.lk1[lane]);
        const float b_ = wave_sum(p.lq2[lane] * p.lk2[lane]);
        lam = expf(a_) - expf(b_) + 0.2f;
    }
    const float ltot = l + __shfl_xor(l, 32);
    const float linv = 1.0f / ltot;
    float* ex = (float*)lds;
    if (sub == 1) {
#pragma unroll
        for (int d = 0; d < 4; ++d)
#pragma unroll
            for (int i = 0; i < 16; ++i) { ex[(rt * 32 + l31) * 129 + d * 32 + (i & 3) + 8 * (i >> 2) + 4 * h] = O[d][i] * linv; if (i == 15) __builtin_amdgcn_sched_barrier(0); }
    }
    __syncthreads();
    if (sub == 0) {
        float ss = 0.f;
#pragma unroll
        for (int d = 0; d < 4; ++d)
#pragma unroll
            for (int i = 0; i < 16; ++i) {
                const float o2 = ex[(rt * 32 + l31) * 129 + d * 32 + (i & 3) + 8 * (i >> 2) + 4 * h];
                const float o = O[d][i] * linv - lam * o2;
                O[d][i] = o; ss += o * o;
                if (i == 15) __builtin_amdgcn_sched_barrier(0);
            }
        ss += __shfl_xor(ss, 32);
        const float rstd = 1.0f / sqrtf(ss * (1.0f / 128.0f) + EPS);
#pragma unroll
        for (int d = 0; d < 4; ++d)
#pragma unroll
            for (int g = 0; g < 4; ++g) {
                bf16_t* zp = az + grow * 1024 + hd * 128 + d * 32 + 8 * g + 4 * h;
                const u32x2 zz = *(const u32x2*)zp;
                u32x2 o;
                o.x = pk2(O[d][4 * g] * rstd * siluf_(bflo(zz.x)), O[d][4 * g + 1] * rstd * siluf_(bfhi(zz.x)));
                o.y = pk2(O[d][4 * g + 2] * rstd * siluf_(bflo(zz.y)), O[d][4 * g + 3] * rstd * siluf_(bfhi(zz.y)));
                *(u32x2*)zp = o;
                if (g == 3) __builtin_amdgcn_sched_barrier(0);
            }
    }
    __syncthreads();
}

constexpr int L_KROWB = 272, L_VROWB = 144, L_SROWB = 272;
constexpr int L_K = 0, L_V = 64 * L_KROWB, L_S = L_V + 32 * L_VROWB, L_END = L_S + 32 * L_SROWB;
DI void gla_item(const Params& p, unsigned char* lds, int b, int hh, int sl) {
    const int tid = threadIdx.x, lane = tid & 63, wave = tid >> 6, l15 = lane & 15, g = lane >> 4;
    const int tt = wave & 3, dvt = wave >> 2;
    unsigned char* ws = p.ws;
    unsigned char* dout = (unsigned char*)p.out;
    const bf16_t* gq = (const bf16_t*)(dout + DO_GQ);
    const bf16_t* gk = (const bf16_t*)(dout + DO_GK);
    const bf16_t* gvT = (const bf16_t*)(ws + OFF_GVT);
    const bf16_t* ktt = (const bf16_t*)(ws + OFF_WIN_T);
    const float* dec = (const float*)(ws + OFF_DEC);
    bf16_t* gz = (bf16_t*)(ws + OFF_GZ);
    float* ssqb = (float*)(ws + OFF_SSQB);
    unsigned char* sK = lds + L_K; unsigned char* sV = lds + L_V; unsigned char* sS = lds + L_S;
    for (int i = tid; i < 32 * L_SROWB / 4; i += 512) ((unsigned*)sS)[i] = 0u;
    f32x4 sacc[2];
#pragma unroll
    for (int c = 0; c < 2; ++c) sacc[c] = (f32x4){0.f, 0.f, 0.f, 0.f};
    u32x4 nk[2]; u32x4 nv; bf16x8 nq[4]; bf16x8 nkt[2][2]; float nd[2]; u32x2 ngz;
    const int cc0 = 16 * (2 * tt) + l15;
    const int krow_ = tid >> 4, kc_ = tid & 15, vdv_ = (tid >> 3) & 31, vc_ = tid & 7;
    const bf16_t* kp = gk + ((size_t)b * 4096 + krow_) * 512 + hh * 128 + kc_ * 8;
    const bf16_t* vp_ = gvT + ((size_t)(b * 4 + hh) * 256 + sl * 32 + vdv_) * 4096 + vc_ * 8;
    const bf16_t* ktp = ktt + ((size_t)(b * 4 + hh) * 128 + cc0) * 4096 + 8 * g;
    const float* dp = dec + (size_t)b * 64 * 512 + hh * 128 + cc0;
    const bf16_t* qp = gq + ((size_t)b * 4096 + 16 * tt + l15) * 512 + hh * 128 + 8 * g;
    bf16_t* gzp = gz + ((size_t)b * 4096 + 16 * tt + l15) * 1024 + hh * 256 + sl * 32 + 16 * dvt + 4 * g;
#define L_LOAD_META()                                                                                                         \
    {                                                                                                                         \
        const bf16_t* km_ = (const bf16_t*)(ws + OFF_KTM) + (size_t)krow_ * 512 + hh * 128 + kc_ * 8;                         \
        nk[0] = *(const u32x4*)km_; nk[1] = *(const u32x4*)(km_ + 32 * 512);                                                  \
        nv = *(const u32x4*)((const bf16_t*)(ws + OFF_GVTM) + (size_t)(hh * 256 + sl * 32 + vdv_) * 64 + vc_ * 8);            \
        _Pragma("unroll") for (int ct = 0; ct < 2; ++ct) _Pragma("unroll") for (int ks = 0; ks < 2; ++ks)                     \
            nkt[ct][ks] = *(const bf16x8*)((const bf16_t*)(ws + OFF_KTTM) + (size_t)(hh * 128 + cc0 + 16 * ct) * 64 + 32 * ks + 8 * g); \
        _Pragma("unroll") for (int ct = 0; ct < 2; ++ct) nd[ct] = ((const float*)(ws + OFF_DECM))[hh * 128 + cc0 + 16 * ct];  \
        _Pragma("unroll") for (int ks = 0; ks < 4; ++ks) nq[ks] = (bf16x8){0, 0, 0, 0, 0, 0, 0, 0};                           \
        ngz = (u32x2){0u, 0u};                                                                                                \
    }
#define L_LOAD_REAL()                                                                                                         \
    {                                                                                                                         \
        nk[0] = *(const u32x4*)kp; nk[1] = *(const u32x4*)(kp + 32 * 512); kp += 64 * 512;                                    \
        nv = *(const u32x4*)vp_; vp_ += 64;                                                                                   \
        _Pragma("unroll") for (int ct = 0; ct < 2; ++ct) _Pragma("unroll") for (int ks = 0; ks < 2; ++ks)                     \
            nkt[ct][ks] = *(const bf16x8*)(ktp + (size_t)(16 * ct) * 4096 + 32 * ks);                                         \
        ktp += 64;                                                                                                            \
        nd[0] = dp[0]; nd[1] = dp[16]; dp += 512;                                                                             \
        _Pragma("unroll") for (int ks = 0; ks < 4; ++ks) nq[ks] = *(const bf16x8*)(qp + 32 * ks);                             \
        qp += 64 * 512;                                                                                                       \
        ngz = *(const u32x2*)gzp; gzp += 64 * 1024;                                                                           \
    }
#define L_STORE()                                                                                                             \
    {                                                                                                                         \
        _Pragma("unroll") for (int i = 0; i < 2; ++i) { const int pi = tid + 512 * i, row = pi >> 4, c = pi & 15;              \
            *(u32x4*)(sK + row * L_KROWB + c * 16) = nk[i]; }                                                                 \
        if (tid < 256) { const int dv = tid >> 3, c = tid & 7; *(u32x4*)(sV + dv * L_VROWB + c * 16) = nv; }                  \
    }
    L_LOAD_META();
    L_STORE();
    for (int n = 0; n <= 64; ++n) {
        bf16x8 cq[4], ckt[2][2]; float cd[2]; u32x2 cgz;
#pragma unroll
        for (int ks = 0; ks < 4; ++ks) cq[ks] = nq[ks];
#pragma unroll
        for (int ct = 0; ct < 2; ++ct) { cd[ct] = nd[ct]; ckt[ct][0] = nkt[ct][0]; ckt[ct][1] = nkt[ct][1]; }
        cgz = ngz;
        __syncthreads();
        if (n + 1 <= 64) L_LOAD_REAL();
        if (n > 0) {
            f32x4 at[4];
#pragma unroll
            for (int jt = 0; jt < 4; ++jt) at[jt] = (f32x4){0.f, 0.f, 0.f, 0.f};
#pragma unroll
            for (int jt = 0; jt < 4; ++jt)
#pragma unroll
                for (int ks = 0; ks < 4; ++ks) {
                    const bf16x8 kf = *(const bf16x8*)(sK + (jt * 16 + l15) * L_KROWB + (ks * 32 + 8 * g) * 2);
                    at[jt] = MFMA16(kf, cq[ks], at[jt]);
                }
            const int tl = 16 * tt + l15;
#pragma unroll
            for (int jt = 0; jt < 4; ++jt)
#pragma unroll
                for (int i = 0; i < 4; ++i) if (16 * jt + 4 * g + i > tl) at[jt][i] = 0.f;
            f32x4 o = (f32x4){0.f, 0.f, 0.f, 0.f};
#pragma unroll
            for (int s2 = 0; s2 < 2; ++s2) {
                u32x4 pa;
                pa.x = pk2(at[2 * s2][0], at[2 * s2][1]); pa.y = pk2(at[2 * s2][2], at[2 * s2][3]);
                pa.z = pk2(at[2 * s2 + 1][0], at[2 * s2 + 1][1]); pa.w = pk2(at[2 * s2 + 1][2], at[2 * s2 + 1][3]);
                const unsigned char* vp = sV + (dvt * 16 + l15) * L_VROWB + (32 * s2 + 4 * g) * 2;
                const u32x2 lo = *(const u32x2*)vp, hi = *(const u32x2*)(vp + 32);
                u32x4 vv; vv.x = lo.x; vv.y = lo.y; vv.z = hi.x; vv.w = hi.y;
                o = MFMA16(__builtin_bit_cast(bf16x8, vv), __builtin_bit_cast(bf16x8, pa), o);
            }
#pragma unroll
            for (int ks = 0; ks < 4; ++ks) {
                const bf16x8 sf = *(const bf16x8*)(sS + (dvt * 16 + l15) * L_SROWB + (ks * 32 + 8 * g) * 2);
                o = MFMA16(sf, cq[ks], o);
            }
            const size_t row = (size_t)b * 4096 + (n - 1) * 64 + 16 * tt + l15;
            float ss = (o[0] * o[0] + o[1] * o[1]) + (o[2] * o[2] + o[3] * o[3]);
            ss += __shfl_xor(ss, 16); ss += __shfl_xor(ss, 32);
            u32x2 ov;
            ov.x = pk2(o[0] * siluf_(bflo(cgz.x)), o[1] * siluf_(bfhi(cgz.x)));
            ov.y = pk2(o[2] * siluf_(bflo(cgz.y)), o[3] * siluf_(bfhi(cgz.y)));
            *(u32x2*)(gz + row * 1024 + hh * 256 + sl * 32 + 16 * dvt + 4 * g) = ov;
            if (g == 0) ssqb[(row * 4 + hh) * 16 + sl * 2 + dvt] = ss;
        }
#pragma unroll
        for (int ks = 0; ks < 2; ++ks) {
            const bf16x8 vf = *(const bf16x8*)(sV + (dvt * 16 + l15) * L_VROWB + (32 * ks + 8 * g) * 2);
            sacc[0] = MFMA16(vf, ckt[0][ks], sacc[0]);
            sacc[1] = MFMA16(vf, ckt[1][ks], sacc[1]);
        }
#pragma unroll
        for (int ct = 0; ct < 2; ++ct)
#pragma unroll
            for (int i = 0; i < 4; ++i) sacc[ct][i] *= cd[ct];
        __syncthreads();
#pragma unroll
        for (int ct = 0; ct < 2; ++ct)
#pragma unroll
            for (int i = 0; i < 4; ++i)
                *(bf16_t*)(sS + (16 * dvt + 4 * g + i) * L_SROWB + (cc0 + 16 * ct) * 2) = f2bf(sacc[ct][i]);
        if (n + 1 <= 64) L_STORE();
    }
#undef L_LOAD_META
#undef L_LOAD_REAL
#undef L_STORE
    __syncthreads();
}

DI void phase2(const Params& p, unsigned char* lds) {
    const int tid = threadIdx.x, lane = tid & 63;
    unsigned* ctr = (unsigned*)(p.ws + OFF_CTR);
    volatile unsigned* sItem = (volatile unsigned*)(lds + LDS_ITEM);
    constexpr unsigned N_GLA = 128, N_ATT = 1024;
    for (;;) {
        if (tid == 0) *sItem = atomicAdd(ctr, 1u);
        __syncthreads();
        const unsigned item = *sItem;
        __syncthreads();
        if (item >= N_GLA + N_ATT) break;
        if (item < N_GLA) gla_item(p, lds, item >> 5, (item >> 3) & 3, item & 7);
        else { const unsigned a = item - N_GLA; attn_item(p, lds, a & 3, (a >> 2) & 7, 31 - (int)(a >> 5)); }
    }
}

DI void phase3(const Params& p, unsigned char* lds) {
    const int tid = threadIdx.x, lane = tid & 63, wave = tid >> 6, l31 = lane & 31, h = lane >> 5;
    const int wn = wave & 1, wm = wave >> 1;
    unsigned char* ws = p.ws;
    const float* ssqb = (const float*)(ws + OFF_SSQB);
    float* sc = (float*)(lds + LDS_SCALE);
    const bf16_t* ga = (const bf16_t*)(ws + OFF_GA);
    const bf16_t* gb = (const bf16_t*)(ws + OFF_GB);
    bf16_t* merged = (bf16_t*)(ws + OFF_AK);
    for (int id = blockIdx.x; id < 512; id += gridDim.x) {
        const int mt = id >> 3, nt = id & 7;
#pragma unroll
        for (int i = 0; i < 2; ++i) {
            const int e = tid + 512 * i, row = e >> 2, hh = e & 3;
            const f32x4* sp = (const f32x4*)(ssqb + (((size_t)mt * 256 + row) * 4 + hh) * 16);
            const f32x4 a = sp[0], b2 = sp[1], c = sp[2], d = sp[3];
            const float s = ((a.x + a.y) + (a.z + a.w)) + ((b2.x + b2.y) + (b2.z + b2.w)) + ((c.x + c.y) + (c.z + c.w)) + ((d.x + d.y) + (d.z + d.w));
            sc[e] = 1.0f / sqrtf(s * (1.0f / 256.0f) + EPS);
        }
        __syncthreads();
        float hs[2][3], rl[2];
#pragma unroll
        for (int im = 0; im < 2; ++im) {
            const int lr = wm * 64 + im * 32 + l31;
            const f32x4 r = *(const f32x4*)(sc + lr * 4);
            hs[im][0] = r.x / r.y; hs[im][1] = r.y / r.z; hs[im][2] = r.z / r.w; rl[im] = r.w;
        }
        f32x16 acc[2][2];
        unsigned mb[2][2][8];
        zero_acc(acc);
        gemm_tile<0, true>(acc, (const bf16_t*)(ws + OFF_WB_T) + (size_t)nt * 128 * 1024, (const bf16_t*)(ws + OFF_GZ) + (size_t)mt * 256 * 1024, 256, lds, hs);
#pragma unroll
        for (int im = 0; im < 2; ++im) {
            const size_t tok = (size_t)mt * 256 + wm * 64 + im * 32 + l31;
#pragma unroll
            for (int in = 0; in < 2; ++in)
#pragma unroll
                for (int g = 0; g < 4; ++g) {
                    const size_t off = tok * 1024 + nt * 128 + wn * 64 + in * 32 + 8 * g + 4 * h;
                    const u32x2 ub = *(const u32x2*)(gb + off);
                    mb[in][im][2 * g] = pk2(sigmoidf_(bflo(ub.x)) * acc[in][im][4 * g + 0] * rl[im], sigmoidf_(bfhi(ub.x)) * acc[in][im][4 * g + 1] * rl[im]);
                    mb[in][im][2 * g + 1] = pk2(sigmoidf_(bflo(ub.y)) * acc[in][im][4 * g + 2] * rl[im], sigmoidf_(bfhi(ub.y)) * acc[in][im][4 * g + 3] * rl[im]);
                }
        }
        zero_acc(acc);
        gemm_tile<0, false>(acc, (const bf16_t*)(ws + OFF_WA_T) + (size_t)nt * 128 * 1024, (const bf16_t*)(ws + OFF_AZ) + (size_t)mt * 256 * 1024, 256, lds, hs);
#pragma unroll
        for (int im = 0; im < 2; ++im) {
            const size_t tok = (size_t)mt * 256 + wm * 64 + im * 32 + l31;
#pragma unroll
            for (int in = 0; in < 2; ++in)
#pragma unroll
                for (int g = 0; g < 4; ++g) {
                    const size_t off = tok * 1024 + nt * 128 + wn * 64 + in * 32 + 8 * g + 4 * h;
                    const u32x2 ua = *(const u32x2*)(ga + off);
                    const unsigned b0 = mb[in][im][2 * g], b1 = mb[in][im][2 * g + 1];
                    const float m0 = sigmoidf_(bflo(ua.x)) * acc[in][im][4 * g + 0] + bflo(b0);
                    const float m1 = sigmoidf_(bfhi(ua.x)) * acc[in][im][4 * g + 1] + bfhi(b0);
                    const float m2 = sigmoidf_(bflo(ua.y)) * acc[in][im][4 * g + 2] + bflo(b1);
                    const float m3 = sigmoidf_(bfhi(ua.y)) * acc[in][im][4 * g + 3] + bfhi(b1);
                    u32x2 o; o.x = pk2(m0, m1); o.y = pk2(m2, m3);
                    *(u32x2*)(merged + off) = o;
                }
        }
        __syncthreads();
    }
}

DI void phase4(const Params& p, unsigned char* lds) {
    const int tid = threadIdx.x, lane = tid & 63, wave = tid >> 6, l31 = lane & 31, h = lane >> 5;
    const int wn = wave & 1, wm = wave >> 1;
    unsigned char* ws = p.ws;
    float* ssqh = (float*)(ws + OFF_SSQH);
    for (int id = blockIdx.x; id < 512; id += gridDim.x) {
        const int mt = id >> 3, nt = id & 7;
        f32x16 acc[2][2];
        zero_acc(acc);
        const float hs0[2][3] = {{1.f, 1.f, 1.f}, {1.f, 1.f, 1.f}};
        gemm_tile<0, false>(acc, (const bf16_t*)(ws + OFF_WO_T) + (size_t)nt * 128 * 1024, (const bf16_t*)(ws + OFF_AK) + (size_t)mt * 256 * 1024, 256, lds, hs0);
#pragma unroll
        for (int im = 0; im < 2; ++im) {
            const size_t tok = (size_t)mt * 256 + wm * 64 + im * 32 + l31;
            float ss = 0.f;
#pragma unroll
            for (int in = 0; in < 2; ++in)
#pragma unroll
                for (int g = 0; g < 4; ++g) {
                    const size_t off = tok * 1024 + nt * 128 + wn * 64 + in * 32 + 8 * g + 4 * h;
                    const f32x4 xv = *(const f32x4*)(p.x + off);
                    f32x4 o;
                    o.x = xv.x + acc[in][im][4 * g + 0]; o.y = xv.y + acc[in][im][4 * g + 1];
                    o.z = xv.z + acc[in][im][4 * g + 2]; o.w = xv.w + acc[in][im][4 * g + 3];
                    ss += (o.x * o.x + o.y * o.y) + (o.z * o.z + o.w * o.w);
                    *(f32x4*)(p.out + off) = o;
                }
            ss += __shfl_xor(ss, 32);
            if (h == 0) ssqh[tok * 16 + nt * 2 + wn] = ss;
        }
    }
}

DI void phase5(const Params& p, unsigned char* lds) {
    const int tid = threadIdx.x, lane = tid & 63, wave = tid >> 6;
    const float* ssqh = (const float*)(p.ws + OFF_SSQH);
    for (int it = blockIdx.x; it < MROWS / 8; it += gridDim.x) {
        const size_t row = (size_t)it * 8 + wave;
        float s = lane < 16 ? ssqh[row * 16 + lane] : 0.f;
        s = wave_sum(s);
        const float rstd = 1.0f / sqrtf(s * (1.0f / 1024.0f) + EPS);
        f32x4* orow = (f32x4*)(p.out + row * 1024) + lane;
        const f32x4* wrow = (const f32x4*)p.final_w + lane;
#pragma unroll
        for (int j = 0; j < 4; ++j) {
            f32x4 v = orow[64 * j]; const f32x4 w = wrow[64 * j];
            v.x = v.x * rstd * w.x; v.y = v.y * rstd * w.y; v.z = v.z * rstd * w.z; v.w = v.w * rstd * w.w;
            orow[64 * j] = v;
        }
    }
}

DI void run_phase(const Params& p, unsigned char* lds, int ph) {
    switch (ph) {
        case 0: phase0(p, lds); break;
        case 1: phase1(p, lds); break;
        case 2: phase15(p, lds); break;
        case 3: phase2(p, lds); break;
        case 4: phase3(p, lds); break;
        case 5: phase4(p, lds); break;
        default: phase5(p, lds); break;
    }
}

__global__ void __launch_bounds__(512) hybrid_fwd(Params p) {
    extern __shared__ __attribute__((aligned(16))) unsigned char lds[];
#if MULTI_LAUNCH
    run_phase(p, lds, p.phase_lo);
#else
    cg::grid_group grid = cg::this_grid();
    phase0(p, lds); grid.sync();
    phase1(p, lds); grid.sync();
    phase15(p, lds); grid.sync();
    phase2(p, lds); grid.sync();
    phase3(p, lds); grid.sync();
    phase4(p, lds); grid.sync();
    phase5(p, lds);
#endif
}

extern "C" void kernel_launch(void* const* d_in, const int* in_sizes, int n_in, void* d_out, int out_size, void* d_ws, size_t ws_size, hipStream_t stream) {
    static int grid = 0;
    if (grid == 0) {
        int dev = 0, cus = 0, per_cu = 0;
        hipGetDevice(&dev);
        hipDeviceGetAttribute(&cus, hipDeviceAttributeMultiprocessorCount, dev);
        hipFuncSetAttribute((const void*)hybrid_fwd, hipFuncAttributeMaxDynamicSharedMemorySize, LDS_BYTES);
        hipOccupancyMaxActiveBlocksPerMultiprocessor(&per_cu, (const void*)hybrid_fwd, 512, LDS_BYTES);
        if (per_cu < 1) per_cu = 1;
        if (per_cu > 1) per_cu = 1;
        if (cus <= 0) cus = 256;
        grid = cus * per_cu;
    }
    Params p{};
    p.x = (const float*)d_in[0]; p.meta = (const float*)d_in[1]; p.norm_w = (const float*)d_in[2]; p.w_in = (const float*)d_in[3];
    p.lq1 = (const float*)d_in[4]; p.lk1 = (const float*)d_in[5]; p.lq2 = (const float*)d_in[6]; p.lk2 = (const float*)d_in[7];
    p.subln_w = (const float*)d_in[8]; p.gate_w2 = (const float*)d_in[9]; p.gate_b = (const float*)d_in[10]; p.gla_norm_w = (const float*)d_in[11];
    p.wa = (const float*)d_in[12]; p.wb = (const float*)d_in[13]; p.wo = (const float*)d_in[14]; p.final_w = (const float*)d_in[15];
    p.out = (float*)d_out; p.ws = (unsigned char*)d_ws;
#if MULTI_LAUNCH
    for (int ph = 0; ph < 7; ++ph) {
        p.phase_lo = ph; p.phase_hi = ph + 1;
        hipLaunchKernelGGL(hybrid_fwd, dim3(grid), dim3(512), LDS_BYTES, stream, p);
    }
#else
    p.phase_lo = 0; p.phase_hi = 7;
    void* args[] = {&p};
    hipError_t e = hipLaunchCooperativeKernel((const void*)hybrid_fwd, dim3(grid), dim3(512), args, LDS_BYTES, stream);
    if (e != hipSuccess) fprintf(stderr, "cooperative launch failed: %s (grid %d)\n", hipGetErrorString(e), grid);
#endif
}
```

```cpp
#include <hip/hip_runtime.h>
#include <hip/hip_cooperative_groups.h>
#include <cstdio>
#include <cstdint>
namespace cg = cooperative_groups;

#ifndef MULTI_LAUNCH
#define MULTI_LAUNCH 0
#endif
#ifndef PROBE_REP
#define PROBE_REP 0
#endif

typedef unsigned short bf16_t;
typedef short bf16x8 __attribute__((ext_vector_type(8)));
typedef float f32x4 __attribute__((ext_vector_type(4)));
typedef float f32x2 __attribute__((ext_vector_type(2)));
typedef float f32x16 __attribute__((ext_vector_type(16)));
typedef unsigned u32x4 __attribute__((ext_vector_type(4)));
typedef unsigned u32x2 __attribute__((ext_vector_type(2)));
typedef __bf16 bfv2 __attribute__((ext_vector_type(2)));

#define DI __device__ __forceinline__
#define MFMA32(a, b, c) __builtin_amdgcn_mfma_f32_32x32x16_bf16((a), (b), (c), 0, 0, 0)
#define MFMA16(a, b, c) __builtin_amdgcn_mfma_f32_16x16x32_bf16((a), (b), (c), 0, 0, 0)

DI unsigned pk2(float a, float b) { f32x2 v = {a, b}; return __builtin_bit_cast(unsigned, __builtin_convertvector(v, bfv2)); }
DI float bf2f(bf16_t v) { return __uint_as_float(((unsigned)v) << 16); }
DI float bflo(unsigned u) { return __uint_as_float(u << 16); }
DI float bfhi(unsigned u) { return __uint_as_float(u & 0xffff0000u); }
DI bf16_t f2bf(float a) { return (bf16_t)(pk2(a, 0.f) & 0xffffu); }
DI float wave_sum(float v) {
#pragma unroll
    for (int o = 32; o; o >>= 1) v += __shfl_xor(v, o);
    return v;
}
DI float sigmoidf_(float z) { return 1.f / (1.f + __expf(-z)); }
DI float siluf_(float z) { return z / (1.f + __expf(-z)); }

constexpr int D = 1024, NB = 4, SEQ = 4096, MROWS = NB * SEQ;
constexpr int NIN = 9232, NINP = 9344;
constexpr float EPS = 1e-5f;

constexpr size_t SZ_ACT = (size_t)MROWS * 1024 * 2;
constexpr size_t OFF_WIN_T = 0;
constexpr size_t OFF_WA_T = OFF_WIN_T + (size_t)NINP * 1024 * 2;
constexpr size_t OFF_WB_T = OFF_WA_T + 2097152;
constexpr size_t OFF_WO_T = OFF_WB_T + 2097152;
constexpr size_t OFF_AK = OFF_WO_T + 2097152;
constexpr size_t OFF_AVT = OFF_AK + SZ_ACT;
constexpr size_t OFF_AZ = OFF_AVT + SZ_ACT;
constexpr size_t OFF_GVT = OFF_AZ + SZ_ACT;
constexpr size_t OFF_GZ = OFF_GVT + SZ_ACT;
constexpr size_t OFF_GA = OFF_GZ + SZ_ACT;
constexpr size_t OFF_GB = OFF_GA + SZ_ACT;
constexpr size_t OFF_GLR = OFF_GB + SZ_ACT;
constexpr size_t OFF_RSTD = OFF_GLR + (size_t)MROWS * 16 * 2;
constexpr size_t OFF_ROPE = OFF_RSTD + 65792;
constexpr size_t OFF_AKM = OFF_ROPE + 263168;
constexpr size_t OFF_AVTM = OFF_AKM + 131072;
constexpr size_t OFF_GVTM = OFF_AVTM + 131072;
constexpr size_t OFF_GKM = OFF_GVTM + 131072;
constexpr size_t OFF_GLRM = OFF_GKM + 16384;
constexpr size_t OFF_KTM = OFF_GLRM + 512;
constexpr size_t OFF_KTTM = OFF_KTM + 65536;
constexpr size_t OFF_DEC = OFF_KTTM + 65536;
constexpr size_t OFF_DECM = OFF_DEC + 524288;
constexpr size_t OFF_SSQB = OFF_DECM + 2048;
constexpr size_t OFF_SSQH = OFF_SSQB + 4194304;
constexpr size_t OFF_CTR = OFF_SSQH + 1048576;
constexpr size_t WS_END = OFF_CTR + 256;
static_assert(WS_END <= 268435456ull, "workspace over 256 MiB");
constexpr size_t DO_AQ = 0, DO_GQ = SZ_ACT, DO_GK = SZ_ACT + SZ_ACT / 2;

constexpr int G_ROWB = 144;
constexpr int G_SW = 128 * G_ROWB, G_SX = 256 * G_ROWB, G_STAGE = G_SW + G_SX;
constexpr int LDS_SCALE = 2 * G_STAGE;
constexpr int LDS_ITEM = LDS_SCALE + 4096;
constexpr int LDS_BYTES = LDS_ITEM + 64;

struct Params {
    const float *x, *meta, *norm_w, *w_in, *lq1, *lk1, *lq2, *lk2, *subln_w, *gate_w2, *gate_b, *gla_norm_w, *wa, *wb, *wo, *final_w;
    float* out;
    unsigned char* ws;
    int phase_lo, phase_hi;
};

template <int MODE>
DI void p0_transpose_item(const Params& p, int item, float* tile) {
    const int tid = threadIdx.x;
    const float* W = MODE == 0 ? p.w_in : MODE == 1 ? p.wa : MODE == 2 ? p.wb : p.wo;
    const int ldw = MODE == 0 ? NIN : 1024;
    const int nbc = MODE == 0 ? NINP / 64 : 16;
    bf16_t* WT = (bf16_t*)(p.ws + (MODE == 0 ? OFF_WIN_T : MODE == 1 ? OFF_WA_T : MODE == 2 ? OFF_WB_T : OFF_WO_T));
    const int kb = item / nbc, nb = item % nbc, k0 = kb * 64, n0 = nb * 64;
#pragma unroll
    for (int i = 0; i < 8; ++i) {
        const int kk = (tid >> 6) + 8 * i, nn = tid & 63, n = n0 + nn, k = k0 + kk;
        int src = n;
        if (MODE == 0) { src = n < 7168 ? n : (n < 9216 ? n + 16 : (n < 9232 ? n - 2048 : -1)); }
        float sc = 1.f;
        if (MODE == 0) sc = p.norm_w[k];
        if (MODE == 1) sc = 0.8f * p.subln_w[k & 127];
        if (MODE == 2) sc = p.gla_norm_w[k & 255];
        float v = 0.f;
        if (src >= 0) v = W[(size_t)k * ldw + src] * sc;
        tile[kk * 65 + nn] = v;
    }
    __syncthreads();
    {
        const int nn = tid >> 3, c = tid & 7;
        const float* s = tile + (8 * c) * 65 + nn;
        u32x4 o;
        o.x = pk2(s[0 * 65], s[1 * 65]); o.y = pk2(s[2 * 65], s[3 * 65]); o.z = pk2(s[4 * 65], s[5 * 65]); o.w = pk2(s[6 * 65], s[7 * 65]);
        *(u32x4*)(WT + (size_t)(n0 + nn) * 1024 + k0 + 8 * c) = o;
    }
    __syncthreads();
}

DI void phase0(const Params& p, unsigned char* lds) {
    const int tid = threadIdx.x, lane = tid & 63, wave = tid >> 6;
    float* tile = (float*)lds;
    constexpr int I_WIN = 16 * (NINP / 64), I_SQ = 256;
    constexpr int I_T = I_WIN + 3 * I_SQ;
    constexpr int I_RSTD = (MROWS + 16 + 7) / 8;
    constexpr int I_ROPE = (4112 * 8 + 511) / 512;
    constexpr int I_ZERO = 393216 / 8192;
    constexpr int I_ALL = I_T + I_RSTD + I_ROPE + I_ZERO;
    for (int it = blockIdx.x; it < I_ALL; it += gridDim.x) {
        int r = it;
        if (r < I_WIN) { p0_transpose_item<0>(p, r, tile); continue; } r -= I_WIN;
        if (r < I_SQ) { p0_transpose_item<1>(p, r, tile); continue; } r -= I_SQ;
        if (r < I_SQ) { p0_transpose_item<2>(p, r, tile); continue; } r -= I_SQ;
        if (r < I_SQ) { p0_transpose_item<3>(p, r, tile); continue; } r -= I_SQ;
        if (r < I_RSTD) {
            const int row = r * 8 + wave;
            if (row < MROWS + 16) {
                const float* src = row < MROWS ? p.x + (size_t)row * 1024 : p.meta + (size_t)(row - MROWS) * 1024;
                const f32x4* xr = (const f32x4*)src + lane;
                float s = 0.f;
#pragma unroll
                for (int j = 0; j < 4; ++j) { const f32x4 v = xr[64 * j]; s += (v.x * v.x + v.y * v.y) + (v.z * v.z + v.w * v.w); }
                s = wave_sum(s);
                if (lane == 0) ((float*)(p.ws + OFF_RSTD))[row] = 1.0f / sqrtf(s * (1.0f / 1024.0f) + EPS);
            }
            continue;
        }
        r -= I_RSTD;
        if (r < I_ROPE) {
            const int e = r * 512 + tid;
            if (e < 4112 * 8) {
                const int pos = e >> 3, i = e & 7;
                const float inv = powf(500000.0f, -(float)i / 8.0f);
                const float ang = (float)pos * inv;
                float* t = (float*)(p.ws + OFF_ROPE) + (size_t)e * 2;
                t[0] = cosf(ang); t[1] = sinf(ang);
            }
            continue;
        }
        r -= I_ROPE;
        { u32x4 z = {0u, 0u, 0u, 0u}; *(u32x4*)(p.ws + OFF_AKM + (size_t)r * 8192 + tid * 16) = z; }
    }
}

template <int XMODE, bool HS>
DI void gemm_tile(f32x16 (&acc)[2][2], const bf16_t* __restrict__ Wt, const void* __restrict__ Xv, int xvalid, unsigned char* lds, const float (&hs)[2][3]) {
    const int tid = threadIdx.x, lane = tid & 63, wave = tid >> 6, l31 = lane & 31, h = lane >> 5;
    const int wn = wave & 1, wm = wave >> 1;
    u32x4 wreg[2];
    u32x4 xreg[4];
    f32x4 xf[8];
#define G_LOAD(kt_)                                                                                                  \
    {                                                                                                                \
        const int k0_ = (kt_) * 64;                                                                                  \
        _Pragma("unroll") for (int i = 0; i < 2; ++i) { const int pi = tid + 512 * i, row = pi >> 3, c = pi & 7;      \
            wreg[i] = *(const u32x4*)(Wt + (size_t)row * 1024 + k0_ + c * 8); }                                      \
        if (XMODE == 1) {                                                                                            \
            _Pragma("unroll") for (int i = 0; i < 8; ++i) { const int pi = tid + 512 * i, row = pi >> 4, c4 = pi & 15; \
                const int rr = row < xvalid ? row : 0;                                                               \
                xf[i] = *(const f32x4*)((const float*)Xv + (size_t)rr * 1024 + k0_ + c4 * 4); }                      \
        } else {                                                                                                     \
            _Pragma("unroll") for (int i = 0; i < 4; ++i) { const int pi = tid + 512 * i, row = pi >> 3, c = pi & 7;  \
                xreg[i] = *(const u32x4*)((const bf16_t*)Xv + (size_t)row * 1024 + k0_ + c * 8); }                   \
        }                                                                                                            \
    }
#define G_STORE(kt_, buf_)                                                                                           \
    {                                                                                                                \
        unsigned char* sW_ = lds + (buf_) * G_STAGE; unsigned char* sX_ = sW_ + G_SW;                                \
        _Pragma("unroll") for (int i = 0; i < 2; ++i) { const int pi = tid + 512 * i, row = pi >> 3, c = pi & 7;      \
            *(u32x4*)(sW_ + row * G_ROWB + c * 16) = wreg[i]; }                                                      \
        if (XMODE == 1) {                                                                                            \
            _Pragma("unroll") for (int i = 0; i < 8; ++i) { const int pi = tid + 512 * i, row = pi >> 4, c4 = pi & 15; \
                u32x2 v_; v_.x = pk2(xf[i].x, xf[i].y); v_.y = pk2(xf[i].z, xf[i].w);                                \
                *(u32x2*)(sX_ + row * G_ROWB + c4 * 8) = v_; }                                                       \
        } else {                                                                                                     \
            _Pragma("unroll") for (int i = 0; i < 4; ++i) { const int pi = tid + 512 * i, row = pi >> 3, c = pi & 7;  \
                *(u32x4*)(sX_ + row * G_ROWB + c * 16) = xreg[i]; }                                                  \
        }                                                                                                            \
    }
    G_LOAD(0);
    G_STORE(0, 0);
    __syncthreads();
    for (int kt = 0; kt < 16; ++kt) {
        if (kt + 1 < 16) G_LOAD(kt + 1);
        if (HS) {
            if (kt == 4 || kt == 8 || kt == 12) {
                const float s0 = kt == 4 ? hs[0][0] : (kt == 8 ? hs[0][1] : hs[0][2]);
                const float s1 = kt == 4 ? hs[1][0] : (kt == 8 ? hs[1][1] : hs[1][2]);
#pragma unroll
                for (int i = 0; i < 16; ++i) { acc[0][0][i] *= s0; acc[1][0][i] *= s0; acc[0][1][i] *= s1; acc[1][1][i] *= s1; }
            }
        }
        {
            const unsigned char* sW = lds + (kt & 1) * G_STAGE + (wn * 64 + l31) * G_ROWB + h * 16;
            const unsigned char* sX = lds + (kt & 1) * G_STAGE + G_SW + (wm * 64 + l31) * G_ROWB + h * 16;
#pragma unroll
            for (int ks = 0; ks < 4; ++ks) {
                const bf16x8 w0 = *(const bf16x8*)(sW + ks * 32), w1 = *(const bf16x8*)(sW + 32 * G_ROWB + ks * 32);
                const bf16x8 x0 = *(const bf16x8*)(sX + ks * 32), x1 = *(const bf16x8*)(sX + 32 * G_ROWB + ks * 32);
                acc[0][0] = MFMA32(w0, x0, acc[0][0]); acc[0][1] = MFMA32(w0, x1, acc[0][1]);
                acc[1][0] = MFMA32(w1, x0, acc[1][0]); acc[1][1] = MFMA32(w1, x1, acc[1][1]);
            }
        }
        if (kt + 1 < 16) G_STORE(kt + 1, (kt + 1) & 1);
        __syncthreads();
    }
#undef G_LOAD
#undef G_STORE
}

DI void zero_acc(f32x16 (&acc)[2][2]) {
#pragma unroll
    for (int a = 0; a < 2; ++a)
#pragma unroll
        for (int b = 0; b < 2; ++b)
#pragma unroll
            for (int i = 0; i < 16; ++i) acc[a][b][i] = 0.f;
}

DI void p1_epilogue(const Params& p, f32x16 (&acc)[2][2], int mt, int nt) {
    const int tid = threadIdx.x, lane = tid & 63, wave = tid >> 6, l31 = lane & 31, h = lane >> 5;
    const int wn = wave & 1, wm = wave >> 1;
    const bool meta = (mt == 64);
    int split, nc0;
    if (nt < 8) { split = 0; nc0 = nt * 128; }
    else if (nt < 16) { split = 1; nc0 = (nt - 8) * 128; }
    else if (nt < 24) { split = 2; nc0 = (nt - 16) * 128; }
    else if (nt < 32) { split = 3; nc0 = (nt - 24) * 128; }
    else if (nt < 36) { split = 4; nc0 = (nt - 32) * 128; }
    else if (nt < 40) { split = 5; nc0 = (nt - 36) * 128; }
    else if (nt < 48) { split = 6; nc0 = (nt - 40) * 128; }
    else if (nt < 56) { split = 7; nc0 = (nt - 48) * 128; }
    else if (nt < 64) { split = 9; nc0 = (nt - 56) * 128; }
    else if (nt < 72) { split = 10; nc0 = (nt - 64) * 128; }
    else { split = 8; nc0 = 0; }
    const float* rstd = (const float*)(p.ws + OFF_RSTD);
    const float* rope = (const float*)(p.ws + OFF_ROPE);
    unsigned char* ws = p.ws;
    unsigned char* dout = (unsigned char*)p.out;
#pragma unroll
    for (int im = 0; im < 2; ++im) {
        const int lr = wm * 64 + im * 32 + l31;
        const int tok = meta ? MROWS + (lr & 15) : mt * 256 + lr;
        const bool rvalid = !meta || lr < 16;
        const float rs = rstd[tok];
        const int pos = meta ? (lr & 15) : 16 + (tok & 4095);
        const int b = (tok >> 12) & 3, s = tok & 4095;
#pragma unroll
        for (int in = 0; in < 2; ++in) {
            const int nb = nc0 + wn * 64 + in * 32;
            float v[16];
#pragma unroll
            for (int i = 0; i < 16; ++i) v[i] = acc[in][im][i] * rs;
            if (split <= 1 && (nb & 63) == 0) {
                const float* cs = rope + ((size_t)pos * 8 + 4 * h) * 2;
#pragma unroll
                for (int i = 0; i < 4; ++i) {
                    const float c = cs[2 * i], sn = cs[2 * i + 1];
                    const float x1 = v[i], x2 = v[i + 4];
                    v[i] = x1 * c - x2 * sn; v[i + 4] = x2 * c + x1 * sn;
                }
            }
            if (!rvalid) continue;
            if (split == 2 || split == 6) {
                const int hshift = split == 2 ? 7 : 8;
                const int nheads = split == 2 ? 8 : 4;
                const int dvn = 1 << hshift;
                bf16_t* base = (bf16_t*)(ws + (split == 2 ? OFF_AVT : OFF_GVT));
                bf16_t* basem = (bf16_t*)(ws + (split == 2 ? OFF_AVTM : OFF_GVTM));
#pragma unroll
                for (int i = 0; i < 16; ++i) {
                    const int n = nb + (i & 3) + 8 * (i >> 2) + 4 * h;
                    const int hd = n >> hshift, dv = n & (dvn - 1);
                    const bf16_t val = f2bf(v[i]);
                    if (meta) basem[(size_t)(hd * dvn + dv) * 64 + 48 + lr] = val;
                    else base[((size_t)(b * nheads + hd) * dvn + dv) * 4096 + s] = val;
                }
            } else {
                bf16_t* dst; int ld; int row = tok;
                bool skip = false;
                switch (split) {
                    case 0: dst = (bf16_t*)(dout + DO_AQ); ld = 1024; skip = meta; break;
                    case 1: if (meta) { dst = (bf16_t*)(ws + OFF_AKM); row = 48 + lr; } else dst = (bf16_t*)(ws + OFF_AK); ld = 1024; break;
                    case 3: dst = (bf16_t*)(ws + OFF_AZ); ld = 1024; skip = meta; break;
                    case 4: dst = (bf16_t*)(dout + DO_GQ); ld = 512; skip = meta; break;
                    case 5: if (meta) { dst = (bf16_t*)(ws + OFF_GKM); row = lr; } else dst = (bf16_t*)(dout + DO_GK); ld = 512; break;
                    case 7: dst = (bf16_t*)(ws + OFF_GZ); ld = 1024; skip = meta; break;
                    case 9: dst = (bf16_t*)(ws + OFF_GA); ld = 1024; skip = meta; break;
                    case 10: dst = (bf16_t*)(ws + OFF_GB); ld = 1024; skip = meta; break;
                    default: if (meta) { dst = (bf16_t*)(ws + OFF_GLRM); row = lr; } else dst = (bf16_t*)(ws + OFF_GLR); ld = 16; skip = (wn != 0 || in != 0); break;
                }
                if (skip) continue;
#pragma unroll
                for (int g = 0; g < 4; ++g) {
                    if (split == 8 && g >= 2) continue;
                    u32x2 o; o.x = pk2(v[4 * g], v[4 * g + 1]); o.y = pk2(v[4 * g + 2], v[4 * g + 3]);
                    *(u32x2*)(dst + (size_t)row * ld + nb + 8 * g + 4 * h) = o;
                }
            }
        }
    }
}

DI void phase1(const Params& p, unsigned char* lds) {
    constexpr int NT = 73;
    constexpr int MAIN = 64 * NT, TOTAL = MAIN + NT;
    const bf16_t* wt = (const bf16_t*)(p.ws + OFF_WIN_T);
    for (int id = blockIdx.x; id < TOTAL; id += gridDim.x) {
        int mt, nt;
        if (id < MAIN) { const int g = id / (16 * NT), rem = id % (16 * NT); nt = rem >> 4; mt = g * 16 + (rem & 15); }
        else { mt = 64; nt = id - MAIN; }
        if (mt == 64) {
            const bool need = (nt >= 8 && nt < 24) || (nt >= 36 && nt < 48) || nt == 72;
            if (!need) continue;
        }
        f32x16 acc[2][2];
        zero_acc(acc);
        const float* X = mt == 64 ? p.meta : p.x + (size_t)mt * 256 * 1024;
        const float hs0[2][3] = {{1.f, 1.f, 1.f}, {1.f, 1.f, 1.f}};
        gemm_tile<1, false>(acc, wt + (size_t)nt * 128 * 1024, X, mt == 64 ? 16 : 256, lds, hs0);
        p1_epilogue(p, acc, mt, nt);
    }
}

DI void phase15(const Params& p, unsigned char* lds) {
    const int tid = threadIdx.x, col = tid;
    float w2[16];
#pragma unroll
    for (int j = 0; j < 16; ++j) w2[j] = p.gate_w2[j * 512 + col];
    const float bias = p.gate_b[col];
    unsigned char* ws = p.ws;
    unsigned char* dout = (unsigned char*)p.out;
    for (int item = blockIdx.x; item < 257; item += gridDim.x) {
        const bool meta = item == 256;
        const int b = item >> 6, c = item & 63;
        const size_t row0 = (size_t)b * 4096 + c * 64;
        const bf16_t* glr = meta ? (const bf16_t*)(ws + OFF_GLRM) : (const bf16_t*)(ws + OFF_GLR) + row0 * 16;
        const int nrows = meta ? 16 : 64;
        bf16_t* qp = (bf16_t*)(dout + DO_GQ) + row0 * 512 + col;
        const bf16_t* kin = meta ? (const bf16_t*)(ws + OFF_GKM) + col : (const bf16_t*)(dout + DO_GK) + row0 * 512 + col;
        bf16_t* kout = meta ? (bf16_t*)(ws + OFF_KTM) + 48 * 512 + col : (bf16_t*)(dout + DO_GK) + row0 * 512 + col;
        bf16_t* ktt = meta ? (bf16_t*)(ws + OFF_KTTM) + (size_t)col * 64 + 48 : (bf16_t*)(ws + OFF_WIN_T) + ((size_t)b * 512 + col) * 4096 + c * 64;
        float bsum = 0.f;
        for (int r0 = 0; r0 < nrows; r0 += 8) {
            float kt8[8];
#pragma unroll
            for (int rr = 0; rr < 8; ++rr) {
                const int r = r0 + rr;
                const u32x4* g4 = (const u32x4*)(glr + r * 16);
                const u32x4 ga = g4[0], gb = g4[1];
                float gk = bias;
                gk += bflo(ga.x) * w2[0] + bfhi(ga.x) * w2[1] + bflo(ga.y) * w2[2] + bfhi(ga.y) * w2[3];
                gk += bflo(ga.z) * w2[4] + bfhi(ga.z) * w2[5] + bflo(ga.w) * w2[6] + bfhi(ga.w) * w2[7];
                gk += bflo(gb.x) * w2[8] + bfhi(gb.x) * w2[9] + bflo(gb.y) * w2[10] + bfhi(gb.y) * w2[11];
                gk += bflo(gb.z) * w2[12] + bfhi(gb.z) * w2[13] + bflo(gb.w) * w2[14] + bfhi(gb.w) * w2[15];
                const float lg = (fminf(gk, 0.f) - log1pf(expf(-fabsf(gk)))) * (1.0f / 16.0f);
                bsum += lg;
                const float kv = bf2f(kin[(size_t)r * 512]);
                const float kt = kv * expf(-bsum);
                kt8[rr] = kt;
                kout[(size_t)r * 512] = f2bf(kt);
                if (!meta) {
                    const float qv = bf2f(qp[(size_t)r * 512]);
                    qp[(size_t)r * 512] = f2bf(qv * 0.08838834764831845f * expf(bsum));
                }
            }
            u32x4 o; o.x = pk2(kt8[0], kt8[1]); o.y = pk2(kt8[2], kt8[3]); o.z = pk2(kt8[4], kt8[5]); o.w = pk2(kt8[6], kt8[7]);
            *(u32x4*)(ktt + r0) = o;
        }
        if (meta) {
            ((float*)(ws + OFF_DECM))[col] = expf(bsum);
            bf16_t* km = (bf16_t*)(ws + OFF_KTM);
            for (int r = 0; r < 48; ++r) km[r * 512 + col] = 0;
            u32x4 z = {0u, 0u, 0u, 0u};
            u32x4* kz = (u32x4*)((bf16_t*)(ws + OFF_KTTM) + (size_t)col * 64);
#pragma unroll
            for (int j = 0; j < 6; ++j) kz[j] = z;
        } else {
            ((float*)(ws + OFF_DEC))[((size_t)b * 64 + c) * 512 + col] = expf(bsum);
        }
    }
}

constexpr int A_KROWB = 272, A_VROWB = 136, A_KB = 64 * A_KROWB, A_VB = 128 * A_VROWB, A_STAGE = A_KB + A_VB;
DI void attn_item(const Params& p, unsigned char* lds, int b, int hd, int qb) {
    const int tid = threadIdx.x, lane = tid & 63, wave = tid >> 6, l31 = lane & 31, h = lane >> 5;
    const int sub = wave >> 2, rt = wave & 3;
    const bf16_t* aq = (const bf16_t*)((unsigned char*)p.out + DO_AQ);
    const bf16_t* ak = (const bf16_t*)(p.ws + OFF_AK);
    const bf16_t* avT = (const bf16_t*)(p.ws + OFF_AVT);
    const bf16_t* akm = (const bf16_t*)(p.ws + OFF_AKM);
    const bf16_t* avTm = (const bf16_t*)(p.ws + OFF_AVTM);
    bf16_t* az = (bf16_t*)(p.ws + OFF_AZ);
    const int qs = qb * 128 + rt * 32 + l31;
    const size_t grow = (size_t)b * 4096 + qs;
    bf16x8 qf[4];
#pragma unroll
    for (int ks = 0; ks < 4; ++ks) qf[ks] = *(const bf16x8*)(aq + grow * 1024 + hd * 128 + sub * 64 + ks * 16 + 8 * h);
    f32x16 O[4];
#pragma unroll
    for (int d = 0; d < 4; ++d)
#pragma unroll
        for (int i = 0; i < 16; ++i) O[d][i] = 0.f;
    float m = -INFINITY, l = 0.f;
    const int T = 2 * qb + 3;
    const float SC = 0.125f * 1.4426950408889634f;
    u32x4 kreg[2], vreg[2];
    const int krow_ = tid >> 4, kc_ = tid & 15, vdv_ = tid >> 3, vc_ = tid & 7;
    const bf16_t* kp = ak + ((size_t)b * 4096 + krow_) * 1024 + hd * 128 + kc_ * 8;
    const bf16_t* vp_ = avT + ((size_t)(b * 8 + hd) * 128 + vdv_) * 4096 + vc_ * 8;
#define A_LOAD_META()                                                                                                         \
    {                                                                                                                         \
        const bf16_t* km_ = akm + (size_t)krow_ * 1024 + hd * 128 + kc_ * 8;                                                  \
        kreg[0] = *(const u32x4*)km_; kreg[1] = *(const u32x4*)(km_ + 32 * 1024);                                             \
        const bf16_t* vm_ = avTm + (size_t)(hd * 128 + vdv_) * 64 + vc_ * 8;                                                  \
        vreg[0] = *(const u32x4*)vm_; vreg[1] = *(const u32x4*)(vm_ + 64 * 64);                                               \
    }
#define A_LOADK_REAL() { kreg[0] = *(const u32x4*)kp; kreg[1] = *(const u32x4*)(kp + 32 * 1024); kp += 64 * 1024; }
#define A_LOADV_REAL() { vreg[0] = *(const u32x4*)vp_; vreg[1] = *(const u32x4*)(vp_ + (size_t)64 * 4096); vp_ += 64; }
#define A_STOREK(buf_)                                                                                                        \
    {                                                                                                                         \
        unsigned char* sK_ = lds + (buf_) * A_STAGE;                                                                          \
        _Pragma("unroll") for (int i = 0; i < 2; ++i) { const int pi = tid + 512 * i, row = pi >> 4, c = pi & 15;              \
            *(u32x4*)(sK_ + row * A_KROWB + c * 16) = kreg[i]; }                                                              \
    }
#define A_STOREV(buf_)                                                                                                        \
    {                                                                                                                         \
        unsigned char* sV_ = lds + (buf_) * A_STAGE + A_KB;                                                                   \
        _Pragma("unroll") for (int i = 0; i < 2; ++i) { const int pi = tid + 512 * i, dv = pi >> 3, c = pi & 7;                \
            unsigned char* d_ = sV_ + dv * A_VROWB + c * 16; u32x2 a_, b_; a_.x = vreg[i].x; a_.y = vreg[i].y; b_.x = vreg[i].z; b_.y = vreg[i].w; \
            *(u32x2*)d_ = a_; *(u32x2*)(d_ + 8) = b_; }                                                                       \
    }
    A_LOAD_META();
    A_STOREK(0);
    A_STOREV(0);
    __syncthreads();
    for (int tt = 0; tt < T; ++tt) {
        if (tt + 1 < T) A_LOADK_REAL();
        {
            const unsigned char* sK = lds + (tt & 1) * A_STAGE;
            const unsigned char* sV = sK + A_KB;
            f32x16 st[2];
#pragma unroll
            for (int k2 = 0; k2 < 2; ++k2)
#pragma unroll
                for (int i = 0; i < 16; ++i) st[k2][i] = 0.f;
#pragma unroll
            for (int k2 = 0; k2 < 2; ++k2)
#pragma unroll
                for (int ks = 0; ks < 4; ++ks) {
                    const bf16x8 kf = *(const bf16x8*)(sK + (k2 * 32 + l31) * A_KROWB + (sub * 64 + ks * 16 + 8 * h) * 2);
                    st[k2] = MFMA32(kf, qf[ks], st[k2]);
                }
            __builtin_amdgcn_sched_barrier(0);
            if (tt + 1 < T) { A_STOREK((tt + 1) & 1); A_LOADV_REAL(); }
            if (tt == 0) {
#pragma unroll
                for (int i = 0; i < 16; ++i) { st[0][i] = -INFINITY; if (i < 8) st[1][i] = -INFINITY; }
            } else if (tt >= 2 * qb + 1) {
                const int kbase = (tt - 1) * 64 + 4 * h;
#pragma unroll
                for (int k2 = 0; k2 < 2; ++k2)
#pragma unroll
                    for (int i = 0; i < 16; ++i) {
                        const int key = kbase + k2 * 32 + (i & 3) + 8 * (i >> 2);
                        if (key > qs) st[k2][i] = -INFINITY;
                    }
            }
            float mx = -INFINITY;
#pragma unroll
            for (int k2 = 0; k2 < 2; ++k2)
#pragma unroll
                for (int i = 0; i < 16; ++i) mx = fmaxf(mx, st[k2][i]);
            mx = fmaxf(mx, __shfl_xor(mx, 32));
            const float mnew = fmaxf(m, mx);
            const float alpha = __builtin_amdgcn_exp2f((m - mnew) * SC);
            const float mc = mnew * SC;
            m = mnew;
            float ps = 0.f;
#pragma unroll
            for (int k2 = 0; k2 < 2; ++k2)
#pragma unroll
                for (int i = 0; i < 16; ++i) { const float pv = __builtin_amdgcn_exp2f(st[k2][i] * SC - mc); st[k2][i] = pv; ps += pv; }
            l = l * alpha + ps;
#pragma unroll
            for (int d = 0; d < 4; ++d)
#pragma unroll
                for (int i = 0; i < 16; ++i) O[d][i] *= alpha;
            bf16x8 pb[4];
#pragma unroll
            for (int k4 = 0; k4 < 4; ++k4) {
                const int k2 = k4 >> 1, o8 = 8 * (k4 & 1);
                u32x4 pk;
                pk.x = pk2(st[k2][o8 + 0], st[k2][o8 + 1]); pk.y = pk2(st[k2][o8 + 2], st[k2][o8 + 3]);
                pk.z = pk2(st[k2][o8 + 4], st[k2][o8 + 5]); pk.w = pk2(st[k2][o8 + 6], st[k2][o8 + 7]);
                pb[k4] = __builtin_bit_cast(bf16x8, pk);
            }
#pragma unroll
            for (int d = 0; d < 4; ++d)
#pragma unroll
                for (int k4 = 0; k4 < 4; ++k4) {
                    const unsigned char* vp = sV + (d * 32 + l31) * A_VROWB + (k4 * 16 + 4 * h) * 2;
                    const u32x2 lo = *(const u32x2*)vp, hi = *(const u32x2*)(vp + 16);
                    u32x4 vv; vv.x = lo.x; vv.y = lo.y; vv.z = hi.x; vv.w = hi.y;
                    O[d] = MFMA32(__builtin_bit_cast(bf16x8, vv), pb[k4], O[d]);
                    if (k4 == 3) __builtin_amdgcn_sched_barrier(0);
                }
        }
        if (tt + 1 < T) A_STOREV((tt + 1) & 1);
        __syncthreads();
    }
#undef A_LOAD_META
#undef A_LOADK_REAL
#undef A_LOADV_REAL
#undef A_STOREK
#undef A_STOREV
    float lam;
    {
        const float a_ = wave_sum(p.lq1[lane] * p.lk1[lane]);
        const float b_ = wave_sum(p.lq2[lane] * p.lk2[lane]);
        lam = expf(a_) - expf(b_) + 0.2f;
    }
    const float ltot = l + __shfl_xor(l, 32);
    const float linv = 1.0f / ltot;
    float* ex = (float*)lds;
    if (sub == 1) {
#pragma unroll
        for (int d = 0; d < 4; ++d)
#pragma unroll
            for (int i = 0; i < 16; ++i) { ex[(rt * 32 + l31) * 129 + d * 32 + (i & 3) + 8 * (i >> 2) + 4 * h] = O[d][i] * linv; if (i == 15) __builtin_amdgcn_sched_barrier(0); }
    }
    __syncthreads();
    if (sub == 0) {
        float ss = 0.f;
#pragma unroll
        for (int d = 0; d < 4; ++d)
#pragma unroll
            for (int i = 0; i < 16; ++i) {
                const float o2 = ex[(rt * 32 + l31) * 129 + d * 32 + (i & 3) + 8 * (i >> 2) + 4 * h];
                const float o = O[d][i] * linv - lam * o2;
                O[d][i] = o; ss += o * o;
                if (i == 15) __builtin_amdgcn_sched_barrier(0);
            }
        ss += __shfl_xor(ss, 32);
        const float rstd = 1.0f / sqrtf(ss * (1.0f / 128.0f) + EPS);
#pragma unroll
        for (int d = 0; d < 4; ++d)
#pragma unroll
            for (int g = 0; g < 4; ++g) {
                bf16_t* zp = az + grow * 1024 + hd * 128 + d * 32 + 8 * g + 4 * h;
                const u32x2 zz = *(const u32x2*)zp;
                u32x2 o;
                o.x = pk2(O[d][4 * g] * rstd * siluf_(bflo(zz.x)), O[d][4 * g + 1] * rstd * siluf_(bfhi(zz.x)));
                o.y = pk2(O[d][4 * g + 2] * rstd * siluf_(bflo(zz.y)), O[d][4 * g + 3] * rstd * siluf_(bfhi(zz.y)));
                *(u32x2*)zp = o;
                if (g == 3) __builtin_amdgcn_sched_barrier(0);
            }
    }
    __syncthreads();
}

constexpr int L_KROWB = 272, L_VROWB = 144, L_SROWB = 272;
constexpr int L_K = 0, L_V = 64 * L_KROWB, L_S = L_V + 32 * L_VROWB, L_END = L_S + 32 * L_SROWB;
DI void gla_item(const Params& p, unsigned char* lds, int b, int hh, int sl) {
    const int tid = threadIdx.x, lane = tid & 63, wave = tid >> 6, l15 = lane & 15, g = lane >> 4;
    const int tt = wave & 3, dvt = wave >> 2;
    unsigned char* ws = p.ws;
    unsigned char* dout = (unsigned char*)p.out;
    const bf16_t* gq = (const bf16_t*)(dout + DO_GQ);
    const bf16_t* gk = (const bf16_t*)(dout + DO_GK);
    const bf16_t* gvT = (const bf16_t*)(ws + OFF_GVT);
    const bf16_t* ktt = (const bf16_t*)(ws + OFF_WIN_T);
    const float* dec = (const float*)(ws + OFF_DEC);
    bf16_t* gz = (bf16_t*)(ws + OFF_GZ);
    float* ssqb = (float*)(ws + OFF_SSQB);
    unsigned char* sK = lds + L_K; unsigned char* sV = lds + L_V; unsigned char* sS = lds + L_S;
    for (int i = tid; i < 32 * L_SROWB / 4; i += 512) ((unsigned*)sS)[i] = 0u;
    f32x4 sacc[2];
#pragma unroll
    for (int c = 0; c < 2; ++c) sacc[c] = (f32x4){0.f, 0.f, 0.f, 0.f};
    u32x4 nk[2]; u32x4 nv; bf16x8 nq[4]; bf16x8 nkt[2][2]; float nd[2]; u32x2 ngz;
    const int cc0 = 16 * (2 * tt) + l15;
    const int krow_ = tid >> 4, kc_ = tid & 15, vdv_ = (tid >> 3) & 31, vc_ = tid & 7;
    const bf16_t* kp = gk + ((size_t)b * 4096 + krow_) * 512 + hh * 128 + kc_ * 8;
    const bf16_t* vp_ = gvT + ((size_t)(b * 4 + hh) * 256 + sl * 32 + vdv_) * 4096 + vc_ * 8;
    const bf16_t* ktp = ktt + ((size_t)(b * 4 + hh) * 128 + cc0) * 4096 + 8 * g;
    const float* dp = dec + (size_t)b * 64 * 512 + hh * 128 + cc0;
    const bf16_t* qp = gq + ((size_t)b * 4096 + 16 * tt + l15) * 512 + hh * 128 + 8 * g;
    bf16_t* gzp = gz + ((size_t)b * 4096 + 16 * tt + l15) * 1024 + hh * 256 + sl * 32 + 16 * dvt + 4 * g;
#define L_LOAD_META()                                                                                                         \
    {                                                                                                                         \
        const bf16_t* km_ = (const bf16_t*)(ws + OFF_KTM) + (size_t)krow_ * 512 + hh * 128 + kc_ * 8;                         \
        nk[0] = *(const u32x4*)km_; nk[1] = *(const u32x4*)(km_ + 32 * 512);                                                  \
        nv = *(const u32x4*)((const bf16_t*)(ws + OFF_GVTM) + (size_t)(hh * 256 + sl * 32 + vdv_) * 64 + vc_ * 8);            \
        _Pragma("unroll") for (int ct = 0; ct < 2; ++ct) _Pragma("unroll") for (int ks = 0; ks < 2; ++ks)                     \
            nkt[ct][ks] = *(const bf16x8*)((const bf16_t*)(ws + OFF_KTTM) + (size_t)(hh * 128 + cc0 + 16 * ct) * 64 + 32 * ks + 8 * g); \
        _Pragma("unroll") for (int ct = 0; ct < 2; ++ct) nd[ct] = ((const float*)(ws + OFF_DECM))[hh * 128 + cc0 + 16 * ct];  \
        _Pragma("unroll") for (int ks = 0; ks < 4; ++ks) nq[ks] = (bf16x8){0, 0, 0, 0, 0, 0, 0, 0};                           \
        ngz = (u32x2){0u, 0u};                                                                                                \
    }
#define L_LOAD_REAL()                                                                                                         \
    {                                                                                                                         \
        nk[0] = *(const u32x4*)kp; nk[1] = *(const u32x4*)(kp + 32 * 512); kp += 64 * 512;                                    \
        nv = *(const u32x4*)vp_; vp_ += 64;                                                                                   \
        _Pragma("unroll") for (int ct = 0; ct < 2; ++ct) _Pragma("unroll") for (int ks = 0; ks < 2; ++ks)                     \
            nkt[ct][ks] = *(const bf16x8*)(ktp + (size_t)(16 * ct) * 4096 + 32 * ks);                                         \
        ktp += 64;                                                                                                            \
        nd[0] = dp[0]; nd[1] = dp[16]; dp += 512;                                                                             \
        _Pragma("unroll") for (int ks = 0; ks < 4; ++ks) nq[ks] = *(const bf16x8*)(qp + 32 * ks);                             \
        qp += 64 * 512;                                                                                                       \
        ngz = *(const u32x2*)gzp; gzp += 64 * 1024;                                                                           \
    }
#define L_STORE()                                                                                                             \
    {                                                                                                                         \
        _Pragma("unroll") for (int i = 0; i < 2; ++i) { const int pi = tid + 512 * i, row = pi >> 4, c = pi & 15;              \
            *(u32x4*)(sK + row * L_KROWB + c * 16) = nk[i]; }                                                                 \
        if (tid < 256) { const int dv = tid >> 3, c = tid & 7; *(u32x4*)(sV + dv * L_VROWB + c * 16) = nv; }                  \
    }
    L_LOAD_META();
    L_STORE();
    for (int n = 0; n <= 64; ++n) {
        bf16x8 cq[4], ckt[2][2]; float cd[2]; u32x2 cgz;
#pragma unroll
        for (int ks = 0; ks < 4; ++ks) cq[ks] = nq[ks];
#pragma unroll
        for (int ct = 0; ct < 2; ++ct) { cd[ct] = nd[ct]; ckt[ct][0] = nkt[ct][0]; ckt[ct][1] = nkt[ct][1]; }
        cgz = ngz;
        __syncthreads();
        if (n + 1 <= 64) L_LOAD_REAL();
        if (n > 0) {
            f32x4 at[4];
#pragma unroll
            for (int jt = 0; jt < 4; ++jt) at[jt] = (f32x4){0.f, 0.f, 0.f, 0.f};
#pragma unroll
            for (int jt = 0; jt < 4; ++jt)
#pragma unroll
                for (int ks = 0; ks < 4; ++ks) {
                    const bf16x8 kf = *(const bf16x8*)(sK + (jt * 16 + l15) * L_KROWB + (ks * 32 + 8 * g) * 2);
                    at[jt] = MFMA16(kf, cq[ks], at[jt]);
                }
            const int tl = 16 * tt + l15;
#pragma unroll
            for (int jt = 0; jt < 4; ++jt)
#pragma unroll
                for (int i = 0; i < 4; ++i) if (16 * jt + 4 * g + i > tl) at[jt][i] = 0.f;
            f32x4 o = (f32x4){0.f, 0.f, 0.f, 0.f};
#pragma unroll
            for (int s2 = 0; s2 < 2; ++s2) {
                u32x4 pa;
                pa.x = pk2(at[2 * s2][0], at[2 * s2][1]); pa.y = pk2(at[2 * s2][2], at[2 * s2][3]);
                pa.z = pk2(at[2 * s2 + 1][0], at[2 * s2 + 1][1]); pa.w = pk2(at[2 * s2 + 1][2], at[2 * s2 + 1][3]);
                const unsigned char* vp = sV + (dvt * 16 + l15) * L_VROWB + (32 * s2 + 4 * g) * 2;
                const u32x2 lo = *(const u32x2*)vp, hi = *(const u32x2*)(vp + 32);
                u32x4 vv; vv.x = lo.x; vv.y = lo.y; vv.z = hi.x; vv.w = hi.y;
                o = MFMA16(__builtin_bit_cast(bf16x8, vv), __builtin_bit_cast(bf16x8, pa), o);
            }
#pragma unroll
            for (int ks = 0; ks < 4; ++ks) {
                const bf16x8 sf = *(const bf16x8*)(sS + (dvt * 16 + l15) * L_SROWB + (ks * 32 + 8 * g) * 2);
                o = MFMA16(sf, cq[ks], o);
            }
            const size_t row = (size_t)b * 4096 + (n - 1) * 64 + 16 * tt + l15;
            float ss = (o[0] * o[0] + o[1] * o[1]) + (o[2] * o[2] + o[3] * o[3]);
            ss += __shfl_xor(ss, 16); ss += __shfl_xor(ss, 32);
            u32x2 ov;
            ov.x = pk2(o[0] * siluf_(bflo(cgz.x)), o[1] * siluf_(bfhi(cgz.x)));
            ov.y = pk2(o[2] * siluf_(bflo(cgz.y)), o[3] * siluf_(bfhi(cgz.y)));
            *(u32x2*)(gz + row * 1024 + hh * 256 + sl * 32 + 16 * dvt + 4 * g) = ov;
            if (g == 0) ssqb[(row * 4 + hh) * 16 + sl * 2 + dvt] = ss;
        }
#pragma unroll
        for (int ks = 0; ks < 2; ++ks) {
            const bf16x8 vf = *(const bf16x8*)(sV + (dvt * 16 + l15) * L_VROWB + (32 * ks + 8 * g) * 2);
            sacc[0] = MFMA16(vf, ckt[0][ks], sacc[0]);
            sacc[1] = MFMA16(vf, ckt[1][ks], sacc[1]);
        }
#pragma unroll
        for (int ct = 0; ct < 2; ++ct)
#pragma unroll
            for (int i = 0; i < 4; ++i) sacc[ct][i] *= cd[ct];
        __syncthreads();
#pragma unroll
        for (int ct = 0; ct < 2; ++ct)
#pragma unroll
            for (int i = 0; i < 4; ++i)
                *(bf16_t*)(sS + (16 * dvt + 4 * g + i) * L_SROWB + (cc0 + 16 * ct) * 2) = f2bf(sacc[ct][i]);
        if (n + 1 <= 64) L_STORE();
    }
#undef L_LOAD_META
#undef L_LOAD_REAL
#undef L_STORE
    __syncthreads();
}

DI void phase2(const Params& p, unsigned char* lds) {
    const int tid = threadIdx.x, lane = tid & 63;
    unsigned* ctr = (unsigned*)(p.ws + OFF_CTR);
    volatile unsigned* sItem = (volatile unsigned*)(lds + LDS_ITEM);
    constexpr unsigned N_GLA = 128, N_ATT = 1024;
    for (;;) {
        if (tid == 0) *sItem = atomicAdd(ctr, 1u);
        __syncthreads();
        const unsigned item = *sItem;
        __syncthreads();
        if (item >= N_GLA + N_ATT) break;
        if (item < N_GLA) gla_item(p, lds, item >> 5, (item >> 3) & 3, item & 7);
        else { const unsigned a = item - N_GLA; attn_item(p, lds, a & 3, (a >> 2) & 7, 31 - (int)(a >> 5)); }
    }
}

DI void phase3(const Params& p, unsigned char* lds) {
    const int tid = threadIdx.x, lane = tid & 63, wave = tid >> 6, l31 = lane & 31, h = lane >> 5;
    const int wn = wave & 1, wm = wave >> 1;
    unsigned char* ws = p.ws;
    const float* ssqb = (const float*)(ws + OFF_SSQB);
    float* sc = (float*)(lds + LDS_SCALE);
    const bf16_t* ga = (const bf16_t*)(ws + OFF_GA);
    const bf16_t* gb = (const bf16_t*)(ws + OFF_GB);
    bf16_t* merged = (bf16_t*)(ws + OFF_AK);
    for (int id = blockIdx.x; id < 512; id += gridDim.x) {
        const int mt = id >> 3, nt = id & 7;
#pragma unroll
        for (int i = 0; i < 2; ++i) {
            const int e = tid + 512 * i, row = e >> 2, hh = e & 3;
            const f32x4* sp = (const f32x4*)(ssqb + (((size_t)mt * 256 + row) * 4 + hh) * 16);
            const f32x4 a = sp[0], b2 = sp[1], c = sp[2], d = sp[3];
            const float s = ((a.x + a.y) + (a.z + a.w)) + ((b2.x + b2.y) + (b2.z + b2.w)) + ((c.x + c.y) + (c.z + c.w)) + ((d.x + d.y) + (d.z + d.w));
            sc[e] = 1.0f / sqrtf(s * (1.0f / 256.0f) + EPS);
        }
        __syncthreads();
        float hs[2][3], rl[2];
#pragma unroll
        for (int im = 0; im < 2; ++im) {
            const int lr = wm * 64 + im * 32 + l31;
            const f32x4 r = *(const f32x4*)(sc + lr * 4);
            hs[im][0] = r.x / r.y; hs[im][1] = r.y / r.z; hs[im][2] = r.z / r.w; rl[im] = r.w;
        }
        f32x16 acc[2][2];
        unsigned mb[2][2][8];
        zero_acc(acc);
        gemm_tile<0, true>(acc, (const bf16_t*)(ws + OFF_WB_T) + (size_t)nt * 128 * 1024, (const bf16_t*)(ws + OFF_GZ) + (size_t)mt * 256 * 1024, 256, lds, hs);
#pragma unroll
        for (int im = 0; im < 2; ++im) {
            const size_t tok = (size_t)mt * 256 + wm * 64 + im * 32 + l31;
#pragma unroll
            for (int in = 0; in < 2; ++in)
#pragma unroll
                for (int g = 0; g < 4; ++g) {
                    const size_t off = tok * 1024 + nt * 128 + wn * 64 + in * 32 + 8 * g + 4 * h;
                    const u32x2 ub = *(const u32x2*)(gb + off);
                    mb[in][im][2 * g] = pk2(sigmoidf_(bflo(ub.x)) * acc[in][im][4 * g + 0] * rl[im], sigmoidf_(bfhi(ub.x)) * acc[in][im][4 * g + 1] * rl[im]);
                    mb[in][im][2 * g + 1] = pk2(sigmoidf_(bflo(ub.y)) * acc[in][im][4 * g + 2] * rl[im], sigmoidf_(bfhi(ub.y)) * acc[in][im][4 * g + 3] * rl[im]);
                }
        }
        zero_acc(acc);
        gemm_tile<0, false>(acc, (const bf16_t*)(ws + OFF_WA_T) + (size_t)nt * 128 * 1024, (const bf16_t*)(ws + OFF_AZ) + (size_t)mt * 256 * 1024, 256, lds, hs);
#pragma unroll
        for (int im = 0; im < 2; ++im) {
            const size_t tok = (size_t)mt * 256 + wm * 64 + im * 32 + l31;
#pragma unroll
            for (int in = 0; in < 2; ++in)
#pragma unroll
                for (int g = 0; g < 4; ++g) {
                    const size_t off = tok * 1024 + nt * 128 + wn * 64 + in * 32 + 8 * g + 4 * h;
                    const u32x2 ua = *(const u32x2*)(ga + off);
                    const unsigned b0 = mb[in][im][2 * g], b1 = mb[in][im][2 * g + 1];
                    const float m0 = sigmoidf_(bflo(ua.x)) * acc[in][im][4 * g + 0] + bflo(b0);
                    const float m1 = sigmoidf_(bfhi(ua.x)) * acc[in][im][4 * g + 1] + bfhi(b0);
                    const float m2 = sigmoidf_(bflo(ua.y)) * acc[in][im][4 * g + 2] + bflo(b1);
                    const float m3 = sigmoidf_(bfhi(ua.y)) * acc[in][im][4 * g + 3] + bfhi(b1);
                    u32x2 o; o.x = pk2(m0, m1); o.y = pk2(m2, m3);
                    *(u32x2*)(merged + off) = o;
                }
        }
        __syncthreads();
    }
}

DI void phase4(const Params& p, unsigned char* lds) {
    const int tid = threadIdx.x, lane = tid & 63, wave = tid >> 6, l31 = lane & 31, h = lane >> 5;
    const int wn = wave & 1, wm = wave >> 1;
    unsigned char* ws = p.ws;
    float* ssqh = (float*)(ws + OFF_SSQH);
    for (int id = blockIdx.x; id < 512; id += gridDim.x) {
        const int mt = id >> 3, nt = id & 7;
        f32x16 acc[2][2];
        zero_acc(acc);
        const float hs0[2][3] = {{1.f, 1.f, 1.f}, {1.f, 1.f, 1.f}};
        gemm_tile<0, false>(acc, (const bf16_t*)(ws + OFF_WO_T) + (size_t)nt * 128 * 1024, (const bf16_t*)(ws + OFF_AK) + (size_t)mt * 256 * 1024, 256, lds, hs0);
#pragma unroll
        for (int im = 0; im < 2; ++im) {
            const size_t tok = (size_t)mt * 256 + wm * 64 + im * 32 + l31;
            float ss = 0.f;
#pragma unroll
            for (int in = 0; in < 2; ++in)
#pragma unroll
                for (int g = 0; g < 4; ++g) {
                    const size_t off = tok * 1024 + nt * 128 + wn * 64 + in * 32 + 8 * g + 4 * h;
                    const f32x4 xv = *(const f32x4*)(p.x + off);
                    f32x4 o;
                    o.x = xv.x + acc[in][im][4 * g + 0]; o.y = xv.y + acc[in][im][4 * g + 1];
                    o.z = xv.z + acc[in][im][4 * g + 2]; o.w = xv.w + acc[in][im][4 * g + 3];
                    ss += (o.x * o.x + o.y * o.y) + (o.z * o.z + o.w * o.w);
                    *(f32x4*)(p.out + off) = o;
                }
            ss += __shfl_xor(ss, 32);
            if (h == 0) ssqh[tok * 16 + nt * 2 + wn] = ss;
        }
    }
}

DI void phase5(const Params& p, unsigned char* lds) {
    const int tid = threadIdx.x, lane = tid & 63, wave = tid >> 6;
    const float* ssqh = (const float*)(p.ws + OFF_SSQH);
    for (int it = blockIdx.x; it < MROWS / 8; it += gridDim.x) {
        const size_t row = (size_t)it * 8 + wave;
        float s = lane < 16 ? ssqh[row * 16 + lane] : 0.f;
        s = wave_sum(s);
        const float rstd = 1.0f / sqrtf(s * (1.0f / 1024.0f) + EPS);
        f32x4* orow = (f32x4*)(p.out + row * 1024) + lane;
        const f32x4* wrow = (const f32x4*)p.final_w + lane;
#pragma unroll
        for (int j = 0; j < 4; ++j) {
            f32x4 v = orow[64 * j]; const f32x4 w = wrow[64 * j];
            v.x = v.x * rstd * w.x; v.y = v.y * rstd * w.y; v.z = v.z * rstd * w.z; v.w = v.w * rstd * w.w;
            orow[64 * j] = v;
        }
    }
}

DI void grid_bar(unsigned* bar, unsigned target) {
    asm volatile("s_waitcnt vmcnt(0)" ::: "memory");
    __syncthreads();
    if (threadIdx.x == 0) {
        __builtin_amdgcn_fence(__ATOMIC_RELEASE, "agent");
        asm volatile("s_waitcnt vmcnt(0)" ::: "memory");
        __hip_atomic_fetch_add(bar, 1u, __ATOMIC_RELAXED, __HIP_MEMORY_SCOPE_AGENT);
        while (__hip_atomic_load(bar, __ATOMIC_RELAXED, __HIP_MEMORY_SCOPE_AGENT) < target) __builtin_amdgcn_s_sleep(2);
        __builtin_amdgcn_fence(__ATOMIC_ACQUIRE, "agent");
        asm volatile("s_waitcnt vmcnt(0)" ::: "memory");
    }
    __syncthreads();
}

DI void run_phase(const Params& p, unsigned char* lds, int ph) {
    switch (ph) {
        case 0: phase0(p, lds); break;
        case 1: phase1(p, lds); break;
        case 2: phase15(p, lds); break;
        case 3: phase2(p, lds); break;
        case 4: phase3(p, lds); break;
        case 5: phase4(p, lds); break;
        default: phase5(p, lds); break;
    }
}

__global__ void __launch_bounds__(512) hybrid_fwd(Params p) {
    extern __shared__ __attribute__((aligned(16))) unsigned char lds[];
#if MULTI_LAUNCH
    run_phase(p, lds, p.phase_lo);
#else
    cg::grid_group grid = cg::this_grid();
    unsigned* bar = (unsigned*)(p.ws + OFF_CTR + 128);
    const unsigned G = gridDim.x;
    phase0(p, lds); if (PROBE_REP & 1) phase0(p, lds); grid.sync();
    phase1(p, lds); if (PROBE_REP & 2) phase1(p, lds); grid_bar(bar, G);
    phase15(p, lds); grid_bar(bar, 2 * G);
    phase2(p, lds); grid_bar(bar, 3 * G);
    phase3(p, lds); if (PROBE_REP & 4) phase3(p, lds); grid_bar(bar, 4 * G);
    phase4(p, lds); if (PROBE_REP & 8) phase4(p, lds); grid_bar(bar, 5 * G);
    phase5(p, lds);
#endif
}

extern "C" void kernel_launch(void* const* d_in, const int* in_sizes, int n_in, void* d_out, int out_size, void* d_ws, size_t ws_size, hipStream_t stream) {
    static int grid = 0;
    if (grid == 0) {
        int dev = 0, cus = 0, per_cu = 0;
        hipGetDevice(&dev);
        hipDeviceGetAttribute(&cus, hipDeviceAttributeMultiprocessorCount, dev);
        hipFuncSetAttribute((const void*)hybrid_fwd, hipFuncAttributeMaxDynamicSharedMemorySize, LDS_BYTES);
        hipOccupancyMaxActiveBlocksPerMultiprocessor(&per_cu, (const void*)hybrid_fwd, 512, LDS_BYTES);
        if (per_cu < 1) per_cu = 1;
        if (per_cu > 1) per_cu = 1;
        if (cus <= 0) cus = 256;
        grid = cus * per_cu;
    }
    hipMemsetAsync((unsigned char*)d_ws + OFF_CTR, 0, 256, stream);
    Params p{};
    p.x = (const float*)d_in[0]; p.meta = (const float*)d_in[1]; p.norm_w = (const float*)d_in[2]; p.w_in = (const float*)d_in[3];
    p.lq1 = (const float*)d_in[4]; p.lk1 = (const float*)d_in[5]; p.lq2 = (const float*)d_in[6]; p.lk2 = (const float*)d_in[7];
    p.subln_w = (const float*)d_in[8]; p.gate_w2 = (const float*)d_in[9]; p.gate_b = (const float*)d_in[10]; p.gla_norm_w = (const float*)d_in[11];
    p.wa = (const float*)d_in[12]; p.wb = (const float*)d_in[13]; p.wo = (const float*)d_in[14]; p.final_w = (const float*)d_in[15];
    p.out = (float*)d_out; p.ws = (unsigned char*)d_ws;
#if MULTI_LAUNCH
    for (int ph = 0; ph < 7; ++ph) {
        p.phase_lo = ph; p.phase_hi = ph + 1;
        hipLaunchKernelGGL(hybrid_fwd, dim3(grid), dim3(512), LDS_BYTES, stream, p);
    }
#else
    p.phase_lo = 0; p.phase_hi = 7;
    void* args[] = {&p};
    hipError_t e = hipLaunchCooperativeKernel((const void*)hybrid_fwd, dim3(grid), dim3(512), args, LDS_BYTES, stream);
    if (e != hipSuccess) fprintf(stderr, "cooperative launch failed: %s (grid %d)\n", hipGetErrorString(e), grid);
#endif
}
```

```cpp
#include <hip/hip_runtime.h>
#include <hip/hip_cooperative_groups.h>
#include <cstdio>
#include <cstdint>
namespace cg = cooperative_groups;

#ifndef MULTI_LAUNCH
#define MULTI_LAUNCH 0
#endif
#ifndef PROBE_REP
#define PROBE_REP 0
#endif

typedef unsigned short bf16_t;
typedef short bf16x8 __attribute__((ext_vector_type(8)));
typedef float f32x4 __attribute__((ext_vector_type(4)));
typedef float f32x2 __attribute__((ext_vector_type(2)));
typedef float f32x16 __attribute__((ext_vector_type(16)));
typedef unsigned u32x4 __attribute__((ext_vector_type(4)));
typedef unsigned u32x2 __attribute__((ext_vector_type(2)));
typedef __bf16 bfv2 __attribute__((ext_vector_type(2)));

#define DI __device__ __forceinline__
#define MFMA32(a, b, c) __builtin_amdgcn_mfma_f32_32x32x16_bf16((a), (b), (c), 0, 0, 0)
#define MFMA16(a, b, c) __builtin_amdgcn_mfma_f32_16x16x32_bf16((a), (b), (c), 0, 0, 0)

DI unsigned pk2(float a, float b) { f32x2 v = {a, b}; return __builtin_bit_cast(unsigned, __builtin_convertvector(v, bfv2)); }
DI float bf2f(bf16_t v) { return __uint_as_float(((unsigned)v) << 16); }
DI float bflo(unsigned u) { return __uint_as_float(u << 16); }
DI float bfhi(unsigned u) { return __uint_as_float(u & 0xffff0000u); }
DI bf16_t f2bf(float a) { return (bf16_t)(pk2(a, 0.f) & 0xffffu); }
DI float wave_sum(float v) {
#pragma unroll
    for (int o = 32; o; o >>= 1) v += __shfl_xor(v, o);
    return v;
}
DI float sigmoidf_(float z) { return 1.f / (1.f + __expf(-z)); }
DI float siluf_(float z) { return z / (1.f + __expf(-z)); }

constexpr int D = 1024, NB = 4, SEQ = 4096, MROWS = NB * SEQ;
constexpr int NIN = 9232, NINP = 9344;
constexpr float EPS = 1e-5f;

constexpr size_t SZ_ACT = (size_t)MROWS * 1024 * 2;
constexpr size_t OFF_WIN_T = 0;
constexpr size_t OFF_WA_T = OFF_WIN_T + (size_t)NINP * 1024 * 2;
constexpr size_t OFF_WB_T = OFF_WA_T + 2097152;
constexpr size_t OFF_WO_T = OFF_WB_T + 2097152;
constexpr size_t OFF_AK = OFF_WO_T + 2097152;
constexpr size_t OFF_AVT = OFF_AK + SZ_ACT;
constexpr size_t OFF_AZ = OFF_AVT + SZ_ACT;
constexpr size_t OFF_GVT = OFF_AZ + SZ_ACT;
constexpr size_t OFF_GZ = OFF_GVT + SZ_ACT;
constexpr size_t OFF_GA = OFF_GZ + SZ_ACT;
constexpr size_t OFF_GB = OFF_GA + SZ_ACT;
constexpr size_t OFF_GLR = OFF_GB + SZ_ACT;
constexpr size_t OFF_RSTD = OFF_GLR + (size_t)MROWS * 16 * 2;
constexpr size_t OFF_ROPE = OFF_RSTD + 65792;
constexpr size_t OFF_AKM = OFF_ROPE + 263168;
constexpr size_t OFF_AVTM = OFF_AKM + 131072;
constexpr size_t OFF_GVTM = OFF_AVTM + 131072;
constexpr size_t OFF_GKM = OFF_GVTM + 131072;
constexpr size_t OFF_GLRM = OFF_GKM + 16384;
constexpr size_t OFF_KTM = OFF_GLRM + 512;
constexpr size_t OFF_KTTM = OFF_KTM + 65536;
constexpr size_t OFF_DEC = OFF_KTTM + 65536;
constexpr size_t OFF_DECM = OFF_DEC + 524288;
constexpr size_t OFF_SSQB = OFF_DECM + 2048;
constexpr size_t OFF_SSQH = OFF_SSQB + 4194304;
constexpr size_t OFF_CTR = OFF_SSQH + 1048576;
constexpr size_t OFF_XBM = OFF_CTR + 256;
constexpr size_t WS_END = OFF_XBM + 32768;
constexpr size_t OFF_XB = OFF_GA;
constexpr size_t OFF_SGA = OFF_GB;
constexpr size_t OFF_SGB = OFF_GB + (size_t)MROWS * 1024;
static_assert(WS_END <= 268435456ull, "workspace over 256 MiB");
constexpr size_t DO_AQ = 0, DO_GQ = SZ_ACT, DO_GK = SZ_ACT + SZ_ACT / 2;

constexpr int G_ROWB = 144;
constexpr int G_SW = 128 * G_ROWB, G_SX = 256 * G_ROWB, G_STAGE = G_SW + G_SX;
constexpr int G_SW4 = 256 * G_ROWB, G_STAGE4 = G_SW4 + G_SX;
constexpr int LDS_SCALE = 2 * G_STAGE4;
constexpr int LDS_ITEM = LDS_SCALE + 4096;
constexpr int LDS_BYTES = LDS_ITEM + 64;

struct Params {
    const float *x, *meta, *norm_w, *w_in, *lq1, *lk1, *lq2, *lk2, *subln_w, *gate_w2, *gate_b, *gla_norm_w, *wa, *wb, *wo, *final_w;
    float* out;
    unsigned char* ws;
    int phase_lo, phase_hi;
};

template <int MODE>
DI void p0_transpose_item(const Params& p, int item, float* tile) {
    const int tid = threadIdx.x;
    const float* W = MODE == 0 ? p.w_in : MODE == 1 ? p.wa : MODE == 2 ? p.wb : p.wo;
    const int ldw = MODE == 0 ? NIN : 1024;
    const int nbc = MODE == 0 ? NINP / 64 : 16;
    bf16_t* WT = (bf16_t*)(p.ws + (MODE == 0 ? OFF_WIN_T : MODE == 1 ? OFF_WA_T : MODE == 2 ? OFF_WB_T : OFF_WO_T));
    const int kb = item / nbc, nb = item % nbc, k0 = kb * 64, n0 = nb * 64;
#pragma unroll
    for (int i = 0; i < 8; ++i) {
        const int kk = (tid >> 6) + 8 * i, nn = tid & 63, n = n0 + nn, k = k0 + kk;
        int src = n;
        if (MODE == 0) { src = n < 7168 ? n : (n < 9216 ? n + 16 : (n < 9232 ? n - 2048 : -1)); }
        float sc = 1.f;
        if (MODE == 0) sc = p.norm_w[k];
        if (MODE == 1) sc = 0.8f * p.subln_w[k & 127];
        if (MODE == 2) sc = p.gla_norm_w[k & 255];
        float v = 0.f;
        if (src >= 0) v = W[(size_t)k * ldw + src] * sc;
        tile[kk * 65 + nn] = v;
    }
    __syncthreads();
    {
        const int nn = tid >> 3, c = tid & 7;
        const float* s = tile + (8 * c) * 65 + nn;
        u32x4 o;
        o.x = pk2(s[0 * 65], s[1 * 65]); o.y = pk2(s[2 * 65], s[3 * 65]); o.z = pk2(s[4 * 65], s[5 * 65]); o.w = pk2(s[6 * 65], s[7 * 65]);
        *(u32x4*)(WT + (size_t)(n0 + nn) * 1024 + k0 + 8 * c) = o;
    }
    __syncthreads();
}

DI void phase0(const Params& p, unsigned char* lds) {
    const int tid = threadIdx.x, lane = tid & 63, wave = tid >> 6;
    float* tile = (float*)lds;
    constexpr int I_WIN = 16 * (NINP / 64), I_SQ = 256;
    constexpr int I_T = I_WIN + 3 * I_SQ;
    constexpr int I_RSTD = (MROWS + 16 + 7) / 8;
    constexpr int I_ROPE = (4112 * 8 + 511) / 512;
    constexpr int I_ZERO = 393216 / 8192;
    constexpr int I_ALL = I_T + I_RSTD + I_ROPE + I_ZERO;
    for (int it = blockIdx.x; it < I_ALL; it += gridDim.x) {
        int r = it;
        if (r < I_WIN) { p0_transpose_item<0>(p, r, tile); continue; } r -= I_WIN;
        if (r < I_SQ) { p0_transpose_item<1>(p, r, tile); continue; } r -= I_SQ;
        if (r < I_SQ) { p0_transpose_item<2>(p, r, tile); continue; } r -= I_SQ;
        if (r < I_SQ) { p0_transpose_item<3>(p, r, tile); continue; } r -= I_SQ;
        if (r < I_RSTD) {
            const int row = r * 8 + wave;
            if (row < MROWS + 16) {
                const float* src = row < MROWS ? p.x + (size_t)row * 1024 : p.meta + (size_t)(row - MROWS) * 1024;
                const f32x4* xr = (const f32x4*)src + lane;
                float s = 0.f;
#pragma unroll
                for (int j = 0; j < 4; ++j) { const f32x4 v = xr[64 * j]; s += (v.x * v.x + v.y * v.y) + (v.z * v.z + v.w * v.w); }
                s = wave_sum(s);
                if (lane == 0) ((float*)(p.ws + OFF_RSTD))[row] = 1.0f / sqrtf(s * (1.0f / 1024.0f) + EPS);
                bf16_t* xbrow = row < MROWS ? (bf16_t*)(p.ws + OFF_XB) + (size_t)row * 1024 : (bf16_t*)(p.ws + OFF_XBM) + (size_t)(row - MROWS) * 1024;
#pragma unroll
                for (int j = 0; j < 4; ++j) { const f32x4 v = xr[64 * j]; u32x2 o; o.x = pk2(v.x, v.y); o.y = pk2(v.z, v.w); *(u32x2*)(xbrow + 256 * j + 4 * lane) = o; }
            }
            continue;
        }
        r -= I_RSTD;
        if (r < I_ROPE) {
            const int e = r * 512 + tid;
            if (e < 4112 * 8) {
                const int pos = e >> 3, i = e & 7;
                const float inv = powf(500000.0f, -(float)i / 8.0f);
                const float ang = (float)pos * inv;
                float* t = (float*)(p.ws + OFF_ROPE) + (size_t)e * 2;
                t[0] = cosf(ang); t[1] = sinf(ang);
            }
            continue;
        }
        r -= I_ROPE;
        { u32x4 z = {0u, 0u, 0u, 0u}; *(u32x4*)(p.ws + OFF_AKM + (size_t)r * 8192 + tid * 16) = z; }
    }
}

template <int NI, bool HS>
DI void gemm_tile(f32x16 (&acc)[NI][2], const bf16_t* __restrict__ Wt, const bf16_t* __restrict__ X, unsigned char* lds, const float (&hs)[2][3]) {
    const int tid = threadIdx.x, lane = tid & 63, wave = tid >> 6, l31 = lane & 31, h = lane >> 5;
    const int wn = wave & 1, wm = wave >> 1;
    constexpr int SW = NI * 64 * G_ROWB, STAGE = SW + G_SX;
    u32x4 wreg[NI];
    u32x4 xreg[4];
    const int prow = tid >> 3, pc = tid & 7;
    const bf16_t* wp = Wt + (size_t)prow * 1024 + pc * 8;
    const bf16_t* xp = X + (size_t)prow * 1024 + pc * 8;
#define G_LOAD(kt_)                                                                                                  \
    {                                                                                                                \
        _Pragma("unroll") for (int i = 0; i < NI; ++i) wreg[i] = *(const u32x4*)(wp + (size_t)i * 64 * 1024 + (kt_) * 64); \
        _Pragma("unroll") for (int i = 0; i < 4; ++i) xreg[i] = *(const u32x4*)(xp + (size_t)i * 64 * 1024 + (kt_) * 64);  \
    }
#define G_STORE(buf_)                                                                                                \
    {                                                                                                                \
        unsigned char* sW_ = lds + (buf_) * STAGE + prow * G_ROWB + pc * 16; unsigned char* sX_ = sW_ + SW;          \
        _Pragma("unroll") for (int i = 0; i < NI; ++i) *(u32x4*)(sW_ + i * 64 * G_ROWB) = wreg[i];                   \
        _Pragma("unroll") for (int i = 0; i < 4; ++i) *(u32x4*)(sX_ + i * 64 * G_ROWB) = xreg[i];                    \
    }
    G_LOAD(0);
    G_STORE(0);
    __syncthreads();
    for (int kt = 0; kt < 16; ++kt) {
        if (kt + 1 < 16) G_LOAD(kt + 1);
        if (HS) {
            if (kt == 4 || kt == 8 || kt == 12) {
                const float s0 = kt == 4 ? hs[0][0] : (kt == 8 ? hs[0][1] : hs[0][2]);
                const float s1 = kt == 4 ? hs[1][0] : (kt == 8 ? hs[1][1] : hs[1][2]);
#pragma unroll
                for (int n = 0; n < NI; ++n)
#pragma unroll
                    for (int i = 0; i < 16; ++i) { acc[n][0][i] *= s0; acc[n][1][i] *= s1; }
            }
        }
        {
            const unsigned char* sW = lds + (kt & 1) * STAGE + (wn * NI * 32 + l31) * G_ROWB + h * 16;
            const unsigned char* sX = lds + (kt & 1) * STAGE + SW + (wm * 64 + l31) * G_ROWB + h * 16;
#pragma unroll
            for (int ks = 0; ks < 4; ++ks) {
                const bf16x8 x0 = *(const bf16x8*)(sX + ks * 32), x1 = *(const bf16x8*)(sX + 32 * G_ROWB + ks * 32);
#pragma unroll
                for (int n = 0; n < NI; ++n) {
                    const bf16x8 w = *(const bf16x8*)(sW + n * 32 * G_ROWB + ks * 32);
                    acc[n][0] = MFMA32(w, x0, acc[n][0]); acc[n][1] = MFMA32(w, x1, acc[n][1]);
                }
            }
        }
        if (kt + 1 < 16) G_STORE((kt + 1) & 1);
        __syncthreads();
    }
#undef G_LOAD
#undef G_STORE
}

template <int NI>
DI void zero_acc(f32x16 (&acc)[NI][2]) {
#pragma unroll
    for (int a = 0; a < NI; ++a)
#pragma unroll
        for (int b = 0; b < 2; ++b)
#pragma unroll
            for (int i = 0; i < 16; ++i) acc[a][b][i] = 0.f;
}

DI unsigned sig_u8(float z) { return (unsigned)(255.0f / (1.0f + __expf(-z)) + 0.5f); }
DI void p1_epilogue(const Params& p, f32x16 (&acc)[4][2], int mt, int nt) {
    const int tid = threadIdx.x, lane = tid & 63, wave = tid >> 6, l31 = lane & 31, h = lane >> 5;
    const int wn = wave & 1, wm = wave >> 1;
    int split, nc0;
    if (nt < 4) { split = 0; nc0 = nt * 256; }
    else if (nt < 8) { split = 1; nc0 = (nt - 4) * 256; }
    else if (nt < 12) { split = 2; nc0 = (nt - 8) * 256; }
    else if (nt < 16) { split = 3; nc0 = (nt - 12) * 256; }
    else if (nt < 18) { split = 4; nc0 = (nt - 16) * 256; }
    else if (nt < 20) { split = 5; nc0 = (nt - 18) * 256; }
    else if (nt < 24) { split = 6; nc0 = (nt - 20) * 256; }
    else if (nt < 28) { split = 7; nc0 = (nt - 24) * 256; }
    else if (nt < 32) { split = 9; nc0 = (nt - 28) * 256; }
    else { split = 10; nc0 = (nt - 32) * 256; }
    const float* rstd = (const float*)(p.ws + OFF_RSTD);
    const float* rope = (const float*)(p.ws + OFF_ROPE);
    unsigned char* ws = p.ws;
    unsigned char* dout = (unsigned char*)p.out;
#pragma unroll
    for (int im = 0; im < 2; ++im) {
        const int tok = mt * 256 + wm * 64 + im * 32 + l31;
        const float rs = rstd[tok];
        const int pos = 16 + (tok & 4095);
        const int b = tok >> 12, s = tok & 4095;
#pragma unroll
        for (int in = 0; in < 4; ++in) {
            const int nb = nc0 + wn * 128 + in * 32;
            float v[16];
#pragma unroll
            for (int i = 0; i < 16; ++i) v[i] = acc[in][im][i] * rs;
            if (split <= 1 && (nb & 63) == 0) {
                const float* cs = rope + ((size_t)pos * 8 + 4 * h) * 2;
#pragma unroll
                for (int i = 0; i < 4; ++i) {
                    const float c = cs[2 * i], sn = cs[2 * i + 1];
                    const float x1 = v[i], x2 = v[i + 4];
                    v[i] = x1 * c - x2 * sn; v[i + 4] = x2 * c + x1 * sn;
                }
            }
            if (split == 2 || split == 6) {
                const int hshift = split == 2 ? 7 : 8;
                const int nheads = split == 2 ? 8 : 4;
                const int dvn = 1 << hshift;
                bf16_t* base = (bf16_t*)(ws + (split == 2 ? OFF_AVT : OFF_GVT));
#pragma unroll
                for (int i = 0; i < 16; ++i) {
                    const int n = nb + (i & 3) + 8 * (i >> 2) + 4 * h;
                    const int hd = n >> hshift, dv = n & (dvn - 1);
                    base[((size_t)(b * nheads + hd) * dvn + dv) * 4096 + s] = f2bf(v[i]);
                }
            } else if (split >= 9) {
                unsigned char* dst = ws + (split == 9 ? OFF_SGA : OFF_SGB) + (size_t)tok * 1024 + nb + 4 * h;
#pragma unroll
                for (int g = 0; g < 4; ++g) {
                    const unsigned o = sig_u8(v[4 * g]) | (sig_u8(v[4 * g + 1]) << 8) | (sig_u8(v[4 * g + 2]) << 16) | (sig_u8(v[4 * g + 3]) << 24);
                    *(unsigned*)(dst + 8 * g) = o;
                }
            } else {
                bf16_t* dst; int ld;
                switch (split) {
                    case 0: dst = (bf16_t*)(dout + DO_AQ); ld = 1024; break;
                    case 1: dst = (bf16_t*)(ws + OFF_AK); ld = 1024; break;
                    case 3: dst = (bf16_t*)(ws + OFF_AZ); ld = 1024; break;
                    case 4: dst = (bf16_t*)(dout + DO_GQ); ld = 512; break;
                    case 5: dst = (bf16_t*)(dout + DO_GK); ld = 512; break;
                    default: dst = (bf16_t*)(ws + OFF_GZ); ld = 1024; break;
                }
#pragma unroll
                for (int g = 0; g < 4; ++g) {
                    u32x2 o; o.x = pk2(v[4 * g], v[4 * g + 1]); o.y = pk2(v[4 * g + 2], v[4 * g + 3]);
                    *(u32x2*)(dst + (size_t)tok * ld + nb + 8 * g + 4 * h) = o;
                }
            }
        }
    }
}

DI void p1_glr_job(const Params& p, unsigned char* lds, int job) {
    const int tid = threadIdx.x, lane = tid & 63, wave = tid >> 6, l15 = lane & 15, g = lane >> 4;
    const int rtile = wave & 3, khalf = wave >> 2;
    const bf16_t* xb = (const bf16_t*)(p.ws + OFF_XB);
    const bf16_t* wt = (const bf16_t*)(p.ws + OFF_WIN_T) + (size_t)9216 * 1024;
    const size_t row0 = (size_t)job * 64 + rtile * 16;
    const bf16_t* ap = xb + (row0 + l15) * 1024 + khalf * 512 + 8 * g;
    const bf16_t* bp = wt + (size_t)l15 * 1024 + khalf * 512 + 8 * g;
    f32x4 acc = (f32x4){0.f, 0.f, 0.f, 0.f};
#pragma unroll 4
    for (int ks = 0; ks < 16; ++ks) {
        const bf16x8 a = *(const bf16x8*)(ap + ks * 32), bb = *(const bf16x8*)(bp + ks * 32);
        acc = MFMA16(a, bb, acc);
    }
    f32x4* red = (f32x4*)lds;
    __syncthreads();
    if (khalf == 1) red[rtile * 64 + lane] = acc;
    __syncthreads();
    if (khalf == 0) {
        const f32x4 o = red[rtile * 64 + lane];
        const float* rstd = (const float*)(p.ws + OFF_RSTD);
        bf16_t* glr = (bf16_t*)(p.ws + OFF_GLR);
#pragma unroll
        for (int i = 0; i < 4; ++i) {
            const size_t row = row0 + 4 * g + i;
            glr[row * 16 + l15] = f2bf((acc[i] + o[i]) * rstd[row]);
        }
    }
    __syncthreads();
}

DI void p1_meta_job(const Params& p, unsigned char* lds, int job) {
    const int tid = threadIdx.x, lane = tid & 63, wave = tid >> 6, l15 = lane & 15, g = lane >> 4;
    int c0;
    if (job < 64) c0 = 1024 + job * 16;
    else if (job < 128) c0 = 2048 + (job - 64) * 16;
    else if (job < 160) c0 = 4608 + (job - 128) * 16;
    else if (job < 224) c0 = 5120 + (job - 160) * 16;
    else c0 = 9216;
    const bf16_t* xbm = (const bf16_t*)(p.ws + OFF_XBM);
    const bf16_t* wt = (const bf16_t*)(p.ws + OFF_WIN_T);
    const bf16_t* ap = xbm + (size_t)l15 * 1024 + wave * 128 + 8 * g;
    const bf16_t* bp = wt + (size_t)(c0 + l15) * 1024 + wave * 128 + 8 * g;
    f32x4 acc = (f32x4){0.f, 0.f, 0.f, 0.f};
#pragma unroll
    for (int ks = 0; ks < 4; ++ks) {
        const bf16x8 a = *(const bf16x8*)(ap + ks * 32), bb = *(const bf16x8*)(bp + ks * 32);
        acc = MFMA16(a, bb, acc);
    }
    f32x4* red = (f32x4*)lds;
    __syncthreads();
    red[wave * 64 + lane] = acc;
    __syncthreads();
    if (wave == 0) {
        f32x4 s = red[lane];
#pragma unroll
        for (int w = 1; w < 8; ++w) { const f32x4 t = red[w * 64 + lane]; s.x += t.x; s.y += t.y; s.z += t.z; s.w += t.w; }
        const float* rstd = (const float*)(p.ws + OFF_RSTD) + MROWS;
        const float* rope = (const float*)(p.ws + OFF_ROPE);
        unsigned char* ws = p.ws;
        const int col = c0 + l15;
#pragma unroll
        for (int i = 0; i < 4; ++i) {
            const int row = 4 * g + i;
            float v = s[i] * rstd[row];
            if (job < 64 && (c0 & 63) == 0) {
                const float other = __shfl_xor(v, 8);
                const float* cs = rope + ((size_t)row * 8 + (l15 & 7)) * 2;
                const float c = cs[0], sn = cs[1];
                v = (l15 < 8) ? (v * c - other * sn) : (v * c + other * sn);
            }
            const bf16_t val = f2bf(v);
            if (job < 64) ((bf16_t*)(ws + OFF_AKM))[(size_t)(48 + row) * 1024 + (col - 1024)] = val;
            else if (job < 128) { const int n = col - 2048; ((bf16_t*)(ws + OFF_AVTM))[(size_t)n * 64 + 48 + row] = val; }
            else if (job < 160) ((bf16_t*)(ws + OFF_GKM))[(size_t)row * 512 + (col - 4608)] = val;
            else if (job < 224) { const int n = col - 5120; ((bf16_t*)(ws + OFF_GVTM))[(size_t)n * 64 + 48 + row] = val; }
            else ((bf16_t*)(ws + OFF_GLRM))[row * 16 + l15] = val;
        }
    }
    __syncthreads();
}

DI void phase1(const Params& p, unsigned char* lds) {
    for (int j = blockIdx.x; j < 256; j += gridDim.x) p1_glr_job(p, lds, j);
    for (int j = blockIdx.x; j < 225; j += gridDim.x) p1_meta_job(p, lds, j);
    constexpr int NT = 36, TOTAL = 64 * NT;
    const bf16_t* wt = (const bf16_t*)(p.ws + OFF_WIN_T);
    const bf16_t* xb = (const bf16_t*)(p.ws + OFF_XB);
    const float hs0[2][3] = {{1.f, 1.f, 1.f}, {1.f, 1.f, 1.f}};
    for (int id = blockIdx.x; id < TOTAL; id += gridDim.x) {
        int mt, nt;
        { const int g = id / (16 * NT), rem = id % (16 * NT); nt = rem >> 4; mt = g * 16 + (rem & 15); }
        f32x16 acc[4][2];
        zero_acc<4>(acc);
        gemm_tile<4, false>(acc, wt + (size_t)nt * 256 * 1024, xb + (size_t)mt * 256 * 1024, lds, hs0);
        p1_epilogue(p, acc, mt, nt);
    }
}

DI void phase15(const Params& p, unsigned char* lds) {
    const int tid = threadIdx.x, col = tid;
    float w2[16];
#pragma unroll
    for (int j = 0; j < 16; ++j) w2[j] = p.gate_w2[j * 512 + col];
    const float bias = p.gate_b[col];
    unsigned char* ws = p.ws;
    unsigned char* dout = (unsigned char*)p.out;
    for (int item = blockIdx.x; item < 257; item += gridDim.x) {
        const bool meta = item == 256;
        const int b = item >> 6, c = item & 63;
        const size_t row0 = (size_t)b * 4096 + c * 64;
        const bf16_t* glr = meta ? (const bf16_t*)(ws + OFF_GLRM) : (const bf16_t*)(ws + OFF_GLR) + row0 * 16;
        const int nrows = meta ? 16 : 64;
        bf16_t* qp = (bf16_t*)(dout + DO_GQ) + row0 * 512 + col;
        const bf16_t* kin = meta ? (const bf16_t*)(ws + OFF_GKM) + col : (const bf16_t*)(dout + DO_GK) + row0 * 512 + col;
        bf16_t* kout = meta ? (bf16_t*)(ws + OFF_KTM) + 48 * 512 + col : (bf16_t*)(dout + DO_GK) + row0 * 512 + col;
        bf16_t* ktt = meta ? (bf16_t*)(ws + OFF_KTTM) + (size_t)col * 64 + 48 : (bf16_t*)(ws + OFF_WIN_T) + ((size_t)b * 512 + col) * 4096 + c * 64;
        __syncthreads();
        if (tid < nrows * 2) ((u32x4*)lds)[tid] = ((const u32x4*)glr)[tid];
        __syncthreads();
        float bsum = 0.f;
        bf16_t kc[8], qc[8], kn[8], qn[8];
#pragma unroll
        for (int rr = 0; rr < 8; ++rr) { kc[rr] = kin[(size_t)rr * 512]; qc[rr] = meta ? (bf16_t)0 : qp[(size_t)rr * 512]; }
        for (int r0 = 0; r0 < nrows; r0 += 8) {
            if (r0 + 8 < nrows) {
#pragma unroll
                for (int rr = 0; rr < 8; ++rr) { kn[rr] = kin[(size_t)(r0 + 8 + rr) * 512]; qn[rr] = meta ? (bf16_t)0 : qp[(size_t)(r0 + 8 + rr) * 512]; }
            }
            float kt8[8];
#pragma unroll
            for (int rr = 0; rr < 8; ++rr) {
                const int r = r0 + rr;
                const u32x4* g4 = (const u32x4*)(lds + r * 32);
                const u32x4 ga = g4[0], gb = g4[1];
                float gk = bias;
                gk += bflo(ga.x) * w2[0] + bfhi(ga.x) * w2[1] + bflo(ga.y) * w2[2] + bfhi(ga.y) * w2[3];
                gk += bflo(ga.z) * w2[4] + bfhi(ga.z) * w2[5] + bflo(ga.w) * w2[6] + bfhi(ga.w) * w2[7];
                gk += bflo(gb.x) * w2[8] + bfhi(gb.x) * w2[9] + bflo(gb.y) * w2[10] + bfhi(gb.y) * w2[11];
                gk += bflo(gb.z) * w2[12] + bfhi(gb.z) * w2[13] + bflo(gb.w) * w2[14] + bfhi(gb.w) * w2[15];
                const float lg = (fminf(gk, 0.f) - log1pf(expf(-fabsf(gk)))) * (1.0f / 16.0f);
                bsum += lg;
                const float kt = bf2f(kc[rr]) * expf(-bsum);
                kt8[rr] = kt;
                kout[(size_t)r * 512] = f2bf(kt);
                if (!meta) qp[(size_t)r * 512] = f2bf(bf2f(qc[rr]) * 0.08838834764831845f * expf(bsum));
            }
            u32x4 o; o.x = pk2(kt8[0], kt8[1]); o.y = pk2(kt8[2], kt8[3]); o.z = pk2(kt8[4], kt8[5]); o.w = pk2(kt8[6], kt8[7]);
            *(u32x4*)(ktt + r0) = o;
#pragma unroll
            for (int rr = 0; rr < 8; ++rr) { kc[rr] = kn[rr]; qc[rr] = qn[rr]; }
        }
        if (meta) {
            ((float*)(ws + OFF_DECM))[col] = expf(bsum);
            bf16_t* km = (bf16_t*)(ws + OFF_KTM);
            for (int r = 0; r < 48; ++r) km[r * 512 + col] = 0;
            u32x4 z = {0u, 0u, 0u, 0u};
            u32x4* kz = (u32x4*)((bf16_t*)(ws + OFF_KTTM) + (size_t)col * 64);
#pragma unroll
            for (int j = 0; j < 6; ++j) kz[j] = z;
        } else {
            ((float*)(ws + OFF_DEC))[((size_t)b * 64 + c) * 512 + col] = expf(bsum);
        }
    }
}

constexpr int A_KROWB = 272, A_VROWB = 136, A_KB = 64 * A_KROWB, A_VB = 128 * A_VROWB, A_STAGE = A_KB + A_VB;
DI void attn_tile(const unsigned char* sK, const unsigned char* sV, int tt, int qb, int qs, int sub, int l31, int h,
                  const bf16x8 (&qf)[4], f32x16 (&O)[4], float& m, float& l) {
    const float SC = 0.125f * 1.4426950408889634f;
    f32x16 st[2];
#pragma unroll
    for (int k2 = 0; k2 < 2; ++k2)
#pragma unroll
        for (int i = 0; i < 16; ++i) st[k2][i] = 0.f;
#pragma unroll
    for (int k2 = 0; k2 < 2; ++k2)
#pragma unroll
        for (int ks = 0; ks < 4; ++ks) {
            const bf16x8 kf = *(const bf16x8*)(sK + (k2 * 32 + l31) * A_KROWB + (sub * 64 + ks * 16 + 8 * h) * 2);
            st[k2] = MFMA32(kf, qf[ks], st[k2]);
        }
    if (tt == 0) {
#pragma unroll
        for (int i = 0; i < 16; ++i) { st[0][i] = -INFINITY; if (i < 8) st[1][i] = -INFINITY; }
    } else if (tt >= 2 * qb + 1) {
        const int kbase = (tt - 1) * 64 + 4 * h;
#pragma unroll
        for (int k2 = 0; k2 < 2; ++k2)
#pragma unroll
            for (int i = 0; i < 16; ++i) {
                const int key = kbase + k2 * 32 + (i & 3) + 8 * (i >> 2);
                if (key > qs) st[k2][i] = -INFINITY;
            }
    }
    float mx = -INFINITY;
#pragma unroll
    for (int k2 = 0; k2 < 2; ++k2)
#pragma unroll
        for (int i = 0; i < 16; ++i) mx = fmaxf(mx, st[k2][i]);
    mx = fmaxf(mx, __shfl_xor(mx, 32));
    const float mnew = fmaxf(m, mx);
    const float alpha = __builtin_amdgcn_exp2f((m - mnew) * SC);
    const float mc = mnew * SC;
    m = mnew;
    float ps = 0.f;
#pragma unroll
    for (int k2 = 0; k2 < 2; ++k2)
#pragma unroll
        for (int i = 0; i < 16; ++i) { const float pv = __builtin_amdgcn_exp2f(st[k2][i] * SC - mc); st[k2][i] = pv; ps += pv; }
    l = l * alpha + ps;
#pragma unroll
    for (int d = 0; d < 4; ++d)
#pragma unroll
        for (int i = 0; i < 16; ++i) O[d][i] *= alpha;
    bf16x8 pb[4];
#pragma unroll
    for (int k4 = 0; k4 < 4; ++k4) {
        const int k2 = k4 >> 1, o8 = 8 * (k4 & 1);
        u32x4 pk;
        pk.x = pk2(st[k2][o8 + 0], st[k2][o8 + 1]); pk.y = pk2(st[k2][o8 + 2], st[k2][o8 + 3]);
        pk.z = pk2(st[k2][o8 + 4], st[k2][o8 + 5]); pk.w = pk2(st[k2][o8 + 6], st[k2][o8 + 7]);
        pb[k4] = __builtin_bit_cast(bf16x8, pk);
    }
#pragma unroll
    for (int d = 0; d < 4; ++d)
#pragma unroll
        for (int k4 = 0; k4 < 4; ++k4) {
            const unsigned char* vp = sV + (d * 32 + l31) * A_VROWB + (k4 * 16 + 4 * h) * 2;
            const u32x2 lo = *(const u32x2*)vp, hi = *(const u32x2*)(vp + 16);
            u32x4 vv; vv.x = lo.x; vv.y = lo.y; vv.z = hi.x; vv.w = hi.y;
            O[d] = MFMA32(__builtin_bit_cast(bf16x8, vv), pb[k4], O[d]);
        }
}

DI void attn_item(const Params& p, unsigned char* lds, int b, int hd, int qb) {
    const int tid = threadIdx.x, lane = tid & 63, wave = tid >> 6, l31 = lane & 31, h = lane >> 5;
    const int sub = wave >> 2, rt = wave & 3;
    const bf16_t* aq = (const bf16_t*)((unsigned char*)p.out + DO_AQ);
    const bf16_t* ak = (const bf16_t*)(p.ws + OFF_AK);
    const bf16_t* avT = (const bf16_t*)(p.ws + OFF_AVT);
    const bf16_t* akm = (const bf16_t*)(p.ws + OFF_AKM);
    const bf16_t* avTm = (const bf16_t*)(p.ws + OFF_AVTM);
    bf16_t* az = (bf16_t*)(p.ws + OFF_AZ);
    const int qs = qb * 128 + rt * 32 + l31;
    const size_t grow = (size_t)b * 4096 + qs;
    bf16x8 qf[4];
#pragma unroll
    for (int ks = 0; ks < 4; ++ks) qf[ks] = *(const bf16x8*)(aq + grow * 1024 + hd * 128 + sub * 64 + ks * 16 + 8 * h);
    f32x16 O[4];
#pragma unroll
    for (int d = 0; d < 4; ++d)
#pragma unroll
        for (int i = 0; i < 16; ++i) O[d][i] = 0.f;
    float m = -INFINITY, l = 0.f;
    const int T = 2 * qb + 3;
    u32x4 k0r[2], v0r[2];
    const int krow_ = tid >> 4, kc_ = tid & 15, vdv_ = tid >> 3, vc_ = tid & 7;
    const bf16_t* kp = ak + ((size_t)b * 4096 + krow_) * 1024 + hd * 128 + kc_ * 8;
    const bf16_t* vp_ = avT + ((size_t)(b * 8 + hd) * 128 + vdv_) * 4096 + vc_ * 8;
#define A_LOAD_REAL(KR, VR)                                                                                                   \
    {                                                                                                                         \
        KR[0] = *(const u32x4*)kp; KR[1] = *(const u32x4*)(kp + 32 * 1024); kp += 64 * 1024;                                  \
        VR[0] = *(const u32x4*)vp_; VR[1] = *(const u32x4*)(vp_ + (size_t)64 * 4096); vp_ += 64;                              \
    }
#define A_STORE(KR, VR, buf_)                                                                                                 \
    {                                                                                                                         \
        unsigned char* sK_ = lds + (buf_) * A_STAGE; unsigned char* sV_ = sK_ + A_KB;                                         \
        _Pragma("unroll") for (int i = 0; i < 2; ++i) { const int pi = tid + 512 * i, row = pi >> 4, c = pi & 15;              \
            *(u32x4*)(sK_ + row * A_KROWB + c * 16) = KR[i]; }                                                                \
        _Pragma("unroll") for (int i = 0; i < 2; ++i) { const int pi = tid + 512 * i, dv = pi >> 3, c = pi & 7;                \
            unsigned char* d_ = sV_ + dv * A_VROWB + c * 16; u32x2 a_, b_; a_.x = VR[i].x; a_.y = VR[i].y; b_.x = VR[i].z; b_.y = VR[i].w; \
            *(u32x2*)d_ = a_; *(u32x2*)(d_ + 8) = b_; }                                                                       \
    }
    {
        const bf16_t* km_ = akm + (size_t)krow_ * 1024 + hd * 128 + kc_ * 8;
        k0r[0] = *(const u32x4*)km_; k0r[1] = *(const u32x4*)(km_ + 32 * 1024);
        const bf16_t* vm_ = avTm + (size_t)(hd * 128 + vdv_) * 64 + vc_ * 8;
        v0r[0] = *(const u32x4*)vm_; v0r[1] = *(const u32x4*)(vm_ + 64 * 64);
    }
    A_STORE(k0r, v0r, 0);
    __syncthreads();
    for (int tt = 0; tt < T; ++tt) {
        if (tt + 1 < T) A_LOAD_REAL(k0r, v0r);
        attn_tile(lds + (tt & 1) * A_STAGE, lds + (tt & 1) * A_STAGE + A_KB, tt, qb, qs, sub, l31, h, qf, O, m, l);
        if (tt + 1 < T) A_STORE(k0r, v0r, (tt + 1) & 1);
        __syncthreads();
    }
#undef A_LOAD_REAL
#undef A_STORE
    float lam;
    {
        const float a_ = wave_sum(p.lq1[lane] * p.lk1[lane]);
        const float b_ = wave_sum(p.lq2[lane] * p.lk2[lane]);
        lam = expf(a_) - expf(b_) + 0.2f;
    }
    const float ltot = l + __shfl_xor(l, 32);
    const float linv = 1.0f / ltot;
    float* ex = (float*)lds;
    if (sub == 1) {
#pragma unroll
        for (int d = 0; d < 4; ++d)
#pragma unroll
            for (int i = 0; i < 16; ++i) { ex[(rt * 32 + l31) * 129 + d * 32 + (i & 3) + 8 * (i >> 2) + 4 * h] = O[d][i] * linv; if (i == 15) __builtin_amdgcn_sched_barrier(0); }
    }
    __syncthreads();
    if (sub == 0) {
        float ss = 0.f;
#pragma unroll
        for (int d = 0; d < 4; ++d)
#pragma unroll
            for (int i = 0; i < 16; ++i) {
                const float o2 = ex[(rt * 32 + l31) * 129 + d * 32 + (i & 3) + 8 * (i >> 2) + 4 * h];
                const float o = O[d][i] * linv - lam * o2;
                O[d][i] = o; ss += o * o;
                if (i == 15) __builtin_amdgcn_sched_barrier(0);
            }
        ss += __shfl_xor(ss, 32);
        const float rstd = 1.0f / sqrtf(ss * (1.0f / 128.0f) + EPS);
#pragma unroll
        for (int d = 0; d < 4; ++d)
#pragma unroll
            for (int g = 0; g < 4; ++g) {
                bf16_t* zp = az + grow * 1024 + hd * 128 + d * 32 + 8 * g + 4 * h;
                const u32x2 zz = *(const u32x2*)zp;
                u32x2 o;
                o.x = pk2(O[d][4 * g] * rstd * siluf_(bflo(zz.x)), O[d][4 * g + 1] * rstd * siluf_(bfhi(zz.x)));
                o.y = pk2(O[d][4 * g + 2] * rstd * siluf_(bflo(zz.y)), O[d][4 * g + 3] * rstd * siluf_(bfhi(zz.y)));
                *(u32x2*)zp = o;
                if (g == 3) __builtin_amdgcn_sched_barrier(0);
            }
    }
    __syncthreads();
}

constexpr int L_KROWB = 272, L_VROWB = 144, L_SROWB = 272;
constexpr int L_K = 0, L_V = 64 * L_KROWB, L_S = L_V + 32 * L_VROWB, L_END = L_S + 32 * L_SROWB;
DI void gla_item(const Params& p, unsigned char* lds, int b, int hh, int sl) {
    const int tid = threadIdx.x, lane = tid & 63, wave = tid >> 6, l15 = lane & 15, g = lane >> 4;
    const int tt = wave & 3, dvt = wave >> 2;
    unsigned char* ws = p.ws;
    unsigned char* dout = (unsigned char*)p.out;
    const bf16_t* gq = (const bf16_t*)(dout + DO_GQ);
    const bf16_t* gk = (const bf16_t*)(dout + DO_GK);
    const bf16_t* gvT = (const bf16_t*)(ws + OFF_GVT);
    const bf16_t* ktt = (const bf16_t*)(ws + OFF_WIN_T);
    const float* dec = (const float*)(ws + OFF_DEC);
    bf16_t* gz = (bf16_t*)(ws + OFF_GZ);
    float* ssqb = (float*)(ws + OFF_SSQB);
    unsigned char* sK = lds + L_K; unsigned char* sV = lds + L_V; unsigned char* sS = lds + L_S;
    for (int i = tid; i < 32 * L_SROWB / 4; i += 512) ((unsigned*)sS)[i] = 0u;
    f32x4 sacc[2];
#pragma unroll
    for (int c = 0; c < 2; ++c) sacc[c] = (f32x4){0.f, 0.f, 0.f, 0.f};
    u32x4 nk[2]; u32x4 nv; bf16x8 nq[4]; bf16x8 nkt[2][2]; float nd[2]; u32x2 ngz;
    const int cc0 = 16 * (2 * tt) + l15;
    const int krow_ = tid >> 4, kc_ = tid & 15, vdv_ = (tid >> 3) & 31, vc_ = tid & 7;
    const bf16_t* kp = gk + ((size_t)b * 4096 + krow_) * 512 + hh * 128 + kc_ * 8;
    const bf16_t* vp_ = gvT + ((size_t)(b * 4 + hh) * 256 + sl * 32 + vdv_) * 4096 + vc_ * 8;
    const bf16_t* ktp = ktt + ((size_t)(b * 4 + hh) * 128 + cc0) * 4096 + 8 * g;
    const float* dp = dec + (size_t)b * 64 * 512 + hh * 128 + cc0;
    const bf16_t* qp = gq + ((size_t)b * 4096 + 16 * tt + l15) * 512 + hh * 128 + 8 * g;
    bf16_t* gzp = gz + ((size_t)b * 4096 + 16 * tt + l15) * 1024 + hh * 256 + sl * 32 + 16 * dvt + 4 * g;
#define L_LOAD_META()                                                                                                         \
    {                                                                                                                         \
        const bf16_t* km_ = (const bf16_t*)(ws + OFF_KTM) + (size_t)krow_ * 512 + hh * 128 + kc_ * 8;                         \
        nk[0] = *(const u32x4*)km_; nk[1] = *(const u32x4*)(km_ + 32 * 512);                                                  \
        nv = *(const u32x4*)((const bf16_t*)(ws + OFF_GVTM) + (size_t)(hh * 256 + sl * 32 + vdv_) * 64 + vc_ * 8);            \
        _Pragma("unroll") for (int ct = 0; ct < 2; ++ct) _Pragma("unroll") for (int ks = 0; ks < 2; ++ks)                     \
            nkt[ct][ks] = *(const bf16x8*)((const bf16_t*)(ws + OFF_KTTM) + (size_t)(hh * 128 + cc0 + 16 * ct) * 64 + 32 * ks + 8 * g); \
        _Pragma("unroll") for (int ct = 0; ct < 2; ++ct) nd[ct] = ((const float*)(ws + OFF_DECM))[hh * 128 + cc0 + 16 * ct];  \
        _Pragma("unroll") for (int ks = 0; ks < 4; ++ks) nq[ks] = (bf16x8){0, 0, 0, 0, 0, 0, 0, 0};                           \
        ngz = (u32x2){0u, 0u};                                                                                                \
    }
#define L_LOAD_REAL()                                                                                                         \
    {                                                                                                                         \
        nk[0] = *(const u32x4*)kp; nk[1] = *(const u32x4*)(kp + 32 * 512); kp += 64 * 512;                                    \
        nv = *(const u32x4*)vp_; vp_ += 64;                                                                                   \
        _Pragma("unroll") for (int ct = 0; ct < 2; ++ct) _Pragma("unroll") for (int ks = 0; ks < 2; ++ks)                     \
            nkt[ct][ks] = *(const bf16x8*)(ktp + (size_t)(16 * ct) * 4096 + 32 * ks);                                         \
        ktp += 64;                                                                                                            \
        nd[0] = dp[0]; nd[1] = dp[16]; dp += 512;                                                                             \
        _Pragma("unroll") for (int ks = 0; ks < 4; ++ks) nq[ks] = *(const bf16x8*)(qp + 32 * ks);                             \
        qp += 64 * 512;                                                                                                       \
        ngz = *(const u32x2*)gzp; gzp += 64 * 1024;                                                                           \
    }
#define L_STORE()                                                                                                             \
    {                                                                                                                         \
        _Pragma("unroll") for (int i = 0; i < 2; ++i) { const int pi = tid + 512 * i, row = pi >> 4, c = pi & 15;              \
            *(u32x4*)(sK + row * L_KROWB + c * 16) = nk[i]; }                                                                 \
        if (tid < 256) { const int dv = tid >> 3, c = tid & 7; *(u32x4*)(sV + dv * L_VROWB + c * 16) = nv; }                  \
    }
    L_LOAD_META();
    L_STORE();
    for (int n = 0; n <= 64; ++n) {
        bf16x8 cq[4], ckt[2][2]; float cd[2]; u32x2 cgz;
#pragma unroll
        for (int ks = 0; ks < 4; ++ks) cq[ks] = nq[ks];
#pragma unroll
        for (int ct = 0; ct < 2; ++ct) { cd[ct] = nd[ct]; ckt[ct][0] = nkt[ct][0]; ckt[ct][1] = nkt[ct][1]; }
        cgz = ngz;
        __syncthreads();
        if (n + 1 <= 64) L_LOAD_REAL();
        if (n > 0) {
            f32x4 at[4];
#pragma unroll
            for (int jt = 0; jt < 4; ++jt) at[jt] = (f32x4){0.f, 0.f, 0.f, 0.f};
#pragma unroll
            for (int jt = 0; jt < 4; ++jt)
#pragma unroll
                for (int ks = 0; ks < 4; ++ks) {
                    const bf16x8 kf = *(const bf16x8*)(sK + (jt * 16 + l15) * L_KROWB + (ks * 32 + 8 * g) * 2);
                    at[jt] = MFMA16(kf, cq[ks], at[jt]);
                }
            const int tl = 16 * tt + l15;
#pragma unroll
            for (int jt = 0; jt < 4; ++jt)
#pragma unroll
                for (int i = 0; i < 4; ++i) if (16 * jt + 4 * g + i > tl) at[jt][i] = 0.f;
            f32x4 o = (f32x4){0.f, 0.f, 0.f, 0.f};
#pragma unroll
            for (int s2 = 0; s2 < 2; ++s2) {
                u32x4 pa;
                pa.x = pk2(at[2 * s2][0], at[2 * s2][1]); pa.y = pk2(at[2 * s2][2], at[2 * s2][3]);
                pa.z = pk2(at[2 * s2 + 1][0], at[2 * s2 + 1][1]); pa.w = pk2(at[2 * s2 + 1][2], at[2 * s2 + 1][3]);
                const unsigned char* vp = sV + (dvt * 16 + l15) * L_VROWB + (32 * s2 + 4 * g) * 2;
                const u32x2 lo = *(const u32x2*)vp, hi = *(const u32x2*)(vp + 32);
                u32x4 vv; vv.x = lo.x; vv.y = lo.y; vv.z = hi.x; vv.w = hi.y;
                o = MFMA16(__builtin_bit_cast(bf16x8, vv), __builtin_bit_cast(bf16x8, pa), o);
            }
#pragma unroll
            for (int ks = 0; ks < 4; ++ks) {
                const bf16x8 sf = *(const bf16x8*)(sS + (dvt * 16 + l15) * L_SROWB + (ks * 32 + 8 * g) * 2);
                o = MFMA16(sf, cq[ks], o);
            }
            const size_t row = (size_t)b * 4096 + (n - 1) * 64 + 16 * tt + l15;
            float ss = (o[0] * o[0] + o[1] * o[1]) + (o[2] * o[2] + o[3] * o[3]);
            ss += __shfl_xor(ss, 16); ss += __shfl_xor(ss, 32);
            u32x2 ov;
            ov.x = pk2(o[0] * siluf_(bflo(cgz.x)), o[1] * siluf_(bfhi(cgz.x)));
            ov.y = pk2(o[2] * siluf_(bflo(cgz.y)), o[3] * siluf_(bfhi(cgz.y)));
            *(u32x2*)(gz + row * 1024 + hh * 256 + sl * 32 + 16 * dvt + 4 * g) = ov;
            if (g == 0) ssqb[(row * 4 + hh) * 16 + sl * 2 + dvt] = ss;
        }
#pragma unroll
        for (int ks = 0; ks < 2; ++ks) {
            const bf16x8 vf = *(const bf16x8*)(sV + (dvt * 16 + l15) * L_VROWB + (32 * ks + 8 * g) * 2);
            sacc[0] = MFMA16(vf, ckt[0][ks], sacc[0]);
            sacc[1] = MFMA16(vf, ckt[1][ks], sacc[1]);
        }
#pragma unroll
        for (int ct = 0; ct < 2; ++ct)
#pragma unroll
            for (int i = 0; i < 4; ++i) sacc[ct][i] *= cd[ct];
        __syncthreads();
#pragma unroll
        for (int ct = 0; ct < 2; ++ct)
#pragma unroll
            for (int i = 0; i < 4; ++i)
                *(bf16_t*)(sS + (16 * dvt + 4 * g + i) * L_SROWB + (cc0 + 16 * ct) * 2) = f2bf(sacc[ct][i]);
        if (n + 1 <= 64) L_STORE();
    }
#undef L_LOAD_META
#undef L_LOAD_REAL
#undef L_STORE
    __syncthreads();
}

DI void phase2(const Params& p, unsigned char* lds) {
    const int tid = threadIdx.x, lane = tid & 63;
    unsigned* ctr = (unsigned*)(p.ws + OFF_CTR);
    volatile unsigned* sItem = (volatile unsigned*)(lds + LDS_ITEM);
    constexpr unsigned N_GLA = 128, N_ATT = 1024;
    for (;;) {
        if (tid == 0) *sItem = atomicAdd(ctr, 1u);
        __syncthreads();
        const unsigned item = *sItem;
        __syncthreads();
        if (item >= N_GLA + N_ATT) break;
        if (item < N_GLA) gla_item(p, lds, item >> 5, (item >> 3) & 3, item & 7);
        else { const unsigned a = item - N_GLA; attn_item(p, lds, a & 3, (a >> 2) & 7, 31 - (int)(a >> 5)); }
    }
}

DI void phase3(const Params& p, unsigned char* lds) {
    const int tid = threadIdx.x, lane = tid & 63, wave = tid >> 6, l31 = lane & 31, h = lane >> 5;
    const int wn = wave & 1, wm = wave >> 1;
    unsigned char* ws = p.ws;
    const float* ssqb = (const float*)(ws + OFF_SSQB);
    float* sc = (float*)(lds + LDS_SCALE);
    const unsigned char* sga = ws + OFF_SGA;
    const unsigned char* sgb = ws + OFF_SGB;
    bf16_t* merged = (bf16_t*)(ws + OFF_AK);
    for (int id = blockIdx.x; id < 512; id += gridDim.x) {
        const int mt = id >> 3, nt = id & 7;
#pragma unroll
        for (int i = 0; i < 2; ++i) {
            const int e = tid + 512 * i, row = e >> 2, hh = e & 3;
            const f32x4* sp = (const f32x4*)(ssqb + (((size_t)mt * 256 + row) * 4 + hh) * 16);
            const f32x4 a = sp[0], b2 = sp[1], c = sp[2], d = sp[3];
            const float s = ((a.x + a.y) + (a.z + a.w)) + ((b2.x + b2.y) + (b2.z + b2.w)) + ((c.x + c.y) + (c.z + c.w)) + ((d.x + d.y) + (d.z + d.w));
            sc[e] = 1.0f / sqrtf(s * (1.0f / 256.0f) + EPS);
        }
        __syncthreads();
        float hs[2][3], rl[2];
#pragma unroll
        for (int im = 0; im < 2; ++im) {
            const int lr = wm * 64 + im * 32 + l31;
            const f32x4 r = *(const f32x4*)(sc + lr * 4);
            hs[im][0] = r.x / r.y; hs[im][1] = r.y / r.z; hs[im][2] = r.z / r.w; rl[im] = r.w;
        }
        f32x16 acc[2][2];
        unsigned mb[2][2][8];
        zero_acc<2>(acc);
        gemm_tile<2, true>(acc, (const bf16_t*)(ws + OFF_WB_T) + (size_t)nt * 128 * 1024, (const bf16_t*)(ws + OFF_GZ) + (size_t)mt * 256 * 1024, lds, hs);
#pragma unroll
        for (int im = 0; im < 2; ++im) {
            const size_t tok = (size_t)mt * 256 + wm * 64 + im * 32 + l31;
#pragma unroll
            for (int in = 0; in < 2; ++in)
#pragma unroll
                for (int g = 0; g < 4; ++g) {
                    const size_t off = tok * 1024 + nt * 128 + wn * 64 + in * 32 + 8 * g + 4 * h;
                    const unsigned ub = *(const unsigned*)(sgb + off);
                    const float q = rl[im] * (1.0f / 255.0f);
                    mb[in][im][2 * g] = pk2((float)(ub & 255u) * q * acc[in][im][4 * g + 0], (float)((ub >> 8) & 255u) * q * acc[in][im][4 * g + 1]);
                    mb[in][im][2 * g + 1] = pk2((float)((ub >> 16) & 255u) * q * acc[in][im][4 * g + 2], (float)(ub >> 24) * q * acc[in][im][4 * g + 3]);
                }
        }
        zero_acc<2>(acc);
        gemm_tile<2, false>(acc, (const bf16_t*)(ws + OFF_WA_T) + (size_t)nt * 128 * 1024, (const bf16_t*)(ws + OFF_AZ) + (size_t)mt * 256 * 1024, lds, hs);
#pragma unroll
        for (int im = 0; im < 2; ++im) {
            const size_t tok = (size_t)mt * 256 + wm * 64 + im * 32 + l31;
#pragma unroll
            for (int in = 0; in < 2; ++in)
#pragma unroll
                for (int g = 0; g < 4; ++g) {
                    const size_t off = tok * 1024 + nt * 128 + wn * 64 + in * 32 + 8 * g + 4 * h;
                    const unsigned ua = *(const unsigned*)(sga + off);
                    const unsigned b0 = mb[in][im][2 * g], b1 = mb[in][im][2 * g + 1];
                    const float q = 1.0f / 255.0f;
                    const float m0 = (float)(ua & 255u) * q * acc[in][im][4 * g + 0] + bflo(b0);
                    const float m1 = (float)((ua >> 8) & 255u) * q * acc[in][im][4 * g + 1] + bfhi(b0);
                    const float m2 = (float)((ua >> 16) & 255u) * q * acc[in][im][4 * g + 2] + bflo(b1);
                    const float m3 = (float)(ua >> 24) * q * acc[in][im][4 * g + 3] + bfhi(b1);
                    u32x2 o; o.x = pk2(m0, m1); o.y = pk2(m2, m3);
                    *(u32x2*)(merged + off) = o;
                }
        }
        __syncthreads();
    }
}

DI void phase4(const Params& p, unsigned char* lds) {
    const int tid = threadIdx.x, lane = tid & 63, wave = tid >> 6, l31 = lane & 31, h = lane >> 5;
    const int wn = wave & 1, wm = wave >> 1;
    unsigned char* ws = p.ws;
    float* ssqh = (float*)(ws + OFF_SSQH);
    for (int id = blockIdx.x; id < 512; id += gridDim.x) {
        const int mt = id >> 3, nt = id & 7;
        f32x16 acc[2][2];
        zero_acc<2>(acc);
        const float hs0[2][3] = {{1.f, 1.f, 1.f}, {1.f, 1.f, 1.f}};
        gemm_tile<2, false>(acc, (const bf16_t*)(ws + OFF_WO_T) + (size_t)nt * 128 * 1024, (const bf16_t*)(ws + OFF_AK) + (size_t)mt * 256 * 1024, lds, hs0);
#pragma unroll
        for (int im = 0; im < 2; ++im) {
            const size_t tok = (size_t)mt * 256 + wm * 64 + im * 32 + l31;
            float ss = 0.f;
#pragma unroll
            for (int in = 0; in < 2; ++in)
#pragma unroll
                for (int g = 0; g < 4; ++g) {
                    const size_t off = tok * 1024 + nt * 128 + wn * 64 + in * 32 + 8 * g + 4 * h;
                    const f32x4 xv = *(const f32x4*)(p.x + off);
                    f32x4 o;
                    o.x = xv.x + acc[in][im][4 * g + 0]; o.y = xv.y + acc[in][im][4 * g + 1];
                    o.z = xv.z + acc[in][im][4 * g + 2]; o.w = xv.w + acc[in][im][4 * g + 3];
                    ss += (o.x * o.x + o.y * o.y) + (o.z * o.z + o.w * o.w);
                    *(f32x4*)(p.out + off) = o;
                }
            ss += __shfl_xor(ss, 32);
            if (h == 0) ssqh[tok * 16 + nt * 2 + wn] = ss;
        }
    }
}

DI void phase5(const Params& p, unsigned char* lds) {
    const int tid = threadIdx.x, lane = tid & 63, wave = tid >> 6;
    const float* ssqh = (const float*)(p.ws + OFF_SSQH);
    for (int it = blockIdx.x; it < MROWS / 8; it += gridDim.x) {
        const size_t row = (size_t)it * 8 + wave;
        float s = lane < 16 ? ssqh[row * 16 + lane] : 0.f;
        s = wave_sum(s);
        const float rstd = 1.0f / sqrtf(s * (1.0f / 1024.0f) + EPS);
        f32x4* orow = (f32x4*)(p.out + row * 1024) + lane;
        const f32x4* wrow = (const f32x4*)p.final_w + lane;
#pragma unroll
        for (int j = 0; j < 4; ++j) {
            f32x4 v = orow[64 * j]; const f32x4 w = wrow[64 * j];
            v.x = v.x * rstd * w.x; v.y = v.y * rstd * w.y; v.z = v.z * rstd * w.z; v.w = v.w * rstd * w.w;
            orow[64 * j] = v;
        }
    }
}

DI void grid_bar(unsigned* bar, unsigned target) {
    asm volatile("s_waitcnt vmcnt(0)" ::: "memory");
    __syncthreads();
    if (threadIdx.x == 0) {
        __builtin_amdgcn_fence(__ATOMIC_RELEASE, "agent");
        asm volatile("s_waitcnt vmcnt(0)" ::: "memory");
        __hip_atomic_fetch_add(bar, 1u, __ATOMIC_RELAXED, __HIP_MEMORY_SCOPE_AGENT);
        while (__hip_atomic_load(bar, __ATOMIC_RELAXED, __HIP_MEMORY_SCOPE_AGENT) < target) __builtin_amdgcn_s_sleep(2);
        __builtin_amdgcn_fence(__ATOMIC_ACQUIRE, "agent");
        asm volatile("s_waitcnt vmcnt(0)" ::: "memory");
    }
    __syncthreads();
}

DI void run_phase(const Params& p, unsigned char* lds, int ph) {
    switch (ph) {
        case 0: phase0(p, lds); break;
        case 1: phase1(p, lds); break;
        case 2: phase15(p, lds); break;
        case 3: phase2(p, lds); break;
        case 4: phase3(p, lds); break;
        case 5: phase4(p, lds); break;
        default: phase5(p, lds); break;
    }
}

__global__ void __launch_bounds__(512) hybrid_fwd(Params p) {
    extern __shared__ __attribute__((aligned(16))) unsigned char lds[];
#if MULTI_LAUNCH
    run_phase(p, lds, p.phase_lo);
#else
    cg::grid_group grid = cg::this_grid();
    unsigned* bar = (unsigned*)(p.ws + OFF_CTR + 128);
    const unsigned G = gridDim.x;
    phase0(p, lds); if (PROBE_REP & 1) phase0(p, lds); grid.sync();
    phase1(p, lds); if (PROBE_REP & 2) phase1(p, lds); grid_bar(bar, G);
    phase15(p, lds); grid_bar(bar, 2 * G);
    phase2(p, lds); grid_bar(bar, 3 * G);
    phase3(p, lds); if (PROBE_REP & 4) phase3(p, lds); grid_bar(bar, 4 * G);
    phase4(p, lds); if (PROBE_REP & 8) phase4(p, lds); grid_bar(bar, 5 * G);
    phase5(p, lds);
#endif
}

extern "C" void kernel_launch(void* const* d_in, const int* in_sizes, int n_in, void* d_out, int out_size, void* d_ws, size_t ws_size, hipStream_t stream) {
    static int grid = 0;
    if (grid == 0) {
        int dev = 0, cus = 0, per_cu = 0;
        hipGetDevice(&dev);
        hipDeviceGetAttribute(&cus, hipDeviceAttributeMultiprocessorCount, dev);
        hipFuncSetAttribute((const void*)hybrid_fwd, hipFuncAttributeMaxDynamicSharedMemorySize, LDS_BYTES);
        hipOccupancyMaxActiveBlocksPerMultiprocessor(&per_cu, (const void*)hybrid_fwd, 512, LDS_BYTES);
        if (per_cu < 1) per_cu = 1;
        if (per_cu > 1) per_cu = 1;
        if (cus <= 0) cus = 256;
        grid = cus * per_cu;
    }
    hipMemsetAsync((unsigned char*)d_ws + OFF_CTR, 0, 256, stream);
    Params p{};
    p.x = (const float*)d_in[0]; p.meta = (const float*)d_in[1]; p.norm_w = (const float*)d_in[2]; p.w_in = (const float*)d_in[3];
    p.lq1 = (const float*)d_in[4]; p.lk1 = (const float*)d_in[5]; p.lq2 = (const float*)d_in[6]; p.lk2 = (const float*)d_in[7];
    p.subln_w = (const float*)d_in[8]; p.gate_w2 = (const float*)d_in[9]; p.gate_b = (const float*)d_in[10]; p.gla_norm_w = (const float*)d_in[11];
    p.wa = (const float*)d_in[12]; p.wb = (const float*)d_in[13]; p.wo = (const float*)d_in[14]; p.final_w = (const float*)d_in[15];
    p.out = (float*)d_out; p.ws = (unsigned char*)d_ws;
#if MULTI_LAUNCH
    for (int ph = 0; ph < 7; ++ph) {
        p.phase_lo = ph; p.phase_hi = ph + 1;
        hipLaunchKernelGGL(hybrid_fwd, dim3(grid), dim3(512), LDS_BYTES, stream, p);
    }
#else
    p.phase_lo = 0; p.phase_hi = 7;
    void* args[] = {&p};
    hipError_t e = hipLaunchCooperativeKernel((const void*)hybrid_fwd, dim3(grid), dim3(512), args, LDS_BYTES, stream);
    if (e != hipSuccess) fprintf(stderr, "cooperative launch failed: %s (grid %d)\n", hipGetErrorString(e), grid);
#endif
}
```

```cpp
#include <hip/hip_runtime.h>
#include <hip/hip_cooperative_groups.h>
#include <cstdio>
#include <cstdint>
namespace cg = cooperative_groups;

#ifndef MULTI_LAUNCH
#define MULTI_LAUNCH 0
#endif
#ifndef PROBE_REP
#define PROBE_REP 0
#endif

typedef unsigned short bf16_t;
typedef short bf16x8 __attribute__((ext_vector_type(8)));
typedef float f32x4 __attribute__((ext_vector_type(4)));
typedef float f32x2 __attribute__((ext_vector_type(2)));
typedef float f32x16 __attribute__((ext_vector_type(16)));
typedef unsigned u32x4 __attribute__((ext_vector_type(4)));
typedef unsigned u32x2 __attribute__((ext_vector_type(2)));
typedef __bf16 bfv2 __attribute__((ext_vector_type(2)));

#define DI __device__ __forceinline__
#define MFMA32(a, b, c) __builtin_amdgcn_mfma_f32_32x32x16_bf16((a), (b), (c), 0, 0, 0)
#define MFMA16(a, b, c) __builtin_amdgcn_mfma_f32_16x16x32_bf16((a), (b), (c), 0, 0, 0)

DI unsigned pk2(float a, float b) { f32x2 v = {a, b}; return __builtin_bit_cast(unsigned, __builtin_convertvector(v, bfv2)); }
DI float bf2f(bf16_t v) { return __uint_as_float(((unsigned)v) << 16); }
DI float bflo(unsigned u) { return __uint_as_float(u << 16); }
DI float bfhi(unsigned u) { return __uint_as_float(u & 0xffff0000u); }
DI bf16_t f2bf(float a) { return (bf16_t)(pk2(a, 0.f) & 0xffffu); }
DI float wave_sum(float v) {
#pragma unroll
    for (int o = 32; o; o >>= 1) v += __shfl_xor(v, o);
    return v;
}
DI float sigmoidf_(float z) { return 1.f / (1.f + __expf(-z)); }
DI float siluf_(float z) { return z / (1.f + __expf(-z)); }

constexpr int D = 1024, NB = 4, SEQ = 4096, MROWS = NB * SEQ;
constexpr int NIN = 9232, NINP = 9344;
constexpr float EPS = 1e-5f;

constexpr size_t SZ_ACT = (size_t)MROWS * 1024 * 2;
constexpr size_t OFF_WIN_T = 0;
constexpr size_t OFF_WA_T = OFF_WIN_T + (size_t)NINP * 1024 * 2;
constexpr size_t OFF_WB_T = OFF_WA_T + 2097152;
constexpr size_t OFF_WO_T = OFF_WB_T + 2097152;
constexpr size_t OFF_AK = OFF_WO_T + 2097152;
constexpr size_t OFF_AVT = OFF_AK + SZ_ACT;
constexpr size_t OFF_AZ = OFF_AVT + SZ_ACT;
constexpr size_t OFF_GVT = OFF_AZ + SZ_ACT;
constexpr size_t OFF_GZ = OFF_GVT + SZ_ACT;
constexpr size_t OFF_GA = OFF_GZ + SZ_ACT;
constexpr size_t OFF_GB = OFF_GA + SZ_ACT;
constexpr size_t OFF_GLR = OFF_GB + SZ_ACT;
constexpr size_t OFF_RSTD = OFF_GLR + (size_t)MROWS * 16 * 2;
constexpr size_t OFF_ROPE = OFF_RSTD + 65792;
constexpr size_t OFF_AKM = OFF_ROPE + 263168;
constexpr size_t OFF_AVTM = OFF_AKM + 131072;
constexpr size_t OFF_GVTM = OFF_AVTM + 131072;
constexpr size_t OFF_GKM = OFF_GVTM + 131072;
constexpr size_t OFF_GLRM = OFF_GKM + 16384;
constexpr size_t OFF_KTM = OFF_GLRM + 512;
constexpr size_t OFF_KTTM = OFF_KTM + 65536;
constexpr size_t OFF_DEC = OFF_KTTM + 65536;
constexpr size_t OFF_DECM = OFF_DEC + 524288;
constexpr size_t OFF_SSQB = OFF_DECM + 2048;
constexpr size_t OFF_SSQH = OFF_SSQB + 4194304;
constexpr size_t OFF_CTR = OFF_SSQH + 1048576;
constexpr size_t OFF_XBM = OFF_CTR + 256;
constexpr size_t OFF_XBAR = OFF_XBM + 32768;
constexpr size_t WS_END = OFF_XBAR + 16384;
constexpr size_t OFF_XB = OFF_GA;
constexpr size_t OFF_SGA = OFF_GB;
constexpr size_t OFF_SGB = OFF_GB + (size_t)MROWS * 1024;
static_assert(WS_END <= 268435456ull, "workspace over 256 MiB");
constexpr size_t DO_AQ = 0, DO_GQ = SZ_ACT, DO_GK = SZ_ACT + SZ_ACT / 2;

constexpr int G_ROWB = 144;
constexpr int G_SW = 128 * G_ROWB, G_SX = 256 * G_ROWB, G_STAGE = G_SW + G_SX;
constexpr int G_SW4 = 256 * G_ROWB, G_STAGE4 = G_SW4 + G_SX;
constexpr int LDS_SCALE = 2 * G_STAGE4;
constexpr int LDS_ITEM = LDS_SCALE + 4096;
constexpr int LDS_BYTES = LDS_ITEM + 64;

struct Params {
    const float *x, *meta, *norm_w, *w_in, *lq1, *lk1, *lq2, *lk2, *subln_w, *gate_w2, *gate_b, *gla_norm_w, *wa, *wb, *wo, *final_w;
    float* out;
    unsigned char* ws;
    int phase_lo, phase_hi;
};

template <int MODE>
DI void p0_transpose_item(const Params& p, int item, float* tile) {
    const int tid = threadIdx.x;
    const float* W = MODE == 0 ? p.w_in : MODE == 1 ? p.wa : MODE == 2 ? p.wb : p.wo;
    const int ldw = MODE == 0 ? NIN : 1024;
    const int nbc = MODE == 0 ? NINP / 64 : 16;
    bf16_t* WT = (bf16_t*)(p.ws + (MODE == 0 ? OFF_WIN_T : MODE == 1 ? OFF_WA_T : MODE == 2 ? OFF_WB_T : OFF_WO_T));
    const int kb = item / nbc, nb = item % nbc, k0 = kb * 64, n0 = nb * 64;
#pragma unroll
    for (int i = 0; i < 8; ++i) {
        const int kk = (tid >> 6) + 8 * i, nn = tid & 63, n = n0 + nn, k = k0 + kk;
        int src = n;
        if (MODE == 0) { src = n < 7168 ? n : (n < 9216 ? n + 16 : (n < 9232 ? n - 2048 : -1)); }
        float sc = 1.f;
        if (MODE == 0) sc = p.norm_w[k];
        if (MODE == 1) sc = 0.8f * p.subln_w[k & 127];
        if (MODE == 2) sc = p.gla_norm_w[k & 255];
        float v = 0.f;
        if (src >= 0) v = W[(size_t)k * ldw + src] * sc;
        tile[kk * 65 + nn] = v;
    }
    __syncthreads();
    {
        const int nn = tid >> 3, c = tid & 7;
        const float* s = tile + (8 * c) * 65 + nn;
        u32x4 o;
        o.x = pk2(s[0 * 65], s[1 * 65]); o.y = pk2(s[2 * 65], s[3 * 65]); o.z = pk2(s[4 * 65], s[5 * 65]); o.w = pk2(s[6 * 65], s[7 * 65]);
        *(u32x4*)(WT + (size_t)(n0 + nn) * 1024 + k0 + 8 * c) = o;
    }
    __syncthreads();
}

DI void phase0(const Params& p, unsigned char* lds) {
    const int tid = threadIdx.x, lane = tid & 63, wave = tid >> 6;
    float* tile = (float*)lds;
    constexpr int I_WIN = 16 * (NINP / 64), I_SQ = 256;
    constexpr int I_T = I_WIN + 3 * I_SQ;
    constexpr int I_RSTD = (MROWS + 16 + 7) / 8;
    constexpr int I_ROPE = (4112 * 8 + 511) / 512;
    constexpr int I_ZERO = 393216 / 8192;
    constexpr int I_ALL = I_T + I_RSTD + I_ROPE + I_ZERO;
    for (int it = blockIdx.x; it < I_ALL; it += gridDim.x) {
        int r = it;
        if (r < I_WIN) { p0_transpose_item<0>(p, r, tile); continue; } r -= I_WIN;
        if (r < I_SQ) { p0_transpose_item<1>(p, r, tile); continue; } r -= I_SQ;
        if (r < I_SQ) { p0_transpose_item<2>(p, r, tile); continue; } r -= I_SQ;
        if (r < I_SQ) { p0_transpose_item<3>(p, r, tile); continue; } r -= I_SQ;
        if (r < I_RSTD) {
            const int row = r * 8 + wave;
            if (row < MROWS + 16) {
                const float* src = row < MROWS ? p.x + (size_t)row * 1024 : p.meta + (size_t)(row - MROWS) * 1024;
                const f32x4* xr = (const f32x4*)src + lane;
                float s = 0.f;
#pragma unroll
                for (int j = 0; j < 4; ++j) { const f32x4 v = xr[64 * j]; s += (v.x * v.x + v.y * v.y) + (v.z * v.z + v.w * v.w); }
                s = wave_sum(s);
                if (lane == 0) ((float*)(p.ws + OFF_RSTD))[row] = 1.0f / sqrtf(s * (1.0f / 1024.0f) + EPS);
                bf16_t* xbrow = row < MROWS ? (bf16_t*)(p.ws + OFF_XB) + (size_t)row * 1024 : (bf16_t*)(p.ws + OFF_XBM) + (size_t)(row - MROWS) * 1024;
#pragma unroll
                for (int j = 0; j < 4; ++j) { const f32x4 v = xr[64 * j]; u32x2 o; o.x = pk2(v.x, v.y); o.y = pk2(v.z, v.w); *(u32x2*)(xbrow + 256 * j + 4 * lane) = o; }
            }
            continue;
        }
        r -= I_RSTD;
        if (r < I_ROPE) {
            const int e = r * 512 + tid;
            if (e < 4112 * 8) {
                const int pos = e >> 3, i = e & 7;
                const float inv = powf(500000.0f, -(float)i / 8.0f);
                const float ang = (float)pos * inv;
                float* t = (float*)(p.ws + OFF_ROPE) + (size_t)e * 2;
                t[0] = cosf(ang); t[1] = sinf(ang);
            }
            continue;
        }
        r -= I_ROPE;
        { u32x4 z = {0u, 0u, 0u, 0u}; *(u32x4*)(p.ws + OFF_AKM + (size_t)r * 8192 + tid * 16) = z; }
    }
}

template <int NI, bool HS>
DI void gemm_tile(f32x16 (&acc)[NI][2], const bf16_t* __restrict__ Wt, const bf16_t* __restrict__ X, unsigned char* lds, const float (&hs)[2][3]) {
    const int tid = threadIdx.x, lane = tid & 63, wave = tid >> 6, l31 = lane & 31, h = lane >> 5;
    const int wn = wave & 1, wm = wave >> 1;
    constexpr int SW = NI * 64 * G_ROWB, STAGE = SW + G_SX;
    u32x4 wreg[NI];
    u32x4 xreg[4];
    const int prow = tid >> 3, pc = tid & 7;
    const bf16_t* wp = Wt + (size_t)prow * 1024 + pc * 8;
    const bf16_t* xp = X + (size_t)prow * 1024 + pc * 8;
#define G_LOAD(kt_)                                                                                                  \
    {                                                                                                                \
        _Pragma("unroll") for (int i = 0; i < NI; ++i) wreg[i] = *(const u32x4*)(wp + (size_t)i * 64 * 1024 + (kt_) * 64); \
        _Pragma("unroll") for (int i = 0; i < 4; ++i) xreg[i] = *(const u32x4*)(xp + (size_t)i * 64 * 1024 + (kt_) * 64);  \
    }
#define G_STORE(buf_)                                                                                                \
    {                                                                                                                \
        unsigned char* sW_ = lds + (buf_) * STAGE + prow * G_ROWB + pc * 16; unsigned char* sX_ = sW_ + SW;          \
        _Pragma("unroll") for (int i = 0; i < NI; ++i) *(u32x4*)(sW_ + i * 64 * G_ROWB) = wreg[i];                   \
        _Pragma("unroll") for (int i = 0; i < 4; ++i) *(u32x4*)(sX_ + i * 64 * G_ROWB) = xreg[i];                    \
    }
    G_LOAD(0);
    G_STORE(0);
    __syncthreads();
    for (int kt = 0; kt < 16; ++kt) {
        if (kt + 1 < 16) G_LOAD(kt + 1);
        if (HS) {
            if (kt == 4 || kt == 8 || kt == 12) {
                const float s0 = kt == 4 ? hs[0][0] : (kt == 8 ? hs[0][1] : hs[0][2]);
                const float s1 = kt == 4 ? hs[1][0] : (kt == 8 ? hs[1][1] : hs[1][2]);
#pragma unroll
                for (int n = 0; n < NI; ++n)
#pragma unroll
                    for (int i = 0; i < 16; ++i) { acc[n][0][i] *= s0; acc[n][1][i] *= s1; }
            }
        }
        {
            const unsigned char* sW = lds + (kt & 1) * STAGE + (wn * NI * 32 + l31) * G_ROWB + h * 16;
            const unsigned char* sX = lds + (kt & 1) * STAGE + SW + (wm * 64 + l31) * G_ROWB + h * 16;
#pragma unroll
            for (int ks = 0; ks < 4; ++ks) {
                const bf16x8 x0 = *(const bf16x8*)(sX + ks * 32), x1 = *(const bf16x8*)(sX + 32 * G_ROWB + ks * 32);
#pragma unroll
                for (int n = 0; n < NI; ++n) {
                    const bf16x8 w = *(const bf16x8*)(sW + n * 32 * G_ROWB + ks * 32);
                    acc[n][0] = MFMA32(w, x0, acc[n][0]); acc[n][1] = MFMA32(w, x1, acc[n][1]);
                }
            }
        }
        if (kt + 1 < 16) G_STORE((kt + 1) & 1);
        __syncthreads();
    }
#undef G_LOAD
#undef G_STORE
}

template <int NI>
DI void zero_acc(f32x16 (&acc)[NI][2]) {
#pragma unroll
    for (int a = 0; a < NI; ++a)
#pragma unroll
        for (int b = 0; b < 2; ++b)
#pragma unroll
            for (int i = 0; i < 16; ++i) acc[a][b][i] = 0.f;
}

DI unsigned sig_u8(float z) { return (unsigned)(255.0f / (1.0f + __expf(-z)) + 0.5f); }
DI void p1_epilogue(const Params& p, f32x16 (&acc)[4][2], int mt, int nt) {
    const int tid = threadIdx.x, lane = tid & 63, wave = tid >> 6, l31 = lane & 31, h = lane >> 5;
    const int wn = wave & 1, wm = wave >> 1;
    int split, nc0;
    if (nt < 4) { split = 0; nc0 = nt * 256; }
    else if (nt < 8) { split = 1; nc0 = (nt - 4) * 256; }
    else if (nt < 12) { split = 2; nc0 = (nt - 8) * 256; }
    else if (nt < 16) { split = 3; nc0 = (nt - 12) * 256; }
    else if (nt < 18) { split = 4; nc0 = (nt - 16) * 256; }
    else if (nt < 20) { split = 5; nc0 = (nt - 18) * 256; }
    else if (nt < 24) { split = 6; nc0 = (nt - 20) * 256; }
    else if (nt < 28) { split = 7; nc0 = (nt - 24) * 256; }
    else if (nt < 32) { split = 9; nc0 = (nt - 28) * 256; }
    else { split = 10; nc0 = (nt - 32) * 256; }
    const float* rstd = (const float*)(p.ws + OFF_RSTD);
    const float* rope = (const float*)(p.ws + OFF_ROPE);
    unsigned char* ws = p.ws;
    unsigned char* dout = (unsigned char*)p.out;
#pragma unroll
    for (int im = 0; im < 2; ++im) {
        const int tok = mt * 256 + wm * 64 + im * 32 + l31;
        const float rs = rstd[tok];
        const int pos = 16 + (tok & 4095);
        const int b = tok >> 12, s = tok & 4095;
#pragma unroll
        for (int in = 0; in < 4; ++in) {
            const int nb = nc0 + wn * 128 + in * 32;
            float v[16];
#pragma unroll
            for (int i = 0; i < 16; ++i) v[i] = acc[in][im][i] * rs;
            if (split <= 1 && (nb & 63) == 0) {
                const float* cs = rope + ((size_t)pos * 8 + 4 * h) * 2;
#pragma unroll
                for (int i = 0; i < 4; ++i) {
                    const float c = cs[2 * i], sn = cs[2 * i + 1];
                    const float x1 = v[i], x2 = v[i + 4];
                    v[i] = x1 * c - x2 * sn; v[i + 4] = x2 * c + x1 * sn;
                }
            }
            if (split == 2 || split == 6) {
                const int hshift = split == 2 ? 7 : 8;
                const int nheads = split == 2 ? 8 : 4;
                const int dvn = 1 << hshift;
                bf16_t* base = (bf16_t*)(ws + (split == 2 ? OFF_AVT : OFF_GVT));
#pragma unroll
                for (int i = 0; i < 16; ++i) {
                    const int n = nb + (i & 3) + 8 * (i >> 2) + 4 * h;
                    const int hd = n >> hshift, dv = n & (dvn - 1);
                    base[((size_t)(b * nheads + hd) * dvn + dv) * 4096 + s] = f2bf(v[i]);
                }
            } else if (split >= 9) {
                unsigned char* dst = ws + (split == 9 ? OFF_SGA : OFF_SGB) + (size_t)tok * 1024 + nb + 4 * h;
#pragma unroll
                for (int g = 0; g < 4; ++g) {
                    const unsigned o = sig_u8(v[4 * g]) | (sig_u8(v[4 * g + 1]) << 8) | (sig_u8(v[4 * g + 2]) << 16) | (sig_u8(v[4 * g + 3]) << 24);
                    *(unsigned*)(dst + 8 * g) = o;
                }
            } else {
                bf16_t* dst; int ld;
                switch (split) {
                    case 0: dst = (bf16_t*)(dout + DO_AQ); ld = 1024; break;
                    case 1: dst = (bf16_t*)(ws + OFF_AK); ld = 1024; break;
                    case 3: dst = (bf16_t*)(ws + OFF_AZ); ld = 1024; break;
                    case 4: dst = (bf16_t*)(dout + DO_GQ); ld = 512; break;
                    case 5: dst = (bf16_t*)(dout + DO_GK); ld = 512; break;
                    default: dst = (bf16_t*)(ws + OFF_GZ); ld = 1024; break;
                }
#pragma unroll
                for (int g = 0; g < 4; ++g) {
                    u32x2 o; o.x = pk2(v[4 * g], v[4 * g + 1]); o.y = pk2(v[4 * g + 2], v[4 * g + 3]);
                    *(u32x2*)(dst + (size_t)tok * ld + nb + 8 * g + 4 * h) = o;
                }
            }
        }
    }
}

DI void p1_glr_job(const Params& p, unsigned char* lds, int job) {
    const int tid = threadIdx.x, lane = tid & 63, wave = tid >> 6, l15 = lane & 15, g = lane >> 4;
    const int rtile = wave & 3, khalf = wave >> 2;
    const bf16_t* xb = (const bf16_t*)(p.ws + OFF_XB);
    const bf16_t* wt = (const bf16_t*)(p.ws + OFF_WIN_T) + (size_t)9216 * 1024;
    const size_t row0 = (size_t)job * 64 + rtile * 16;
    const bf16_t* ap = xb + (row0 + l15) * 1024 + khalf * 512 + 8 * g;
    const bf16_t* bp = wt + (size_t)l15 * 1024 + khalf * 512 + 8 * g;
    f32x4 acc = (f32x4){0.f, 0.f, 0.f, 0.f};
#pragma unroll 4
    for (int ks = 0; ks < 16; ++ks) {
        const bf16x8 a = *(const bf16x8*)(ap + ks * 32), bb = *(const bf16x8*)(bp + ks * 32);
        acc = MFMA16(a, bb, acc);
    }
    f32x4* red = (f32x4*)lds;
    __syncthreads();
    if (khalf == 1) red[rtile * 64 + lane] = acc;
    __syncthreads();
    if (khalf == 0) {
        const f32x4 o = red[rtile * 64 + lane];
        const float* rstd = (const float*)(p.ws + OFF_RSTD);
        bf16_t* glr = (bf16_t*)(p.ws + OFF_GLR);
#pragma unroll
        for (int i = 0; i < 4; ++i) {
            const size_t row = row0 + 4 * g + i;
            glr[row * 16 + l15] = f2bf((acc[i] + o[i]) * rstd[row]);
        }
    }
    __syncthreads();
}

DI void p1_meta_job(const Params& p, unsigned char* lds, int job) {
    const int tid = threadIdx.x, lane = tid & 63, wave = tid >> 6, l15 = lane & 15, g = lane >> 4;
    int c0;
    if (job < 64) c0 = 1024 + job * 16;
    else if (job < 128) c0 = 2048 + (job - 64) * 16;
    else if (job < 160) c0 = 4608 + (job - 128) * 16;
    else if (job < 224) c0 = 5120 + (job - 160) * 16;
    else c0 = 9216;
    const bf16_t* xbm = (const bf16_t*)(p.ws + OFF_XBM);
    const bf16_t* wt = (const bf16_t*)(p.ws + OFF_WIN_T);
    const bf16_t* ap = xbm + (size_t)l15 * 1024 + wave * 128 + 8 * g;
    const bf16_t* bp = wt + (size_t)(c0 + l15) * 1024 + wave * 128 + 8 * g;
    f32x4 acc = (f32x4){0.f, 0.f, 0.f, 0.f};
#pragma unroll
    for (int ks = 0; ks < 4; ++ks) {
        const bf16x8 a = *(const bf16x8*)(ap + ks * 32), bb = *(const bf16x8*)(bp + ks * 32);
        acc = MFMA16(a, bb, acc);
    }
    f32x4* red = (f32x4*)lds;
    __syncthreads();
    red[wave * 64 + lane] = acc;
    __syncthreads();
    if (wave == 0) {
        f32x4 s = red[lane];
#pragma unroll
        for (int w = 1; w < 8; ++w) { const f32x4 t = red[w * 64 + lane]; s.x += t.x; s.y += t.y; s.z += t.z; s.w += t.w; }
        const float* rstd = (const float*)(p.ws + OFF_RSTD) + MROWS;
        const float* rope = (const float*)(p.ws + OFF_ROPE);
        unsigned char* ws = p.ws;
        const int col = c0 + l15;
#pragma unroll
        for (int i = 0; i < 4; ++i) {
            const int row = 4 * g + i;
            float v = s[i] * rstd[row];
            if (job < 64 && (c0 & 63) == 0) {
                const float other = __shfl_xor(v, 8);
                const float* cs = rope + ((size_t)row * 8 + (l15 & 7)) * 2;
                const float c = cs[0], sn = cs[1];
                v = (l15 < 8) ? (v * c - other * sn) : (v * c + other * sn);
            }
            const bf16_t val = f2bf(v);
            if (job < 64) ((bf16_t*)(ws + OFF_AKM))[(size_t)(48 + row) * 1024 + (col - 1024)] = val;
            else if (job < 128) { const int n = col - 2048; ((bf16_t*)(ws + OFF_AVTM))[(size_t)n * 64 + 48 + row] = val; }
            else if (job < 160) ((bf16_t*)(ws + OFF_GKM))[(size_t)row * 512 + (col - 4608)] = val;
            else if (job < 224) { const int n = col - 5120; ((bf16_t*)(ws + OFF_GVTM))[(size_t)n * 64 + 48 + row] = val; }
            else ((bf16_t*)(ws + OFF_GLRM))[row * 16 + l15] = val;
        }
    }
    __syncthreads();
}

DI void phase1(const Params& p, unsigned char* lds) {
    for (int j = blockIdx.x; j < 256; j += gridDim.x) p1_glr_job(p, lds, j);
    for (int j = blockIdx.x; j < 225; j += gridDim.x) p1_meta_job(p, lds, j);
    constexpr int NT = 36, TOTAL = 64 * NT;
    const bf16_t* wt = (const bf16_t*)(p.ws + OFF_WIN_T);
    const bf16_t* xb = (const bf16_t*)(p.ws + OFF_XB);
    const float hs0[2][3] = {{1.f, 1.f, 1.f}, {1.f, 1.f, 1.f}};
    for (int id = blockIdx.x; id < TOTAL; id += gridDim.x) {
        int mt, nt;
        { const int g = id / (16 * NT), rem = id % (16 * NT); nt = rem >> 4; mt = g * 16 + (rem & 15); }
        f32x16 acc[4][2];
        zero_acc<4>(acc);
        gemm_tile<4, false>(acc, wt + (size_t)nt * 256 * 1024, xb + (size_t)mt * 256 * 1024, lds, hs0);
        p1_epilogue(p, acc, mt, nt);
    }
}

DI void phase15(const Params& p, unsigned char* lds) {
    const int tid = threadIdx.x, col = tid;
    float w2[16];
#pragma unroll
    for (int j = 0; j < 16; ++j) w2[j] = p.gate_w2[j * 512 + col];
    const float bias = p.gate_b[col];
    unsigned char* ws = p.ws;
    unsigned char* dout = (unsigned char*)p.out;
    for (int item = blockIdx.x; item < 257; item += gridDim.x) {
        const bool meta = item == 256;
        const int b = item >> 6, c = item & 63;
        const size_t row0 = (size_t)b * 4096 + c * 64;
        const bf16_t* glr = meta ? (const bf16_t*)(ws + OFF_GLRM) : (const bf16_t*)(ws + OFF_GLR) + row0 * 16;
        const int nrows = meta ? 16 : 64;
        bf16_t* qp = (bf16_t*)(dout + DO_GQ) + row0 * 512 + col;
        const bf16_t* kin = meta ? (const bf16_t*)(ws + OFF_GKM) + col : (const bf16_t*)(dout + DO_GK) + row0 * 512 + col;
        bf16_t* kout = meta ? (bf16_t*)(ws + OFF_KTM) + 48 * 512 + col : (bf16_t*)(dout + DO_GK) + row0 * 512 + col;
        bf16_t* ktt = meta ? (bf16_t*)(ws + OFF_KTTM) + (size_t)col * 64 + 48 : (bf16_t*)(ws + OFF_WIN_T) + ((size_t)b * 512 + col) * 4096 + c * 64;
        __syncthreads();
        if (tid < nrows * 2) ((u32x4*)lds)[tid] = ((const u32x4*)glr)[tid];
        __syncthreads();
        float bsum = 0.f;
        bf16_t kc[8], qc[8], kn[8], qn[8];
#pragma unroll
        for (int rr = 0; rr < 8; ++rr) { kc[rr] = kin[(size_t)rr * 512]; qc[rr] = meta ? (bf16_t)0 : qp[(size_t)rr * 512]; }
        for (int r0 = 0; r0 < nrows; r0 += 8) {
            if (r0 + 8 < nrows) {
#pragma unroll
                for (int rr = 0; rr < 8; ++rr) { kn[rr] = kin[(size_t)(r0 + 8 + rr) * 512]; qn[rr] = meta ? (bf16_t)0 : qp[(size_t)(r0 + 8 + rr) * 512]; }
            }
            float kt8[8];
#pragma unroll
            for (int rr = 0; rr < 8; ++rr) {
                const int r = r0 + rr;
                const u32x4* g4 = (const u32x4*)(lds + r * 32);
                const u32x4 ga = g4[0], gb = g4[1];
                float gk = bias;
                gk += bflo(ga.x) * w2[0] + bfhi(ga.x) * w2[1] + bflo(ga.y) * w2[2] + bfhi(ga.y) * w2[3];
                gk += bflo(ga.z) * w2[4] + bfhi(ga.z) * w2[5] + bflo(ga.w) * w2[6] + bfhi(ga.w) * w2[7];
                gk += bflo(gb.x) * w2[8] + bfhi(gb.x) * w2[9] + bflo(gb.y) * w2[10] + bfhi(gb.y) * w2[11];
                gk += bflo(gb.z) * w2[12] + bfhi(gb.z) * w2[13] + bflo(gb.w) * w2[14] + bfhi(gb.w) * w2[15];
                const float lg = (fminf(gk, 0.f) - log1pf(expf(-fabsf(gk)))) * (1.0f / 16.0f);
                bsum += lg;
                const float kt = bf2f(kc[rr]) * expf(-bsum);
                kt8[rr] = kt;
                kout[(size_t)r * 512] = f2bf(kt);
                if (!meta) qp[(size_t)r * 512] = f2bf(bf2f(qc[rr]) * 0.08838834764831845f * expf(bsum));
            }
            u32x4 o; o.x = pk2(kt8[0], kt8[1]); o.y = pk2(kt8[2], kt8[3]); o.z = pk2(kt8[4], kt8[5]); o.w = pk2(kt8[6], kt8[7]);
            *(u32x4*)(ktt + r0) = o;
#pragma unroll
            for (int rr = 0; rr < 8; ++rr) { kc[rr] = kn[rr]; qc[rr] = qn[rr]; }
        }
        if (meta) {
            ((float*)(ws + OFF_DECM))[col] = expf(bsum);
            bf16_t* km = (bf16_t*)(ws + OFF_KTM);
            for (int r = 0; r < 48; ++r) km[r * 512 + col] = 0;
            u32x4 z = {0u, 0u, 0u, 0u};
            u32x4* kz = (u32x4*)((bf16_t*)(ws + OFF_KTTM) + (size_t)col * 64);
#pragma unroll
            for (int j = 0; j < 6; ++j) kz[j] = z;
        } else {
            ((float*)(ws + OFF_DEC))[((size_t)b * 64 + c) * 512 + col] = expf(bsum);
        }
    }
}

constexpr int A_KROWB = 272, A_VROWB = 136, A_KB = 64 * A_KROWB, A_VB = 128 * A_VROWB, A_STAGE = A_KB + A_VB;
DI void attn_tile(const unsigned char* sK, const unsigned char* sV, int tt, int qb, int qs, int sub, int l31, int h,
                  const bf16x8 (&qf)[4], f32x16 (&O)[4], float& m, float& l) {
    const float SC = 0.125f * 1.4426950408889634f;
    f32x16 st[2];
#pragma unroll
    for (int k2 = 0; k2 < 2; ++k2)
#pragma unroll
        for (int i = 0; i < 16; ++i) st[k2][i] = 0.f;
#pragma unroll
    for (int k2 = 0; k2 < 2; ++k2)
#pragma unroll
        for (int ks = 0; ks < 4; ++ks) {
            const bf16x8 kf = *(const bf16x8*)(sK + (k2 * 32 + l31) * A_KROWB + (sub * 64 + ks * 16 + 8 * h) * 2);
            st[k2] = MFMA32(kf, qf[ks], st[k2]);
        }
    if (tt == 0) {
#pragma unroll
        for (int i = 0; i < 16; ++i) { st[0][i] = -INFINITY; if (i < 8) st[1][i] = -INFINITY; }
    } else if (tt >= 2 * qb + 1) {
        const int kbase = (tt - 1) * 64 + 4 * h;
#pragma unroll
        for (int k2 = 0; k2 < 2; ++k2)
#pragma unroll
            for (int i = 0; i < 16; ++i) {
                const int key = kbase + k2 * 32 + (i & 3) + 8 * (i >> 2);
                if (key > qs) st[k2][i] = -INFINITY;
            }
    }
    float mx = -INFINITY;
#pragma unroll
    for (int k2 = 0; k2 < 2; ++k2)
#pragma unroll
        for (int i = 0; i < 16; ++i) mx = fmaxf(mx, st[k2][i]);
    mx = fmaxf(mx, __shfl_xor(mx, 32));
    const float mnew = fmaxf(m, mx);
    const float alpha = __builtin_amdgcn_exp2f((m - mnew) * SC);
    const float mc = mnew * SC;
    m = mnew;
    float ps = 0.f;
#pragma unroll
    for (int k2 = 0; k2 < 2; ++k2)
#pragma unroll
        for (int i = 0; i < 16; ++i) { const float pv = __builtin_amdgcn_exp2f(st[k2][i] * SC - mc); st[k2][i] = pv; ps += pv; }
    l = l * alpha + ps;
#pragma unroll
    for (int d = 0; d < 4; ++d)
#pragma unroll
        for (int i = 0; i < 16; ++i) O[d][i] *= alpha;
    bf16x8 pb[4];
#pragma unroll
    for (int k4 = 0; k4 < 4; ++k4) {
        const int k2 = k4 >> 1, o8 = 8 * (k4 & 1);
        u32x4 pk;
        pk.x = pk2(st[k2][o8 + 0], st[k2][o8 + 1]); pk.y = pk2(st[k2][o8 + 2], st[k2][o8 + 3]);
        pk.z = pk2(st[k2][o8 + 4], st[k2][o8 + 5]); pk.w = pk2(st[k2][o8 + 6], st[k2][o8 + 7]);
        pb[k4] = __builtin_bit_cast(bf16x8, pk);
    }
#pragma unroll
    for (int d = 0; d < 4; ++d)
#pragma unroll
        for (int k4 = 0; k4 < 4; ++k4) {
            const unsigned char* vp = sV + (d * 32 + l31) * A_VROWB + (k4 * 16 + 4 * h) * 2;
            const u32x2 lo = *(const u32x2*)vp, hi = *(const u32x2*)(vp + 16);
            u32x4 vv; vv.x = lo.x; vv.y = lo.y; vv.z = hi.x; vv.w = hi.y;
            O[d] = MFMA32(__builtin_bit_cast(bf16x8, vv), pb[k4], O[d]);
        }
}

DI void attn_item(const Params& p, unsigned char* lds, int b, int hd, int qb) {
    const int tid = threadIdx.x, lane = tid & 63, wave = tid >> 6, l31 = lane & 31, h = lane >> 5;
    const int sub = wave >> 2, rt = wave & 3;
    const bf16_t* aq = (const bf16_t*)((unsigned char*)p.out + DO_AQ);
    const bf16_t* ak = (const bf16_t*)(p.ws + OFF_AK);
    const bf16_t* avT = (const bf16_t*)(p.ws + OFF_AVT);
    const bf16_t* akm = (const bf16_t*)(p.ws + OFF_AKM);
    const bf16_t* avTm = (const bf16_t*)(p.ws + OFF_AVTM);
    bf16_t* az = (bf16_t*)(p.ws + OFF_AZ);
    const int qs = qb * 128 + rt * 32 + l31;
    const size_t grow = (size_t)b * 4096 + qs;
    bf16x8 qf[4];
#pragma unroll
    for (int ks = 0; ks < 4; ++ks) qf[ks] = *(const bf16x8*)(aq + grow * 1024 + hd * 128 + sub * 64 + ks * 16 + 8 * h);
    f32x16 O[4];
#pragma unroll
    for (int d = 0; d < 4; ++d)
#pragma unroll
        for (int i = 0; i < 16; ++i) O[d][i] = 0.f;
    float m = -INFINITY, l = 0.f;
    const int T = 2 * qb + 3;
    u32x4 k0r[2], v0r[2];
    const int krow_ = tid >> 4, kc_ = tid & 15, vdv_ = tid >> 3, vc_ = tid & 7;
    const bf16_t* kp = ak + ((size_t)b * 4096 + krow_) * 1024 + hd * 128 + kc_ * 8;
    const bf16_t* vp_ = avT + ((size_t)(b * 8 + hd) * 128 + vdv_) * 4096 + vc_ * 8;
#define A_LOAD_REAL(KR, VR)                                                                                                   \
    {                                                                                                                         \
        KR[0] = *(const u32x4*)kp; KR[1] = *(const u32x4*)(kp + 32 * 1024); kp += 64 * 1024;                                  \
        VR[0] = *(const u32x4*)vp_; VR[1] = *(const u32x4*)(vp_ + (size_t)64 * 4096); vp_ += 64;                              \
    }
#define A_STORE(KR, VR, buf_)                                                                                                 \
    {                                                                                                                         \
        unsigned char* sK_ = lds + (buf_) * A_STAGE; unsigned char* sV_ = sK_ + A_KB;                                         \
        _Pragma("unroll") for (int i = 0; i < 2; ++i) { const int pi = tid + 512 * i, row = pi >> 4, c = pi & 15;              \
            *(u32x4*)(sK_ + row * A_KROWB + c * 16) = KR[i]; }                                                                \
        _Pragma("unroll") for (int i = 0; i < 2; ++i) { const int pi = tid + 512 * i, dv = pi >> 3, c = pi & 7;                \
            unsigned char* d_ = sV_ + dv * A_VROWB + c * 16; u32x2 a_, b_; a_.x = VR[i].x; a_.y = VR[i].y; b_.x = VR[i].z; b_.y = VR[i].w; \
            *(u32x2*)d_ = a_; *(u32x2*)(d_ + 8) = b_; }                                                                       \
    }
    {
        const bf16_t* km_ = akm + (size_t)krow_ * 1024 + hd * 128 + kc_ * 8;
        k0r[0] = *(const u32x4*)km_; k0r[1] = *(const u32x4*)(km_ + 32 * 1024);
        const bf16_t* vm_ = avTm + (size_t)(hd * 128 + vdv_) * 64 + vc_ * 8;
        v0r[0] = *(const u32x4*)vm_; v0r[1] = *(const u32x4*)(vm_ + 64 * 64);
    }
    A_STORE(k0r, v0r, 0);
    __syncthreads();
    for (int tt = 0; tt < T; ++tt) {
        if (tt + 1 < T) A_LOAD_REAL(k0r, v0r);
        attn_tile(lds + (tt & 1) * A_STAGE, lds + (tt & 1) * A_STAGE + A_KB, tt, qb, qs, sub, l31, h, qf, O, m, l);
        if (tt + 1 < T) A_STORE(k0r, v0r, (tt + 1) & 1);
        __syncthreads();
    }
#undef A_LOAD_REAL
#undef A_STORE
    float lam;
    {
        const float a_ = wave_sum(p.lq1[lane] * p.lk1[lane]);
        const float b_ = wave_sum(p.lq2[lane] * p.lk2[lane]);
        lam = expf(a_) - expf(b_) + 0.2f;
    }
    const float ltot = l + __shfl_xor(l, 32);
    const float linv = 1.0f / ltot;
    float* ex = (float*)lds;
    if (sub == 1) {
#pragma unroll
        for (int d = 0; d < 4; ++d)
#pragma unroll
            for (int i = 0; i < 16; ++i) { ex[(rt * 32 + l31) * 129 + d * 32 + (i & 3) + 8 * (i >> 2) + 4 * h] = O[d][i] * linv; if (i == 15) __builtin_amdgcn_sched_barrier(0); }
    }
    __syncthreads();
    if (sub == 0) {
        float ss = 0.f;
#pragma unroll
        for (int d = 0; d < 4; ++d)
#pragma unroll
            for (int i = 0; i < 16; ++i) {
                const float o2 = ex[(rt * 32 + l31) * 129 + d * 32 + (i & 3) + 8 * (i >> 2) + 4 * h];
                const float o = O[d][i] * linv - lam * o2;
                O[d][i] = o; ss += o * o;
                if (i == 15) __builtin_amdgcn_sched_barrier(0);
            }
        ss += __shfl_xor(ss, 32);
        const float rstd = 1.0f / sqrtf(ss * (1.0f / 128.0f) + EPS);
#pragma unroll
        for (int d = 0; d < 4; ++d)
#pragma unroll
            for (int g = 0; g < 4; ++g) {
                bf16_t* zp = az + grow * 1024 + hd * 128 + d * 32 + 8 * g + 4 * h;
                const u32x2 zz = *(const u32x2*)zp;
                u32x2 o;
                o.x = pk2(O[d][4 * g] * rstd * siluf_(bflo(zz.x)), O[d][4 * g + 1] * rstd * siluf_(bfhi(zz.x)));
                o.y = pk2(O[d][4 * g + 2] * rstd * siluf_(bflo(zz.y)), O[d][4 * g + 3] * rstd * siluf_(bfhi(zz.y)));
                *(u32x2*)zp = o;
                if (g == 3) __builtin_amdgcn_sched_barrier(0);
            }
    }
    __syncthreads();
}

constexpr int L_KROWB = 272, L_VROWB = 144, L_SROWB = 272;
constexpr int L_K = 0, L_V = 64 * L_KROWB, L_S = L_V + 32 * L_VROWB, L_END = L_S + 32 * L_SROWB;
DI void gla_item(const Params& p, unsigned char* lds, int b, int hh, int sl) {
    const int tid = threadIdx.x, lane = tid & 63, wave = tid >> 6, l15 = lane & 15, g = lane >> 4;
    const int tt = wave & 3, dvt = wave >> 2;
    unsigned char* ws = p.ws;
    unsigned char* dout = (unsigned char*)p.out;
    const bf16_t* gq = (const bf16_t*)(dout + DO_GQ);
    const bf16_t* gk = (const bf16_t*)(dout + DO_GK);
    const bf16_t* gvT = (const bf16_t*)(ws + OFF_GVT);
    const bf16_t* ktt = (const bf16_t*)(ws + OFF_WIN_T);
    const float* dec = (const float*)(ws + OFF_DEC);
    bf16_t* gz = (bf16_t*)(ws + OFF_GZ);
    float* ssqb = (float*)(ws + OFF_SSQB);
    unsigned char* sK = lds + L_K; unsigned char* sV = lds + L_V; unsigned char* sS = lds + L_S;
    for (int i = tid; i < 32 * L_SROWB / 4; i += 512) ((unsigned*)sS)[i] = 0u;
    f32x4 sacc[2];
#pragma unroll
    for (int c = 0; c < 2; ++c) sacc[c] = (f32x4){0.f, 0.f, 0.f, 0.f};
    u32x4 nk[2]; u32x4 nv; bf16x8 nq[4]; bf16x8 nkt[2][2]; float nd[2]; u32x2 ngz;
    const int cc0 = 16 * (2 * tt) + l15;
    const int krow_ = tid >> 4, kc_ = tid & 15, vdv_ = (tid >> 3) & 31, vc_ = tid & 7;
    const bf16_t* kp = gk + ((size_t)b * 4096 + krow_) * 512 + hh * 128 + kc_ * 8;
    const bf16_t* vp_ = gvT + ((size_t)(b * 4 + hh) * 256 + sl * 32 + vdv_) * 4096 + vc_ * 8;
    const bf16_t* ktp = ktt + ((size_t)(b * 4 + hh) * 128 + cc0) * 4096 + 8 * g;
    const float* dp = dec + (size_t)b * 64 * 512 + hh * 128 + cc0;
    const bf16_t* qp = gq + ((size_t)b * 4096 + 16 * tt + l15) * 512 + hh * 128 + 8 * g;
    bf16_t* gzp = gz + ((size_t)b * 4096 + 16 * tt + l15) * 1024 + hh * 256 + sl * 32 + 16 * dvt + 4 * g;
#define L_LOAD_META()                                                                                                         \
    {                                                                                                                         \
        const bf16_t* km_ = (const bf16_t*)(ws + OFF_KTM) + (size_t)krow_ * 512 + hh * 128 + kc_ * 8;                         \
        nk[0] = *(const u32x4*)km_; nk[1] = *(const u32x4*)(km_ + 32 * 512);                                                  \
        nv = *(const u32x4*)((const bf16_t*)(ws + OFF_GVTM) + (size_t)(hh * 256 + sl * 32 + vdv_) * 64 + vc_ * 8);            \
        _Pragma("unroll") for (int ct = 0; ct < 2; ++ct) _Pragma("unroll") for (int ks = 0; ks < 2; ++ks)                     \
            nkt[ct][ks] = *(const bf16x8*)((const bf16_t*)(ws + OFF_KTTM) + (size_t)(hh * 128 + cc0 + 16 * ct) * 64 + 32 * ks + 8 * g); \
        _Pragma("unroll") for (int ct = 0; ct < 2; ++ct) nd[ct] = ((const float*)(ws + OFF_DECM))[hh * 128 + cc0 + 16 * ct];  \
        _Pragma("unroll") for (int ks = 0; ks < 4; ++ks) nq[ks] = (bf16x8){0, 0, 0, 0, 0, 0, 0, 0};                           \
        ngz = (u32x2){0u, 0u};                                                                                                \
    }
#define L_LOAD_REAL()                                                                                                         \
    {                                                                                                                         \
        nk[0] = *(const u32x4*)kp; nk[1] = *(const u32x4*)(kp + 32 * 512); kp += 64 * 512;                                    \
        nv = *(const u32x4*)vp_; vp_ += 64;                                                                                   \
        _Pragma("unroll") for (int ct = 0; ct < 2; ++ct) _Pragma("unroll") for (int ks = 0; ks < 2; ++ks)                     \
            nkt[ct][ks] = *(const bf16x8*)(ktp + (size_t)(16 * ct) * 4096 + 32 * ks);                                         \
        ktp += 64;                                                                                                            \
        nd[0] = dp[0]; nd[1] = dp[16]; dp += 512;                                                                             \
        _Pragma("unroll") for (int ks = 0; ks < 4; ++ks) nq[ks] = *(const bf16x8*)(qp + 32 * ks);                             \
        qp += 64 * 512;                                                                                                       \
        ngz = *(const u32x2*)gzp; gzp += 64 * 1024;                                                                           \
    }
#define L_STORE()                                                                                                             \
    {                                                                                                                         \
        _Pragma("unroll") for (int i = 0; i < 2; ++i) { const int pi = tid + 512 * i, row = pi >> 4, c = pi & 15;              \
            *(u32x4*)(sK + row * L_KROWB + c * 16) = nk[i]; }                                                                 \
        if (tid < 256) { const int dv = tid >> 3, c = tid & 7; *(u32x4*)(sV + dv * L_VROWB + c * 16) = nv; }                  \
    }
    L_LOAD_META();
    L_STORE();
    for (int n = 0; n <= 64; ++n) {
        bf16x8 cq[4], ckt[2][2]; float cd[2]; u32x2 cgz;
#pragma unroll
        for (int ks = 0; ks < 4; ++ks) cq[ks] = nq[ks];
#pragma unroll
        for (int ct = 0; ct < 2; ++ct) { cd[ct] = nd[ct]; ckt[ct][0] = nkt[ct][0]; ckt[ct][1] = nkt[ct][1]; }
        cgz = ngz;
        __syncthreads();
        if (n + 1 <= 64) L_LOAD_REAL();
        if (n > 0) {
            f32x4 at[4];
#pragma unroll
            for (int jt = 0; jt < 4; ++jt) at[jt] = (f32x4){0.f, 0.f, 0.f, 0.f};
#pragma unroll
            for (int jt = 0; jt < 4; ++jt)
#pragma unroll
                for (int ks = 0; ks < 4; ++ks) {
                    const bf16x8 kf = *(const bf16x8*)(sK + (jt * 16 + l15) * L_KROWB + (ks * 32 + 8 * g) * 2);
                    at[jt] = MFMA16(kf, cq[ks], at[jt]);
                }
            const int tl = 16 * tt + l15;
#pragma unroll
            for (int jt = 0; jt < 4; ++jt)
#pragma unroll
                for (int i = 0; i < 4; ++i) if (16 * jt + 4 * g + i > tl) at[jt][i] = 0.f;
            f32x4 o = (f32x4){0.f, 0.f, 0.f, 0.f};
#pragma unroll
            for (int s2 = 0; s2 < 2; ++s2) {
                u32x4 pa;
                pa.x = pk2(at[2 * s2][0], at[2 * s2][1]); pa.y = pk2(at[2 * s2][2], at[2 * s2][3]);
                pa.z = pk2(at[2 * s2 + 1][0], at[2 * s2 + 1][1]); pa.w = pk2(at[2 * s2 + 1][2], at[2 * s2 + 1][3]);
                const unsigned char* vp = sV + (dvt * 16 + l15) * L_VROWB + (32 * s2 + 4 * g) * 2;
                const u32x2 lo = *(const u32x2*)vp, hi = *(const u32x2*)(vp + 32);
                u32x4 vv; vv.x = lo.x; vv.y = lo.y; vv.z = hi.x; vv.w = hi.y;
                o = MFMA16(__builtin_bit_cast(bf16x8, vv), __builtin_bit_cast(bf16x8, pa), o);
            }
#pragma unroll
            for (int ks = 0; ks < 4; ++ks) {
                const bf16x8 sf = *(const bf16x8*)(sS + (dvt * 16 + l15) * L_SROWB + (ks * 32 + 8 * g) * 2);
                o = MFMA16(sf, cq[ks], o);
            }
            const size_t row = (size_t)b * 4096 + (n - 1) * 64 + 16 * tt + l15;
            float ss = (o[0] * o[0] + o[1] * o[1]) + (o[2] * o[2] + o[3] * o[3]);
            ss += __shfl_xor(ss, 16); ss += __shfl_xor(ss, 32);
            u32x2 ov;
            ov.x = pk2(o[0] * siluf_(bflo(cgz.x)), o[1] * siluf_(bfhi(cgz.x)));
            ov.y = pk2(o[2] * siluf_(bflo(cgz.y)), o[3] * siluf_(bfhi(cgz.y)));
            *(u32x2*)(gz + row * 1024 + hh * 256 + sl * 32 + 16 * dvt + 4 * g) = ov;
            if (g == 0) ssqb[(row * 4 + hh) * 16 + sl * 2 + dvt] = ss;
        }
#pragma unroll
        for (int ks = 0; ks < 2; ++ks) {
            const bf16x8 vf = *(const bf16x8*)(sV + (dvt * 16 + l15) * L_VROWB + (32 * ks + 8 * g) * 2);
            sacc[0] = MFMA16(vf, ckt[0][ks], sacc[0]);
            sacc[1] = MFMA16(vf, ckt[1][ks], sacc[1]);
        }
#pragma unroll
        for (int ct = 0; ct < 2; ++ct)
#pragma unroll
            for (int i = 0; i < 4; ++i) sacc[ct][i] *= cd[ct];
        __syncthreads();
#pragma unroll
        for (int ct = 0; ct < 2; ++ct)
#pragma unroll
            for (int i = 0; i < 4; ++i)
                *(bf16_t*)(sS + (16 * dvt + 4 * g + i) * L_SROWB + (cc0 + 16 * ct) * 2) = f2bf(sacc[ct][i]);
        if (n + 1 <= 64) L_STORE();
    }
#undef L_LOAD_META
#undef L_LOAD_REAL
#undef L_STORE
    __syncthreads();
}

DI void phase2(const Params& p, unsigned char* lds) {
    const int tid = threadIdx.x, lane = tid & 63;
    unsigned* ctr = (unsigned*)(p.ws + OFF_CTR);
    volatile unsigned* sItem = (volatile unsigned*)(lds + LDS_ITEM);
    constexpr unsigned N_GLA = 128, N_ATT = 1024;
    for (;;) {
        if (tid == 0) *sItem = atomicAdd(ctr, 1u);
        __syncthreads();
        const unsigned item = *sItem;
        __syncthreads();
        if (item >= N_GLA + N_ATT) break;
        if (item < N_GLA) gla_item(p, lds, item >> 5, (item >> 3) & 3, item & 7);
        else { const unsigned a = item - N_GLA; attn_item(p, lds, a & 3, (a >> 2) & 7, 31 - (int)(a >> 5)); }
    }
}

DI void phase3(const Params& p, unsigned char* lds) {
    const int tid = threadIdx.x, lane = tid & 63, wave = tid >> 6, l31 = lane & 31, h = lane >> 5;
    const int wn = wave & 1, wm = wave >> 1;
    unsigned char* ws = p.ws;
    const float* ssqb = (const float*)(ws + OFF_SSQB);
    float* sc = (float*)(lds + LDS_SCALE);
    const unsigned char* sga = ws + OFF_SGA;
    const unsigned char* sgb = ws + OFF_SGB;
    bf16_t* merged = (bf16_t*)(ws + OFF_AK);
    for (int id = blockIdx.x; id < 512; id += gridDim.x) {
        const int mt = id >> 3, nt = id & 7;
#pragma unroll
        for (int i = 0; i < 2; ++i) {
            const int e = tid + 512 * i, row = e >> 2, hh = e & 3;
            const f32x4* sp = (const f32x4*)(ssqb + (((size_t)mt * 256 + row) * 4 + hh) * 16);
            const f32x4 a = sp[0], b2 = sp[1], c = sp[2], d = sp[3];
            const float s = ((a.x + a.y) + (a.z + a.w)) + ((b2.x + b2.y) + (b2.z + b2.w)) + ((c.x + c.y) + (c.z + c.w)) + ((d.x + d.y) + (d.z + d.w));
            sc[e] = 1.0f / sqrtf(s * (1.0f / 256.0f) + EPS);
        }
        __syncthreads();
        float hs[2][3], rl[2];
#pragma unroll
        for (int im = 0; im < 2; ++im) {
            const int lr = wm * 64 + im * 32 + l31;
            const f32x4 r = *(const f32x4*)(sc + lr * 4);
            hs[im][0] = r.x / r.y; hs[im][1] = r.y / r.z; hs[im][2] = r.z / r.w; rl[im] = r.w;
        }
        f32x16 acc[2][2];
        unsigned mb[2][2][8];
        zero_acc<2>(acc);
        gemm_tile<2, true>(acc, (const bf16_t*)(ws + OFF_WB_T) + (size_t)nt * 128 * 1024, (const bf16_t*)(ws + OFF_GZ) + (size_t)mt * 256 * 1024, lds, hs);
#pragma unroll
        for (int im = 0; im < 2; ++im) {
            const size_t tok = (size_t)mt * 256 + wm * 64 + im * 32 + l31;
#pragma unroll
            for (int in = 0; in < 2; ++in)
#pragma unroll
                for (int g = 0; g < 4; ++g) {
                    const size_t off = tok * 1024 + nt * 128 + wn * 64 + in * 32 + 8 * g + 4 * h;
                    const unsigned ub = *(const unsigned*)(sgb + off);
                    const float q = rl[im] * (1.0f / 255.0f);
                    mb[in][im][2 * g] = pk2((float)(ub & 255u) * q * acc[in][im][4 * g + 0], (float)((ub >> 8) & 255u) * q * acc[in][im][4 * g + 1]);
                    mb[in][im][2 * g + 1] = pk2((float)((ub >> 16) & 255u) * q * acc[in][im][4 * g + 2], (float)(ub >> 24) * q * acc[in][im][4 * g + 3]);
                }
        }
        zero_acc<2>(acc);
        gemm_tile<2, false>(acc, (const bf16_t*)(ws + OFF_WA_T) + (size_t)nt * 128 * 1024, (const bf16_t*)(ws + OFF_AZ) + (size_t)mt * 256 * 1024, lds, hs);
#pragma unroll
        for (int im = 0; im < 2; ++im) {
            const size_t tok = (size_t)mt * 256 + wm * 64 + im * 32 + l31;
#pragma unroll
            for (int in = 0; in < 2; ++in)
#pragma unroll
                for (int g = 0; g < 4; ++g) {
                    const size_t off = tok * 1024 + nt * 128 + wn * 64 + in * 32 + 8 * g + 4 * h;
                    const unsigned ua = *(const unsigned*)(sga + off);
                    const unsigned b0 = mb[in][im][2 * g], b1 = mb[in][im][2 * g + 1];
                    const float q = 1.0f / 255.0f;
                    const float m0 = (float)(ua & 255u) * q * acc[in][im][4 * g + 0] + bflo(b0);
                    const float m1 = (float)((ua >> 8) & 255u) * q * acc[in][im][4 * g + 1] + bfhi(b0);
                    const float m2 = (float)((ua >> 16) & 255u) * q * acc[in][im][4 * g + 2] + bflo(b1);
                    const float m3 = (float)(ua >> 24) * q * acc[in][im][4 * g + 3] + bfhi(b1);
                    u32x2 o; o.x = pk2(m0, m1); o.y = pk2(m2, m3);
                    *(u32x2*)(merged + off) = o;
                }
        }
        __syncthreads();
    }
}

DI void phase4(const Params& p, unsigned char* lds) {
    const int tid = threadIdx.x, lane = tid & 63, wave = tid >> 6, l31 = lane & 31, h = lane >> 5;
    const int wn = wave & 1, wm = wave >> 1;
    unsigned char* ws = p.ws;
    float* ssqh = (float*)(ws + OFF_SSQH);
    for (int id = blockIdx.x; id < 512; id += gridDim.x) {
        const int mt = id >> 3, nt = id & 7;
        f32x16 acc[2][2];
        zero_acc<2>(acc);
        const float hs0[2][3] = {{1.f, 1.f, 1.f}, {1.f, 1.f, 1.f}};
        gemm_tile<2, false>(acc, (const bf16_t*)(ws + OFF_WO_T) + (size_t)nt * 128 * 1024, (const bf16_t*)(ws + OFF_AK) + (size_t)mt * 256 * 1024, lds, hs0);
#pragma unroll
        for (int im = 0; im < 2; ++im) {
            const size_t tok = (size_t)mt * 256 + wm * 64 + im * 32 + l31;
            float ss = 0.f;
#pragma unroll
            for (int in = 0; in < 2; ++in)
#pragma unroll
                for (int g = 0; g < 4; ++g) {
                    const size_t off = tok * 1024 + nt * 128 + wn * 64 + in * 32 + 8 * g + 4 * h;
                    const f32x4 xv = *(const f32x4*)(p.x + off);
                    f32x4 o;
                    o.x = xv.x + acc[in][im][4 * g + 0]; o.y = xv.y + acc[in][im][4 * g + 1];
                    o.z = xv.z + acc[in][im][4 * g + 2]; o.w = xv.w + acc[in][im][4 * g + 3];
                    ss += (o.x * o.x + o.y * o.y) + (o.z * o.z + o.w * o.w);
                    *(f32x4*)(p.out + off) = o;
                }
            ss += __shfl_xor(ss, 32);
            if (h == 0) ssqh[tok * 16 + nt * 2 + wn] = ss;
        }
    }
}

DI void phase5(const Params& p, unsigned char* lds) {
    const int tid = threadIdx.x, lane = tid & 63, wave = tid >> 6;
    const float* ssqh = (const float*)(p.ws + OFF_SSQH);
    for (int it = blockIdx.x; it < MROWS / 8; it += gridDim.x) {
        const size_t row = (size_t)it * 8 + wave;
        float s = lane < 16 ? ssqh[row * 16 + lane] : 0.f;
        s = wave_sum(s);
        const float rstd = 1.0f / sqrtf(s * (1.0f / 1024.0f) + EPS);
        f32x4* orow = (f32x4*)(p.out + row * 1024) + lane;
        const f32x4* wrow = (const f32x4*)p.final_w + lane;
#pragma unroll
        for (int j = 0; j < 4; ++j) {
            f32x4 v = orow[64 * j]; const f32x4 w = wrow[64 * j];
            v.x = v.x * rstd * w.x; v.y = v.y * rstd * w.y; v.z = v.z * rstd * w.z; v.w = v.w * rstd * w.w;
            orow[64 * j] = v;
        }
    }
}

#define XB_TMO      128
#define XB_XCNT(j)  (256  + 64 * (j))
#define XB_XSUB(j)  (1280 + 64 * (j))
#define XB_XGEN(j)  (2304 + 64 * (j))
#define XB_TOP      3328
#define XB_TOPGEN   3392
#define XCD_BAR_WORDS 3456
#define XB_SPIN_CAP (1u << 18)
#define LAS __attribute__((address_space(3)))
DI unsigned xb_ld(unsigned* p)              { return __hip_atomic_load(p, __ATOMIC_RELAXED, __HIP_MEMORY_SCOPE_AGENT); }
DI unsigned xb_add(unsigned* p, unsigned v) { return __hip_atomic_fetch_add(p, v, __ATOMIC_RELAXED, __HIP_MEMORY_SCOPE_AGENT); }
DI unsigned xb_xcc_id() { return (unsigned)__builtin_amdgcn_s_getreg((3 << 11) | 20) & 0xFu; }
#define XB_SPIN(cond, bar) do { unsigned _sp = 0; while (cond) { __builtin_amdgcn_s_sleep(1); \
    if ((++_sp & 255u) == 0u) { if (xb_ld(&(bar)[XB_TMO])) break; if (_sp > XB_SPIN_CAP) { atomicAdd(&(bar)[XB_TMO], 1u); break; } } } } while (0)
struct XcdBarrier { unsigned* bar; unsigned x; volatile LAS unsigned* st; };
DI XcdBarrier xcd_barrier_post(unsigned* bar, volatile LAS unsigned* st) {
    XcdBarrier b; b.bar = bar; b.x = xb_xcc_id(); b.st = st;
    if (threadIdx.x == 0) (void)xb_add(&bar[XB_XCNT(b.x)], 1u);
    return b;
}
DI void xcd_barrier_complete(unsigned* bar, unsigned x, unsigned& nloc, unsigned& nx) {
    const unsigned G = gridDim.x * gridDim.y * gridDim.z;
    unsigned sum, cnt, mine, sp = 0u;
    for (;;) {
        sum = 0u; cnt = 0u; mine = 0u;
#pragma unroll
        for (unsigned j = 0; j < 16; ++j) { const unsigned c = xb_ld(&bar[XB_XCNT(j)]); sum += c; cnt += (c > 0u) ? 1u : 0u; mine = (j == x) ? c : mine; }
        if (sum == G) break;
        __builtin_amdgcn_s_sleep(1);
        if ((++sp & 255u) == 0u) { if (xb_ld(&bar[XB_TMO])) break; if (sp > XB_SPIN_CAP) { atomicAdd(&bar[XB_TMO], 1u); break; } }
    }
    nloc = mine > 0u ? mine : 1u; nx = cnt > 0u ? cnt : 1u;
}
DI void xcd_barrier(const XcdBarrier& b) {
    asm volatile("s_waitcnt vmcnt(0)" ::: "memory");
    __syncthreads();
    if (threadIdx.x == 0) {
        unsigned* bar = b.bar;
        __builtin_amdgcn_s_waitcnt(0);
        unsigned nloc = b.st[0], nx = b.st[1];
        if (nloc == 0u) { xcd_barrier_complete(bar, b.x, nloc, nx); b.st[0] = nloc; b.st[1] = nx; }
        const unsigned old = xb_add(&bar[XB_XSUB(b.x)], 1u);
        const unsigned gen = old / nloc;
        if (old + 1u == (gen + 1u) * nloc) {
            __builtin_amdgcn_fence(__ATOMIC_RELEASE, "agent");
            asm volatile("s_waitcnt vmcnt(0)" ::: "memory");
            const unsigned og = xb_add(&bar[XB_TOP], 1u);
            const unsigned tg = og / nx;
            if (og + 1u == (tg + 1u) * nx) xb_add(&bar[XB_TOPGEN], 1u);
            else XB_SPIN(xb_ld(&bar[XB_TOPGEN]) == tg, bar);
            __builtin_amdgcn_fence(__ATOMIC_ACQUIRE, "agent");
            xb_add(&bar[XB_XGEN(b.x)], 1u);
            asm volatile("s_waitcnt vmcnt(0)" ::: "memory");
        } else {
            XB_SPIN(xb_ld(&bar[XB_XGEN(b.x)]) == gen, bar);
            __builtin_amdgcn_fence(__ATOMIC_ACQUIRE, "agent");
            asm volatile("s_waitcnt vmcnt(0)" ::: "memory");
        }
    }
    __syncthreads();
}

DI void run_phase(const Params& p, unsigned char* lds, int ph) {
    switch (ph) {
        case 0: phase0(p, lds); break;
        case 1: phase1(p, lds); break;
        case 2: phase15(p, lds); break;
        case 3: phase2(p, lds); break;
        case 4: phase3(p, lds); break;
        case 5: phase4(p, lds); break;
        default: phase5(p, lds); break;
    }
}

__global__ void __launch_bounds__(512) hybrid_fwd(Params p) {
    extern __shared__ __attribute__((aligned(16))) unsigned char lds[];
#if MULTI_LAUNCH
    run_phase(p, lds, p.phase_lo);
#else
    cg::grid_group grid = cg::this_grid();
    if (p.phase_lo == 77) grid.sync();
    volatile LAS unsigned* st = (volatile LAS unsigned*)(lds + LDS_ITEM + 16);
    if (threadIdx.x == 0) { st[0] = 0u; st[1] = 0u; }
    __syncthreads();
    XcdBarrier xb = xcd_barrier_post((unsigned*)(p.ws + OFF_XBAR), st);
    phase0(p, lds); xcd_barrier(xb);
    phase1(p, lds); xcd_barrier(xb);
    phase15(p, lds); xcd_barrier(xb);
    phase2(p, lds); xcd_barrier(xb);
    phase3(p, lds); xcd_barrier(xb);
    phase4(p, lds); xcd_barrier(xb);
    phase5(p, lds);
#endif
}

extern "C" void kernel_launch(void* const* d_in, const int* in_sizes, int n_in, void* d_out, int out_size, void* d_ws, size_t ws_size, hipStream_t stream) {
    static int grid = 0;
    if (grid == 0) {
        int dev = 0, cus = 0, per_cu = 0;
        hipGetDevice(&dev);
        hipDeviceGetAttribute(&cus, hipDeviceAttributeMultiprocessorCount, dev);
        hipFuncSetAttribute((const void*)hybrid_fwd, hipFuncAttributeMaxDynamicSharedMemorySize, LDS_BYTES);
        hipOccupancyMaxActiveBlocksPerMultiprocessor(&per_cu, (const void*)hybrid_fwd, 512, LDS_BYTES);
        if (per_cu < 1) per_cu = 1;
        if (per_cu > 1) per_cu = 1;
        if (cus <= 0) cus = 256;
        grid = cus * per_cu;
    }
    hipMemsetAsync((unsigned char*)d_ws + OFF_CTR, 0, 256, stream);
    hipMemsetAsync((unsigned char*)d_ws + OFF_XBAR, 0, 16384, stream);
    Params p{};
    p.x = (const float*)d_in[0]; p.meta = (const float*)d_in[1]; p.norm_w = (const float*)d_in[2]; p.w_in = (const float*)d_in[3];
    p.lq1 = (const float*)d_in[4]; p.lk1 = (const float*)d_in[5]; p.lq2 = (const float*)d_in[6]; p.lk2 = (const float*)d_in[7];
    p.subln_w = (const float*)d_in[8]; p.gate_w2 = (const float*)d_in[9]; p.gate_b = (const float*)d_in[10]; p.gla_norm_w = (const float*)d_in[11];
    p.wa = (const float*)d_in[12]; p.wb = (const float*)d_in[13]; p.wo = (const float*)d_in[14]; p.final_w = (const float*)d_in[15];
    p.out = (float*)d_out; p.ws = (unsigned char*)d_ws;
#if MULTI_LAUNCH
    for (int ph = 0; ph < 7; ++ph) {
        p.phase_lo = ph; p.phase_hi = ph + 1;
        hipLaunchKernelGGL(hybrid_fwd, dim3(grid), dim3(512), LDS_BYTES, stream, p);
    }
#else
    p.phase_lo = 0; p.phase_hi = 7;
    void* args[] = {&p};
    hipError_t e = hipLaunchCooperativeKernel((const void*)hybrid_fwd, dim3(grid), dim3(512), args, LDS_BYTES, stream);
    if (e != hipSuccess) fprintf(stderr, "cooperative launch failed: %s (grid %d)\n", hipGetErrorString(e), grid);
#endif
}
```

```cpp
#include <hip/hip_runtime.h>
#include <hip/hip_cooperative_groups.h>
#include <cstdio>
#include <cstdint>
namespace cg = cooperative_groups;

#ifndef MULTI_LAUNCH
#define MULTI_LAUNCH 0
#endif
#ifndef PROBE_REP
#define PROBE_REP 0
#endif

typedef unsigned short bf16_t;
typedef short bf16x8 __attribute__((ext_vector_type(8)));
typedef float f32x4 __attribute__((ext_vector_type(4)));
typedef float f32x2 __attribute__((ext_vector_type(2)));
typedef float f32x16 __attribute__((ext_vector_type(16)));
typedef unsigned u32x4 __attribute__((ext_vector_type(4)));
typedef unsigned u32x2 __attribute__((ext_vector_type(2)));
typedef __bf16 bfv2 __attribute__((ext_vector_type(2)));

#define DI __device__ __forceinline__
#define MFMA32(a, b, c) __builtin_amdgcn_mfma_f32_32x32x16_bf16((a), (b), (c), 0, 0, 0)
#define MFMA16(a, b, c) __builtin_amdgcn_mfma_f32_16x16x32_bf16((a), (b), (c), 0, 0, 0)

DI unsigned pk2(float a, float b) { f32x2 v = {a, b}; return __builtin_bit_cast(unsigned, __builtin_convertvector(v, bfv2)); }
DI float bf2f(bf16_t v) { return __uint_as_float(((unsigned)v) << 16); }
DI float bflo(unsigned u) { return __uint_as_float(u << 16); }
DI float bfhi(unsigned u) { return __uint_as_float(u & 0xffff0000u); }
DI bf16_t f2bf(float a) { return (bf16_t)(pk2(a, 0.f) & 0xffffu); }
DI float wave_sum(float v) {
#pragma unroll
    for (int o = 32; o; o >>= 1) v += __shfl_xor(v, o);
    return v;
}
DI float sigmoidf_(float z) { return 1.f / (1.f + __expf(-z)); }
DI float siluf_(float z) { return z / (1.f + __expf(-z)); }

constexpr int D = 1024, NB = 4, SEQ = 4096, MROWS = NB * SEQ;
constexpr int NIN = 9232, NINP = 9344;
constexpr float EPS = 1e-5f;

constexpr size_t SZ_ACT = (size_t)MROWS * 1024 * 2;
constexpr size_t OFF_WIN_T = 0;
constexpr size_t OFF_WA_T = OFF_WIN_T + (size_t)NINP * 1024 * 2;
constexpr size_t OFF_WB_T = OFF_WA_T + 2097152;
constexpr size_t OFF_WO_T = OFF_WB_T + 2097152;
constexpr size_t OFF_AK = OFF_WO_T + 2097152;
constexpr size_t OFF_AVT = OFF_AK + SZ_ACT;
constexpr size_t OFF_AZ = OFF_AVT + SZ_ACT;
constexpr size_t OFF_GVT = OFF_AZ + SZ_ACT;
constexpr size_t OFF_GZ = OFF_GVT + SZ_ACT;
constexpr size_t OFF_GA = OFF_GZ + SZ_ACT;
constexpr size_t OFF_GB = OFF_GA + SZ_ACT;
constexpr size_t OFF_GLR = OFF_GB + SZ_ACT;
constexpr size_t OFF_RSTD = OFF_GLR + (size_t)MROWS * 16 * 2;
constexpr size_t OFF_ROPE = OFF_RSTD + 65792;
constexpr size_t OFF_AKM = OFF_ROPE + 263168;
constexpr size_t OFF_AVTM = OFF_AKM + 131072;
constexpr size_t OFF_GVTM = OFF_AVTM + 131072;
constexpr size_t OFF_GKM = OFF_GVTM + 131072;
constexpr size_t OFF_GLRM = OFF_GKM + 16384;
constexpr size_t OFF_KTM = OFF_GLRM + 512;
constexpr size_t OFF_KTTM = OFF_KTM + 65536;
constexpr size_t OFF_DEC = OFF_KTTM + 65536;
constexpr size_t OFF_DECM = OFF_DEC + 524288;
constexpr size_t OFF_SSQB = OFF_DECM + 2048;
constexpr size_t OFF_SSQH = OFF_SSQB + 4194304;
constexpr size_t OFF_CTR = OFF_SSQH + 1048576;
constexpr size_t OFF_XBM = OFF_CTR + 256;
constexpr size_t OFF_XBAR = OFF_XBM + 32768;
constexpr size_t WS_END = OFF_XBAR + 16384;
constexpr size_t OFF_XB = OFF_GA;
constexpr size_t OFF_SGA = OFF_GB;
constexpr size_t OFF_SGB = OFF_GB + (size_t)MROWS * 1024;
static_assert(WS_END <= 268435456ull, "workspace over 256 MiB");
constexpr size_t DO_AQ = 0, DO_GQ = SZ_ACT, DO_GK = SZ_ACT + SZ_ACT / 2;

constexpr int G_ROWB = 144;
constexpr int G_SW = 128 * G_ROWB, G_SX = 256 * G_ROWB, G_STAGE = G_SW + G_SX;
constexpr int G_SW4 = 256 * G_ROWB, G_STAGE4 = G_SW4 + G_SX;
constexpr int LDS_SCALE = 2 * G_STAGE4;
constexpr int LDS_ITEM = LDS_SCALE + 4096;
constexpr int LDS_BYTES = LDS_ITEM + 64;

struct Params {
    const float *x, *meta, *norm_w, *w_in, *lq1, *lk1, *lq2, *lk2, *subln_w, *gate_w2, *gate_b, *gla_norm_w, *wa, *wb, *wo, *final_w;
    float* out;
    unsigned char* ws;
    int phase_lo, phase_hi;
};

template <int MODE>
DI void p0_transpose_item(const Params& p, int item, float* tile) {
    const int tid = threadIdx.x;
    const float* W = MODE == 0 ? p.w_in : MODE == 1 ? p.wa : MODE == 2 ? p.wb : p.wo;
    const int ldw = MODE == 0 ? NIN : 1024;
    const int nbc = MODE == 0 ? NINP / 64 : 16;
    bf16_t* WT = (bf16_t*)(p.ws + (MODE == 0 ? OFF_WIN_T : MODE == 1 ? OFF_WA_T : MODE == 2 ? OFF_WB_T : OFF_WO_T));
    const int kb = item / nbc, nb = item % nbc, k0 = kb * 64, n0 = nb * 64;
#pragma unroll
    for (int i = 0; i < 8; ++i) {
        const int kk = (tid >> 6) + 8 * i, nn = tid & 63, n = n0 + nn, k = k0 + kk;
        int src = n;
        if (MODE == 0) { src = n < 7168 ? n : (n < 9216 ? n + 16 : (n < 9232 ? n - 2048 : -1)); }
        float sc = 1.f;
        if (MODE == 0) sc = p.norm_w[k];
        if (MODE == 1) sc = 0.8f * p.subln_w[k & 127];
        if (MODE == 2) sc = p.gla_norm_w[k & 255];
        float v = 0.f;
        if (src >= 0) v = W[(size_t)k * ldw + src] * sc;
        tile[kk * 65 + nn] = v;
    }
    __syncthreads();
    {
        const int nn = tid >> 3, c = tid & 7;
        const float* s = tile + (8 * c) * 65 + nn;
        u32x4 o;
        o.x = pk2(s[0 * 65], s[1 * 65]); o.y = pk2(s[2 * 65], s[3 * 65]); o.z = pk2(s[4 * 65], s[5 * 65]); o.w = pk2(s[6 * 65], s[7 * 65]);
        *(u32x4*)(WT + (size_t)(n0 + nn) * 1024 + k0 + 8 * c) = o;
    }
    __syncthreads();
}

DI void phase0(const Params& p, unsigned char* lds) {
    const int tid = threadIdx.x, lane = tid & 63, wave = tid >> 6;
    float* tile = (float*)lds;
    constexpr int I_WIN = 16 * (NINP / 64), I_SQ = 256;
    constexpr int I_T = I_WIN + 3 * I_SQ;
    constexpr int I_RSTD = (MROWS + 16 + 7) / 8;
    constexpr int I_ROPE = (4112 * 8 + 511) / 512;
    constexpr int I_ZERO = 393216 / 8192;
    constexpr int I_ALL = I_T + I_RSTD + I_ROPE + I_ZERO;
    for (int it = blockIdx.x; it < I_ALL; it += gridDim.x) {
        int r = it;
        if (r < I_WIN) { p0_transpose_item<0>(p, r, tile); continue; } r -= I_WIN;
        if (r < I_SQ) { p0_transpose_item<1>(p, r, tile); continue; } r -= I_SQ;
        if (r < I_SQ) { p0_transpose_item<2>(p, r, tile); continue; } r -= I_SQ;
        if (r < I_SQ) { p0_transpose_item<3>(p, r, tile); continue; } r -= I_SQ;
        if (r < I_RSTD) {
            const int row = r * 8 + wave;
            if (row < MROWS + 16) {
                const float* src = row < MROWS ? p.x + (size_t)row * 1024 : p.meta + (size_t)(row - MROWS) * 1024;
                const f32x4* xr = (const f32x4*)src + lane;
                float s = 0.f;
#pragma unroll
                for (int j = 0; j < 4; ++j) { const f32x4 v = xr[64 * j]; s += (v.x * v.x + v.y * v.y) + (v.z * v.z + v.w * v.w); }
                s = wave_sum(s);
                if (lane == 0) ((float*)(p.ws + OFF_RSTD))[row] = 1.0f / sqrtf(s * (1.0f / 1024.0f) + EPS);
                bf16_t* xbrow = row < MROWS ? (bf16_t*)(p.ws + OFF_XB) + (size_t)row * 1024 : (bf16_t*)(p.ws + OFF_XBM) + (size_t)(row - MROWS) * 1024;
#pragma unroll
                for (int j = 0; j < 4; ++j) { const f32x4 v = xr[64 * j]; u32x2 o; o.x = pk2(v.x, v.y); o.y = pk2(v.z, v.w); *(u32x2*)(xbrow + 256 * j + 4 * lane) = o; }
            }
            continue;
        }
        r -= I_RSTD;
        if (r < I_ROPE) {
            const int e = r * 512 + tid;
            if (e < 4112 * 8) {
                const int pos = e >> 3, i = e & 7;
                const float inv = powf(500000.0f, -(float)i / 8.0f);
                const float ang = (float)pos * inv;
                float* t = (float*)(p.ws + OFF_ROPE) + (size_t)e * 2;
                t[0] = cosf(ang); t[1] = sinf(ang);
            }
            continue;
        }
        r -= I_ROPE;
        { u32x4 z = {0u, 0u, 0u, 0u}; *(u32x4*)(p.ws + OFF_AKM + (size_t)r * 8192 + tid * 16) = z; }
    }
}

template <int NI, bool HS>
DI void gemm_tile(f32x16 (&acc)[NI][2], const bf16_t* __restrict__ Wt, const bf16_t* __restrict__ X, unsigned char* lds, const float (&hs)[2][3]) {
    const int tid = threadIdx.x, lane = tid & 63, wave = tid >> 6, l31 = lane & 31, h = lane >> 5;
    const int wn = wave & 1, wm = wave >> 1;
    constexpr int SW = NI * 64 * G_ROWB, STAGE = SW + G_SX;
    u32x4 wreg[NI];
    u32x4 xreg[4];
    const int prow = tid >> 3, pc = tid & 7;
    const bf16_t* wp = Wt + (size_t)prow * 1024 + pc * 8;
    const bf16_t* xp = X + (size_t)prow * 1024 + pc * 8;
#define G_LOAD(kt_)                                                                                                  \
    {                                                                                                                \
        _Pragma("unroll") for (int i = 0; i < NI; ++i) wreg[i] = *(const u32x4*)(wp + (size_t)i * 64 * 1024 + (kt_) * 64); \
        _Pragma("unroll") for (int i = 0; i < 4; ++i) xreg[i] = *(const u32x4*)(xp + (size_t)i * 64 * 1024 + (kt_) * 64);  \
    }
#define G_STORE(buf_)                                                                                                \
    {                                                                                                                \
        unsigned char* sW_ = lds + (buf_) * STAGE + prow * G_ROWB + pc * 16; unsigned char* sX_ = sW_ + SW;          \
        _Pragma("unroll") for (int i = 0; i < NI; ++i) *(u32x4*)(sW_ + i * 64 * G_ROWB) = wreg[i];                   \
        _Pragma("unroll") for (int i = 0; i < 4; ++i) *(u32x4*)(sX_ + i * 64 * G_ROWB) = xreg[i];                    \
    }
    G_LOAD(0);
    G_STORE(0);
    __syncthreads();
    for (int kt = 0; kt < 16; ++kt) {
        if (kt + 1 < 16) G_LOAD(kt + 1);
        if (HS) {
            if (kt == 4 || kt == 8 || kt == 12) {
                const float s0 = kt == 4 ? hs[0][0] : (kt == 8 ? hs[0][1] : hs[0][2]);
                const float s1 = kt == 4 ? hs[1][0] : (kt == 8 ? hs[1][1] : hs[1][2]);
#pragma unroll
                for (int n = 0; n < NI; ++n)
#pragma unroll
                    for (int i = 0; i < 16; ++i) { acc[n][0][i] *= s0; acc[n][1][i] *= s1; }
            }
        }
        {
            const unsigned char* sW = lds + (kt & 1) * STAGE + (wn * NI * 32 + l31) * G_ROWB + h * 16;
            const unsigned char* sX = lds + (kt & 1) * STAGE + SW + (wm * 64 + l31) * G_ROWB + h * 16;
#pragma unroll
            for (int ks = 0; ks < 4; ++ks) {
                const bf16x8 x0 = *(const bf16x8*)(sX + ks * 32), x1 = *(const bf16x8*)(sX + 32 * G_ROWB + ks * 32);
#pragma unroll
                for (int n = 0; n < NI; ++n) {
                    const bf16x8 w = *(const bf16x8*)(sW + n * 32 * G_ROWB + ks * 32);
                    acc[n][0] = MFMA32(w, x0, acc[n][0]); acc[n][1] = MFMA32(w, x1, acc[n][1]);
                }
            }
        }
        if (kt + 1 < 16) G_STORE((kt + 1) & 1);
        __syncthreads();
    }
#undef G_LOAD
#undef G_STORE
}

template <int NI>
DI void zero_acc(f32x16 (&acc)[NI][2]) {
#pragma unroll
    for (int a = 0; a < NI; ++a)
#pragma unroll
        for (int b = 0; b < 2; ++b)
#pragma unroll
            for (int i = 0; i < 16; ++i) acc[a][b][i] = 0.f;
}

DI unsigned sig_u8(float z) { return (unsigned)(255.0f / (1.0f + __expf(-z)) + 0.5f); }
DI void p1_epilogue(const Params& p, f32x16 (&acc)[4][2], int mt, int nt) {
    const int tid = threadIdx.x, lane = tid & 63, wave = tid >> 6, l31 = lane & 31, h = lane >> 5;
    const int wn = wave & 1, wm = wave >> 1;
    int split, nc0;
    if (nt < 4) { split = 0; nc0 = nt * 256; }
    else if (nt < 8) { split = 1; nc0 = (nt - 4) * 256; }
    else if (nt < 12) { split = 2; nc0 = (nt - 8) * 256; }
    else if (nt < 16) { split = 3; nc0 = (nt - 12) * 256; }
    else if (nt < 18) { split = 4; nc0 = (nt - 16) * 256; }
    else if (nt < 20) { split = 5; nc0 = (nt - 18) * 256; }
    else if (nt < 24) { split = 6; nc0 = (nt - 20) * 256; }
    else if (nt < 28) { split = 7; nc0 = (nt - 24) * 256; }
    else if (nt < 32) { split = 9; nc0 = (nt - 28) * 256; }
    else { split = 10; nc0 = (nt - 32) * 256; }
    const float* rstd = (const float*)(p.ws + OFF_RSTD);
    const float* rope = (const float*)(p.ws + OFF_ROPE);
    unsigned char* ws = p.ws;
    unsigned char* dout = (unsigned char*)p.out;
#pragma unroll
    for (int im = 0; im < 2; ++im) {
        const int tok = mt * 256 + wm * 64 + im * 32 + l31;
        const float rs = rstd[tok];
        const int pos = 16 + (tok & 4095);
        const int b = tok >> 12, s = tok & 4095;
#pragma unroll
        for (int in = 0; in < 4; ++in) {
            const int nb = nc0 + wn * 128 + in * 32;
            float v[16];
#pragma unroll
            for (int i = 0; i < 16; ++i) v[i] = acc[in][im][i] * rs;
            if (split <= 1 && (nb & 63) == 0) {
                const float* cs = rope + ((size_t)pos * 8 + 4 * h) * 2;
#pragma unroll
                for (int i = 0; i < 4; ++i) {
                    const float c = cs[2 * i], sn = cs[2 * i + 1];
                    const float x1 = v[i], x2 = v[i + 4];
                    v[i] = x1 * c - x2 * sn; v[i + 4] = x2 * c + x1 * sn;
                }
            }
            if (split == 2 || split == 6) {
                const int hshift = split == 2 ? 7 : 8;
                const int nheads = split == 2 ? 8 : 4;
                const int dvn = 1 << hshift;
                bf16_t* base = (bf16_t*)(ws + (split == 2 ? OFF_AVT : OFF_GVT));
#pragma unroll
                for (int i = 0; i < 16; ++i) {
                    const int n = nb + (i & 3) + 8 * (i >> 2) + 4 * h;
                    const int hd = n >> hshift, dv = n & (dvn - 1);
                    base[((size_t)(b * nheads + hd) * dvn + dv) * 4096 + s] = f2bf(v[i]);
                }
            } else if (split >= 9) {
                unsigned char* dst = ws + (split == 9 ? OFF_SGA : OFF_SGB) + (size_t)tok * 1024 + nb + 4 * h;
#pragma unroll
                for (int g = 0; g < 4; ++g) {
                    const unsigned o = sig_u8(v[4 * g]) | (sig_u8(v[4 * g + 1]) << 8) | (sig_u8(v[4 * g + 2]) << 16) | (sig_u8(v[4 * g + 3]) << 24);
                    *(unsigned*)(dst + 8 * g) = o;
                }
            } else {
                bf16_t* dst; int ld;
                switch (split) {
                    case 0: dst = (bf16_t*)(dout + DO_AQ); ld = 1024; break;
                    case 1: dst = (bf16_t*)(ws + OFF_AK); ld = 1024; break;
                    case 3: dst = (bf16_t*)(ws + OFF_AZ); ld = 1024; break;
                    case 4: dst = (bf16_t*)(dout + DO_GQ); ld = 512; break;
                    case 5: dst = (bf16_t*)(dout + DO_GK); ld = 512; break;
                    default: dst = (bf16_t*)(ws + OFF_GZ); ld = 1024; break;
                }
#pragma unroll
                for (int g = 0; g < 4; ++g) {
                    u32x2 o; o.x = pk2(v[4 * g], v[4 * g + 1]); o.y = pk2(v[4 * g + 2], v[4 * g + 3]);
                    *(u32x2*)(dst + (size_t)tok * ld + nb + 8 * g + 4 * h) = o;
                }
            }
        }
    }
}

DI void p1_glr_job(const Params& p, unsigned char* lds, int job) {
    const int tid = threadIdx.x, lane = tid & 63, wave = tid >> 6, l15 = lane & 15, g = lane >> 4;
    const int rtile = wave & 3, khalf = wave >> 2;
    const bf16_t* xb = (const bf16_t*)(p.ws + OFF_XB);
    const bf16_t* wt = (const bf16_t*)(p.ws + OFF_WIN_T) + (size_t)9216 * 1024;
    const size_t row0 = (size_t)job * 64 + rtile * 16;
    const bf16_t* ap = xb + (row0 + l15) * 1024 + khalf * 512 + 8 * g;
    const bf16_t* bp = wt + (size_t)l15 * 1024 + khalf * 512 + 8 * g;
    f32x4 acc = (f32x4){0.f, 0.f, 0.f, 0.f};
#pragma unroll 4
    for (int ks = 0; ks < 16; ++ks) {
        const bf16x8 a = *(const bf16x8*)(ap + ks * 32), bb = *(const bf16x8*)(bp + ks * 32);
        acc = MFMA16(a, bb, acc);
    }
    f32x4* red = (f32x4*)lds;
    __syncthreads();
    if (khalf == 1) red[rtile * 64 + lane] = acc;
    __syncthreads();
    if (khalf == 0) {
        const f32x4 o = red[rtile * 64 + lane];
        const float* rstd = (const float*)(p.ws + OFF_RSTD);
        bf16_t* glr = (bf16_t*)(p.ws + OFF_GLR);
#pragma unroll
        for (int i = 0; i < 4; ++i) {
            const size_t row = row0 + 4 * g + i;
            glr[row * 16 + l15] = f2bf((acc[i] + o[i]) * rstd[row]);
        }
    }
    __syncthreads();
}

DI void p1_meta_job(const Params& p, unsigned char* lds, int job) {
    const int tid = threadIdx.x, lane = tid & 63, wave = tid >> 6, l15 = lane & 15, g = lane >> 4;
    int c0;
    if (job < 64) c0 = 1024 + job * 16;
    else if (job < 128) c0 = 2048 + (job - 64) * 16;
    else if (job < 160) c0 = 4608 + (job - 128) * 16;
    else if (job < 224) c0 = 5120 + (job - 160) * 16;
    else c0 = 9216;
    const bf16_t* xbm = (const bf16_t*)(p.ws + OFF_XBM);
    const bf16_t* wt = (const bf16_t*)(p.ws + OFF_WIN_T);
    const bf16_t* ap = xbm + (size_t)l15 * 1024 + wave * 128 + 8 * g;
    const bf16_t* bp = wt + (size_t)(c0 + l15) * 1024 + wave * 128 + 8 * g;
    f32x4 acc = (f32x4){0.f, 0.f, 0.f, 0.f};
#pragma unroll
    for (int ks = 0; ks < 4; ++ks) {
        const bf16x8 a = *(const bf16x8*)(ap + ks * 32), bb = *(const bf16x8*)(bp + ks * 32);
        acc = MFMA16(a, bb, acc);
    }
    f32x4* red = (f32x4*)lds;
    __syncthreads();
    red[wave * 64 + lane] = acc;
    __syncthreads();
    if (wave == 0) {
        f32x4 s = red[lane];
#pragma unroll
        for (int w = 1; w < 8; ++w) { const f32x4 t = red[w * 64 + lane]; s.x += t.x; s.y += t.y; s.z += t.z; s.w += t.w; }
        const float* rstd = (const float*)(p.ws + OFF_RSTD) + MROWS;
        const float* rope = (const float*)(p.ws + OFF_ROPE);
        unsigned char* ws = p.ws;
        const int col = c0 + l15;
#pragma unroll
        for (int i = 0; i < 4; ++i) {
            const int row = 4 * g + i;
            float v = s[i] * rstd[row];
            if (job < 64 && (c0 & 63) == 0) {
                const float other = __shfl_xor(v, 8);
                const float* cs = rope + ((size_t)row * 8 + (l15 & 7)) * 2;
                const float c = cs[0], sn = cs[1];
                v = (l15 < 8) ? (v * c - other * sn) : (v * c + other * sn);
            }
            const bf16_t val = f2bf(v);
            if (job < 64) ((bf16_t*)(ws + OFF_AKM))[(size_t)(48 + row) * 1024 + (col - 1024)] = val;
            else if (job < 128) { const int n = col - 2048; ((bf16_t*)(ws + OFF_AVTM))[(size_t)n * 64 + 48 + row] = val; }
            else if (job < 160) ((bf16_t*)(ws + OFF_GKM))[(size_t)row * 512 + (col - 4608)] = val;
            else if (job < 224) { const int n = col - 5120; ((bf16_t*)(ws + OFF_GVTM))[(size_t)n * 64 + 48 + row] = val; }
            else ((bf16_t*)(ws + OFF_GLRM))[row * 16 + l15] = val;
        }
    }
    __syncthreads();
}

DI void phase1(const Params& p, unsigned char* lds) {
    for (int j = blockIdx.x; j < 256; j += gridDim.x) p1_glr_job(p, lds, j);
    for (int j = blockIdx.x; j < 225; j += gridDim.x) p1_meta_job(p, lds, j);
    constexpr int NT = 36, TOTAL = 64 * NT;
    const bf16_t* wt = (const bf16_t*)(p.ws + OFF_WIN_T);
    const bf16_t* xb = (const bf16_t*)(p.ws + OFF_XB);
    const float hs0[2][3] = {{1.f, 1.f, 1.f}, {1.f, 1.f, 1.f}};
    for (int id = blockIdx.x; id < TOTAL; id += gridDim.x) {
        int mt, nt;
        {
            const int g = id / (16 * NT), rem = id % (16 * NT), reg = rem >> 8, w = rem & 255, x = w & 7, j = w >> 3;
            const int mo = 4 * (x & 3) + (j & 3), no = 8 * (x >> 2) + (j >> 2);
            nt = reg * 16 + no; mt = g * 16 + mo;
            if (reg == 2) { const int e = rem - 512; nt = 32 + (e >> 4); mt = g * 16 + (e & 15); }
        }
        f32x16 acc[4][2];
        zero_acc<4>(acc);
        gemm_tile<4, false>(acc, wt + (size_t)nt * 256 * 1024, xb + (size_t)mt * 256 * 1024, lds, hs0);
        p1_epilogue(p, acc, mt, nt);
    }
}

DI void phase15(const Params& p, unsigned char* lds) {
    const int tid = threadIdx.x, col = tid;
    float w2[16];
#pragma unroll
    for (int j = 0; j < 16; ++j) w2[j] = p.gate_w2[j * 512 + col];
    const float bias = p.gate_b[col];
    unsigned char* ws = p.ws;
    unsigned char* dout = (unsigned char*)p.out;
    for (int item = blockIdx.x; item < 257; item += gridDim.x) {
        const bool meta = item == 256;
        const int b = item >> 6, c = item & 63;
        const size_t row0 = (size_t)b * 4096 + c * 64;
        const bf16_t* glr = meta ? (const bf16_t*)(ws + OFF_GLRM) : (const bf16_t*)(ws + OFF_GLR) + row0 * 16;
        const int nrows = meta ? 16 : 64;
        bf16_t* qp = (bf16_t*)(dout + DO_GQ) + row0 * 512 + col;
        const bf16_t* kin = meta ? (const bf16_t*)(ws + OFF_GKM) + col : (const bf16_t*)(dout + DO_GK) + row0 * 512 + col;
        bf16_t* kout = meta ? (bf16_t*)(ws + OFF_KTM) + 48 * 512 + col : (bf16_t*)(dout + DO_GK) + row0 * 512 + col;
        bf16_t* ktt = meta ? (bf16_t*)(ws + OFF_KTTM) + (size_t)col * 64 + 48 : (bf16_t*)(ws + OFF_WIN_T) + ((size_t)b * 512 + col) * 4096 + c * 64;
        __syncthreads();
        if (tid < nrows * 2) ((u32x4*)lds)[tid] = ((const u32x4*)glr)[tid];
        __syncthreads();
        float bsum = 0.f;
        bf16_t kc[8], qc[8], kn[8], qn[8];
#pragma unroll
        for (int rr = 0; rr < 8; ++rr) { kc[rr] = kin[(size_t)rr * 512]; qc[rr] = meta ? (bf16_t)0 : qp[(size_t)rr * 512]; }
        for (int r0 = 0; r0 < nrows; r0 += 8) {
            if (r0 + 8 < nrows) {
#pragma unroll
                for (int rr = 0; rr < 8; ++rr) { kn[rr] = kin[(size_t)(r0 + 8 + rr) * 512]; qn[rr] = meta ? (bf16_t)0 : qp[(size_t)(r0 + 8 + rr) * 512]; }
            }
            float kt8[8];
#pragma unroll
            for (int rr = 0; rr < 8; ++rr) {
                const int r = r0 + rr;
                const u32x4* g4 = (const u32x4*)(lds + r * 32);
                const u32x4 ga = g4[0], gb = g4[1];
                float gk = bias;
                gk += bflo(ga.x) * w2[0] + bfhi(ga.x) * w2[1] + bflo(ga.y) * w2[2] + bfhi(ga.y) * w2[3];
                gk += bflo(ga.z) * w2[4] + bfhi(ga.z) * w2[5] + bflo(ga.w) * w2[6] + bfhi(ga.w) * w2[7];
                gk += bflo(gb.x) * w2[8] + bfhi(gb.x) * w2[9] + bflo(gb.y) * w2[10] + bfhi(gb.y) * w2[11];
                gk += bflo(gb.z) * w2[12] + bfhi(gb.z) * w2[13] + bflo(gb.w) * w2[14] + bfhi(gb.w) * w2[15];
                const float lg = (fminf(gk, 0.f) - log1pf(expf(-fabsf(gk)))) * (1.0f / 16.0f);
                bsum += lg;
                const float kt = bf2f(kc[rr]) * expf(-bsum);
                kt8[rr] = kt;
                kout[(size_t)r * 512] = f2bf(kt);
                if (!meta) qp[(size_t)r * 512] = f2bf(bf2f(qc[rr]) * 0.08838834764831845f * expf(bsum));
            }
            u32x4 o; o.x = pk2(kt8[0], kt8[1]); o.y = pk2(kt8[2], kt8[3]); o.z = pk2(kt8[4], kt8[5]); o.w = pk2(kt8[6], kt8[7]);
            *(u32x4*)(ktt + r0) = o;
#pragma unroll
            for (int rr = 0; rr < 8; ++rr) { kc[rr] = kn[rr]; qc[rr] = qn[rr]; }
        }
        if (meta) {
            ((float*)(ws + OFF_DECM))[col] = expf(bsum);
            bf16_t* km = (bf16_t*)(ws + OFF_KTM);
            for (int r = 0; r < 48; ++r) km[r * 512 + col] = 0;
            u32x4 z = {0u, 0u, 0u, 0u};
            u32x4* kz = (u32x4*)((bf16_t*)(ws + OFF_KTTM) + (size_t)col * 64);
#pragma unroll
            for (int j = 0; j < 6; ++j) kz[j] = z;
        } else {
            ((float*)(ws + OFF_DEC))[((size_t)b * 64 + c) * 512 + col] = expf(bsum);
        }
    }
}

constexpr int A_KROWB = 272, A_VROWB = 136, A_KB = 64 * A_KROWB, A_VB = 128 * A_VROWB, A_STAGE = A_KB + A_VB;
DI void attn_tile(const unsigned char* sK, const unsigned char* sV, int tt, int qb, int qs, int sub, int l31, int h,
                  const bf16x8 (&qf)[4], f32x16 (&O)[4], float& m, float& l) {
    const float SC = 0.125f * 1.4426950408889634f;
    f32x16 st[2];
#pragma unroll
    for (int k2 = 0; k2 < 2; ++k2)
#pragma unroll
        for (int i = 0; i < 16; ++i) st[k2][i] = 0.f;
#pragma unroll
    for (int k2 = 0; k2 < 2; ++k2)
#pragma unroll
        for (int ks = 0; ks < 4; ++ks) {
            const bf16x8 kf = *(const bf16x8*)(sK + (k2 * 32 + l31) * A_KROWB + (sub * 64 + ks * 16 + 8 * h) * 2);
            st[k2] = MFMA32(kf, qf[ks], st[k2]);
        }
    if (tt == 0) {
#pragma unroll
        for (int i = 0; i < 16; ++i) { st[0][i] = -INFINITY; if (i < 8) st[1][i] = -INFINITY; }
    } else if (tt >= 2 * qb + 1) {
        const int kbase = (tt - 1) * 64 + 4 * h;
#pragma unroll
        for (int k2 = 0; k2 < 2; ++k2)
#pragma unroll
            for (int i = 0; i < 16; ++i) {
                const int key = kbase + k2 * 32 + (i & 3) + 8 * (i >> 2);
                if (key > qs) st[k2][i] = -INFINITY;
            }
    }
    float mx = -INFINITY;
#pragma unroll
    for (int k2 = 0; k2 < 2; ++k2)
#pragma unroll
        for (int i = 0; i < 16; ++i) mx = fmaxf(mx, st[k2][i]);
    mx = fmaxf(mx, __shfl_xor(mx, 32));
    const float mnew = fmaxf(m, mx);
    const float alpha = __builtin_amdgcn_exp2f((m - mnew) * SC);
    const float mc = mnew * SC;
    m = mnew;
    float ps = 0.f;
#pragma unroll
    for (int k2 = 0; k2 < 2; ++k2)
#pragma unroll
        for (int i = 0; i < 16; ++i) { const float pv = __builtin_amdgcn_exp2f(st[k2][i] * SC - mc); st[k2][i] = pv; ps += pv; }
    l = l * alpha + ps;
#pragma unroll
    for (int d = 0; d < 4; ++d)
#pragma unroll
        for (int i = 0; i < 16; ++i) O[d][i] *= alpha;
    bf16x8 pb[4];
#pragma unroll
    for (int k4 = 0; k4 < 4; ++k4) {
        const int k2 = k4 >> 1, o8 = 8 * (k4 & 1);
        u32x4 pk;
        pk.x = pk2(st[k2][o8 + 0], st[k2][o8 + 1]); pk.y = pk2(st[k2][o8 + 2], st[k2][o8 + 3]);
        pk.z = pk2(st[k2][o8 + 4], st[k2][o8 + 5]); pk.w = pk2(st[k2][o8 + 6], st[k2][o8 + 7]);
        pb[k4] = __builtin_bit_cast(bf16x8, pk);
    }
#pragma unroll
    for (int d = 0; d < 4; ++d)
#pragma unroll
        for (int k4 = 0; k4 < 4; ++k4) {
            const unsigned char* vp = sV + (d * 32 + l31) * A_VROWB + (k4 * 16 + 4 * h) * 2;
            const u32x2 lo = *(const u32x2*)vp, hi = *(const u32x2*)(vp + 16);
            u32x4 vv; vv.x = lo.x; vv.y = lo.y; vv.z = hi.x; vv.w = hi.y;
            O[d] = MFMA32(__builtin_bit_cast(bf16x8, vv), pb[k4], O[d]);
        }
}

DI void attn_item(const Params& p, unsigned char* lds, int b, int hd, int qb) {
    const int tid = threadIdx.x, lane = tid & 63, wave = tid >> 6, l31 = lane & 31, h = lane >> 5;
    const int sub = wave >> 2, rt = wave & 3;
    const bf16_t* aq = (const bf16_t*)((unsigned char*)p.out + DO_AQ);
    const bf16_t* ak = (const bf16_t*)(p.ws + OFF_AK);
    const bf16_t* avT = (const bf16_t*)(p.ws + OFF_AVT);
    const bf16_t* akm = (const bf16_t*)(p.ws + OFF_AKM);
    const bf16_t* avTm = (const bf16_t*)(p.ws + OFF_AVTM);
    bf16_t* az = (bf16_t*)(p.ws + OFF_AZ);
    const int qs = qb * 128 + rt * 32 + l31;
    const size_t grow = (size_t)b * 4096 + qs;
    bf16x8 qf[4];
#pragma unroll
    for (int ks = 0; ks < 4; ++ks) qf[ks] = *(const bf16x8*)(aq + grow * 1024 + hd * 128 + sub * 64 + ks * 16 + 8 * h);
    f32x16 O[4];
#pragma unroll
    for (int d = 0; d < 4; ++d)
#pragma unroll
        for (int i = 0; i < 16; ++i) O[d][i] = 0.f;
    float m = -INFINITY, l = 0.f;
    const int T = 2 * qb + 3;
    u32x4 k0r[2], v0r[2];
    const int krow_ = tid >> 4, kc_ = tid & 15, vdv_ = tid >> 3, vc_ = tid & 7;
    const bf16_t* kp = ak + ((size_t)b * 4096 + krow_) * 1024 + hd * 128 + kc_ * 8;
    const bf16_t* vp_ = avT + ((size_t)(b * 8 + hd) * 128 + vdv_) * 4096 + vc_ * 8;
#define A_LOAD_REAL(KR, VR)                                                                                                   \
    {                                                                                                                         \
        KR[0] = *(const u32x4*)kp; KR[1] = *(const u32x4*)(kp + 32 * 1024); kp += 64 * 1024;                                  \
        VR[0] = *(const u32x4*)vp_; VR[1] = *(const u32x4*)(vp_ + (size_t)64 * 4096); vp_ += 64;                              \
    }
#define A_STORE(KR, VR, buf_)                                                                                                 \
    {                                                                                                                         \
        unsigned char* sK_ = lds + (buf_) * A_STAGE; unsigned char* sV_ = sK_ + A_KB;                                         \
        _Pragma("unroll") for (int i = 0; i < 2; ++i) { const int pi = tid + 512 * i, row = pi >> 4, c = pi & 15;              \
            *(u32x4*)(sK_ + row * A_KROWB + c * 16) = KR[i]; }                                                                \
        _Pragma("unroll") for (int i = 0; i < 2; ++i) { const int pi = tid + 512 * i, dv = pi >> 3, c = pi & 7;                \
            unsigned char* d_ = sV_ + dv * A_VROWB + c * 16; u32x2 a_, b_; a_.x = VR[i].x; a_.y = VR[i].y; b_.x = VR[i].z; b_.y = VR[i].w; \
            *(u32x2*)d_ = a_; *(u32x2*)(d_ + 8) = b_; }                                                                       \
    }
    {
        const bf16_t* km_ = akm + (size_t)krow_ * 1024 + hd * 128 + kc_ * 8;
        k0r[0] = *(const u32x4*)km_; k0r[1] = *(const u32x4*)(km_ + 32 * 1024);
        const bf16_t* vm_ = avTm + (size_t)(hd * 128 + vdv_) * 64 + vc_ * 8;
        v0r[0] = *(const u32x4*)vm_; v0r[1] = *(const u32x4*)(vm_ + 64 * 64);
    }
    A_STORE(k0r, v0r, 0);
    __syncthreads();
    for (int tt = 0; tt < T; ++tt) {
        if (tt + 1 < T) A_LOAD_REAL(k0r, v0r);
        attn_tile(lds + (tt & 1) * A_STAGE, lds + (tt & 1) * A_STAGE + A_KB, tt, qb, qs, sub, l31, h, qf, O, m, l);
        if (tt + 1 < T) A_STORE(k0r, v0r, (tt + 1) & 1);
        __syncthreads();
    }
#undef A_LOAD_REAL
#undef A_STORE
    float lam;
    {
        const float a_ = wave_sum(p.lq1[lane] * p.lk1[lane]);
        const float b_ = wave_sum(p.lq2[lane] * p.lk2[lane]);
        lam = expf(a_) - expf(b_) + 0.2f;
    }
    const float ltot = l + __shfl_xor(l, 32);
    const float linv = 1.0f / ltot;
    float* ex = (float*)lds;
    if (sub == 1) {
#pragma unroll
        for (int d = 0; d < 4; ++d)
#pragma unroll
            for (int i = 0; i < 16; ++i) { ex[(rt * 32 + l31) * 129 + d * 32 + (i & 3) + 8 * (i >> 2) + 4 * h] = O[d][i] * linv; if (i == 15) __builtin_amdgcn_sched_barrier(0); }
    }
    __syncthreads();
    if (sub == 0) {
        float ss = 0.f;
#pragma unroll
        for (int d = 0; d < 4; ++d)
#pragma unroll
            for (int i = 0; i < 16; ++i) {
                const float o2 = ex[(rt * 32 + l31) * 129 + d * 32 + (i & 3) + 8 * (i >> 2) + 4 * h];
                const float o = O[d][i] * linv - lam * o2;
                O[d][i] = o; ss += o * o;
                if (i == 15) __builtin_amdgcn_sched_barrier(0);
            }
        ss += __shfl_xor(ss, 32);
        const float rstd = 1.0f / sqrtf(ss * (1.0f / 128.0f) + EPS);
#pragma unroll
        for (int d = 0; d < 4; ++d)
#pragma unroll
            for (int g = 0; g < 4; ++g) {
                bf16_t* zp = az + grow * 1024 + hd * 128 + d * 32 + 8 * g + 4 * h;
                const u32x2 zz = *(const u32x2*)zp;
                u32x2 o;
                o.x = pk2(O[d][4 * g] * rstd * siluf_(bflo(zz.x)), O[d][4 * g + 1] * rstd * siluf_(bfhi(zz.x)));
                o.y = pk2(O[d][4 * g + 2] * rstd * siluf_(bflo(zz.y)), O[d][4 * g + 3] * rstd * siluf_(bfhi(zz.y)));
                *(u32x2*)zp = o;
                if (g == 3) __builtin_amdgcn_sched_barrier(0);
            }
    }
    __syncthreads();
}

constexpr int L_KROWB = 272, L_VROWB = 144, L_SROWB = 272;
constexpr int L_K = 0, L_V = 64 * L_KROWB, L_S = L_V + 32 * L_VROWB, L_END = L_S + 32 * L_SROWB;
DI void gla_item(const Params& p, unsigned char* lds, int b, int hh, int sl) {
    const int tid = threadIdx.x, lane = tid & 63, wave = tid >> 6, l15 = lane & 15, g = lane >> 4;
    const int tt = wave & 3, dvt = wave >> 2;
    unsigned char* ws = p.ws;
    unsigned char* dout = (unsigned char*)p.out;
    const bf16_t* gq = (const bf16_t*)(dout + DO_GQ);
    const bf16_t* gk = (const bf16_t*)(dout + DO_GK);
    const bf16_t* gvT = (const bf16_t*)(ws + OFF_GVT);
    const bf16_t* ktt = (const bf16_t*)(ws + OFF_WIN_T);
    const float* dec = (const float*)(ws + OFF_DEC);
    bf16_t* gz = (bf16_t*)(ws + OFF_GZ);
    float* ssqb = (float*)(ws + OFF_SSQB);
    unsigned char* sK = lds + L_K; unsigned char* sV = lds + L_V; unsigned char* sS = lds + L_S;
    for (int i = tid; i < 32 * L_SROWB / 4; i += 512) ((unsigned*)sS)[i] = 0u;
    f32x4 sacc[2];
#pragma unroll
    for (int c = 0; c < 2; ++c) sacc[c] = (f32x4){0.f, 0.f, 0.f, 0.f};
    u32x4 nk[2]; u32x4 nv; bf16x8 nq[4]; bf16x8 nkt[2][2]; float nd[2]; u32x2 ngz;
    const int cc0 = 16 * (2 * tt) + l15;
    const int krow_ = tid >> 4, kc_ = tid & 15, vdv_ = (tid >> 3) & 31, vc_ = tid & 7;
    const bf16_t* kp = gk + ((size_t)b * 4096 + krow_) * 512 + hh * 128 + kc_ * 8;
    const bf16_t* vp_ = gvT + ((size_t)(b * 4 + hh) * 256 + sl * 32 + vdv_) * 4096 + vc_ * 8;
    const bf16_t* ktp = ktt + ((size_t)(b * 4 + hh) * 128 + cc0) * 4096 + 8 * g;
    const float* dp = dec + (size_t)b * 64 * 512 + hh * 128 + cc0;
    const bf16_t* qp = gq + ((size_t)b * 4096 + 16 * tt + l15) * 512 + hh * 128 + 8 * g;
    bf16_t* gzp = gz + ((size_t)b * 4096 + 16 * tt + l15) * 1024 + hh * 256 + sl * 32 + 16 * dvt + 4 * g;
#define L_LOAD_META()                                                                                                         \
    {                                                                                                                         \
        const bf16_t* km_ = (const bf16_t*)(ws + OFF_KTM) + (size_t)krow_ * 512 + hh * 128 + kc_ * 8;                         \
        nk[0] = *(const u32x4*)km_; nk[1] = *(const u32x4*)(km_ + 32 * 512);                                                  \
        nv = *(const u32x4*)((const bf16_t*)(ws + OFF_GVTM) + (size_t)(hh * 256 + sl * 32 + vdv_) * 64 + vc_ * 8);            \
        _Pragma("unroll") for (int ct = 0; ct < 2; ++ct) _Pragma("unroll") for (int ks = 0; ks < 2; ++ks)                     \
            nkt[ct][ks] = *(const bf16x8*)((const bf16_t*)(ws + OFF_KTTM) + (size_t)(hh * 128 + cc0 + 16 * ct) * 64 + 32 * ks + 8 * g); \
        _Pragma("unroll") for (int ct = 0; ct < 2; ++ct) nd[ct] = ((const float*)(ws + OFF_DECM))[hh * 128 + cc0 + 16 * ct];  \
        _Pragma("unroll") for (int ks = 0; ks < 4; ++ks) nq[ks] = (bf16x8){0, 0, 0, 0, 0, 0, 0, 0};                           \
        ngz = (u32x2){0u, 0u};                                                                                                \
    }
#define L_LOAD_REAL()                                                                                                         \
    {                                                                                                                         \
        nk[0] = *(const u32x4*)kp; nk[1] = *(const u32x4*)(kp + 32 * 512); kp += 64 * 512;                                    \
        nv = *(const u32x4*)vp_; vp_ += 64;                                                                                   \
        _Pragma("unroll") for (int ct = 0; ct < 2; ++ct) _Pragma("unroll") for (int ks = 0; ks < 2; ++ks)                     \
            nkt[ct][ks] = *(const bf16x8*)(ktp + (size_t)(16 * ct) * 4096 + 32 * ks);                                         \
        ktp += 64;                                                                                                            \
        nd[0] = dp[0]; nd[1] = dp[16]; dp += 512;                                                                             \
        _Pragma("unroll") for (int ks = 0; ks < 4; ++ks) nq[ks] = *(const bf16x8*)(qp + 32 * ks);                             \
        qp += 64 * 512;                                                                                                       \
        ngz = *(const u32x2*)gzp; gzp += 64 * 1024;                                                                           \
    }
#define L_STORE()                                                                                                             \
    {                                                                                                                         \
        _Pragma("unroll") for (int i = 0; i < 2; ++i) { const int pi = tid + 512 * i, row = pi >> 4, c = pi & 15;              \
            *(u32x4*)(sK + row * L_KROWB + c * 16) = nk[i]; }                                                                 \
        if (tid < 256) { const int dv = tid >> 3, c = tid & 7; *(u32x4*)(sV + dv * L_VROWB + c * 16) = nv; }                  \
    }
    L_LOAD_META();
    L_STORE();
    for (int n = 0; n <= 64; ++n) {
        bf16x8 cq[4], ckt[2][2]; float cd[2]; u32x2 cgz;
#pragma unroll
        for (int ks = 0; ks < 4; ++ks) cq[ks] = nq[ks];
#pragma unroll
        for (int ct = 0; ct < 2; ++ct) { cd[ct] = nd[ct]; ckt[ct][0] = nkt[ct][0]; ckt[ct][1] = nkt[ct][1]; }
        cgz = ngz;
        __syncthreads();
        if (n + 1 <= 64) L_LOAD_REAL();
        if (n > 0) {
            f32x4 at[4];
#pragma unroll
            for (int jt = 0; jt < 4; ++jt) at[jt] = (f32x4){0.f, 0.f, 0.f, 0.f};
#pragma unroll
            for (int jt = 0; jt < 4; ++jt)
#pragma unroll
                for (int ks = 0; ks < 4; ++ks) {
                    const bf16x8 kf = *(const bf16x8*)(sK + (jt * 16 + l15) * L_KROWB + (ks * 32 + 8 * g) * 2);
                    at[jt] = MFMA16(kf, cq[ks], at[jt]);
                }
            const int tl = 16 * tt + l15;
#pragma unroll
            for (int jt = 0; jt < 4; ++jt)
#pragma unroll
                for (int i = 0; i < 4; ++i) if (16 * jt + 4 * g + i > tl) at[jt][i] = 0.f;
            f32x4 o = (f32x4){0.f, 0.f, 0.f, 0.f};
#pragma unroll
            for (int s2 = 0; s2 < 2; ++s2) {
                u32x4 pa;
                pa.x = pk2(at[2 * s2][0], at[2 * s2][1]); pa.y = pk2(at[2 * s2][2], at[2 * s2][3]);
                pa.z = pk2(at[2 * s2 + 1][0], at[2 * s2 + 1][1]); pa.w = pk2(at[2 * s2 + 1][2], at[2 * s2 + 1][3]);
                const unsigned char* vp = sV + (dvt * 16 + l15) * L_VROWB + (32 * s2 + 4 * g) * 2;
                const u32x2 lo = *(const u32x2*)vp, hi = *(const u32x2*)(vp + 32);
                u32x4 vv; vv.x = lo.x; vv.y = lo.y; vv.z = hi.x; vv.w = hi.y;
                o = MFMA16(__builtin_bit_cast(bf16x8, vv), __builtin_bit_cast(bf16x8, pa), o);
            }
#pragma unroll
            for (int ks = 0; ks < 4; ++ks) {
                const bf16x8 sf = *(const bf16x8*)(sS + (dvt * 16 + l15) * L_SROWB + (ks * 32 + 8 * g) * 2);
                o = MFMA16(sf, cq[ks], o);
            }
            const size_t row = (size_t)b * 4096 + (n - 1) * 64 + 16 * tt + l15;
            float ss = (o[0] * o[0] + o[1] * o[1]) + (o[2] * o[2] + o[3] * o[3]);
            ss += __shfl_xor(ss, 16); ss += __shfl_xor(ss, 32);
            u32x2 ov;
            ov.x = pk2(o[0] * siluf_(bflo(cgz.x)), o[1] * siluf_(bfhi(cgz.x)));
            ov.y = pk2(o[2] * siluf_(bflo(cgz.y)), o[3] * siluf_(bfhi(cgz.y)));
            *(u32x2*)(gz + row * 1024 + hh * 256 + sl * 32 + 16 * dvt + 4 * g) = ov;
            if (g == 0) ssqb[(row * 4 + hh) * 16 + sl * 2 + dvt] = ss;
        }
#pragma unroll
        for (int ks = 0; ks < 2; ++ks) {
            const bf16x8 vf = *(const bf16x8*)(sV + (dvt * 16 + l15) * L_VROWB + (32 * ks + 8 * g) * 2);
            sacc[0] = MFMA16(vf, ckt[0][ks], sacc[0]);
            sacc[1] = MFMA16(vf, ckt[1][ks], sacc[1]);
        }
#pragma unroll
        for (int ct = 0; ct < 2; ++ct)
#pragma unroll
            for (int i = 0; i < 4; ++i) sacc[ct][i] *= cd[ct];
        __syncthreads();
#pragma unroll
        for (int ct = 0; ct < 2; ++ct)
#pragma unroll
            for (int i = 0; i < 4; ++i)
                *(bf16_t*)(sS + (16 * dvt + 4 * g + i) * L_SROWB + (cc0 + 16 * ct) * 2) = f2bf(sacc[ct][i]);
        if (n + 1 <= 64) L_STORE();
    }
#undef L_LOAD_META
#undef L_LOAD_REAL
#undef L_STORE
    __syncthreads();
}

DI void phase2(const Params& p, unsigned char* lds) {
    const int tid = threadIdx.x, lane = tid & 63;
    unsigned* ctr = (unsigned*)(p.ws + OFF_CTR);
    volatile unsigned* sItem = (volatile unsigned*)(lds + LDS_ITEM);
    constexpr unsigned N_GLA = 128, N_ATT = 1024;
    for (;;) {
        if (tid == 0) *sItem = atomicAdd(ctr, 1u);
        __syncthreads();
        const unsigned item = *sItem;
        __syncthreads();
        if (item >= N_GLA + N_ATT) break;
        if (item < N_GLA) gla_item(p, lds, item >> 5, (item >> 3) & 3, item & 7);
        else { const unsigned a = item - N_GLA; attn_item(p, lds, a & 3, (a >> 2) & 7, 31 - (int)(a >> 5)); }
    }
}

DI void phase3(const Params& p, unsigned char* lds) {
    const int tid = threadIdx.x, lane = tid & 63, wave = tid >> 6, l31 = lane & 31, h = lane >> 5;
    const int wn = wave & 1, wm = wave >> 1;
    unsigned char* ws = p.ws;
    const float* ssqb = (const float*)(ws + OFF_SSQB);
    float* sc = (float*)(lds + LDS_SCALE);
    const unsigned char* sga = ws + OFF_SGA;
    const unsigned char* sgb = ws + OFF_SGB;
    bf16_t* merged = (bf16_t*)(ws + OFF_AK);
    for (int id = blockIdx.x; id < 512; id += gridDim.x) {
        const int mt = (id >> 8) * 32 + 4 * (id & 7) + ((id >> 3) & 3), nt = (id >> 5) & 7;
#pragma unroll
        for (int i = 0; i < 2; ++i) {
            const int e = tid + 512 * i, row = e >> 2, hh = e & 3;
            const f32x4* sp = (const f32x4*)(ssqb + (((size_t)mt * 256 + row) * 4 + hh) * 16);
            const f32x4 a = sp[0], b2 = sp[1], c = sp[2], d = sp[3];
            const float s = ((a.x + a.y) + (a.z + a.w)) + ((b2.x + b2.y) + (b2.z + b2.w)) + ((c.x + c.y) + (c.z + c.w)) + ((d.x + d.y) + (d.z + d.w));
            sc[e] = 1.0f / sqrtf(s * (1.0f / 256.0f) + EPS);
        }
        __syncthreads();
        float hs[2][3], rl[2];
#pragma unroll
        for (int im = 0; im < 2; ++im) {
            const int lr = wm * 64 + im * 32 + l31;
            const f32x4 r = *(const f32x4*)(sc + lr * 4);
            hs[im][0] = r.x / r.y; hs[im][1] = r.y / r.z; hs[im][2] = r.z / r.w; rl[im] = r.w;
        }
        f32x16 acc[2][2];
        unsigned mb[2][2][8];
        zero_acc<2>(acc);
        gemm_tile<2, true>(acc, (const bf16_t*)(ws + OFF_WB_T) + (size_t)nt * 128 * 1024, (const bf16_t*)(ws + OFF_GZ) + (size_t)mt * 256 * 1024, lds, hs);
#pragma unroll
        for (int im = 0; im < 2; ++im) {
            const size_t tok = (size_t)mt * 256 + wm * 64 + im * 32 + l31;
#pragma unroll
            for (int in = 0; in < 2; ++in)
#pragma unroll
                for (int g = 0; g < 4; ++g) {
                    const size_t off = tok * 1024 + nt * 128 + wn * 64 + in * 32 + 8 * g + 4 * h;
                    const unsigned ub = *(const unsigned*)(sgb + off);
                    const float q = rl[im] * (1.0f / 255.0f);
                    mb[in][im][2 * g] = pk2((float)(ub & 255u) * q * acc[in][im][4 * g + 0], (float)((ub >> 8) & 255u) * q * acc[in][im][4 * g + 1]);
                    mb[in][im][2 * g + 1] = pk2((float)((ub >> 16) & 255u) * q * acc[in][im][4 * g + 2], (float)(ub >> 24) * q * acc[in][im][4 * g + 3]);
                }
        }
        zero_acc<2>(acc);
        gemm_tile<2, false>(acc, (const bf16_t*)(ws + OFF_WA_T) + (size_t)nt * 128 * 1024, (const bf16_t*)(ws + OFF_AZ) + (size_t)mt * 256 * 1024, lds, hs);
#pragma unroll
        for (int im = 0; im < 2; ++im) {
            const size_t tok = (size_t)mt * 256 + wm * 64 + im * 32 + l31;
#pragma unroll
            for (int in = 0; in < 2; ++in)
#pragma unroll
                for (int g = 0; g < 4; ++g) {
                    const size_t off = tok * 1024 + nt * 128 + wn * 64 + in * 32 + 8 * g + 4 * h;
                    const unsigned ua = *(const unsigned*)(sga + off);
                    const unsigned b0 = mb[in][im][2 * g], b1 = mb[in][im][2 * g + 1];
                    const float q = 1.0f / 255.0f;
                    const float m0 = (float)(ua & 255u) * q * acc[in][im][4 * g + 0] + bflo(b0);
                    const float m1 = (float)((ua >> 8) & 255u) * q * acc[in][im][4 * g + 1] + bfhi(b0);
                    const float m2 = (float)((ua >> 16) & 255u) * q * acc[in][im][4 * g + 2] + bflo(b1);
                    const float m3 = (float)(ua >> 24) * q * acc[in][im][4 * g + 3] + bfhi(b1);
                    u32x2 o; o.x = pk2(m0, m1); o.y = pk2(m2, m3);
                    *(u32x2*)(merged + off) = o;
                }
        }
        __syncthreads();
    }
}

DI void phase4(const Params& p, unsigned char* lds) {
    const int tid = threadIdx.x, lane = tid & 63, wave = tid >> 6, l31 = lane & 31, h = lane >> 5;
    const int wn = wave & 1, wm = wave >> 1;
    unsigned char* ws = p.ws;
    float* ssqh = (float*)(ws + OFF_SSQH);
    for (int id = blockIdx.x; id < 512; id += gridDim.x) {
        const int mt = (id >> 8) * 32 + 4 * (id & 7) + ((id >> 3) & 3), nt = (id >> 5) & 7;
        f32x16 acc[2][2];
        zero_acc<2>(acc);
        const float hs0[2][3] = {{1.f, 1.f, 1.f}, {1.f, 1.f, 1.f}};
        gemm_tile<2, false>(acc, (const bf16_t*)(ws + OFF_WO_T) + (size_t)nt * 128 * 1024, (const bf16_t*)(ws + OFF_AK) + (size_t)mt * 256 * 1024, lds, hs0);
#pragma unroll
        for (int im = 0; im < 2; ++im) {
            const size_t tok = (size_t)mt * 256 + wm * 64 + im * 32 + l31;
            float ss = 0.f;
#pragma unroll
            for (int in = 0; in < 2; ++in)
#pragma unroll
                for (int g = 0; g < 4; ++g) {
                    const size_t off = tok * 1024 + nt * 128 + wn * 64 + in * 32 + 8 * g + 4 * h;
                    const f32x4 xv = *(const f32x4*)(p.x + off);
                    f32x4 o;
                    o.x = xv.x + acc[in][im][4 * g + 0]; o.y = xv.y + acc[in][im][4 * g + 1];
                    o.z = xv.z + acc[in][im][4 * g + 2]; o.w = xv.w + acc[in][im][4 * g + 3];
                    ss += (o.x * o.x + o.y * o.y) + (o.z * o.z + o.w * o.w);
                    *(f32x4*)(p.out + off) = o;
                }
            ss += __shfl_xor(ss, 32);
            if (h == 0) ssqh[tok * 16 + nt * 2 + wn] = ss;
        }
    }
}

DI void phase5(const Params& p, unsigned char* lds) {
    const int tid = threadIdx.x, lane = tid & 63, wave = tid >> 6;
    const float* ssqh = (const float*)(p.ws + OFF_SSQH);
    for (int it = blockIdx.x; it < MROWS / 8; it += gridDim.x) {
        const size_t row = (size_t)it * 8 + wave;
        float s = lane < 16 ? ssqh[row * 16 + lane] : 0.f;
        s = wave_sum(s);
        const float rstd = 1.0f / sqrtf(s * (1.0f / 1024.0f) + EPS);
        f32x4* orow = (f32x4*)(p.out + row * 1024) + lane;
        const f32x4* wrow = (const f32x4*)p.final_w + lane;
#pragma unroll
        for (int j = 0; j < 4; ++j) {
            f32x4 v = orow[64 * j]; const f32x4 w = wrow[64 * j];
            v.x = v.x * rstd * w.x; v.y = v.y * rstd * w.y; v.z = v.z * rstd * w.z; v.w = v.w * rstd * w.w;
            orow[64 * j] = v;
        }
    }
}

#define XB_TMO      128
#define XB_XCNT(j)  (256  + 64 * (j))
#define XB_XSUB(j)  (1280 + 64 * (j))
#define XB_XGEN(j)  (2304 + 64 * (j))
#define XB_TOP      3328
#define XB_TOPGEN   3392
#define XCD_BAR_WORDS 3456
#define XB_SPIN_CAP (1u << 18)
#define LAS __attribute__((address_space(3)))
DI unsigned xb_ld(unsigned* p)              { return __hip_atomic_load(p, __ATOMIC_RELAXED, __HIP_MEMORY_SCOPE_AGENT); }
DI unsigned xb_add(unsigned* p, unsigned v) { return __hip_atomic_fetch_add(p, v, __ATOMIC_RELAXED, __HIP_MEMORY_SCOPE_AGENT); }
DI unsigned xb_xcc_id() { return (unsigned)__builtin_amdgcn_s_getreg((3 << 11) | 20) & 0xFu; }
#define XB_SPIN(cond, bar) do { unsigned _sp = 0; while (cond) { __builtin_amdgcn_s_sleep(1); \
    if ((++_sp & 255u) == 0u) { if (xb_ld(&(bar)[XB_TMO])) break; if (_sp > XB_SPIN_CAP) { atomicAdd(&(bar)[XB_TMO], 1u); break; } } } } while (0)
struct XcdBarrier { unsigned* bar; unsigned x; volatile LAS unsigned* st; };
DI XcdBarrier xcd_barrier_post(unsigned* bar, volatile LAS unsigned* st) {
    XcdBarrier b; b.bar = bar; b.x = xb_xcc_id(); b.st = st;
    if (threadIdx.x == 0) (void)xb_add(&bar[XB_XCNT(b.x)], 1u);
    return b;
}
DI void xcd_barrier_complete(unsigned* bar, unsigned x, unsigned& nloc, unsigned& nx) {
    const unsigned G = gridDim.x * gridDim.y * gridDim.z;
    unsigned sum, cnt, mine, sp = 0u;
    for (;;) {
        sum = 0u; cnt = 0u; mine = 0u;
#pragma unroll
        for (unsigned j = 0; j < 16; ++j) { const unsigned c = xb_ld(&bar[XB_XCNT(j)]); sum += c; cnt += (c > 0u) ? 1u : 0u; mine = (j == x) ? c : mine; }
        if (sum == G) break;
        __builtin_amdgcn_s_sleep(1);
        if ((++sp & 255u) == 0u) { if (xb_ld(&bar[XB_TMO])) break; if (sp > XB_SPIN_CAP) { atomicAdd(&bar[XB_TMO], 1u); break; } }
    }
    nloc = mine > 0u ? mine : 1u; nx = cnt > 0u ? cnt : 1u;
}
DI void xcd_barrier(const XcdBarrier& b) {
    asm volatile("s_waitcnt vmcnt(0)" ::: "memory");
    __syncthreads();
    if (threadIdx.x == 0) {
        unsigned* bar = b.bar;
        __builtin_amdgcn_s_waitcnt(0);
        unsigned nloc = b.st[0], nx = b.st[1];
        if (nloc == 0u) { xcd_barrier_complete(bar, b.x, nloc, nx); b.st[0] = nloc; b.st[1] = nx; }
        const unsigned old = xb_add(&bar[XB_XSUB(b.x)], 1u);
        const unsigned gen = old / nloc;
        if (old + 1u == (gen + 1u) * nloc) {
            __builtin_amdgcn_fence(__ATOMIC_RELEASE, "agent");
            asm volatile("s_waitcnt vmcnt(0)" ::: "memory");
            const unsigned og = xb_add(&bar[XB_TOP], 1u);
            const unsigned tg = og / nx;
            if (og + 1u == (tg + 1u) * nx) xb_add(&bar[XB_TOPGEN], 1u);
            else XB_SPIN(xb_ld(&bar[XB_TOPGEN]) == tg, bar);
            __builtin_amdgcn_fence(__ATOMIC_ACQUIRE, "agent");
            xb_add(&bar[XB_XGEN(b.x)], 1u);
            asm volatile("s_waitcnt vmcnt(0)" ::: "memory");
        } else {
            XB_SPIN(xb_ld(&bar[XB_XGEN(b.x)]) == gen, bar);
            __builtin_amdgcn_fence(__ATOMIC_ACQUIRE, "agent");
            asm volatile("s_waitcnt vmcnt(0)" ::: "memory");
        }
    }
    __syncthreads();
}

DI void run_phase(const Params& p, unsigned char* lds, int ph) {
    switch (ph) {
        case 0: phase0(p, lds); break;
        case 1: phase1(p, lds); break;
        case 2: phase15(p, lds); break;
        case 3: phase2(p, lds); break;
        case 4: phase3(p, lds); break;
        case 5: phase4(p, lds); break;
        default: phase5(p, lds); break;
    }
}

__global__ void __launch_bounds__(512) hybrid_fwd(Params p) {
    extern __shared__ __attribute__((aligned(16))) unsigned char lds[];
#if MULTI_LAUNCH
    run_phase(p, lds, p.phase_lo);
#else
    cg::grid_group grid = cg::this_grid();
    if (p.phase_lo == 77) grid.sync();
    volatile LAS unsigned* st = (volatile LAS unsigned*)(lds + LDS_ITEM + 16);
    if (threadIdx.x == 0) { st[0] = 0u; st[1] = 0u; }
    __syncthreads();
    XcdBarrier xb = xcd_barrier_post((unsigned*)(p.ws + OFF_XBAR), st);
    phase0(p, lds); xcd_barrier(xb);
    phase1(p, lds); xcd_barrier(xb);
    phase15(p, lds); xcd_barrier(xb);
    phase2(p, lds); xcd_barrier(xb);
    phase3(p, lds); xcd_barrier(xb);
    phase4(p, lds); xcd_barrier(xb);
    phase5(p, lds);
#endif
}

extern "C" void kernel_launch(void* const* d_in, const int* in_sizes, int n_in, void* d_out, int out_size, void* d_ws, size_t ws_size, hipStream_t stream) {
    static int grid = 0;
    if (grid == 0) {
        int dev = 0, cus = 0, per_cu = 0;
        hipGetDevice(&dev);
        hipDeviceGetAttribute(&cus, hipDeviceAttributeMultiprocessorCount, dev);
        hipFuncSetAttribute((const void*)hybrid_fwd, hipFuncAttributeMaxDynamicSharedMemorySize, LDS_BYTES);
        hipOccupancyMaxActiveBlocksPerMultiprocessor(&per_cu, (const void*)hybrid_fwd, 512, LDS_BYTES);
        if (per_cu < 1) per_cu = 1;
        if (per_cu > 1) per_cu = 1;
        if (cus <= 0) cus = 256;
        grid = cus * per_cu;
    }
    hipMemsetAsync((unsigned char*)d_ws + OFF_CTR, 0, 256, stream);
    hipMemsetAsync((unsigned char*)d_ws + OFF_XBAR, 0, 16384, stream);
    Params p{};
    p.x = (const float*)d_in[0]; p.meta = (const float*)d_in[1]; p.norm_w = (const float*)d_in[2]; p.w_in = (const float*)d_in[3];
    p.lq1 = (const float*)d_in[4]; p.lk1 = (const float*)d_in[5]; p.lq2 = (const float*)d_in[6]; p.lk2 = (const float*)d_in[7];
    p.subln_w = (const float*)d_in[8]; p.gate_w2 = (const float*)d_in[9]; p.gate_b = (const float*)d_in[10]; p.gla_norm_w = (const float*)d_in[11];
    p.wa = (const float*)d_in[12]; p.wb = (const float*)d_in[13]; p.wo = (const float*)d_in[14]; p.final_w = (const float*)d_in[15];
    p.out = (float*)d_out; p.ws = (unsigned char*)d_ws;
#if MULTI_LAUNCH
    for (int ph = 0; ph < 7; ++ph) {
        p.phase_lo = ph; p.phase_hi = ph + 1;
        hipLaunchKernelGGL(hybrid_fwd, dim3(grid), dim3(512), LDS_BYTES, stream, p);
    }
#else
    p.phase_lo = 0; p.phase_hi = 7;
    void* args[] = {&p};
    hipError_t e = hipLaunchCooperativeKernel((const void*)hybrid_fwd, dim3(grid), dim3(512), args, LDS_BYTES, stream);
    if (e != hipSuccess) fprintf(stderr, "cooperative launch failed: %s (grid %d)\n", hipGetErrorString(e), grid);
#endif
}
```

```cpp
#include <hip/hip_runtime.h>
#include <hip/hip_cooperative_groups.h>
#include <cstdio>
#include <cstdint>
namespace cg = cooperative_groups;

#ifndef MULTI_LAUNCH
#define MULTI_LAUNCH 0
#endif
#ifndef PROBE_REP
#define PROBE_REP 0
#endif

typedef unsigned short bf16_t;
typedef short bf16x8 __attribute__((ext_vector_type(8)));
typedef float f32x4 __attribute__((ext_vector_type(4)));
typedef float f32x2 __attribute__((ext_vector_type(2)));
typedef float f32x16 __attribute__((ext_vector_type(16)));
typedef unsigned u32x4 __attribute__((ext_vector_type(4)));
typedef unsigned u32x2 __attribute__((ext_vector_type(2)));
typedef __bf16 bfv2 __attribute__((ext_vector_type(2)));

#define DI __device__ __forceinline__
#define MFMA32(a, b, c) __builtin_amdgcn_mfma_f32_32x32x16_bf16((a), (b), (c), 0, 0, 0)
#define MFMA16(a, b, c) __builtin_amdgcn_mfma_f32_16x16x32_bf16((a), (b), (c), 0, 0, 0)

DI unsigned pk2(float a, float b) { f32x2 v = {a, b}; return __builtin_bit_cast(unsigned, __builtin_convertvector(v, bfv2)); }
DI float bf2f(bf16_t v) { return __uint_as_float(((unsigned)v) << 16); }
DI float bflo(unsigned u) { return __uint_as_float(u << 16); }
DI float bfhi(unsigned u) { return __uint_as_float(u & 0xffff0000u); }
DI bf16_t f2bf(float a) { return (bf16_t)(pk2(a, 0.f) & 0xffffu); }
DI float wave_sum(float v) {
#pragma unroll
    for (int o = 32; o; o >>= 1) v += __shfl_xor(v, o);
    return v;
}
DI float sigmoidf_(float z) { return 1.f / (1.f + __expf(-z)); }
DI float siluf_(float z) { return z / (1.f + __expf(-z)); }

constexpr int D = 1024, NB = 4, SEQ = 4096, MROWS = NB * SEQ;
constexpr int NIN = 9232, NINP = 9344;
constexpr float EPS = 1e-5f;

constexpr size_t SZ_ACT = (size_t)MROWS * 1024 * 2;
constexpr size_t OFF_WIN_T = 0;
constexpr size_t OFF_WA_T = OFF_WIN_T + (size_t)NINP * 1024 * 2;
constexpr size_t OFF_WB_T = OFF_WA_T + 2097152;
constexpr size_t OFF_WO_T = OFF_WB_T + 2097152;
constexpr size_t OFF_AK = OFF_WO_T + 2097152;
constexpr size_t OFF_AVT = OFF_AK + SZ_ACT;
constexpr size_t OFF_AZ = OFF_AVT + SZ_ACT;
constexpr size_t OFF_GVT = OFF_AZ + SZ_ACT;
constexpr size_t OFF_GZ = OFF_GVT + SZ_ACT;
constexpr size_t OFF_GA = OFF_GZ + SZ_ACT;
constexpr size_t OFF_GB = OFF_GA + SZ_ACT;
constexpr size_t OFF_GLR = OFF_GB + SZ_ACT;
constexpr size_t OFF_RSTD = OFF_GLR + (size_t)MROWS * 16 * 2;
constexpr size_t OFF_ROPE = OFF_RSTD + 65792;
constexpr size_t OFF_AKM = OFF_ROPE + 263168;
constexpr size_t OFF_AVTM = OFF_AKM + 131072;
constexpr size_t OFF_GVTM = OFF_AVTM + 131072;
constexpr size_t OFF_GKM = OFF_GVTM + 131072;
constexpr size_t OFF_GLRM = OFF_GKM + 16384;
constexpr size_t OFF_KTM = OFF_GLRM + 512;
constexpr size_t OFF_KTTM = OFF_KTM + 65536;
constexpr size_t OFF_DEC = OFF_KTTM + 65536;
constexpr size_t OFF_DECM = OFF_DEC + 524288;
constexpr size_t OFF_SSQB = OFF_DECM + 2048;
constexpr size_t OFF_SSQH = OFF_SSQB + 4194304;
constexpr size_t OFF_CTR = OFF_SSQH + 1048576;
constexpr size_t OFF_XBM = OFF_CTR + 256;
constexpr size_t OFF_XBAR = OFF_XBM + 32768;
constexpr size_t WS_END = OFF_XBAR + 16384;
constexpr size_t OFF_XB = OFF_GA;
constexpr size_t OFF_SGA = OFF_GB;
constexpr size_t OFF_SGB = OFF_GB + (size_t)MROWS * 1024;
static_assert(WS_END <= 268435456ull, "workspace over 256 MiB");
constexpr size_t DO_AQ = 0, DO_GQ = SZ_ACT, DO_GK = SZ_ACT + SZ_ACT / 2;

constexpr int G_ROWB = 144;
constexpr int G_SW = 128 * G_ROWB, G_SX = 256 * G_ROWB, G_STAGE = G_SW + G_SX;
constexpr int G_SW4 = 256 * G_ROWB, G_STAGE4 = G_SW4 + G_SX;
constexpr int LDS_SCALE = 2 * G_STAGE4;
constexpr int LDS_ITEM = LDS_SCALE + 4096;
constexpr int LDS_BYTES = LDS_ITEM + 64;

struct Params {
    const float *x, *meta, *norm_w, *w_in, *lq1, *lk1, *lq2, *lk2, *subln_w, *gate_w2, *gate_b, *gla_norm_w, *wa, *wb, *wo, *final_w;
    float* out;
    unsigned char* ws;
    int phase_lo, phase_hi;
};

template <int MODE>
DI void p0_transpose_item(const Params& p, int item, float* tile) {
    const int tid = threadIdx.x;
    const float* W = MODE == 0 ? p.w_in : MODE == 1 ? p.wa : MODE == 2 ? p.wb : p.wo;
    const int ldw = MODE == 0 ? NIN : 1024;
    const int nbc = MODE == 0 ? NINP / 64 : 16;
    bf16_t* WT = (bf16_t*)(p.ws + (MODE == 0 ? OFF_WIN_T : MODE == 1 ? OFF_WA_T : MODE == 2 ? OFF_WB_T : OFF_WO_T));
    const int kb = item / nbc, nb = item % nbc, k0 = kb * 64, n0 = nb * 64;
#pragma unroll
    for (int i = 0; i < 8; ++i) {
        const int kk = (tid >> 6) + 8 * i, nn = tid & 63, n = n0 + nn, k = k0 + kk;
        int src = n;
        if (MODE == 0) { src = n < 7168 ? n : (n < 9216 ? n + 16 : (n < 9232 ? n - 2048 : -1)); }
        float sc = 1.f;
        if (MODE == 0) sc = p.norm_w[k];
        if (MODE == 1) sc = 0.8f * p.subln_w[k & 127];
        if (MODE == 2) sc = p.gla_norm_w[k & 255];
        float v = 0.f;
        if (src >= 0) v = W[(size_t)k * ldw + src] * sc;
        tile[kk * 65 + nn] = v;
    }
    __syncthreads();
    {
        const int nn = tid >> 3, c = tid & 7;
        const float* s = tile + (8 * c) * 65 + nn;
        u32x4 o;
        o.x = pk2(s[0 * 65], s[1 * 65]); o.y = pk2(s[2 * 65], s[3 * 65]); o.z = pk2(s[4 * 65], s[5 * 65]); o.w = pk2(s[6 * 65], s[7 * 65]);
        *(u32x4*)(WT + (size_t)(n0 + nn) * 1024 + k0 + 8 * c) = o;
    }
    __syncthreads();
}

DI void phase0(const Params& p, unsigned char* lds) {
    const int tid = threadIdx.x, lane = tid & 63, wave = tid >> 6;
    float* tile = (float*)lds;
    constexpr int I_WIN = 16 * (NINP / 64), I_SQ = 256;
    constexpr int I_T = I_WIN + 3 * I_SQ;
    constexpr int I_RSTD = (MROWS + 16 + 7) / 8;
    constexpr int I_ROPE = (4112 * 8 + 511) / 512;
    constexpr int I_ZERO = 393216 / 8192;
    constexpr int I_ALL = I_T + I_RSTD + I_ROPE + I_ZERO;
    for (int it = blockIdx.x; it < I_ALL; it += gridDim.x) {
        int r = it;
        if (r < I_WIN) { p0_transpose_item<0>(p, r, tile); continue; } r -= I_WIN;
        if (r < I_SQ) { p0_transpose_item<1>(p, r, tile); continue; } r -= I_SQ;
        if (r < I_SQ) { p0_transpose_item<2>(p, r, tile); continue; } r -= I_SQ;
        if (r < I_SQ) { p0_transpose_item<3>(p, r, tile); continue; } r -= I_SQ;
        if (r < I_RSTD) {
            const int row = r * 8 + wave;
            if (row < MROWS + 16) {
                const float* src = row < MROWS ? p.x + (size_t)row * 1024 : p.meta + (size_t)(row - MROWS) * 1024;
                const f32x4* xr = (const f32x4*)src + lane;
                float s = 0.f;
#pragma unroll
                for (int j = 0; j < 4; ++j) { const f32x4 v = xr[64 * j]; s += (v.x * v.x + v.y * v.y) + (v.z * v.z + v.w * v.w); }
                s = wave_sum(s);
                if (lane == 0) ((float*)(p.ws + OFF_RSTD))[row] = 1.0f / sqrtf(s * (1.0f / 1024.0f) + EPS);
                bf16_t* xbrow = row < MROWS ? (bf16_t*)(p.ws + OFF_XB) + (size_t)row * 1024 : (bf16_t*)(p.ws + OFF_XBM) + (size_t)(row - MROWS) * 1024;
#pragma unroll
                for (int j = 0; j < 4; ++j) { const f32x4 v = xr[64 * j]; u32x2 o; o.x = pk2(v.x, v.y); o.y = pk2(v.z, v.w); *(u32x2*)(xbrow + 256 * j + 4 * lane) = o; }
            }
            continue;
        }
        r -= I_RSTD;
        if (r < I_ROPE) {
            const int e = r * 512 + tid;
            if (e < 4112 * 8) {
                const int pos = e >> 3, i = e & 7;
                const float inv = powf(500000.0f, -(float)i / 8.0f);
                const float ang = (float)pos * inv;
                float* t = (float*)(p.ws + OFF_ROPE) + (size_t)e * 2;
                t[0] = cosf(ang); t[1] = sinf(ang);
            }
            continue;
        }
        r -= I_ROPE;
        { u32x4 z = {0u, 0u, 0u, 0u}; *(u32x4*)(p.ws + OFF_AKM + (size_t)r * 8192 + tid * 16) = z; }
    }
}

template <int NI, bool HS>
DI void gemm_tile(f32x16 (&acc)[NI][2], const bf16_t* __restrict__ Wt, const bf16_t* __restrict__ X, unsigned char* lds, const float (&hs)[2][3]) {
    const int tid = threadIdx.x, lane = tid & 63, wave = tid >> 6, l31 = lane & 31, h = lane >> 5;
    const int wn = wave & 1, wm = wave >> 1;
    constexpr int SW = NI * 64 * G_ROWB, STAGE = SW + G_SX;
    u32x4 wreg[NI];
    u32x4 xreg[4];
    const int prow = tid >> 3, pc = tid & 7;
    const bf16_t* wp = Wt + (size_t)prow * 1024 + pc * 8;
    const bf16_t* xp = X + (size_t)prow * 1024 + pc * 8;
#define G_LOAD(kt_)                                                                                                  \
    {                                                                                                                \
        _Pragma("unroll") for (int i = 0; i < NI; ++i) wreg[i] = *(const u32x4*)(wp + (size_t)i * 64 * 1024 + (kt_) * 64); \
        _Pragma("unroll") for (int i = 0; i < 4; ++i) xreg[i] = *(const u32x4*)(xp + (size_t)i * 64 * 1024 + (kt_) * 64);  \
    }
#define G_STORE(buf_)                                                                                                \
    {                                                                                                                \
        unsigned char* sW_ = lds + (buf_) * STAGE + prow * G_ROWB + pc * 16; unsigned char* sX_ = sW_ + SW;          \
        _Pragma("unroll") for (int i = 0; i < NI; ++i) *(u32x4*)(sW_ + i * 64 * G_ROWB) = wreg[i];                   \
        _Pragma("unroll") for (int i = 0; i < 4; ++i) *(u32x4*)(sX_ + i * 64 * G_ROWB) = xreg[i];                    \
    }
    G_LOAD(0);
    G_STORE(0);
    __syncthreads();
    for (int kt = 0; kt < 16; ++kt) {
        if (kt + 1 < 16) G_LOAD(kt + 1);
        if (HS) {
            if (kt == 4 || kt == 8 || kt == 12) {
                const float s0 = kt == 4 ? hs[0][0] : (kt == 8 ? hs[0][1] : hs[0][2]);
                const float s1 = kt == 4 ? hs[1][0] : (kt == 8 ? hs[1][1] : hs[1][2]);
#pragma unroll
                for (int n = 0; n < NI; ++n)
#pragma unroll
                    for (int i = 0; i < 16; ++i) { acc[n][0][i] *= s0; acc[n][1][i] *= s1; }
            }
        }
        {
            const unsigned char* sW = lds + (kt & 1) * STAGE + (wn * NI * 32 + l31) * G_ROWB + h * 16;
            const unsigned char* sX = lds + (kt & 1) * STAGE + SW + (wm * 64 + l31) * G_ROWB + h * 16;
#pragma unroll
            for (int ks = 0; ks < 4; ++ks) {
                const bf16x8 x0 = *(const bf16x8*)(sX + ks * 32), x1 = *(const bf16x8*)(sX + 32 * G_ROWB + ks * 32);
#pragma unroll
                for (int n = 0; n < NI; ++n) {
                    const bf16x8 w = *(const bf16x8*)(sW + n * 32 * G_ROWB + ks * 32);
                    acc[n][0] = MFMA32(w, x0, acc[n][0]); acc[n][1] = MFMA32(w, x1, acc[n][1]);
                }
            }
        }
        if (kt + 1 < 16) G_STORE((kt + 1) & 1);
        __syncthreads();
    }
#undef G_LOAD
#undef G_STORE
}

template <int NI>
DI void zero_acc(f32x16 (&acc)[NI][2]) {
#pragma unroll
    for (int a = 0; a < NI; ++a)
#pragma unroll
        for (int b = 0; b < 2; ++b)
#pragma unroll
            for (int i = 0; i < 16; ++i) acc[a][b][i] = 0.f;
}

DI unsigned sig_u8(float z) { return (unsigned)(255.0f / (1.0f + __expf(-z)) + 0.5f); }
DI void p1_epilogue(const Params& p, f32x16 (&acc)[4][2], int mt, int nt) {
    const int tid = threadIdx.x, lane = tid & 63, wave = tid >> 6, l31 = lane & 31, h = lane >> 5;
    const int wn = wave & 1, wm = wave >> 1;
    int split, nc0;
    if (nt < 4) { split = 0; nc0 = nt * 256; }
    else if (nt < 8) { split = 1; nc0 = (nt - 4) * 256; }
    else if (nt < 12) { split = 2; nc0 = (nt - 8) * 256; }
    else if (nt < 16) { split = 3; nc0 = (nt - 12) * 256; }
    else if (nt < 18) { split = 4; nc0 = (nt - 16) * 256; }
    else if (nt < 20) { split = 5; nc0 = (nt - 18) * 256; }
    else if (nt < 24) { split = 6; nc0 = (nt - 20) * 256; }
    else if (nt < 28) { split = 7; nc0 = (nt - 24) * 256; }
    else if (nt < 32) { split = 9; nc0 = (nt - 28) * 256; }
    else { split = 10; nc0 = (nt - 32) * 256; }
    const float* rstd = (const float*)(p.ws + OFF_RSTD);
    const float* rope = (const float*)(p.ws + OFF_ROPE);
    unsigned char* ws = p.ws;
    unsigned char* dout = (unsigned char*)p.out;
#pragma unroll
    for (int im = 0; im < 2; ++im) {
        const int tok = mt * 256 + wm * 64 + im * 32 + l31;
        const float rs = rstd[tok];
        const int pos = 16 + (tok & 4095);
        const int b = tok >> 12, s = tok & 4095;
#pragma unroll
        for (int in = 0; in < 4; ++in) {
            const int nb = nc0 + wn * 128 + in * 32;
            float v[16];
#pragma unroll
            for (int i = 0; i < 16; ++i) v[i] = acc[in][im][i] * rs;
            if (split <= 1 && (nb & 63) == 0) {
                const float* cs = rope + ((size_t)pos * 8 + 4 * h) * 2;
#pragma unroll
                for (int i = 0; i < 4; ++i) {
                    const float c = cs[2 * i], sn = cs[2 * i + 1];
                    const float x1 = v[i], x2 = v[i + 4];
                    v[i] = x1 * c - x2 * sn; v[i + 4] = x2 * c + x1 * sn;
                }
            }
            if (split == 2 || split == 6) {
                const int hshift = split == 2 ? 7 : 8;
                const int nheads = split == 2 ? 8 : 4;
                const int dvn = 1 << hshift;
                bf16_t* base = (bf16_t*)(ws + (split == 2 ? OFF_AVT : OFF_GVT));
#pragma unroll
                for (int i = 0; i < 16; ++i) {
                    const int n = nb + (i & 3) + 8 * (i >> 2) + 4 * h;
                    const int hd = n >> hshift, dv = n & (dvn - 1);
                    base[((size_t)(b * nheads + hd) * dvn + dv) * 4096 + s] = f2bf(v[i]);
                }
            } else if (split >= 9) {
                unsigned char* dst = ws + (split == 9 ? OFF_SGA : OFF_SGB) + (size_t)tok * 1024 + nb + 4 * h;
#pragma unroll
                for (int g = 0; g < 4; ++g) {
                    const unsigned o = sig_u8(v[4 * g]) | (sig_u8(v[4 * g + 1]) << 8) | (sig_u8(v[4 * g + 2]) << 16) | (sig_u8(v[4 * g + 3]) << 24);
                    *(unsigned*)(dst + 8 * g) = o;
                }
            } else {
                bf16_t* dst; int ld;
                switch (split) {
                    case 0: dst = (bf16_t*)(dout + DO_AQ); ld = 1024; break;
                    case 1: dst = (bf16_t*)(ws + OFF_AK); ld = 1024; break;
                    case 3: dst = (bf16_t*)(ws + OFF_AZ); ld = 1024; break;
                    case 4: dst = (bf16_t*)(dout + DO_GQ); ld = 512; break;
                    case 5: dst = (bf16_t*)(dout + DO_GK); ld = 512; break;
                    default: dst = (bf16_t*)(ws + OFF_GZ); ld = 1024; break;
                }
#pragma unroll
                for (int g = 0; g < 4; ++g) {
                    u32x2 o; o.x = pk2(v[4 * g], v[4 * g + 1]); o.y = pk2(v[4 * g + 2], v[4 * g + 3]);
                    *(u32x2*)(dst + (size_t)tok * ld + nb + 8 * g + 4 * h) = o;
                }
            }
        }
    }
}

DI void p1_glr_job(const Params& p, unsigned char* lds, int job) {
    const int tid = threadIdx.x, lane = tid & 63, wave = tid >> 6, l15 = lane & 15, g = lane >> 4;
    const int rtile = wave & 3, khalf = wave >> 2;
    const bf16_t* xb = (const bf16_t*)(p.ws + OFF_XB);
    const bf16_t* wt = (const bf16_t*)(p.ws + OFF_WIN_T) + (size_t)9216 * 1024;
    const size_t row0 = (size_t)job * 64 + rtile * 16;
    const bf16_t* ap = xb + (row0 + l15) * 1024 + khalf * 512 + 8 * g;
    const bf16_t* bp = wt + (size_t)l15 * 1024 + khalf * 512 + 8 * g;
    f32x4 acc = (f32x4){0.f, 0.f, 0.f, 0.f};
#pragma unroll 4
    for (int ks = 0; ks < 16; ++ks) {
        const bf16x8 a = *(const bf16x8*)(ap + ks * 32), bb = *(const bf16x8*)(bp + ks * 32);
        acc = MFMA16(a, bb, acc);
    }
    f32x4* red = (f32x4*)lds;
    __syncthreads();
    if (khalf == 1) red[rtile * 64 + lane] = acc;
    __syncthreads();
    if (khalf == 0) {
        const f32x4 o = red[rtile * 64 + lane];
        const float* rstd = (const float*)(p.ws + OFF_RSTD);
        bf16_t* glr = (bf16_t*)(p.ws + OFF_GLR);
#pragma unroll
        for (int i = 0; i < 4; ++i) {
            const size_t row = row0 + 4 * g + i;
            glr[row * 16 + l15] = f2bf((acc[i] + o[i]) * rstd[row]);
        }
    }
    __syncthreads();
}

DI void p1_meta_job(const Params& p, unsigned char* lds, int job) {
    const int tid = threadIdx.x, lane = tid & 63, wave = tid >> 6, l15 = lane & 15, g = lane >> 4;
    int c0;
    if (job < 64) c0 = 1024 + job * 16;
    else if (job < 128) c0 = 2048 + (job - 64) * 16;
    else if (job < 160) c0 = 4608 + (job - 128) * 16;
    else if (job < 224) c0 = 5120 + (job - 160) * 16;
    else c0 = 9216;
    const bf16_t* xbm = (const bf16_t*)(p.ws + OFF_XBM);
    const bf16_t* wt = (const bf16_t*)(p.ws + OFF_WIN_T);
    const bf16_t* ap = xbm + (size_t)l15 * 1024 + wave * 128 + 8 * g;
    const bf16_t* bp = wt + (size_t)(c0 + l15) * 1024 + wave * 128 + 8 * g;
    f32x4 acc = (f32x4){0.f, 0.f, 0.f, 0.f};
#pragma unroll
    for (int ks = 0; ks < 4; ++ks) {
        const bf16x8 a = *(const bf16x8*)(ap + ks * 32), bb = *(const bf16x8*)(bp + ks * 32);
        acc = MFMA16(a, bb, acc);
    }
    f32x4* red = (f32x4*)lds;
    __syncthreads();
    red[wave * 64 + lane] = acc;
    __syncthreads();
    if (wave == 0) {
        f32x4 s = red[lane];
#pragma unroll
        for (int w = 1; w < 8; ++w) { const f32x4 t = red[w * 64 + lane]; s.x += t.x; s.y += t.y; s.z += t.z; s.w += t.w; }
        const float* rstd = (const float*)(p.ws + OFF_RSTD) + MROWS;
        const float* rope = (const float*)(p.ws + OFF_ROPE);
        unsigned char* ws = p.ws;
        const int col = c0 + l15;
#pragma unroll
        for (int i = 0; i < 4; ++i) {
            const int row = 4 * g + i;
            float v = s[i] * rstd[row];
            if (job < 64 && (c0 & 63) == 0) {
                const float other = __shfl_xor(v, 8);
                const float* cs = rope + ((size_t)row * 8 + (l15 & 7)) * 2;
                const float c = cs[0], sn = cs[1];
                v = (l15 < 8) ? (v * c - other * sn) : (v * c + other * sn);
            }
            const bf16_t val = f2bf(v);
            if (job < 64) ((bf16_t*)(ws + OFF_AKM))[(size_t)(48 + row) * 1024 + (col - 1024)] = val;
            else if (job < 128) { const int n = col - 2048; ((bf16_t*)(ws + OFF_AVTM))[(size_t)n * 64 + 48 + row] = val; }
            else if (job < 160) ((bf16_t*)(ws + OFF_GKM))[(size_t)row * 512 + (col - 4608)] = val;
            else if (job < 224) { const int n = col - 5120; ((bf16_t*)(ws + OFF_GVTM))[(size_t)n * 64 + 48 + row] = val; }
            else ((bf16_t*)(ws + OFF_GLRM))[row * 16 + l15] = val;
        }
    }
    __syncthreads();
}

DI void phase1(const Params& p, unsigned char* lds) {
    for (int j = blockIdx.x; j < 256; j += gridDim.x) p1_glr_job(p, lds, j);
    for (int j = blockIdx.x; j < 225; j += gridDim.x) p1_meta_job(p, lds, j);
    constexpr int NT = 36, TOTAL = 64 * NT;
    const bf16_t* wt = (const bf16_t*)(p.ws + OFF_WIN_T);
    const bf16_t* xb = (const bf16_t*)(p.ws + OFF_XB);
    const float hs0[2][3] = {{1.f, 1.f, 1.f}, {1.f, 1.f, 1.f}};
    for (int id = blockIdx.x; id < TOTAL; id += gridDim.x) {
        int mt, nt;
        {
            const int g = id / (16 * NT), rem = id % (16 * NT), reg = rem >> 8, w = rem & 255, x = w & 7, j = w >> 3;
            const int mo = 4 * (x & 3) + (j & 3), no = 8 * (x >> 2) + (j >> 2);
            nt = reg * 16 + no; mt = g * 16 + mo;
            if (reg == 2) { const int e = rem - 512; nt = 32 + (e >> 4); mt = g * 16 + (e & 15); }
        }
        f32x16 acc[4][2];
        zero_acc<4>(acc);
        gemm_tile<4, false>(acc, wt + (size_t)nt * 256 * 1024, xb + (size_t)mt * 256 * 1024, lds, hs0);
        p1_epilogue(p, acc, mt, nt);
    }
}

DI void phase15(const Params& p, unsigned char* lds) {
    const int tid = threadIdx.x, col = tid;
    float w2[16];
#pragma unroll
    for (int j = 0; j < 16; ++j) w2[j] = p.gate_w2[j * 512 + col];
    const float bias = p.gate_b[col];
    unsigned char* ws = p.ws;
    unsigned char* dout = (unsigned char*)p.out;
    for (int item = blockIdx.x; item < 257; item += gridDim.x) {
        const bool meta = item == 256;
        const int b = item >> 6, c = item & 63;
        const size_t row0 = (size_t)b * 4096 + c * 64;
        const bf16_t* glr = meta ? (const bf16_t*)(ws + OFF_GLRM) : (const bf16_t*)(ws + OFF_GLR) + row0 * 16;
        const int nrows = meta ? 16 : 64;
        bf16_t* qp = (bf16_t*)(dout + DO_GQ) + row0 * 512 + col;
        const bf16_t* kin = meta ? (const bf16_t*)(ws + OFF_GKM) + col : (const bf16_t*)(dout + DO_GK) + row0 * 512 + col;
        bf16_t* kout = meta ? (bf16_t*)(ws + OFF_KTM) + 48 * 512 + col : (bf16_t*)(dout + DO_GK) + row0 * 512 + col;
        bf16_t* ktt = meta ? (bf16_t*)(ws + OFF_KTTM) + (size_t)col * 64 + 48 : (bf16_t*)(ws + OFF_WIN_T) + ((size_t)b * 512 + col) * 4096 + c * 64;
        __syncthreads();
        if (tid < nrows * 2) ((u32x4*)lds)[tid] = ((const u32x4*)glr)[tid];
        __syncthreads();
        float bsum = 0.f;
        bf16_t kc[8], qc[8], kn[8], qn[8];
#pragma unroll
        for (int rr = 0; rr < 8; ++rr) { kc[rr] = kin[(size_t)rr * 512]; qc[rr] = meta ? (bf16_t)0 : qp[(size_t)rr * 512]; }
        for (int r0 = 0; r0 < nrows; r0 += 8) {
            if (r0 + 8 < nrows) {
#pragma unroll
                for (int rr = 0; rr < 8; ++rr) { kn[rr] = kin[(size_t)(r0 + 8 + rr) * 512]; qn[rr] = meta ? (bf16_t)0 : qp[(size_t)(r0 + 8 + rr) * 512]; }
            }
            float kt8[8];
#pragma unroll
            for (int rr = 0; rr < 8; ++rr) {
                const int r = r0 + rr;
                const u32x4* g4 = (const u32x4*)(lds + r * 32);
                const u32x4 ga = g4[0], gb = g4[1];
                float gk = bias;
                gk += bflo(ga.x) * w2[0] + bfhi(ga.x) * w2[1] + bflo(ga.y) * w2[2] + bfhi(ga.y) * w2[3];
                gk += bflo(ga.z) * w2[4] + bfhi(ga.z) * w2[5] + bflo(ga.w) * w2[6] + bfhi(ga.w) * w2[7];
                gk += bflo(gb.x) * w2[8] + bfhi(gb.x) * w2[9] + bflo(gb.y) * w2[10] + bfhi(gb.y) * w2[11];
                gk += bflo(gb.z) * w2[12] + bfhi(gb.z) * w2[13] + bflo(gb.w) * w2[14] + bfhi(gb.w) * w2[15];
                const float lg = (fminf(gk, 0.f) - log1pf(expf(-fabsf(gk)))) * (1.0f / 16.0f);
                bsum += lg;
                const float kt = bf2f(kc[rr]) * expf(-bsum);
                kt8[rr] = kt;
                kout[(size_t)r * 512] = f2bf(kt);
                if (!meta) qp[(size_t)r * 512] = f2bf(bf2f(qc[rr]) * 0.08838834764831845f * expf(bsum));
            }
            u32x4 o; o.x = pk2(kt8[0], kt8[1]); o.y = pk2(kt8[2], kt8[3]); o.z = pk2(kt8[4], kt8[5]); o.w = pk2(kt8[6], kt8[7]);
            *(u32x4*)(ktt + r0) = o;
#pragma unroll
            for (int rr = 0; rr < 8; ++rr) { kc[rr] = kn[rr]; qc[rr] = qn[rr]; }
        }
        if (meta) {
            ((float*)(ws + OFF_DECM))[col] = expf(bsum);
            bf16_t* km = (bf16_t*)(ws + OFF_KTM);
            for (int r = 0; r < 48; ++r) km[r * 512 + col] = 0;
            u32x4 z = {0u, 0u, 0u, 0u};
            u32x4* kz = (u32x4*)((bf16_t*)(ws + OFF_KTTM) + (size_t)col * 64);
#pragma unroll
            for (int j = 0; j < 6; ++j) kz[j] = z;
        } else {
            ((float*)(ws + OFF_DEC))[((size_t)b * 64 + c) * 512 + col] = expf(bsum);
        }
    }
}

constexpr int A_KROWB = 272, A_VROWB = 136, A_KB = 64 * A_KROWB, A_VB = 128 * A_VROWB, A_STAGE = A_KB + A_VB;
DI void attn_tile(const unsigned char* sK, const unsigned char* sV, int tt, int qb, int qs, int sub, int l31, int h,
                  const bf16x8 (&qf)[4], f32x16 (&O)[4], float& m, float& l) {
    const float SC = 0.125f * 1.4426950408889634f;
    f32x16 st[2];
#pragma unroll
    for (int k2 = 0; k2 < 2; ++k2)
#pragma unroll
        for (int i = 0; i < 16; ++i) st[k2][i] = 0.f;
#pragma unroll
    for (int k2 = 0; k2 < 2; ++k2)
#pragma unroll
        for (int ks = 0; ks < 4; ++ks) {
            const bf16x8 kf = *(const bf16x8*)(sK + (k2 * 32 + l31) * A_KROWB + (sub * 64 + ks * 16 + 8 * h) * 2);
            st[k2] = MFMA32(kf, qf[ks], st[k2]);
        }
    if (tt == 0) {
#pragma unroll
        for (int i = 0; i < 16; ++i) { st[0][i] = -INFINITY; if (i < 8) st[1][i] = -INFINITY; }
    } else if (tt >= 2 * qb + 1) {
        const int kbase = (tt - 1) * 64 + 4 * h;
#pragma unroll
        for (int k2 = 0; k2 < 2; ++k2)
#pragma unroll
            for (int i = 0; i < 16; ++i) {
                const int key = kbase + k2 * 32 + (i & 3) + 8 * (i >> 2);
                if (key > qs) st[k2][i] = -INFINITY;
            }
    }
    float mx = -INFINITY;
#pragma unroll
    for (int k2 = 0; k2 < 2; ++k2)
#pragma unroll
        for (int i = 0; i < 16; ++i) mx = fmaxf(mx, st[k2][i]);
    mx = fmaxf(mx, __shfl_xor(mx, 32));
    const float mnew = fmaxf(m, mx);
    const float alpha = __builtin_amdgcn_exp2f((m - mnew) * SC);
    const float mc = mnew * SC;
    m = mnew;
    float ps = 0.f;
#pragma unroll
    for (int k2 = 0; k2 < 2; ++k2)
#pragma unroll
        for (int i = 0; i < 16; ++i) { const float pv = __builtin_amdgcn_exp2f(st[k2][i] * SC - mc); st[k2][i] = pv; ps += pv; }
    l = l * alpha + ps;
#pragma unroll
    for (int d = 0; d < 4; ++d)
#pragma unroll
        for (int i = 0; i < 16; ++i) O[d][i] *= alpha;
    bf16x8 pb[4];
#pragma unroll
    for (int k4 = 0; k4 < 4; ++k4) {
        const int k2 = k4 >> 1, o8 = 8 * (k4 & 1);
        u32x4 pk;
        pk.x = pk2(st[k2][o8 + 0], st[k2][o8 + 1]); pk.y = pk2(st[k2][o8 + 2], st[k2][o8 + 3]);
        pk.z = pk2(st[k2][o8 + 4], st[k2][o8 + 5]); pk.w = pk2(st[k2][o8 + 6], st[k2][o8 + 7]);
        pb[k4] = __builtin_bit_cast(bf16x8, pk);
    }
#pragma unroll
    for (int d = 0; d < 4; ++d)
#pragma unroll
        for (int k4 = 0; k4 < 4; ++k4) {
            const unsigned char* vp = sV + (d * 32 + l31) * A_VROWB + (k4 * 16 + 4 * h) * 2;
            const u32x2 lo = *(const u32x2*)vp, hi = *(const u32x2*)(vp + 16);
            u32x4 vv; vv.x = lo.x; vv.y = lo.y; vv.z = hi.x; vv.w = hi.y;
            O[d] = MFMA32(__builtin_bit_cast(bf16x8, vv), pb[k4], O[d]);
        }
}

DI void attn_item(const Params& p, unsigned char* lds, int b, int hd, int qb) {
    const int tid = threadIdx.x, lane = tid & 63, wave = tid >> 6, l31 = lane & 31, h = lane >> 5;
    const int sub = wave >> 2, rt = wave & 3;
    const bf16_t* aq = (const bf16_t*)((unsigned char*)p.out + DO_AQ);
    const bf16_t* ak = (const bf16_t*)(p.ws + OFF_AK);
    const bf16_t* avT = (const bf16_t*)(p.ws + OFF_AVT);
    const bf16_t* akm = (const bf16_t*)(p.ws + OFF_AKM);
    const bf16_t* avTm = (const bf16_t*)(p.ws + OFF_AVTM);
    bf16_t* az = (bf16_t*)(p.ws + OFF_AZ);
    const int qs = qb * 128 + rt * 32 + l31;
    const size_t grow = (size_t)b * 4096 + qs;
    bf16x8 qf[4];
#pragma unroll
    for (int ks = 0; ks < 4; ++ks) qf[ks] = *(const bf16x8*)(aq + grow * 1024 + hd * 128 + sub * 64 + ks * 16 + 8 * h);
    f32x16 O[4];
#pragma unroll
    for (int d = 0; d < 4; ++d)
#pragma unroll
        for (int i = 0; i < 16; ++i) O[d][i] = 0.f;
    float m = -INFINITY, l = 0.f;
    const int T = 2 * qb + 3;
    u32x4 k0r[2], v0r[2];
    const int krow_ = tid >> 4, kc_ = tid & 15, vdv_ = tid >> 3, vc_ = tid & 7;
    const bf16_t* kp = ak + ((size_t)b * 4096 + krow_) * 1024 + hd * 128 + kc_ * 8;
    const bf16_t* vp_ = avT + ((size_t)(b * 8 + hd) * 128 + vdv_) * 4096 + vc_ * 8;
#define A_LOAD_REAL(KR, VR)                                                                                                   \
    {                                                                                                                         \
        KR[0] = *(const u32x4*)kp; KR[1] = *(const u32x4*)(kp + 32 * 1024); kp += 64 * 1024;                                  \
        VR[0] = *(const u32x4*)vp_; VR[1] = *(const u32x4*)(vp_ + (size_t)64 * 4096); vp_ += 64;                              \
    }
#define A_STORE(KR, VR, buf_)                                                                                                 \
    {                                                                                                                         \
        unsigned char* sK_ = lds + (buf_) * A_STAGE; unsigned char* sV_ = sK_ + A_KB;                                         \
        _Pragma("unroll") for (int i = 0; i < 2; ++i) { const int pi = tid + 512 * i, row = pi >> 4, c = pi & 15;              \
            *(u32x4*)(sK_ + row * A_KROWB + c * 16) = KR[i]; }                                                                \
        _Pragma("unroll") for (int i = 0; i < 2; ++i) { const int pi = tid + 512 * i, dv = pi >> 3, c = pi & 7;                \
            unsigned char* d_ = sV_ + dv * A_VROWB + c * 16; u32x2 a_, b_; a_.x = VR[i].x; a_.y = VR[i].y; b_.x = VR[i].z; b_.y = VR[i].w; \
            *(u32x2*)d_ = a_; *(u32x2*)(d_ + 8) = b_; }                                                                       \
    }
    {
        const bf16_t* km_ = akm + (size_t)krow_ * 1024 + hd * 128 + kc_ * 8;
        k0r[0] = *(const u32x4*)km_; k0r[1] = *(const u32x4*)(km_ + 32 * 1024);
        const bf16_t* vm_ = avTm + (size_t)(hd * 128 + vdv_) * 64 + vc_ * 8;
        v0r[0] = *(const u32x4*)vm_; v0r[1] = *(const u32x4*)(vm_ + 64 * 64);
    }
    A_STORE(k0r, v0r, 0);
    __syncthreads();
    for (int tt = 0; tt < T; ++tt) {
        if (tt + 1 < T) A_LOAD_REAL(k0r, v0r);
        attn_tile(lds + (tt & 1) * A_STAGE, lds + (tt & 1) * A_STAGE + A_KB, tt, qb, qs, sub, l31, h, qf, O, m, l);
        if (tt + 1 < T) A_STORE(k0r, v0r, (tt + 1) & 1);
        __syncthreads();
    }
#undef A_LOAD_REAL
#undef A_STORE
    float lam;
    {
        const float a_ = wave_sum(p.lq1[lane] * p.lk1[lane]);
        const float b_ = wave_sum(p.lq2[lane] * p.lk2[lane]);
        lam = expf(a_) - expf(b_) + 0.2f;
    }
    const float ltot = l + __shfl_xor(l, 32);
    const float linv = 1.0f / ltot;
    float* ex = (float*)lds;
    if (sub == 1) {
#pragma unroll
        for (int d = 0; d < 4; ++d)
#pragma unroll
            for (int i = 0; i < 16; ++i) { ex[(rt * 32 + l31) * 129 + d * 32 + (i & 3) + 8 * (i >> 2) + 4 * h] = O[d][i] * linv; if (i == 15) __builtin_amdgcn_sched_barrier(0); }
    }
    __syncthreads();
    if (sub == 0) {
        float ss = 0.f;
#pragma unroll
        for (int d = 0; d < 4; ++d)
#pragma unroll
            for (int i = 0; i < 16; ++i) {
                const float o2 = ex[(rt * 32 + l31) * 129 + d * 32 + (i & 3) + 8 * (i >> 2) + 4 * h];
                const float o = O[d][i] * linv - lam * o2;
                O[d][i] = o; ss += o * o;
                if (i == 15) __builtin_amdgcn_sched_barrier(0);
            }
        ss += __shfl_xor(ss, 32);
        const float rstd = 1.0f / sqrtf(ss * (1.0f / 128.0f) + EPS);
#pragma unroll
        for (int d = 0; d < 4; ++d)
#pragma unroll
            for (int g = 0; g < 4; ++g) {
                bf16_t* zp = az + grow * 1024 + hd * 128 + d * 32 + 8 * g + 4 * h;
                const u32x2 zz = *(const u32x2*)zp;
                u32x2 o;
                o.x = pk2(O[d][4 * g] * rstd * siluf_(bflo(zz.x)), O[d][4 * g + 1] * rstd * siluf_(bfhi(zz.x)));
                o.y = pk2(O[d][4 * g + 2] * rstd * siluf_(bflo(zz.y)), O[d][4 * g + 3] * rstd * siluf_(bfhi(zz.y)));
                *(u32x2*)zp = o;
                if (g == 3) __builtin_amdgcn_sched_barrier(0);
            }
    }
    __syncthreads();
}

constexpr int L_KROWB = 272, L_VROWB = 144, L_SROWB = 272;
constexpr int L_K = 0, L_V = 64 * L_KROWB, L_S = L_V + 32 * L_VROWB, L_END = L_S + 32 * L_SROWB;
DI void gla_item(const Params& p, unsigned char* lds, int b, int hh, int sl) {
    const int tid = threadIdx.x, lane = tid & 63, wave = tid >> 6, l15 = lane & 15, g = lane >> 4;
    const int tt = wave & 3, dvt = wave >> 2;
    unsigned char* ws = p.ws;
    unsigned char* dout = (unsigned char*)p.out;
    const bf16_t* gq = (const bf16_t*)(dout + DO_GQ);
    const bf16_t* gk = (const bf16_t*)(dout + DO_GK);
    const bf16_t* gvT = (const bf16_t*)(ws + OFF_GVT);
    const bf16_t* ktt = (const bf16_t*)(ws + OFF_WIN_T);
    const float* dec = (const float*)(ws + OFF_DEC);
    bf16_t* gz = (bf16_t*)(ws + OFF_GZ);
    float* ssqb = (float*)(ws + OFF_SSQB);
    unsigned char* sK = lds + L_K; unsigned char* sV = lds + L_V; unsigned char* sS = lds + L_S;
    for (int i = tid; i < 32 * L_SROWB / 4; i += 512) ((unsigned*)sS)[i] = 0u;
    f32x4 sacc[2];
#pragma unroll
    for (int c = 0; c < 2; ++c) sacc[c] = (f32x4){0.f, 0.f, 0.f, 0.f};
    u32x4 nk[2]; u32x4 nv; bf16x8 nq[4]; bf16x8 nkt[2][2]; float nd[2]; u32x2 ngz;
    const int cc0 = 16 * (2 * tt) + l15;
    const int krow_ = tid >> 4, kc_ = tid & 15, vdv_ = (tid >> 3) & 31, vc_ = tid & 7;
    const bf16_t* kp = gk + ((size_t)b * 4096 + krow_) * 512 + hh * 128 + kc_ * 8;
    const bf16_t* vp_ = gvT + ((size_t)(b * 4 + hh) * 256 + sl * 32 + vdv_) * 4096 + vc_ * 8;
    const bf16_t* ktp = ktt + ((size_t)(b * 4 + hh) * 128 + cc0) * 4096 + 8 * g;
    const float* dp = dec + (size_t)b * 64 * 512 + hh * 128 + cc0;
    const bf16_t* qp = gq + ((size_t)b * 4096 + 16 * tt + l15) * 512 + hh * 128 + 8 * g;
    bf16_t* gzp = gz + ((size_t)b * 4096 + 16 * tt + l15) * 1024 + hh * 256 + sl * 32 + 16 * dvt + 4 * g;
#define L_LOAD_META()                                                                                                         \
    {                                                                                                                         \
        const bf16_t* km_ = (const bf16_t*)(ws + OFF_KTM) + (size_t)krow_ * 512 + hh * 128 + kc_ * 8;                         \
        nk[0] = *(const u32x4*)km_; nk[1] = *(const u32x4*)(km_ + 32 * 512);                                                  \
        nv = *(const u32x4*)((const bf16_t*)(ws + OFF_GVTM) + (size_t)(hh * 256 + sl * 32 + vdv_) * 64 + vc_ * 8);            \
        _Pragma("unroll") for (int ct = 0; ct < 2; ++ct) _Pragma("unroll") for (int ks = 0; ks < 2; ++ks)                     \
            nkt[ct][ks] = *(const bf16x8*)((const bf16_t*)(ws + OFF_KTTM) + (size_t)(hh * 128 + cc0 + 16 * ct) * 64 + 32 * ks + 8 * g); \
        _Pragma("unroll") for (int ct = 0; ct < 2; ++ct) nd[ct] = ((const float*)(ws + OFF_DECM))[hh * 128 + cc0 + 16 * ct];  \
        _Pragma("unroll") for (int ks = 0; ks < 4; ++ks) nq[ks] = (bf16x8){0, 0, 0, 0, 0, 0, 0, 0};                           \
        ngz = (u32x2){0u, 0u};                                                                                                \
    }
#define L_LOAD_REAL()                                                                                                         \
    {                                                                                                                         \
        nk[0] = *(const u32x4*)kp; nk[1] = *(const u32x4*)(kp + 32 * 512); kp += 64 * 512;                                    \
        nv = *(const u32x4*)vp_; vp_ += 64;                                                                                   \
        _Pragma("unroll") for (int ct = 0; ct < 2; ++ct) _Pragma("unroll") for (int ks = 0; ks < 2; ++ks)                     \
            nkt[ct][ks] = *(const bf16x8*)(ktp + (size_t)(16 * ct) * 4096 + 32 * ks);                                         \
        ktp += 64;                                                                                                            \
        nd[0] = dp[0]; nd[1] = dp[16]; dp += 512;                                                                             \
        _Pragma("unroll") for (int ks = 0; ks < 4; ++ks) nq[ks] = *(const bf16x8*)(qp + 32 * ks);                             \
        qp += 64 * 512;                                                                                                       \
        ngz = *(const u32x2*)gzp; gzp += 64 * 1024;                                                                           \
    }
#define L_STORE()                                                                                                             \
    {                                                                                                                         \
        _Pragma("unroll") for (int i = 0; i < 2; ++i) { const int pi = tid + 512 * i, row = pi >> 4, c = pi & 15;              \
            *(u32x4*)(sK + row * L_KROWB + c * 16) = nk[i]; }                                                                 \
        if (tid < 256) { const int dv = tid >> 3, c = tid & 7; *(u32x4*)(sV + dv * L_VROWB + c * 16) = nv; }                  \
    }
    L_LOAD_META();
    L_STORE();
    for (int n = 0; n <= 64; ++n) {
        bf16x8 cq[4], ckt[2][2]; float cd[2]; u32x2 cgz;
#pragma unroll
        for (int ks = 0; ks < 4; ++ks) cq[ks] = nq[ks];
#pragma unroll
        for (int ct = 0; ct < 2; ++ct) { cd[ct] = nd[ct]; ckt[ct][0] = nkt[ct][0]; ckt[ct][1] = nkt[ct][1]; }
        cgz = ngz;
        __syncthreads();
        if (n + 1 <= 64) L_LOAD_REAL();
        if (n > 0) {
            f32x4 at[4];
#pragma unroll
            for (int jt = 0; jt < 4; ++jt) at[jt] = (f32x4){0.f, 0.f, 0.f, 0.f};
#pragma unroll
            for (int jt = 0; jt < 4; ++jt)
#pragma unroll
                for (int ks = 0; ks < 4; ++ks) {
                    const bf16x8 kf = *(const bf16x8*)(sK + (jt * 16 + l15) * L_KROWB + (ks * 32 + 8 * g) * 2);
                    at[jt] = MFMA16(kf, cq[ks], at[jt]);
                }
            const int tl = 16 * tt + l15;
#pragma unroll
            for (int jt = 0; jt < 4; ++jt)
#pragma unroll
                for (int i = 0; i < 4; ++i) if (16 * jt + 4 * g + i > tl) at[jt][i] = 0.f;
            f32x4 o = (f32x4){0.f, 0.f, 0.f, 0.f};
#pragma unroll
            for (int s2 = 0; s2 < 2; ++s2) {
                u32x4 pa;
                pa.x = pk2(at[2 * s2][0], at[2 * s2][1]); pa.y = pk2(at[2 * s2][2], at[2 * s2][3]);
                pa.z = pk2(at[2 * s2 + 1][0], at[2 * s2 + 1][1]); pa.w = pk2(at[2 * s2 + 1][2], at[2 * s2 + 1][3]);
                const unsigned char* vp = sV + (dvt * 16 + l15) * L_VROWB + (32 * s2 + 4 * g) * 2;
                const u32x2 lo = *(const u32x2*)vp, hi = *(const u32x2*)(vp + 32);
                u32x4 vv; vv.x = lo.x; vv.y = lo.y; vv.z = hi.x; vv.w = hi.y;
                o = MFMA16(__builtin_bit_cast(bf16x8, vv), __builtin_bit_cast(bf16x8, pa), o);
            }
#pragma unroll
            for (int ks = 0; ks < 4; ++ks) {
                const bf16x8 sf = *(const bf16x8*)(sS + (dvt * 16 + l15) * L_SROWB + (ks * 32 + 8 * g) * 2);
                o = MFMA16(sf, cq[ks], o);
            }
            const size_t row = (size_t)b * 4096 + (n - 1) * 64 + 16 * tt + l15;
            float ss = (o[0] * o[0] + o[1] * o[1]) + (o[2] * o[2] + o[3] * o[3]);
            ss += __shfl_xor(ss, 16); ss += __shfl_xor(ss, 32);
            u32x2 ov;
            ov.x = pk2(o[0] * siluf_(bflo(cgz.x)), o[1] * siluf_(bfhi(cgz.x)));
            ov.y = pk2(o[2] * siluf_(bflo(cgz.y)), o[3] * siluf_(bfhi(cgz.y)));
            *(u32x2*)(gz + row * 1024 + hh * 256 + sl * 32 + 16 * dvt + 4 * g) = ov;
            if (g == 0) ssqb[(row * 4 + hh) * 16 + sl * 2 + dvt] = ss;
        }
#pragma unroll
        for (int ks = 0; ks < 2; ++ks) {
            const bf16x8 vf = *(const bf16x8*)(sV + (dvt * 16 + l15) * L_VROWB + (32 * ks + 8 * g) * 2);
            sacc[0] = MFMA16(vf, ckt[0][ks], sacc[0]);
            sacc[1] = MFMA16(vf, ckt[1][ks], sacc[1]);
        }
#pragma unroll
        for (int ct = 0; ct < 2; ++ct)
#pragma unroll
            for (int i = 0; i < 4; ++i) sacc[ct][i] *= cd[ct];
        __syncthreads();
#pragma unroll
        for (int ct = 0; ct < 2; ++ct)
#pragma unroll
            for (int i = 0; i < 4; ++i)
                *(bf16_t*)(sS + (16 * dvt + 4 * g + i) * L_SROWB + (cc0 + 16 * ct) * 2) = f2bf(sacc[ct][i]);
        if (n + 1 <= 64) L_STORE();
    }
#undef L_LOAD_META
#undef L_LOAD_REAL
#undef L_STORE
    __syncthreads();
}

DI void phase2(const Params& p, unsigned char* lds) {
    const int tid = threadIdx.x;
    volatile unsigned* sItem = (volatile unsigned*)(lds + LDS_ITEM);
    constexpr unsigned N_GLA = 16, N_ATT = 128;
    if (tid == 0) sItem[1] = 0u;
    for (;;) {
        if (tid == 0) {
            unsigned* heads = (unsigned*)(p.ws + OFF_CTR);
            const unsigned x0 = (unsigned)__builtin_amdgcn_s_getreg((3 << 11) | 20) & 7u;
            unsigned k = sItem[1], it = 0xffffffffu;
            while (k < 8u) {
                const unsigned x = (x0 + k) & 7u;
                const unsigned got = atomicAdd(heads + x, 1u);
                if (got < N_GLA + N_ATT) { it = got | (x << 16); break; }
                ++k;
            }
            sItem[1] = k; sItem[0] = it;
        }
        __syncthreads();
        const unsigned item = (unsigned)__builtin_amdgcn_readfirstlane((int)sItem[0]);
        __syncthreads();
        if (item == 0xffffffffu) break;
        const unsigned x = item >> 16, idx = item & 0xffffu;
        if (idx < N_GLA) { const unsigned gi = x * 16 + idx; gla_item(p, lds, gi >> 5, (gi >> 3) & 3, gi & 7); }
        else { const unsigned a = idx - N_GLA, pair = 4 * x + (a >> 5); attn_item(p, lds, pair & 3, pair >> 2, 31 - (int)(a & 31)); }
    }
}

DI void phase3(const Params& p, unsigned char* lds) {
    const int tid = threadIdx.x, lane = tid & 63, wave = tid >> 6, l31 = lane & 31, h = lane >> 5;
    const int wn = wave & 1, wm = wave >> 1;
    unsigned char* ws = p.ws;
    const float* ssqb = (const float*)(ws + OFF_SSQB);
    float* sc = (float*)(lds + LDS_SCALE);
    const unsigned char* sga = ws + OFF_SGA;
    const unsigned char* sgb = ws + OFF_SGB;
    bf16_t* merged = (bf16_t*)(ws + OFF_AK);
    for (int id = blockIdx.x; id < 512; id += gridDim.x) {
        const int mt = (id >> 8) * 32 + 4 * (id & 7) + ((id >> 3) & 3), nt = (id >> 5) & 7;
#pragma unroll
        for (int i = 0; i < 2; ++i) {
            const int e = tid + 512 * i, row = e >> 2, hh = e & 3;
            const f32x4* sp = (const f32x4*)(ssqb + (((size_t)mt * 256 + row) * 4 + hh) * 16);
            const f32x4 a = sp[0], b2 = sp[1], c = sp[2], d = sp[3];
            const float s = ((a.x + a.y) + (a.z + a.w)) + ((b2.x + b2.y) + (b2.z + b2.w)) + ((c.x + c.y) + (c.z + c.w)) + ((d.x + d.y) + (d.z + d.w));
            sc[e] = 1.0f / sqrtf(s * (1.0f / 256.0f) + EPS);
        }
        __syncthreads();
        float hs[2][3], rl[2];
#pragma unroll
        for (int im = 0; im < 2; ++im) {
            const int lr = wm * 64 + im * 32 + l31;
            const f32x4 r = *(const f32x4*)(sc + lr * 4);
            hs[im][0] = r.x / r.y; hs[im][1] = r.y / r.z; hs[im][2] = r.z / r.w; rl[im] = r.w;
        }
        f32x16 acc[2][2];
        unsigned mb[2][2][8];
        zero_acc<2>(acc);
        gemm_tile<2, true>(acc, (const bf16_t*)(ws + OFF_WB_T) + (size_t)nt * 128 * 1024, (const bf16_t*)(ws + OFF_GZ) + (size_t)mt * 256 * 1024, lds, hs);
#pragma unroll
        for (int im = 0; im < 2; ++im) {
            const size_t tok = (size_t)mt * 256 + wm * 64 + im * 32 + l31;
#pragma unroll
            for (int in = 0; in < 2; ++in)
#pragma unroll
                for (int g = 0; g < 4; ++g) {
                    const size_t off = tok * 1024 + nt * 128 + wn * 64 + in * 32 + 8 * g + 4 * h;
                    const unsigned ub = *(const unsigned*)(sgb + off);
                    const float q = rl[im] * (1.0f / 255.0f);
                    mb[in][im][2 * g] = pk2((float)(ub & 255u) * q * acc[in][im][4 * g + 0], (float)((ub >> 8) & 255u) * q * acc[in][im][4 * g + 1]);
                    mb[in][im][2 * g + 1] = pk2((float)((ub >> 16) & 255u) * q * acc[in][im][4 * g + 2], (float)(ub >> 24) * q * acc[in][im][4 * g + 3]);
                }
        }
        zero_acc<2>(acc);
        gemm_tile<2, false>(acc, (const bf16_t*)(ws + OFF_WA_T) + (size_t)nt * 128 * 1024, (const bf16_t*)(ws + OFF_AZ) + (size_t)mt * 256 * 1024, lds, hs);
#pragma unroll
        for (int im = 0; im < 2; ++im) {
            const size_t tok = (size_t)mt * 256 + wm * 64 + im * 32 + l31;
#pragma unroll
            for (int in = 0; in < 2; ++in)
#pragma unroll
                for (int g = 0; g < 4; ++g) {
                    const size_t off = tok * 1024 + nt * 128 + wn * 64 + in * 32 + 8 * g + 4 * h;
                    const unsigned ua = *(const unsigned*)(sga + off);
                    const unsigned b0 = mb[in][im][2 * g], b1 = mb[in][im][2 * g + 1];
                    const float q = 1.0f / 255.0f;
                    const float m0 = (float)(ua & 255u) * q * acc[in][im][4 * g + 0] + bflo(b0);
                    const float m1 = (float)((ua >> 8) & 255u) * q * acc[in][im][4 * g + 1] + bfhi(b0);
                    const float m2 = (float)((ua >> 16) & 255u) * q * acc[in][im][4 * g + 2] + bflo(b1);
                    const float m3 = (float)(ua >> 24) * q * acc[in][im][4 * g + 3] + bfhi(b1);
                    u32x2 o; o.x = pk2(m0, m1); o.y = pk2(m2, m3);
                    *(u32x2*)(merged + off) = o;
                }
        }
        __syncthreads();
    }
}

DI void phase4(const Params& p, unsigned char* lds) {
    const int tid = threadIdx.x, lane = tid & 63, wave = tid >> 6, l31 = lane & 31, h = lane >> 5;
    const int wn = wave & 1, wm = wave >> 1;
    unsigned char* ws = p.ws;
    float* ssqh = (float*)(ws + OFF_SSQH);
    for (int id = blockIdx.x; id < 512; id += gridDim.x) {
        const int mt = (id >> 8) * 32 + 4 * (id & 7) + ((id >> 3) & 3), nt = (id >> 5) & 7;
        f32x16 acc[2][2];
        zero_acc<2>(acc);
        const float hs0[2][3] = {{1.f, 1.f, 1.f}, {1.f, 1.f, 1.f}};
        gemm_tile<2, false>(acc, (const bf16_t*)(ws + OFF_WO_T) + (size_t)nt * 128 * 1024, (const bf16_t*)(ws + OFF_AK) + (size_t)mt * 256 * 1024, lds, hs0);
#pragma unroll
        for (int im = 0; im < 2; ++im) {
            const size_t tok = (size_t)mt * 256 + wm * 64 + im * 32 + l31;
            float ss = 0.f;
#pragma unroll
            for (int in = 0; in < 2; ++in)
#pragma unroll
                for (int g = 0; g < 4; ++g) {
                    const size_t off = tok * 1024 + nt * 128 + wn * 64 + in * 32 + 8 * g + 4 * h;
                    const f32x4 xv = *(const f32x4*)(p.x + off);
                    f32x4 o;
                    o.x = xv.x + acc[in][im][4 * g + 0]; o.y = xv.y + acc[in][im][4 * g + 1];
                    o.z = xv.z + acc[in][im][4 * g + 2]; o.w = xv.w + acc[in][im][4 * g + 3];
                    ss += (o.x * o.x + o.y * o.y) + (o.z * o.z + o.w * o.w);
                    *(f32x4*)(p.out + off) = o;
                }
            ss += __shfl_xor(ss, 32);
            if (h == 0) ssqh[tok * 16 + nt * 2 + wn] = ss;
        }
    }
}

DI void phase5(const Params& p, unsigned char* lds) {
    const int tid = threadIdx.x, lane = tid & 63, wave = tid >> 6;
    const float* ssqh = (const float*)(p.ws + OFF_SSQH);
    for (int it = blockIdx.x; it < MROWS / 8; it += gridDim.x) {
        const size_t row = (size_t)it * 8 + wave;
        float s = lane < 16 ? ssqh[row * 16 + lane] : 0.f;
        s = wave_sum(s);
        const float rstd = 1.0f / sqrtf(s * (1.0f / 1024.0f) + EPS);
        f32x4* orow = (f32x4*)(p.out + row * 1024) + lane;
        const f32x4* wrow = (const f32x4*)p.final_w + lane;
#pragma unroll
        for (int j = 0; j < 4; ++j) {
            f32x4 v = orow[64 * j]; const f32x4 w = wrow[64 * j];
            v.x = v.x * rstd * w.x; v.y = v.y * rstd * w.y; v.z = v.z * rstd * w.z; v.w = v.w * rstd * w.w;
            orow[64 * j] = v;
        }
    }
}

#define XB_TMO      128
#define XB_XCNT(j)  (256  + 64 * (j))
#define XB_XSUB(j)  (1280 + 64 * (j))
#define XB_XGEN(j)  (2304 + 64 * (j))
#define XB_TOP      3328
#define XB_TOPGEN   3392
#define XCD_BAR_WORDS 3456
#define XB_SPIN_CAP (1u << 18)
#define LAS __attribute__((address_space(3)))
DI unsigned xb_ld(unsigned* p)              { return __hip_atomic_load(p, __ATOMIC_RELAXED, __HIP_MEMORY_SCOPE_AGENT); }
DI unsigned xb_add(unsigned* p, unsigned v) { return __hip_atomic_fetch_add(p, v, __ATOMIC_RELAXED, __HIP_MEMORY_SCOPE_AGENT); }
DI unsigned xb_xcc_id() { return (unsigned)__builtin_amdgcn_s_getreg((3 << 11) | 20) & 0xFu; }
#define XB_SPIN(cond, bar) do { unsigned _sp = 0; while (cond) { __builtin_amdgcn_s_sleep(1); \
    if ((++_sp & 255u) == 0u) { if (xb_ld(&(bar)[XB_TMO])) break; if (_sp > XB_SPIN_CAP) { atomicAdd(&(bar)[XB_TMO], 1u); break; } } } } while (0)
struct XcdBarrier { unsigned* bar; unsigned x; volatile LAS unsigned* st; };
DI XcdBarrier xcd_barrier_post(unsigned* bar, volatile LAS unsigned* st) {
    XcdBarrier b; b.bar = bar; b.x = xb_xcc_id(); b.st = st;
    if (threadIdx.x == 0) (void)xb_add(&bar[XB_XCNT(b.x)], 1u);
    return b;
}
DI void xcd_barrier_complete(unsigned* bar, unsigned x, unsigned& nloc, unsigned& nx) {
    const unsigned G = gridDim.x * gridDim.y * gridDim.z;
    unsigned sum, cnt, mine, sp = 0u;
    for (;;) {
        sum = 0u; cnt = 0u; mine = 0u;
#pragma unroll
        for (unsigned j = 0; j < 16; ++j) { const unsigned c = xb_ld(&bar[XB_XCNT(j)]); sum += c; cnt += (c > 0u) ? 1u : 0u; mine = (j == x) ? c : mine; }
        if (sum == G) break;
        __builtin_amdgcn_s_sleep(1);
        if ((++sp & 255u) == 0u) { if (xb_ld(&bar[XB_TMO])) break; if (sp > XB_SPIN_CAP) { atomicAdd(&bar[XB_TMO], 1u); break; } }
    }
    nloc = mine > 0u ? mine : 1u; nx = cnt > 0u ? cnt : 1u;
}
DI void xcd_barrier(const XcdBarrier& b) {
    asm volatile("s_waitcnt vmcnt(0)" ::: "memory");
    __syncthreads();
    if (threadIdx.x == 0) {
        unsigned* bar = b.bar;
        __builtin_amdgcn_s_waitcnt(0);
        unsigned nloc = b.st[0], nx = b.st[1];
        if (nloc == 0u) { xcd_barrier_complete(bar, b.x, nloc, nx); b.st[0] = nloc; b.st[1] = nx; }
        const unsigned old = xb_add(&bar[XB_XSUB(b.x)], 1u);
        const unsigned gen = old / nloc;
        if (old + 1u == (gen + 1u) * nloc) {
            __builtin_amdgcn_fence(__ATOMIC_RELEASE, "agent");
            asm volatile("s_waitcnt vmcnt(0)" ::: "memory");
            const unsigned og = xb_add(&bar[XB_TOP], 1u);
            const unsigned tg = og / nx;
            if (og + 1u == (tg + 1u) * nx) xb_add(&bar[XB_TOPGEN], 1u);
            else XB_SPIN(xb_ld(&bar[XB_TOPGEN]) == tg, bar);
            __builtin_amdgcn_fence(__ATOMIC_ACQUIRE, "agent");
            xb_add(&bar[XB_XGEN(b.x)], 1u);
            asm volatile("s_waitcnt vmcnt(0)" ::: "memory");
        } else {
            XB_SPIN(xb_ld(&bar[XB_XGEN(b.x)]) == gen, bar);
            __builtin_amdgcn_fence(__ATOMIC_ACQUIRE, "agent");
            asm volatile("s_waitcnt vmcnt(0)" ::: "memory");
        }
    }
    __syncthreads();
}

DI void run_phase(const Params& p, unsigned char* lds, int ph) {
    switch (ph) {
        case 0: phase0(p, lds); break;
        case 1: phase1(p, lds); break;
        case 2: phase15(p, lds); break;
        case 3: phase2(p, lds); break;
        case 4: phase3(p, lds); break;
        case 5: phase4(p, lds); break;
        default: phase5(p, lds); break;
    }
}

__global__ void __launch_bounds__(512) hybrid_fwd(Params p) {
    extern __shared__ __attribute__((aligned(16))) unsigned char lds[];
#if MULTI_LAUNCH
    run_phase(p, lds, p.phase_lo);
#else
    cg::grid_group grid = cg::this_grid();
    if (p.phase_lo == 77) grid.sync();
    volatile LAS unsigned* st = (volatile LAS unsigned*)(lds + LDS_ITEM + 16);
    if (threadIdx.x == 0) { st[0] = 0u; st[1] = 0u; }
    __syncthreads();
    XcdBarrier xb = xcd_barrier_post((unsigned*)(p.ws + OFF_XBAR), st);
    phase0(p, lds); xcd_barrier(xb);
    phase1(p, lds); xcd_barrier(xb);
    phase15(p, lds); xcd_barrier(xb);
    phase2(p, lds); xcd_barrier(xb);
    phase3(p, lds); xcd_barrier(xb);
    phase4(p, lds); xcd_barrier(xb);
    phase5(p, lds);
#endif
}

extern "C" void kernel_launch(void* const* d_in, const int* in_sizes, int n_in, void* d_out, int out_size, void* d_ws, size_t ws_size, hipStream_t stream) {
    static int grid = 0;
    if (grid == 0) {
        int dev = 0, cus = 0, per_cu = 0;
        hipGetDevice(&dev);
        hipDeviceGetAttribute(&cus, hipDeviceAttributeMultiprocessorCount, dev);
        hipFuncSetAttribute((const void*)hybrid_fwd, hipFuncAttributeMaxDynamicSharedMemorySize, LDS_BYTES);
        hipOccupancyMaxActiveBlocksPerMultiprocessor(&per_cu, (const void*)hybrid_fwd, 512, LDS_BYTES);
        if (per_cu < 1) per_cu = 1;
        if (per_cu > 1) per_cu = 1;
        if (cus <= 0) cus = 256;
        grid = cus * per_cu;
    }
    hipMemsetAsync((unsigned char*)d_ws + OFF_CTR, 0, 256, stream);
    hipMemsetAsync((unsigned char*)d_ws + OFF_XBAR, 0, 16384, stream);
    Params p{};
    p.x = (const float*)d_in[0]; p.meta = (const float*)d_in[1]; p.norm_w = (const float*)d_in[2]; p.w_in = (const float*)d_in[3];
    p.lq1 = (const float*)d_in[4]; p.lk1 = (const float*)d_in[5]; p.lq2 = (const float*)d_in[6]; p.lk2 = (const float*)d_in[7];
    p.subln_w = (const float*)d_in[8]; p.gate_w2 = (const float*)d_in[9]; p.gate_b = (const float*)d_in[10]; p.gla_norm_w = (const float*)d_in[11];
    p.wa = (const float*)d_in[12]; p.wb = (const float*)d_in[13]; p.wo = (const float*)d_in[14]; p.final_w = (const float*)d_in[15];
    p.out = (float*)d_out; p.ws = (unsigned char*)d_ws;
#if MULTI_LAUNCH
    for (int ph = 0; ph < 7; ++ph) {
        p.phase_lo = ph; p.phase_hi = ph + 1;
        hipLaunchKernelGGL(hybrid_fwd, dim3(grid), dim3(512), LDS_BYTES, stream, p);
    }
#else
    p.phase_lo = 0; p.phase_hi = 7;
    void* args[] = {&p};
    hipError_t e = hipLaunchCooperativeKernel((const void*)hybrid_fwd, dim3(grid), dim3(512), args, LDS_BYTES, stream);
    if (e != hipSuccess) fprintf(stderr, "cooperative launch failed: %s (grid %d)\n", hipGetErrorString(e), grid);
#endif
}
```

```cpp
#include <hip/hip_runtime.h>
#include <hip/hip_cooperative_groups.h>
#include <cstdio>
#include <cstdint>
namespace cg = cooperative_groups;

#ifndef MULTI_LAUNCH
#define MULTI_LAUNCH 0
#endif
#ifndef PROBE_REP
#define PROBE_REP 0
#endif

typedef unsigned short bf16_t;
typedef short bf16x8 __attribute__((ext_vector_type(8)));
typedef float f32x4 __attribute__((ext_vector_type(4)));
typedef float f32x2 __attribute__((ext_vector_type(2)));
typedef float f32x16 __attribute__((ext_vector_type(16)));
typedef unsigned u32x4 __attribute__((ext_vector_type(4)));
typedef unsigned u32x2 __attribute__((ext_vector_type(2)));
typedef __bf16 bfv2 __attribute__((ext_vector_type(2)));

#define DI __device__ __forceinline__
#define MFMA32(a, b, c) __builtin_amdgcn_mfma_f32_32x32x16_bf16((a), (b), (c), 0, 0, 0)
#define MFMA16(a, b, c) __builtin_amdgcn_mfma_f32_16x16x32_bf16((a), (b), (c), 0, 0, 0)

DI unsigned pk2(float a, float b) { f32x2 v = {a, b}; return __builtin_bit_cast(unsigned, __builtin_convertvector(v, bfv2)); }
DI float bf2f(bf16_t v) { return __uint_as_float(((unsigned)v) << 16); }
DI float bflo(unsigned u) { return __uint_as_float(u << 16); }
DI float bfhi(unsigned u) { return __uint_as_float(u & 0xffff0000u); }
DI bf16_t f2bf(float a) { return (bf16_t)(pk2(a, 0.f) & 0xffffu); }
DI float wave_sum(float v) {
#pragma unroll
    for (int o = 32; o; o >>= 1) v += __shfl_xor(v, o);
    return v;
}
DI float sigmoidf_(float z) { return 1.f / (1.f + __expf(-z)); }
DI float siluf_(float z) { return z / (1.f + __expf(-z)); }

constexpr int D = 1024, NB = 4, SEQ = 4096, MROWS = NB * SEQ;
constexpr int NIN = 9232, NINP = 9344;
constexpr float EPS = 1e-5f;

constexpr size_t SZ_ACT = (size_t)MROWS * 1024 * 2;
constexpr size_t OFF_WIN_T = 0;
constexpr size_t OFF_WA_T = OFF_WIN_T + (size_t)NINP * 1024 * 2;
constexpr size_t OFF_WB_T = OFF_WA_T + 2097152;
constexpr size_t OFF_WO_T = OFF_WB_T + 2097152;
constexpr size_t OFF_AK = OFF_WO_T + 2097152;
constexpr size_t OFF_AVT = OFF_AK + SZ_ACT;
constexpr size_t OFF_AZ = OFF_AVT + SZ_ACT;
constexpr size_t OFF_GVT = OFF_AZ + SZ_ACT;
constexpr size_t OFF_GZ = OFF_GVT + SZ_ACT;
constexpr size_t OFF_GA = OFF_GZ + SZ_ACT;
constexpr size_t OFF_GB = OFF_GA + SZ_ACT;
constexpr size_t OFF_GLR = OFF_GB + SZ_ACT;
constexpr size_t OFF_RSTD = OFF_GLR + (size_t)MROWS * 16 * 2;
constexpr size_t OFF_ROPE = OFF_RSTD + 65792;
constexpr size_t OFF_AKM = OFF_ROPE + 263168;
constexpr size_t OFF_AVTM = OFF_AKM + 131072;
constexpr size_t OFF_GVTM = OFF_AVTM + 131072;
constexpr size_t OFF_GKM = OFF_GVTM + 131072;
constexpr size_t OFF_GLRM = OFF_GKM + 16384;
constexpr size_t OFF_KTM = OFF_GLRM + 512;
constexpr size_t OFF_KTTM = OFF_KTM + 65536;
constexpr size_t OFF_DEC = OFF_KTTM + 65536;
constexpr size_t OFF_DECM = OFF_DEC + 524288;
constexpr size_t OFF_SSQB = OFF_DECM + 2048;
constexpr size_t OFF_SSQH = OFF_SSQB + 4194304;
constexpr size_t OFF_CTR = OFF_SSQH + 1048576;
constexpr size_t OFF_XBM = OFF_CTR + 256;
constexpr size_t OFF_XBAR = OFF_XBM + 32768;
constexpr size_t WS_END = OFF_XBAR + 16384;
constexpr size_t OFF_XB = OFF_GA;
constexpr size_t OFF_SGA = OFF_GB;
constexpr size_t OFF_SGB = OFF_GB + (size_t)MROWS * 1024;
static_assert(WS_END <= 268435456ull, "workspace over 256 MiB");
constexpr size_t DO_AQ = 0, DO_GQ = SZ_ACT, DO_GK = SZ_ACT + SZ_ACT / 2;

constexpr int G_ROWB = 144;
constexpr int G_SW = 128 * G_ROWB, G_SX = 256 * G_ROWB, G_STAGE = G_SW + G_SX;
constexpr int G_SW4 = 256 * G_ROWB, G_STAGE4 = G_SW4 + G_SX;
constexpr int LDS_SCALE = 2 * G_STAGE4;
constexpr int LDS_ITEM = LDS_SCALE + 4096;
constexpr int LDS_BYTES = LDS_ITEM + 64;

struct Params {
    const float *x, *meta, *norm_w, *w_in, *lq1, *lk1, *lq2, *lk2, *subln_w, *gate_w2, *gate_b, *gla_norm_w, *wa, *wb, *wo, *final_w;
    float* out;
    unsigned char* ws;
    int phase_lo, phase_hi;
};

template <int MODE>
DI void p0_transpose_item(const Params& p, int item, float* tile) {
    const int tid = threadIdx.x;
    const float* W = MODE == 0 ? p.w_in : MODE == 1 ? p.wa : MODE == 2 ? p.wb : p.wo;
    const int ldw = MODE == 0 ? NIN : 1024;
    const int nbc = MODE == 0 ? NINP / 64 : 16;
    bf16_t* WT = (bf16_t*)(p.ws + (MODE == 0 ? OFF_WIN_T : MODE == 1 ? OFF_WA_T : MODE == 2 ? OFF_WB_T : OFF_WO_T));
    const int kb = item / nbc, nb = item % nbc, k0 = kb * 64, n0 = nb * 64;
#pragma unroll
    for (int i = 0; i < 8; ++i) {
        const int kk = (tid >> 6) + 8 * i, nn = tid & 63, n = n0 + nn, k = k0 + kk;
        int src = n;
        if (MODE == 0) { src = n < 7168 ? n : (n < 9216 ? n + 16 : (n < 9232 ? n - 2048 : -1)); }
        float sc = 1.f;
        if (MODE == 0) sc = p.norm_w[k];
        if (MODE == 1) sc = 0.8f * p.subln_w[k & 127];
        if (MODE == 2) sc = p.gla_norm_w[k & 255];
        float v = 0.f;
        if (src >= 0) v = W[(size_t)k * ldw + src] * sc;
        tile[kk * 65 + nn] = v;
    }
    __syncthreads();
    {
        const int nn = tid >> 3, c = tid & 7;
        const float* s = tile + (8 * c) * 65 + nn;
        u32x4 o;
        o.x = pk2(s[0 * 65], s[1 * 65]); o.y = pk2(s[2 * 65], s[3 * 65]); o.z = pk2(s[4 * 65], s[5 * 65]); o.w = pk2(s[6 * 65], s[7 * 65]);
        *(u32x4*)(WT + (size_t)(n0 + nn) * 1024 + k0 + 8 * c) = o;
    }
    __syncthreads();
}

DI void phase0(const Params& p, unsigned char* lds) {
    const int tid = threadIdx.x, lane = tid & 63, wave = tid >> 6;
    float* tile = (float*)lds;
    constexpr int I_WIN = 16 * (NINP / 64), I_SQ = 256;
    constexpr int I_T = I_WIN + 3 * I_SQ;
    constexpr int I_RSTD = (MROWS + 16 + 7) / 8;
    constexpr int I_ROPE = (4112 * 8 + 511) / 512;
    constexpr int I_ZERO = 393216 / 8192;
    constexpr int I_ALL = I_T + I_RSTD + I_ROPE + I_ZERO;
    for (int it = blockIdx.x; it < I_ALL; it += gridDim.x) {
        int r = it;
        if (r < I_WIN) { p0_transpose_item<0>(p, r, tile); continue; } r -= I_WIN;
        if (r < I_SQ) { p0_transpose_item<1>(p, r, tile); continue; } r -= I_SQ;
        if (r < I_SQ) { p0_transpose_item<2>(p, r, tile); continue; } r -= I_SQ;
        if (r < I_SQ) { p0_transpose_item<3>(p, r, tile); continue; } r -= I_SQ;
        if (r < I_RSTD) {
            const int row = r * 8 + wave;
            if (row < MROWS + 16) {
                const float* src = row < MROWS ? p.x + (size_t)row * 1024 : p.meta + (size_t)(row - MROWS) * 1024;
                const f32x4* xr = (const f32x4*)src + lane;
                float s = 0.f;
#pragma unroll
                for (int j = 0; j < 4; ++j) { const f32x4 v = xr[64 * j]; s += (v.x * v.x + v.y * v.y) + (v.z * v.z + v.w * v.w); }
                s = wave_sum(s);
                if (lane == 0) ((float*)(p.ws + OFF_RSTD))[row] = 1.0f / sqrtf(s * (1.0f / 1024.0f) + EPS);
                bf16_t* xbrow = row < MROWS ? (bf16_t*)(p.ws + OFF_XB) + (size_t)row * 1024 : (bf16_t*)(p.ws + OFF_XBM) + (size_t)(row - MROWS) * 1024;
#pragma unroll
                for (int j = 0; j < 4; ++j) { const f32x4 v = xr[64 * j]; u32x2 o; o.x = pk2(v.x, v.y); o.y = pk2(v.z, v.w); *(u32x2*)(xbrow + 256 * j + 4 * lane) = o; }
            }
            continue;
        }
        r -= I_RSTD;
        if (r < I_ROPE) {
            const int e = r * 512 + tid;
            if (e < 4112 * 8) {
                const int pos = e >> 3, i = e & 7;
                const float inv = powf(500000.0f, -(float)i / 8.0f);
                const float ang = (float)pos * inv;
                float* t = (float*)(p.ws + OFF_ROPE) + (size_t)e * 2;
                t[0] = cosf(ang); t[1] = sinf(ang);
            }
            continue;
        }
        r -= I_ROPE;
        { u32x4 z = {0u, 0u, 0u, 0u}; *(u32x4*)(p.ws + OFF_AKM + (size_t)r * 8192 + tid * 16) = z; }
    }
}

template <int NI, bool HS>
DI void gemm_tile(f32x16 (&acc)[NI][2], const bf16_t* __restrict__ Wt, const bf16_t* __restrict__ X, unsigned char* lds, const float (&hs)[2][3]) {
    const int tid = threadIdx.x, lane = tid & 63, wave = tid >> 6, l31 = lane & 31, h = lane >> 5;
    const int wn = wave & 1, wm = wave >> 1;
    constexpr int SW = NI * 64 * G_ROWB, STAGE = SW + G_SX;
    u32x4 wreg[NI];
    u32x4 xreg[4];
    const int prow = tid >> 3, pc = tid & 7;
    const bf16_t* wp = Wt + (size_t)prow * 1024 + pc * 8;
    const bf16_t* xp = X + (size_t)prow * 1024 + pc * 8;
#define G_LOAD(kt_)                                                                                                  \
    {                                                                                                                \
        _Pragma("unroll") for (int i = 0; i < NI; ++i) wreg[i] = *(const u32x4*)(wp + (size_t)i * 64 * 1024 + (kt_) * 64); \
        _Pragma("unroll") for (int i = 0; i < 4; ++i) xreg[i] = *(const u32x4*)(xp + (size_t)i * 64 * 1024 + (kt_) * 64);  \
    }
#define G_STORE(buf_)                                                                                                \
    {                                                                                                                \
        unsigned char* sW_ = lds + (buf_) * STAGE + prow * G_ROWB + pc * 16; unsigned char* sX_ = sW_ + SW;          \
        _Pragma("unroll") for (int i = 0; i < NI; ++i) *(u32x4*)(sW_ + i * 64 * G_ROWB) = wreg[i];                   \
        _Pragma("unroll") for (int i = 0; i < 4; ++i) *(u32x4*)(sX_ + i * 64 * G_ROWB) = xreg[i];                    \
    }
    G_LOAD(0);
    G_STORE(0);
    __syncthreads();
    for (int kt = 0; kt < 16; ++kt) {
        if (kt + 1 < 16) G_LOAD(kt + 1);
        if (HS) {
            if (kt == 4 || kt == 8 || kt == 12) {
                const float s0 = kt == 4 ? hs[0][0] : (kt == 8 ? hs[0][1] : hs[0][2]);
                const float s1 = kt == 4 ? hs[1][0] : (kt == 8 ? hs[1][1] : hs[1][2]);
#pragma unroll
                for (int n = 0; n < NI; ++n)
#pragma unroll
                    for (int i = 0; i < 16; ++i) { acc[n][0][i] *= s0; acc[n][1][i] *= s1; }
            }
        }
        {
            const unsigned char* sW = lds + (kt & 1) * STAGE + (wn * NI * 32 + l31) * G_ROWB + h * 16;
            const unsigned char* sX = lds + (kt & 1) * STAGE + SW + (wm * 64 + l31) * G_ROWB + h * 16;
#pragma unroll
            for (int ks = 0; ks < 4; ++ks) {
                const bf16x8 x0 = *(const bf16x8*)(sX + ks * 32), x1 = *(const bf16x8*)(sX + 32 * G_ROWB + ks * 32);
#pragma unroll
                for (int n = 0; n < NI; ++n) {
                    const bf16x8 w = *(const bf16x8*)(sW + n * 32 * G_ROWB + ks * 32);
                    acc[n][0] = MFMA32(w, x0, acc[n][0]); acc[n][1] = MFMA32(w, x1, acc[n][1]);
                }
            }
        }
        if (kt + 1 < 16) G_STORE((kt + 1) & 1);
        __syncthreads();
    }
#undef G_LOAD
#undef G_STORE
}

template <int NI>
DI void zero_acc(f32x16 (&acc)[NI][2]) {
#pragma unroll
    for (int a = 0; a < NI; ++a)
#pragma unroll
        for (int b = 0; b < 2; ++b)
#pragma unroll
            for (int i = 0; i < 16; ++i) acc[a][b][i] = 0.f;
}

DI unsigned sig_u8(float z) { return (unsigned)(255.0f / (1.0f + __expf(-z)) + 0.5f); }
DI void p1_epilogue(const Params& p, f32x16 (&acc)[4][2], int mt, int nt) {
    const int tid = threadIdx.x, lane = tid & 63, wave = tid >> 6, l31 = lane & 31, h = lane >> 5;
    const int wn = wave & 1, wm = wave >> 1;
    int split, nc0;
    if (nt < 4) { split = 0; nc0 = nt * 256; }
    else if (nt < 8) { split = 1; nc0 = (nt - 4) * 256; }
    else if (nt < 12) { split = 2; nc0 = (nt - 8) * 256; }
    else if (nt < 16) { split = 3; nc0 = (nt - 12) * 256; }
    else if (nt < 18) { split = 4; nc0 = (nt - 16) * 256; }
    else if (nt < 20) { split = 5; nc0 = (nt - 18) * 256; }
    else if (nt < 24) { split = 6; nc0 = (nt - 20) * 256; }
    else if (nt < 28) { split = 7; nc0 = (nt - 24) * 256; }
    else if (nt < 32) { split = 9; nc0 = (nt - 28) * 256; }
    else { split = 10; nc0 = (nt - 32) * 256; }
    const float* rstd = (const float*)(p.ws + OFF_RSTD);
    const float* rope = (const float*)(p.ws + OFF_ROPE);
    unsigned char* ws = p.ws;
    unsigned char* dout = (unsigned char*)p.out;
#pragma unroll
    for (int im = 0; im < 2; ++im) {
        const int tok = mt * 256 + wm * 64 + im * 32 + l31;
        const float rs = rstd[tok];
        const int pos = 16 + (tok & 4095);
        const int b = tok >> 12, s = tok & 4095;
#pragma unroll
        for (int in = 0; in < 4; ++in) {
            const int nb = nc0 + wn * 128 + in * 32;
            float v[16];
#pragma unroll
            for (int i = 0; i < 16; ++i) v[i] = acc[in][im][i] * rs;
            if (split <= 1 && (nb & 63) == 0) {
                const float* cs = rope + ((size_t)pos * 8 + 4 * h) * 2;
#pragma unroll
                for (int i = 0; i < 4; ++i) {
                    const float c = cs[2 * i], sn = cs[2 * i + 1];
                    const float x1 = v[i], x2 = v[i + 4];
                    v[i] = x1 * c - x2 * sn; v[i + 4] = x2 * c + x1 * sn;
                }
            }
            if (split == 2 || split == 6) {
                const int hshift = split == 2 ? 7 : 8;
                const int nheads = split == 2 ? 8 : 4;
                const int dvn = 1 << hshift;
                bf16_t* base = (bf16_t*)(ws + (split == 2 ? OFF_AVT : OFF_GVT));
#pragma unroll
                for (int i = 0; i < 16; ++i) {
                    const int n = nb + (i & 3) + 8 * (i >> 2) + 4 * h;
                    const int hd = n >> hshift, dv = n & (dvn - 1);
                    base[((size_t)(b * nheads + hd) * dvn + dv) * 4096 + s] = f2bf(v[i]);
                }
            } else if (split >= 9) {
                unsigned char* dst = ws + (split == 9 ? OFF_SGA : OFF_SGB) + (size_t)tok * 1024 + nb + 4 * h;
#pragma unroll
                for (int g = 0; g < 4; ++g) {
                    const unsigned o = sig_u8(v[4 * g]) | (sig_u8(v[4 * g + 1]) << 8) | (sig_u8(v[4 * g + 2]) << 16) | (sig_u8(v[4 * g + 3]) << 24);
                    *(unsigned*)(dst + 8 * g) = o;
                }
            } else {
                bf16_t* dst; int ld;
                switch (split) {
                    case 0: dst = (bf16_t*)(dout + DO_AQ); ld = 1024; break;
                    case 1: dst = (bf16_t*)(ws + OFF_AK); ld = 1024; break;
                    case 3: dst = (bf16_t*)(ws + OFF_AZ); ld = 1024; break;
                    case 4: dst = (bf16_t*)(dout + DO_GQ); ld = 512; break;
                    case 5: dst = (bf16_t*)(dout + DO_GK); ld = 512; break;
                    default: dst = (bf16_t*)(ws + OFF_GZ); ld = 1024; break;
                }
#pragma unroll
                for (int g = 0; g < 4; ++g) {
                    u32x2 o; o.x = pk2(v[4 * g], v[4 * g + 1]); o.y = pk2(v[4 * g + 2], v[4 * g + 3]);
                    *(u32x2*)(dst + (size_t)tok * ld + nb + 8 * g + 4 * h) = o;
                }
            }
        }
    }
}

DI void p1_glr_job(const Params& p, unsigned char* lds, int job) {
    const int tid = threadIdx.x, lane = tid & 63, wave = tid >> 6, l15 = lane & 15, g = lane >> 4;
    const int rtile = wave & 3, khalf = wave >> 2;
    const bf16_t* xb = (const bf16_t*)(p.ws + OFF_XB);
    const bf16_t* wt = (const bf16_t*)(p.ws + OFF_WIN_T) + (size_t)9216 * 1024;
    const size_t row0 = (size_t)job * 64 + rtile * 16;
    const bf16_t* ap = xb + (row0 + l15) * 1024 + khalf * 512 + 8 * g;
    const bf16_t* bp = wt + (size_t)l15 * 1024 + khalf * 512 + 8 * g;
    f32x4 acc = (f32x4){0.f, 0.f, 0.f, 0.f};
#pragma unroll 4
    for (int ks = 0; ks < 16; ++ks) {
        const bf16x8 a = *(const bf16x8*)(ap + ks * 32), bb = *(const bf16x8*)(bp + ks * 32);
        acc = MFMA16(a, bb, acc);
    }
    f32x4* red = (f32x4*)lds;
    __syncthreads();
    if (khalf == 1) red[rtile * 64 + lane] = acc;
    __syncthreads();
    if (khalf == 0) {
        const f32x4 o = red[rtile * 64 + lane];
        const float* rstd = (const float*)(p.ws + OFF_RSTD);
        bf16_t* glr = (bf16_t*)(p.ws + OFF_GLR);
#pragma unroll
        for (int i = 0; i < 4; ++i) {
            const size_t row = row0 + 4 * g + i;
            glr[row * 16 + l15] = f2bf((acc[i] + o[i]) * rstd[row]);
        }
    }
    __syncthreads();
}

DI void p1_meta_job(const Params& p, unsigned char* lds, int job) {
    const int tid = threadIdx.x, lane = tid & 63, wave = tid >> 6, l15 = lane & 15, g = lane >> 4;
    int c0;
    if (job < 64) c0 = 1024 + job * 16;
    else if (job < 128) c0 = 2048 + (job - 64) * 16;
    else if (job < 160) c0 = 4608 + (job - 128) * 16;
    else if (job < 224) c0 = 5120 + (job - 160) * 16;
    else c0 = 9216;
    const bf16_t* xbm = (const bf16_t*)(p.ws + OFF_XBM);
    const bf16_t* wt = (const bf16_t*)(p.ws + OFF_WIN_T);
    const bf16_t* ap = xbm + (size_t)l15 * 1024 + wave * 128 + 8 * g;
    const bf16_t* bp = wt + (size_t)(c0 + l15) * 1024 + wave * 128 + 8 * g;
    f32x4 acc = (f32x4){0.f, 0.f, 0.f, 0.f};
#pragma unroll
    for (int ks = 0; ks < 4; ++ks) {
        const bf16x8 a = *(const bf16x8*)(ap + ks * 32), bb = *(const bf16x8*)(bp + ks * 32);
        acc = MFMA16(a, bb, acc);
    }
    f32x4* red = (f32x4*)lds;
    __syncthreads();
    red[wave * 64 + lane] = acc;
    __syncthreads();
    if (wave == 0) {
        f32x4 s = red[lane];
#pragma unroll
        for (int w = 1; w < 8; ++w) { const f32x4 t = red[w * 64 + lane]; s.x += t.x; s.y += t.y; s.z += t.z; s.w += t.w; }
        const float* rstd = (const float*)(p.ws + OFF_RSTD) + MROWS;
        const float* rope = (const float*)(p.ws + OFF_ROPE);
        unsigned char* ws = p.ws;
        const int col = c0 + l15;
#pragma unroll
        for (int i = 0; i < 4; ++i) {
            const int row = 4 * g + i;
            float v = s[i] * rstd[row];
            if (job < 64 && (c0 & 63) == 0) {
                const float other = __shfl_xor(v, 8);
                const float* cs = rope + ((size_t)row * 8 + (l15 & 7)) * 2;
                const float c = cs[0], sn = cs[1];
                v = (l15 < 8) ? (v * c - other * sn) : (v * c + other * sn);
            }
            const bf16_t val = f2bf(v);
            if (job < 64) ((bf16_t*)(ws + OFF_AKM))[(size_t)(48 + row) * 1024 + (col - 1024)] = val;
            else if (job < 128) { const int n = col - 2048; ((bf16_t*)(ws + OFF_AVTM))[(size_t)n * 64 + 48 + row] = val; }
            else if (job < 160) ((bf16_t*)(ws + OFF_GKM))[(size_t)row * 512 + (col - 4608)] = val;
            else if (job < 224) { const int n = col - 5120; ((bf16_t*)(ws + OFF_GVTM))[(size_t)n * 64 + 48 + row] = val; }
            else ((bf16_t*)(ws + OFF_GLRM))[row * 16 + l15] = val;
        }
    }
    __syncthreads();
}

DI void phase1(const Params& p, unsigned char* lds) {
    for (int j = blockIdx.x; j < 256; j += gridDim.x) p1_glr_job(p, lds, j);
    for (int j = blockIdx.x; j < 225; j += gridDim.x) p1_meta_job(p, lds, j);
    constexpr int NT = 36, TOTAL = 64 * NT;
    const bf16_t* wt = (const bf16_t*)(p.ws + OFF_WIN_T);
    const bf16_t* xb = (const bf16_t*)(p.ws + OFF_XB);
    const float hs0[2][3] = {{1.f, 1.f, 1.f}, {1.f, 1.f, 1.f}};
    for (int id = blockIdx.x; id < TOTAL; id += gridDim.x) {
        int mt, nt;
        {
            const int g = id / (16 * NT), rem = id % (16 * NT), reg = rem >> 8, w = rem & 255, x = w & 7, j = w >> 3;
            const int mo = 4 * (x & 3) + (j & 3), no = 8 * (x >> 2) + (j >> 2);
            nt = reg * 16 + no; mt = g * 16 + mo;
            if (reg == 2) { const int e = rem - 512; nt = 32 + (e >> 4); mt = g * 16 + (e & 15); }
        }
        f32x16 acc[4][2];
        zero_acc<4>(acc);
        gemm_tile<4, false>(acc, wt + (size_t)nt * 256 * 1024, xb + (size_t)mt * 256 * 1024, lds, hs0);
        p1_epilogue(p, acc, mt, nt);
    }
}

DI void phase15(const Params& p, unsigned char* lds) {
    const int tid = threadIdx.x, col = tid;
    float w2[16];
#pragma unroll
    for (int j = 0; j < 16; ++j) w2[j] = p.gate_w2[j * 512 + col];
    const float bias = p.gate_b[col];
    unsigned char* ws = p.ws;
    unsigned char* dout = (unsigned char*)p.out;
    for (int item = blockIdx.x; item < 257; item += gridDim.x) {
        const bool meta = item == 256;
        const int b = item >> 6, c = item & 63;
        const size_t row0 = (size_t)b * 4096 + c * 64;
        const bf16_t* glr = meta ? (const bf16_t*)(ws + OFF_GLRM) : (const bf16_t*)(ws + OFF_GLR) + row0 * 16;
        const int nrows = meta ? 16 : 64;
        bf16_t* qp = (bf16_t*)(dout + DO_GQ) + row0 * 512 + col;
        const bf16_t* kin = meta ? (const bf16_t*)(ws + OFF_GKM) + col : (const bf16_t*)(dout + DO_GK) + row0 * 512 + col;
        bf16_t* kout = meta ? (bf16_t*)(ws + OFF_KTM) + 48 * 512 + col : (bf16_t*)(dout + DO_GK) + row0 * 512 + col;
        bf16_t* ktt = meta ? (bf16_t*)(ws + OFF_KTTM) + (size_t)col * 64 + 48 : (bf16_t*)(ws + OFF_WIN_T) + ((size_t)b * 512 + col) * 4096 + c * 64;
        __syncthreads();
        if (tid < nrows * 2) ((u32x4*)lds)[tid] = ((const u32x4*)glr)[tid];
        __syncthreads();
        float bsum = 0.f;
        bf16_t kc[8], qc[8], kn[8], qn[8];
#pragma unroll
        for (int rr = 0; rr < 8; ++rr) { kc[rr] = kin[(size_t)rr * 512]; qc[rr] = meta ? (bf16_t)0 : qp[(size_t)rr * 512]; }
        for (int r0 = 0; r0 < nrows; r0 += 8) {
            if (r0 + 8 < nrows) {
#pragma unroll
                for (int rr = 0; rr < 8; ++rr) { kn[rr] = kin[(size_t)(r0 + 8 + rr) * 512]; qn[rr] = meta ? (bf16_t)0 : qp[(size_t)(r0 + 8 + rr) * 512]; }
            }
            float kt8[8];
#pragma unroll
            for (int rr = 0; rr < 8; ++rr) {
                const int r = r0 + rr;
                const u32x4* g4 = (const u32x4*)(lds + r * 32);
                const u32x4 ga = g4[0], gb = g4[1];
                float gk = bias;
                gk += bflo(ga.x) * w2[0] + bfhi(ga.x) * w2[1] + bflo(ga.y) * w2[2] + bfhi(ga.y) * w2[3];
                gk += bflo(ga.z) * w2[4] + bfhi(ga.z) * w2[5] + bflo(ga.w) * w2[6] + bfhi(ga.w) * w2[7];
                gk += bflo(gb.x) * w2[8] + bfhi(gb.x) * w2[9] + bflo(gb.y) * w2[10] + bfhi(gb.y) * w2[11];
                gk += bflo(gb.z) * w2[12] + bfhi(gb.z) * w2[13] + bflo(gb.w) * w2[14] + bfhi(gb.w) * w2[15];
                const float lg = (fminf(gk, 0.f) - log1pf(expf(-fabsf(gk)))) * (1.0f / 16.0f);
                bsum += lg;
                const float kt = bf2f(kc[rr]) * expf(-bsum);
                kt8[rr] = kt;
                kout[(size_t)r * 512] = f2bf(kt);
                if (!meta) qp[(size_t)r * 512] = f2bf(bf2f(qc[rr]) * 0.08838834764831845f * expf(bsum));
            }
            u32x4 o; o.x = pk2(kt8[0], kt8[1]); o.y = pk2(kt8[2], kt8[3]); o.z = pk2(kt8[4], kt8[5]); o.w = pk2(kt8[6], kt8[7]);
            *(u32x4*)(ktt + r0) = o;
#pragma unroll
            for (int rr = 0; rr < 8; ++rr) { kc[rr] = kn[rr]; qc[rr] = qn[rr]; }
        }
        if (meta) {
            ((float*)(ws + OFF_DECM))[col] = expf(bsum);
            bf16_t* km = (bf16_t*)(ws + OFF_KTM);
            for (int r = 0; r < 48; ++r) km[r * 512 + col] = 0;
            u32x4 z = {0u, 0u, 0u, 0u};
            u32x4* kz = (u32x4*)((bf16_t*)(ws + OFF_KTTM) + (size_t)col * 64);
#pragma unroll
            for (int j = 0; j < 6; ++j) kz[j] = z;
        } else {
            ((float*)(ws + OFF_DEC))[((size_t)b * 64 + c) * 512 + col] = expf(bsum);
        }
    }
}

constexpr int A_KROWB = 272, A_VROWB = 144, A_KB = 64 * A_KROWB, A_VB = 128 * A_VROWB, A_STAGE = A_KB + A_VB;
DI void attn_tile(const unsigned char* sK, const unsigned char* sV, int tt, int qb, int qs, int sub, int l31, int h,
                  const bf16x8 (&qf)[4], f32x16 (&O)[4], float& m, float& l) {
    const float SC = 0.125f * 1.4426950408889634f;
    f32x16 st[2];
#pragma unroll
    for (int k2 = 0; k2 < 2; ++k2)
#pragma unroll
        for (int i = 0; i < 16; ++i) st[k2][i] = 0.f;
#pragma unroll
    for (int k2 = 0; k2 < 2; ++k2)
#pragma unroll
        for (int ks = 0; ks < 4; ++ks) {
            const bf16x8 kf = *(const bf16x8*)(sK + (k2 * 32 + l31) * A_KROWB + (sub * 64 + ks * 16 + 8 * h) * 2);
            st[k2] = MFMA32(kf, qf[ks], st[k2]);
        }
    if (tt == 0) {
#pragma unroll
        for (int i = 0; i < 16; ++i) { st[0][i] = -INFINITY; if (i < 8) st[1][i] = -INFINITY; }
    } else if (tt >= 2 * qb + 1) {
        const int kbase = (tt - 1) * 64 + 4 * h;
#pragma unroll
        for (int k2 = 0; k2 < 2; ++k2)
#pragma unroll
            for (int i = 0; i < 16; ++i) {
                const int key = kbase + k2 * 32 + (i & 3) + 8 * (i >> 2);
                if (key > qs) st[k2][i] = -INFINITY;
            }
    }
    float mx = -INFINITY;
#pragma unroll
    for (int k2 = 0; k2 < 2; ++k2)
#pragma unroll
        for (int i = 0; i < 16; ++i) mx = fmaxf(mx, st[k2][i]);
    mx = fmaxf(mx, __shfl_xor(mx, 32));
    const float mnew = fmaxf(m, mx);
    const float alpha = __builtin_amdgcn_exp2f((m - mnew) * SC);
    const float mc = mnew * SC;
    m = mnew;
    float ps = 0.f;
#pragma unroll
    for (int k2 = 0; k2 < 2; ++k2)
#pragma unroll
        for (int i = 0; i < 16; ++i) { const float pv = __builtin_amdgcn_exp2f(st[k2][i] * SC - mc); st[k2][i] = pv; ps += pv; }
    l = l * alpha + ps;
#pragma unroll
    for (int d = 0; d < 4; ++d)
#pragma unroll
        for (int i = 0; i < 16; ++i) O[d][i] *= alpha;
    bf16x8 pb[4];
#pragma unroll
    for (int k4 = 0; k4 < 4; ++k4) {
        const int k2 = k4 >> 1, o8 = 8 * (k4 & 1);
        u32x4 pk;
        pk.x = pk2(st[k2][o8 + 0], st[k2][o8 + 1]); pk.y = pk2(st[k2][o8 + 2], st[k2][o8 + 3]);
        pk.z = pk2(st[k2][o8 + 4], st[k2][o8 + 5]); pk.w = pk2(st[k2][o8 + 6], st[k2][o8 + 7]);
        pb[k4] = __builtin_bit_cast(bf16x8, pk);
    }
#pragma unroll
    for (int d = 0; d < 4; ++d)
#pragma unroll
        for (int k4 = 0; k4 < 4; ++k4) {
            const bf16x8 vv = *(const bf16x8*)(sV + (d * 32 + l31) * A_VROWB + k4 * 32 + 16 * h);
            O[d] = MFMA32(vv, pb[k4], O[d]);
        }
}

DI void attn_item(const Params& p, unsigned char* lds, int b, int hd, int qb) {
    const int tid = threadIdx.x, lane = tid & 63, wave = tid >> 6, l31 = lane & 31, h = lane >> 5;
    const int sub = wave >> 2, rt = wave & 3;
    const bf16_t* aq = (const bf16_t*)((unsigned char*)p.out + DO_AQ);
    const bf16_t* ak = (const bf16_t*)(p.ws + OFF_AK);
    const bf16_t* avT = (const bf16_t*)(p.ws + OFF_AVT);
    const bf16_t* akm = (const bf16_t*)(p.ws + OFF_AKM);
    const bf16_t* avTm = (const bf16_t*)(p.ws + OFF_AVTM);
    bf16_t* az = (bf16_t*)(p.ws + OFF_AZ);
    const int qs = qb * 128 + rt * 32 + l31;
    const size_t grow = (size_t)b * 4096 + qs;
    bf16x8 qf[4];
#pragma unroll
    for (int ks = 0; ks < 4; ++ks) qf[ks] = *(const bf16x8*)(aq + grow * 1024 + hd * 128 + sub * 64 + ks * 16 + 8 * h);
    f32x16 O[4];
#pragma unroll
    for (int d = 0; d < 4; ++d)
#pragma unroll
        for (int i = 0; i < 16; ++i) O[d][i] = 0.f;
    float m = -INFINITY, l = 0.f;
    const int T = 2 * qb + 3;
    u32x4 k0r[2], v0r[2];
    const int krow_ = tid >> 4, kc_ = tid & 15, vdv_ = tid >> 3, vc_ = tid & 7;
    const bf16_t* kp = ak + ((size_t)b * 4096 + krow_) * 1024 + hd * 128 + kc_ * 8;
    const bf16_t* vp_ = avT + ((size_t)(b * 8 + hd) * 128 + vdv_) * 4096 + vc_ * 8;
#define A_LOAD_REAL(KR, VR)                                                                                                   \
    {                                                                                                                         \
        KR[0] = *(const u32x4*)kp; KR[1] = *(const u32x4*)(kp + 32 * 1024); kp += 64 * 1024;                                  \
        VR[0] = *(const u32x4*)vp_; VR[1] = *(const u32x4*)(vp_ + (size_t)64 * 4096); vp_ += 64;                              \
    }
#define A_STORE(KR, VR, buf_)                                                                                                 \
    {                                                                                                                         \
        unsigned char* sK_ = lds + (buf_) * A_STAGE; unsigned char* sV_ = sK_ + A_KB;                                         \
        _Pragma("unroll") for (int i = 0; i < 2; ++i) { const int pi = tid + 512 * i, row = pi >> 4, c = pi & 15;              \
            *(u32x4*)(sK_ + row * A_KROWB + c * 16) = KR[i]; }                                                                \
        _Pragma("unroll") for (int i = 0; i < 2; ++i) { const int pi = tid + 512 * i, dv = pi >> 3, c = pi & 7;                \
            unsigned char* d_ = sV_ + dv * A_VROWB + (c >> 1) * 32 + 8 * (c & 1); u32x2 a_, b_; a_.x = VR[i].x; a_.y = VR[i].y; b_.x = VR[i].z; b_.y = VR[i].w; \
            *(u32x2*)d_ = a_; *(u32x2*)(d_ + 16) = b_; }                                                                      \
    }
    {
        const bf16_t* km_ = akm + (size_t)krow_ * 1024 + hd * 128 + kc_ * 8;
        k0r[0] = *(const u32x4*)km_; k0r[1] = *(const u32x4*)(km_ + 32 * 1024);
        const bf16_t* vm_ = avTm + (size_t)(hd * 128 + vdv_) * 64 + vc_ * 8;
        v0r[0] = *(const u32x4*)vm_; v0r[1] = *(const u32x4*)(vm_ + 64 * 64);
    }
    A_STORE(k0r, v0r, 0);
    __syncthreads();
    for (int tt = 0; tt < T; ++tt) {
        if (tt + 1 < T) A_LOAD_REAL(k0r, v0r);
        attn_tile(lds + (tt & 1) * A_STAGE, lds + (tt & 1) * A_STAGE + A_KB, tt, qb, qs, sub, l31, h, qf, O, m, l);
        if (tt + 1 < T) A_STORE(k0r, v0r, (tt + 1) & 1);
        __syncthreads();
    }
#undef A_LOAD_REAL
#undef A_STORE
    float lam;
    {
        const float a_ = wave_sum(p.lq1[lane] * p.lk1[lane]);
        const float b_ = wave_sum(p.lq2[lane] * p.lk2[lane]);
        lam = expf(a_) - expf(b_) + 0.2f;
    }
    const float ltot = l + __shfl_xor(l, 32);
    const float linv = 1.0f / ltot;
    float* ex = (float*)lds;
    if (sub == 1) {
#pragma unroll
        for (int d = 0; d < 4; ++d)
#pragma unroll
            for (int i = 0; i < 16; ++i) { ex[(rt * 32 + l31) * 129 + d * 32 + (i & 3) + 8 * (i >> 2) + 4 * h] = O[d][i] * linv; if (i == 15) __builtin_amdgcn_sched_barrier(0); }
    }
    __syncthreads();
    if (sub == 0) {
        float ss = 0.f;
#pragma unroll
        for (int d = 0; d < 4; ++d)
#pragma unroll
            for (int i = 0; i < 16; ++i) {
                const float o2 = ex[(rt * 32 + l31) * 129 + d * 32 + (i & 3) + 8 * (i >> 2) + 4 * h];
                const float o = O[d][i] * linv - lam * o2;
                O[d][i] = o; ss += o * o;
                if (i == 15) __builtin_amdgcn_sched_barrier(0);
            }
        ss += __shfl_xor(ss, 32);
        const float rstd = 1.0f / sqrtf(ss * (1.0f / 128.0f) + EPS);
#pragma unroll
        for (int d = 0; d < 4; ++d)
#pragma unroll
            for (int g = 0; g < 4; ++g) {
                bf16_t* zp = az + grow * 1024 + hd * 128 + d * 32 + 8 * g + 4 * h;
                const u32x2 zz = *(const u32x2*)zp;
                u32x2 o;
                o.x = pk2(O[d][4 * g] * rstd * siluf_(bflo(zz.x)), O[d][4 * g + 1] * rstd * siluf_(bfhi(zz.x)));
                o.y = pk2(O[d][4 * g + 2] * rstd * siluf_(bflo(zz.y)), O[d][4 * g + 3] * rstd * siluf_(bfhi(zz.y)));
                *(u32x2*)zp = o;
                if (g == 3) __builtin_amdgcn_sched_barrier(0);
            }
    }
    __syncthreads();
}

constexpr int L_KROWB = 272, L_VROWB = 144, L_SROWB = 272;
constexpr int L_K = 0, L_V = 64 * L_KROWB, L_S = L_V + 32 * L_VROWB, L_END = L_S + 32 * L_SROWB;
DI void gla_item(const Params& p, unsigned char* lds, int b, int hh, int sl) {
    const int tid = threadIdx.x, lane = tid & 63, wave = tid >> 6, l15 = lane & 15, g = lane >> 4;
    const int tt = wave & 3, dvt = wave >> 2;
    unsigned char* ws = p.ws;
    unsigned char* dout = (unsigned char*)p.out;
    const bf16_t* gq = (const bf16_t*)(dout + DO_GQ);
    const bf16_t* gk = (const bf16_t*)(dout + DO_GK);
    const bf16_t* gvT = (const bf16_t*)(ws + OFF_GVT);
    const bf16_t* ktt = (const bf16_t*)(ws + OFF_WIN_T);
    const float* dec = (const float*)(ws + OFF_DEC);
    bf16_t* gz = (bf16_t*)(ws + OFF_GZ);
    float* ssqb = (float*)(ws + OFF_SSQB);
    unsigned char* sK = lds + L_K; unsigned char* sV = lds + L_V; unsigned char* sS = lds + L_S;
    for (int i = tid; i < 32 * L_SROWB / 4; i += 512) ((unsigned*)sS)[i] = 0u;
    f32x4 sacc[2];
#pragma unroll
    for (int c = 0; c < 2; ++c) sacc[c] = (f32x4){0.f, 0.f, 0.f, 0.f};
    u32x4 nk[2]; u32x4 nv; bf16x8 nq[4]; bf16x8 nkt[2][2]; float nd[2]; u32x2 ngz;
    const int cc0 = 16 * (2 * tt) + l15;
    const int krow_ = tid >> 4, kc_ = tid & 15, vdv_ = (tid >> 3) & 31, vc_ = tid & 7;
    const bf16_t* kp = gk + ((size_t)b * 4096 + krow_) * 512 + hh * 128 + kc_ * 8;
    const bf16_t* vp_ = gvT + ((size_t)(b * 4 + hh) * 256 + sl * 32 + vdv_) * 4096 + vc_ * 8;
    const bf16_t* ktp = ktt + ((size_t)(b * 4 + hh) * 128 + cc0) * 4096 + 8 * g;
    const float* dp = dec + (size_t)b * 64 * 512 + hh * 128 + cc0;
    const bf16_t* qp = gq + ((size_t)b * 4096 + 16 * tt + l15) * 512 + hh * 128 + 8 * g;
    bf16_t* gzp = gz + ((size_t)b * 4096 + 16 * tt + l15) * 1024 + hh * 256 + sl * 32 + 16 * dvt + 4 * g;
#define L_LOAD_META()                                                                                                         \
    {                                                                                                                         \
        const bf16_t* km_ = (const bf16_t*)(ws + OFF_KTM) + (size_t)krow_ * 512 + hh * 128 + kc_ * 8;                         \
        nk[0] = *(const u32x4*)km_; nk[1] = *(const u32x4*)(km_ + 32 * 512);                                                  \
        nv = *(const u32x4*)((const bf16_t*)(ws + OFF_GVTM) + (size_t)(hh * 256 + sl * 32 + vdv_) * 64 + vc_ * 8);            \
        _Pragma("unroll") for (int ct = 0; ct < 2; ++ct) _Pragma("unroll") for (int ks = 0; ks < 2; ++ks)                     \
            nkt[ct][ks] = *(const bf16x8*)((const bf16_t*)(ws + OFF_KTTM) + (size_t)(hh * 128 + cc0 + 16 * ct) * 64 + 32 * ks + 8 * g); \
        _Pragma("unroll") for (int ct = 0; ct < 2; ++ct) nd[ct] = ((const float*)(ws + OFF_DECM))[hh * 128 + cc0 + 16 * ct];  \
        _Pragma("unroll") for (int ks = 0; ks < 4; ++ks) nq[ks] = (bf16x8){0, 0, 0, 0, 0, 0, 0, 0};                           \
        ngz = (u32x2){0u, 0u};                                                                                                \
    }
#define L_LOAD_REAL()                                                                                                         \
    {                                                                                                                         \
        nk[0] = *(const u32x4*)kp; nk[1] = *(const u32x4*)(kp + 32 * 512); kp += 64 * 512;                                    \
        nv = *(const u32x4*)vp_; vp_ += 64;                                                                                   \
        _Pragma("unroll") for (int ct = 0; ct < 2; ++ct) _Pragma("unroll") for (int ks = 0; ks < 2; ++ks)                     \
            nkt[ct][ks] = *(const bf16x8*)(ktp + (size_t)(16 * ct) * 4096 + 32 * ks);                                         \
        ktp += 64;                                                                                                            \
        nd[0] = dp[0]; nd[1] = dp[16]; dp += 512;                                                                             \
        _Pragma("unroll") for (int ks = 0; ks < 4; ++ks) nq[ks] = *(const bf16x8*)(qp + 32 * ks);                             \
        qp += 64 * 512;                                                                                                       \
        ngz = *(const u32x2*)gzp; gzp += 64 * 1024;                                                                           \
    }
#define L_STORE()                                                                                                             \
    {                                                                                                                         \
        _Pragma("unroll") for (int i = 0; i < 2; ++i) { const int pi = tid + 512 * i, row = pi >> 4, c = pi & 15;              \
            *(u32x4*)(sK + row * L_KROWB + c * 16) = nk[i]; }                                                                 \
        if (tid < 256) { const int dv = tid >> 3, c = tid & 7; *(u32x4*)(sV + dv * L_VROWB + c * 16) = nv; }                  \
    }
    L_LOAD_META();
    L_STORE();
    for (int n = 0; n <= 64; ++n) {
        bf16x8 cq[4], ckt[2][2]; float cd[2]; u32x2 cgz;
#pragma unroll
        for (int ks = 0; ks < 4; ++ks) cq[ks] = nq[ks];
#pragma unroll
        for (int ct = 0; ct < 2; ++ct) { cd[ct] = nd[ct]; ckt[ct][0] = nkt[ct][0]; ckt[ct][1] = nkt[ct][1]; }
        cgz = ngz;
        __syncthreads();
        if (n + 1 <= 64) L_LOAD_REAL();
        if (n > 0) {
            f32x4 at[4];
#pragma unroll
            for (int jt = 0; jt < 4; ++jt) at[jt] = (f32x4){0.f, 0.f, 0.f, 0.f};
#pragma unroll
            for (int jt = 0; jt < 4; ++jt)
#pragma unroll
                for (int ks = 0; ks < 4; ++ks) {
                    const bf16x8 kf = *(const bf16x8*)(sK + (jt * 16 + l15) * L_KROWB + (ks * 32 + 8 * g) * 2);
                    at[jt] = MFMA16(kf, cq[ks], at[jt]);
                }
            const int tl = 16 * tt + l15;
#pragma unroll
            for (int jt = 0; jt < 4; ++jt)
#pragma unroll
                for (int i = 0; i < 4; ++i) if (16 * jt + 4 * g + i > tl) at[jt][i] = 0.f;
            f32x4 o = (f32x4){0.f, 0.f, 0.f, 0.f};
#pragma unroll
            for (int s2 = 0; s2 < 2; ++s2) {
                u32x4 pa;
                pa.x = pk2(at[2 * s2][0], at[2 * s2][1]); pa.y = pk2(at[2 * s2][2], at[2 * s2][3]);
                pa.z = pk2(at[2 * s2 + 1][0], at[2 * s2 + 1][1]); pa.w = pk2(at[2 * s2 + 1][2], at[2 * s2 + 1][3]);
                const unsigned char* vp = sV + (dvt * 16 + l15) * L_VROWB + (32 * s2 + 4 * g) * 2;
                const u32x2 lo = *(const u32x2*)vp, hi = *(const u32x2*)(vp + 32);
                u32x4 vv; vv.x = lo.x; vv.y = lo.y; vv.z = hi.x; vv.w = hi.y;
                o = MFMA16(__builtin_bit_cast(bf16x8, vv), __builtin_bit_cast(bf16x8, pa), o);
            }
#pragma unroll
            for (int ks = 0; ks < 4; ++ks) {
                const bf16x8 sf = *(const bf16x8*)(sS + (dvt * 16 + l15) * L_SROWB + (ks * 32 + 8 * g) * 2);
                o = MFMA16(sf, cq[ks], o);
            }
            const size_t row = (size_t)b * 4096 + (n - 1) * 64 + 16 * tt + l15;
            float ss = (o[0] * o[0] + o[1] * o[1]) + (o[2] * o[2] + o[3] * o[3]);
            ss += __shfl_xor(ss, 16); ss += __shfl_xor(ss, 32);
            u32x2 ov;
            ov.x = pk2(o[0] * siluf_(bflo(cgz.x)), o[1] * siluf_(bfhi(cgz.x)));
            ov.y = pk2(o[2] * siluf_(bflo(cgz.y)), o[3] * siluf_(bfhi(cgz.y)));
            *(u32x2*)(gz + row * 1024 + hh * 256 + sl * 32 + 16 * dvt + 4 * g) = ov;
            if (g == 0) ssqb[(row * 4 + hh) * 16 + sl * 2 + dvt] = ss;
        }
#pragma unroll
        for (int ks = 0; ks < 2; ++ks) {
            const bf16x8 vf = *(const bf16x8*)(sV + (dvt * 16 + l15) * L_VROWB + (32 * ks + 8 * g) * 2);
            sacc[0] = MFMA16(vf, ckt[0][ks], sacc[0]);
            sacc[1] = MFMA16(vf, ckt[1][ks], sacc[1]);
        }
#pragma unroll
        for (int ct = 0; ct < 2; ++ct)
#pragma unroll
            for (int i = 0; i < 4; ++i) sacc[ct][i] *= cd[ct];
        __syncthreads();
#pragma unroll
        for (int ct = 0; ct < 2; ++ct)
#pragma unroll
            for (int i = 0; i < 4; ++i)
                *(bf16_t*)(sS + (16 * dvt + 4 * g + i) * L_SROWB + (cc0 + 16 * ct) * 2) = f2bf(sacc[ct][i]);
        if (n + 1 <= 64) L_STORE();
    }
#undef L_LOAD_META
#undef L_LOAD_REAL
#undef L_STORE
    __syncthreads();
}

DI void phase2(const Params& p, unsigned char* lds) {
    const int tid = threadIdx.x;
    volatile unsigned* sItem = (volatile unsigned*)(lds + LDS_ITEM);
    constexpr unsigned N_GLA = 16, N_ATT = 128;
    if (tid == 0) sItem[1] = 0u;
    for (;;) {
        if (tid == 0) {
            unsigned* heads = (unsigned*)(p.ws + OFF_CTR);
            const unsigned x0 = (unsigned)__builtin_amdgcn_s_getreg((3 << 11) | 20) & 7u;
            unsigned k = sItem[1], it = 0xffffffffu;
            while (k < 8u) {
                const unsigned x = (x0 + k) & 7u;
                const unsigned got = atomicAdd(heads + x, 1u);
                if (got < N_GLA + N_ATT) { it = got | (x << 16); break; }
                ++k;
            }
            sItem[1] = k; sItem[0] = it;
        }
        __syncthreads();
        const unsigned item = (unsigned)__builtin_amdgcn_readfirstlane((int)sItem[0]);
        __syncthreads();
        if (item == 0xffffffffu) break;
        const unsigned x = item >> 16, idx = item & 0xffffu;
        if (idx < N_GLA) { const unsigned gi = x * 16 + idx; gla_item(p, lds, gi >> 5, (gi >> 3) & 3, gi & 7); }
        else { const unsigned a = idx - N_GLA, pair = 4 * x + (a >> 5); attn_item(p, lds, pair & 3, pair >> 2, 31 - (int)(a & 31)); }
    }
}

DI void phase3(const Params& p, unsigned char* lds) {
    const int tid = threadIdx.x, lane = tid & 63, wave = tid >> 6, l31 = lane & 31, h = lane >> 5;
    const int wn = wave & 1, wm = wave >> 1;
    unsigned char* ws = p.ws;
    const float* ssqb = (const float*)(ws + OFF_SSQB);
    float* sc = (float*)(lds + LDS_SCALE);
    const unsigned char* sga = ws + OFF_SGA;
    const unsigned char* sgb = ws + OFF_SGB;
    bf16_t* merged = (bf16_t*)(ws + OFF_AK);
    for (int id = blockIdx.x; id < 512; id += gridDim.x) {
        const int mt = (id >> 8) * 32 + 4 * (id & 7) + ((id >> 3) & 3), nt = (id >> 5) & 7;
#pragma unroll
        for (int i = 0; i < 2; ++i) {
            const int e = tid + 512 * i, row = e >> 2, hh = e & 3;
            const f32x4* sp = (const f32x4*)(ssqb + (((size_t)mt * 256 + row) * 4 + hh) * 16);
            const f32x4 a = sp[0], b2 = sp[1], c = sp[2], d = sp[3];
            const float s = ((a.x + a.y) + (a.z + a.w)) + ((b2.x + b2.y) + (b2.z + b2.w)) + ((c.x + c.y) + (c.z + c.w)) + ((d.x + d.y) + (d.z + d.w));
            sc[e] = 1.0f / sqrtf(s * (1.0f / 256.0f) + EPS);
        }
        __syncthreads();
        float hs[2][3], rl[2];
#pragma unroll
        for (int im = 0; im < 2; ++im) {
            const int lr = wm * 64 + im * 32 + l31;
            const f32x4 r = *(const f32x4*)(sc + lr * 4);
            hs[im][0] = r.x / r.y; hs[im][1] = r.y / r.z; hs[im][2] = r.z / r.w; rl[im] = r.w;
        }
        f32x16 acc[2][2];
        unsigned mb[2][2][8];
        zero_acc<2>(acc);
        gemm_tile<2, true>(acc, (const bf16_t*)(ws + OFF_WB_T) + (size_t)nt * 128 * 1024, (const bf16_t*)(ws + OFF_GZ) + (size_t)mt * 256 * 1024, lds, hs);
#pragma unroll
        for (int im = 0; im < 2; ++im) {
            const size_t tok = (size_t)mt * 256 + wm * 64 + im * 32 + l31;
#pragma unroll
            for (int in = 0; in < 2; ++in)
#pragma unroll
                for (int g = 0; g < 4; ++g) {
                    const size_t off = tok * 1024 + nt * 128 + wn * 64 + in * 32 + 8 * g + 4 * h;
                    const unsigned ub = *(const unsigned*)(sgb + off);
                    const float q = rl[im] * (1.0f / 255.0f);
                    mb[in][im][2 * g] = pk2((float)(ub & 255u) * q * acc[in][im][4 * g + 0], (float)((ub >> 8) & 255u) * q * acc[in][im][4 * g + 1]);
                    mb[in][im][2 * g + 1] = pk2((float)((ub >> 16) & 255u) * q * acc[in][im][4 * g + 2], (float)(ub >> 24) * q * acc[in][im][4 * g + 3]);
                }
        }
        zero_acc<2>(acc);
        gemm_tile<2, false>(acc, (const bf16_t*)(ws + OFF_WA_T) + (size_t)nt * 128 * 1024, (const bf16_t*)(ws + OFF_AZ) + (size_t)mt * 256 * 1024, lds, hs);
#pragma unroll
        for (int im = 0; im < 2; ++im) {
            const size_t tok = (size_t)mt * 256 + wm * 64 + im * 32 + l31;
#pragma unroll
            for (int in = 0; in < 2; ++in)
#pragma unroll
                for (int g = 0; g < 4; ++g) {
                    const size_t off = tok * 1024 + nt * 128 + wn * 64 + in * 32 + 8 * g + 4 * h;
                    const unsigned ua = *(const unsigned*)(sga + off);
                    const unsigned b0 = mb[in][im][2 * g], b1 = mb[in][im][2 * g + 1];
                    const float q = 1.0f / 255.0f;
                    const float m0 = (float)(ua & 255u) * q * acc[in][im][4 * g + 0] + bflo(b0);
                    const float m1 = (float)((ua >> 8) & 255u) * q * acc[in][im][4 * g + 1] + bfhi(b0);
                    const float m2 = (float)((ua >> 16) & 255u) * q * acc[in][im][4 * g + 2] + bflo(b1);
                    const float m3 = (float)(ua >> 24) * q * acc[in][im][4 * g + 3] + bfhi(b1);
                    u32x2 o; o.x = pk2(m0, m1); o.y = pk2(m2, m3);
                    *(u32x2*)(merged + off) = o;
                }
        }
        __syncthreads();
    }
}

DI void phase4(const Params& p, unsigned char* lds) {
    const int tid = threadIdx.x, lane = tid & 63, wave = tid >> 6, l31 = lane & 31, h = lane >> 5;
    const int wn = wave & 1, wm = wave >> 1;
    unsigned char* ws = p.ws;
    float* ssqh = (float*)(ws + OFF_SSQH);
    for (int id = blockIdx.x; id < 512; id += gridDim.x) {
        const int mt = (id >> 8) * 32 + 4 * (id & 7) + ((id >> 3) & 3), nt = (id >> 5) & 7;
        f32x16 acc[2][2];
        zero_acc<2>(acc);
        const float hs0[2][3] = {{1.f, 1.f, 1.f}, {1.f, 1.f, 1.f}};
        gemm_tile<2, false>(acc, (const bf16_t*)(ws + OFF_WO_T) + (size_t)nt * 128 * 1024, (const bf16_t*)(ws + OFF_AK) + (size_t)mt * 256 * 1024, lds, hs0);
#pragma unroll
        for (int im = 0; im < 2; ++im) {
            const size_t tok = (size_t)mt * 256 + wm * 64 + im * 32 + l31;
            float ss = 0.f;
#pragma unroll
            for (int in = 0; in < 2; ++in)
#pragma unroll
                for (int g = 0; g < 4; ++g) {
                    const size_t off = tok * 1024 + nt * 128 + wn * 64 + in * 32 + 8 * g + 4 * h;
                    const f32x4 xv = *(const f32x4*)(p.x + off);
                    f32x4 o;
                    o.x = xv.x + acc[in][im][4 * g + 0]; o.y = xv.y + acc[in][im][4 * g + 1];
                    o.z = xv.z + acc[in][im][4 * g + 2]; o.w = xv.w + acc[in][im][4 * g + 3];
                    ss += (o.x * o.x + o.y * o.y) + (o.z * o.z + o.w * o.w);
                    *(f32x4*)(p.out + off) = o;
                }
            ss += __shfl_xor(ss, 32);
            if (h == 0) ssqh[tok * 16 + nt * 2 + wn] = ss;
        }
    }
}

DI void phase5(const Params& p, unsigned char* lds) {
    const int tid = threadIdx.x, lane = tid & 63, wave = tid >> 6;
    const float* ssqh = (const float*)(p.ws + OFF_SSQH);
    for (int it = blockIdx.x; it < MROWS / 8; it += gridDim.x) {
        const size_t row = (size_t)it * 8 + wave;
        float s = lane < 16 ? ssqh[row * 16 + lane] : 0.f;
        s = wave_sum(s);
        const float rstd = 1.0f / sqrtf(s * (1.0f / 1024.0f) + EPS);
        f32x4* orow = (f32x4*)(p.out + row * 1024) + lane;
        const f32x4* wrow = (const f32x4*)p.final_w + lane;
#pragma unroll
        for (int j = 0; j < 4; ++j) {
            f32x4 v = orow[64 * j]; const f32x4 w = wrow[64 * j];
            v.x = v.x * rstd * w.x; v.y = v.y * rstd * w.y; v.z = v.z * rstd * w.z; v.w = v.w * rstd * w.w;
            orow[64 * j] = v;
        }
    }
}

#define XB_TMO      128
#define XB_XCNT(j)  (256  + 64 * (j))
#define XB_XSUB(j)  (1280 + 64 * (j))
#define XB_XGEN(j)  (2304 + 64 * (j))
#define XB_TOP      3328
#define XB_TOPGEN   3392
#define XCD_BAR_WORDS 3456
#define XB_SPIN_CAP (1u << 18)
#define LAS __attribute__((address_space(3)))
DI unsigned xb_ld(unsigned* p)              { return __hip_atomic_load(p, __ATOMIC_RELAXED, __HIP_MEMORY_SCOPE_AGENT); }
DI unsigned xb_add(unsigned* p, unsigned v) { return __hip_atomic_fetch_add(p, v, __ATOMIC_RELAXED, __HIP_MEMORY_SCOPE_AGENT); }
DI unsigned xb_xcc_id() { return (unsigned)__builtin_amdgcn_s_getreg((3 << 11) | 20) & 0xFu; }
#define XB_SPIN(cond, bar) do { unsigned _sp = 0; while (cond) { __builtin_amdgcn_s_sleep(1); \
    if ((++_sp & 255u) == 0u) { if (xb_ld(&(bar)[XB_TMO])) break; if (_sp > XB_SPIN_CAP) { atomicAdd(&(bar)[XB_TMO], 1u); break; } } } } while (0)
struct XcdBarrier { unsigned* bar; unsigned x; volatile LAS unsigned* st; };
DI XcdBarrier xcd_barrier_post(unsigned* bar, volatile LAS unsigned* st) {
    XcdBarrier b; b.bar = bar; b.x = xb_xcc_id(); b.st = st;
    if (threadIdx.x == 0) (void)xb_add(&bar[XB_XCNT(b.x)], 1u);
    return b;
}
DI void xcd_barrier_complete(unsigned* bar, unsigned x, unsigned& nloc, unsigned& nx) {
    const unsigned G = gridDim.x * gridDim.y * gridDim.z;
    unsigned sum, cnt, mine, sp = 0u;
    for (;;) {
        sum = 0u; cnt = 0u; mine = 0u;
#pragma unroll
        for (unsigned j = 0; j < 16; ++j) { const unsigned c = xb_ld(&bar[XB_XCNT(j)]); sum += c; cnt += (c > 0u) ? 1u : 0u; mine = (j == x) ? c : mine; }
        if (sum == G) break;
        __builtin_amdgcn_s_sleep(1);
        if ((++sp & 255u) == 0u) { if (xb_ld(&bar[XB_TMO])) break; if (sp > XB_SPIN_CAP) { atomicAdd(&bar[XB_TMO], 1u); break; } }
    }
    nloc = mine > 0u ? mine : 1u; nx = cnt > 0u ? cnt : 1u;
}
DI void xcd_barrier(const XcdBarrier& b) {
    asm volatile("s_waitcnt vmcnt(0)" ::: "memory");
    __syncthreads();
    if (threadIdx.x == 0) {
        unsigned* bar = b.bar;
        __builtin_amdgcn_s_waitcnt(0);
        unsigned nloc = b.st[0], nx = b.st[1];
        if (nloc == 0u) { xcd_barrier_complete(bar, b.x, nloc, nx); b.st[0] = nloc; b.st[1] = nx; }
        const unsigned old = xb_add(&bar[XB_XSUB(b.x)], 1u);
        const unsigned gen = old / nloc;
        if (old + 1u == (gen + 1u) * nloc) {
            __builtin_amdgcn_fence(__ATOMIC_RELEASE, "agent");
            asm volatile("s_waitcnt vmcnt(0)" ::: "memory");
            const unsigned og = xb_add(&bar[XB_TOP], 1u);
            const unsigned tg = og / nx;
            if (og + 1u == (tg + 1u) * nx) xb_add(&bar[XB_TOPGEN], 1u);
            else XB_SPIN(xb_ld(&bar[XB_TOPGEN]) == tg, bar);
            __builtin_amdgcn_fence(__ATOMIC_ACQUIRE, "agent");
            xb_add(&bar[XB_XGEN(b.x)], 1u);
            asm volatile("s_waitcnt vmcnt(0)" ::: "memory");
        } else {
            XB_SPIN(xb_ld(&bar[XB_XGEN(b.x)]) == gen, bar);
            __builtin_amdgcn_fence(__ATOMIC_ACQUIRE, "agent");
            asm volatile("s_waitcnt vmcnt(0)" ::: "memory");
        }
    }
    __syncthreads();
}

DI void run_phase(const Params& p, unsigned char* lds, int ph) {
    switch (ph) {
        case 0: phase0(p, lds); break;
        case 1: phase1(p, lds); break;
        case 2: phase15(p, lds); break;
        case 3: phase2(p, lds); break;
        case 4: phase3(p, lds); break;
        case 5: phase4(p, lds); break;
        default: phase5(p, lds); break;
    }
}

__global__ void __launch_bounds__(512) hybrid_fwd(Params p) {
    extern __shared__ __attribute__((aligned(16))) unsigned char lds[];
#if MULTI_LAUNCH
    run_phase(p, lds, p.phase_lo);
#else
    cg::grid_group grid = cg::this_grid();
    if (p.phase_lo == 77) grid.sync();
    volatile LAS unsigned* st = (volatile LAS unsigned*)(lds + LDS_ITEM + 16);
    if (threadIdx.x == 0) { st[0] = 0u; st[1] = 0u; }
    __syncthreads();
    XcdBarrier xb = xcd_barrier_post((unsigned*)(p.ws + OFF_XBAR), st);
    phase0(p, lds); xcd_barrier(xb);
    phase1(p, lds); xcd_barrier(xb);
    phase15(p, lds); xcd_barrier(xb);
    phase2(p, lds); xcd_barrier(xb);
    phase3(p, lds); xcd_barrier(xb);
    phase4(p, lds); xcd_barrier(xb);
    phase5(p, lds);
#endif
}

extern "C" void kernel_launch(void* const* d_in, const int* in_sizes, int n_in, void* d_out, int out_size, void* d_ws, size_t ws_size, hipStream_t stream) {
    static int grid = 0;
    if (grid == 0) {
        int dev = 0, cus = 0, per_cu = 0;
        hipGetDevice(&dev);
        hipDeviceGetAttribute(&cus, hipDeviceAttributeMultiprocessorCount, dev);
        hipFuncSetAttribute((const void*)hybrid_fwd, hipFuncAttributeMaxDynamicSharedMemorySize, LDS_BYTES);
        hipOccupancyMaxActiveBlocksPerMultiprocessor(&per_cu, (const void*)hybrid_fwd, 512, LDS_BYTES);
        if (per_cu < 1) per_cu = 1;
        if (per_cu > 1) per_cu = 1;
        if (cus <= 0) cus = 256;
        grid = cus * per_cu;
    }
    hipMemsetAsync((unsigned char*)d_ws + OFF_CTR, 0, 256, stream);
    hipMemsetAsync((unsigned char*)d_ws + OFF_XBAR, 0, 16384, stream);
    Params p{};
    p.x = (const float*)d_in[0]; p.meta = (const float*)d_in[1]; p.norm_w = (const float*)d_in[2]; p.w_in = (const float*)d_in[3];
    p.lq1 = (const float*)d_in[4]; p.lk1 = (const float*)d_in[5]; p.lq2 = (const float*)d_in[6]; p.lk2 = (const float*)d_in[7];
    p.subln_w = (const float*)d_in[8]; p.gate_w2 = (const float*)d_in[9]; p.gate_b = (const float*)d_in[10]; p.gla_norm_w = (const float*)d_in[11];
    p.wa = (const float*)d_in[12]; p.wb = (const float*)d_in[13]; p.wo = (const float*)d_in[14]; p.final_w = (const float*)d_in[15];
    p.out = (float*)d_out; p.ws = (unsigned char*)d_ws;
#if MULTI_LAUNCH
    for (int ph = 0; ph < 7; ++ph) {
        p.phase_lo = ph; p.phase_hi = ph + 1;
        hipLaunchKernelGGL(hybrid_fwd, dim3(grid), dim3(512), LDS_BYTES, stream, p);
    }
#else
    p.phase_lo = 0; p.phase_hi = 7;
    void* args[] = {&p};
    hipError_t e = hipLaunchCooperativeKernel((const void*)hybrid_fwd, dim3(grid), dim3(512), args, LDS_BYTES, stream);
    if (e != hipSuccess) fprintf(stderr, "cooperative launch failed: %s (grid %d)\n", hipGetErrorString(e), grid);
#endif
}
```

```cpp
#include <hip/hip_runtime.h>
#include <hip/hip_cooperative_groups.h>
#include <cstdio>
#include <cstdint>
namespace cg = cooperative_groups;

#ifndef MULTI_LAUNCH
#define MULTI_LAUNCH 0
#endif
#ifndef PROBE_REP
#define PROBE_REP 0
#endif

typedef unsigned short bf16_t;
typedef short bf16x8 __attribute__((ext_vector_type(8)));
typedef float f32x4 __attribute__((ext_vector_type(4)));
typedef float f32x2 __attribute__((ext_vector_type(2)));
typedef float f32x16 __attribute__((ext_vector_type(16)));
typedef unsigned u32x4 __attribute__((ext_vector_type(4)));
typedef unsigned u32x2 __attribute__((ext_vector_type(2)));
typedef __bf16 bfv2 __attribute__((ext_vector_type(2)));

#define DI __device__ __forceinline__
#define MFMA32(a, b, c) __builtin_amdgcn_mfma_f32_32x32x16_bf16((a), (b), (c), 0, 0, 0)
#define MFMA16(a, b, c) __builtin_amdgcn_mfma_f32_16x16x32_bf16((a), (b), (c), 0, 0, 0)

DI unsigned pk2(float a, float b) { f32x2 v = {a, b}; return __builtin_bit_cast(unsigned, __builtin_convertvector(v, bfv2)); }
DI float bf2f(bf16_t v) { return __uint_as_float(((unsigned)v) << 16); }
DI float bflo(unsigned u) { return __uint_as_float(u << 16); }
DI float bfhi(unsigned u) { return __uint_as_float(u & 0xffff0000u); }
DI bf16_t f2bf(float a) { return (bf16_t)(pk2(a, 0.f) & 0xffffu); }
DI float wave_sum(float v) {
#pragma unroll
    for (int o = 32; o; o >>= 1) v += __shfl_xor(v, o);
    return v;
}
DI int opaque_tid() { int t = threadIdx.x; asm volatile("" : "+v"(t)); return t; }
DI float sigmoidf_(float z) { return 1.f / (1.f + __expf(-z)); }
DI float siluf_(float z) { return z / (1.f + __expf(-z)); }

constexpr int D = 1024, NB = 4, SEQ = 4096, MROWS = NB * SEQ;
constexpr int NIN = 9232, NINP = 9344;
constexpr float EPS = 1e-5f;

constexpr size_t SZ_ACT = (size_t)MROWS * 1024 * 2;
constexpr size_t OFF_WIN_T = 0;
constexpr size_t OFF_WA_T = OFF_WIN_T + (size_t)NINP * 1024 * 2;
constexpr size_t OFF_WB_T = OFF_WA_T + 2097152;
constexpr size_t OFF_WO_T = OFF_WB_T + 2097152;
constexpr size_t OFF_AK = OFF_WO_T + 2097152;
constexpr size_t OFF_AVT = OFF_AK + SZ_ACT;
constexpr size_t OFF_AZ = OFF_AVT + SZ_ACT;
constexpr size_t OFF_GVT = OFF_AZ + SZ_ACT;
constexpr size_t OFF_GZ = OFF_GVT + SZ_ACT;
constexpr size_t OFF_GA = OFF_GZ + SZ_ACT;
constexpr size_t OFF_GB = OFF_GA + SZ_ACT;
constexpr size_t OFF_GLR = OFF_GB + SZ_ACT;
constexpr size_t OFF_RSTD = OFF_GLR + (size_t)MROWS * 16 * 2;
constexpr size_t OFF_ROPE = OFF_RSTD + 65792;
constexpr size_t OFF_AKM = OFF_ROPE + 263168;
constexpr size_t OFF_AVTM = OFF_AKM + 131072;
constexpr size_t OFF_GVTM = OFF_AVTM + 131072;
constexpr size_t OFF_GKM = OFF_GVTM + 131072;
constexpr size_t OFF_GLRM = OFF_GKM + 16384;
constexpr size_t OFF_KTM = OFF_GLRM + 512;
constexpr size_t OFF_KTTM = OFF_KTM + 65536;
constexpr size_t OFF_DEC = OFF_KTTM + 65536;
constexpr size_t OFF_DECM = OFF_DEC + 524288;
constexpr size_t OFF_SSQB = OFF_DECM + 2048;
constexpr size_t OFF_SSQH = OFF_SSQB + 4194304;
constexpr size_t OFF_CTR = OFF_SSQH + 1048576;
constexpr size_t OFF_XBM = OFF_CTR + 256;
constexpr size_t OFF_XBAR = OFF_XBM + 32768;
constexpr size_t WS_END = OFF_XBAR + 16384;
constexpr size_t OFF_XB = OFF_GA;
constexpr size_t OFF_SGA = OFF_GB;
constexpr size_t OFF_SGB = OFF_GB + (size_t)MROWS * 1024;
static_assert(WS_END <= 268435456ull, "workspace over 256 MiB");
constexpr size_t DO_AQ = 0, DO_GQ = SZ_ACT, DO_GK = SZ_ACT + SZ_ACT / 2;

constexpr int G_ROWB = 144;
constexpr int G_SW = 128 * G_ROWB, G_SX = 256 * G_ROWB, G_STAGE = G_SW + G_SX;
constexpr int G_SW4 = 256 * G_ROWB, G_STAGE4 = G_SW4 + G_SX;
constexpr int LDS_SCALE = 2 * G_STAGE4;
constexpr int LDS_ITEM = LDS_SCALE + 4096;
constexpr int LDS_BYTES = LDS_ITEM + 64;

struct Params {
    const float *x, *meta, *norm_w, *w_in, *lq1, *lk1, *lq2, *lk2, *subln_w, *gate_w2, *gate_b, *gla_norm_w, *wa, *wb, *wo, *final_w;
    float* out;
    unsigned char* ws;
    int phase_lo, phase_hi;
};

template <int MODE>
DI void p0_transpose_item(const Params& p, int item, float* tile) {
    const int tid = opaque_tid();
    const float* W = MODE == 0 ? p.w_in : MODE == 1 ? p.wa : MODE == 2 ? p.wb : p.wo;
    const int ldw = MODE == 0 ? NIN : 1024;
    const int nbc = MODE == 0 ? NINP / 64 : 16;
    bf16_t* WT = (bf16_t*)(p.ws + (MODE == 0 ? OFF_WIN_T : MODE == 1 ? OFF_WA_T : MODE == 2 ? OFF_WB_T : OFF_WO_T));
    const int kb = item / nbc, nb = item % nbc, k0 = kb * 64, n0 = nb * 64;
#pragma unroll
    for (int i = 0; i < 8; ++i) {
        const int kk = (tid >> 6) + 8 * i, nn = tid & 63, n = n0 + nn, k = k0 + kk;
        int src = n;
        if (MODE == 0) { src = n < 7168 ? n : (n < 9216 ? n + 16 : (n < 9232 ? n - 2048 : -1)); }
        float sc = 1.f;
        if (MODE == 0) sc = p.norm_w[k];
        if (MODE == 1) sc = 0.8f * p.subln_w[k & 127];
        if (MODE == 2) sc = p.gla_norm_w[k & 255];
        float v = 0.f;
        if (src >= 0) v = W[(size_t)k * ldw + src] * sc;
        tile[kk * 65 + nn] = v;
    }
    __syncthreads();
    {
        const int nn = tid >> 3, c = tid & 7;
        const float* s = tile + (8 * c) * 65 + nn;
        u32x4 o;
        o.x = pk2(s[0 * 65], s[1 * 65]); o.y = pk2(s[2 * 65], s[3 * 65]); o.z = pk2(s[4 * 65], s[5 * 65]); o.w = pk2(s[6 * 65], s[7 * 65]);
        *(u32x4*)(WT + (size_t)(n0 + nn) * 1024 + k0 + 8 * c) = o;
    }
    __syncthreads();
}

DI void phase0(const Params& p, unsigned char* lds) {
    const int tid = opaque_tid(), lane = tid & 63, wave = tid >> 6;
    float* tile = (float*)lds;
    constexpr int I_WIN = 16 * (NINP / 64), I_SQ = 256;
    constexpr int I_T = I_WIN + 3 * I_SQ;
    constexpr int I_RSTD = (MROWS + 16 + 7) / 8;
    constexpr int I_ROPE = (4112 * 8 + 511) / 512;
    constexpr int I_ZERO = 393216 / 8192;
    constexpr int I_ALL = I_T + I_RSTD + I_ROPE + I_ZERO;
    for (int it = blockIdx.x; it < I_ALL; it += gridDim.x) {
        int r = it;
        if (r < I_WIN) { p0_transpose_item<0>(p, r, tile); continue; } r -= I_WIN;
        if (r < I_SQ) { p0_transpose_item<1>(p, r, tile); continue; } r -= I_SQ;
        if (r < I_SQ) { p0_transpose_item<2>(p, r, tile); continue; } r -= I_SQ;
        if (r < I_SQ) { p0_transpose_item<3>(p, r, tile); continue; } r -= I_SQ;
        if (r < I_RSTD) {
            const int row = r * 8 + wave;
            if (row < MROWS + 16) {
                const float* src = row < MROWS ? p.x + (size_t)row * 1024 : p.meta + (size_t)(row - MROWS) * 1024;
                const f32x4* xr = (const f32x4*)src + lane;
                float s = 0.f;
#pragma unroll
                for (int j = 0; j < 4; ++j) { const f32x4 v = xr[64 * j]; s += (v.x * v.x + v.y * v.y) + (v.z * v.z + v.w * v.w); }
                s = wave_sum(s);
                if (lane == 0) ((float*)(p.ws + OFF_RSTD))[row] = 1.0f / sqrtf(s * (1.0f / 1024.0f) + EPS);
                bf16_t* xbrow = row < MROWS ? (bf16_t*)(p.ws + OFF_XB) + (size_t)row * 1024 : (bf16_t*)(p.ws + OFF_XBM) + (size_t)(row - MROWS) * 1024;
#pragma unroll
                for (int j = 0; j < 4; ++j) { const f32x4 v = xr[64 * j]; u32x2 o; o.x = pk2(v.x, v.y); o.y = pk2(v.z, v.w); *(u32x2*)(xbrow + 256 * j + 4 * lane) = o; }
            }
            continue;
        }
        r -= I_RSTD;
        if (r < I_ROPE) {
            const int e = r * 512 + tid;
            if (e < 4112 * 8) {
                const int pos = e >> 3, i = e & 7;
                const float inv = powf(500000.0f, -(float)i / 8.0f);
                const float ang = (float)pos * inv;
                float* t = (float*)(p.ws + OFF_ROPE) + (size_t)e * 2;
                t[0] = cosf(ang); t[1] = sinf(ang);
            }
            continue;
        }
        r -= I_ROPE;
        { u32x4 z = {0u, 0u, 0u, 0u}; *(u32x4*)(p.ws + OFF_AKM + (size_t)r * 8192 + tid * 16) = z; }
    }
}

template <int NI, bool HS>
DI void gemm_tile(f32x16 (&acc)[NI][2], const bf16_t* __restrict__ Wt, const bf16_t* __restrict__ X, unsigned char* lds, const float (&hs)[2][3]) {
    const int tid = opaque_tid(), lane = tid & 63, wave = tid >> 6, l31 = lane & 31, h = lane >> 5;
    const int wn = wave & 1, wm = wave >> 1;
    constexpr int SW = NI * 64 * G_ROWB, STAGE = SW + G_SX;
    u32x4 wreg[NI];
    u32x4 xreg[4];
    const int prow = tid >> 3, pc = tid & 7;
    const bf16_t* wp = Wt + (size_t)prow * 1024 + pc * 8;
    const bf16_t* xp = X + (size_t)prow * 1024 + pc * 8;
#define G_LOAD(kt_)                                                                                                  \
    {                                                                                                                \
        _Pragma("unroll") for (int i = 0; i < NI; ++i) wreg[i] = *(const u32x4*)(wp + (size_t)i * 64 * 1024 + (kt_) * 64); \
        _Pragma("unroll") for (int i = 0; i < 4; ++i) xreg[i] = *(const u32x4*)(xp + (size_t)i * 64 * 1024 + (kt_) * 64);  \
    }
#define G_STORE(buf_)                                                                                                \
    {                                                                                                                \
        unsigned char* sW_ = lds + (buf_) * STAGE + prow * G_ROWB + pc * 16; unsigned char* sX_ = sW_ + SW;          \
        _Pragma("unroll") for (int i = 0; i < NI; ++i) *(u32x4*)(sW_ + i * 64 * G_ROWB) = wreg[i];                   \
        _Pragma("unroll") for (int i = 0; i < 4; ++i) *(u32x4*)(sX_ + i * 64 * G_ROWB) = xreg[i];                    \
    }
    G_LOAD(0);
    G_STORE(0);
    __syncthreads();
    for (int kt = 0; kt < 16; ++kt) {
        if (kt + 1 < 16) G_LOAD(kt + 1);
        if (HS) {
            if (kt == 4 || kt == 8 || kt == 12) {
                const float s0 = kt == 4 ? hs[0][0] : (kt == 8 ? hs[0][1] : hs[0][2]);
                const float s1 = kt == 4 ? hs[1][0] : (kt == 8 ? hs[1][1] : hs[1][2]);
#pragma unroll
                for (int n = 0; n < NI; ++n)
#pragma unroll
                    for (int i = 0; i < 16; ++i) { acc[n][0][i] *= s0; acc[n][1][i] *= s1; }
            }
        }
        {
            const unsigned char* sW = lds + (kt & 1) * STAGE + (wn * NI * 32 + l31) * G_ROWB + h * 16;
            const unsigned char* sX = lds + (kt & 1) * STAGE + SW + (wm * 64 + l31) * G_ROWB + h * 16;
#pragma unroll
            for (int ks = 0; ks < 4; ++ks) {
                const bf16x8 x0 = *(const bf16x8*)(sX + ks * 32), x1 = *(const bf16x8*)(sX + 32 * G_ROWB + ks * 32);
#pragma unroll
                for (int n = 0; n < NI; ++n) {
                    const bf16x8 w = *(const bf16x8*)(sW + n * 32 * G_ROWB + ks * 32);
                    acc[n][0] = MFMA32(w, x0, acc[n][0]); acc[n][1] = MFMA32(w, x1, acc[n][1]);
                }
            }
        }
        if (kt + 1 < 16) G_STORE((kt + 1) & 1);
        __syncthreads();
    }
#undef G_LOAD
#undef G_STORE
}

template <int NI>
DI void zero_acc(f32x16 (&acc)[NI][2]) {
#pragma unroll
    for (int a = 0; a < NI; ++a)
#pragma unroll
        for (int b = 0; b < 2; ++b)
#pragma unroll
            for (int i = 0; i < 16; ++i) acc[a][b][i] = 0.f;
}

namespace pg8 {
#define PG8_LAS __attribute__((address_space(3)))
typedef unsigned short bf16_t;
typedef short bf16x8 __attribute__((ext_vector_type(8)));
typedef float f32x4 __attribute__((ext_vector_type(4)));
typedef unsigned u32x4 __attribute__((ext_vector_type(4)));
constexpr int BM = 256, BK = 64, HALF = 128, HTB = HALF * BK * 2  , STAGE_BYTES = 8 * HTB, NXCD = 8, WGM = 8;

__host__ __device__ __forceinline__ int lds_byte(int r, int c) { const int st = (r >> 4) * 2 + (c >> 5), rr = r & 15, cc = c & 31, ob = rr * 64 + cc * 2; return st * 1024 + (ob ^ (((ob >> 9) & 1) << 5)); }
__host__ __device__ __forceinline__ void stage_rc(int b, int& R, int& C) { const int st = b / 1024, sb = b % 1024, swz = sb ^ (((sb >> 9) & 1) << 5); R = (st >> 1) * 16 + swz / 64; C = (st & 1) * 32 + (swz % 64) / 2; }
__host__ __device__ __forceinline__ int perm32(int rho) { const int n = rho >> 4, i = rho & 15; return 8 * (i >> 2) + 4 * n + (i & 3); }

struct Unit { int pm, pn; };
struct Gemm { const bf16_t* A; const bf16_t* Bt; int M, N, K; };

template <class Epi, class Sched, bool ALIGN_EPI = false, bool SP2 = false>
__device__ __forceinline__ void gemm_phase(PG8_LAS unsigned char* lds, const Gemm g, const Sched& S, const Epi& E) {
    const int tid = opaque_tid(), wid = __builtin_amdgcn_readfirstlane(tid >> 6), lane = tid & 63, wr = wid >> 2, wc = wid & 3, fr = lane & 15, fq = lane >> 4;
    const int K = g.K, nt = K / BK;
    unsigned voffA[2], voffB[2];
#pragma unroll
    for (int i = 0; i < 2; ++i) { int R, C; stage_rc(tid * 16 + i * 8192, R, C); const int Rb = Epi::PERM ? ((R & ~31) + perm32(R & 31)) : R;
        voffA[i] = (unsigned)(R * K + C) * 2u; voffB[i] = (unsigned)(Rb * K + C) * 2u; }
    const size_t kstep = (size_t)(BK * 2);
    const size_t hstep = (size_t)HALF * K * 2;
    const size_t tstep = 2 * hstep;
    const unsigned ldsw = (unsigned)wid * 1024u;
    const int aoff = lds_byte(wr * 64 + fr, fq * 8), boff = lds_byte(wc * 32 + fr, fq * 8);
#define PG8_SA(b, h) (((b) * 2 + (h)) * HTB)
#define PG8_SB(b, h) ((4 + (b) * 2 + (h)) * HTB)
#define PG8_STAGE(bufoff, gbase, voff) do { _Pragma("unroll") for (int _i = 0; _i < 2; ++_i) \
        __builtin_amdgcn_global_load_lds((const unsigned*)((const char*)(gbase) + (voff)[_i]), (PG8_LAS unsigned*)(lds + (bufoff) + ldsw + _i * 8192), 16, 0, 0); } while (0)
#define PG8_LDA(dst, b, h) do { _Pragma("unroll") for (int m = 0; m < 4; ++m) _Pragma("unroll") for (int k = 0; k < 2; ++k) dst[m][k] = *(const PG8_LAS bf16x8*)(lds + PG8_SA(b, h) + aoff + m * 2048 + k * 1024); } while (0)
#define PG8_LDB(dst, b, h) do { _Pragma("unroll") for (int n = 0; n < 2; ++n) _Pragma("unroll") for (int k = 0; k < 2; ++k) dst[n][k] = *(const PG8_LAS bf16x8*)(lds + PG8_SB(b, h) + boff + n * 2048 + k * 1024); } while (0)
#define PG8_MMA(ai, bj, At, Bt) do { __builtin_amdgcn_s_setprio(1); _Pragma("unroll") for (int m = 0; m < 4; ++m) _Pragma("unroll") for (int n = 0; n < 2; ++n) _Pragma("unroll") for (int k = 0; k < 2; ++k) \
        acc[ai][bj][m][n] = __builtin_amdgcn_mfma_f32_16x16x32_bf16(Bt[n][k], At[m][k], acc[ai][bj][m][n], 0, 0, 0); __builtin_amdgcn_s_setprio(0); } while (0)
#define PG8_WAIT_V(n) asm volatile("s_waitcnt vmcnt(" #n ")" ::: "memory")
#define PG8_WAIT_L(n) asm volatile("s_waitcnt lgkmcnt(" #n ")" ::: "memory")
#define PG8_BAR __builtin_amdgcn_s_barrier()
#define PG8_SCHED __builtin_amdgcn_sched_barrier(0)
    Unit cur, nxt; int ui = 0;
    if (!S.next(0, cur)) return;
    f32x4 acc[2][2][4][2];
#pragma unroll
    for (int a = 0; a < 2; ++a)
#pragma unroll
        for (int b = 0; b < 2; ++b)
#pragma unroll
            for (int m = 0; m < 4; ++m)
#pragma unroll
                for (int n = 0; n < 2; ++n) acc[a][b][m][n] = (f32x4){0.f, 0.f, 0.f, 0.f};
    bf16x8 At[4][2], B0[2][2], B1[2][2];
    const char* cA = (const char*)g.A + (size_t)cur.pm * tstep; const char* cB = (const char*)g.Bt + (size_t)cur.pn * tstep;
    S.a_ready(cur);
    if constexpr (SP2) {
        PG8_STAGE(PG8_SB(0, 0), cB, voffB); PG8_STAGE(PG8_SB(0, 1), cB + hstep, voffB); PG8_STAGE(PG8_SA(0, 0), cA, voffA); PG8_STAGE(PG8_SA(0, 1), cA + hstep, voffA);
        if (wr == 1) PG8_BAR;
        PG8_WAIT_V(2); PG8_BAR;
        PG8_STAGE(PG8_SB(1, 0), cB + kstep, voffB); PG8_STAGE(PG8_SA(1, 0), cA + kstep, voffA); PG8_STAGE(PG8_SB(1, 1), cB + hstep + kstep, voffB);
        PG8_WAIT_V(6); PG8_BAR;
    } else {
        PG8_STAGE(PG8_SB(0, 0), cB, voffB); PG8_STAGE(PG8_SA(0, 0), cA, voffA); PG8_STAGE(PG8_SB(0, 1), cB + hstep, voffB); PG8_STAGE(PG8_SA(0, 1), cA + hstep, voffA);
        if (wr == 1) PG8_BAR;
        PG8_WAIT_V(4); PG8_BAR;
        PG8_STAGE(PG8_SB(1, 0), cB + kstep, voffB); PG8_STAGE(PG8_SA(1, 0), cA + kstep, voffA); PG8_STAGE(PG8_SB(1, 1), cB + hstep + kstep, voffB);
        PG8_WAIT_V(6); PG8_BAR;
    }
    for (;;) {
        const bool has_next = S.next(ui + 1, nxt);
        const char* nA = has_next ? (const char*)g.A + (size_t)nxt.pm * tstep : cA; const char* nB = has_next ? (const char*)g.Bt + (size_t)nxt.pn * tstep : cB;
        for (int t = 0; t < nt; t += 2) {
            const bool last = (t == nt - 2);
            const char* a1 = cA + (size_t)(t + 1) * kstep;
            const char* a2 = last ? nA : cA + (size_t)(t + 2) * kstep; const char* b2 = last ? nB : cB + (size_t)(t + 2) * kstep;
            const char* a3 = a2 + kstep; const char* b3 = b2 + kstep;
            if (last && has_next) S.a_ready(nxt);
            if constexpr (SP2) {
            PG8_LDB(B0, 0, 0); PG8_LDB(B1, 0, 1); PG8_SCHED; PG8_LDA(At, 0, 0); PG8_STAGE(PG8_SA(1, 1), a1 + hstep, voffA);
            PG8_WAIT_V(8); PG8_WAIT_L(0); PG8_BAR; PG8_MMA(0, 0, At, B0); PG8_MMA(0, 1, At, B1); PG8_BAR; PG8_SCHED;
            PG8_LDA(At, 0, 1); PG8_STAGE(PG8_SB(0, 0), b2, voffB); PG8_STAGE(PG8_SB(0, 1), b2 + hstep, voffB); PG8_STAGE(PG8_SA(0, 0), a2, voffA);
            PG8_WAIT_V(8); PG8_WAIT_L(0); PG8_BAR; PG8_MMA(1, 0, At, B0); PG8_MMA(1, 1, At, B1); PG8_BAR; PG8_SCHED;
            PG8_LDB(B0, 1, 0); PG8_LDB(B1, 1, 1); PG8_SCHED; PG8_LDA(At, 1, 0); PG8_STAGE(PG8_SA(0, 1), a2 + hstep, voffA);
            PG8_WAIT_V(8); PG8_WAIT_L(0); PG8_BAR; PG8_MMA(0, 0, At, B0); PG8_MMA(0, 1, At, B1); PG8_BAR; PG8_SCHED;
            PG8_LDA(At, 1, 1); PG8_STAGE(PG8_SB(1, 0), b3, voffB); PG8_STAGE(PG8_SB(1, 1), b3 + hstep, voffB); PG8_STAGE(PG8_SA(1, 0), a3, voffA);
            PG8_WAIT_V(8); PG8_WAIT_L(0); PG8_BAR; PG8_MMA(1, 0, At, B0); PG8_MMA(1, 1, At, B1); PG8_BAR; PG8_SCHED;
            } else {
            PG8_LDB(B0, 0, 0); PG8_SCHED; PG8_LDA(At, 0, 0); PG8_STAGE(PG8_SA(1, 1), a1 + hstep, voffA);
            PG8_WAIT_L(8); PG8_BAR; PG8_WAIT_L(0); PG8_MMA(0, 0, At, B0); PG8_BAR; PG8_SCHED;
            PG8_LDB(B1, 0, 1); PG8_STAGE(PG8_SB(0, 0), b2, voffB);
            PG8_BAR; PG8_WAIT_L(0); PG8_MMA(0, 1, At, B1); PG8_BAR;
            PG8_LDA(At, 0, 1); PG8_STAGE(PG8_SA(0, 0), a2, voffA);
            PG8_BAR; PG8_WAIT_L(0); PG8_MMA(1, 0, At, B0); PG8_BAR; PG8_SCHED;
            PG8_STAGE(PG8_SB(0, 1), b2 + hstep, voffB);
            PG8_WAIT_V(6); PG8_BAR; PG8_MMA(1, 1, At, B1); PG8_BAR;
            PG8_LDB(B0, 1, 0); PG8_SCHED; PG8_LDA(At, 1, 0); PG8_STAGE(PG8_SA(0, 1), a2 + hstep, voffA);
            PG8_WAIT_L(8); PG8_BAR; PG8_WAIT_L(0); PG8_MMA(0, 0, At, B0); PG8_BAR; PG8_SCHED;
            PG8_LDB(B1, 1, 1); PG8_STAGE(PG8_SB(1, 0), b3, voffB);
            PG8_BAR; PG8_WAIT_L(0); PG8_MMA(0, 1, At, B1); PG8_BAR;
            PG8_LDA(At, 1, 1); PG8_STAGE(PG8_SA(1, 0), a3, voffA);
            PG8_BAR; PG8_WAIT_L(0); PG8_MMA(1, 0, At, B0); PG8_BAR; PG8_SCHED;
            PG8_STAGE(PG8_SB(1, 1), b3 + hstep, voffB);
            PG8_WAIT_V(6); PG8_BAR; PG8_MMA(1, 1, At, B1); PG8_BAR;
            }
        }
        if constexpr (ALIGN_EPI) { if (wr == 0) PG8_BAR; }
        if constexpr (!Epi::AFTER_DRAIN) { E(acc, cur, wr, wc, fr, fq); S.done(cur); }
        if (!has_next) break;
#pragma unroll
        for (int a = 0; a < 2; ++a)
#pragma unroll
            for (int b = 0; b < 2; ++b)
#pragma unroll
                for (int m = 0; m < 4; ++m)
#pragma unroll
                    for (int n = 0; n < 2; ++n) acc[a][b][m][n] = (f32x4){0.f, 0.f, 0.f, 0.f};
        cur = nxt; cA = nA; cB = nB; ++ui;
        if constexpr (ALIGN_EPI) { if (wr == 1) PG8_BAR; }
    }
    PG8_WAIT_V(0);
    if constexpr (!ALIGN_EPI) { if (wr == 0) PG8_BAR; }
    PG8_BAR;
    if constexpr (Epi::AFTER_DRAIN) { E.fused(acc, cur, wr, wc, fr, fq, lds, wid, lane); S.done(cur); }
#undef PG8_SA
#undef PG8_SB
#undef PG8_STAGE
#undef PG8_LDA
#undef PG8_LDB
#undef PG8_MMA
#undef PG8_WAIT_V
#undef PG8_WAIT_L
#undef PG8_BAR
#undef PG8_SCHED
}
}

DI unsigned sig_u8(float z) { return (unsigned)(255.0f / (1.0f + __expf(-z)) + 0.5f); }
struct SchedP1 {
    DI bool next(int i, pg8::Unit& u) const {
        constexpr int NT = 36;
        const int id = (int)blockIdx.x + i * (int)gridDim.x;
        if (id >= 64 * NT) return false;
        const int g = id / (16 * NT), rem = id % (16 * NT), reg = rem >> 8, w = rem & 255, x = w & 7, j = w >> 3;
        int mt = g * 16 + 4 * (x & 3) + (j & 3), nt = reg * 16 + 8 * (x >> 2) + (j >> 2);
        if (reg == 2) { const int e = rem - 512; nt = 32 + (e >> 4); mt = g * 16 + (e & 15); }
        u.pm = mt; u.pn = nt; return true;
    }
    DI void a_ready(const pg8::Unit&) const {}
    DI void done(const pg8::Unit&) const {}
};
struct SchedSq {
    DI bool next(int i, pg8::Unit& u) const {
        const int id = (int)blockIdx.x + i * (int)gridDim.x;
        if (id >= 256) return false;
        u.pm = 8 * (id & 7) + ((id >> 3) & 7); u.pn = id >> 6; return true;
    }
    DI void a_ready(const pg8::Unit&) const {}
    DI void done(const pg8::Unit&) const {}
};
struct EpiInProj {
    static constexpr bool PERM = false, AFTER_DRAIN = false;
    unsigned char* ws; unsigned char* dout;
    DI void operator()(const pg8::f32x4 (&acc)[2][2][4][2], const pg8::Unit& u, int wr, int wc, int fr, int fq) const {
        const int nt = u.pn;
        int split, nc0;
        if (nt < 4) { split = 0; nc0 = nt * 256; }
        else if (nt < 8) { split = 1; nc0 = (nt - 4) * 256; }
        else if (nt < 12) { split = 2; nc0 = (nt - 8) * 256; }
        else if (nt < 16) { split = 3; nc0 = (nt - 12) * 256; }
        else if (nt < 18) { split = 4; nc0 = (nt - 16) * 256; }
        else if (nt < 20) { split = 5; nc0 = (nt - 18) * 256; }
        else if (nt < 24) { split = 6; nc0 = (nt - 20) * 256; }
        else if (nt < 28) { split = 7; nc0 = (nt - 24) * 256; }
        else if (nt < 32) { split = 9; nc0 = (nt - 28) * 256; }
        else { split = 10; nc0 = (nt - 32) * 256; }
        const float* rstd = (const float*)(ws + OFF_RSTD);
        const float* rope = (const float*)(ws + OFF_ROPE);
        const bool do_rope = split <= 1 && (wc & 1) == 0;
#pragma unroll
        for (int ai = 0; ai < 2; ++ai)
#pragma unroll
            for (int m = 0; m < 4; ++m) {
                const int tok = u.pm * 256 + ai * 128 + wr * 64 + m * 16 + fr;
                const float rs = rstd[tok];
                const int pos = 16 + (tok & 4095), b = tok >> 12, s = tok & 4095;
#pragma unroll
                for (int bj = 0; bj < 2; ++bj)
#pragma unroll
                    for (int n = 0; n < 2; ++n) {
                        const int nb = nc0 + bj * 128 + wc * 32 + n * 16 + 4 * fq;
                        float v[4];
#pragma unroll
                        for (int j = 0; j < 4; ++j) v[j] = acc[ai][bj][m][n][j] * rs;
                        if (n == 0 && do_rope) {
                            const float* cs = rope + ((size_t)pos * 8 + 4 * (fq & 1)) * 2;
#pragma unroll
                            for (int j = 0; j < 4; ++j) {
                                const float other = __shfl_xor(v[j], 32);
                                const float c = cs[2 * j], sn = cs[2 * j + 1];
                                v[j] = fq < 2 ? (v[j] * c - other * sn) : (v[j] * c + other * sn);
                            }
                        }
                        if (split == 2 || split == 6) {
                            const int hshift = split == 2 ? 7 : 8, nheads = split == 2 ? 8 : 4, dvn = 1 << hshift;
                            bf16_t* base = (bf16_t*)(ws + (split == 2 ? OFF_AVT : OFF_GVT));
#pragma unroll
                            for (int j = 0; j < 4; ++j) {
                                const int nn = nb + j, hd = nn >> hshift, dv = nn & (dvn - 1);
                                base[((size_t)(b * nheads + hd) * dvn + dv) * 4096 + s] = f2bf(v[j]);
                            }
                        } else if (split >= 9) {
                            const unsigned o = sig_u8(v[0]) | (sig_u8(v[1]) << 8) | (sig_u8(v[2]) << 16) | (sig_u8(v[3]) << 24);
                            *(unsigned*)(ws + (split == 9 ? OFF_SGA : OFF_SGB) + (size_t)tok * 1024 + nb) = o;
                        } else {
                            bf16_t* dst; int ld;
                            switch (split) {
                                case 0: dst = (bf16_t*)(dout + DO_AQ); ld = 1024; break;
                                case 1: dst = (bf16_t*)(ws + OFF_AK); ld = 1024; break;
                                case 3: dst = (bf16_t*)(ws + OFF_AZ); ld = 1024; break;
                                case 4: dst = (bf16_t*)(dout + DO_GQ); ld = 512; break;
                                case 5: dst = (bf16_t*)(dout + DO_GK); ld = 512; break;
                                default: dst = (bf16_t*)(ws + OFF_GZ); ld = 1024; break;
                            }
                            u32x2 o; o.x = pk2(v[0], v[1]); o.y = pk2(v[2], v[3]);
                            *(u32x2*)(dst + (size_t)tok * ld + nb) = o;
                        }
                    }
            }
    }
};

DI void p1_glr_job(const Params& p, unsigned char* lds, int job) {
    const int tid = opaque_tid(), lane = tid & 63, wave = tid >> 6, l15 = lane & 15, g = lane >> 4;
    const int rtile = wave & 3, khalf = wave >> 2;
    const bf16_t* xb = (const bf16_t*)(p.ws + OFF_XB);
    const bf16_t* wt = (const bf16_t*)(p.ws + OFF_WIN_T) + (size_t)9216 * 1024;
    const size_t row0 = (size_t)job * 64 + rtile * 16;
    const bf16_t* ap = xb + (row0 + l15) * 1024 + khalf * 512 + 8 * g;
    const bf16_t* bp = wt + (size_t)l15 * 1024 + khalf * 512 + 8 * g;
    f32x4 acc = (f32x4){0.f, 0.f, 0.f, 0.f};
#pragma unroll 4
    for (int ks = 0; ks < 16; ++ks) {
        const bf16x8 a = *(const bf16x8*)(ap + ks * 32), bb = *(const bf16x8*)(bp + ks * 32);
        acc = MFMA16(a, bb, acc);
    }
    f32x4* red = (f32x4*)lds;
    __syncthreads();
    if (khalf == 1) red[rtile * 64 + lane] = acc;
    __syncthreads();
    if (khalf == 0) {
        const f32x4 o = red[rtile * 64 + lane];
        const float* rstd = (const float*)(p.ws + OFF_RSTD);
        bf16_t* glr = (bf16_t*)(p.ws + OFF_GLR);
#pragma unroll
        for (int i = 0; i < 4; ++i) {
            const size_t row = row0 + 4 * g + i;
            glr[row * 16 + l15] = f2bf((acc[i] + o[i]) * rstd[row]);
        }
    }
    __syncthreads();
}

DI void p1_meta_job(const Params& p, unsigned char* lds, int job) {
    const int tid = opaque_tid(), lane = tid & 63, wave = tid >> 6, l15 = lane & 15, g = lane >> 4;
    int c0;
    if (job < 64) c0 = 1024 + job * 16;
    else if (job < 128) c0 = 2048 + (job - 64) * 16;
    else if (job < 160) c0 = 4608 + (job - 128) * 16;
    else if (job < 224) c0 = 5120 + (job - 160) * 16;
    else c0 = 9216;
    const bf16_t* xbm = (const bf16_t*)(p.ws + OFF_XBM);
    const bf16_t* wt = (const bf16_t*)(p.ws + OFF_WIN_T);
    const bf16_t* ap = xbm + (size_t)l15 * 1024 + wave * 128 + 8 * g;
    const bf16_t* bp = wt + (size_t)(c0 + l15) * 1024 + wave * 128 + 8 * g;
    f32x4 acc = (f32x4){0.f, 0.f, 0.f, 0.f};
#pragma unroll
    for (int ks = 0; ks < 4; ++ks) {
        const bf16x8 a = *(const bf16x8*)(ap + ks * 32), bb = *(const bf16x8*)(bp + ks * 32);
        acc = MFMA16(a, bb, acc);
    }
    f32x4* red = (f32x4*)lds;
    __syncthreads();
    red[wave * 64 + lane] = acc;
    __syncthreads();
    if (wave == 0) {
        f32x4 s = red[lane];
#pragma unroll
        for (int w = 1; w < 8; ++w) { const f32x4 t = red[w * 64 + lane]; s.x += t.x; s.y += t.y; s.z += t.z; s.w += t.w; }
        const float* rstd = (const float*)(p.ws + OFF_RSTD) + MROWS;
        const float* rope = (const float*)(p.ws + OFF_ROPE);
        unsigned char* ws = p.ws;
        const int col = c0 + l15;
#pragma unroll
        for (int i = 0; i < 4; ++i) {
            const int row = 4 * g + i;
            float v = s[i] * rstd[row];
            if (job < 64 && (c0 & 63) == 0) {
                const float other = __shfl_xor(v, 8);
                const float* cs = rope + ((size_t)row * 8 + (l15 & 7)) * 2;
                const float c = cs[0], sn = cs[1];
                v = (l15 < 8) ? (v * c - other * sn) : (v * c + other * sn);
            }
            const bf16_t val = f2bf(v);
            if (job < 64) ((bf16_t*)(ws + OFF_AKM))[(size_t)(48 + row) * 1024 + (col - 1024)] = val;
            else if (job < 128) { const int n = col - 2048; ((bf16_t*)(ws + OFF_AVTM))[(size_t)n * 64 + 48 + row] = val; }
            else if (job < 160) ((bf16_t*)(ws + OFF_GKM))[(size_t)row * 512 + (col - 4608)] = val;
            else if (job < 224) { const int n = col - 5120; ((bf16_t*)(ws + OFF_GVTM))[(size_t)n * 64 + 48 + row] = val; }
            else ((bf16_t*)(ws + OFF_GLRM))[row * 16 + l15] = val;
        }
    }
    __syncthreads();
}

DI void phase1(const Params& p, unsigned char* lds) {
    for (int j = blockIdx.x; j < 256; j += gridDim.x) p1_glr_job(p, lds, j);
    for (int j = blockIdx.x; j < 225; j += gridDim.x) p1_meta_job(p, lds, j);
    pg8::Gemm g; g.A = (const bf16_t*)(p.ws + OFF_XB); g.Bt = (const bf16_t*)(p.ws + OFF_WIN_T); g.M = MROWS; g.N = 9216; g.K = 1024;
    SchedP1 S; EpiInProj E; E.ws = p.ws; E.dout = (unsigned char*)p.out;
    pg8::gemm_phase<EpiInProj, SchedP1, true, true>((PG8_LAS unsigned char*)lds, g, S, E);
}

DI void phase15(const Params& p, unsigned char* lds) {
    const int tid = opaque_tid(), col = tid;
    float w2[16];
#pragma unroll
    for (int j = 0; j < 16; ++j) w2[j] = p.gate_w2[j * 512 + col];
    const float bias = p.gate_b[col];
    unsigned char* ws = p.ws;
    unsigned char* dout = (unsigned char*)p.out;
    for (int item = blockIdx.x; item < 257; item += gridDim.x) {
        const bool meta = item == 256;
        const int b = item >> 6, c = item & 63;
        const size_t row0 = (size_t)b * 4096 + c * 64;
        const bf16_t* glr = meta ? (const bf16_t*)(ws + OFF_GLRM) : (const bf16_t*)(ws + OFF_GLR) + row0 * 16;
        const int nrows = meta ? 16 : 64;
        bf16_t* qp = (bf16_t*)(dout + DO_GQ) + row0 * 512 + col;
        const bf16_t* kin = meta ? (const bf16_t*)(ws + OFF_GKM) + col : (const bf16_t*)(dout + DO_GK) + row0 * 512 + col;
        bf16_t* kout = meta ? (bf16_t*)(ws + OFF_KTM) + 48 * 512 + col : (bf16_t*)(dout + DO_GK) + row0 * 512 + col;
        bf16_t* ktt = meta ? (bf16_t*)(ws + OFF_KTTM) + (size_t)col * 64 + 48 : (bf16_t*)(ws + OFF_WIN_T) + ((size_t)b * 512 + col) * 4096 + c * 64;
        __syncthreads();
        if (tid < nrows * 2) ((u32x4*)lds)[tid] = ((const u32x4*)glr)[tid];
        __syncthreads();
        float bsum = 0.f;
        bf16_t kc[8], qc[8], kn[8], qn[8];
#pragma unroll
        for (int rr = 0; rr < 8; ++rr) { kc[rr] = kin[(size_t)rr * 512]; qc[rr] = meta ? (bf16_t)0 : qp[(size_t)rr * 512]; }
        for (int r0 = 0; r0 < nrows; r0 += 8) {
            if (r0 + 8 < nrows) {
#pragma unroll
                for (int rr = 0; rr < 8; ++rr) { kn[rr] = kin[(size_t)(r0 + 8 + rr) * 512]; qn[rr] = meta ? (bf16_t)0 : qp[(size_t)(r0 + 8 + rr) * 512]; }
            }
            float kt8[8];
#pragma unroll
            for (int rr = 0; rr < 8; ++rr) {
                const int r = r0 + rr;
                const u32x4* g4 = (const u32x4*)(lds + r * 32);
                const u32x4 ga = g4[0], gb = g4[1];
                float gk = bias;
                gk += bflo(ga.x) * w2[0] + bfhi(ga.x) * w2[1] + bflo(ga.y) * w2[2] + bfhi(ga.y) * w2[3];
                gk += bflo(ga.z) * w2[4] + bfhi(ga.z) * w2[5] + bflo(ga.w) * w2[6] + bfhi(ga.w) * w2[7];
                gk += bflo(gb.x) * w2[8] + bfhi(gb.x) * w2[9] + bflo(gb.y) * w2[10] + bfhi(gb.y) * w2[11];
                gk += bflo(gb.z) * w2[12] + bfhi(gb.z) * w2[13] + bflo(gb.w) * w2[14] + bfhi(gb.w) * w2[15];
                const float lg = (fminf(gk, 0.f) - log1pf(expf(-fabsf(gk)))) * (1.0f / 16.0f);
                bsum += lg;
                const float kt = bf2f(kc[rr]) * expf(-bsum);
                kt8[rr] = kt;
                kout[(size_t)r * 512] = f2bf(kt);
                if (!meta) qp[(size_t)r * 512] = f2bf(bf2f(qc[rr]) * 0.08838834764831845f * expf(bsum));
            }
            u32x4 o; o.x = pk2(kt8[0], kt8[1]); o.y = pk2(kt8[2], kt8[3]); o.z = pk2(kt8[4], kt8[5]); o.w = pk2(kt8[6], kt8[7]);
            *(u32x4*)(ktt + r0) = o;
#pragma unroll
            for (int rr = 0; rr < 8; ++rr) { kc[rr] = kn[rr]; qc[rr] = qn[rr]; }
        }
        if (meta) {
            ((float*)(ws + OFF_DECM))[col] = expf(bsum);
            bf16_t* km = (bf16_t*)(ws + OFF_KTM);
            for (int r = 0; r < 48; ++r) km[r * 512 + col] = 0;
            u32x4 z = {0u, 0u, 0u, 0u};
            u32x4* kz = (u32x4*)((bf16_t*)(ws + OFF_KTTM) + (size_t)col * 64);
#pragma unroll
            for (int j = 0; j < 6; ++j) kz[j] = z;
        } else {
            ((float*)(ws + OFF_DEC))[((size_t)b * 64 + c) * 512 + col] = expf(bsum);
        }
    }
}

constexpr int A_KROWB = 272, A_VROWB = 144, A_KB = 64 * A_KROWB, A_VB = 128 * A_VROWB, A_STAGE = A_KB + A_VB;
DI void attn_tile(const unsigned char* sK, const unsigned char* sV, int tt, int qb, int qs, int sub, int l31, int h,
                  const bf16x8 (&qf)[4], f32x16 (&O)[4], float& m, float& l) {
    const float SC = 0.125f * 1.4426950408889634f;
    f32x16 st[2];
#pragma unroll
    for (int k2 = 0; k2 < 2; ++k2)
#pragma unroll
        for (int i = 0; i < 16; ++i) st[k2][i] = 0.f;
#pragma unroll
    for (int k2 = 0; k2 < 2; ++k2)
#pragma unroll
        for (int ks = 0; ks < 4; ++ks) {
            const bf16x8 kf = *(const bf16x8*)(sK + (k2 * 32 + l31) * A_KROWB + (sub * 64 + ks * 16 + 8 * h) * 2);
            st[k2] = MFMA32(kf, qf[ks], st[k2]);
        }
    if (tt == 0) {
#pragma unroll
        for (int i = 0; i < 16; ++i) { st[0][i] = -INFINITY; if (i < 8) st[1][i] = -INFINITY; }
    } else if (tt >= 2 * qb + 1) {
        const int kbase = (tt - 1) * 64 + 4 * h;
#pragma unroll
        for (int k2 = 0; k2 < 2; ++k2)
#pragma unroll
            for (int i = 0; i < 16; ++i) {
                const int key = kbase + k2 * 32 + (i & 3) + 8 * (i >> 2);
                if (key > qs) st[k2][i] = -INFINITY;
            }
    }
    float mx = -INFINITY;
#pragma unroll
    for (int k2 = 0; k2 < 2; ++k2)
#pragma unroll
        for (int i = 0; i < 16; ++i) mx = fmaxf(mx, st[k2][i]);
    mx = fmaxf(mx, __shfl_xor(mx, 32));
    const float mnew = fmaxf(m, mx);
    const float alpha = __builtin_amdgcn_exp2f((m - mnew) * SC);
    const float mc = mnew * SC;
    m = mnew;
    float ps = 0.f;
#pragma unroll
    for (int k2 = 0; k2 < 2; ++k2)
#pragma unroll
        for (int i = 0; i < 16; ++i) { const float pv = __builtin_amdgcn_exp2f(st[k2][i] * SC - mc); st[k2][i] = pv; ps += pv; }
    l = l * alpha + ps;
#pragma unroll
    for (int d = 0; d < 4; ++d)
#pragma unroll
        for (int i = 0; i < 16; ++i) O[d][i] *= alpha;
    bf16x8 pb[4];
#pragma unroll
    for (int k4 = 0; k4 < 4; ++k4) {
        const int k2 = k4 >> 1, o8 = 8 * (k4 & 1);
        u32x4 pk;
        pk.x = pk2(st[k2][o8 + 0], st[k2][o8 + 1]); pk.y = pk2(st[k2][o8 + 2], st[k2][o8 + 3]);
        pk.z = pk2(st[k2][o8 + 4], st[k2][o8 + 5]); pk.w = pk2(st[k2][o8 + 6], st[k2][o8 + 7]);
        pb[k4] = __builtin_bit_cast(bf16x8, pk);
    }
#pragma unroll
    for (int d = 0; d < 4; ++d)
#pragma unroll
        for (int k4 = 0; k4 < 4; ++k4) {
            const bf16x8 vv = *(const bf16x8*)(sV + (d * 32 + l31) * A_VROWB + k4 * 32 + 16 * h);
            O[d] = MFMA32(vv, pb[k4], O[d]);
        }
}

DI void attn_item(const Params& p, unsigned char* lds, int b, int hd, int qb) {
    const int tid = opaque_tid(), lane = tid & 63, wave = tid >> 6, l31 = lane & 31, h = lane >> 5;
    const int sub = wave >> 2, rt = wave & 3;
    const bf16_t* aq = (const bf16_t*)((unsigned char*)p.out + DO_AQ);
    const bf16_t* ak = (const bf16_t*)(p.ws + OFF_AK);
    const bf16_t* avT = (const bf16_t*)(p.ws + OFF_AVT);
    const bf16_t* akm = (const bf16_t*)(p.ws + OFF_AKM);
    const bf16_t* avTm = (const bf16_t*)(p.ws + OFF_AVTM);
    bf16_t* az = (bf16_t*)(p.ws + OFF_AZ);
    const int qs = qb * 128 + rt * 32 + l31;
    const size_t grow = (size_t)b * 4096 + qs;
    bf16x8 qf[4];
#pragma unroll
    for (int ks = 0; ks < 4; ++ks) qf[ks] = *(const bf16x8*)(aq + grow * 1024 + hd * 128 + sub * 64 + ks * 16 + 8 * h);
    f32x16 O[4];
#pragma unroll
    for (int d = 0; d < 4; ++d)
#pragma unroll
        for (int i = 0; i < 16; ++i) O[d][i] = 0.f;
    float m = -INFINITY, l = 0.f;
    const int T = 2 * qb + 3;
    u32x4 k0r[2], v0r[2];
    const int krow_ = tid >> 4, kc_ = tid & 15, vdv_ = tid >> 3, vc_ = tid & 7;
    const bf16_t* kp = ak + ((size_t)b * 4096 + krow_) * 1024 + hd * 128 + kc_ * 8;
    const bf16_t* vp_ = avT + ((size_t)(b * 8 + hd) * 128 + vdv_) * 4096 + vc_ * 8;
#define A_LOAD_REAL(KR, VR)                                                                                                   \
    {                                                                                                                         \
        KR[0] = *(const u32x4*)kp; KR[1] = *(const u32x4*)(kp + 32 * 1024); kp += 64 * 1024;                                  \
        VR[0] = *(const u32x4*)vp_; VR[1] = *(const u32x4*)(vp_ + (size_t)64 * 4096); vp_ += 64;                              \
    }
#define A_STORE(KR, VR, buf_)                                                                                                 \
    {                                                                                                                         \
        unsigned char* sK_ = lds + (buf_) * A_STAGE; unsigned char* sV_ = sK_ + A_KB;                                         \
        _Pragma("unroll") for (int i = 0; i < 2; ++i) { const int pi = tid + 512 * i, row = pi >> 4, c = pi & 15;              \
            *(u32x4*)(sK_ + row * A_KROWB + c * 16) = KR[i]; }                                                                \
        _Pragma("unroll") for (int i = 0; i < 2; ++i) { const int pi = tid + 512 * i, dv = pi >> 3, c = pi & 7;                \
            unsigned char* d_ = sV_ + dv * A_VROWB + (c >> 1) * 32 + 8 * (c & 1); u32x2 a_, b_; a_.x = VR[i].x; a_.y = VR[i].y; b_.x = VR[i].z; b_.y = VR[i].w; \
            *(u32x2*)d_ = a_; *(u32x2*)(d_ + 16) = b_; }                                                                      \
    }
    {
        const bf16_t* km_ = akm + (size_t)krow_ * 1024 + hd * 128 + kc_ * 8;
        k0r[0] = *(const u32x4*)km_; k0r[1] = *(const u32x4*)(km_ + 32 * 1024);
        const bf16_t* vm_ = avTm + (size_t)(hd * 128 + vdv_) * 64 + vc_ * 8;
        v0r[0] = *(const u32x4*)vm_; v0r[1] = *(const u32x4*)(vm_ + 64 * 64);
    }
    A_STORE(k0r, v0r, 0);
    __syncthreads();
    for (int tt = 0; tt < T; ++tt) {
        if (tt + 1 < T) A_LOAD_REAL(k0r, v0r);
        attn_tile(lds + (tt & 1) * A_STAGE, lds + (tt & 1) * A_STAGE + A_KB, tt, qb, qs, sub, l31, h, qf, O, m, l);
        if (tt + 1 < T) A_STORE(k0r, v0r, (tt + 1) & 1);
        __syncthreads();
    }
#undef A_LOAD_REAL
#undef A_STORE
    float lam;
    {
        const float a_ = wave_sum(p.lq1[lane] * p.lk1[lane]);
        const float b_ = wave_sum(p.lq2[lane] * p.lk2[lane]);
        lam = expf(a_) - expf(b_) + 0.2f;
    }
    const float ltot = l + __shfl_xor(l, 32);
    const float linv = 1.0f / ltot;
    float* ex = (float*)lds;
    if (sub == 1) {
#pragma unroll
        for (int d = 0; d < 4; ++d)
#pragma unroll
            for (int i = 0; i < 16; ++i) { ex[(rt * 32 + l31) * 129 + d * 32 + (i & 3) + 8 * (i >> 2) + 4 * h] = O[d][i] * linv; if (i == 15) __builtin_amdgcn_sched_barrier(0); }
    }
    __syncthreads();
    if (sub == 0) {
        float ss = 0.f;
#pragma unroll
        for (int d = 0; d < 4; ++d)
#pragma unroll
            for (int i = 0; i < 16; ++i) {
                const float o2 = ex[(rt * 32 + l31) * 129 + d * 32 + (i & 3) + 8 * (i >> 2) + 4 * h];
                const float o = O[d][i] * linv - lam * o2;
                O[d][i] = o; ss += o * o;
                if (i == 15) __builtin_amdgcn_sched_barrier(0);
            }
        ss += __shfl_xor(ss, 32);
        const float rstd = 1.0f / sqrtf(ss * (1.0f / 128.0f) + EPS);
#pragma unroll
        for (int d = 0; d < 4; ++d)
#pragma unroll
            for (int g = 0; g < 4; ++g) {
                bf16_t* zp = az + grow * 1024 + hd * 128 + d * 32 + 8 * g + 4 * h;
                const u32x2 zz = *(const u32x2*)zp;
                u32x2 o;
                o.x = pk2(O[d][4 * g] * rstd * siluf_(bflo(zz.x)), O[d][4 * g + 1] * rstd * siluf_(bfhi(zz.x)));
                o.y = pk2(O[d][4 * g + 2] * rstd * siluf_(bflo(zz.y)), O[d][4 * g + 3] * rstd * siluf_(bfhi(zz.y)));
                *(u32x2*)zp = o;
                if (g == 3) __builtin_amdgcn_sched_barrier(0);
            }
    }
    __syncthreads();
}

constexpr int L_KROWB = 272, L_VROWB = 144, L_SROWB = 272;
constexpr int L_K = 0, L_V = 64 * L_KROWB, L_S = L_V + 32 * L_VROWB, L_END = L_S + 32 * L_SROWB;
DI void gla_item(const Params& p, unsigned char* lds, int b, int hh, int sl) {
    const int tid = opaque_tid(), lane = tid & 63, wave = tid >> 6, l15 = lane & 15, g = lane >> 4;
    const int tt = wave & 3, dvt = wave >> 2;
    unsigned char* ws = p.ws;
    unsigned char* dout = (unsigned char*)p.out;
    const bf16_t* gq = (const bf16_t*)(dout + DO_GQ);
    const bf16_t* gk = (const bf16_t*)(dout + DO_GK);
    const bf16_t* gvT = (const bf16_t*)(ws + OFF_GVT);
    const bf16_t* ktt = (const bf16_t*)(ws + OFF_WIN_T);
    const float* dec = (const float*)(ws + OFF_DEC);
    bf16_t* gz = (bf16_t*)(ws + OFF_GZ);
    float* ssqb = (float*)(ws + OFF_SSQB);
    unsigned char* sK = lds + L_K; unsigned char* sV = lds + L_V; unsigned char* sS = lds + L_S;
    for (int i = tid; i < 32 * L_SROWB / 4; i += 512) ((unsigned*)sS)[i] = 0u;
    f32x4 sacc[2];
#pragma unroll
    for (int c = 0; c < 2; ++c) sacc[c] = (f32x4){0.f, 0.f, 0.f, 0.f};
    u32x4 nk[2]; u32x4 nv; bf16x8 nq[4]; bf16x8 nkt[2][2]; float nd[2]; u32x2 ngz;
    const int cc0 = 16 * (2 * tt) + l15;
    const int krow_ = tid >> 4, kc_ = tid & 15, vdv_ = (tid >> 3) & 31, vc_ = tid & 7;
    const bf16_t* kp = gk + ((size_t)b * 4096 + krow_) * 512 + hh * 128 + kc_ * 8;
    const bf16_t* vp_ = gvT + ((size_t)(b * 4 + hh) * 256 + sl * 32 + vdv_) * 4096 + vc_ * 8;
    const bf16_t* ktp = ktt + ((size_t)(b * 4 + hh) * 128 + cc0) * 4096 + 8 * g;
    const float* dp = dec + (size_t)b * 64 * 512 + hh * 128 + cc0;
    const bf16_t* qp = gq + ((size_t)b * 4096 + 16 * tt + l15) * 512 + hh * 128 + 8 * g;
    bf16_t* gzp = gz + ((size_t)b * 4096 + 16 * tt + l15) * 1024 + hh * 256 + sl * 32 + 16 * dvt + 4 * g;
#define L_LOAD_META()                                                                                                         \
    {                                                                                                                         \
        const bf16_t* km_ = (const bf16_t*)(ws + OFF_KTM) + (size_t)krow_ * 512 + hh * 128 + kc_ * 8;                         \
        nk[0] = *(const u32x4*)km_; nk[1] = *(const u32x4*)(km_ + 32 * 512);                                                  \
        nv = *(const u32x4*)((const bf16_t*)(ws + OFF_GVTM) + (size_t)(hh * 256 + sl * 32 + vdv_) * 64 + vc_ * 8);            \
        _Pragma("unroll") for (int ct = 0; ct < 2; ++ct) _Pragma("unroll") for (int ks = 0; ks < 2; ++ks)                     \
            nkt[ct][ks] = *(const bf16x8*)((const bf16_t*)(ws + OFF_KTTM) + (size_t)(hh * 128 + cc0 + 16 * ct) * 64 + 32 * ks + 8 * g); \
        _Pragma("unroll") for (int ct = 0; ct < 2; ++ct) nd[ct] = ((const float*)(ws + OFF_DECM))[hh * 128 + cc0 + 16 * ct];  \
        _Pragma("unroll") for (int ks = 0; ks < 4; ++ks) nq[ks] = (bf16x8){0, 0, 0, 0, 0, 0, 0, 0};                           \
        ngz = (u32x2){0u, 0u};                                                                                                \
    }
#define L_LOAD_REAL()                                                                                                         \
    {                                                                                                                         \
        nk[0] = *(const u32x4*)kp; nk[1] = *(const u32x4*)(kp + 32 * 512); kp += 64 * 512;                                    \
        nv = *(const u32x4*)vp_; vp_ += 64;                                                                                   \
        _Pragma("unroll") for (int ct = 0; ct < 2; ++ct) _Pragma("unroll") for (int ks = 0; ks < 2; ++ks)                     \
            nkt[ct][ks] = *(const bf16x8*)(ktp + (size_t)(16 * ct) * 4096 + 32 * ks);                                         \
        ktp += 64;                                                                                                            \
        nd[0] = dp[0]; nd[1] = dp[16]; dp += 512;                                                                             \
        _Pragma("unroll") for (int ks = 0; ks < 4; ++ks) nq[ks] = *(const bf16x8*)(qp + 32 * ks);                             \
        qp += 64 * 512;                                                                                                       \
        ngz = *(const u32x2*)gzp; gzp += 64 * 1024;                                                                           \
    }
#define L_STORE()                                                                                                             \
    {                                                                                                                         \
        _Pragma("unroll") for (int i = 0; i < 2; ++i) { const int pi = tid + 512 * i, row = pi >> 4, c = pi & 15;              \
            *(u32x4*)(sK + row * L_KROWB + c * 16) = nk[i]; }                                                                 \
        if (tid < 256) { const int dv = tid >> 3, c = tid & 7; *(u32x4*)(sV + dv * L_VROWB + c * 16) = nv; }                  \
    }
    L_LOAD_META();
    L_STORE();
    for (int n = 0; n <= 64; ++n) {
        bf16x8 cq[4], ckt[2][2]; float cd[2]; u32x2 cgz;
#pragma unroll
        for (int ks = 0; ks < 4; ++ks) cq[ks] = nq[ks];
#pragma unroll
        for (int ct = 0; ct < 2; ++ct) { cd[ct] = nd[ct]; ckt[ct][0] = nkt[ct][0]; ckt[ct][1] = nkt[ct][1]; }
        cgz = ngz;
        __syncthreads();
        if (n + 1 <= 64) L_LOAD_REAL();
        if (n > 0) {
            f32x4 at[4];
#pragma unroll
            for (int jt = 0; jt < 4; ++jt) at[jt] = (f32x4){0.f, 0.f, 0.f, 0.f};
#pragma unroll
            for (int jt = 0; jt < 4; ++jt)
#pragma unroll
                for (int ks = 0; ks < 4; ++ks) {
                    const bf16x8 kf = *(const bf16x8*)(sK + (jt * 16 + l15) * L_KROWB + (ks * 32 + 8 * g) * 2);
                    at[jt] = MFMA16(kf, cq[ks], at[jt]);
                }
            const int tl = 16 * tt + l15;
#pragma unroll
            for (int jt = 0; jt < 4; ++jt)
#pragma unroll
                for (int i = 0; i < 4; ++i) if (16 * jt + 4 * g + i > tl) at[jt][i] = 0.f;
            f32x4 o = (f32x4){0.f, 0.f, 0.f, 0.f};
#pragma unroll
            for (int s2 = 0; s2 < 2; ++s2) {
                u32x4 pa;
                pa.x = pk2(at[2 * s2][0], at[2 * s2][1]); pa.y = pk2(at[2 * s2][2], at[2 * s2][3]);
                pa.z = pk2(at[2 * s2 + 1][0], at[2 * s2 + 1][1]); pa.w = pk2(at[2 * s2 + 1][2], at[2 * s2 + 1][3]);
                const unsigned char* vp = sV + (dvt * 16 + l15) * L_VROWB + (32 * s2 + 4 * g) * 2;
                const u32x2 lo = *(const u32x2*)vp, hi = *(const u32x2*)(vp + 32);
                u32x4 vv; vv.x = lo.x; vv.y = lo.y; vv.z = hi.x; vv.w = hi.y;
                o = MFMA16(__builtin_bit_cast(bf16x8, vv), __builtin_bit_cast(bf16x8, pa), o);
            }
#pragma unroll
            for (int ks = 0; ks < 4; ++ks) {
                const bf16x8 sf = *(const bf16x8*)(sS + (dvt * 16 + l15) * L_SROWB + (ks * 32 + 8 * g) * 2);
                o = MFMA16(sf, cq[ks], o);
            }
            const size_t row = (size_t)b * 4096 + (n - 1) * 64 + 16 * tt + l15;
            float ss = (o[0] * o[0] + o[1] * o[1]) + (o[2] * o[2] + o[3] * o[3]);
            ss += __shfl_xor(ss, 16); ss += __shfl_xor(ss, 32);
            u32x2 ov;
            ov.x = pk2(o[0] * siluf_(bflo(cgz.x)), o[1] * siluf_(bfhi(cgz.x)));
            ov.y = pk2(o[2] * siluf_(bflo(cgz.y)), o[3] * siluf_(bfhi(cgz.y)));
            *(u32x2*)(gz + row * 1024 + hh * 256 + sl * 32 + 16 * dvt + 4 * g) = ov;
            if (g == 0) ssqb[(row * 4 + hh) * 16 + sl * 2 + dvt] = ss;
        }
#pragma unroll
        for (int ks = 0; ks < 2; ++ks) {
            const bf16x8 vf = *(const bf16x8*)(sV + (dvt * 16 + l15) * L_VROWB + (32 * ks + 8 * g) * 2);
            sacc[0] = MFMA16(vf, ckt[0][ks], sacc[0]);
            sacc[1] = MFMA16(vf, ckt[1][ks], sacc[1]);
        }
#pragma unroll
        for (int ct = 0; ct < 2; ++ct)
#pragma unroll
            for (int i = 0; i < 4; ++i) sacc[ct][i] *= cd[ct];
        __syncthreads();
#pragma unroll
        for (int ct = 0; ct < 2; ++ct)
#pragma unroll
            for (int i = 0; i < 4; ++i)
                *(bf16_t*)(sS + (16 * dvt + 4 * g + i) * L_SROWB + (cc0 + 16 * ct) * 2) = f2bf(sacc[ct][i]);
        if (n + 1 <= 64) L_STORE();
    }
#undef L_LOAD_META
#undef L_LOAD_REAL
#undef L_STORE
    __syncthreads();
}

DI void phase2(const Params& p, unsigned char* lds) {
    const int tid = opaque_tid();
    volatile unsigned* sItem = (volatile unsigned*)(lds + LDS_ITEM);
    constexpr unsigned N_GLA = 16, N_ATT = 128;
    if (tid == 0) sItem[1] = 0u;
    for (;;) {
        if (tid == 0) {
            unsigned* heads = (unsigned*)(p.ws + OFF_CTR);
            const unsigned x0 = (unsigned)__builtin_amdgcn_s_getreg((3 << 11) | 20) & 7u;
            unsigned k = sItem[1], it = 0xffffffffu;
            while (k < 8u) {
                const unsigned x = (x0 + k) & 7u;
                const unsigned got = atomicAdd(heads + x, 1u);
                if (got < N_GLA + N_ATT) { it = got | (x << 16); break; }
                ++k;
            }
            sItem[1] = k; sItem[0] = it;
        }
        __syncthreads();
        const unsigned item = (unsigned)__builtin_amdgcn_readfirstlane((int)sItem[0]);
        __syncthreads();
        if (item == 0xffffffffu) break;
        const unsigned x = item >> 16, idx = item & 0xffffu;
        if (idx < N_GLA) { const unsigned gi = x * 16 + idx; gla_item(p, lds, gi >> 5, (gi >> 3) & 3, gi & 7); }
        else { const unsigned a = idx - N_GLA, pair = 4 * x + (a >> 5); attn_item(p, lds, pair & 3, pair >> 2, 31 - (int)(a & 31)); }
    }
}

DI void phase25(const Params& p, unsigned char* lds) {
    const int tid = opaque_tid(), lane = tid & 63, wave = tid >> 6;
    const float* ssqb = (const float*)(p.ws + OFF_SSQB);
    bf16_t* gz = (bf16_t*)(p.ws + OFF_GZ);
    for (int it = blockIdx.x; it < MROWS / 8; it += gridDim.x) {
        const size_t row = (size_t)it * 8 + wave;
        float s = ssqb[(row * 4 + (lane >> 4)) * 16 + (lane & 15)];
        s += __shfl_xor(s, 1); s += __shfl_xor(s, 2); s += __shfl_xor(s, 4); s += __shfl_xor(s, 8);
        const float r = 1.0f / sqrtf(s * (1.0f / 256.0f) + EPS);
        u32x4* ptr = (u32x4*)(gz + row * 1024 + lane * 16);
#pragma unroll
        for (int j = 0; j < 2; ++j) {
            u32x4 u = ptr[j], o;
            o.x = pk2(bflo(u.x) * r, bfhi(u.x) * r); o.y = pk2(bflo(u.y) * r, bfhi(u.y) * r);
            o.z = pk2(bflo(u.z) * r, bfhi(u.z) * r); o.w = pk2(bflo(u.w) * r, bfhi(u.w) * r);
            ptr[j] = o;
        }
    }
}

template <int PASS>
struct EpiMerge {
    static constexpr bool PERM = false, AFTER_DRAIN = false;
    unsigned char* ws;
    DI void operator()(const pg8::f32x4 (&acc)[2][2][4][2], const pg8::Unit& u, int wr, int wc, int fr, int fq) const {
        const unsigned char* sg = ws + (PASS == 0 ? OFF_SGB : OFF_SGA);
        bf16_t* merged = (bf16_t*)(ws + OFF_AK);
#pragma unroll
        for (int ai = 0; ai < 2; ++ai)
#pragma unroll
            for (int m = 0; m < 4; ++m) {
                const size_t tok = (size_t)u.pm * 256 + ai * 128 + wr * 64 + m * 16 + fr;
#pragma unroll
                for (int bj = 0; bj < 2; ++bj)
#pragma unroll
                    for (int n = 0; n < 2; ++n) {
                        const size_t off = tok * 1024 + u.pn * 256 + bj * 128 + wc * 32 + n * 16 + 4 * fq;
                        const unsigned ug = *(const unsigned*)(sg + off);
                        const float q = 1.0f / 255.0f;
                        float m0 = (float)(ug & 255u) * q * acc[ai][bj][m][n][0], m1 = (float)((ug >> 8) & 255u) * q * acc[ai][bj][m][n][1];
                        float m2 = (float)((ug >> 16) & 255u) * q * acc[ai][bj][m][n][2], m3 = (float)(ug >> 24) * q * acc[ai][bj][m][n][3];
                        if (PASS == 1) { const u32x2 t = *(const u32x2*)(merged + off); m0 += bflo(t.x); m1 += bfhi(t.x); m2 += bflo(t.y); m3 += bfhi(t.y); }
                        u32x2 o; o.x = pk2(m0, m1); o.y = pk2(m2, m3);
                        *(u32x2*)(merged + off) = o;
                    }
            }
    }
};
struct EpiOut {
    static constexpr bool PERM = false, AFTER_DRAIN = false;
    unsigned char* ws; const float* x; float* out;
    DI void operator()(const pg8::f32x4 (&acc)[2][2][4][2], const pg8::Unit& u, int wr, int wc, int fr, int fq) const {
        float* ssqh = (float*)(ws + OFF_SSQH);
#pragma unroll
        for (int ai = 0; ai < 2; ++ai)
#pragma unroll
            for (int m = 0; m < 4; ++m) {
                const size_t tok = (size_t)u.pm * 256 + ai * 128 + wr * 64 + m * 16 + fr;
                float ss = 0.f;
#pragma unroll
                for (int bj = 0; bj < 2; ++bj)
#pragma unroll
                    for (int n = 0; n < 2; ++n) {
                        const size_t off = tok * 1024 + u.pn * 256 + bj * 128 + wc * 32 + n * 16 + 4 * fq;
                        const f32x4 xv = *(const f32x4*)(x + off);
                        f32x4 o;
                        o.x = xv.x + acc[ai][bj][m][n][0]; o.y = xv.y + acc[ai][bj][m][n][1];
                        o.z = xv.z + acc[ai][bj][m][n][2]; o.w = xv.w + acc[ai][bj][m][n][3];
                        ss += (o.x * o.x + o.y * o.y) + (o.z * o.z + o.w * o.w);
                        *(f32x4*)(out + off) = o;
                    }
                ss += __shfl_xor(ss, 16); ss += __shfl_xor(ss, 32);
                if (fq == 0) ssqh[tok * 16 + u.pn * 4 + wc] = ss;
            }
    }
};
DI void phase3(const Params& p, unsigned char* lds) {
    SchedSq S;
    {
        pg8::Gemm g; g.A = (const bf16_t*)(p.ws + OFF_GZ); g.Bt = (const bf16_t*)(p.ws + OFF_WB_T); g.M = MROWS; g.N = 1024; g.K = 1024;
        EpiMerge<0> E; E.ws = p.ws;
        pg8::gemm_phase<EpiMerge<0>, SchedSq, true, true>((PG8_LAS unsigned char*)lds, g, S, E);
    }
    {
        pg8::Gemm g; g.A = (const bf16_t*)(p.ws + OFF_AZ); g.Bt = (const bf16_t*)(p.ws + OFF_WA_T); g.M = MROWS; g.N = 1024; g.K = 1024;
        EpiMerge<1> E; E.ws = p.ws;
        pg8::gemm_phase<EpiMerge<1>, SchedSq, true, true>((PG8_LAS unsigned char*)lds, g, S, E);
    }
}
DI void phase4(const Params& p, unsigned char* lds) {
    SchedSq S;
    pg8::Gemm g; g.A = (const bf16_t*)(p.ws + OFF_AK); g.Bt = (const bf16_t*)(p.ws + OFF_WO_T); g.M = MROWS; g.N = 1024; g.K = 1024;
    EpiOut E; E.ws = p.ws; E.x = p.x; E.out = p.out;
    pg8::gemm_phase<EpiOut, SchedSq, true, true>((PG8_LAS unsigned char*)lds, g, S, E);
}

DI void phase5(const Params& p, unsigned char* lds) {
    const int tid = opaque_tid(), lane = tid & 63, wave = tid >> 6;
    const float* ssqh = (const float*)(p.ws + OFF_SSQH);
    for (int it = blockIdx.x; it < MROWS / 8; it += gridDim.x) {
        const size_t row = (size_t)it * 8 + wave;
        float s = lane < 16 ? ssqh[row * 16 + lane] : 0.f;
        s = wave_sum(s);
        const float rstd = 1.0f / sqrtf(s * (1.0f / 1024.0f) + EPS);
        f32x4* orow = (f32x4*)(p.out + row * 1024) + lane;
        const f32x4* wrow = (const f32x4*)p.final_w + lane;
#pragma unroll
        for (int j = 0; j < 4; ++j) {
            f32x4 v = orow[64 * j]; const f32x4 w = wrow[64 * j];
            v.x = v.x * rstd * w.x; v.y = v.y * rstd * w.y; v.z = v.z * rstd * w.z; v.w = v.w * rstd * w.w;
            orow[64 * j] = v;
        }
    }
}

#define XB_TMO      128
#define XB_XCNT(j)  (256  + 64 * (j))
#define XB_XSUB(j)  (1280 + 64 * (j))
#define XB_XGEN(j)  (2304 + 64 * (j))
#define XB_TOP      3328
#define XB_TOPGEN   3392
#define XCD_BAR_WORDS 3456
#define XB_SPIN_CAP (1u << 18)
#define LAS __attribute__((address_space(3)))
DI unsigned xb_ld(unsigned* p)              { return __hip_atomic_load(p, __ATOMIC_RELAXED, __HIP_MEMORY_SCOPE_AGENT); }
DI unsigned xb_add(unsigned* p, unsigned v) { return __hip_atomic_fetch_add(p, v, __ATOMIC_RELAXED, __HIP_MEMORY_SCOPE_AGENT); }
DI unsigned xb_xcc_id() { return (unsigned)__builtin_amdgcn_s_getreg((3 << 11) | 20) & 0xFu; }
#define XB_SPIN(cond, bar) do { unsigned _sp = 0; while (cond) { __builtin_amdgcn_s_sleep(1); \
    if ((++_sp & 255u) == 0u) { if (xb_ld(&(bar)[XB_TMO])) break; if (_sp > XB_SPIN_CAP) { atomicAdd(&(bar)[XB_TMO], 1u); break; } } } } while (0)
struct XcdBarrier { unsigned* bar; unsigned x; volatile LAS unsigned* st; };
DI XcdBarrier xcd_barrier_post(unsigned* bar, volatile LAS unsigned* st) {
    XcdBarrier b; b.bar = bar; b.x = xb_xcc_id(); b.st = st;
    if (threadIdx.x == 0) (void)xb_add(&bar[XB_XCNT(b.x)], 1u);
    return b;
}
DI void xcd_barrier_complete(unsigned* bar, unsigned x, unsigned& nloc, unsigned& nx) {
    const unsigned G = gridDim.x * gridDim.y * gridDim.z;
    unsigned sum, cnt, mine, sp = 0u;
    for (;;) {
        sum = 0u; cnt = 0u; mine = 0u;
#pragma unroll
        for (unsigned j = 0; j < 16; ++j) { const unsigned c = xb_ld(&bar[XB_XCNT(j)]); sum += c; cnt += (c > 0u) ? 1u : 0u; mine = (j == x) ? c : mine; }
        if (sum == G) break;
        __builtin_amdgcn_s_sleep(1);
        if ((++sp & 255u) == 0u) { if (xb_ld(&bar[XB_TMO])) break; if (sp > XB_SPIN_CAP) { atomicAdd(&bar[XB_TMO], 1u); break; } }
    }
    nloc = mine > 0u ? mine : 1u; nx = cnt > 0u ? cnt : 1u;
}
DI void xcd_barrier(const XcdBarrier& b) {
    asm volatile("s_waitcnt vmcnt(0)" ::: "memory");
    __syncthreads();
    if (threadIdx.x == 0) {
        unsigned* bar = b.bar;
        __builtin_amdgcn_s_waitcnt(0);
        unsigned nloc = b.st[0], nx = b.st[1];
        if (nloc == 0u) { xcd_barrier_complete(bar, b.x, nloc, nx); b.st[0] = nloc; b.st[1] = nx; }
        const unsigned old = xb_add(&bar[XB_XSUB(b.x)], 1u);
        const unsigned gen = old / nloc;
        if (old + 1u == (gen + 1u) * nloc) {
            __builtin_amdgcn_fence(__ATOMIC_RELEASE, "agent");
            asm volatile("s_waitcnt vmcnt(0)" ::: "memory");
            const unsigned og = xb_add(&bar[XB_TOP], 1u);
            const unsigned tg = og / nx;
            if (og + 1u == (tg + 1u) * nx) xb_add(&bar[XB_TOPGEN], 1u);
            else XB_SPIN(xb_ld(&bar[XB_TOPGEN]) == tg, bar);
            __builtin_amdgcn_fence(__ATOMIC_ACQUIRE, "agent");
            xb_add(&bar[XB_XGEN(b.x)], 1u);
            asm volatile("s_waitcnt vmcnt(0)" ::: "memory");
        } else {
            XB_SPIN(xb_ld(&bar[XB_XGEN(b.x)]) == gen, bar);
            __builtin_amdgcn_fence(__ATOMIC_ACQUIRE, "agent");
            asm volatile("s_waitcnt vmcnt(0)" ::: "memory");
        }
    }
    __syncthreads();
}

DI void run_phase(const Params& p, unsigned char* lds, int ph) {
    switch (ph) {
        case 0: phase0(p, lds); break;
        case 1: phase1(p, lds); break;
        case 2: phase15(p, lds); break;
        case 3: phase2(p, lds); break;
        case 4: phase25(p, lds); phase3(p, lds); break;
        case 5: phase4(p, lds); break;
        default: phase5(p, lds); break;
    }
}

__global__ void __launch_bounds__(512) hybrid_fwd(Params p) {
    extern __shared__ __attribute__((aligned(16))) unsigned char lds[];
#if MULTI_LAUNCH
    run_phase(p, lds, p.phase_lo);
#else
    cg::grid_group grid = cg::this_grid();
    if (p.phase_lo == 77) grid.sync();
    {
        volatile LAS unsigned* st = (volatile LAS unsigned*)(lds + LDS_ITEM + 16);
        if (threadIdx.x == 0) { st[0] = 0u; st[1] = 0u; }
        __syncthreads();
        (void)xcd_barrier_post((unsigned*)(p.ws + OFF_XBAR), st);
    }
#define GRID_BARRIER() { XcdBarrier xb_; xb_.bar = (unsigned*)(p.ws + OFF_XBAR); xb_.x = xb_xcc_id(); xb_.st = (volatile LAS unsigned*)(lds + LDS_ITEM + 16); xcd_barrier(xb_); }
    phase0(p, lds); GRID_BARRIER();
    phase1(p, lds); GRID_BARRIER();
    phase15(p, lds); GRID_BARRIER();
    phase2(p, lds); GRID_BARRIER();
    phase25(p, lds); GRID_BARRIER();
    phase3(p, lds); GRID_BARRIER();
    phase4(p, lds); GRID_BARRIER();
    phase5(p, lds);
#endif
}

extern "C" void kernel_launch(void* const* d_in, const int* in_sizes, int n_in, void* d_out, int out_size, void* d_ws, size_t ws_size, hipStream_t stream) {
    static int grid = 0;
    if (grid == 0) {
        int dev = 0, cus = 0, per_cu = 0;
        hipGetDevice(&dev);
        hipDeviceGetAttribute(&cus, hipDeviceAttributeMultiprocessorCount, dev);
        hipFuncSetAttribute((const void*)hybrid_fwd, hipFuncAttributeMaxDynamicSharedMemorySize, LDS_BYTES);
        hipOccupancyMaxActiveBlocksPerMultiprocessor(&per_cu, (const void*)hybrid_fwd, 512, LDS_BYTES);
        if (per_cu < 1) per_cu = 1;
        if (per_cu > 1) per_cu = 1;
        if (cus <= 0) cus = 256;
        grid = cus * per_cu;
    }
    hipMemsetAsync((unsigned char*)d_ws + OFF_CTR, 0, 256, stream);
    hipMemsetAsync((unsigned char*)d_ws + OFF_XBAR, 0, 16384, stream);
    Params p{};
    p.x = (const float*)d_in[0]; p.meta = (const float*)d_in[1]; p.norm_w = (const float*)d_in[2]; p.w_in = (const float*)d_in[3];
    p.lq1 = (const float*)d_in[4]; p.lk1 = (const float*)d_in[5]; p.lq2 = (const float*)d_in[6]; p.lk2 = (const float*)d_in[7];
    p.subln_w = (const float*)d_in[8]; p.gate_w2 = (const float*)d_in[9]; p.gate_b = (const float*)d_in[10]; p.gla_norm_w = (const float*)d_in[11];
    p.wa = (const float*)d_in[12]; p.wb = (const float*)d_in[13]; p.wo = (const float*)d_in[14]; p.final_w = (const float*)d_in[15];
    p.out = (float*)d_out; p.ws = (unsigned char*)d_ws;
#if MULTI_LAUNCH
    for (int ph = 0; ph < 7; ++ph) {
        p.phase_lo = ph; p.phase_hi = ph + 1;
        hipLaunchKernelGGL(hybrid_fwd, dim3(grid), dim3(512), LDS_BYTES, stream, p);
    }
#else
    p.phase_lo = 0; p.phase_hi = 7;
    void* args[] = {&p};
    hipError_t e = hipLaunchCooperativeKernel((const void*)hybrid_fwd, dim3(grid), dim3(512), args, LDS_BYTES, stream);
    if (e != hipSuccess) fprintf(stderr, "cooperative launch failed: %s (grid %d)\n", hipGetErrorString(e), grid);
#endif
}
```

```cpp
#include <hip/hip_runtime.h>
#include <hip/hip_cooperative_groups.h>
#include <cstdio>
#include <cstdint>
namespace cg = cooperative_groups;

#ifndef MULTI_LAUNCH
#define MULTI_LAUNCH 0
#endif
#ifndef PROBE_REP
#define PROBE_REP 0
#endif

typedef unsigned short bf16_t;
typedef short bf16x8 __attribute__((ext_vector_type(8)));
typedef float f32x4 __attribute__((ext_vector_type(4)));
typedef float f32x2 __attribute__((ext_vector_type(2)));
typedef float f32x16 __attribute__((ext_vector_type(16)));
typedef unsigned u32x4 __attribute__((ext_vector_type(4)));
typedef unsigned u32x2 __attribute__((ext_vector_type(2)));
typedef __bf16 bfv2 __attribute__((ext_vector_type(2)));

#define DI __device__ __forceinline__
#define MFMA32(a, b, c) __builtin_amdgcn_mfma_f32_32x32x16_bf16((a), (b), (c), 0, 0, 0)
#define MFMA16(a, b, c) __builtin_amdgcn_mfma_f32_16x16x32_bf16((a), (b), (c), 0, 0, 0)

DI unsigned pk2(float a, float b) { f32x2 v = {a, b}; return __builtin_bit_cast(unsigned, __builtin_convertvector(v, bfv2)); }
DI float bf2f(bf16_t v) { return __uint_as_float(((unsigned)v) << 16); }
DI float bflo(unsigned u) { return __uint_as_float(u << 16); }
DI float bfhi(unsigned u) { return __uint_as_float(u & 0xffff0000u); }
DI bf16_t f2bf(float a) { return (bf16_t)(pk2(a, 0.f) & 0xffffu); }
DI float wave_sum(float v) {
#pragma unroll
    for (int o = 32; o; o >>= 1) v += __shfl_xor(v, o);
    return v;
}
DI int opaque_tid() { int t = threadIdx.x; asm volatile("" : "+v"(t)); return t; }
DI float sigmoidf_(float z) { return 1.f / (1.f + __expf(-z)); }
DI float siluf_(float z) { return z / (1.f + __expf(-z)); }

constexpr int D = 1024, NB = 4, SEQ = 4096, MROWS = NB * SEQ;
constexpr int NIN = 9232, NINP = 9344;
constexpr float EPS = 1e-5f;

constexpr size_t SZ_ACT = (size_t)MROWS * 1024 * 2;
constexpr size_t OFF_WIN_T = 0;
constexpr size_t OFF_WA_T = OFF_WIN_T + (size_t)NINP * 1024 * 2;
constexpr size_t OFF_WB_T = OFF_WA_T + 2097152;
constexpr size_t OFF_WO_T = OFF_WB_T + 2097152;
constexpr size_t OFF_AK = OFF_WO_T + 2097152;
constexpr size_t OFF_AVT = OFF_AK + SZ_ACT;
constexpr size_t OFF_AZ = OFF_AVT + SZ_ACT;
constexpr size_t OFF_GVT = OFF_AZ + SZ_ACT;
constexpr size_t OFF_GZ = OFF_GVT + SZ_ACT;
constexpr size_t OFF_GA = OFF_GZ + SZ_ACT;
constexpr size_t OFF_GB = OFF_GA + SZ_ACT;
constexpr size_t OFF_GLR = OFF_GB + SZ_ACT;
constexpr size_t OFF_RSTD = OFF_GLR + (size_t)MROWS * 16 * 2;
constexpr size_t OFF_ROPE = OFF_RSTD + 65792;
constexpr size_t OFF_AKM = OFF_ROPE + 263168;
constexpr size_t OFF_AVTM = OFF_AKM + 131072;
constexpr size_t OFF_GVTM = OFF_AVTM + 131072;
constexpr size_t OFF_GKM = OFF_GVTM + 131072;
constexpr size_t OFF_GLRM = OFF_GKM + 16384;
constexpr size_t OFF_KTM = OFF_GLRM + 512;
constexpr size_t OFF_KTTM = OFF_KTM + 65536;
constexpr size_t OFF_DEC = OFF_KTTM + 65536;
constexpr size_t OFF_DECM = OFF_DEC + 524288;
constexpr size_t OFF_SSQB = OFF_DECM + 2048;
constexpr size_t OFF_SSQH = OFF_SSQB + 4194304;
constexpr size_t OFF_CTR = OFF_SSQH + 1048576;
constexpr size_t OFF_XBM = OFF_CTR + 256;
constexpr size_t OFF_XBAR = OFF_XBM + 32768;
constexpr size_t WS_END = OFF_XBAR + 16384;
constexpr size_t OFF_XB = OFF_GA;
constexpr size_t OFF_SGA = OFF_GB;
constexpr size_t OFF_SGB = OFF_GB + (size_t)MROWS * 1024;
static_assert(WS_END <= 268435456ull, "workspace over 256 MiB");
constexpr size_t DO_AQ = 0, DO_GQ = SZ_ACT, DO_GK = SZ_ACT + SZ_ACT / 2;

constexpr int G_ROWB = 144;
constexpr int G_SW = 128 * G_ROWB, G_SX = 256 * G_ROWB, G_STAGE = G_SW + G_SX;
constexpr int G_SW4 = 256 * G_ROWB, G_STAGE4 = G_SW4 + G_SX;
constexpr int LDS_SCALE = 2 * G_STAGE4;
constexpr int LDS_ITEM = LDS_SCALE + 4096;
constexpr int LDS_BYTES = LDS_ITEM + 64;

struct Params {
    const float *x, *meta, *norm_w, *w_in, *lq1, *lk1, *lq2, *lk2, *subln_w, *gate_w2, *gate_b, *gla_norm_w, *wa, *wb, *wo, *final_w;
    float* out;
    unsigned char* ws;
    int phase_lo, phase_hi;
};

template <int MODE>
DI void p0_transpose_item(const Params& p, int item, float* tile) {
    const int tid = opaque_tid();
    const float* W = MODE == 0 ? p.w_in : MODE == 1 ? p.wa : MODE == 2 ? p.wb : p.wo;
    const int ldw = MODE == 0 ? NIN : 1024;
    const int nbc = MODE == 0 ? NINP / 64 : 16;
    bf16_t* WT = (bf16_t*)(p.ws + (MODE == 0 ? OFF_WIN_T : MODE == 1 ? OFF_WA_T : MODE == 2 ? OFF_WB_T : OFF_WO_T));
    const int kb = item / nbc, nb = item % nbc, k0 = kb * 64, n0 = nb * 64;
#pragma unroll
    for (int i = 0; i < 8; ++i) {
        const int kk = (tid >> 6) + 8 * i, nn = tid & 63, n = n0 + nn, k = k0 + kk;
        int src = n;
        if (MODE == 0) { src = n < 7168 ? n : (n < 9216 ? n + 16 : (n < 9232 ? n - 2048 : -1)); }
        float sc = 1.f;
        if (MODE == 0) sc = p.norm_w[k];
        if (MODE == 1) sc = 0.8f * p.subln_w[k & 127];
        if (MODE == 2) sc = p.gla_norm_w[k & 255];
        float v = 0.f;
        if (src >= 0) v = W[(size_t)k * ldw + src] * sc;
        tile[kk * 65 + nn] = v;
    }
    __syncthreads();
    {
        const int nn = tid >> 3, c = tid & 7;
        const float* s = tile + (8 * c) * 65 + nn;
        u32x4 o;
        o.x = pk2(s[0 * 65], s[1 * 65]); o.y = pk2(s[2 * 65], s[3 * 65]); o.z = pk2(s[4 * 65], s[5 * 65]); o.w = pk2(s[6 * 65], s[7 * 65]);
        *(u32x4*)(WT + (size_t)(n0 + nn) * 1024 + k0 + 8 * c) = o;
    }
    __syncthreads();
}

DI void phase0(const Params& p, unsigned char* lds) {
    const int tid = opaque_tid(), lane = tid & 63, wave = tid >> 6;
    float* tile = (float*)lds;
    constexpr int I_WIN = 16 * (NINP / 64), I_SQ = 256;
    constexpr int I_T = I_WIN + 3 * I_SQ;
    constexpr int I_RSTD = (MROWS + 16 + 7) / 8;
    constexpr int I_ROPE = (4112 * 8 + 511) / 512;
    constexpr int I_ZERO = 393216 / 8192;
    constexpr int I_ALL = I_T + I_RSTD + I_ROPE + I_ZERO;
    for (int it = blockIdx.x; it < I_ALL; it += gridDim.x) {
        int r = it;
        if (r < I_WIN) { p0_transpose_item<0>(p, r, tile); continue; } r -= I_WIN;
        if (r < I_SQ) { p0_transpose_item<1>(p, r, tile); continue; } r -= I_SQ;
        if (r < I_SQ) { p0_transpose_item<2>(p, r, tile); continue; } r -= I_SQ;
        if (r < I_SQ) { p0_transpose_item<3>(p, r, tile); continue; } r -= I_SQ;
        if (r < I_RSTD) {
            const int row = r * 8 + wave;
            if (row < MROWS + 16) {
                const float* src = row < MROWS ? p.x + (size_t)row * 1024 : p.meta + (size_t)(row - MROWS) * 1024;
                const f32x4* xr = (const f32x4*)src + lane;
                float s = 0.f;
#pragma unroll
                for (int j = 0; j < 4; ++j) { const f32x4 v = xr[64 * j]; s += (v.x * v.x + v.y * v.y) + (v.z * v.z + v.w * v.w); }
                s = wave_sum(s);
                if (lane == 0) ((float*)(p.ws + OFF_RSTD))[row] = 1.0f / sqrtf(s * (1.0f / 1024.0f) + EPS);
                bf16_t* xbrow = row < MROWS ? (bf16_t*)(p.ws + OFF_XB) + (size_t)row * 1024 : (bf16_t*)(p.ws + OFF_XBM) + (size_t)(row - MROWS) * 1024;
#pragma unroll
                for (int j = 0; j < 4; ++j) { const f32x4 v = xr[64 * j]; u32x2 o; o.x = pk2(v.x, v.y); o.y = pk2(v.z, v.w); *(u32x2*)(xbrow + 256 * j + 4 * lane) = o; }
            }
            continue;
        }
        r -= I_RSTD;
        if (r < I_ROPE) {
            const int e = r * 512 + tid;
            if (e < 4112 * 8) {
                const int pos = e >> 3, i = e & 7;
                const float inv = powf(500000.0f, -(float)i / 8.0f);
                const float ang = (float)pos * inv;
                float* t = (float*)(p.ws + OFF_ROPE) + (size_t)e * 2;
                t[0] = cosf(ang); t[1] = sinf(ang);
            }
            continue;
        }
        r -= I_ROPE;
        { u32x4 z = {0u, 0u, 0u, 0u}; *(u32x4*)(p.ws + OFF_AKM + (size_t)r * 8192 + tid * 16) = z; }
    }
}

template <int NI, bool HS>
DI void gemm_tile(f32x16 (&acc)[NI][2], const bf16_t* __restrict__ Wt, const bf16_t* __restrict__ X, unsigned char* lds, const float (&hs)[2][3]) {
    const int tid = opaque_tid(), lane = tid & 63, wave = tid >> 6, l31 = lane & 31, h = lane >> 5;
    const int wn = wave & 1, wm = wave >> 1;
    constexpr int SW = NI * 64 * G_ROWB, STAGE = SW + G_SX;
    u32x4 wreg[NI];
    u32x4 xreg[4];
    const int prow = tid >> 3, pc = tid & 7;
    const bf16_t* wp = Wt + (size_t)prow * 1024 + pc * 8;
    const bf16_t* xp = X + (size_t)prow * 1024 + pc * 8;
#define G_LOAD(kt_)                                                                                                  \
    {                                                                                                                \
        _Pragma("unroll") for (int i = 0; i < NI; ++i) wreg[i] = *(const u32x4*)(wp + (size_t)i * 64 * 1024 + (kt_) * 64); \
        _Pragma("unroll") for (int i = 0; i < 4; ++i) xreg[i] = *(const u32x4*)(xp + (size_t)i * 64 * 1024 + (kt_) * 64);  \
    }
#define G_STORE(buf_)                                                                                                \
    {                                                                                                                \
        unsigned char* sW_ = lds + (buf_) * STAGE + prow * G_ROWB + pc * 16; unsigned char* sX_ = sW_ + SW;          \
        _Pragma("unroll") for (int i = 0; i < NI; ++i) *(u32x4*)(sW_ + i * 64 * G_ROWB) = wreg[i];                   \
        _Pragma("unroll") for (int i = 0; i < 4; ++i) *(u32x4*)(sX_ + i * 64 * G_ROWB) = xreg[i];                    \
    }
    G_LOAD(0);
    G_STORE(0);
    __syncthreads();
    for (int kt = 0; kt < 16; ++kt) {
        if (kt + 1 < 16) G_LOAD(kt + 1);
        if (HS) {
            if (kt == 4 || kt == 8 || kt == 12) {
                const float s0 = kt == 4 ? hs[0][0] : (kt == 8 ? hs[0][1] : hs[0][2]);
                const float s1 = kt == 4 ? hs[1][0] : (kt == 8 ? hs[1][1] : hs[1][2]);
#pragma unroll
                for (int n = 0; n < NI; ++n)
#pragma unroll
                    for (int i = 0; i < 16; ++i) { acc[n][0][i] *= s0; acc[n][1][i] *= s1; }
            }
        }
        {
            const unsigned char* sW = lds + (kt & 1) * STAGE + (wn * NI * 32 + l31) * G_ROWB + h * 16;
            const unsigned char* sX = lds + (kt & 1) * STAGE + SW + (wm * 64 + l31) * G_ROWB + h * 16;
#pragma unroll
            for (int ks = 0; ks < 4; ++ks) {
                const bf16x8 x0 = *(const bf16x8*)(sX + ks * 32), x1 = *(const bf16x8*)(sX + 32 * G_ROWB + ks * 32);
#pragma unroll
                for (int n = 0; n < NI; ++n) {
                    const bf16x8 w = *(const bf16x8*)(sW + n * 32 * G_ROWB + ks * 32);
                    acc[n][0] = MFMA32(w, x0, acc[n][0]); acc[n][1] = MFMA32(w, x1, acc[n][1]);
                }
            }
        }
        if (kt + 1 < 16) G_STORE((kt + 1) & 1);
        __syncthreads();
    }
#undef G_LOAD
#undef G_STORE
}

template <int NI>
DI void zero_acc(f32x16 (&acc)[NI][2]) {
#pragma unroll
    for (int a = 0; a < NI; ++a)
#pragma unroll
        for (int b = 0; b < 2; ++b)
#pragma unroll
            for (int i = 0; i < 16; ++i) acc[a][b][i] = 0.f;
}

namespace pg8 {
#define PG8_LAS __attribute__((address_space(3)))
typedef unsigned short bf16_t;
typedef short bf16x8 __attribute__((ext_vector_type(8)));
typedef float f32x4 __attribute__((ext_vector_type(4)));
typedef unsigned u32x4 __attribute__((ext_vector_type(4)));
constexpr int BM = 256, BK = 64, HALF = 128, HTB = HALF * BK * 2  , STAGE_BYTES = 8 * HTB, NXCD = 8, WGM = 8;

__host__ __device__ __forceinline__ int lds_byte(int r, int c) { const int st = (r >> 4) * 2 + (c >> 5), rr = r & 15, cc = c & 31, ob = rr * 64 + cc * 2; return st * 1024 + (ob ^ (((ob >> 9) & 1) << 5)); }
__host__ __device__ __forceinline__ void stage_rc(int b, int& R, int& C) { const int st = b / 1024, sb = b % 1024, swz = sb ^ (((sb >> 9) & 1) << 5); R = (st >> 1) * 16 + swz / 64; C = (st & 1) * 32 + (swz % 64) / 2; }
__host__ __device__ __forceinline__ int perm32(int rho) { const int n = rho >> 4, i = rho & 15; return 8 * (i >> 2) + 4 * n + (i & 3); }

struct Unit { int pm, pn; };
struct Gemm { const bf16_t* A; const bf16_t* Bt; int M, N, K; };

template <class Epi, class Sched, bool ALIGN_EPI = false, bool SP2 = false>
__device__ __forceinline__ void gemm_phase(PG8_LAS unsigned char* lds, const Gemm g, const Sched& S, const Epi& E) {
    const int tid = opaque_tid(), wid = __builtin_amdgcn_readfirstlane(tid >> 6), lane = tid & 63, wr = wid >> 2, wc = wid & 3, fr = lane & 15, fq = lane >> 4;
    const int K = g.K, nt = K / BK;
    unsigned voffA[2], voffB[2];
#pragma unroll
    for (int i = 0; i < 2; ++i) { int R, C; stage_rc(tid * 16 + i * 8192, R, C); const int Rb = Epi::PERM ? ((R & ~31) + perm32(R & 31)) : R;
        voffA[i] = (unsigned)(R * K + C) * 2u; voffB[i] = (unsigned)(Rb * K + C) * 2u; }
    const size_t kstep = (size_t)(BK * 2);
    const size_t hstep = (size_t)HALF * K * 2;
    const size_t tstep = 2 * hstep;
    const unsigned ldsw = (unsigned)wid * 1024u;
    const int aoff = lds_byte(wr * 64 + fr, fq * 8), boff = lds_byte(wc * 32 + fr, fq * 8);
#define PG8_SA(b, h) (((b) * 2 + (h)) * HTB)
#define PG8_SB(b, h) ((4 + (b) * 2 + (h)) * HTB)
#define PG8_STAGE(bufoff, gbase, voff) do { _Pragma("unroll") for (int _i = 0; _i < 2; ++_i) \
        __builtin_amdgcn_global_load_lds((const unsigned*)((const char*)(gbase) + (voff)[_i]), (PG8_LAS unsigned*)(lds + (bufoff) + ldsw + _i * 8192), 16, 0, 0); } while (0)
#define PG8_LDA(dst, b, h) do { _Pragma("unroll") for (int m = 0; m < 4; ++m) _Pragma("unroll") for (int k = 0; k < 2; ++k) dst[m][k] = *(const PG8_LAS bf16x8*)(lds + PG8_SA(b, h) + aoff + m * 2048 + k * 1024); } while (0)
#define PG8_LDB(dst, b, h) do { _Pragma("unroll") for (int n = 0; n < 2; ++n) _Pragma("unroll") for (int k = 0; k < 2; ++k) dst[n][k] = *(const PG8_LAS bf16x8*)(lds + PG8_SB(b, h) + boff + n * 2048 + k * 1024); } while (0)
#define PG8_MMA(ai, bj, At, Bt) do { __builtin_amdgcn_s_setprio(1); _Pragma("unroll") for (int m = 0; m < 4; ++m) _Pragma("unroll") for (int n = 0; n < 2; ++n) _Pragma("unroll") for (int k = 0; k < 2; ++k) \
        acc[ai][bj][m][n] = __builtin_amdgcn_mfma_f32_16x16x32_bf16(Bt[n][k], At[m][k], acc[ai][bj][m][n], 0, 0, 0); __builtin_amdgcn_s_setprio(0); } while (0)
#define PG8_WAIT_V(n) asm volatile("s_waitcnt vmcnt(" #n ")" ::: "memory")
#define PG8_WAIT_L(n) asm volatile("s_waitcnt lgkmcnt(" #n ")" ::: "memory")
#define PG8_BAR __builtin_amdgcn_s_barrier()
#define PG8_SCHED __builtin_amdgcn_sched_barrier(0)
    Unit cur, nxt; int ui = 0;
    if (!S.next(0, cur)) return;
    f32x4 acc[2][2][4][2];
#pragma unroll
    for (int a = 0; a < 2; ++a)
#pragma unroll
        for (int b = 0; b < 2; ++b)
#pragma unroll
            for (int m = 0; m < 4; ++m)
#pragma unroll
                for (int n = 0; n < 2; ++n) acc[a][b][m][n] = (f32x4){0.f, 0.f, 0.f, 0.f};
    bf16x8 At[4][2], B0[2][2], B1[2][2];
    const char* cA = (const char*)g.A + (size_t)cur.pm * tstep; const char* cB = (const char*)g.Bt + (size_t)cur.pn * tstep;
    S.a_ready(cur);
    if constexpr (SP2) {
        PG8_STAGE(PG8_SB(0, 0), cB, voffB); PG8_STAGE(PG8_SB(0, 1), cB + hstep, voffB); PG8_STAGE(PG8_SA(0, 0), cA, voffA); PG8_STAGE(PG8_SA(0, 1), cA + hstep, voffA);
        if (wr == 1) PG8_BAR;
        PG8_WAIT_V(2); PG8_BAR;
        PG8_STAGE(PG8_SB(1, 0), cB + kstep, voffB); PG8_STAGE(PG8_SA(1, 0), cA + kstep, voffA); PG8_STAGE(PG8_SB(1, 1), cB + hstep + kstep, voffB);
        PG8_WAIT_V(6); PG8_BAR;
    } else {
        PG8_STAGE(PG8_SB(0, 0), cB, voffB); PG8_STAGE(PG8_SA(0, 0), cA, voffA); PG8_STAGE(PG8_SB(0, 1), cB + hstep, voffB); PG8_STAGE(PG8_SA(0, 1), cA + hstep, voffA);
        if (wr == 1) PG8_BAR;
        PG8_WAIT_V(4); PG8_BAR;
        PG8_STAGE(PG8_SB(1, 0), cB + kstep, voffB); PG8_STAGE(PG8_SA(1, 0), cA + kstep, voffA); PG8_STAGE(PG8_SB(1, 1), cB + hstep + kstep, voffB);
        PG8_WAIT_V(6); PG8_BAR;
    }
    for (;;) {
        const bool has_next = S.next(ui + 1, nxt);
        const char* nA = has_next ? (const char*)g.A + (size_t)nxt.pm * tstep : cA; const char* nB = has_next ? (const char*)g.Bt + (size_t)nxt.pn * tstep : cB;
        for (int t = 0; t < nt; t += 2) {
            const bool last = (t == nt - 2);
            const char* a1 = cA + (size_t)(t + 1) * kstep;
            const char* a2 = last ? nA : cA + (size_t)(t + 2) * kstep; const char* b2 = last ? nB : cB + (size_t)(t + 2) * kstep;
            const char* a3 = a2 + kstep; const char* b3 = b2 + kstep;
            if (last && has_next) S.a_ready(nxt);
            if constexpr (SP2) {
            PG8_LDB(B0, 0, 0); PG8_LDB(B1, 0, 1); PG8_SCHED; PG8_LDA(At, 0, 0); PG8_STAGE(PG8_SA(1, 1), a1 + hstep, voffA);
            PG8_WAIT_V(8); PG8_WAIT_L(0); PG8_BAR; PG8_MMA(0, 0, At, B0); PG8_MMA(0, 1, At, B1); PG8_BAR; PG8_SCHED;
            PG8_LDA(At, 0, 1); PG8_STAGE(PG8_SB(0, 0), b2, voffB); PG8_STAGE(PG8_SB(0, 1), b2 + hstep, voffB); PG8_STAGE(PG8_SA(0, 0), a2, voffA);
            PG8_WAIT_V(8); PG8_WAIT_L(0); PG8_BAR; PG8_MMA(1, 0, At, B0); PG8_MMA(1, 1, At, B1); PG8_BAR; PG8_SCHED;
            PG8_LDB(B0, 1, 0); PG8_LDB(B1, 1, 1); PG8_SCHED; PG8_LDA(At, 1, 0); PG8_STAGE(PG8_SA(0, 1), a2 + hstep, voffA);
            PG8_WAIT_V(8); PG8_WAIT_L(0); PG8_BAR; PG8_MMA(0, 0, At, B0); PG8_MMA(0, 1, At, B1); PG8_BAR; PG8_SCHED;
            PG8_LDA(At, 1, 1); PG8_STAGE(PG8_SB(1, 0), b3, voffB); PG8_STAGE(PG8_SB(1, 1), b3 + hstep, voffB); PG8_STAGE(PG8_SA(1, 0), a3, voffA);
            PG8_WAIT_V(8); PG8_WAIT_L(0); PG8_BAR; PG8_MMA(1, 0, At, B0); PG8_MMA(1, 1, At, B1); PG8_BAR; PG8_SCHED;
            } else {
            PG8_LDB(B0, 0, 0); PG8_SCHED; PG8_LDA(At, 0, 0); PG8_STAGE(PG8_SA(1, 1), a1 + hstep, voffA);
            PG8_WAIT_L(8); PG8_BAR; PG8_WAIT_L(0); PG8_MMA(0, 0, At, B0); PG8_BAR; PG8_SCHED;
            PG8_LDB(B1, 0, 1); PG8_STAGE(PG8_SB(0, 0), b2, voffB);
            PG8_BAR; PG8_WAIT_L(0); PG8_MMA(0, 1, At, B1); PG8_BAR;
            PG8_LDA(At, 0, 1); PG8_STAGE(PG8_SA(0, 0), a2, voffA);
            PG8_BAR; PG8_WAIT_L(0); PG8_MMA(1, 0, At, B0); PG8_BAR; PG8_SCHED;
            PG8_STAGE(PG8_SB(0, 1), b2 + hstep, voffB);
            PG8_WAIT_V(6); PG8_BAR; PG8_MMA(1, 1, At, B1); PG8_BAR;
            PG8_LDB(B0, 1, 0); PG8_SCHED; PG8_LDA(At, 1, 0); PG8_STAGE(PG8_SA(0, 1), a2 + hstep, voffA);
            PG8_WAIT_L(8); PG8_BAR; PG8_WAIT_L(0); PG8_MMA(0, 0, At, B0); PG8_BAR; PG8_SCHED;
            PG8_LDB(B1, 1, 1); PG8_STAGE(PG8_SB(1, 0), b3, voffB);
            PG8_BAR; PG8_WAIT_L(0); PG8_MMA(0, 1, At, B1); PG8_BAR;
            PG8_LDA(At, 1, 1); PG8_STAGE(PG8_SA(1, 0), a3, voffA);
            PG8_BAR; PG8_WAIT_L(0); PG8_MMA(1, 0, At, B0); PG8_BAR; PG8_SCHED;
            PG8_STAGE(PG8_SB(1, 1), b3 + hstep, voffB);
            PG8_WAIT_V(6); PG8_BAR; PG8_MMA(1, 1, At, B1); PG8_BAR;
            }
        }
        if constexpr (ALIGN_EPI) { if (wr == 0) PG8_BAR; }
        if constexpr (!Epi::AFTER_DRAIN) { E(acc, cur, wr, wc, fr, fq); S.done(cur); }
        if (!has_next) break;
#pragma unroll
        for (int a = 0; a < 2; ++a)
#pragma unroll
            for (int b = 0; b < 2; ++b)
#pragma unroll
                for (int m = 0; m < 4; ++m)
#pragma unroll
                    for (int n = 0; n < 2; ++n) acc[a][b][m][n] = (f32x4){0.f, 0.f, 0.f, 0.f};
        cur = nxt; cA = nA; cB = nB; ++ui;
        if constexpr (ALIGN_EPI) { if (wr == 1) PG8_BAR; }
    }
    PG8_WAIT_V(0);
    if constexpr (!ALIGN_EPI) { if (wr == 0) PG8_BAR; }
    PG8_BAR;
    if constexpr (Epi::AFTER_DRAIN) { E.fused(acc, cur, wr, wc, fr, fq, lds, wid, lane); S.done(cur); }
#undef PG8_SA
#undef PG8_SB
#undef PG8_STAGE
#undef PG8_LDA
#undef PG8_LDB
#undef PG8_MMA
#undef PG8_WAIT_V
#undef PG8_WAIT_L
#undef PG8_BAR
#undef PG8_SCHED
}
}

DI unsigned sig_u8(float z) { return (unsigned)(255.0f / (1.0f + __expf(-z)) + 0.5f); }
struct SchedP1 {
    DI bool next(int i, pg8::Unit& u) const {
        constexpr int NT = 36;
        const int id = (int)blockIdx.x + i * (int)gridDim.x;
        if (id >= 64 * NT) return false;
        const int g = id / (16 * NT), rem = id % (16 * NT), reg = rem >> 8, w = rem & 255, x = w & 7, j = w >> 3;
        int mt = g * 16 + 4 * (x & 3) + (j & 3), nt = reg * 16 + 8 * (x >> 2) + (j >> 2);
        if (reg == 2) { const int e = rem - 512; nt = 32 + (e >> 4); mt = g * 16 + (e & 15); }
        u.pm = mt; u.pn = nt; return true;
    }
    DI void a_ready(const pg8::Unit&) const {}
    DI void done(const pg8::Unit&) const {}
};
struct SchedSq {
    DI bool next(int i, pg8::Unit& u) const {
        const int id = (int)blockIdx.x + i * (int)gridDim.x;
        if (id >= 256) return false;
        u.pm = 8 * (id & 7) + ((id >> 3) & 7); u.pn = id >> 6; return true;
    }
    DI void a_ready(const pg8::Unit&) const {}
    DI void done(const pg8::Unit&) const {}
};
struct EpiInProj {
    static constexpr bool PERM = false, AFTER_DRAIN = false;
    unsigned char* ws; unsigned char* dout;
    DI void operator()(const pg8::f32x4 (&acc)[2][2][4][2], const pg8::Unit& u, int wr, int wc, int fr, int fq) const {
        const int nt = u.pn;
        int split, nc0;
        if (nt < 4) { split = 0; nc0 = nt * 256; }
        else if (nt < 8) { split = 1; nc0 = (nt - 4) * 256; }
        else if (nt < 12) { split = 2; nc0 = (nt - 8) * 256; }
        else if (nt < 16) { split = 3; nc0 = (nt - 12) * 256; }
        else if (nt < 18) { split = 4; nc0 = (nt - 16) * 256; }
        else if (nt < 20) { split = 5; nc0 = (nt - 18) * 256; }
        else if (nt < 24) { split = 6; nc0 = (nt - 20) * 256; }
        else if (nt < 28) { split = 7; nc0 = (nt - 24) * 256; }
        else if (nt < 32) { split = 9; nc0 = (nt - 28) * 256; }
        else { split = 10; nc0 = (nt - 32) * 256; }
        const float* rstd = (const float*)(ws + OFF_RSTD);
        const float* rope = (const float*)(ws + OFF_ROPE);
        const bool do_rope = split <= 1 && (wc & 1) == 0;
#pragma unroll
        for (int ai = 0; ai < 2; ++ai)
#pragma unroll
            for (int m = 0; m < 4; ++m) {
                const int tok = u.pm * 256 + ai * 128 + wr * 64 + m * 16 + fr;
                const float rs = rstd[tok];
                const int pos = 16 + (tok & 4095), b = tok >> 12, s = tok & 4095;
#pragma unroll
                for (int bj = 0; bj < 2; ++bj)
#pragma unroll
                    for (int n = 0; n < 2; ++n) {
                        const int nb = nc0 + bj * 128 + wc * 32 + n * 16 + 4 * fq;
                        float v[4];
#pragma unroll
                        for (int j = 0; j < 4; ++j) v[j] = acc[ai][bj][m][n][j] * rs;
                        if (n == 0 && do_rope) {
                            const float* cs = rope + ((size_t)pos * 8 + 4 * (fq & 1)) * 2;
#pragma unroll
                            for (int j = 0; j < 4; ++j) {
                                const float other = __shfl_xor(v[j], 32);
                                const float c = cs[2 * j], sn = cs[2 * j + 1];
                                v[j] = fq < 2 ? (v[j] * c - other * sn) : (v[j] * c + other * sn);
                            }
                        }
                        if (split == 2 || split == 6) {
                            const int hshift = split == 2 ? 7 : 8, nheads = split == 2 ? 8 : 4, dvn = 1 << hshift;
                            bf16_t* base = (bf16_t*)(ws + (split == 2 ? OFF_AVT : OFF_GVT));
#pragma unroll
                            for (int j = 0; j < 4; ++j) {
                                const int nn = nb + j, hd = nn >> hshift, dv = nn & (dvn - 1);
                                base[((size_t)(b * nheads + hd) * dvn + dv) * 4096 + s] = f2bf(v[j]);
                            }
                        } else if (split >= 9) {
                            const unsigned o = sig_u8(v[0]) | (sig_u8(v[1]) << 8) | (sig_u8(v[2]) << 16) | (sig_u8(v[3]) << 24);
                            *(unsigned*)(ws + (split == 9 ? OFF_SGA : OFF_SGB) + (size_t)tok * 1024 + nb) = o;
                        } else {
                            bf16_t* dst; int ld;
                            switch (split) {
                                case 0: dst = (bf16_t*)(dout + DO_AQ); ld = 1024; break;
                                case 1: dst = (bf16_t*)(ws + OFF_AK); ld = 1024; break;
                                case 3: dst = (bf16_t*)(ws + OFF_AZ); ld = 1024; break;
                                case 4: dst = (bf16_t*)(dout + DO_GQ); ld = 512; break;
                                case 5: dst = (bf16_t*)(dout + DO_GK); ld = 512; break;
                                default: dst = (bf16_t*)(ws + OFF_GZ); ld = 1024; break;
                            }
                            u32x2 o; o.x = pk2(v[0], v[1]); o.y = pk2(v[2], v[3]);
                            *(u32x2*)(dst + (size_t)tok * ld + nb) = o;
                        }
                    }
            }
    }
};

DI void p1_glr_job(const Params& p, unsigned char* lds, int job) {
    const int tid = opaque_tid(), lane = tid & 63, wave = tid >> 6, l15 = lane & 15, g = lane >> 4;
    const int rtile = wave & 3, khalf = wave >> 2;
    const bf16_t* xb = (const bf16_t*)(p.ws + OFF_XB);
    const bf16_t* wt = (const bf16_t*)(p.ws + OFF_WIN_T) + (size_t)9216 * 1024;
    const size_t row0 = (size_t)job * 64 + rtile * 16;
    const bf16_t* ap = xb + (row0 + l15) * 1024 + khalf * 512 + 8 * g;
    const bf16_t* bp = wt + (size_t)l15 * 1024 + khalf * 512 + 8 * g;
    f32x4 acc = (f32x4){0.f, 0.f, 0.f, 0.f};
#pragma unroll 4
    for (int ks = 0; ks < 16; ++ks) {
        const bf16x8 a = *(const bf16x8*)(ap + ks * 32), bb = *(const bf16x8*)(bp + ks * 32);
        acc = MFMA16(a, bb, acc);
    }
    f32x4* red = (f32x4*)lds;
    __syncthreads();
    if (khalf == 1) red[rtile * 64 + lane] = acc;
    __syncthreads();
    if (khalf == 0) {
        const f32x4 o = red[rtile * 64 + lane];
        const float* rstd = (const float*)(p.ws + OFF_RSTD);
        bf16_t* glr = (bf16_t*)(p.ws + OFF_GLR);
#pragma unroll
        for (int i = 0; i < 4; ++i) {
            const size_t row = row0 + 4 * g + i;
            glr[row * 16 + l15] = f2bf((acc[i] + o[i]) * rstd[row]);
        }
    }
    __syncthreads();
}

DI void p1_meta_job(const Params& p, unsigned char* lds, int job) {
    const int tid = opaque_tid(), lane = tid & 63, wave = tid >> 6, l15 = lane & 15, g = lane >> 4;
    int c0;
    if (job < 64) c0 = 1024 + job * 16;
    else if (job < 128) c0 = 2048 + (job - 64) * 16;
    else if (job < 160) c0 = 4608 + (job - 128) * 16;
    else if (job < 224) c0 = 5120 + (job - 160) * 16;
    else c0 = 9216;
    const bf16_t* xbm = (const bf16_t*)(p.ws + OFF_XBM);
    const bf16_t* wt = (const bf16_t*)(p.ws + OFF_WIN_T);
    const bf16_t* ap = xbm + (size_t)l15 * 1024 + wave * 128 + 8 * g;
    const bf16_t* bp = wt + (size_t)(c0 + l15) * 1024 + wave * 128 + 8 * g;
    f32x4 acc = (f32x4){0.f, 0.f, 0.f, 0.f};
#pragma unroll
    for (int ks = 0; ks < 4; ++ks) {
        const bf16x8 a = *(const bf16x8*)(ap + ks * 32), bb = *(const bf16x8*)(bp + ks * 32);
        acc = MFMA16(a, bb, acc);
    }
    f32x4* red = (f32x4*)lds;
    __syncthreads();
    red[wave * 64 + lane] = acc;
    __syncthreads();
    if (wave == 0) {
        f32x4 s = red[lane];
#pragma unroll
        for (int w = 1; w < 8; ++w) { const f32x4 t = red[w * 64 + lane]; s.x += t.x; s.y += t.y; s.z += t.z; s.w += t.w; }
        const float* rstd = (const float*)(p.ws + OFF_RSTD) + MROWS;
        const float* rope = (const float*)(p.ws + OFF_ROPE);
        unsigned char* ws = p.ws;
        const int col = c0 + l15;
#pragma unroll
        for (int i = 0; i < 4; ++i) {
            const int row = 4 * g + i;
            float v = s[i] * rstd[row];
            if (job < 64 && (c0 & 63) == 0) {
                const float other = __shfl_xor(v, 8);
                const float* cs = rope + ((size_t)row * 8 + (l15 & 7)) * 2;
                const float c = cs[0], sn = cs[1];
                v = (l15 < 8) ? (v * c - other * sn) : (v * c + other * sn);
            }
            const bf16_t val = f2bf(v);
            if (job < 64) ((bf16_t*)(ws + OFF_AKM))[(size_t)(48 + row) * 1024 + (col - 1024)] = val;
            else if (job < 128) { const int n = col - 2048; ((bf16_t*)(ws + OFF_AVTM))[(size_t)n * 64 + 48 + row] = val; }
            else if (job < 160) ((bf16_t*)(ws + OFF_GKM))[(size_t)row * 512 + (col - 4608)] = val;
            else if (job < 224) { const int n = col - 5120; ((bf16_t*)(ws + OFF_GVTM))[(size_t)n * 64 + 48 + row] = val; }
            else ((bf16_t*)(ws + OFF_GLRM))[row * 16 + l15] = val;
        }
    }
    __syncthreads();
}

DI void phase1(const Params& p, unsigned char* lds) {
    for (int j = blockIdx.x; j < 256; j += gridDim.x) p1_glr_job(p, lds, j);
    for (int j = blockIdx.x; j < 225; j += gridDim.x) p1_meta_job(p, lds, j);
    pg8::Gemm g; g.A = (const bf16_t*)(p.ws + OFF_XB); g.Bt = (const bf16_t*)(p.ws + OFF_WIN_T); g.M = MROWS; g.N = 9216; g.K = 1024;
    SchedP1 S; EpiInProj E; E.ws = p.ws; E.dout = (unsigned char*)p.out;
    pg8::gemm_phase<EpiInProj, SchedP1, true, true>((PG8_LAS unsigned char*)lds, g, S, E);
}

DI void phase15(const Params& p, unsigned char* lds) {
    const int tid = opaque_tid(), col = tid;
    float w2[16];
#pragma unroll
    for (int j = 0; j < 16; ++j) w2[j] = p.gate_w2[j * 512 + col];
    const float bias = p.gate_b[col];
    unsigned char* ws = p.ws;
    unsigned char* dout = (unsigned char*)p.out;
    for (int item = blockIdx.x; item < 257; item += gridDim.x) {
        const bool meta = item == 256;
        const int b = item >> 6, c = item & 63;
        const size_t row0 = (size_t)b * 4096 + c * 64;
        const bf16_t* glr = meta ? (const bf16_t*)(ws + OFF_GLRM) : (const bf16_t*)(ws + OFF_GLR) + row0 * 16;
        const int nrows = meta ? 16 : 64;
        bf16_t* qp = (bf16_t*)(dout + DO_GQ) + row0 * 512 + col;
        const bf16_t* kin = meta ? (const bf16_t*)(ws + OFF_GKM) + col : (const bf16_t*)(dout + DO_GK) + row0 * 512 + col;
        bf16_t* kout = meta ? (bf16_t*)(ws + OFF_KTM) + 48 * 512 + col : (bf16_t*)(dout + DO_GK) + row0 * 512 + col;
        bf16_t* ktt = meta ? (bf16_t*)(ws + OFF_KTTM) + (size_t)col * 64 + 48 : (bf16_t*)(ws + OFF_WIN_T) + ((size_t)b * 512 + col) * 4096 + c * 64;
        __syncthreads();
        if (tid < nrows * 2) ((u32x4*)lds)[tid] = ((const u32x4*)glr)[tid];
        __syncthreads();
        float bsum = 0.f;
        bf16_t kc[8], qc[8], kn[8], qn[8];
#pragma unroll
        for (int rr = 0; rr < 8; ++rr) { kc[rr] = kin[(size_t)rr * 512]; qc[rr] = meta ? (bf16_t)0 : qp[(size_t)rr * 512]; }
        for (int r0 = 0; r0 < nrows; r0 += 8) {
            if (r0 + 8 < nrows) {
#pragma unroll
                for (int rr = 0; rr < 8; ++rr) { kn[rr] = kin[(size_t)(r0 + 8 + rr) * 512]; qn[rr] = meta ? (bf16_t)0 : qp[(size_t)(r0 + 8 + rr) * 512]; }
            }
            float kt8[8];
#pragma unroll
            for (int rr = 0; rr < 8; ++rr) {
                const int r = r0 + rr;
                const u32x4* g4 = (const u32x4*)(lds + r * 32);
                const u32x4 ga = g4[0], gb = g4[1];
                float gk = bias;
                gk += bflo(ga.x) * w2[0] + bfhi(ga.x) * w2[1] + bflo(ga.y) * w2[2] + bfhi(ga.y) * w2[3];
                gk += bflo(ga.z) * w2[4] + bfhi(ga.z) * w2[5] + bflo(ga.w) * w2[6] + bfhi(ga.w) * w2[7];
                gk += bflo(gb.x) * w2[8] + bfhi(gb.x) * w2[9] + bflo(gb.y) * w2[10] + bfhi(gb.y) * w2[11];
                gk += bflo(gb.z) * w2[12] + bfhi(gb.z) * w2[13] + bflo(gb.w) * w2[14] + bfhi(gb.w) * w2[15];
                const float lg = (fminf(gk, 0.f) - __logf(1.0f + __expf(-fabsf(gk)))) * (1.0f / 16.0f);
                bsum += lg;
                const float eb = __expf(bsum);
                const float kt = bf2f(kc[rr]) * __builtin_amdgcn_rcpf(eb);
                kt8[rr] = kt;
                kout[(size_t)r * 512] = f2bf(kt);
                if (!meta) qp[(size_t)r * 512] = f2bf(bf2f(qc[rr]) * 0.08838834764831845f * eb);
            }
            u32x4 o; o.x = pk2(kt8[0], kt8[1]); o.y = pk2(kt8[2], kt8[3]); o.z = pk2(kt8[4], kt8[5]); o.w = pk2(kt8[6], kt8[7]);
            *(u32x4*)(ktt + r0) = o;
#pragma unroll
            for (int rr = 0; rr < 8; ++rr) { kc[rr] = kn[rr]; qc[rr] = qn[rr]; }
        }
        if (meta) {
            ((float*)(ws + OFF_DECM))[col] = expf(bsum);
            bf16_t* km = (bf16_t*)(ws + OFF_KTM);
            for (int r = 0; r < 48; ++r) km[r * 512 + col] = 0;
            u32x4 z = {0u, 0u, 0u, 0u};
            u32x4* kz = (u32x4*)((bf16_t*)(ws + OFF_KTTM) + (size_t)col * 64);
#pragma unroll
            for (int j = 0; j < 6; ++j) kz[j] = z;
        } else {
            ((float*)(ws + OFF_DEC))[((size_t)b * 64 + c) * 512 + col] = expf(bsum);
        }
    }
}

constexpr int A_KROWB = 272, A_VROWB = 144, A_KB = 64 * A_KROWB, A_VB = 128 * A_VROWB, A_STAGE = A_KB + A_VB;
DI void attn_tile(const unsigned char* sK, const unsigned char* sV, int tt, int qb, int qs, int sub, int l31, int h,
                  const bf16x8 (&qf)[4], f32x16 (&O)[4], float& m, float& l) {
    const float SC = 0.125f * 1.4426950408889634f;
    f32x16 st[2];
#pragma unroll
    for (int k2 = 0; k2 < 2; ++k2)
#pragma unroll
        for (int i = 0; i < 16; ++i) st[k2][i] = 0.f;
#pragma unroll
    for (int k2 = 0; k2 < 2; ++k2)
#pragma unroll
        for (int ks = 0; ks < 4; ++ks) {
            const bf16x8 kf = *(const bf16x8*)(sK + (k2 * 32 + l31) * A_KROWB + (sub * 64 + ks * 16 + 8 * h) * 2);
            st[k2] = MFMA32(kf, qf[ks], st[k2]);
        }
    if (tt == 0) {
#pragma unroll
        for (int i = 0; i < 16; ++i) { st[0][i] = -INFINITY; if (i < 8) st[1][i] = -INFINITY; }
    } else if (tt >= 2 * qb + 1) {
        const int kbase = (tt - 1) * 64 + 4 * h;
#pragma unroll
        for (int k2 = 0; k2 < 2; ++k2)
#pragma unroll
            for (int i = 0; i < 16; ++i) {
                const int key = kbase + k2 * 32 + (i & 3) + 8 * (i >> 2);
                if (key > qs) st[k2][i] = -INFINITY;
            }
    }
    float mx = -INFINITY;
#pragma unroll
    for (int k2 = 0; k2 < 2; ++k2)
#pragma unroll
        for (int i = 0; i < 16; ++i) mx = fmaxf(mx, st[k2][i]);
    mx = fmaxf(mx, __shfl_xor(mx, 32));
    const float mnew = fmaxf(m, mx);
    const float alpha = __builtin_amdgcn_exp2f((m - mnew) * SC);
    const float mc = mnew * SC;
    m = mnew;
    float ps = 0.f;
#pragma unroll
    for (int k2 = 0; k2 < 2; ++k2)
#pragma unroll
        for (int i = 0; i < 16; ++i) { const float pv = __builtin_amdgcn_exp2f(st[k2][i] * SC - mc); st[k2][i] = pv; ps += pv; }
    l = l * alpha + ps;
#pragma unroll
    for (int d = 0; d < 4; ++d)
#pragma unroll
        for (int i = 0; i < 16; ++i) O[d][i] *= alpha;
    bf16x8 pb[4];
#pragma unroll
    for (int k4 = 0; k4 < 4; ++k4) {
        const int k2 = k4 >> 1, o8 = 8 * (k4 & 1);
        u32x4 pk;
        pk.x = pk2(st[k2][o8 + 0], st[k2][o8 + 1]); pk.y = pk2(st[k2][o8 + 2], st[k2][o8 + 3]);
        pk.z = pk2(st[k2][o8 + 4], st[k2][o8 + 5]); pk.w = pk2(st[k2][o8 + 6], st[k2][o8 + 7]);
        pb[k4] = __builtin_bit_cast(bf16x8, pk);
    }
#pragma unroll
    for (int d = 0; d < 4; ++d)
#pragma unroll
        for (int k4 = 0; k4 < 4; ++k4) {
            const bf16x8 vv = *(const bf16x8*)(sV + (d * 32 + l31) * A_VROWB + k4 * 32 + 16 * h);
            O[d] = MFMA32(vv, pb[k4], O[d]);
        }
}

DI void attn_item(const Params& p, unsigned char* lds, int b, int hd, int qb) {
    const int tid = opaque_tid(), lane = tid & 63, wave = tid >> 6, l31 = lane & 31, h = lane >> 5;
    const int sub = wave >> 2, rt = wave & 3;
    const bf16_t* aq = (const bf16_t*)((unsigned char*)p.out + DO_AQ);
    const bf16_t* ak = (const bf16_t*)(p.ws + OFF_AK);
    const bf16_t* avT = (const bf16_t*)(p.ws + OFF_AVT);
    const bf16_t* akm = (const bf16_t*)(p.ws + OFF_AKM);
    const bf16_t* avTm = (const bf16_t*)(p.ws + OFF_AVTM);
    bf16_t* az = (bf16_t*)(p.ws + OFF_AZ);
    const int qs = qb * 128 + rt * 32 + l31;
    const size_t grow = (size_t)b * 4096 + qs;
    bf16x8 qf[4];
#pragma unroll
    for (int ks = 0; ks < 4; ++ks) qf[ks] = *(const bf16x8*)(aq + grow * 1024 + hd * 128 + sub * 64 + ks * 16 + 8 * h);
    f32x16 O[4];
#pragma unroll
    for (int d = 0; d < 4; ++d)
#pragma unroll
        for (int i = 0; i < 16; ++i) O[d][i] = 0.f;
    float m = -INFINITY, l = 0.f;
    const int T = 2 * qb + 3;
    u32x4 k0r[2], v0r[2];
    const int krow_ = tid >> 4, kc_ = tid & 15, vdv_ = tid >> 3, vc_ = tid & 7;
    const bf16_t* kp = ak + ((size_t)b * 4096 + krow_) * 1024 + hd * 128 + kc_ * 8;
    const bf16_t* vp_ = avT + ((size_t)(b * 8 + hd) * 128 + vdv_) * 4096 + vc_ * 8;
#define A_LOAD_REAL(KR, VR)                                                                                                   \
    {                                                                                                                         \
        KR[0] = *(const u32x4*)kp; KR[1] = *(const u32x4*)(kp + 32 * 1024); kp += 64 * 1024;                                  \
        VR[0] = *(const u32x4*)vp_; VR[1] = *(const u32x4*)(vp_ + (size_t)64 * 4096); vp_ += 64;                              \
    }
#define A_STORE(KR, VR, buf_)                                                                                                 \
    {                                                                                                                         \
        unsigned char* sK_ = lds + (buf_) * A_STAGE; unsigned char* sV_ = sK_ + A_KB;                                         \
        _Pragma("unroll") for (int i = 0; i < 2; ++i) { const int pi = tid + 512 * i, row = pi >> 4, c = pi & 15;              \
            *(u32x4*)(sK_ + row * A_KROWB + c * 16) = KR[i]; }                                                                \
        _Pragma("unroll") for (int i = 0; i < 2; ++i) { const int pi = tid + 512 * i, dv = pi >> 3, c = pi & 7;                \
            unsigned char* d_ = sV_ + dv * A_VROWB + (c >> 1) * 32 + 8 * (c & 1); u32x2 a_, b_; a_.x = VR[i].x; a_.y = VR[i].y; b_.x = VR[i].z; b_.y = VR[i].w; \
            *(u32x2*)d_ = a_; *(u32x2*)(d_ + 16) = b_; }                                                                      \
    }
    {
        const bf16_t* km_ = akm + (size_t)krow_ * 1024 + hd * 128 + kc_ * 8;
        k0r[0] = *(const u32x4*)km_; k0r[1] = *(const u32x4*)(km_ + 32 * 1024);
        const bf16_t* vm_ = avTm + (size_t)(hd * 128 + vdv_) * 64 + vc_ * 8;
        v0r[0] = *(const u32x4*)vm_; v0r[1] = *(const u32x4*)(vm_ + 64 * 64);
    }
    A_STORE(k0r, v0r, 0);
    __syncthreads();
    for (int tt = 0; tt < T; ++tt) {
        if (tt + 1 < T) A_LOAD_REAL(k0r, v0r);
        attn_tile(lds + (tt & 1) * A_STAGE, lds + (tt & 1) * A_STAGE + A_KB, tt, qb, qs, sub, l31, h, qf, O, m, l);
        if (tt + 1 < T) A_STORE(k0r, v0r, (tt + 1) & 1);
        __syncthreads();
    }
#undef A_LOAD_REAL
#undef A_STORE
    float lam;
    {
        const float a_ = wave_sum(p.lq1[lane] * p.lk1[lane]);
        const float b_ = wave_sum(p.lq2[lane] * p.lk2[lane]);
        lam = expf(a_) - expf(b_) + 0.2f;
    }
    const float ltot = l + __shfl_xor(l, 32);
    const float linv = 1.0f / ltot;
    float* ex = (float*)lds;
    if (sub == 1) {
#pragma unroll
        for (int d = 0; d < 4; ++d)
#pragma unroll
            for (int i = 0; i < 16; ++i) { ex[(rt * 32 + l31) * 129 + d * 32 + (i & 3) + 8 * (i >> 2) + 4 * h] = O[d][i] * linv; if (i == 15) __builtin_amdgcn_sched_barrier(0); }
    }
    __syncthreads();
    if (sub == 0) {
        float ss = 0.f;
#pragma unroll
        for (int d = 0; d < 4; ++d)
#pragma unroll
            for (int i = 0; i < 16; ++i) {
                const float o2 = ex[(rt * 32 + l31) * 129 + d * 32 + (i & 3) + 8 * (i >> 2) + 4 * h];
                const float o = O[d][i] * linv - lam * o2;
                O[d][i] = o; ss += o * o;
                if (i == 15) __builtin_amdgcn_sched_barrier(0);
            }
        ss += __shfl_xor(ss, 32);
        const float rstd = 1.0f / sqrtf(ss * (1.0f / 128.0f) + EPS);
#pragma unroll
        for (int d = 0; d < 4; ++d)
#pragma unroll
            for (int g = 0; g < 4; ++g) {
                bf16_t* zp = az + grow * 1024 + hd * 128 + d * 32 + 8 * g + 4 * h;
                const u32x2 zz = *(const u32x2*)zp;
                u32x2 o;
                o.x = pk2(O[d][4 * g] * rstd * siluf_(bflo(zz.x)), O[d][4 * g + 1] * rstd * siluf_(bfhi(zz.x)));
                o.y = pk2(O[d][4 * g + 2] * rstd * siluf_(bflo(zz.y)), O[d][4 * g + 3] * rstd * siluf_(bfhi(zz.y)));
                *(u32x2*)zp = o;
                if (g == 3) __builtin_amdgcn_sched_barrier(0);
            }
    }
    __syncthreads();
}

constexpr int L_KROWB = 272, L_VROWB = 144, L_SROWB = 272;
constexpr int L_K = 0, L_V = 64 * L_KROWB, L_S = L_V + 32 * L_VROWB, L_END = L_S + 32 * L_SROWB;
DI void gla_item(const Params& p, unsigned char* lds, int b, int hh, int sl) {
    const int tid = opaque_tid(), lane = tid & 63, wave = tid >> 6, l15 = lane & 15, g = lane >> 4;
    const int tt = wave & 3, dvt = wave >> 2;
    unsigned char* ws = p.ws;
    unsigned char* dout = (unsigned char*)p.out;
    const bf16_t* gq = (const bf16_t*)(dout + DO_GQ);
    const bf16_t* gk = (const bf16_t*)(dout + DO_GK);
    const bf16_t* gvT = (const bf16_t*)(ws + OFF_GVT);
    const bf16_t* ktt = (const bf16_t*)(ws + OFF_WIN_T);
    const float* dec = (const float*)(ws + OFF_DEC);
    bf16_t* gz = (bf16_t*)(ws + OFF_GZ);
    float* ssqb = (float*)(ws + OFF_SSQB);
    unsigned char* sK = lds + L_K; unsigned char* sV = lds + L_V; unsigned char* sS = lds + L_S;
    for (int i = tid; i < 32 * L_SROWB / 4; i += 512) ((unsigned*)sS)[i] = 0u;
    f32x4 sacc[2];
#pragma unroll
    for (int c = 0; c < 2; ++c) sacc[c] = (f32x4){0.f, 0.f, 0.f, 0.f};
    u32x4 nk[2]; u32x4 nv; bf16x8 nq[4]; bf16x8 nkt[2][2]; float nd[2]; u32x2 ngz;
    const int cc0 = 16 * (2 * tt) + l15;
    const int krow_ = tid >> 4, kc_ = tid & 15, vdv_ = (tid >> 3) & 31, vc_ = tid & 7;
    const bf16_t* kp = gk + ((size_t)b * 4096 + krow_) * 512 + hh * 128 + kc_ * 8;
    const bf16_t* vp_ = gvT + ((size_t)(b * 4 + hh) * 256 + sl * 32 + vdv_) * 4096 + vc_ * 8;
    const bf16_t* ktp = ktt + ((size_t)(b * 4 + hh) * 128 + cc0) * 4096 + 8 * g;
    const float* dp = dec + (size_t)b * 64 * 512 + hh * 128 + cc0;
    const bf16_t* qp = gq + ((size_t)b * 4096 + 16 * tt + l15) * 512 + hh * 128 + 8 * g;
    bf16_t* gzp = gz + ((size_t)b * 4096 + 16 * tt + l15) * 1024 + hh * 256 + sl * 32 + 16 * dvt + 4 * g;
#define L_LOAD_META()                                                                                                         \
    {                                                                                                                         \
        const bf16_t* km_ = (const bf16_t*)(ws + OFF_KTM) + (size_t)krow_ * 512 + hh * 128 + kc_ * 8;                         \
        nk[0] = *(const u32x4*)km_; nk[1] = *(const u32x4*)(km_ + 32 * 512);                                                  \
        nv = *(const u32x4*)((const bf16_t*)(ws + OFF_GVTM) + (size_t)(hh * 256 + sl * 32 + vdv_) * 64 + vc_ * 8);            \
        _Pragma("unroll") for (int ct = 0; ct < 2; ++ct) _Pragma("unroll") for (int ks = 0; ks < 2; ++ks)                     \
            nkt[ct][ks] = *(const bf16x8*)((const bf16_t*)(ws + OFF_KTTM) + (size_t)(hh * 128 + cc0 + 16 * ct) * 64 + 32 * ks + 8 * g); \
        _Pragma("unroll") for (int ct = 0; ct < 2; ++ct) nd[ct] = ((const float*)(ws + OFF_DECM))[hh * 128 + cc0 + 16 * ct];  \
        _Pragma("unroll") for (int ks = 0; ks < 4; ++ks) nq[ks] = (bf16x8){0, 0, 0, 0, 0, 0, 0, 0};                           \
        ngz = (u32x2){0u, 0u};                                                                                                \
    }
#define L_LOAD_REAL()                                                                                                         \
    {                                                                                                                         \
        nk[0] = *(const u32x4*)kp; nk[1] = *(const u32x4*)(kp + 32 * 512); kp += 64 * 512;                                    \
        nv = *(const u32x4*)vp_; vp_ += 64;                                                                                   \
        _Pragma("unroll") for (int ct = 0; ct < 2; ++ct) _Pragma("unroll") for (int ks = 0; ks < 2; ++ks)                     \
            nkt[ct][ks] = *(const bf16x8*)(ktp + (size_t)(16 * ct) * 4096 + 32 * ks);                                         \
        ktp += 64;                                                                                                            \
        nd[0] = dp[0]; nd[1] = dp[16]; dp += 512;                                                                             \
        _Pragma("unroll") for (int ks = 0; ks < 4; ++ks) nq[ks] = *(const bf16x8*)(qp + 32 * ks);                             \
        qp += 64 * 512;                                                                                                       \
        ngz = *(const u32x2*)gzp; gzp += 64 * 1024;                                                                           \
    }
#define L_STORE()                                                                                                             \
    {                                                                                                                         \
        _Pragma("unroll") for (int i = 0; i < 2; ++i) { const int pi = tid + 512 * i, row = pi >> 4, c = pi & 15;              \
            *(u32x4*)(sK + row * L_KROWB + c * 16) = nk[i]; }                                                                 \
        if (tid < 256) { const int dv = tid >> 3, c = tid & 7; *(u32x4*)(sV + dv * L_VROWB + c * 16) = nv; }                  \
    }
    L_LOAD_META();
    L_STORE();
    for (int n = 0; n <= 64; ++n) {
        bf16x8 cq[4], ckt[2][2]; float cd[2]; u32x2 cgz;
#pragma unroll
        for (int ks = 0; ks < 4; ++ks) cq[ks] = nq[ks];
#pragma unroll
        for (int ct = 0; ct < 2; ++ct) { cd[ct] = nd[ct]; ckt[ct][0] = nkt[ct][0]; ckt[ct][1] = nkt[ct][1]; }
        cgz = ngz;
        __syncthreads();
        if (n + 1 <= 64) L_LOAD_REAL();
        if (n > 0) {
            f32x4 at[4];
#pragma unroll
            for (int jt = 0; jt < 4; ++jt) at[jt] = (f32x4){0.f, 0.f, 0.f, 0.f};
#pragma unroll
            for (int jt = 0; jt < 4; ++jt)
#pragma unroll
                for (int ks = 0; ks < 4; ++ks) {
                    const bf16x8 kf = *(const bf16x8*)(sK + (jt * 16 + l15) * L_KROWB + (ks * 32 + 8 * g) * 2);
                    at[jt] = MFMA16(kf, cq[ks], at[jt]);
                }
            const int tl = 16 * tt + l15;
#pragma unroll
            for (int jt = 0; jt < 4; ++jt)
#pragma unroll
                for (int i = 0; i < 4; ++i) if (16 * jt + 4 * g + i > tl) at[jt][i] = 0.f;
            f32x4 o = (f32x4){0.f, 0.f, 0.f, 0.f};
#pragma unroll
            for (int s2 = 0; s2 < 2; ++s2) {
                u32x4 pa;
                pa.x = pk2(at[2 * s2][0], at[2 * s2][1]); pa.y = pk2(at[2 * s2][2], at[2 * s2][3]);
                pa.z = pk2(at[2 * s2 + 1][0], at[2 * s2 + 1][1]); pa.w = pk2(at[2 * s2 + 1][2], at[2 * s2 + 1][3]);
                const unsigned char* vp = sV + (dvt * 16 + l15) * L_VROWB + (32 * s2 + 4 * g) * 2;
                const u32x2 lo = *(const u32x2*)vp, hi = *(const u32x2*)(vp + 32);
                u32x4 vv; vv.x = lo.x; vv.y = lo.y; vv.z = hi.x; vv.w = hi.y;
                o = MFMA16(__builtin_bit_cast(bf16x8, vv), __builtin_bit_cast(bf16x8, pa), o);
            }
#pragma unroll
            for (int ks = 0; ks < 4; ++ks) {
                const bf16x8 sf = *(const bf16x8*)(sS + (dvt * 16 + l15) * L_SROWB + (ks * 32 + 8 * g) * 2);
                o = MFMA16(sf, cq[ks], o);
            }
            const size_t row = (size_t)b * 4096 + (n - 1) * 64 + 16 * tt + l15;
            float ss = (o[0] * o[0] + o[1] * o[1]) + (o[2] * o[2] + o[3] * o[3]);
            ss += __shfl_xor(ss, 16); ss += __shfl_xor(ss, 32);
            u32x2 ov;
            ov.x = pk2(o[0] * siluf_(bflo(cgz.x)), o[1] * siluf_(bfhi(cgz.x)));
            ov.y = pk2(o[2] * siluf_(bflo(cgz.y)), o[3] * siluf_(bfhi(cgz.y)));
            *(u32x2*)(gz + row * 1024 + hh * 256 + sl * 32 + 16 * dvt + 4 * g) = ov;
            if (g == 0) ssqb[(row * 4 + hh) * 16 + sl * 2 + dvt] = ss;
        }
#pragma unroll
        for (int ks = 0; ks < 2; ++ks) {
            const bf16x8 vf = *(const bf16x8*)(sV + (dvt * 16 + l15) * L_VROWB + (32 * ks + 8 * g) * 2);
            sacc[0] = MFMA16(vf, ckt[0][ks], sacc[0]);
            sacc[1] = MFMA16(vf, ckt[1][ks], sacc[1]);
        }
#pragma unroll
        for (int ct = 0; ct < 2; ++ct)
#pragma unroll
            for (int i = 0; i < 4; ++i) sacc[ct][i] *= cd[ct];
        __syncthreads();
#pragma unroll
        for (int ct = 0; ct < 2; ++ct)
#pragma unroll
            for (int i = 0; i < 4; ++i)
                *(bf16_t*)(sS + (16 * dvt + 4 * g + i) * L_SROWB + (cc0 + 16 * ct) * 2) = f2bf(sacc[ct][i]);
        if (n + 1 <= 64) L_STORE();
    }
#undef L_LOAD_META
#undef L_LOAD_REAL
#undef L_STORE
    __syncthreads();
}

DI void phase2(const Params& p, unsigned char* lds) {
    const int tid = opaque_tid();
    volatile unsigned* sItem = (volatile unsigned*)(lds + LDS_ITEM);
    constexpr unsigned N_GLA = 16, N_ATT = 128;
    if (tid == 0) sItem[1] = 0u;
    for (;;) {
        if (tid == 0) {
            unsigned* heads = (unsigned*)(p.ws + OFF_CTR);
            const unsigned x0 = (unsigned)__builtin_amdgcn_s_getreg((3 << 11) | 20) & 7u;
            unsigned k = sItem[1], it = 0xffffffffu;
            while (k < 8u) {
                const unsigned x = (x0 + k) & 7u;
                const unsigned got = atomicAdd(heads + x, 1u);
                if (got < N_GLA + N_ATT) { it = got | (x << 16); break; }
                ++k;
            }
            sItem[1] = k; sItem[0] = it;
        }
        __syncthreads();
        const unsigned item = (unsigned)__builtin_amdgcn_readfirstlane((int)sItem[0]);
        __syncthreads();
        if (item == 0xffffffffu) break;
        const unsigned x = item >> 16, idx = item & 0xffffu;
        if (idx < N_GLA) { const unsigned gi = x * 16 + idx; gla_item(p, lds, gi >> 5, (gi >> 3) & 3, gi & 7); }
        else { const unsigned a = idx - N_GLA, pair = 4 * x + (a >> 5); attn_item(p, lds, pair & 3, pair >> 2, 31 - (int)(a & 31)); }
    }
}

DI void phase25(const Params& p, unsigned char* lds) {
    const int tid = opaque_tid(), lane = tid & 63, wave = tid >> 6;
    const float* ssqb = (const float*)(p.ws + OFF_SSQB);
    bf16_t* gz = (bf16_t*)(p.ws + OFF_GZ);
    for (int it = blockIdx.x; it < MROWS / 8; it += gridDim.x) {
        const size_t row = (size_t)it * 8 + wave;
        float s = ssqb[(row * 4 + (lane >> 4)) * 16 + (lane & 15)];
        s += __shfl_xor(s, 1); s += __shfl_xor(s, 2); s += __shfl_xor(s, 4); s += __shfl_xor(s, 8);
        const float r = 1.0f / sqrtf(s * (1.0f / 256.0f) + EPS);
        u32x4* ptr = (u32x4*)(gz + row * 1024 + lane * 16);
#pragma unroll
        for (int j = 0; j < 2; ++j) {
            u32x4 u = ptr[j], o;
            o.x = pk2(bflo(u.x) * r, bfhi(u.x) * r); o.y = pk2(bflo(u.y) * r, bfhi(u.y) * r);
            o.z = pk2(bflo(u.z) * r, bfhi(u.z) * r); o.w = pk2(bflo(u.w) * r, bfhi(u.w) * r);
            ptr[j] = o;
        }
    }
}

template <int PASS>
struct EpiMerge {
    static constexpr bool PERM = false, AFTER_DRAIN = false;
    unsigned char* ws;
    DI void operator()(const pg8::f32x4 (&acc)[2][2][4][2], const pg8::Unit& u, int wr, int wc, int fr, int fq) const {
        const unsigned char* sg = ws + (PASS == 0 ? OFF_SGB : OFF_SGA);
        bf16_t* merged = (bf16_t*)(ws + OFF_AK);
#pragma unroll
        for (int ai = 0; ai < 2; ++ai)
#pragma unroll
            for (int m = 0; m < 4; ++m) {
                const size_t tok = (size_t)u.pm * 256 + ai * 128 + wr * 64 + m * 16 + fr;
#pragma unroll
                for (int bj = 0; bj < 2; ++bj)
#pragma unroll
                    for (int n = 0; n < 2; ++n) {
                        const size_t off = tok * 1024 + u.pn * 256 + bj * 128 + wc * 32 + n * 16 + 4 * fq;
                        const unsigned ug = *(const unsigned*)(sg + off);
                        const float q = 1.0f / 255.0f;
                        float m0 = (float)(ug & 255u) * q * acc[ai][bj][m][n][0], m1 = (float)((ug >> 8) & 255u) * q * acc[ai][bj][m][n][1];
                        float m2 = (float)((ug >> 16) & 255u) * q * acc[ai][bj][m][n][2], m3 = (float)(ug >> 24) * q * acc[ai][bj][m][n][3];
                        if (PASS == 1) { const u32x2 t = *(const u32x2*)(merged + off); m0 += bflo(t.x); m1 += bfhi(t.x); m2 += bflo(t.y); m3 += bfhi(t.y); }
                        u32x2 o; o.x = pk2(m0, m1); o.y = pk2(m2, m3);
                        *(u32x2*)(merged + off) = o;
                    }
            }
    }
};
struct EpiOut {
    static constexpr bool PERM = false, AFTER_DRAIN = false;
    unsigned char* ws; const float* x; float* out;
    DI void operator()(const pg8::f32x4 (&acc)[2][2][4][2], const pg8::Unit& u, int wr, int wc, int fr, int fq) const {
        float* ssqh = (float*)(ws + OFF_SSQH);
#pragma unroll
        for (int ai = 0; ai < 2; ++ai)
#pragma unroll
            for (int m = 0; m < 4; ++m) {
                const size_t tok = (size_t)u.pm * 256 + ai * 128 + wr * 64 + m * 16 + fr;
                float ss = 0.f;
#pragma unroll
                for (int bj = 0; bj < 2; ++bj)
#pragma unroll
                    for (int n = 0; n < 2; ++n) {
                        const size_t off = tok * 1024 + u.pn * 256 + bj * 128 + wc * 32 + n * 16 + 4 * fq;
                        const f32x4 xv = *(const f32x4*)(x + off);
                        f32x4 o;
                        o.x = xv.x + acc[ai][bj][m][n][0]; o.y = xv.y + acc[ai][bj][m][n][1];
                        o.z = xv.z + acc[ai][bj][m][n][2]; o.w = xv.w + acc[ai][bj][m][n][3];
                        ss += (o.x * o.x + o.y * o.y) + (o.z * o.z + o.w * o.w);
                        *(f32x4*)(out + off) = o;
                    }
                ss += __shfl_xor(ss, 16); ss += __shfl_xor(ss, 32);
                if (fq == 0) ssqh[tok * 16 + u.pn * 4 + wc] = ss;
            }
    }
};
DI void phase3(const Params& p, unsigned char* lds) {
    SchedSq S;
    {
        pg8::Gemm g; g.A = (const bf16_t*)(p.ws + OFF_GZ); g.Bt = (const bf16_t*)(p.ws + OFF_WB_T); g.M = MROWS; g.N = 1024; g.K = 1024;
        EpiMerge<0> E; E.ws = p.ws;
        pg8::gemm_phase<EpiMerge<0>, SchedSq, true, true>((PG8_LAS unsigned char*)lds, g, S, E);
    }
    {
        pg8::Gemm g; g.A = (const bf16_t*)(p.ws + OFF_AZ); g.Bt = (const bf16_t*)(p.ws + OFF_WA_T); g.M = MROWS; g.N = 1024; g.K = 1024;
        EpiMerge<1> E; E.ws = p.ws;
        pg8::gemm_phase<EpiMerge<1>, SchedSq, true, true>((PG8_LAS unsigned char*)lds, g, S, E);
    }
}
DI void phase4(const Params& p, unsigned char* lds) {
    SchedSq S;
    pg8::Gemm g; g.A = (const bf16_t*)(p.ws + OFF_AK); g.Bt = (const bf16_t*)(p.ws + OFF_WO_T); g.M = MROWS; g.N = 1024; g.K = 1024;
    EpiOut E; E.ws = p.ws; E.x = p.x; E.out = p.out;
    pg8::gemm_phase<EpiOut, SchedSq, true, true>((PG8_LAS unsigned char*)lds, g, S, E);
}

DI void phase5(const Params& p, unsigned char* lds) {
    const int tid = opaque_tid(), lane = tid & 63, wave = tid >> 6;
    const float* ssqh = (const float*)(p.ws + OFF_SSQH);
    for (int it = blockIdx.x; it < MROWS / 8; it += gridDim.x) {
        const size_t row = (size_t)it * 8 + wave;
        float s = lane < 16 ? ssqh[row * 16 + lane] : 0.f;
        s = wave_sum(s);
        const float rstd = 1.0f / sqrtf(s * (1.0f / 1024.0f) + EPS);
        f32x4* orow = (f32x4*)(p.out + row * 1024) + lane;
        const f32x4* wrow = (const f32x4*)p.final_w + lane;
#pragma unroll
        for (int j = 0; j < 4; ++j) {
            f32x4 v = orow[64 * j]; const f32x4 w = wrow[64 * j];
            v.x = v.x * rstd * w.x; v.y = v.y * rstd * w.y; v.z = v.z * rstd * w.z; v.w = v.w * rstd * w.w;
            orow[64 * j] = v;
        }
    }
}

#define XB_TMO      128
#define XB_XCNT(j)  (256  + 64 * (j))
#define XB_XSUB(j)  (1280 + 64 * (j))
#define XB_XGEN(j)  (2304 + 64 * (j))
#define XB_TOP      3328
#define XB_TOPGEN   3392
#define XCD_BAR_WORDS 3456
#define XB_SPIN_CAP (1u << 18)
#define LAS __attribute__((address_space(3)))
DI unsigned xb_ld(unsigned* p)              { return __hip_atomic_load(p, __ATOMIC_RELAXED, __HIP_MEMORY_SCOPE_AGENT); }
DI unsigned xb_add(unsigned* p, unsigned v) { return __hip_atomic_fetch_add(p, v, __ATOMIC_RELAXED, __HIP_MEMORY_SCOPE_AGENT); }
DI unsigned xb_xcc_id() { return (unsigned)__builtin_amdgcn_s_getreg((3 << 11) | 20) & 0xFu; }
#define XB_SPIN(cond, bar) do { unsigned _sp = 0; while (cond) { __builtin_amdgcn_s_sleep(1); \
    if ((++_sp & 255u) == 0u) { if (xb_ld(&(bar)[XB_TMO])) break; if (_sp > XB_SPIN_CAP) { atomicAdd(&(bar)[XB_TMO], 1u); break; } } } } while (0)
struct XcdBarrier { unsigned* bar; unsigned x; volatile LAS unsigned* st; };
DI XcdBarrier xcd_barrier_post(unsigned* bar, volatile LAS unsigned* st) {
    XcdBarrier b; b.bar = bar; b.x = xb_xcc_id(); b.st = st;
    if (threadIdx.x == 0) (void)xb_add(&bar[XB_XCNT(b.x)], 1u);
    return b;
}
DI void xcd_barrier_complete(unsigned* bar, unsigned x, unsigned& nloc, unsigned& nx) {
    const unsigned G = gridDim.x * gridDim.y * gridDim.z;
    unsigned sum, cnt, mine, sp = 0u;
    for (;;) {
        sum = 0u; cnt = 0u; mine = 0u;
#pragma unroll
        for (unsigned j = 0; j < 16; ++j) { const unsigned c = xb_ld(&bar[XB_XCNT(j)]); sum += c; cnt += (c > 0u) ? 1u : 0u; mine = (j == x) ? c : mine; }
        if (sum == G) break;
        __builtin_amdgcn_s_sleep(1);
        if ((++sp & 255u) == 0u) { if (xb_ld(&bar[XB_TMO])) break; if (sp > XB_SPIN_CAP) { atomicAdd(&bar[XB_TMO], 1u); break; } }
    }
    nloc = mine > 0u ? mine : 1u; nx = cnt > 0u ? cnt : 1u;
}
DI void xcd_barrier(const XcdBarrier& b) {
    asm volatile("s_waitcnt vmcnt(0)" ::: "memory");
    __syncthreads();
    if (threadIdx.x == 0) {
        unsigned* bar = b.bar;
        __builtin_amdgcn_s_waitcnt(0);
        unsigned nloc = b.st[0], nx = b.st[1];
        if (nloc == 0u) { xcd_barrier_complete(bar, b.x, nloc, nx); b.st[0] = nloc; b.st[1] = nx; }
        const unsigned old = xb_add(&bar[XB_XSUB(b.x)], 1u);
        const unsigned gen = old / nloc;
        if (old + 1u == (gen + 1u) * nloc) {
            __builtin_amdgcn_fence(__ATOMIC_RELEASE, "agent");
            asm volatile("s_waitcnt vmcnt(0)" ::: "memory");
            const unsigned og = xb_add(&bar[XB_TOP], 1u);
            const unsigned tg = og / nx;
            if (og + 1u == (tg + 1u) * nx) xb_add(&bar[XB_TOPGEN], 1u);
            else XB_SPIN(xb_ld(&bar[XB_TOPGEN]) == tg, bar);
            __builtin_amdgcn_fence(__ATOMIC_ACQUIRE, "agent");
            xb_add(&bar[XB_XGEN(b.x)], 1u);
            asm volatile("s_waitcnt vmcnt(0)" ::: "memory");
        } else {
            XB_SPIN(xb_ld(&bar[XB_XGEN(b.x)]) == gen, bar);
            __builtin_amdgcn_fence(__ATOMIC_ACQUIRE, "agent");
            asm volatile("s_waitcnt vmcnt(0)" ::: "memory");
        }
    }
    __syncthreads();
}

DI void run_phase(const Params& p, unsigned char* lds, int ph) {
    switch (ph) {
        case 0: phase0(p, lds); break;
        case 1: phase1(p, lds); break;
        case 2: phase15(p, lds); break;
        case 3: phase2(p, lds); break;
        case 4: phase25(p, lds); phase3(p, lds); break;
        case 5: phase4(p, lds); break;
        default: phase5(p, lds); break;
    }
}

__global__ void __launch_bounds__(512) hybrid_fwd(Params p) {
    extern __shared__ __attribute__((aligned(16))) unsigned char lds[];
#if MULTI_LAUNCH
    run_phase(p, lds, p.phase_lo);
#else
    cg::grid_group grid = cg::this_grid();
    if (p.phase_lo == 77) grid.sync();
    {
        volatile LAS unsigned* st = (volatile LAS unsigned*)(lds + LDS_ITEM + 16);
        if (threadIdx.x == 0) { st[0] = 0u; st[1] = 0u; }
        __syncthreads();
        (void)xcd_barrier_post((unsigned*)(p.ws + OFF_XBAR), st);
    }
#define GRID_BARRIER() { XcdBarrier xb_; xb_.bar = (unsigned*)(p.ws + OFF_XBAR); xb_.x = xb_xcc_id(); xb_.st = (volatile LAS unsigned*)(lds + LDS_ITEM + 16); xcd_barrier(xb_); }
    phase0(p, lds); GRID_BARRIER();
    phase1(p, lds); GRID_BARRIER();
    phase15(p, lds); GRID_BARRIER();
    phase2(p, lds); GRID_BARRIER();
    phase25(p, lds); GRID_BARRIER();
    phase3(p, lds); GRID_BARRIER();
    phase4(p, lds); GRID_BARRIER();
    phase5(p, lds);
#endif
}

extern "C" void kernel_launch(void* const* d_in, const int* in_sizes, int n_in, void* d_out, int out_size, void* d_ws, size_t ws_size, hipStream_t stream) {
    static int grid = 0;
    if (grid == 0) {
        int dev = 0, cus = 0, per_cu = 0;
        hipGetDevice(&dev);
        hipDeviceGetAttribute(&cus, hipDeviceAttributeMultiprocessorCount, dev);
        hipFuncSetAttribute((const void*)hybrid_fwd, hipFuncAttributeMaxDynamicSharedMemorySize, LDS_BYTES);
        hipOccupancyMaxActiveBlocksPerMultiprocessor(&per_cu, (const void*)hybrid_fwd, 512, LDS_BYTES);
        if (per_cu < 1) per_cu = 1;
        if (per_cu > 1) per_cu = 1;
        if (cus <= 0) cus = 256;
        grid = cus * per_cu;
    }
    hipMemsetAsync((unsigned char*)d_ws + OFF_CTR, 0, 256, stream);
    hipMemsetAsync((unsigned char*)d_ws + OFF_XBAR, 0, 16384, stream);
    Params p{};
    p.x = (const float*)d_in[0]; p.meta = (const float*)d_in[1]; p.norm_w = (const float*)d_in[2]; p.w_in = (const float*)d_in[3];
    p.lq1 = (const float*)d_in[4]; p.lk1 = (const float*)d_in[5]; p.lq2 = (const float*)d_in[6]; p.lk2 = (const float*)d_in[7];
    p.subln_w = (const float*)d_in[8]; p.gate_w2 = (const float*)d_in[9]; p.gate_b = (const float*)d_in[10]; p.gla_norm_w = (const float*)d_in[11];
    p.wa = (const float*)d_in[12]; p.wb = (const float*)d_in[13]; p.wo = (const float*)d_in[14]; p.final_w = (const float*)d_in[15];
    p.out = (float*)d_out; p.ws = (unsigned char*)d_ws;
#if MULTI_LAUNCH
    for (int ph = 0; ph < 7; ++ph) {
        p.phase_lo = ph; p.phase_hi = ph + 1;
        hipLaunchKernelGGL(hybrid_fwd, dim3(grid), dim3(512), LDS_BYTES, stream, p);
    }
#else
    p.phase_lo = 0; p.phase_hi = 7;
    void* args[] = {&p};
    hipError_t e = hipLaunchCooperativeKernel((const void*)hybrid_fwd, dim3(grid), dim3(512), args, LDS_BYTES, stream);
    if (e != hipSuccess) fprintf(stderr, "cooperative launch failed: %s (grid %d)\n", hipGetErrorString(e), grid);
#endif
}
```

```cpp
#include <hip/hip_runtime.h>
#include <hip/hip_cooperative_groups.h>
#include <cstdio>
#include <cstdint>
namespace cg = cooperative_groups;

#ifndef MULTI_LAUNCH
#define MULTI_LAUNCH 0
#endif
#ifndef PROBE_REP
#define PROBE_REP 0
#endif

typedef unsigned short bf16_t;
typedef short bf16x8 __attribute__((ext_vector_type(8)));
typedef float f32x4 __attribute__((ext_vector_type(4)));
typedef float f32x2 __attribute__((ext_vector_type(2)));
typedef float f32x16 __attribute__((ext_vector_type(16)));
typedef unsigned u32x4 __attribute__((ext_vector_type(4)));
typedef unsigned u32x2 __attribute__((ext_vector_type(2)));
typedef __bf16 bfv2 __attribute__((ext_vector_type(2)));

#define DI __device__ __forceinline__
#define MFMA32(a, b, c) __builtin_amdgcn_mfma_f32_32x32x16_bf16((a), (b), (c), 0, 0, 0)
#define MFMA16(a, b, c) __builtin_amdgcn_mfma_f32_16x16x32_bf16((a), (b), (c), 0, 0, 0)

DI unsigned pk2(float a, float b) { f32x2 v = {a, b}; return __builtin_bit_cast(unsigned, __builtin_convertvector(v, bfv2)); }
DI float bf2f(bf16_t v) { return __uint_as_float(((unsigned)v) << 16); }
DI float bflo(unsigned u) { return __uint_as_float(u << 16); }
DI float bfhi(unsigned u) { return __uint_as_float(u & 0xffff0000u); }
DI bf16_t f2bf(float a) { return (bf16_t)(pk2(a, 0.f) & 0xffffu); }
DI float wave_sum(float v) {
#pragma unroll
    for (int o = 32; o; o >>= 1) v += __shfl_xor(v, o);
    return v;
}
DI int opaque_tid() { int t = threadIdx.x; asm volatile("" : "+v"(t)); return t; }
DI float sigmoidf_(float z) { return 1.f / (1.f + __expf(-z)); }
DI float siluf_(float z) { return z / (1.f + __expf(-z)); }

constexpr int D = 1024, NB = 4, SEQ = 4096, MROWS = NB * SEQ;
constexpr int NIN = 9232, NINP = 9344;
constexpr float EPS = 1e-5f;

constexpr size_t SZ_ACT = (size_t)MROWS * 1024 * 2;
constexpr size_t OFF_WIN_T = 0;
constexpr size_t OFF_WA_T = OFF_WIN_T + (size_t)NINP * 1024 * 2;
constexpr size_t OFF_WB_T = OFF_WA_T + 2097152;
constexpr size_t OFF_WO_T = OFF_WB_T + 2097152;
constexpr size_t OFF_AK = OFF_WO_T + 2097152;
constexpr size_t OFF_AVT = OFF_AK + SZ_ACT;
constexpr size_t OFF_AZ = OFF_AVT + SZ_ACT;
constexpr size_t OFF_GVT = OFF_AZ + SZ_ACT;
constexpr size_t OFF_GZ = OFF_GVT + SZ_ACT;
constexpr size_t OFF_GA = OFF_GZ + SZ_ACT;
constexpr size_t OFF_GB = OFF_GA + SZ_ACT;
constexpr size_t OFF_GLR = OFF_GB + SZ_ACT;
constexpr size_t OFF_RSTD = OFF_GLR + (size_t)MROWS * 16 * 2;
constexpr size_t OFF_ROPE = OFF_RSTD + 65792;
constexpr size_t OFF_AKM = OFF_ROPE + 263168;
constexpr size_t OFF_AVTM = OFF_AKM + 131072;
constexpr size_t OFF_GVTM = OFF_AVTM + 131072;
constexpr size_t OFF_GKM = OFF_GVTM + 131072;
constexpr size_t OFF_GLRM = OFF_GKM + 16384;
constexpr size_t OFF_KTM = OFF_GLRM + 512;
constexpr size_t OFF_KTTM = OFF_KTM + 65536;
constexpr size_t OFF_DEC = OFF_KTTM + 65536;
constexpr size_t OFF_DECM = OFF_DEC + 524288;
constexpr size_t OFF_SSQB = OFF_DECM + 2048;
constexpr size_t OFF_SSQH = OFF_SSQB + 4194304;
constexpr size_t OFF_CTR = OFF_SSQH + 1048576;
constexpr size_t OFF_XBM = OFF_CTR + 256;
constexpr size_t OFF_XBAR = OFF_XBM + 32768;
constexpr size_t WS_END = OFF_XBAR + 16384;
constexpr size_t OFF_XB = OFF_GA;
constexpr size_t OFF_SGA = OFF_GB;
constexpr size_t OFF_SGB = OFF_GB + (size_t)MROWS * 1024;
static_assert(WS_END <= 268435456ull, "workspace over 256 MiB");
constexpr size_t DO_AQ = 0, DO_GQ = SZ_ACT, DO_GK = SZ_ACT + SZ_ACT / 2;

constexpr int G_ROWB = 144;
constexpr int G_SW = 128 * G_ROWB, G_SX = 256 * G_ROWB, G_STAGE = G_SW + G_SX;
constexpr int G_SW4 = 256 * G_ROWB, G_STAGE4 = G_SW4 + G_SX;
constexpr int LDS_SCALE = 2 * G_STAGE4;
constexpr int LDS_ITEM = LDS_SCALE + 4096;
constexpr int LDS_BYTES = LDS_ITEM + 64;

struct Params {
    const float *x, *meta, *norm_w, *w_in, *lq1, *lk1, *lq2, *lk2, *subln_w, *gate_w2, *gate_b, *gla_norm_w, *wa, *wb, *wo, *final_w;
    float* out;
    unsigned char* ws;
    int phase_lo, phase_hi;
};

template <int MODE>
DI void p0_transpose_item(const Params& p, int item, float* tile) {
    const int tid = opaque_tid();
    const float* W = MODE == 0 ? p.w_in : MODE == 1 ? p.wa : MODE == 2 ? p.wb : p.wo;
    const int ldw = MODE == 0 ? NIN : 1024;
    const int nbc = MODE == 0 ? NINP / 64 : 16;
    bf16_t* WT = (bf16_t*)(p.ws + (MODE == 0 ? OFF_WIN_T : MODE == 1 ? OFF_WA_T : MODE == 2 ? OFF_WB_T : OFF_WO_T));
    const int kb = item / nbc, nb = item % nbc, k0 = kb * 64, n0 = nb * 64;
#pragma unroll
    for (int i = 0; i < 8; ++i) {
        const int kk = (tid >> 6) + 8 * i, nn = tid & 63, n = n0 + nn, k = k0 + kk;
        int src = n;
        if (MODE == 0) { src = n < 7168 ? n : (n < 9216 ? n + 16 : (n < 9232 ? n - 2048 : -1)); }
        float sc = 1.f;
        if (MODE == 0) sc = p.norm_w[k];
        if (MODE == 1) sc = 0.8f * p.subln_w[k & 127];
        if (MODE == 2) sc = p.gla_norm_w[k & 255];
        float v = 0.f;
        if (src >= 0) v = W[(size_t)k * ldw + src] * sc;
        tile[kk * 65 + nn] = v;
    }
    __syncthreads();
    {
        const int nn = tid >> 3, c = tid & 7;
        const float* s = tile + (8 * c) * 65 + nn;
        u32x4 o;
        o.x = pk2(s[0 * 65], s[1 * 65]); o.y = pk2(s[2 * 65], s[3 * 65]); o.z = pk2(s[4 * 65], s[5 * 65]); o.w = pk2(s[6 * 65], s[7 * 65]);
        *(u32x4*)(WT + (size_t)(n0 + nn) * 1024 + k0 + 8 * c) = o;
    }
    __syncthreads();
}

DI void phase0(const Params& p, unsigned char* lds) {
    const int tid = opaque_tid(), lane = tid & 63, wave = tid >> 6;
    float* tile = (float*)lds;
    constexpr int I_WIN = 16 * (NINP / 64), I_SQ = 256;
    constexpr int I_T = I_WIN + 3 * I_SQ;
    constexpr int I_RSTD = (MROWS + 16 + 7) / 8;
    constexpr int I_ROPE = (4112 * 8 + 511) / 512;
    constexpr int I_ZERO = 393216 / 8192;
    constexpr int I_ALL = I_T + I_RSTD + I_ROPE + I_ZERO;
    for (int it = blockIdx.x; it < I_ALL; it += gridDim.x) {
        int r = it;
        if (r < I_WIN) { p0_transpose_item<0>(p, r, tile); continue; } r -= I_WIN;
        if (r < I_SQ) { p0_transpose_item<1>(p, r, tile); continue; } r -= I_SQ;
        if (r < I_SQ) { p0_transpose_item<2>(p, r, tile); continue; } r -= I_SQ;
        if (r < I_SQ) { p0_transpose_item<3>(p, r, tile); continue; } r -= I_SQ;
        if (r < I_RSTD) {
            const int row = r * 8 + wave;
            if (row < MROWS + 16) {
                const float* src = row < MROWS ? p.x + (size_t)row * 1024 : p.meta + (size_t)(row - MROWS) * 1024;
                const f32x4* xr = (const f32x4*)src + lane;
                float s = 0.f;
#pragma unroll
                for (int j = 0; j < 4; ++j) { const f32x4 v = xr[64 * j]; s += (v.x * v.x + v.y * v.y) + (v.z * v.z + v.w * v.w); }
                s = wave_sum(s);
                if (lane == 0) ((float*)(p.ws + OFF_RSTD))[row] = 1.0f / sqrtf(s * (1.0f / 1024.0f) + EPS);
                bf16_t* xbrow = row < MROWS ? (bf16_t*)(p.ws + OFF_XB) + (size_t)row * 1024 : (bf16_t*)(p.ws + OFF_XBM) + (size_t)(row - MROWS) * 1024;
#pragma unroll
                for (int j = 0; j < 4; ++j) { const f32x4 v = xr[64 * j]; u32x2 o; o.x = pk2(v.x, v.y); o.y = pk2(v.z, v.w); *(u32x2*)(xbrow + 256 * j + 4 * lane) = o; }
            }
            continue;
        }
        r -= I_RSTD;
        if (r < I_ROPE) {
            const int e = r * 512 + tid;
            if (e < 4112 * 8) {
                const int pos = e >> 3, i = e & 7;
                const float inv = powf(500000.0f, -(float)i / 8.0f);
                const float ang = (float)pos * inv;
                float* t = (float*)(p.ws + OFF_ROPE) + (size_t)e * 2;
                t[0] = cosf(ang); t[1] = sinf(ang);
            }
            continue;
        }
        r -= I_ROPE;
        { u32x4 z = {0u, 0u, 0u, 0u}; *(u32x4*)(p.ws + OFF_AKM + (size_t)r * 8192 + tid * 16) = z; }
    }
}

template <int NI, bool HS>
DI void gemm_tile(f32x16 (&acc)[NI][2], const bf16_t* __restrict__ Wt, const bf16_t* __restrict__ X, unsigned char* lds, const float (&hs)[2][3]) {
    const int tid = opaque_tid(), lane = tid & 63, wave = tid >> 6, l31 = lane & 31, h = lane >> 5;
    const int wn = wave & 1, wm = wave >> 1;
    constexpr int SW = NI * 64 * G_ROWB, STAGE = SW + G_SX;
    u32x4 wreg[NI];
    u32x4 xreg[4];
    const int prow = tid >> 3, pc = tid & 7;
    const bf16_t* wp = Wt + (size_t)prow * 1024 + pc * 8;
    const bf16_t* xp = X + (size_t)prow * 1024 + pc * 8;
#define G_LOAD(kt_)                                                                                                  \
    {                                                                                                                \
        _Pragma("unroll") for (int i = 0; i < NI; ++i) wreg[i] = *(const u32x4*)(wp + (size_t)i * 64 * 1024 + (kt_) * 64); \
        _Pragma("unroll") for (int i = 0; i < 4; ++i) xreg[i] = *(const u32x4*)(xp + (size_t)i * 64 * 1024 + (kt_) * 64);  \
    }
#define G_STORE(buf_)                                                                                                \
    {                                                                                                                \
        unsigned char* sW_ = lds + (buf_) * STAGE + prow * G_ROWB + pc * 16; unsigned char* sX_ = sW_ + SW;          \
        _Pragma("unroll") for (int i = 0; i < NI; ++i) *(u32x4*)(sW_ + i * 64 * G_ROWB) = wreg[i];                   \
        _Pragma("unroll") for (int i = 0; i < 4; ++i) *(u32x4*)(sX_ + i * 64 * G_ROWB) = xreg[i];                    \
    }
    G_LOAD(0);
    G_STORE(0);
    __syncthreads();
    for (int kt = 0; kt < 16; ++kt) {
        if (kt + 1 < 16) G_LOAD(kt + 1);
        if (HS) {
            if (kt == 4 || kt == 8 || kt == 12) {
                const float s0 = kt == 4 ? hs[0][0] : (kt == 8 ? hs[0][1] : hs[0][2]);
                const float s1 = kt == 4 ? hs[1][0] : (kt == 8 ? hs[1][1] : hs[1][2]);
#pragma unroll
                for (int n = 0; n < NI; ++n)
#pragma unroll
                    for (int i = 0; i < 16; ++i) { acc[n][0][i] *= s0; acc[n][1][i] *= s1; }
            }
        }
        {
            const unsigned char* sW = lds + (kt & 1) * STAGE + (wn * NI * 32 + l31) * G_ROWB + h * 16;
            const unsigned char* sX = lds + (kt & 1) * STAGE + SW + (wm * 64 + l31) * G_ROWB + h * 16;
#pragma unroll
            for (int ks = 0; ks < 4; ++ks) {
                const bf16x8 x0 = *(const bf16x8*)(sX + ks * 32), x1 = *(const bf16x8*)(sX + 32 * G_ROWB + ks * 32);
#pragma unroll
                for (int n = 0; n < NI; ++n) {
                    const bf16x8 w = *(const bf16x8*)(sW + n * 32 * G_ROWB + ks * 32);
                    acc[n][0] = MFMA32(w, x0, acc[n][0]); acc[n][1] = MFMA32(w, x1, acc[n][1]);
                }
            }
        }
        if (kt + 1 < 16) G_STORE((kt + 1) & 1);
        __syncthreads();
    }
#undef G_LOAD
#undef G_STORE
}

template <int NI>
DI void zero_acc(f32x16 (&acc)[NI][2]) {
#pragma unroll
    for (int a = 0; a < NI; ++a)
#pragma unroll
        for (int b = 0; b < 2; ++b)
#pragma unroll
            for (int i = 0; i < 16; ++i) acc[a][b][i] = 0.f;
}

namespace pg8 {
#define PG8_LAS __attribute__((address_space(3)))
typedef unsigned short bf16_t;
typedef short bf16x8 __attribute__((ext_vector_type(8)));
typedef float f32x4 __attribute__((ext_vector_type(4)));
typedef unsigned u32x4 __attribute__((ext_vector_type(4)));
constexpr int BM = 256, BK = 64, HALF = 128, HTB = HALF * BK * 2  , STAGE_BYTES = 8 * HTB, NXCD = 8, WGM = 8;

__host__ __device__ __forceinline__ int lds_byte(int r, int c) { const int st = (r >> 4) * 2 + (c >> 5), rr = r & 15, cc = c & 31, ob = rr * 64 + cc * 2; return st * 1024 + (ob ^ (((ob >> 9) & 1) << 5)); }
__host__ __device__ __forceinline__ void stage_rc(int b, int& R, int& C) { const int st = b / 1024, sb = b % 1024, swz = sb ^ (((sb >> 9) & 1) << 5); R = (st >> 1) * 16 + swz / 64; C = (st & 1) * 32 + (swz % 64) / 2; }
__host__ __device__ __forceinline__ int perm32(int rho) { const int n = rho >> 4, i = rho & 15; return 8 * (i >> 2) + 4 * n + (i & 3); }

struct Unit { int pm, pn; };
struct Gemm { const bf16_t* A; const bf16_t* Bt; int M, N, K; };

template <class Epi, class Sched, bool ALIGN_EPI = false, bool SP2 = false>
__device__ __forceinline__ void gemm_phase(PG8_LAS unsigned char* lds, const Gemm g, const Sched& S, const Epi& E) {
    const int tid = opaque_tid(), wid = __builtin_amdgcn_readfirstlane(tid >> 6), lane = tid & 63, wr = wid >> 2, wc = wid & 3, fr = lane & 15, fq = lane >> 4;
    const int K = g.K, nt = K / BK;
    unsigned voffA[2], voffB[2];
#pragma unroll
    for (int i = 0; i < 2; ++i) { int R, C; stage_rc(tid * 16 + i * 8192, R, C); const int Rb = Epi::PERM ? ((R & ~31) + perm32(R & 31)) : R;
        voffA[i] = (unsigned)(R * K + C) * 2u; voffB[i] = (unsigned)(Rb * K + C) * 2u; }
    const size_t kstep = (size_t)(BK * 2);
    const size_t hstep = (size_t)HALF * K * 2;
    const size_t tstep = 2 * hstep;
    const unsigned ldsw = (unsigned)wid * 1024u;
    const int aoff = lds_byte(wr * 64 + fr, fq * 8), boff = lds_byte(wc * 32 + fr, fq * 8);
#define PG8_SA(b, h) (((b) * 2 + (h)) * HTB)
#define PG8_SB(b, h) ((4 + (b) * 2 + (h)) * HTB)
#define PG8_STAGE(bufoff, gbase, voff) do { _Pragma("unroll") for (int _i = 0; _i < 2; ++_i) \
        __builtin_amdgcn_global_load_lds((const unsigned*)((const char*)(gbase) + (voff)[_i]), (PG8_LAS unsigned*)(lds + (bufoff) + ldsw + _i * 8192), 16, 0, 0); } while (0)
#define PG8_LDA(dst, b, h) do { _Pragma("unroll") for (int m = 0; m < 4; ++m) _Pragma("unroll") for (int k = 0; k < 2; ++k) dst[m][k] = *(const PG8_LAS bf16x8*)(lds + PG8_SA(b, h) + aoff + m * 2048 + k * 1024); } while (0)
#define PG8_LDB(dst, b, h) do { _Pragma("unroll") for (int n = 0; n < 2; ++n) _Pragma("unroll") for (int k = 0; k < 2; ++k) dst[n][k] = *(const PG8_LAS bf16x8*)(lds + PG8_SB(b, h) + boff + n * 2048 + k * 1024); } while (0)
#define PG8_MMA(ai, bj, At, Bt) do { __builtin_amdgcn_s_setprio(1); _Pragma("unroll") for (int m = 0; m < 4; ++m) _Pragma("unroll") for (int n = 0; n < 2; ++n) _Pragma("unroll") for (int k = 0; k < 2; ++k) \
        acc[ai][bj][m][n] = __builtin_amdgcn_mfma_f32_16x16x32_bf16(Bt[n][k], At[m][k], acc[ai][bj][m][n], 0, 0, 0); __builtin_amdgcn_s_setprio(0); } while (0)
#define PG8_WAIT_V(n) asm volatile("s_waitcnt vmcnt(" #n ")" ::: "memory")
#define PG8_WAIT_L(n) asm volatile("s_waitcnt lgkmcnt(" #n ")" ::: "memory")
#define PG8_BAR __builtin_amdgcn_s_barrier()
#define PG8_SCHED __builtin_amdgcn_sched_barrier(0)
    Unit cur, nxt; int ui = 0;
    if (!S.next(0, cur)) return;
    f32x4 acc[2][2][4][2];
#pragma unroll
    for (int a = 0; a < 2; ++a)
#pragma unroll
        for (int b = 0; b < 2; ++b)
#pragma unroll
            for (int m = 0; m < 4; ++m)
#pragma unroll
                for (int n = 0; n < 2; ++n) acc[a][b][m][n] = (f32x4){0.f, 0.f, 0.f, 0.f};
    bf16x8 At[4][2], B0[2][2], B1[2][2];
    const char* cA = (const char*)g.A + (size_t)cur.pm * tstep; const char* cB = (const char*)g.Bt + (size_t)cur.pn * tstep;
    S.a_ready(cur);
    if constexpr (SP2) {
        PG8_STAGE(PG8_SB(0, 0), cB, voffB); PG8_STAGE(PG8_SB(0, 1), cB + hstep, voffB); PG8_STAGE(PG8_SA(0, 0), cA, voffA); PG8_STAGE(PG8_SA(0, 1), cA + hstep, voffA);
        if (wr == 1) PG8_BAR;
        PG8_WAIT_V(2); PG8_BAR;
        PG8_STAGE(PG8_SB(1, 0), cB + kstep, voffB); PG8_STAGE(PG8_SA(1, 0), cA + kstep, voffA); PG8_STAGE(PG8_SB(1, 1), cB + hstep + kstep, voffB);
        PG8_WAIT_V(6); PG8_BAR;
    } else {
        PG8_STAGE(PG8_SB(0, 0), cB, voffB); PG8_STAGE(PG8_SA(0, 0), cA, voffA); PG8_STAGE(PG8_SB(0, 1), cB + hstep, voffB); PG8_STAGE(PG8_SA(0, 1), cA + hstep, voffA);
        if (wr == 1) PG8_BAR;
        PG8_WAIT_V(4); PG8_BAR;
        PG8_STAGE(PG8_SB(1, 0), cB + kstep, voffB); PG8_STAGE(PG8_SA(1, 0), cA + kstep, voffA); PG8_STAGE(PG8_SB(1, 1), cB + hstep + kstep, voffB);
        PG8_WAIT_V(6); PG8_BAR;
    }
    for (;;) {
        const bool has_next = S.next(ui + 1, nxt);
        const char* nA = has_next ? (const char*)g.A + (size_t)nxt.pm * tstep : cA; const char* nB = has_next ? (const char*)g.Bt + (size_t)nxt.pn * tstep : cB;
        for (int t = 0; t < nt; t += 2) {
            const bool last = (t == nt - 2);
            const char* a1 = cA + (size_t)(t + 1) * kstep;
            const char* a2 = last ? nA : cA + (size_t)(t + 2) * kstep; const char* b2 = last ? nB : cB + (size_t)(t + 2) * kstep;
            const char* a3 = a2 + kstep; const char* b3 = b2 + kstep;
            if (last && has_next) S.a_ready(nxt);
            if constexpr (SP2) {
            PG8_LDB(B0, 0, 0); PG8_LDB(B1, 0, 1); PG8_SCHED; PG8_LDA(At, 0, 0); PG8_STAGE(PG8_SA(1, 1), a1 + hstep, voffA);
            PG8_WAIT_V(8); PG8_WAIT_L(0); PG8_BAR; PG8_MMA(0, 0, At, B0); PG8_MMA(0, 1, At, B1); PG8_BAR; PG8_SCHED;
            PG8_LDA(At, 0, 1); PG8_STAGE(PG8_SB(0, 0), b2, voffB); PG8_STAGE(PG8_SB(0, 1), b2 + hstep, voffB); PG8_STAGE(PG8_SA(0, 0), a2, voffA);
            PG8_WAIT_V(8); PG8_WAIT_L(0); PG8_BAR; PG8_MMA(1, 0, At, B0); PG8_MMA(1, 1, At, B1); PG8_BAR; PG8_SCHED;
            PG8_LDB(B0, 1, 0); PG8_LDB(B1, 1, 1); PG8_SCHED; PG8_LDA(At, 1, 0); PG8_STAGE(PG8_SA(0, 1), a2 + hstep, voffA);
            PG8_WAIT_V(8); PG8_WAIT_L(0); PG8_BAR; PG8_MMA(0, 0, At, B0); PG8_MMA(0, 1, At, B1); PG8_BAR; PG8_SCHED;
            PG8_LDA(At, 1, 1); PG8_STAGE(PG8_SB(1, 0), b3, voffB); PG8_STAGE(PG8_SB(1, 1), b3 + hstep, voffB); PG8_STAGE(PG8_SA(1, 0), a3, voffA);
            PG8_WAIT_V(8); PG8_WAIT_L(0); PG8_BAR; PG8_MMA(1, 0, At, B0); PG8_MMA(1, 1, At, B1); PG8_BAR; PG8_SCHED;
            } else {
            PG8_LDB(B0, 0, 0); PG8_SCHED; PG8_LDA(At, 0, 0); PG8_STAGE(PG8_SA(1, 1), a1 + hstep, voffA);
            PG8_WAIT_L(8); PG8_BAR; PG8_WAIT_L(0); PG8_MMA(0, 0, At, B0); PG8_BAR; PG8_SCHED;
            PG8_LDB(B1, 0, 1); PG8_STAGE(PG8_SB(0, 0), b2, voffB);
            PG8_BAR; PG8_WAIT_L(0); PG8_MMA(0, 1, At, B1); PG8_BAR;
            PG8_LDA(At, 0, 1); PG8_STAGE(PG8_SA(0, 0), a2, voffA);
            PG8_BAR; PG8_WAIT_L(0); PG8_MMA(1, 0, At, B0); PG8_BAR; PG8_SCHED;
            PG8_STAGE(PG8_SB(0, 1), b2 + hstep, voffB);
            PG8_WAIT_V(6); PG8_BAR; PG8_MMA(1, 1, At, B1); PG8_BAR;
            PG8_LDB(B0, 1, 0); PG8_SCHED; PG8_LDA(At, 1, 0); PG8_STAGE(PG8_SA(0, 1), a2 + hstep, voffA);
            PG8_WAIT_L(8); PG8_BAR; PG8_WAIT_L(0); PG8_MMA(0, 0, At, B0); PG8_BAR; PG8_SCHED;
            PG8_LDB(B1, 1, 1); PG8_STAGE(PG8_SB(1, 0), b3, voffB);
            PG8_BAR; PG8_WAIT_L(0); PG8_MMA(0, 1, At, B1); PG8_BAR;
            PG8_LDA(At, 1, 1); PG8_STAGE(PG8_SA(1, 0), a3, voffA);
            PG8_BAR; PG8_WAIT_L(0); PG8_MMA(1, 0, At, B0); PG8_BAR; PG8_SCHED;
            PG8_STAGE(PG8_SB(1, 1), b3 + hstep, voffB);
            PG8_WAIT_V(6); PG8_BAR; PG8_MMA(1, 1, At, B1); PG8_BAR;
            }
        }
        if constexpr (ALIGN_EPI) { if (wr == 0) PG8_BAR; }
        if constexpr (!Epi::AFTER_DRAIN) { E(acc, cur, wr, wc, fr, fq); S.done(cur); }
        if (!has_next) break;
#pragma unroll
        for (int a = 0; a < 2; ++a)
#pragma unroll
            for (int b = 0; b < 2; ++b)
#pragma unroll
                for (int m = 0; m < 4; ++m)
#pragma unroll
                    for (int n = 0; n < 2; ++n) acc[a][b][m][n] = (f32x4){0.f, 0.f, 0.f, 0.f};
        cur = nxt; cA = nA; cB = nB; ++ui;
        if constexpr (ALIGN_EPI) { if (wr == 1) PG8_BAR; }
    }
    PG8_WAIT_V(0);
    if constexpr (!ALIGN_EPI) { if (wr == 0) PG8_BAR; }
    PG8_BAR;
    if constexpr (Epi::AFTER_DRAIN) { E.fused(acc, cur, wr, wc, fr, fq, lds, wid, lane); S.done(cur); }
#undef PG8_SA
#undef PG8_SB
#undef PG8_STAGE
#undef PG8_LDA
#undef PG8_LDB
#undef PG8_MMA
#undef PG8_WAIT_V
#undef PG8_WAIT_L
#undef PG8_BAR
#undef PG8_SCHED
}
}

DI unsigned sig_u8(float z) { return (unsigned)(255.0f / (1.0f + __expf(-z)) + 0.5f); }
struct SchedP1 {
    DI bool next(int i, pg8::Unit& u) const {
        constexpr int NT = 36;
        const int id = (int)blockIdx.x + i * (int)gridDim.x;
        if (id >= 64 * NT) return false;
        const int g = id / (16 * NT), rem = id % (16 * NT), reg = rem >> 8, w = rem & 255, x = w & 7, j = w >> 3;
        int mt = g * 16 + 4 * (x & 3) + (j & 3), nt = reg * 16 + 8 * (x >> 2) + (j >> 2);
        if (reg == 2) { const int e = rem - 512; nt = 32 + (e >> 4); mt = g * 16 + (e & 15); }
        u.pm = mt; u.pn = nt; return true;
    }
    DI void a_ready(const pg8::Unit&) const {}
    DI void done(const pg8::Unit&) const {}
};
struct SchedSq {
    DI bool next(int i, pg8::Unit& u) const {
        const int id = (int)blockIdx.x + i * (int)gridDim.x;
        if (id >= 256) return false;
        u.pm = 8 * (id & 7) + ((id >> 3) & 7); u.pn = id >> 6; return true;
    }
    DI void a_ready(const pg8::Unit&) const {}
    DI void done(const pg8::Unit&) const {}
};
struct EpiInProj {
    static constexpr bool PERM = false, AFTER_DRAIN = false;
    unsigned char* ws; unsigned char* dout;
    DI void operator()(const pg8::f32x4 (&acc)[2][2][4][2], const pg8::Unit& u, int wr, int wc, int fr, int fq) const {
        const int nt = u.pn;
        int split, nc0;
        if (nt < 4) { split = 0; nc0 = nt * 256; }
        else if (nt < 8) { split = 1; nc0 = (nt - 4) * 256; }
        else if (nt < 12) { split = 2; nc0 = (nt - 8) * 256; }
        else if (nt < 16) { split = 3; nc0 = (nt - 12) * 256; }
        else if (nt < 18) { split = 4; nc0 = (nt - 16) * 256; }
        else if (nt < 20) { split = 5; nc0 = (nt - 18) * 256; }
        else if (nt < 24) { split = 6; nc0 = (nt - 20) * 256; }
        else if (nt < 28) { split = 7; nc0 = (nt - 24) * 256; }
        else if (nt < 32) { split = 9; nc0 = (nt - 28) * 256; }
        else { split = 10; nc0 = (nt - 32) * 256; }
        const float* rstd = (const float*)(ws + OFF_RSTD);
        const float* rope = (const float*)(ws + OFF_ROPE);
        const bool do_rope = split <= 1 && (wc & 1) == 0;
#pragma unroll
        for (int ai = 0; ai < 2; ++ai)
#pragma unroll
            for (int m = 0; m < 4; ++m) {
                const int tok = u.pm * 256 + ai * 128 + wr * 64 + m * 16 + fr;
                const float rs = rstd[tok];
                const int pos = 16 + (tok & 4095), b = tok >> 12, s = tok & 4095;
#pragma unroll
                for (int bj = 0; bj < 2; ++bj)
#pragma unroll
                    for (int n = 0; n < 2; ++n) {
                        const int nb = nc0 + bj * 128 + wc * 32 + n * 16 + 4 * fq;
                        float v[4];
#pragma unroll
                        for (int j = 0; j < 4; ++j) v[j] = acc[ai][bj][m][n][j] * rs;
                        if (n == 0 && do_rope) {
                            const float* cs = rope + ((size_t)pos * 8 + 4 * (fq & 1)) * 2;
#pragma unroll
                            for (int j = 0; j < 4; ++j) {
                                const float other = __shfl_xor(v[j], 32);
                                const float c = cs[2 * j], sn = cs[2 * j + 1];
                                v[j] = fq < 2 ? (v[j] * c - other * sn) : (v[j] * c + other * sn);
                            }
                        }
                        if (split == 2 || split == 6) {
                            const int hshift = split == 2 ? 7 : 8, nheads = split == 2 ? 8 : 4, dvn = 1 << hshift;
                            bf16_t* base = (bf16_t*)(ws + (split == 2 ? OFF_AVT : OFF_GVT));
#pragma unroll
                            for (int j = 0; j < 4; ++j) {
                                const int nn = nb + j, hd = nn >> hshift, dv = nn & (dvn - 1);
                                base[((size_t)(b * nheads + hd) * dvn + dv) * 4096 + s] = f2bf(v[j]);
                            }
                        } else if (split >= 9) {
                            const unsigned o = sig_u8(v[0]) | (sig_u8(v[1]) << 8) | (sig_u8(v[2]) << 16) | (sig_u8(v[3]) << 24);
                            *(unsigned*)(ws + (split == 9 ? OFF_SGA : OFF_SGB) + (size_t)tok * 1024 + nb) = o;
                        } else {
                            bf16_t* dst; int ld;
                            switch (split) {
                                case 0: dst = (bf16_t*)(dout + DO_AQ); ld = 1024; break;
                                case 1: dst = (bf16_t*)(ws + OFF_AK); ld = 1024; break;
                                case 3: dst = (bf16_t*)(ws + OFF_AZ); ld = 1024; break;
                                case 4: dst = (bf16_t*)(dout + DO_GQ); ld = 512; break;
                                case 5: dst = (bf16_t*)(dout + DO_GK); ld = 512; break;
                                default: dst = (bf16_t*)(ws + OFF_GZ); ld = 1024; break;
                            }
                            u32x2 o; o.x = pk2(v[0], v[1]); o.y = pk2(v[2], v[3]);
                            *(u32x2*)(dst + (size_t)tok * ld + nb) = o;
                        }
                    }
            }
    }
};

DI void p1_glr_job(const Params& p, unsigned char* lds, int job) {
    const int tid = opaque_tid(), lane = tid & 63, wave = tid >> 6, l15 = lane & 15, g = lane >> 4;
    const int rtile = wave & 3, khalf = wave >> 2;
    const bf16_t* xb = (const bf16_t*)(p.ws + OFF_XB);
    const bf16_t* wt = (const bf16_t*)(p.ws + OFF_WIN_T) + (size_t)9216 * 1024;
    const size_t row0 = (size_t)job * 64 + rtile * 16;
    const bf16_t* ap = xb + (row0 + l15) * 1024 + khalf * 512 + 8 * g;
    const bf16_t* bp = wt + (size_t)l15 * 1024 + khalf * 512 + 8 * g;
    f32x4 acc = (f32x4){0.f, 0.f, 0.f, 0.f};
#pragma unroll 4
    for (int ks = 0; ks < 16; ++ks) {
        const bf16x8 a = *(const bf16x8*)(ap + ks * 32), bb = *(const bf16x8*)(bp + ks * 32);
        acc = MFMA16(a, bb, acc);
    }
    f32x4* red = (f32x4*)lds;
    __syncthreads();
    if (khalf == 1) red[rtile * 64 + lane] = acc;
    __syncthreads();
    if (khalf == 0) {
        const f32x4 o = red[rtile * 64 + lane];
        const float* rstd = (const float*)(p.ws + OFF_RSTD);
        bf16_t* glr = (bf16_t*)(p.ws + OFF_GLR);
#pragma unroll
        for (int i = 0; i < 4; ++i) {
            const size_t row = row0 + 4 * g + i;
            glr[row * 16 + l15] = f2bf((acc[i] + o[i]) * rstd[row]);
        }
    }
    __syncthreads();
}

DI void p1_meta_job(const Params& p, unsigned char* lds, int job) {
    const int tid = opaque_tid(), lane = tid & 63, wave = tid >> 6, l15 = lane & 15, g = lane >> 4;
    int c0;
    if (job < 64) c0 = 1024 + job * 16;
    else if (job < 128) c0 = 2048 + (job - 64) * 16;
    else if (job < 160) c0 = 4608 + (job - 128) * 16;
    else if (job < 224) c0 = 5120 + (job - 160) * 16;
    else c0 = 9216;
    const bf16_t* xbm = (const bf16_t*)(p.ws + OFF_XBM);
    const bf16_t* wt = (const bf16_t*)(p.ws + OFF_WIN_T);
    const bf16_t* ap = xbm + (size_t)l15 * 1024 + wave * 128 + 8 * g;
    const bf16_t* bp = wt + (size_t)(c0 + l15) * 1024 + wave * 128 + 8 * g;
    f32x4 acc = (f32x4){0.f, 0.f, 0.f, 0.f};
#pragma unroll
    for (int ks = 0; ks < 4; ++ks) {
        const bf16x8 a = *(const bf16x8*)(ap + ks * 32), bb = *(const bf16x8*)(bp + ks * 32);
        acc = MFMA16(a, bb, acc);
    }
    f32x4* red = (f32x4*)lds;
    __syncthreads();
    red[wave * 64 + lane] = acc;
    __syncthreads();
    if (wave == 0) {
        f32x4 s = red[lane];
#pragma unroll
        for (int w = 1; w < 8; ++w) { const f32x4 t = red[w * 64 + lane]; s.x += t.x; s.y += t.y; s.z += t.z; s.w += t.w; }
        const float* rstd = (const float*)(p.ws + OFF_RSTD) + MROWS;
        const float* rope = (const float*)(p.ws + OFF_ROPE);
        unsigned char* ws = p.ws;
        const int col = c0 + l15;
#pragma unroll
        for (int i = 0; i < 4; ++i) {
            const int row = 4 * g + i;
            float v = s[i] * rstd[row];
            if (job < 64 && (c0 & 63) == 0) {
                const float other = __shfl_xor(v, 8);
                const float* cs = rope + ((size_t)row * 8 + (l15 & 7)) * 2;
                const float c = cs[0], sn = cs[1];
                v = (l15 < 8) ? (v * c - other * sn) : (v * c + other * sn);
            }
            const bf16_t val = f2bf(v);
            if (job < 64) ((bf16_t*)(ws + OFF_AKM))[(size_t)(48 + row) * 1024 + (col - 1024)] = val;
            else if (job < 128) { const int n = col - 2048; ((bf16_t*)(ws + OFF_AVTM))[(size_t)n * 64 + 48 + row] = val; }
            else if (job < 160) ((bf16_t*)(ws + OFF_GKM))[(size_t)row * 512 + (col - 4608)] = val;
            else if (job < 224) { const int n = col - 5120; ((bf16_t*)(ws + OFF_GVTM))[(size_t)n * 64 + 48 + row] = val; }
            else ((bf16_t*)(ws + OFF_GLRM))[row * 16 + l15] = val;
        }
    }
    __syncthreads();
}

DI void phase1(const Params& p, unsigned char* lds) {
    for (int j = blockIdx.x; j < 256; j += gridDim.x) p1_glr_job(p, lds, j);
    for (int j = blockIdx.x; j < 225; j += gridDim.x) p1_meta_job(p, lds, j);
    pg8::Gemm g; g.A = (const bf16_t*)(p.ws + OFF_XB); g.Bt = (const bf16_t*)(p.ws + OFF_WIN_T); g.M = MROWS; g.N = 9216; g.K = 1024;
    SchedP1 S; EpiInProj E; E.ws = p.ws; E.dout = (unsigned char*)p.out;
    pg8::gemm_phase<EpiInProj, SchedP1, true, true>((PG8_LAS unsigned char*)lds, g, S, E);
}

DI void phase15(const Params& p, unsigned char* lds) {
    const int tid = opaque_tid(), col = tid;
    float w2[16];
#pragma unroll
    for (int j = 0; j < 16; ++j) w2[j] = p.gate_w2[j * 512 + col];
    const float bias = p.gate_b[col];
    unsigned char* ws = p.ws;
    unsigned char* dout = (unsigned char*)p.out;
    for (int item = blockIdx.x; item < 257; item += gridDim.x) {
        const bool meta = item == 256;
        const int b = item >> 6, c = item & 63;
        const size_t row0 = (size_t)b * 4096 + c * 64;
        const bf16_t* glr = meta ? (const bf16_t*)(ws + OFF_GLRM) : (const bf16_t*)(ws + OFF_GLR) + row0 * 16;
        const int nrows = meta ? 16 : 64;
        bf16_t* qp = (bf16_t*)(dout + DO_GQ) + row0 * 512 + col;
        const bf16_t* kin = meta ? (const bf16_t*)(ws + OFF_GKM) + col : (const bf16_t*)(dout + DO_GK) + row0 * 512 + col;
        bf16_t* kout = meta ? (bf16_t*)(ws + OFF_KTM) + 48 * 512 + col : (bf16_t*)(dout + DO_GK) + row0 * 512 + col;
        bf16_t* ktt = meta ? (bf16_t*)(ws + OFF_KTTM) + (size_t)col * 64 + 48 : (bf16_t*)(ws + OFF_WIN_T) + ((size_t)b * 512 + col) * 4096 + c * 64;
        __syncthreads();
        if (tid < nrows * 2) ((u32x4*)lds)[tid] = ((const u32x4*)glr)[tid];
        __syncthreads();
        float bsum = 0.f;
        bf16_t kc[8], qc[8], kn[8], qn[8];
#pragma unroll
        for (int rr = 0; rr < 8; ++rr) { kc[rr] = kin[(size_t)rr * 512]; qc[rr] = meta ? (bf16_t)0 : qp[(size_t)rr * 512]; }
        for (int r0 = 0; r0 < nrows; r0 += 8) {
            if (r0 + 8 < nrows) {
#pragma unroll
                for (int rr = 0; rr < 8; ++rr) { kn[rr] = kin[(size_t)(r0 + 8 + rr) * 512]; qn[rr] = meta ? (bf16_t)0 : qp[(size_t)(r0 + 8 + rr) * 512]; }
            }
            float kt8[8];
#pragma unroll
            for (int rr = 0; rr < 8; ++rr) {
                const int r = r0 + rr;
                const u32x4* g4 = (const u32x4*)(lds + r * 32);
                const u32x4 ga = g4[0], gb = g4[1];
                float gk = bias;
                gk += bflo(ga.x) * w2[0] + bfhi(ga.x) * w2[1] + bflo(ga.y) * w2[2] + bfhi(ga.y) * w2[3];
                gk += bflo(ga.z) * w2[4] + bfhi(ga.z) * w2[5] + bflo(ga.w) * w2[6] + bfhi(ga.w) * w2[7];
                gk += bflo(gb.x) * w2[8] + bfhi(gb.x) * w2[9] + bflo(gb.y) * w2[10] + bfhi(gb.y) * w2[11];
                gk += bflo(gb.z) * w2[12] + bfhi(gb.z) * w2[13] + bflo(gb.w) * w2[14] + bfhi(gb.w) * w2[15];
                const float lg = (fminf(gk, 0.f) - __logf(1.0f + __expf(-fabsf(gk)))) * (1.0f / 16.0f);
                bsum += lg;
                const float eb = __expf(bsum);
                const float kt = bf2f(kc[rr]) * __builtin_amdgcn_rcpf(eb);
                kt8[rr] = kt;
                kout[(size_t)r * 512] = f2bf(kt);
                if (!meta) qp[(size_t)r * 512] = f2bf(bf2f(qc[rr]) * 0.08838834764831845f * eb);
            }
            u32x4 o; o.x = pk2(kt8[0], kt8[1]); o.y = pk2(kt8[2], kt8[3]); o.z = pk2(kt8[4], kt8[5]); o.w = pk2(kt8[6], kt8[7]);
            *(u32x4*)(ktt + r0) = o;
#pragma unroll
            for (int rr = 0; rr < 8; ++rr) { kc[rr] = kn[rr]; qc[rr] = qn[rr]; }
        }
        if (meta) {
            ((float*)(ws + OFF_DECM))[col] = expf(bsum);
            bf16_t* km = (bf16_t*)(ws + OFF_KTM);
            for (int r = 0; r < 48; ++r) km[r * 512 + col] = 0;
            u32x4 z = {0u, 0u, 0u, 0u};
            u32x4* kz = (u32x4*)((bf16_t*)(ws + OFF_KTTM) + (size_t)col * 64);
#pragma unroll
            for (int j = 0; j < 6; ++j) kz[j] = z;
        } else {
            ((float*)(ws + OFF_DEC))[((size_t)b * 64 + c) * 512 + col] = expf(bsum);
        }
    }
}

constexpr int A_KROWB = 272, A_VROWB = 144, A_KB = 64 * A_KROWB, A_VB = 128 * A_VROWB, A_STAGE = A_KB + A_VB;
DI void attn_tile(const unsigned char* sK, const unsigned char* sV, int tt, int qb, int qs, int sub, int l31, int h,
                  const bf16x8 (&qf)[4], f32x16 (&O)[4], float& m, float& l) {
    const float SC = 0.125f * 1.4426950408889634f;
    f32x16 st[2];
#pragma unroll
    for (int k2 = 0; k2 < 2; ++k2)
#pragma unroll
        for (int i = 0; i < 16; ++i) st[k2][i] = 0.f;
#pragma unroll
    for (int k2 = 0; k2 < 2; ++k2)
#pragma unroll
        for (int ks = 0; ks < 4; ++ks) {
            const bf16x8 kf = *(const bf16x8*)(sK + (k2 * 32 + l31) * A_KROWB + (sub * 64 + ks * 16 + 8 * h) * 2);
            st[k2] = MFMA32(kf, qf[ks], st[k2]);
        }
    if (tt == 0) {
#pragma unroll
        for (int i = 0; i < 16; ++i) { st[0][i] = -INFINITY; if (i < 8) st[1][i] = -INFINITY; }
    } else if (tt >= 2 * qb + 1) {
        const int kbase = (tt - 1) * 64 + 4 * h;
#pragma unroll
        for (int k2 = 0; k2 < 2; ++k2)
#pragma unroll
            for (int i = 0; i < 16; ++i) {
                const int key = kbase + k2 * 32 + (i & 3) + 8 * (i >> 2);
                if (key > qs) st[k2][i] = -INFINITY;
            }
    }
    float mx = -INFINITY;
#pragma unroll
    for (int k2 = 0; k2 < 2; ++k2)
#pragma unroll
        for (int i = 0; i < 16; ++i) mx = fmaxf(mx, st[k2][i]);
    mx = fmaxf(mx, __shfl_xor(mx, 32));
    const float mnew = fmaxf(m, mx);
    const float alpha = __builtin_amdgcn_exp2f((m - mnew) * SC);
    const float mc = mnew * SC;
    m = mnew;
    float ps = 0.f;
#pragma unroll
    for (int k2 = 0; k2 < 2; ++k2)
#pragma unroll
        for (int i = 0; i < 16; ++i) { const float pv = __builtin_amdgcn_exp2f(st[k2][i] * SC - mc); st[k2][i] = pv; ps += pv; }
    l = l * alpha + ps;
#pragma unroll
    for (int d = 0; d < 4; ++d)
#pragma unroll
        for (int i = 0; i < 16; ++i) O[d][i] *= alpha;
    bf16x8 pb[4];
#pragma unroll
    for (int k4 = 0; k4 < 4; ++k4) {
        const int k2 = k4 >> 1, o8 = 8 * (k4 & 1);
        u32x4 pk;
        pk.x = pk2(st[k2][o8 + 0], st[k2][o8 + 1]); pk.y = pk2(st[k2][o8 + 2], st[k2][o8 + 3]);
        pk.z = pk2(st[k2][o8 + 4], st[k2][o8 + 5]); pk.w = pk2(st[k2][o8 + 6], st[k2][o8 + 7]);
        pb[k4] = __builtin_bit_cast(bf16x8, pk);
    }
#pragma unroll
    for (int d = 0; d < 4; ++d)
#pragma unroll
        for (int k4 = 0; k4 < 4; ++k4) {
            const bf16x8 vv = *(const bf16x8*)(sV + (d * 32 + l31) * A_VROWB + k4 * 32 + 16 * h);
            O[d] = MFMA32(vv, pb[k4], O[d]);
        }
}

DI void attn_item(const Params& p, unsigned char* lds, int b, int hd, int qb) {
    const int tid = opaque_tid(), lane = tid & 63, wave = tid >> 6, l31 = lane & 31, h = lane >> 5;
    const int sub = wave >> 2, rt = wave & 3;
    const bf16_t* aq = (const bf16_t*)((unsigned char*)p.out + DO_AQ);
    const bf16_t* ak = (const bf16_t*)(p.ws + OFF_AK);
    const bf16_t* avT = (const bf16_t*)(p.ws + OFF_AVT);
    const bf16_t* akm = (const bf16_t*)(p.ws + OFF_AKM);
    const bf16_t* avTm = (const bf16_t*)(p.ws + OFF_AVTM);
    bf16_t* az = (bf16_t*)(p.ws + OFF_AZ);
    const int qs = qb * 128 + rt * 32 + l31;
    const size_t grow = (size_t)b * 4096 + qs;
    bf16x8 qf[4];
#pragma unroll
    for (int ks = 0; ks < 4; ++ks) qf[ks] = *(const bf16x8*)(aq + grow * 1024 + hd * 128 + sub * 64 + ks * 16 + 8 * h);
    f32x16 O[4];
#pragma unroll
    for (int d = 0; d < 4; ++d)
#pragma unroll
        for (int i = 0; i < 16; ++i) O[d][i] = 0.f;
    float m = -INFINITY, l = 0.f;
    const int T = 2 * qb + 3;
    u32x4 k0r[2], v0r[2];
    const int krow_ = tid >> 4, kc_ = tid & 15, vdv_ = tid >> 3, vc_ = tid & 7;
    const bf16_t* kp = ak + ((size_t)b * 4096 + krow_) * 1024 + hd * 128 + kc_ * 8;
    const bf16_t* vp_ = avT + ((size_t)(b * 8 + hd) * 128 + vdv_) * 4096 + vc_ * 8;
#define A_LOAD_REAL(KR, VR)                                                                                                   \
    {                                                                                                                         \
        KR[0] = *(const u32x4*)kp; KR[1] = *(const u32x4*)(kp + 32 * 1024); kp += 64 * 1024;                                  \
        VR[0] = *(const u32x4*)vp_; VR[1] = *(const u32x4*)(vp_ + (size_t)64 * 4096); vp_ += 64;                              \
    }
#define A_STORE(KR, VR, buf_)                                                                                                 \
    {                                                                                                                         \
        unsigned char* sK_ = lds + (buf_) * A_STAGE; unsigned char* sV_ = sK_ + A_KB;                                         \
        _Pragma("unroll") for (int i = 0; i < 2; ++i) { const int pi = tid + 512 * i, row = pi >> 4, c = pi & 15;              \
            *(u32x4*)(sK_ + row * A_KROWB + c * 16) = KR[i]; }                                                                \
        _Pragma("unroll") for (int i = 0; i < 2; ++i) { const int pi = tid + 512 * i, dv = pi >> 3, c = pi & 7;                \
            unsigned char* d_ = sV_ + dv * A_VROWB + (c >> 1) * 32 + 8 * (c & 1); u32x2 a_, b_; a_.x = VR[i].x; a_.y = VR[i].y; b_.x = VR[i].z; b_.y = VR[i].w; \
            *(u32x2*)d_ = a_; *(u32x2*)(d_ + 16) = b_; }                                                                      \
    }
    {
        const bf16_t* km_ = akm + (size_t)krow_ * 1024 + hd * 128 + kc_ * 8;
        k0r[0] = *(const u32x4*)km_; k0r[1] = *(const u32x4*)(km_ + 32 * 1024);
        const bf16_t* vm_ = avTm + (size_t)(hd * 128 + vdv_) * 64 + vc_ * 8;
        v0r[0] = *(const u32x4*)vm_; v0r[1] = *(const u32x4*)(vm_ + 64 * 64);
    }
    A_STORE(k0r, v0r, 0);
    __syncthreads();
    for (int tt = 0; tt < T; ++tt) {
        if (tt + 1 < T) A_LOAD_REAL(k0r, v0r);
        attn_tile(lds + (tt & 1) * A_STAGE, lds + (tt & 1) * A_STAGE + A_KB, tt, qb, qs, sub, l31, h, qf, O, m, l);
        if (tt + 1 < T) A_STORE(k0r, v0r, (tt + 1) & 1);
        __syncthreads();
    }
#undef A_LOAD_REAL
#undef A_STORE
    float lam;
    {
        const float a_ = wave_sum(p.lq1[lane] * p.lk1[lane]);
        const float b_ = wave_sum(p.lq2[lane] * p.lk2[lane]);
        lam = expf(a_) - expf(b_) + 0.2f;
    }
    const float ltot = l + __shfl_xor(l, 32);
    const float linv = 1.0f / ltot;
    float* ex = (float*)lds;
    if (sub == 1) {
#pragma unroll
        for (int d = 0; d < 4; ++d)
#pragma unroll
            for (int i = 0; i < 16; ++i) { ex[(rt * 32 + l31) * 129 + d * 32 + (i & 3) + 8 * (i >> 2) + 4 * h] = O[d][i] * linv; if (i == 15) __builtin_amdgcn_sched_barrier(0); }
    }
    __syncthreads();
    if (sub == 0) {
        float ss = 0.f;
#pragma unroll
        for (int d = 0; d < 4; ++d)
#pragma unroll
            for (int i = 0; i < 16; ++i) {
                const float o2 = ex[(rt * 32 + l31) * 129 + d * 32 + (i & 3) + 8 * (i >> 2) + 4 * h];
                const float o = O[d][i] * linv - lam * o2;
                O[d][i] = o; ss += o * o;
                if (i == 15) __builtin_amdgcn_sched_barrier(0);
            }
        ss += __shfl_xor(ss, 32);
        const float rstd = 1.0f / sqrtf(ss * (1.0f / 128.0f) + EPS);
#pragma unroll
        for (int d = 0; d < 4; ++d)
#pragma unroll
            for (int g = 0; g < 4; ++g) {
                bf16_t* zp = az + grow * 1024 + hd * 128 + d * 32 + 8 * g + 4 * h;
                const u32x2 zz = *(const u32x2*)zp;
                u32x2 o;
                o.x = pk2(O[d][4 * g] * rstd * siluf_(bflo(zz.x)), O[d][4 * g + 1] * rstd * siluf_(bfhi(zz.x)));
                o.y = pk2(O[d][4 * g + 2] * rstd * siluf_(bflo(zz.y)), O[d][4 * g + 3] * rstd * siluf_(bfhi(zz.y)));
                *(u32x2*)zp = o;
                if (g == 3) __builtin_amdgcn_sched_barrier(0);
            }
    }
    __syncthreads();
}

constexpr int L_KROWB = 272, L_VROWB = 144, L_SROWB = 272;
constexpr int GLA_DL = 4;
#define L_BAR() { asm volatile("s_waitcnt lgkmcnt(0)" ::: "memory"); __builtin_amdgcn_s_barrier(); asm volatile("" ::: "memory"); }
template <int DL>
DI void gla_item(const Params& p, unsigned char* lds, int b, int hh, int sl) {
    constexpr int SLW = 32 * DL, NVP = SLW / 64;
    constexpr int L_K = 0, L_V = 64 * L_KROWB, L_S = L_V + SLW * L_VROWB;
    const int tid = opaque_tid(), lane = tid & 63, wave = tid >> 6, l15 = lane & 15, g = lane >> 4;
    const int tt = wave & 3, dvt = wave >> 2;
    unsigned char* ws = p.ws;
    unsigned char* dout = (unsigned char*)p.out;
    const bf16_t* gq = (const bf16_t*)(dout + DO_GQ);
    const bf16_t* gk = (const bf16_t*)(dout + DO_GK);
    const bf16_t* gvT = (const bf16_t*)(ws + OFF_GVT);
    const bf16_t* ktt = (const bf16_t*)(ws + OFF_WIN_T);
    const float* dec = (const float*)(ws + OFF_DEC);
    bf16_t* gz = (bf16_t*)(ws + OFF_GZ);
    float* ssqb = (float*)(ws + OFF_SSQB);
    unsigned char* sK = lds + L_K; unsigned char* sV = lds + L_V; unsigned char* sS = lds + L_S;
    for (int i = tid; i < SLW * L_SROWB / 4; i += 512) ((unsigned*)sS)[i] = 0u;
    f32x4 sacc[DL][2];
#pragma unroll
    for (int dl = 0; dl < DL; ++dl)
#pragma unroll
        for (int c = 0; c < 2; ++c) sacc[dl][c] = (f32x4){0.f, 0.f, 0.f, 0.f};
    u32x4 nk[2]; u32x4 nv[NVP]; bf16x8 nq[4]; bf16x8 nkt[2][2]; float nd[2]; u32x2 ngz[DL];
    const int cc0 = 16 * (2 * tt) + l15;
    const int dv0 = 16 * (dvt * DL);
    const int krow_ = tid >> 4, kc_ = tid & 15, vdv_ = tid >> 3, vc_ = tid & 7;
    const bf16_t* kp = gk + ((size_t)b * 4096 + krow_) * 512 + hh * 128 + kc_ * 8;
    const bf16_t* vp_ = gvT + ((size_t)(b * 4 + hh) * 256 + sl * SLW + vdv_) * 4096 + vc_ * 8;
    const bf16_t* ktp = ktt + ((size_t)(b * 4 + hh) * 128 + cc0) * 4096 + 8 * g;
    const float* dp = dec + (size_t)b * 64 * 512 + hh * 128 + cc0;
    const bf16_t* qp = gq + ((size_t)b * 4096 + 16 * tt + l15) * 512 + hh * 128 + 8 * g;
    bf16_t* gzp = gz + ((size_t)b * 4096 + 16 * tt + l15) * 1024 + hh * 256 + sl * SLW + dv0 + 4 * g;
#define L_LOAD_META()                                                                                                         \
    {                                                                                                                         \
        const bf16_t* km_ = (const bf16_t*)(ws + OFF_KTM) + (size_t)krow_ * 512 + hh * 128 + kc_ * 8;                         \
        nk[0] = *(const u32x4*)km_; nk[1] = *(const u32x4*)(km_ + 32 * 512);                                                  \
        _Pragma("unroll") for (int i = 0; i < NVP; ++i)                                                                       \
            nv[i] = *(const u32x4*)((const bf16_t*)(ws + OFF_GVTM) + (size_t)(hh * 256 + sl * SLW + vdv_ + 64 * i) * 64 + vc_ * 8); \
        _Pragma("unroll") for (int ct = 0; ct < 2; ++ct) _Pragma("unroll") for (int ks = 0; ks < 2; ++ks)                     \
            nkt[ct][ks] = *(const bf16x8*)((const bf16_t*)(ws + OFF_KTTM) + (size_t)(hh * 128 + cc0 + 16 * ct) * 64 + 32 * ks + 8 * g); \
        _Pragma("unroll") for (int ct = 0; ct < 2; ++ct) nd[ct] = ((const float*)(ws + OFF_DECM))[hh * 128 + cc0 + 16 * ct];  \
        _Pragma("unroll") for (int ks = 0; ks < 4; ++ks) nq[ks] = (bf16x8){0, 0, 0, 0, 0, 0, 0, 0};                           \
        _Pragma("unroll") for (int dl = 0; dl < DL; ++dl) ngz[dl] = (u32x2){0u, 0u};                                          \
    }
#define L_LOAD_REAL()                                                                                                         \
    {                                                                                                                         \
        nk[0] = *(const u32x4*)kp; nk[1] = *(const u32x4*)(kp + 32 * 512); kp += 64 * 512;                                    \
        _Pragma("unroll") for (int i = 0; i < NVP; ++i) nv[i] = *(const u32x4*)(vp_ + (size_t)(64 * i) * 4096);               \
        vp_ += 64;                                                                                                            \
        _Pragma("unroll") for (int ct = 0; ct < 2; ++ct) _Pragma("unroll") for (int ks = 0; ks < 2; ++ks)                     \
            nkt[ct][ks] = *(const bf16x8*)(ktp + (size_t)(16 * ct) * 4096 + 32 * ks);                                         \
        ktp += 64;                                                                                                            \
        nd[0] = dp[0]; nd[1] = dp[16]; dp += 512;                                                                             \
        _Pragma("unroll") for (int ks = 0; ks < 4; ++ks) nq[ks] = *(const bf16x8*)(qp + 32 * ks);                             \
        qp += 64 * 512;                                                                                                       \
        _Pragma("unroll") for (int dl = 0; dl < DL; ++dl) ngz[dl] = *(const u32x2*)(gzp + 16 * dl);                           \
        gzp += 64 * 1024;                                                                                                     \
    }
#define L_STORE()                                                                                                             \
    {                                                                                                                         \
        _Pragma("unroll") for (int i = 0; i < 2; ++i) { const int pi = tid + 512 * i, row = pi >> 4, c = pi & 15;              \
            *(u32x4*)(sK + row * L_KROWB + c * 16) = nk[i]; }                                                                 \
        _Pragma("unroll") for (int i = 0; i < NVP; ++i) *(u32x4*)(sV + (vdv_ + 64 * i) * L_VROWB + vc_ * 16) = nv[i];          \
    }
    L_LOAD_META();
    L_STORE();
    for (int n = 0; n <= 64; ++n) {
        bf16x8 cq[4], ckt[2][2]; float cd[2]; u32x2 cgz[DL];
#pragma unroll
        for (int ks = 0; ks < 4; ++ks) cq[ks] = nq[ks];
#pragma unroll
        for (int ct = 0; ct < 2; ++ct) { cd[ct] = nd[ct]; ckt[ct][0] = nkt[ct][0]; ckt[ct][1] = nkt[ct][1]; }
#pragma unroll
        for (int dl = 0; dl < DL; ++dl) cgz[dl] = ngz[dl];
        L_BAR();
        if (n + 1 <= 64) L_LOAD_REAL();
        if (n > 0) {
            f32x4 at[4];
#pragma unroll
            for (int jt = 0; jt < 4; ++jt) at[jt] = (f32x4){0.f, 0.f, 0.f, 0.f};
#pragma unroll
            for (int jt = 0; jt < 4; ++jt)
#pragma unroll
                for (int ks = 0; ks < 4; ++ks) {
                    const bf16x8 kf = *(const bf16x8*)(sK + (jt * 16 + l15) * L_KROWB + (ks * 32 + 8 * g) * 2);
                    at[jt] = MFMA16(kf, cq[ks], at[jt]);
                }
            const int tl = 16 * tt + l15;
#pragma unroll
            for (int jt = 0; jt < 4; ++jt)
#pragma unroll
                for (int i = 0; i < 4; ++i) if (16 * jt + 4 * g + i > tl) at[jt][i] = 0.f;
            bf16x8 pa[2];
#pragma unroll
            for (int s2 = 0; s2 < 2; ++s2) {
                u32x4 t;
                t.x = pk2(at[2 * s2][0], at[2 * s2][1]); t.y = pk2(at[2 * s2][2], at[2 * s2][3]);
                t.z = pk2(at[2 * s2 + 1][0], at[2 * s2 + 1][1]); t.w = pk2(at[2 * s2 + 1][2], at[2 * s2 + 1][3]);
                pa[s2] = __builtin_bit_cast(bf16x8, t);
            }
            const size_t row = (size_t)b * 4096 + (n - 1) * 64 + 16 * tt + l15;
#pragma unroll
            for (int dl = 0; dl < DL; ++dl) {
                const int dvr = dv0 + 16 * dl + l15;
                f32x4 o = (f32x4){0.f, 0.f, 0.f, 0.f};
#pragma unroll
                for (int s2 = 0; s2 < 2; ++s2) {
                    const unsigned char* vp = sV + dvr * L_VROWB + (32 * s2 + 4 * g) * 2;
                    const u32x2 lo = *(const u32x2*)vp, hi = *(const u32x2*)(vp + 32);
                    u32x4 vv; vv.x = lo.x; vv.y = lo.y; vv.z = hi.x; vv.w = hi.y;
                    o = MFMA16(__builtin_bit_cast(bf16x8, vv), pa[s2], o);
                }
#pragma unroll
                for (int ks = 0; ks < 4; ++ks) {
                    const bf16x8 sf = *(const bf16x8*)(sS + dvr * L_SROWB + (ks * 32 + 8 * g) * 2);
                    o = MFMA16(sf, cq[ks], o);
                }
                float ss = (o[0] * o[0] + o[1] * o[1]) + (o[2] * o[2] + o[3] * o[3]);
                ss += __shfl_xor(ss, 16); ss += __shfl_xor(ss, 32);
                u32x2 ov;
                ov.x = pk2(o[0] * siluf_(bflo(cgz[dl].x)), o[1] * siluf_(bfhi(cgz[dl].x)));
                ov.y = pk2(o[2] * siluf_(bflo(cgz[dl].y)), o[3] * siluf_(bfhi(cgz[dl].y)));
                *(u32x2*)(gz + row * 1024 + hh * 256 + sl * SLW + dv0 + 16 * dl + 4 * g) = ov;
                if (g == 0) ssqb[(row * 4 + hh) * 16 + sl * 2 * DL + dvt * DL + dl] = ss;
            }
        }
#pragma unroll
        for (int dl = 0; dl < DL; ++dl) {
#pragma unroll
            for (int ks = 0; ks < 2; ++ks) {
                const bf16x8 vf = *(const bf16x8*)(sV + (dv0 + 16 * dl + l15) * L_VROWB + (32 * ks + 8 * g) * 2);
                sacc[dl][0] = MFMA16(vf, ckt[0][ks], sacc[dl][0]);
                sacc[dl][1] = MFMA16(vf, ckt[1][ks], sacc[dl][1]);
            }
#pragma unroll
            for (int ct = 0; ct < 2; ++ct)
#pragma unroll
                for (int i = 0; i < 4; ++i) sacc[dl][ct][i] *= cd[ct];
        }
        L_BAR();
#pragma unroll
        for (int dl = 0; dl < DL; ++dl)
#pragma unroll
            for (int ct = 0; ct < 2; ++ct)
#pragma unroll
                for (int i = 0; i < 4; ++i)
                    *(bf16_t*)(sS + (dv0 + 16 * dl + 4 * g + i) * L_SROWB + (cc0 + 16 * ct) * 2) = f2bf(sacc[dl][ct][i]);
        if (n + 1 <= 64) L_STORE();
    }
#undef L_LOAD_META
#undef L_LOAD_REAL
#undef L_STORE
    __syncthreads();
}

DI void phase2(const Params& p, unsigned char* lds) {
    const int tid = opaque_tid();
    volatile unsigned* sItem = (volatile unsigned*)(lds + LDS_ITEM);
    constexpr unsigned NSL = 8 / GLA_DL, N_GLA = 2 * NSL, N_ATT = 128;
    if (tid == 0) sItem[1] = 0u;
    for (;;) {
        if (tid == 0) {
            unsigned* heads = (unsigned*)(p.ws + OFF_CTR);
            const unsigned x0 = (unsigned)__builtin_amdgcn_s_getreg((3 << 11) | 20) & 7u;
            unsigned k = sItem[1], it = 0xffffffffu;
            while (k < 8u) {
                const unsigned x = (x0 + k) & 7u;
                const unsigned got = atomicAdd(heads + x, 1u);
                if (got < N_GLA + N_ATT) { it = got | (x << 16); break; }
                ++k;
            }
            sItem[1] = k; sItem[0] = it;
        }
        __syncthreads();
        const unsigned item = (unsigned)__builtin_amdgcn_readfirstlane((int)sItem[0]);
        __syncthreads();
        if (item == 0xffffffffu) break;
        const unsigned x = item >> 16, idx = item & 0xffffu;
        if (idx < N_GLA) { const unsigned gi = x * N_GLA + idx; gla_item<GLA_DL>(p, lds, gi / (4 * NSL), (gi / NSL) & 3, gi % NSL); }
        else { const unsigned a = idx - N_GLA, pair = 4 * x + (a >> 5); attn_item(p, lds, pair & 3, pair >> 2, 31 - (int)(a & 31)); }
    }
}

DI void phase25(const Params& p, unsigned char* lds) {
    const int tid = opaque_tid(), lane = tid & 63, wave = tid >> 6;
    const float* ssqb = (const float*)(p.ws + OFF_SSQB);
    bf16_t* gz = (bf16_t*)(p.ws + OFF_GZ);
    for (int it = blockIdx.x; it < MROWS / 8; it += gridDim.x) {
        const size_t row = (size_t)it * 8 + wave;
        float s = ssqb[(row * 4 + (lane >> 4)) * 16 + (lane & 15)];
        s += __shfl_xor(s, 1); s += __shfl_xor(s, 2); s += __shfl_xor(s, 4); s += __shfl_xor(s, 8);
        const float r = 1.0f / sqrtf(s * (1.0f / 256.0f) + EPS);
        u32x4* ptr = (u32x4*)(gz + row * 1024 + lane * 16);
#pragma unroll
        for (int j = 0; j < 2; ++j) {
            u32x4 u = ptr[j], o;
            o.x = pk2(bflo(u.x) * r, bfhi(u.x) * r); o.y = pk2(bflo(u.y) * r, bfhi(u.y) * r);
            o.z = pk2(bflo(u.z) * r, bfhi(u.z) * r); o.w = pk2(bflo(u.w) * r, bfhi(u.w) * r);
            ptr[j] = o;
        }
    }
}

template <int PASS>
struct EpiMerge {
    static constexpr bool PERM = false, AFTER_DRAIN = false;
    unsigned char* ws;
    DI void operator()(const pg8::f32x4 (&acc)[2][2][4][2], const pg8::Unit& u, int wr, int wc, int fr, int fq) const {
        const unsigned char* sg = ws + (PASS == 0 ? OFF_SGB : OFF_SGA);
        bf16_t* merged = (bf16_t*)(ws + OFF_AK);
#pragma unroll
        for (int ai = 0; ai < 2; ++ai)
#pragma unroll
            for (int m = 0; m < 4; ++m) {
                const size_t tok = (size_t)u.pm * 256 + ai * 128 + wr * 64 + m * 16 + fr;
#pragma unroll
                for (int bj = 0; bj < 2; ++bj)
#pragma unroll
                    for (int n = 0; n < 2; ++n) {
                        const size_t off = tok * 1024 + u.pn * 256 + bj * 128 + wc * 32 + n * 16 + 4 * fq;
                        const unsigned ug = *(const unsigned*)(sg + off);
                        const float q = 1.0f / 255.0f;
                        float m0 = (float)(ug & 255u) * q * acc[ai][bj][m][n][0], m1 = (float)((ug >> 8) & 255u) * q * acc[ai][bj][m][n][1];
                        float m2 = (float)((ug >> 16) & 255u) * q * acc[ai][bj][m][n][2], m3 = (float)(ug >> 24) * q * acc[ai][bj][m][n][3];
                        if (PASS == 1) { const u32x2 t = *(const u32x2*)(merged + off); m0 += bflo(t.x); m1 += bfhi(t.x); m2 += bflo(t.y); m3 += bfhi(t.y); }
                        u32x2 o; o.x = pk2(m0, m1); o.y = pk2(m2, m3);
                        *(u32x2*)(merged + off) = o;
                    }
            }
    }
};
struct EpiOut {
    static constexpr bool PERM = false, AFTER_DRAIN = false;
    unsigned char* ws; const float* x; float* out;
    DI void operator()(const pg8::f32x4 (&acc)[2][2][4][2], const pg8::Unit& u, int wr, int wc, int fr, int fq) const {
        float* ssqh = (float*)(ws + OFF_SSQH);
#pragma unroll
        for (int ai = 0; ai < 2; ++ai)
#pragma unroll
            for (int m = 0; m < 4; ++m) {
                const size_t tok = (size_t)u.pm * 256 + ai * 128 + wr * 64 + m * 16 + fr;
                float ss = 0.f;
#pragma unroll
                for (int bj = 0; bj < 2; ++bj)
#pragma unroll
                    for (int n = 0; n < 2; ++n) {
                        const size_t off = tok * 1024 + u.pn * 256 + bj * 128 + wc * 32 + n * 16 + 4 * fq;
                        const f32x4 xv = *(const f32x4*)(x + off);
                        f32x4 o;
                        o.x = xv.x + acc[ai][bj][m][n][0]; o.y = xv.y + acc[ai][bj][m][n][1];
                        o.z = xv.z + acc[ai][bj][m][n][2]; o.w = xv.w + acc[ai][bj][m][n][3];
                        ss += (o.x * o.x + o.y * o.y) + (o.z * o.z + o.w * o.w);
                        *(f32x4*)(out + off) = o;
                    }
                ss += __shfl_xor(ss, 16); ss += __shfl_xor(ss, 32);
                if (fq == 0) ssqh[tok * 16 + u.pn * 4 + wc] = ss;
            }
    }
};
DI void phase3(const Params& p, unsigned char* lds) {
    SchedSq S;
    {
        pg8::Gemm g; g.A = (const bf16_t*)(p.ws + OFF_GZ); g.Bt = (const bf16_t*)(p.ws + OFF_WB_T); g.M = MROWS; g.N = 1024; g.K = 1024;
        EpiMerge<0> E; E.ws = p.ws;
        pg8::gemm_phase<EpiMerge<0>, SchedSq, true, true>((PG8_LAS unsigned char*)lds, g, S, E);
    }
    {
        pg8::Gemm g; g.A = (const bf16_t*)(p.ws + OFF_AZ); g.Bt = (const bf16_t*)(p.ws + OFF_WA_T); g.M = MROWS; g.N = 1024; g.K = 1024;
        EpiMerge<1> E; E.ws = p.ws;
        pg8::gemm_phase<EpiMerge<1>, SchedSq, true, true>((PG8_LAS unsigned char*)lds, g, S, E);
    }
}
DI void phase4(const Params& p, unsigned char* lds) {
    SchedSq S;
    pg8::Gemm g; g.A = (const bf16_t*)(p.ws + OFF_AK); g.Bt = (const bf16_t*)(p.ws + OFF_WO_T); g.M = MROWS; g.N = 1024; g.K = 1024;
    EpiOut E; E.ws = p.ws; E.x = p.x; E.out = p.out;
    pg8::gemm_phase<EpiOut, SchedSq, true, true>((PG8_LAS unsigned char*)lds, g, S, E);
}

DI void phase5(const Params& p, unsigned char* lds) {
    const int tid = opaque_tid(), lane = tid & 63, wave = tid >> 6;
    const float* ssqh = (const float*)(p.ws + OFF_SSQH);
    for (int it = blockIdx.x; it < MROWS / 8; it += gridDim.x) {
        const size_t row = (size_t)it * 8 + wave;
        float s = lane < 16 ? ssqh[row * 16 + lane] : 0.f;
        s = wave_sum(s);
        const float rstd = 1.0f / sqrtf(s * (1.0f / 1024.0f) + EPS);
        f32x4* orow = (f32x4*)(p.out + row * 1024) + lane;
        const f32x4* wrow = (const f32x4*)p.final_w + lane;
#pragma unroll
        for (int j = 0; j < 4; ++j) {
            f32x4 v = orow[64 * j]; const f32x4 w = wrow[64 * j];
            v.x = v.x * rstd * w.x; v.y = v.y * rstd * w.y; v.z = v.z * rstd * w.z; v.w = v.w * rstd * w.w;
            orow[64 * j] = v;
        }
    }
}

#define XB_TMO      128
#define XB_XCNT(j)  (256  + 64 * (j))
#define XB_XSUB(j)  (1280 + 64 * (j))
#define XB_XGEN(j)  (2304 + 64 * (j))
#define XB_TOP      3328
#define XB_TOPGEN   3392
#define XCD_BAR_WORDS 3456
#define XB_SPIN_CAP (1u << 18)
#define LAS __attribute__((address_space(3)))
DI unsigned xb_ld(unsigned* p)              { return __hip_atomic_load(p, __ATOMIC_RELAXED, __HIP_MEMORY_SCOPE_AGENT); }
DI unsigned xb_add(unsigned* p, unsigned v) { return __hip_atomic_fetch_add(p, v, __ATOMIC_RELAXED, __HIP_MEMORY_SCOPE_AGENT); }
DI unsigned xb_xcc_id() { return (unsigned)__builtin_amdgcn_s_getreg((3 << 11) | 20) & 0xFu; }
#define XB_SPIN(cond, bar) do { unsigned _sp = 0; while (cond) { __builtin_amdgcn_s_sleep(1); \
    if ((++_sp & 255u) == 0u) { if (xb_ld(&(bar)[XB_TMO])) break; if (_sp > XB_SPIN_CAP) { atomicAdd(&(bar)[XB_TMO], 1u); break; } } } } while (0)
struct XcdBarrier { unsigned* bar; unsigned x; volatile LAS unsigned* st; };
DI XcdBarrier xcd_barrier_post(unsigned* bar, volatile LAS unsigned* st) {
    XcdBarrier b; b.bar = bar; b.x = xb_xcc_id(); b.st = st;
    if (threadIdx.x == 0) (void)xb_add(&bar[XB_XCNT(b.x)], 1u);
    return b;
}
DI void xcd_barrier_complete(unsigned* bar, unsigned x, unsigned& nloc, unsigned& nx) {
    const unsigned G = gridDim.x * gridDim.y * gridDim.z;
    unsigned sum, cnt, mine, sp = 0u;
    for (;;) {
        sum = 0u; cnt = 0u; mine = 0u;
#pragma unroll
        for (unsigned j = 0; j < 16; ++j) { const unsigned c = xb_ld(&bar[XB_XCNT(j)]); sum += c; cnt += (c > 0u) ? 1u : 0u; mine = (j == x) ? c : mine; }
        if (sum == G) break;
        __builtin_amdgcn_s_sleep(1);
        if ((++sp & 255u) == 0u) { if (xb_ld(&bar[XB_TMO])) break; if (sp > XB_SPIN_CAP) { atomicAdd(&bar[XB_TMO], 1u); break; } }
    }
    nloc = mine > 0u ? mine : 1u; nx = cnt > 0u ? cnt : 1u;
}
DI void xcd_barrier(const XcdBarrier& b) {
    asm volatile("s_waitcnt vmcnt(0)" ::: "memory");
    __syncthreads();
    if (threadIdx.x == 0) {
        unsigned* bar = b.bar;
        __builtin_amdgcn_s_waitcnt(0);
        unsigned nloc = b.st[0], nx = b.st[1];
        if (nloc == 0u) { xcd_barrier_complete(bar, b.x, nloc, nx); b.st[0] = nloc; b.st[1] = nx; }
        const unsigned old = xb_add(&bar[XB_XSUB(b.x)], 1u);
        const unsigned gen = old / nloc;
        if (old + 1u == (gen + 1u) * nloc) {
            __builtin_amdgcn_fence(__ATOMIC_RELEASE, "agent");
            asm volatile("s_waitcnt vmcnt(0)" ::: "memory");
            const unsigned og = xb_add(&bar[XB_TOP], 1u);
            const unsigned tg = og / nx;
            if (og + 1u == (tg + 1u) * nx) xb_add(&bar[XB_TOPGEN], 1u);
            else XB_SPIN(xb_ld(&bar[XB_TOPGEN]) == tg, bar);
            __builtin_amdgcn_fence(__ATOMIC_ACQUIRE, "agent");
            xb_add(&bar[XB_XGEN(b.x)], 1u);
            asm volatile("s_waitcnt vmcnt(0)" ::: "memory");
        } else {
            XB_SPIN(xb_ld(&bar[XB_XGEN(b.x)]) == gen, bar);
            __builtin_amdgcn_fence(__ATOMIC_ACQUIRE, "agent");
            asm volatile("s_waitcnt vmcnt(0)" ::: "memory");
        }
    }
    __syncthreads();
}

DI void run_phase(const Params& p, unsigned char* lds, int ph) {
    switch (ph) {
        case 0: phase0(p, lds); break;
        case 1: phase1(p, lds); break;
        case 2: phase15(p, lds); break;
        case 3: phase2(p, lds); break;
        case 4: phase25(p, lds); phase3(p, lds); break;
        case 5: phase4(p, lds); break;
        default: phase5(p, lds); break;
    }
}

__global__ void __launch_bounds__(512) hybrid_fwd(Params p) {
    extern __shared__ __attribute__((aligned(16))) unsigned char lds[];
#if MULTI_LAUNCH
    run_phase(p, lds, p.phase_lo);
#else
    cg::grid_group grid = cg::this_grid();
    if (p.phase_lo == 77) grid.sync();
    {
        volatile LAS unsigned* st = (volatile LAS unsigned*)(lds + LDS_ITEM + 16);
        if (threadIdx.x == 0) { st[0] = 0u; st[1] = 0u; }
        __syncthreads();
        (void)xcd_barrier_post((unsigned*)(p.ws + OFF_XBAR), st);
    }
#define GRID_BARRIER() { XcdBarrier xb_; xb_.bar = (unsigned*)(p.ws + OFF_XBAR); xb_.x = xb_xcc_id(); xb_.st = (volatile LAS unsigned*)(lds + LDS_ITEM + 16); xcd_barrier(xb_); }
    phase0(p, lds); GRID_BARRIER();
    phase1(p, lds); GRID_BARRIER();
    phase15(p, lds); GRID_BARRIER();
    phase2(p, lds); GRID_BARRIER();
    phase25(p, lds); GRID_BARRIER();
    phase3(p, lds); GRID_BARRIER();
    phase4(p, lds); GRID_BARRIER();
    phase5(p, lds);
#endif
}

extern "C" void kernel_launch(void* const* d_in, const int* in_sizes, int n_in, void* d_out, int out_size, void* d_ws, size_t ws_size, hipStream_t stream) {
    static int grid = 0;
    if (grid == 0) {
        int dev = 0, cus = 0, per_cu = 0;
        hipGetDevice(&dev);
        hipDeviceGetAttribute(&cus, hipDeviceAttributeMultiprocessorCount, dev);
        hipFuncSetAttribute((const void*)hybrid_fwd, hipFuncAttributeMaxDynamicSharedMemorySize, LDS_BYTES);
        hipOccupancyMaxActiveBlocksPerMultiprocessor(&per_cu, (const void*)hybrid_fwd, 512, LDS_BYTES);
        if (per_cu < 1) per_cu = 1;
        if (per_cu > 1) per_cu = 1;
        if (cus <= 0) cus = 256;
        grid = cus * per_cu;
    }
    hipMemsetAsync((unsigned char*)d_ws + OFF_CTR, 0, 256, stream);
    hipMemsetAsync((unsigned char*)d_ws + OFF_XBAR, 0, 16384, stream);
    Params p{};
    p.x = (const float*)d_in[0]; p.meta = (const float*)d_in[1]; p.norm_w = (const float*)d_in[2]; p.w_in = (const float*)d_in[3];
    p.lq1 = (const float*)d_in[4]; p.lk1 = (const float*)d_in[5]; p.lq2 = (const float*)d_in[6]; p.lk2 = (const float*)d_in[7];
    p.subln_w = (const float*)d_in[8]; p.gate_w2 = (const float*)d_in[9]; p.gate_b = (const float*)d_in[10]; p.gla_norm_w = (const float*)d_in[11];
    p.wa = (const float*)d_in[12]; p.wb = (const float*)d_in[13]; p.wo = (const float*)d_in[14]; p.final_w = (const float*)d_in[15];
    p.out = (float*)d_out; p.ws = (unsigned char*)d_ws;
#if MULTI_LAUNCH
    for (int ph = 0; ph < 7; ++ph) {
        p.phase_lo = ph; p.phase_hi = ph + 1;
        hipLaunchKernelGGL(hybrid_fwd, dim3(grid), dim3(512), LDS_BYTES, stream, p);
    }
#else
    p.phase_lo = 0; p.phase_hi = 7;
    void* args[] = {&p};
    hipError_t e = hipLaunchCooperativeKernel((const void*)hybrid_fwd, dim3(grid), dim3(512), args, LDS_BYTES, stream);
    if (e != hipSuccess) fprintf(stderr, "cooperative launch failed: %s (grid %d)\n", hipGetErrorString(e), grid);
#endif
}
```

```cpp
#include <hip/hip_runtime.h>
#include <hip/hip_cooperative_groups.h>
#include <cstdio>
#include <cstdint>
namespace cg = cooperative_groups;

#ifndef MULTI_LAUNCH
#define MULTI_LAUNCH 0
#endif
#ifndef PROBE_REP
#define PROBE_REP 0
#endif

typedef unsigned short bf16_t;
typedef short bf16x8 __attribute__((ext_vector_type(8)));
typedef float f32x4 __attribute__((ext_vector_type(4)));
typedef float f32x2 __attribute__((ext_vector_type(2)));
typedef float f32x16 __attribute__((ext_vector_type(16)));
typedef unsigned u32x4 __attribute__((ext_vector_type(4)));
typedef unsigned u32x2 __attribute__((ext_vector_type(2)));
typedef __bf16 bfv2 __attribute__((ext_vector_type(2)));

#define DI __device__ __forceinline__
#define MFMA32(a, b, c) __builtin_amdgcn_mfma_f32_32x32x16_bf16((a), (b), (c), 0, 0, 0)
#define MFMA16(a, b, c) __builtin_amdgcn_mfma_f32_16x16x32_bf16((a), (b), (c), 0, 0, 0)

DI unsigned pk2(float a, float b) { f32x2 v = {a, b}; return __builtin_bit_cast(unsigned, __builtin_convertvector(v, bfv2)); }
DI float bf2f(bf16_t v) { return __uint_as_float(((unsigned)v) << 16); }
DI float bflo(unsigned u) { return __uint_as_float(u << 16); }
DI float bfhi(unsigned u) { return __uint_as_float(u & 0xffff0000u); }
DI bf16_t f2bf(float a) { return (bf16_t)(pk2(a, 0.f) & 0xffffu); }
DI float wave_sum(float v) {
#pragma unroll
    for (int o = 32; o; o >>= 1) v += __shfl_xor(v, o);
    return v;
}
DI int opaque_tid() { int t = threadIdx.x; asm volatile("" : "+v"(t)); return t; }
DI float sigmoidf_(float z) { return 1.f / (1.f + __expf(-z)); }
DI float siluf_(float z) { return z / (1.f + __expf(-z)); }

constexpr int D = 1024, NB = 4, SEQ = 4096, MROWS = NB * SEQ;
constexpr int NIN = 9232, NINP = 9344;
constexpr float EPS = 1e-5f;

constexpr size_t SZ_ACT = (size_t)MROWS * 1024 * 2;
constexpr size_t OFF_WIN_T = 0;
constexpr size_t OFF_WA_T = OFF_WIN_T + (size_t)NINP * 1024 * 2;
constexpr size_t OFF_WB_T = OFF_WA_T + 2097152;
constexpr size_t OFF_WO_T = OFF_WB_T + 2097152;
constexpr size_t OFF_AK = OFF_WO_T + 2097152;
constexpr size_t OFF_AVT = OFF_AK + SZ_ACT;
constexpr size_t OFF_AZ = OFF_AVT + SZ_ACT;
constexpr size_t OFF_GVT = OFF_AZ + SZ_ACT;
constexpr size_t OFF_GZ = OFF_GVT + SZ_ACT;
constexpr size_t OFF_GA = OFF_GZ + SZ_ACT;
constexpr size_t OFF_GB = OFF_GA + SZ_ACT;
constexpr size_t OFF_GLR = OFF_GB + SZ_ACT;
constexpr size_t OFF_RSTD = OFF_GLR + (size_t)MROWS * 16 * 2;
constexpr size_t OFF_ROPE = OFF_RSTD + 65792;
constexpr size_t OFF_AKM = OFF_ROPE + 263168;
constexpr size_t OFF_AVTM = OFF_AKM + 131072;
constexpr size_t OFF_GVTM = OFF_AVTM + 131072;
constexpr size_t OFF_GKM = OFF_GVTM + 131072;
constexpr size_t OFF_GLRM = OFF_GKM + 16384;
constexpr size_t OFF_KTM = OFF_GLRM + 512;
constexpr size_t OFF_KTTM = OFF_KTM + 65536;
constexpr size_t OFF_DEC = OFF_KTTM + 65536;
constexpr size_t OFF_DECM = OFF_DEC + 524288;
constexpr size_t OFF_SSQB = OFF_DECM + 2048;
constexpr size_t OFF_SSQH = OFF_SSQB + 4194304;
constexpr size_t OFF_CTR = OFF_SSQH + 1048576;
constexpr size_t OFF_XBM = OFF_CTR + 256;
constexpr size_t OFF_XBAR = OFF_XBM + 32768;
constexpr size_t WS_END = OFF_XBAR + 16384;
constexpr size_t OFF_XB = OFF_GA;
constexpr size_t OFF_SGA = OFF_GB;
constexpr size_t OFF_SGB = OFF_GB + (size_t)MROWS * 1024;
static_assert(WS_END <= 268435456ull, "workspace over 256 MiB");
constexpr size_t DO_AQ = 0, DO_GQ = SZ_ACT, DO_GK = SZ_ACT + SZ_ACT / 2;

constexpr int G_ROWB = 144;
constexpr int G_SW = 128 * G_ROWB, G_SX = 256 * G_ROWB, G_STAGE = G_SW + G_SX;
constexpr int G_SW4 = 256 * G_ROWB, G_STAGE4 = G_SW4 + G_SX;
constexpr int LDS_SCALE = 2 * G_STAGE4;
constexpr int LDS_ITEM = LDS_SCALE + 4096;
constexpr int LDS_BYTES = LDS_ITEM + 64;

struct Params {
    const float *x, *meta, *norm_w, *w_in, *lq1, *lk1, *lq2, *lk2, *subln_w, *gate_w2, *gate_b, *gla_norm_w, *wa, *wb, *wo, *final_w;
    float* out;
    unsigned char* ws;
    int phase_lo, phase_hi;
};

template <int MODE>
DI void p0_transpose_item(const Params& p, int item, float* tile) {
    const int tid = opaque_tid();
    const float* W = MODE == 0 ? p.w_in : MODE == 1 ? p.wa : MODE == 2 ? p.wb : p.wo;
    const int ldw = MODE == 0 ? NIN : 1024;
    const int nbc = MODE == 0 ? NINP / 64 : 16;
    bf16_t* WT = (bf16_t*)(p.ws + (MODE == 0 ? OFF_WIN_T : MODE == 1 ? OFF_WA_T : MODE == 2 ? OFF_WB_T : OFF_WO_T));
    const int kb = item / nbc, nb = item % nbc, k0 = kb * 64, n0 = nb * 64;
#pragma unroll
    for (int i = 0; i < 8; ++i) {
        const int kk = (tid >> 6) + 8 * i, nn = tid & 63, n = n0 + nn, k = k0 + kk;
        int src = n;
        if (MODE == 0) { src = n < 7168 ? n : (n < 9216 ? n + 16 : (n < 9232 ? n - 2048 : -1)); }
        float sc = 1.f;
        if (MODE == 0) sc = p.norm_w[k];
        if (MODE == 1) sc = 0.8f * p.subln_w[k & 127];
        if (MODE == 2) sc = p.gla_norm_w[k & 255];
        float v = 0.f;
        if (src >= 0) v = W[(size_t)k * ldw + src] * sc;
        tile[kk * 65 + nn] = v;
    }
    __syncthreads();
    {
        const int nn = tid >> 3, c = tid & 7;
        const float* s = tile + (8 * c) * 65 + nn;
        u32x4 o;
        o.x = pk2(s[0 * 65], s[1 * 65]); o.y = pk2(s[2 * 65], s[3 * 65]); o.z = pk2(s[4 * 65], s[5 * 65]); o.w = pk2(s[6 * 65], s[7 * 65]);
        *(u32x4*)(WT + (size_t)(n0 + nn) * 1024 + k0 + 8 * c) = o;
    }
    __syncthreads();
}

DI void phase0(const Params& p, unsigned char* lds) {
    const int tid = opaque_tid(), lane = tid & 63, wave = tid >> 6;
    float* tile = (float*)lds;
    constexpr int I_WIN = 16 * (NINP / 64), I_SQ = 256;
    constexpr int I_T = I_WIN + 3 * I_SQ;
    constexpr int I_RSTD = (MROWS + 16 + 7) / 8;
    constexpr int I_ROPE = (4112 * 8 + 511) / 512;
    constexpr int I_ZERO = 393216 / 8192;
    constexpr int I_ALL = I_T + I_RSTD + I_ROPE + I_ZERO;
    for (int it = blockIdx.x; it < I_ALL; it += gridDim.x) {
        int r = it;
        if (r < I_WIN) { p0_transpose_item<0>(p, r, tile); continue; } r -= I_WIN;
        if (r < I_SQ) { p0_transpose_item<1>(p, r, tile); continue; } r -= I_SQ;
        if (r < I_SQ) { p0_transpose_item<2>(p, r, tile); continue; } r -= I_SQ;
        if (r < I_SQ) { p0_transpose_item<3>(p, r, tile); continue; } r -= I_SQ;
        if (r < I_RSTD) {
            const int row = r * 8 + wave;
            if (row < MROWS + 16) {
                const float* src = row < MROWS ? p.x + (size_t)row * 1024 : p.meta + (size_t)(row - MROWS) * 1024;
                const f32x4* xr = (const f32x4*)src + lane;
                float s = 0.f;
#pragma unroll
                for (int j = 0; j < 4; ++j) { const f32x4 v = xr[64 * j]; s += (v.x * v.x + v.y * v.y) + (v.z * v.z + v.w * v.w); }
                s = wave_sum(s);
                if (lane == 0) ((float*)(p.ws + OFF_RSTD))[row] = 1.0f / sqrtf(s * (1.0f / 1024.0f) + EPS);
                bf16_t* xbrow = row < MROWS ? (bf16_t*)(p.ws + OFF_XB) + (size_t)row * 1024 : (bf16_t*)(p.ws + OFF_XBM) + (size_t)(row - MROWS) * 1024;
#pragma unroll
                for (int j = 0; j < 4; ++j) { const f32x4 v = xr[64 * j]; u32x2 o; o.x = pk2(v.x, v.y); o.y = pk2(v.z, v.w); *(u32x2*)(xbrow + 256 * j + 4 * lane) = o; }
            }
            continue;
        }
        r -= I_RSTD;
        if (r < I_ROPE) {
            const int e = r * 512 + tid;
            if (e < 4112 * 8) {
                const int pos = e >> 3, i = e & 7;
                const float inv = powf(500000.0f, -(float)i / 8.0f);
                const float ang = (float)pos * inv;
                float* t = (float*)(p.ws + OFF_ROPE) + (size_t)e * 2;
                t[0] = cosf(ang); t[1] = sinf(ang);
            }
            continue;
        }
        r -= I_ROPE;
        { u32x4 z = {0u, 0u, 0u, 0u}; *(u32x4*)(p.ws + OFF_AKM + (size_t)r * 8192 + tid * 16) = z; }
    }
}

template <int NI, bool HS>
DI void gemm_tile(f32x16 (&acc)[NI][2], const bf16_t* __restrict__ Wt, const bf16_t* __restrict__ X, unsigned char* lds, const float (&hs)[2][3]) {
    const int tid = opaque_tid(), lane = tid & 63, wave = tid >> 6, l31 = lane & 31, h = lane >> 5;
    const int wn = wave & 1, wm = wave >> 1;
    constexpr int SW = NI * 64 * G_ROWB, STAGE = SW + G_SX;
    u32x4 wreg[NI];
    u32x4 xreg[4];
    const int prow = tid >> 3, pc = tid & 7;
    const bf16_t* wp = Wt + (size_t)prow * 1024 + pc * 8;
    const bf16_t* xp = X + (size_t)prow * 1024 + pc * 8;
#define G_LOAD(kt_)                                                                                                  \
    {                                                                                                                \
        _Pragma("unroll") for (int i = 0; i < NI; ++i) wreg[i] = *(const u32x4*)(wp + (size_t)i * 64 * 1024 + (kt_) * 64); \
        _Pragma("unroll") for (int i = 0; i < 4; ++i) xreg[i] = *(const u32x4*)(xp + (size_t)i * 64 * 1024 + (kt_) * 64);  \
    }
#define G_STORE(buf_)                                                                                                \
    {                                                                                                                \
        unsigned char* sW_ = lds + (buf_) * STAGE + prow * G_ROWB + pc * 16; unsigned char* sX_ = sW_ + SW;          \
        _Pragma("unroll") for (int i = 0; i < NI; ++i) *(u32x4*)(sW_ + i * 64 * G_ROWB) = wreg[i];                   \
        _Pragma("unroll") for (int i = 0; i < 4; ++i) *(u32x4*)(sX_ + i * 64 * G_ROWB) = xreg[i];                    \
    }
    G_LOAD(0);
    G_STORE(0);
    __syncthreads();
    for (int kt = 0; kt < 16; ++kt) {
        if (kt + 1 < 16) G_LOAD(kt + 1);
        if (HS) {
            if (kt == 4 || kt == 8 || kt == 12) {
                const float s0 = kt == 4 ? hs[0][0] : (kt == 8 ? hs[0][1] : hs[0][2]);
                const float s1 = kt == 4 ? hs[1][0] : (kt == 8 ? hs[1][1] : hs[1][2]);
#pragma unroll
                for (int n = 0; n < NI; ++n)
#pragma unroll
                    for (int i = 0; i < 16; ++i) { acc[n][0][i] *= s0; acc[n][1][i] *= s1; }
            }
        }
        {
            const unsigned char* sW = lds + (kt & 1) * STAGE + (wn * NI * 32 + l31) * G_ROWB + h * 16;
            const unsigned char* sX = lds + (kt & 1) * STAGE + SW + (wm * 64 + l31) * G_ROWB + h * 16;
#pragma unroll
            for (int ks = 0; ks < 4; ++ks) {
                const bf16x8 x0 = *(const bf16x8*)(sX + ks * 32), x1 = *(const bf16x8*)(sX + 32 * G_ROWB + ks * 32);
#pragma unroll
                for (int n = 0; n < NI; ++n) {
                    const bf16x8 w = *(const bf16x8*)(sW + n * 32 * G_ROWB + ks * 32);
                    acc[n][0] = MFMA32(w, x0, acc[n][0]); acc[n][1] = MFMA32(w, x1, acc[n][1]);
                }
            }
        }
        if (kt + 1 < 16) G_STORE((kt + 1) & 1);
        __syncthreads();
    }
#undef G_LOAD
#undef G_STORE
}

template <int NI>
DI void zero_acc(f32x16 (&acc)[NI][2]) {
#pragma unroll
    for (int a = 0; a < NI; ++a)
#pragma unroll
        for (int b = 0; b < 2; ++b)
#pragma unroll
            for (int i = 0; i < 16; ++i) acc[a][b][i] = 0.f;
}

namespace pg8 {
#define PG8_LAS __attribute__((address_space(3)))
typedef unsigned short bf16_t;
typedef short bf16x8 __attribute__((ext_vector_type(8)));
typedef float f32x4 __attribute__((ext_vector_type(4)));
typedef unsigned u32x4 __attribute__((ext_vector_type(4)));
constexpr int BM = 256, BK = 64, HALF = 128, HTB = HALF * BK * 2  , STAGE_BYTES = 8 * HTB, NXCD = 8, WGM = 8;

__host__ __device__ __forceinline__ int lds_byte(int r, int c) { const int st = (r >> 4) * 2 + (c >> 5), rr = r & 15, cc = c & 31, ob = rr * 64 + cc * 2; return st * 1024 + (ob ^ (((ob >> 9) & 1) << 5)); }
__host__ __device__ __forceinline__ void stage_rc(int b, int& R, int& C) { const int st = b / 1024, sb = b % 1024, swz = sb ^ (((sb >> 9) & 1) << 5); R = (st >> 1) * 16 + swz / 64; C = (st & 1) * 32 + (swz % 64) / 2; }
__host__ __device__ __forceinline__ int perm32(int rho) { const int n = rho >> 4, i = rho & 15; return 8 * (i >> 2) + 4 * n + (i & 3); }

struct Unit { int pm, pn; };
struct Gemm { const bf16_t* A; const bf16_t* Bt; int M, N, K; };

template <class Epi, class Sched, bool ALIGN_EPI = false, bool SP2 = false>
__device__ __forceinline__ void gemm_phase(PG8_LAS unsigned char* lds, const Gemm g, const Sched& S, const Epi& E) {
    const int tid = opaque_tid(), wid = __builtin_amdgcn_readfirstlane(tid >> 6), lane = tid & 63, wr = wid >> 2, wc = wid & 3, fr = lane & 15, fq = lane >> 4;
    const int K = g.K, nt = K / BK;
    unsigned voffA[2], voffB[2];
#pragma unroll
    for (int i = 0; i < 2; ++i) { int R, C; stage_rc(tid * 16 + i * 8192, R, C); const int Rb = Epi::PERM ? ((R & ~31) + perm32(R & 31)) : R;
        voffA[i] = (unsigned)(R * K + C) * 2u; voffB[i] = (unsigned)(Rb * K + C) * 2u; }
    const size_t kstep = (size_t)(BK * 2);
    const size_t hstep = (size_t)HALF * K * 2;
    const size_t tstep = 2 * hstep;
    const unsigned ldsw = (unsigned)wid * 1024u;
    const int aoff = lds_byte(wr * 64 + fr, fq * 8), boff = lds_byte(wc * 32 + fr, fq * 8);
#define PG8_SA(b, h) (((b) * 2 + (h)) * HTB)
#define PG8_SB(b, h) ((4 + (b) * 2 + (h)) * HTB)
#define PG8_STAGE(bufoff, gbase, voff) do { _Pragma("unroll") for (int _i = 0; _i < 2; ++_i) \
        __builtin_amdgcn_global_load_lds((const unsigned*)((const char*)(gbase) + (voff)[_i]), (PG8_LAS unsigned*)(lds + (bufoff) + ldsw + _i * 8192), 16, 0, 0); } while (0)
#define PG8_LDA(dst, b, h) do { _Pragma("unroll") for (int m = 0; m < 4; ++m) _Pragma("unroll") for (int k = 0; k < 2; ++k) dst[m][k] = *(const PG8_LAS bf16x8*)(lds + PG8_SA(b, h) + aoff + m * 2048 + k * 1024); } while (0)
#define PG8_LDB(dst, b, h) do { _Pragma("unroll") for (int n = 0; n < 2; ++n) _Pragma("unroll") for (int k = 0; k < 2; ++k) dst[n][k] = *(const PG8_LAS bf16x8*)(lds + PG8_SB(b, h) + boff + n * 2048 + k * 1024); } while (0)
#define PG8_MMA(ai, bj, At, Bt) do { __builtin_amdgcn_s_setprio(1); _Pragma("unroll") for (int m = 0; m < 4; ++m) _Pragma("unroll") for (int n = 0; n < 2; ++n) _Pragma("unroll") for (int k = 0; k < 2; ++k) \
        acc[ai][bj][m][n] = __builtin_amdgcn_mfma_f32_16x16x32_bf16(Bt[n][k], At[m][k], acc[ai][bj][m][n], 0, 0, 0); __builtin_amdgcn_s_setprio(0); } while (0)
#define PG8_WAIT_V(n) asm volatile("s_waitcnt vmcnt(" #n ")" ::: "memory")
#define PG8_WAIT_L(n) asm volatile("s_waitcnt lgkmcnt(" #n ")" ::: "memory")
#define PG8_BAR __builtin_amdgcn_s_barrier()
#define PG8_SCHED __builtin_amdgcn_sched_barrier(0)
    Unit cur, nxt; int ui = 0;
    if (!S.next(0, cur)) return;
    f32x4 acc[2][2][4][2];
#pragma unroll
    for (int a = 0; a < 2; ++a)
#pragma unroll
        for (int b = 0; b < 2; ++b)
#pragma unroll
            for (int m = 0; m < 4; ++m)
#pragma unroll
                for (int n = 0; n < 2; ++n) acc[a][b][m][n] = (f32x4){0.f, 0.f, 0.f, 0.f};
    bf16x8 At[4][2], B0[2][2], B1[2][2];
    const char* cA = (const char*)g.A + (size_t)cur.pm * tstep; const char* cB = (const char*)g.Bt + (size_t)cur.pn * tstep;
    S.a_ready(cur);
    if constexpr (SP2) {
        PG8_STAGE(PG8_SB(0, 0), cB, voffB); PG8_STAGE(PG8_SB(0, 1), cB + hstep, voffB); PG8_STAGE(PG8_SA(0, 0), cA, voffA); PG8_STAGE(PG8_SA(0, 1), cA + hstep, voffA);
        if (wr == 1) PG8_BAR;
        PG8_WAIT_V(2); PG8_BAR;
        PG8_STAGE(PG8_SB(1, 0), cB + kstep, voffB); PG8_STAGE(PG8_SA(1, 0), cA + kstep, voffA); PG8_STAGE(PG8_SB(1, 1), cB + hstep + kstep, voffB);
        PG8_WAIT_V(6); PG8_BAR;
    } else {
        PG8_STAGE(PG8_SB(0, 0), cB, voffB); PG8_STAGE(PG8_SA(0, 0), cA, voffA); PG8_STAGE(PG8_SB(0, 1), cB + hstep, voffB); PG8_STAGE(PG8_SA(0, 1), cA + hstep, voffA);
        if (wr == 1) PG8_BAR;
        PG8_WAIT_V(4); PG8_BAR;
        PG8_STAGE(PG8_SB(1, 0), cB + kstep, voffB); PG8_STAGE(PG8_SA(1, 0), cA + kstep, voffA); PG8_STAGE(PG8_SB(1, 1), cB + hstep + kstep, voffB);
        PG8_WAIT_V(6); PG8_BAR;
    }
    for (;;) {
        const bool has_next = S.next(ui + 1, nxt);
        const char* nA = has_next ? (const char*)g.A + (size_t)nxt.pm * tstep : cA; const char* nB = has_next ? (const char*)g.Bt + (size_t)nxt.pn * tstep : cB;
        for (int t = 0; t < nt; t += 2) {
            const bool last = (t == nt - 2);
            const char* a1 = cA + (size_t)(t + 1) * kstep;
            const char* a2 = last ? nA : cA + (size_t)(t + 2) * kstep; const char* b2 = last ? nB : cB + (size_t)(t + 2) * kstep;
            const char* a3 = a2 + kstep; const char* b3 = b2 + kstep;
            if (last && has_next) S.a_ready(nxt);
            if constexpr (SP2) {
            PG8_LDB(B0, 0, 0); PG8_LDB(B1, 0, 1); PG8_SCHED; PG8_LDA(At, 0, 0); PG8_STAGE(PG8_SA(1, 1), a1 + hstep, voffA);
            PG8_WAIT_V(8); PG8_WAIT_L(0); PG8_BAR; PG8_MMA(0, 0, At, B0); PG8_MMA(0, 1, At, B1); PG8_BAR; PG8_SCHED;
            PG8_LDA(At, 0, 1); PG8_STAGE(PG8_SB(0, 0), b2, voffB); PG8_STAGE(PG8_SB(0, 1), b2 + hstep, voffB); PG8_STAGE(PG8_SA(0, 0), a2, voffA);
            PG8_WAIT_V(8); PG8_WAIT_L(0); PG8_BAR; PG8_MMA(1, 0, At, B0); PG8_MMA(1, 1, At, B1); PG8_BAR; PG8_SCHED;
            PG8_LDB(B0, 1, 0); PG8_LDB(B1, 1, 1); PG8_SCHED; PG8_LDA(At, 1, 0); PG8_STAGE(PG8_SA(0, 1), a2 + hstep, voffA);
            PG8_WAIT_V(8); PG8_WAIT_L(0); PG8_BAR; PG8_MMA(0, 0, At, B0); PG8_MMA(0, 1, At, B1); PG8_BAR; PG8_SCHED;
            PG8_LDA(At, 1, 1); PG8_STAGE(PG8_SB(1, 0), b3, voffB); PG8_STAGE(PG8_SB(1, 1), b3 + hstep, voffB); PG8_STAGE(PG8_SA(1, 0), a3, voffA);
            PG8_WAIT_V(8); PG8_WAIT_L(0); PG8_BAR; PG8_MMA(1, 0, At, B0); PG8_MMA(1, 1, At, B1); PG8_BAR; PG8_SCHED;
            } else {
            PG8_LDB(B0, 0, 0); PG8_SCHED; PG8_LDA(At, 0, 0); PG8_STAGE(PG8_SA(1, 1), a1 + hstep, voffA);
            PG8_WAIT_L(8); PG8_BAR; PG8_WAIT_L(0); PG8_MMA(0, 0, At, B0); PG8_BAR; PG8_SCHED;
            PG8_LDB(B1, 0, 1); PG8_STAGE(PG8_SB(0, 0), b2, voffB);
            PG8_BAR; PG8_WAIT_L(0); PG8_MMA(0, 1, At, B1); PG8_BAR;
            PG8_LDA(At, 0, 1); PG8_STAGE(PG8_SA(0, 0), a2, voffA);
            PG8_BAR; PG8_WAIT_L(0); PG8_MMA(1, 0, At, B0); PG8_BAR; PG8_SCHED;
            PG8_STAGE(PG8_SB(0, 1), b2 + hstep, voffB);
            PG8_WAIT_V(6); PG8_BAR; PG8_MMA(1, 1, At, B1); PG8_BAR;
            PG8_LDB(B0, 1, 0); PG8_SCHED; PG8_LDA(At, 1, 0); PG8_STAGE(PG8_SA(0, 1), a2 + hstep, voffA);
            PG8_WAIT_L(8); PG8_BAR; PG8_WAIT_L(0); PG8_MMA(0, 0, At, B0); PG8_BAR; PG8_SCHED;
            PG8_LDB(B1, 1, 1); PG8_STAGE(PG8_SB(1, 0), b3, voffB);
            PG8_BAR; PG8_WAIT_L(0); PG8_MMA(0, 1, At, B1); PG8_BAR;
            PG8_LDA(At, 1, 1); PG8_STAGE(PG8_SA(1, 0), a3, voffA);
            PG8_BAR; PG8_WAIT_L(0); PG8_MMA(1, 0, At, B0); PG8_BAR; PG8_SCHED;
            PG8_STAGE(PG8_SB(1, 1), b3 + hstep, voffB);
            PG8_WAIT_V(6); PG8_BAR; PG8_MMA(1, 1, At, B1); PG8_BAR;
            }
        }
        if constexpr (ALIGN_EPI) { if (wr == 0) PG8_BAR; }
        if constexpr (!Epi::AFTER_DRAIN) { E(acc, cur, wr, wc, fr, fq); S.done(cur); }
        if (!has_next) break;
#pragma unroll
        for (int a = 0; a < 2; ++a)
#pragma unroll
            for (int b = 0; b < 2; ++b)
#pragma unroll
                for (int m = 0; m < 4; ++m)
#pragma unroll
                    for (int n = 0; n < 2; ++n) acc[a][b][m][n] = (f32x4){0.f, 0.f, 0.f, 0.f};
        cur = nxt; cA = nA; cB = nB; ++ui;
        if constexpr (ALIGN_EPI) { if (wr == 1) PG8_BAR; }
    }
    PG8_WAIT_V(0);
    if constexpr (!ALIGN_EPI) { if (wr == 0) PG8_BAR; }
    PG8_BAR;
    if constexpr (Epi::AFTER_DRAIN) { E.fused(acc, cur, wr, wc, fr, fq, lds, wid, lane); S.done(cur); }
#undef PG8_SA
#undef PG8_SB
#undef PG8_STAGE
#undef PG8_LDA
#undef PG8_LDB
#undef PG8_MMA
#undef PG8_WAIT_V
#undef PG8_WAIT_L
#undef PG8_BAR
#undef PG8_SCHED
}
}

DI unsigned sig_u8(float z) { return (unsigned)(255.0f / (1.0f + __expf(-z)) + 0.5f); }
struct SchedP1 {
    DI bool next(int i, pg8::Unit& u) const {
        constexpr int NT = 36;
        const int id = (int)blockIdx.x + i * (int)gridDim.x;
        if (id >= 64 * NT) return false;
        const int g = id / (16 * NT), rem = id % (16 * NT), reg = rem >> 8, w = rem & 255, x = w & 7, j = w >> 3;
        int mt = g * 16 + 4 * (x & 3) + (j & 3), nt = reg * 16 + 8 * (x >> 2) + (j >> 2);
        if (reg == 2) { const int e = rem - 512; nt = 32 + (e >> 4); mt = g * 16 + (e & 15); }
        u.pm = mt; u.pn = nt; return true;
    }
    DI void a_ready(const pg8::Unit&) const {}
    DI void done(const pg8::Unit&) const {}
};
struct SchedSq {
    DI bool next(int i, pg8::Unit& u) const {
        const int id = (int)blockIdx.x + i * (int)gridDim.x;
        if (id >= 256) return false;
        u.pm = 8 * (id & 7) + ((id >> 3) & 7); u.pn = id >> 6; return true;
    }
    DI void a_ready(const pg8::Unit&) const {}
    DI void done(const pg8::Unit&) const {}
};
struct EpiInProj {
    static constexpr bool PERM = false, AFTER_DRAIN = false;
    unsigned char* ws; unsigned char* dout;
    DI void operator()(const pg8::f32x4 (&acc)[2][2][4][2], const pg8::Unit& u, int wr, int wc, int fr, int fq) const {
        const int nt = u.pn;
        int split, nc0;
        if (nt < 4) { split = 0; nc0 = nt * 256; }
        else if (nt < 8) { split = 1; nc0 = (nt - 4) * 256; }
        else if (nt < 12) { split = 2; nc0 = (nt - 8) * 256; }
        else if (nt < 16) { split = 3; nc0 = (nt - 12) * 256; }
        else if (nt < 18) { split = 4; nc0 = (nt - 16) * 256; }
        else if (nt < 20) { split = 5; nc0 = (nt - 18) * 256; }
        else if (nt < 24) { split = 6; nc0 = (nt - 20) * 256; }
        else if (nt < 28) { split = 7; nc0 = (nt - 24) * 256; }
        else if (nt < 32) { split = 9; nc0 = (nt - 28) * 256; }
        else { split = 10; nc0 = (nt - 32) * 256; }
        const float* rstd = (const float*)(ws + OFF_RSTD);
        const float* rope = (const float*)(ws + OFF_ROPE);
        const bool do_rope = split <= 1 && (wc & 1) == 0;
#pragma unroll
        for (int ai = 0; ai < 2; ++ai)
#pragma unroll
            for (int m = 0; m < 4; ++m) {
                const int tok = u.pm * 256 + ai * 128 + wr * 64 + m * 16 + fr;
                const float rs = rstd[tok];
                const int pos = 16 + (tok & 4095), b = tok >> 12, s = tok & 4095;
#pragma unroll
                for (int bj = 0; bj < 2; ++bj)
#pragma unroll
                    for (int n = 0; n < 2; ++n) {
                        const int nb = nc0 + bj * 128 + wc * 32 + n * 16 + 4 * fq;
                        float v[4];
#pragma unroll
                        for (int j = 0; j < 4; ++j) v[j] = acc[ai][bj][m][n][j] * rs;
                        if (n == 0 && do_rope) {
                            const float* cs = rope + ((size_t)pos * 8 + 4 * (fq & 1)) * 2;
#pragma unroll
                            for (int j = 0; j < 4; ++j) {
                                const float other = __shfl_xor(v[j], 32);
                                const float c = cs[2 * j], sn = cs[2 * j + 1];
                                v[j] = fq < 2 ? (v[j] * c - other * sn) : (v[j] * c + other * sn);
                            }
                        }
                        if (split == 2 || split == 6) {
                            const int hshift = split == 2 ? 7 : 8, nheads = split == 2 ? 8 : 4, dvn = 1 << hshift;
                            bf16_t* base = (bf16_t*)(ws + (split == 2 ? OFF_AVT : OFF_GVT));
#pragma unroll
                            for (int j = 0; j < 4; ++j) {
                                const int nn = nb + j, hd = nn >> hshift, dv = nn & (dvn - 1);
                                base[((size_t)(b * nheads + hd) * dvn + dv) * 4096 + s] = f2bf(v[j]);
                            }
                        } else if (split >= 9) {
                            const unsigned o = sig_u8(v[0]) | (sig_u8(v[1]) << 8) | (sig_u8(v[2]) << 16) | (sig_u8(v[3]) << 24);
                            *(unsigned*)(ws + (split == 9 ? OFF_SGA : OFF_SGB) + (size_t)tok * 1024 + nb) = o;
                        } else {
                            bf16_t* dst; int ld;
                            switch (split) {
                                case 0: dst = (bf16_t*)(dout + DO_AQ); ld = 1024; break;
                                case 1: dst = (bf16_t*)(ws + OFF_AK); ld = 1024; break;
                                case 3: dst = (bf16_t*)(ws + OFF_AZ); ld = 1024; break;
                                case 4: dst = (bf16_t*)(dout + DO_GQ); ld = 512; break;
                                case 5: dst = (bf16_t*)(dout + DO_GK); ld = 512; break;
                                default: dst = (bf16_t*)(ws + OFF_GZ); ld = 1024; break;
                            }
                            u32x2 o; o.x = pk2(v[0], v[1]); o.y = pk2(v[2], v[3]);
                            *(u32x2*)(dst + (size_t)tok * ld + nb) = o;
                        }
                    }
            }
    }
};

DI void p1_glr_job(const Params& p, unsigned char* lds, int job) {
    const int tid = opaque_tid(), lane = tid & 63, wave = tid >> 6, l15 = lane & 15, g = lane >> 4;
    const int rtile = wave & 3, khalf = wave >> 2;
    const bf16_t* xb = (const bf16_t*)(p.ws + OFF_XB);
    const bf16_t* wt = (const bf16_t*)(p.ws + OFF_WIN_T) + (size_t)9216 * 1024;
    const size_t row0 = (size_t)job * 64 + rtile * 16;
    const bf16_t* ap = xb + (row0 + l15) * 1024 + khalf * 512 + 8 * g;
    const bf16_t* bp = wt + (size_t)l15 * 1024 + khalf * 512 + 8 * g;
    f32x4 acc = (f32x4){0.f, 0.f, 0.f, 0.f};
#pragma unroll 4
    for (int ks = 0; ks < 16; ++ks) {
        const bf16x8 a = *(const bf16x8*)(ap + ks * 32), bb = *(const bf16x8*)(bp + ks * 32);
        acc = MFMA16(a, bb, acc);
    }
    f32x4* red = (f32x4*)lds;
    __syncthreads();
    if (khalf == 1) red[rtile * 64 + lane] = acc;
    __syncthreads();
    if (khalf == 0) {
        const f32x4 o = red[rtile * 64 + lane];
        const float* rstd = (const float*)(p.ws + OFF_RSTD);
        bf16_t* glr = (bf16_t*)(p.ws + OFF_GLR);
#pragma unroll
        for (int i = 0; i < 4; ++i) {
            const size_t row = row0 + 4 * g + i;
            glr[row * 16 + l15] = f2bf((acc[i] + o[i]) * rstd[row]);
        }
    }
    __syncthreads();
}

DI void p1_meta_job(const Params& p, unsigned char* lds, int job) {
    const int tid = opaque_tid(), lane = tid & 63, wave = tid >> 6, l15 = lane & 15, g = lane >> 4;
    int c0;
    if (job < 64) c0 = 1024 + job * 16;
    else if (job < 128) c0 = 2048 + (job - 64) * 16;
    else if (job < 160) c0 = 4608 + (job - 128) * 16;
    else if (job < 224) c0 = 5120 + (job - 160) * 16;
    else c0 = 9216;
    const bf16_t* xbm = (const bf16_t*)(p.ws + OFF_XBM);
    const bf16_t* wt = (const bf16_t*)(p.ws + OFF_WIN_T);
    const bf16_t* ap = xbm + (size_t)l15 * 1024 + wave * 128 + 8 * g;
    const bf16_t* bp = wt + (size_t)(c0 + l15) * 1024 + wave * 128 + 8 * g;
    f32x4 acc = (f32x4){0.f, 0.f, 0.f, 0.f};
#pragma unroll
    for (int ks = 0; ks < 4; ++ks) {
        const bf16x8 a = *(const bf16x8*)(ap + ks * 32), bb = *(const bf16x8*)(bp + ks * 32);
        acc = MFMA16(a, bb, acc);
    }
    f32x4* red = (f32x4*)lds;
    __syncthreads();
    red[wave * 64 + lane] = acc;
    __syncthreads();
    if (wave == 0) {
        f32x4 s = red[lane];
#pragma unroll
        for (int w = 1; w < 8; ++w) { const f32x4 t = red[w * 64 + lane]; s.x += t.x; s.y += t.y; s.z += t.z; s.w += t.w; }
        const float* rstd = (const float*)(p.ws + OFF_RSTD) + MROWS;
        const float* rope = (const float*)(p.ws + OFF_ROPE);
        unsigned char* ws = p.ws;
        const int col = c0 + l15;
#pragma unroll
        for (int i = 0; i < 4; ++i) {
            const int row = 4 * g + i;
            float v = s[i] * rstd[row];
            if (job < 64 && (c0 & 63) == 0) {
                const float other = __shfl_xor(v, 8);
                const float* cs = rope + ((size_t)row * 8 + (l15 & 7)) * 2;
                const float c = cs[0], sn = cs[1];
                v = (l15 < 8) ? (v * c - other * sn) : (v * c + other * sn);
            }
            const bf16_t val = f2bf(v);
            if (job < 64) ((bf16_t*)(ws + OFF_AKM))[(size_t)(48 + row) * 1024 + (col - 1024)] = val;
            else if (job < 128) { const int n = col - 2048; ((bf16_t*)(ws + OFF_AVTM))[(size_t)n * 64 + 48 + row] = val; }
            else if (job < 160) ((bf16_t*)(ws + OFF_GKM))[(size_t)row * 512 + (col - 4608)] = val;
            else if (job < 224) { const int n = col - 5120; ((bf16_t*)(ws + OFF_GVTM))[(size_t)n * 64 + 48 + row] = val; }
            else ((bf16_t*)(ws + OFF_GLRM))[row * 16 + l15] = val;
        }
    }
    __syncthreads();
}

DI void phase1(const Params& p, unsigned char* lds) {
    for (int j = blockIdx.x; j < 256; j += gridDim.x) p1_glr_job(p, lds, j);
    for (int j = blockIdx.x; j < 225; j += gridDim.x) p1_meta_job(p, lds, j);
    pg8::Gemm g; g.A = (const bf16_t*)(p.ws + OFF_XB); g.Bt = (const bf16_t*)(p.ws + OFF_WIN_T); g.M = MROWS; g.N = 9216; g.K = 1024;
    SchedP1 S; EpiInProj E; E.ws = p.ws; E.dout = (unsigned char*)p.out;
    pg8::gemm_phase<EpiInProj, SchedP1, true, true>((PG8_LAS unsigned char*)lds, g, S, E);
}

DI void phase15(const Params& p, unsigned char* lds) {
    const int tid = opaque_tid(), col = tid;
    float w2[16];
#pragma unroll
    for (int j = 0; j < 16; ++j) w2[j] = p.gate_w2[j * 512 + col];
    const float bias = p.gate_b[col];
    unsigned char* ws = p.ws;
    unsigned char* dout = (unsigned char*)p.out;
    for (int item = blockIdx.x; item < 257; item += gridDim.x) {
        const bool meta = item == 256;
        const int b = item >> 6, c = item & 63;
        const size_t row0 = (size_t)b * 4096 + c * 64;
        const bf16_t* glr = meta ? (const bf16_t*)(ws + OFF_GLRM) : (const bf16_t*)(ws + OFF_GLR) + row0 * 16;
        const int nrows = meta ? 16 : 64;
        bf16_t* qp = (bf16_t*)(dout + DO_GQ) + row0 * 512 + col;
        const bf16_t* kin = meta ? (const bf16_t*)(ws + OFF_GKM) + col : (const bf16_t*)(dout + DO_GK) + row0 * 512 + col;
        bf16_t* kout = meta ? (bf16_t*)(ws + OFF_KTM) + 48 * 512 + col : (bf16_t*)(dout + DO_GK) + row0 * 512 + col;
        bf16_t* ktt = meta ? (bf16_t*)(ws + OFF_KTTM) + (size_t)col * 64 + 48 : (bf16_t*)(ws + OFF_WIN_T) + ((size_t)b * 512 + col) * 4096 + c * 64;
        __syncthreads();
        if (tid < nrows * 2) ((u32x4*)lds)[tid] = ((const u32x4*)glr)[tid];
        __syncthreads();
        float bsum = 0.f;
        bf16_t kc[8], qc[8], kn[8], qn[8];
#pragma unroll
        for (int rr = 0; rr < 8; ++rr) { kc[rr] = kin[(size_t)rr * 512]; qc[rr] = meta ? (bf16_t)0 : qp[(size_t)rr * 512]; }
        for (int r0 = 0; r0 < nrows; r0 += 8) {
            if (r0 + 8 < nrows) {
#pragma unroll
                for (int rr = 0; rr < 8; ++rr) { kn[rr] = kin[(size_t)(r0 + 8 + rr) * 512]; qn[rr] = meta ? (bf16_t)0 : qp[(size_t)(r0 + 8 + rr) * 512]; }
            }
            float kt8[8];
#pragma unroll
            for (int rr = 0; rr < 8; ++rr) {
                const int r = r0 + rr;
                const u32x4* g4 = (const u32x4*)(lds + r * 32);
                const u32x4 ga = g4[0], gb = g4[1];
                float gk = bias;
                gk += bflo(ga.x) * w2[0] + bfhi(ga.x) * w2[1] + bflo(ga.y) * w2[2] + bfhi(ga.y) * w2[3];
                gk += bflo(ga.z) * w2[4] + bfhi(ga.z) * w2[5] + bflo(ga.w) * w2[6] + bfhi(ga.w) * w2[7];
                gk += bflo(gb.x) * w2[8] + bfhi(gb.x) * w2[9] + bflo(gb.y) * w2[10] + bfhi(gb.y) * w2[11];
                gk += bflo(gb.z) * w2[12] + bfhi(gb.z) * w2[13] + bflo(gb.w) * w2[14] + bfhi(gb.w) * w2[15];
                const float lg = (fminf(gk, 0.f) - __logf(1.0f + __expf(-fabsf(gk)))) * (1.0f / 16.0f);
                bsum += lg;
                const float eb = __expf(bsum);
                const float kt = bf2f(kc[rr]) * __builtin_amdgcn_rcpf(eb);
                kt8[rr] = kt;
                kout[(size_t)r * 512] = f2bf(kt);
                if (!meta) qp[(size_t)r * 512] = f2bf(bf2f(qc[rr]) * 0.08838834764831845f * eb);
            }
            u32x4 o; o.x = pk2(kt8[0], kt8[1]); o.y = pk2(kt8[2], kt8[3]); o.z = pk2(kt8[4], kt8[5]); o.w = pk2(kt8[6], kt8[7]);
            *(u32x4*)(ktt + r0) = o;
#pragma unroll
            for (int rr = 0; rr < 8; ++rr) { kc[rr] = kn[rr]; qc[rr] = qn[rr]; }
        }
        if (meta) {
            ((float*)(ws + OFF_DECM))[col] = expf(bsum);
            bf16_t* km = (bf16_t*)(ws + OFF_KTM);
            for (int r = 0; r < 48; ++r) km[r * 512 + col] = 0;
            u32x4 z = {0u, 0u, 0u, 0u};
            u32x4* kz = (u32x4*)((bf16_t*)(ws + OFF_KTTM) + (size_t)col * 64);
#pragma unroll
            for (int j = 0; j < 6; ++j) kz[j] = z;
        } else {
            ((float*)(ws + OFF_DEC))[((size_t)b * 64 + c) * 512 + col] = expf(bsum);
        }
    }
}

constexpr int A_KROWB = 272, A_VROWB = 144, A_KB = 64 * A_KROWB, A_VB = 128 * A_VROWB, A_STAGE = A_KB + A_VB;
DI void attn_tile(const unsigned char* sK, const unsigned char* sV, int tt, int qb, int qs, int sub, int l31, int h,
                  const bf16x8 (&qf)[4], f32x16 (&O)[4], float& m, float& l) {
    const float SC = 0.125f * 1.4426950408889634f;
    f32x16 st[2];
#pragma unroll
    for (int k2 = 0; k2 < 2; ++k2)
#pragma unroll
        for (int i = 0; i < 16; ++i) st[k2][i] = 0.f;
#pragma unroll
    for (int k2 = 0; k2 < 2; ++k2)
#pragma unroll
        for (int ks = 0; ks < 4; ++ks) {
            const bf16x8 kf = *(const bf16x8*)(sK + (k2 * 32 + l31) * A_KROWB + (sub * 64 + ks * 16 + 8 * h) * 2);
            st[k2] = MFMA32(kf, qf[ks], st[k2]);
        }
    if (tt == 0) {
#pragma unroll
        for (int i = 0; i < 16; ++i) { st[0][i] = -INFINITY; if (i < 8) st[1][i] = -INFINITY; }
    } else if (tt >= 2 * qb + 1) {
        const int kbase = (tt - 1) * 64 + 4 * h;
#pragma unroll
        for (int k2 = 0; k2 < 2; ++k2)
#pragma unroll
            for (int i = 0; i < 16; ++i) {
                const int key = kbase + k2 * 32 + (i & 3) + 8 * (i >> 2);
                if (key > qs) st[k2][i] = -INFINITY;
            }
    }
    float mx = -INFINITY;
#pragma unroll
    for (int k2 = 0; k2 < 2; ++k2)
#pragma unroll
        for (int i = 0; i < 16; ++i) mx = fmaxf(mx, st[k2][i]);
    mx = fmaxf(mx, __shfl_xor(mx, 32));
    const float mnew = fmaxf(m, mx);
    const float alpha = __builtin_amdgcn_exp2f((m - mnew) * SC);
    const float mc = mnew * SC;
    m = mnew;
    float ps = 0.f;
#pragma unroll
    for (int k2 = 0; k2 < 2; ++k2)
#pragma unroll
        for (int i = 0; i < 16; ++i) { const float pv = __builtin_amdgcn_exp2f(st[k2][i] * SC - mc); st[k2][i] = pv; ps += pv; }
    l = l * alpha + ps;
#pragma unroll
    for (int d = 0; d < 4; ++d)
#pragma unroll
        for (int i = 0; i < 16; ++i) O[d][i] *= alpha;
    bf16x8 pb[4];
#pragma unroll
    for (int k4 = 0; k4 < 4; ++k4) {
        const int k2 = k4 >> 1, o8 = 8 * (k4 & 1);
        u32x4 pk;
        pk.x = pk2(st[k2][o8 + 0], st[k2][o8 + 1]); pk.y = pk2(st[k2][o8 + 2], st[k2][o8 + 3]);
        pk.z = pk2(st[k2][o8 + 4], st[k2][o8 + 5]); pk.w = pk2(st[k2][o8 + 6], st[k2][o8 + 7]);
        pb[k4] = __builtin_bit_cast(bf16x8, pk);
    }
#pragma unroll
    for (int d = 0; d < 4; ++d)
#pragma unroll
        for (int k4 = 0; k4 < 4; ++k4) {
            const bf16x8 vv = *(const bf16x8*)(sV + (d * 32 + l31) * A_VROWB + k4 * 32 + 16 * h);
            O[d] = MFMA32(vv, pb[k4], O[d]);
        }
}

DI void attn_item(const Params& p, unsigned char* lds, int b, int hd, int qb) {
    const int tid = opaque_tid(), lane = tid & 63, wave = tid >> 6, l31 = lane & 31, h = lane >> 5;
    const int sub = wave >> 2, rt = wave & 3;
    const bf16_t* aq = (const bf16_t*)((unsigned char*)p.out + DO_AQ);
    const bf16_t* ak = (const bf16_t*)(p.ws + OFF_AK);
    const bf16_t* avT = (const bf16_t*)(p.ws + OFF_AVT);
    const bf16_t* akm = (const bf16_t*)(p.ws + OFF_AKM);
    const bf16_t* avTm = (const bf16_t*)(p.ws + OFF_AVTM);
    bf16_t* az = (bf16_t*)(p.ws + OFF_AZ);
    const int qs = qb * 128 + rt * 32 + l31;
    const size_t grow = (size_t)b * 4096 + qs;
    bf16x8 qf[4];
#pragma unroll
    for (int ks = 0; ks < 4; ++ks) qf[ks] = *(const bf16x8*)(aq + grow * 1024 + hd * 128 + sub * 64 + ks * 16 + 8 * h);
    f32x16 O[4];
#pragma unroll
    for (int d = 0; d < 4; ++d)
#pragma unroll
        for (int i = 0; i < 16; ++i) O[d][i] = 0.f;
    float m = -INFINITY, l = 0.f;
    const int T = 2 * qb + 3;
    u32x4 k0r[2], v0r[2];
    const int krow_ = tid >> 4, kc_ = tid & 15, vdv_ = tid >> 3, vc_ = tid & 7;
    const bf16_t* kp = ak + ((size_t)b * 4096 + krow_) * 1024 + hd * 128 + kc_ * 8;
    const bf16_t* vp_ = avT + ((size_t)(b * 8 + hd) * 128 + vdv_) * 4096 + vc_ * 8;
#define A_LOAD_REAL(KR, VR)                                                                                                   \
    {                                                                                                                         \
        KR[0] = *(const u32x4*)kp; KR[1] = *(const u32x4*)(kp + 32 * 1024); kp += 64 * 1024;                                  \
        VR[0] = *(const u32x4*)vp_; VR[1] = *(const u32x4*)(vp_ + (size_t)64 * 4096); vp_ += 64;                              \
    }
#define A_STORE(KR, VR, buf_)                                                                                                 \
    {                                                                                                                         \
        unsigned char* sK_ = lds + (buf_) * A_STAGE; unsigned char* sV_ = sK_ + A_KB;                                         \
        _Pragma("unroll") for (int i = 0; i < 2; ++i) { const int pi = tid + 512 * i, row = pi >> 4, c = pi & 15;              \
            *(u32x4*)(sK_ + row * A_KROWB + c * 16) = KR[i]; }                                                                \
        _Pragma("unroll") for (int i = 0; i < 2; ++i) { const int pi = tid + 512 * i, dv = pi >> 3, c = pi & 7;                \
            unsigned char* d_ = sV_ + dv * A_VROWB + (c >> 1) * 32 + 8 * (c & 1); u32x2 a_, b_; a_.x = VR[i].x; a_.y = VR[i].y; b_.x = VR[i].z; b_.y = VR[i].w; \
            *(u32x2*)d_ = a_; *(u32x2*)(d_ + 16) = b_; }                                                                      \
    }
    {
        const bf16_t* km_ = akm + (size_t)krow_ * 1024 + hd * 128 + kc_ * 8;
        k0r[0] = *(const u32x4*)km_; k0r[1] = *(const u32x4*)(km_ + 32 * 1024);
        const bf16_t* vm_ = avTm + (size_t)(hd * 128 + vdv_) * 64 + vc_ * 8;
        v0r[0] = *(const u32x4*)vm_; v0r[1] = *(const u32x4*)(vm_ + 64 * 64);
    }
    A_STORE(k0r, v0r, 0);
    __syncthreads();
    for (int tt = 0; tt < T; ++tt) {
        if (tt + 1 < T) A_LOAD_REAL(k0r, v0r);
        attn_tile(lds + (tt & 1) * A_STAGE, lds + (tt & 1) * A_STAGE + A_KB, tt, qb, qs, sub, l31, h, qf, O, m, l);
        if (tt + 1 < T) A_STORE(k0r, v0r, (tt + 1) & 1);
        __syncthreads();
    }
#undef A_LOAD_REAL
#undef A_STORE
    float lam;
    {
        const float a_ = wave_sum(p.lq1[lane] * p.lk1[lane]);
        const float b_ = wave_sum(p.lq2[lane] * p.lk2[lane]);
        lam = expf(a_) - expf(b_) + 0.2f;
    }
    const float ltot = l + __shfl_xor(l, 32);
    const float linv = 1.0f / ltot;
    float* ex = (float*)lds;
    if (sub == 1) {
#pragma unroll
        for (int d = 0; d < 4; ++d)
#pragma unroll
            for (int i = 0; i < 16; ++i) { ex[(rt * 32 + l31) * 129 + d * 32 + (i & 3) + 8 * (i >> 2) + 4 * h] = O[d][i] * linv; if (i == 15) __builtin_amdgcn_sched_barrier(0); }
    }
    __syncthreads();
    if (sub == 0) {
        float ss = 0.f;
#pragma unroll
        for (int d = 0; d < 4; ++d)
#pragma unroll
            for (int i = 0; i < 16; ++i) {
                const float o2 = ex[(rt * 32 + l31) * 129 + d * 32 + (i & 3) + 8 * (i >> 2) + 4 * h];
                const float o = O[d][i] * linv - lam * o2;
                O[d][i] = o; ss += o * o;
                if (i == 15) __builtin_amdgcn_sched_barrier(0);
            }
        ss += __shfl_xor(ss, 32);
        const float rstd = 1.0f / sqrtf(ss * (1.0f / 128.0f) + EPS);
#pragma unroll
        for (int d = 0; d < 4; ++d)
#pragma unroll
            for (int g = 0; g < 4; ++g) {
                bf16_t* zp = az + grow * 1024 + hd * 128 + d * 32 + 8 * g + 4 * h;
                const u32x2 zz = *(const u32x2*)zp;
                u32x2 o;
                o.x = pk2(O[d][4 * g] * rstd * siluf_(bflo(zz.x)), O[d][4 * g + 1] * rstd * siluf_(bfhi(zz.x)));
                o.y = pk2(O[d][4 * g + 2] * rstd * siluf_(bflo(zz.y)), O[d][4 * g + 3] * rstd * siluf_(bfhi(zz.y)));
                *(u32x2*)zp = o;
                if (g == 3) __builtin_amdgcn_sched_barrier(0);
            }
    }
    __syncthreads();
}

constexpr int L_KROWB = 272, L_VROWB = 144, L_SROWB = 272;
constexpr int GLA_DL = 4;
#define L_BAR() { asm volatile("s_waitcnt lgkmcnt(0)" ::: "memory"); __builtin_amdgcn_s_barrier(); asm volatile("" ::: "memory"); }
template <int DL>
DI void gla_item(const Params& p, unsigned char* lds, int b, int hh, int sl) {
    constexpr int SLW = 32 * DL, NVP = SLW / 64;
    constexpr int L_K = 0, L_V = 64 * L_KROWB, L_S = L_V + SLW * L_VROWB;
    const int tid = opaque_tid(), lane = tid & 63, wave = tid >> 6, l15 = lane & 15, g = lane >> 4;
    const int tt = wave & 3, dvt = wave >> 2;
    unsigned char* ws = p.ws;
    unsigned char* dout = (unsigned char*)p.out;
    const bf16_t* gq = (const bf16_t*)(dout + DO_GQ);
    const bf16_t* gk = (const bf16_t*)(dout + DO_GK);
    const bf16_t* gvT = (const bf16_t*)(ws + OFF_GVT);
    const bf16_t* ktt = (const bf16_t*)(ws + OFF_WIN_T);
    const float* dec = (const float*)(ws + OFF_DEC);
    bf16_t* gz = (bf16_t*)(ws + OFF_GZ);
    float* ssqb = (float*)(ws + OFF_SSQB);
    unsigned char* sK = lds + L_K; unsigned char* sV = lds + L_V; unsigned char* sS = lds + L_S;
    for (int i = tid; i < SLW * L_SROWB / 4; i += 512) ((unsigned*)sS)[i] = 0u;
    f32x4 sacc[DL][2];
#pragma unroll
    for (int dl = 0; dl < DL; ++dl)
#pragma unroll
        for (int c = 0; c < 2; ++c) sacc[dl][c] = (f32x4){0.f, 0.f, 0.f, 0.f};
    u32x4 nk[2]; u32x4 nv[NVP]; bf16x8 nq[4]; bf16x8 nkt[2][2]; float nd[2]; u32x2 ngz[DL];
    const int cc0 = 16 * (2 * tt) + l15;
    const int dv0 = 16 * (dvt * DL);
    const int krow_ = tid >> 4, kc_ = tid & 15, vdv_ = tid >> 3, vc_ = tid & 7;
    const bf16_t* kp = gk + ((size_t)b * 4096 + krow_) * 512 + hh * 128 + kc_ * 8;
    const bf16_t* vp_ = gvT + ((size_t)(b * 4 + hh) * 256 + sl * SLW + vdv_) * 4096 + vc_ * 8;
    const bf16_t* ktp = ktt + ((size_t)(b * 4 + hh) * 128 + cc0) * 4096 + 8 * g;
    const float* dp = dec + (size_t)b * 64 * 512 + hh * 128 + cc0;
    const bf16_t* qp = gq + ((size_t)b * 4096 + 16 * tt + l15) * 512 + hh * 128 + 8 * g;
    bf16_t* gzp = gz + ((size_t)b * 4096 + 16 * tt + l15) * 1024 + hh * 256 + sl * SLW + dv0 + 4 * g;
#define L_LOAD_META()                                                                                                         \
    {                                                                                                                         \
        const bf16_t* km_ = (const bf16_t*)(ws + OFF_KTM) + (size_t)krow_ * 512 + hh * 128 + kc_ * 8;                         \
        nk[0] = *(const u32x4*)km_; nk[1] = *(const u32x4*)(km_ + 32 * 512);                                                  \
        _Pragma("unroll") for (int i = 0; i < NVP; ++i)                                                                       \
            nv[i] = *(const u32x4*)((const bf16_t*)(ws + OFF_GVTM) + (size_t)(hh * 256 + sl * SLW + vdv_ + 64 * i) * 64 + vc_ * 8); \
        _Pragma("unroll") for (int ct = 0; ct < 2; ++ct) _Pragma("unroll") for (int ks = 0; ks < 2; ++ks)                     \
            nkt[ct][ks] = *(const bf16x8*)((const bf16_t*)(ws + OFF_KTTM) + (size_t)(hh * 128 + cc0 + 16 * ct) * 64 + 32 * ks + 8 * g); \
        _Pragma("unroll") for (int ct = 0; ct < 2; ++ct) nd[ct] = ((const float*)(ws + OFF_DECM))[hh * 128 + cc0 + 16 * ct];  \
        _Pragma("unroll") for (int ks = 0; ks < 4; ++ks) nq[ks] = (bf16x8){0, 0, 0, 0, 0, 0, 0, 0};                           \
        _Pragma("unroll") for (int dl = 0; dl < DL; ++dl) ngz[dl] = (u32x2){0u, 0u};                                          \
    }
#define L_LOAD_REAL()                                                                                                         \
    {                                                                                                                         \
        nk[0] = *(const u32x4*)kp; nk[1] = *(const u32x4*)(kp + 32 * 512); kp += 64 * 512;                                    \
        _Pragma("unroll") for (int i = 0; i < NVP; ++i) nv[i] = *(const u32x4*)(vp_ + (size_t)(64 * i) * 4096);               \
        vp_ += 64;                                                                                                            \
        _Pragma("unroll") for (int ct = 0; ct < 2; ++ct) _Pragma("unroll") for (int ks = 0; ks < 2; ++ks)                     \
            nkt[ct][ks] = *(const bf16x8*)(ktp + (size_t)(16 * ct) * 4096 + 32 * ks);                                         \
        ktp += 64;                                                                                                            \
        nd[0] = dp[0]; nd[1] = dp[16]; dp += 512;                                                                             \
        _Pragma("unroll") for (int ks = 0; ks < 4; ++ks) nq[ks] = *(const bf16x8*)(qp + 32 * ks);                             \
        qp += 64 * 512;                                                                                                       \
        _Pragma("unroll") for (int dl = 0; dl < DL; ++dl) ngz[dl] = *(const u32x2*)(gzp + 16 * dl);                           \
        gzp += 64 * 1024;                                                                                                     \
    }
#define L_STORE()                                                                                                             \
    {                                                                                                                         \
        _Pragma("unroll") for (int i = 0; i < 2; ++i) { const int pi = tid + 512 * i, row = pi >> 4, c = pi & 15;              \
            *(u32x4*)(sK + row * L_KROWB + c * 16) = nk[i]; }                                                                 \
        _Pragma("unroll") for (int i = 0; i < NVP; ++i) *(u32x4*)(sV + (vdv_ + 64 * i) * L_VROWB + vc_ * 16) = nv[i];          \
    }
    L_LOAD_META();
    L_STORE();
    for (int n = 0; n <= 64; ++n) {
        bf16x8 cq[4], ckt[2][2]; float cd[2]; u32x2 cgz[DL];
#pragma unroll
        for (int ks = 0; ks < 4; ++ks) cq[ks] = nq[ks];
#pragma unroll
        for (int ct = 0; ct < 2; ++ct) { cd[ct] = nd[ct]; ckt[ct][0] = nkt[ct][0]; ckt[ct][1] = nkt[ct][1]; }
#pragma unroll
        for (int dl = 0; dl < DL; ++dl) cgz[dl] = ngz[dl];
        L_BAR();
        if (n + 1 <= 64) L_LOAD_REAL();
        if (n > 0) {
            f32x4 at[4];
#pragma unroll
            for (int jt = 0; jt < 4; ++jt) at[jt] = (f32x4){0.f, 0.f, 0.f, 0.f};
#pragma unroll
            for (int jt = 0; jt < 4; ++jt)
#pragma unroll
                for (int ks = 0; ks < 4; ++ks) {
                    const bf16x8 kf = *(const bf16x8*)(sK + (jt * 16 + l15) * L_KROWB + (ks * 32 + 8 * g) * 2);
                    at[jt] = MFMA16(kf, cq[ks], at[jt]);
                }
            const int tl = 16 * tt + l15;
#pragma unroll
            for (int jt = 0; jt < 4; ++jt)
#pragma unroll
                for (int i = 0; i < 4; ++i) if (16 * jt + 4 * g + i > tl) at[jt][i] = 0.f;
            bf16x8 pa[2];
#pragma unroll
            for (int s2 = 0; s2 < 2; ++s2) {
                u32x4 t;
                t.x = pk2(at[2 * s2][0], at[2 * s2][1]); t.y = pk2(at[2 * s2][2], at[2 * s2][3]);
                t.z = pk2(at[2 * s2 + 1][0], at[2 * s2 + 1][1]); t.w = pk2(at[2 * s2 + 1][2], at[2 * s2 + 1][3]);
                pa[s2] = __builtin_bit_cast(bf16x8, t);
            }
            const size_t row = (size_t)b * 4096 + (n - 1) * 64 + 16 * tt + l15;
#pragma unroll
            for (int dl = 0; dl < DL; ++dl) {
                const int dvr = dv0 + 16 * dl + l15;
                f32x4 o = (f32x4){0.f, 0.f, 0.f, 0.f};
#pragma unroll
                for (int s2 = 0; s2 < 2; ++s2) {
                    const unsigned char* vp = sV + dvr * L_VROWB + (32 * s2 + 4 * g) * 2;
                    const u32x2 lo = *(const u32x2*)vp, hi = *(const u32x2*)(vp + 32);
                    u32x4 vv; vv.x = lo.x; vv.y = lo.y; vv.z = hi.x; vv.w = hi.y;
                    o = MFMA16(__builtin_bit_cast(bf16x8, vv), pa[s2], o);
                }
#pragma unroll
                for (int ks = 0; ks < 4; ++ks) {
                    const bf16x8 sf = *(const bf16x8*)(sS + dvr * L_SROWB + (ks * 32 + 8 * g) * 2);
                    o = MFMA16(sf, cq[ks], o);
                }
                float ss = (o[0] * o[0] + o[1] * o[1]) + (o[2] * o[2] + o[3] * o[3]);
                ss += __shfl_xor(ss, 16); ss += __shfl_xor(ss, 32);
                u32x2 ov;
                ov.x = pk2(o[0] * siluf_(bflo(cgz[dl].x)), o[1] * siluf_(bfhi(cgz[dl].x)));
                ov.y = pk2(o[2] * siluf_(bflo(cgz[dl].y)), o[3] * siluf_(bfhi(cgz[dl].y)));
                *(u32x2*)(gz + row * 1024 + hh * 256 + sl * SLW + dv0 + 16 * dl + 4 * g) = ov;
                if (g == 0) ssqb[(row * 4 + hh) * 16 + sl * 2 * DL + dvt * DL + dl] = ss;
            }
        }
#pragma unroll
        for (int dl = 0; dl < DL; ++dl) {
#pragma unroll
            for (int ks = 0; ks < 2; ++ks) {
                const bf16x8 vf = *(const bf16x8*)(sV + (dv0 + 16 * dl + l15) * L_VROWB + (32 * ks + 8 * g) * 2);
                sacc[dl][0] = MFMA16(vf, ckt[0][ks], sacc[dl][0]);
                sacc[dl][1] = MFMA16(vf, ckt[1][ks], sacc[dl][1]);
            }
#pragma unroll
            for (int ct = 0; ct < 2; ++ct)
#pragma unroll
                for (int i = 0; i < 4; ++i) sacc[dl][ct][i] *= cd[ct];
        }
        L_BAR();
#pragma unroll
        for (int dl = 0; dl < DL; ++dl)
#pragma unroll
            for (int ct = 0; ct < 2; ++ct)
#pragma unroll
                for (int i = 0; i < 4; ++i)
                    *(bf16_t*)(sS + (dv0 + 16 * dl + 4 * g + i) * L_SROWB + (cc0 + 16 * ct) * 2) = f2bf(sacc[dl][ct][i]);
        if (n + 1 <= 64) L_STORE();
    }
#undef L_LOAD_META
#undef L_LOAD_REAL
#undef L_STORE
    __syncthreads();
}

DI void phase2(const Params& p, unsigned char* lds) {
    const int tid = opaque_tid();
    volatile unsigned* sItem = (volatile unsigned*)(lds + LDS_ITEM);
    constexpr unsigned NSL = 8 / GLA_DL, N_GLA = 2 * NSL, N_ATT = 128;
    if (tid == 0) sItem[1] = 0u;
    for (;;) {
        if (tid == 0) {
            unsigned* heads = (unsigned*)(p.ws + OFF_CTR);
            const unsigned x0 = (unsigned)__builtin_amdgcn_s_getreg((3 << 11) | 20) & 7u;
            unsigned k = sItem[1], it = 0xffffffffu;
            while (k < 8u) {
                const unsigned x = (x0 + k) & 7u;
                const unsigned got = atomicAdd(heads + x, 1u);
                if (got < N_GLA + N_ATT) { it = got | (x << 16); break; }
                ++k;
            }
            sItem[1] = k; sItem[0] = it;
        }
        __syncthreads();
        const unsigned item = (unsigned)__builtin_amdgcn_readfirstlane((int)sItem[0]);
        __syncthreads();
        if (item == 0xffffffffu) break;
        const unsigned x = item >> 16, idx = item & 0xffffu;
        if (idx < N_GLA) { const unsigned gi = x * N_GLA + idx; gla_item<GLA_DL>(p, lds, gi / (4 * NSL), (gi / NSL) & 3, gi % NSL); }
        else { const unsigned a = idx - N_GLA, pair = 4 * x + (a >> 5); attn_item(p, lds, pair & 3, pair >> 2, 31 - (int)(a & 31)); }
    }
}

DI void phase25(const Params& p, unsigned char* lds) {
    const int tid = opaque_tid(), lane = tid & 63, wave = tid >> 6;
    const float* ssqb = (const float*)(p.ws + OFF_SSQB);
    bf16_t* gz = (bf16_t*)(p.ws + OFF_GZ);
    for (int it = blockIdx.x; it < MROWS / 8; it += gridDim.x) {
        const size_t row = (size_t)it * 8 + wave;
        float s = ssqb[(row * 4 + (lane >> 4)) * 16 + (lane & 15)];
        s += __shfl_xor(s, 1); s += __shfl_xor(s, 2); s += __shfl_xor(s, 4); s += __shfl_xor(s, 8);
        const float r = 1.0f / sqrtf(s * (1.0f / 256.0f) + EPS);
        u32x4* ptr = (u32x4*)(gz + row * 1024 + lane * 16);
#pragma unroll
        for (int j = 0; j < 2; ++j) {
            u32x4 u = ptr[j], o;
            o.x = pk2(bflo(u.x) * r, bfhi(u.x) * r); o.y = pk2(bflo(u.y) * r, bfhi(u.y) * r);
            o.z = pk2(bflo(u.z) * r, bfhi(u.z) * r); o.w = pk2(bflo(u.w) * r, bfhi(u.w) * r);
            ptr[j] = o;
        }
    }
}

template <int PASS>
struct EpiMerge {
    static constexpr bool PERM = false, AFTER_DRAIN = false;
    unsigned char* ws;
    DI void operator()(const pg8::f32x4 (&acc)[2][2][4][2], const pg8::Unit& u, int wr, int wc, int fr, int fq) const {
        const unsigned char* sg = ws + (PASS == 0 ? OFF_SGB : OFF_SGA);
        bf16_t* merged = (bf16_t*)(ws + OFF_AK);
#pragma unroll
        for (int ai = 0; ai < 2; ++ai)
#pragma unroll
            for (int m = 0; m < 4; ++m) {
                const size_t tok = (size_t)u.pm * 256 + ai * 128 + wr * 64 + m * 16 + fr;
#pragma unroll
                for (int bj = 0; bj < 2; ++bj)
#pragma unroll
                    for (int n = 0; n < 2; ++n) {
                        const size_t off = tok * 1024 + u.pn * 256 + bj * 128 + wc * 32 + n * 16 + 4 * fq;
                        const unsigned ug = *(const unsigned*)(sg + off);
                        const float q = 1.0f / 255.0f;
                        float m0 = (float)(ug & 255u) * q * acc[ai][bj][m][n][0], m1 = (float)((ug >> 8) & 255u) * q * acc[ai][bj][m][n][1];
                        float m2 = (float)((ug >> 16) & 255u) * q * acc[ai][bj][m][n][2], m3 = (float)(ug >> 24) * q * acc[ai][bj][m][n][3];
                        if (PASS == 1) { const u32x2 t = *(const u32x2*)(merged + off); m0 += bflo(t.x); m1 += bfhi(t.x); m2 += bflo(t.y); m3 += bfhi(t.y); }
                        u32x2 o; o.x = pk2(m0, m1); o.y = pk2(m2, m3);
                        *(u32x2*)(merged + off) = o;
                    }
            }
    }
};
struct EpiOut {
    static constexpr bool PERM = false, AFTER_DRAIN = true;
    unsigned char* ws; const float* x; float* out; const float* fw;
    DI void fused(pg8::f32x4 (&acc)[2][2][4][2], const pg8::Unit& u, int wr, int wc, int fr, int fq, PG8_LAS unsigned char* lds, int wid, int lane) const {
        float* ssqh = (float*)(ws + OFF_SSQH);
        unsigned* pcnt = (unsigned*)(ws + OFF_XBAR + 14336) + u.pm;
#pragma unroll
        for (int ai = 0; ai < 2; ++ai)
#pragma unroll
            for (int m = 0; m < 4; ++m) {
                const size_t tok = (size_t)u.pm * 256 + ai * 128 + wr * 64 + m * 16 + fr;
                float ss = 0.f;
#pragma unroll
                for (int bj = 0; bj < 2; ++bj)
#pragma unroll
                    for (int n = 0; n < 2; ++n) {
                        const size_t off = tok * 1024 + u.pn * 256 + bj * 128 + wc * 32 + n * 16 + 4 * fq;
                        const f32x4 xv = *(const f32x4*)(x + off);
                        f32x4 o = acc[ai][bj][m][n];
                        o.x += xv.x; o.y += xv.y; o.z += xv.z; o.w += xv.w;
                        acc[ai][bj][m][n] = o;
                        ss += (o.x * o.x + o.y * o.y) + (o.z * o.z + o.w * o.w);
                    }
                ss += __shfl_xor(ss, 16); ss += __shfl_xor(ss, 32);
                if (fq == 0) ssqh[tok * 16 + u.pn * 4 + wc] = ss;
            }
        asm volatile("s_waitcnt vmcnt(0)" ::: "memory");
        __syncthreads();
        if (threadIdx.x == 0) {
            __builtin_amdgcn_fence(__ATOMIC_RELEASE, "agent");
            asm volatile("s_waitcnt vmcnt(0)" ::: "memory");
            __hip_atomic_fetch_add(pcnt, 1u, __ATOMIC_RELAXED, __HIP_MEMORY_SCOPE_AGENT);
            unsigned spins = 0u;
            while (__hip_atomic_load(pcnt, __ATOMIC_RELAXED, __HIP_MEMORY_SCOPE_AGENT) < 4u && ++spins < (1u << 22)) __builtin_amdgcn_s_sleep(1);
            __builtin_amdgcn_fence(__ATOMIC_ACQUIRE, "agent");
            asm volatile("s_waitcnt vmcnt(0)" ::: "memory");
        }
        __syncthreads();
#pragma unroll
        for (int ai = 0; ai < 2; ++ai)
#pragma unroll
            for (int m = 0; m < 4; ++m) {
                const size_t tok = (size_t)u.pm * 256 + ai * 128 + wr * 64 + m * 16 + fr;
                const f32x4* sp = (const f32x4*)(ssqh + tok * 16);
                const f32x4 a = sp[0], b2 = sp[1], c = sp[2], d = sp[3];
                const float s = ((a.x + a.y) + (a.z + a.w)) + ((b2.x + b2.y) + (b2.z + b2.w)) + ((c.x + c.y) + (c.z + c.w)) + ((d.x + d.y) + (d.z + d.w));
                const float rstd = 1.0f / sqrtf(s * (1.0f / 1024.0f) + EPS);
#pragma unroll
                for (int bj = 0; bj < 2; ++bj)
#pragma unroll
                    for (int n = 0; n < 2; ++n) {
                        const int col = u.pn * 256 + bj * 128 + wc * 32 + n * 16 + 4 * fq;
                        const f32x4 w = *(const f32x4*)(fw + col);
                        f32x4 o = acc[ai][bj][m][n];
                        o.x = o.x * rstd * w.x; o.y = o.y * rstd * w.y; o.z = o.z * rstd * w.z; o.w = o.w * rstd * w.w;
                        *(f32x4*)(out + tok * 1024 + col) = o;
                    }
            }
    }
};
DI void phase3(const Params& p, unsigned char* lds) {
    SchedSq S;
    {
        pg8::Gemm g; g.A = (const bf16_t*)(p.ws + OFF_GZ); g.Bt = (const bf16_t*)(p.ws + OFF_WB_T); g.M = MROWS; g.N = 1024; g.K = 1024;
        EpiMerge<0> E; E.ws = p.ws;
        pg8::gemm_phase<EpiMerge<0>, SchedSq, true, true>((PG8_LAS unsigned char*)lds, g, S, E);
    }
    {
        pg8::Gemm g; g.A = (const bf16_t*)(p.ws + OFF_AZ); g.Bt = (const bf16_t*)(p.ws + OFF_WA_T); g.M = MROWS; g.N = 1024; g.K = 1024;
        EpiMerge<1> E; E.ws = p.ws;
        pg8::gemm_phase<EpiMerge<1>, SchedSq, true, true>((PG8_LAS unsigned char*)lds, g, S, E);
    }
}
DI void phase4(const Params& p, unsigned char* lds) {
    SchedSq S;
    pg8::Gemm g; g.A = (const bf16_t*)(p.ws + OFF_AK); g.Bt = (const bf16_t*)(p.ws + OFF_WO_T); g.M = MROWS; g.N = 1024; g.K = 1024;
    EpiOut E; E.ws = p.ws; E.x = p.x; E.out = p.out; E.fw = p.final_w;
    pg8::gemm_phase<EpiOut, SchedSq, false, true>((PG8_LAS unsigned char*)lds, g, S, E);
}

DI void phase5(const Params& p, unsigned char* lds) {
    const int tid = opaque_tid(), lane = tid & 63, wave = tid >> 6;
    const float* ssqh = (const float*)(p.ws + OFF_SSQH);
    for (int it = blockIdx.x; it < MROWS / 8; it += gridDim.x) {
        const size_t row = (size_t)it * 8 + wave;
        float s = lane < 16 ? ssqh[row * 16 + lane] : 0.f;
        s = wave_sum(s);
        const float rstd = 1.0f / sqrtf(s * (1.0f / 1024.0f) + EPS);
        f32x4* orow = (f32x4*)(p.out + row * 1024) + lane;
        const f32x4* wrow = (const f32x4*)p.final_w + lane;
#pragma unroll
        for (int j = 0; j < 4; ++j) {
            f32x4 v = orow[64 * j]; const f32x4 w = wrow[64 * j];
            v.x = v.x * rstd * w.x; v.y = v.y * rstd * w.y; v.z = v.z * rstd * w.z; v.w = v.w * rstd * w.w;
            orow[64 * j] = v;
        }
    }
}

#define XB_TMO      128
#define XB_XCNT(j)  (256  + 64 * (j))
#define XB_XSUB(j)  (1280 + 64 * (j))
#define XB_XGEN(j)  (2304 + 64 * (j))
#define XB_TOP      3328
#define XB_TOPGEN   3392
#define XCD_BAR_WORDS 3456
#define XB_SPIN_CAP (1u << 18)
#define LAS __attribute__((address_space(3)))
DI unsigned xb_ld(unsigned* p)              { return __hip_atomic_load(p, __ATOMIC_RELAXED, __HIP_MEMORY_SCOPE_AGENT); }
DI unsigned xb_add(unsigned* p, unsigned v) { return __hip_atomic_fetch_add(p, v, __ATOMIC_RELAXED, __HIP_MEMORY_SCOPE_AGENT); }
DI unsigned xb_xcc_id() { return (unsigned)__builtin_amdgcn_s_getreg((3 << 11) | 20) & 0xFu; }
#define XB_SPIN(cond, bar) do { unsigned _sp = 0; while (cond) { __builtin_amdgcn_s_sleep(1); \
    if ((++_sp & 255u) == 0u) { if (xb_ld(&(bar)[XB_TMO])) break; if (_sp > XB_SPIN_CAP) { atomicAdd(&(bar)[XB_TMO], 1u); break; } } } } while (0)
struct XcdBarrier { unsigned* bar; unsigned x; volatile LAS unsigned* st; };
DI XcdBarrier xcd_barrier_post(unsigned* bar, volatile LAS unsigned* st) {
    XcdBarrier b; b.bar = bar; b.x = xb_xcc_id(); b.st = st;
    if (threadIdx.x == 0) (void)xb_add(&bar[XB_XCNT(b.x)], 1u);
    return b;
}
DI void xcd_barrier_complete(unsigned* bar, unsigned x, unsigned& nloc, unsigned& nx) {
    const unsigned G = gridDim.x * gridDim.y * gridDim.z;
    unsigned sum, cnt, mine, sp = 0u;
    for (;;) {
        sum = 0u; cnt = 0u; mine = 0u;
#pragma unroll
        for (unsigned j = 0; j < 16; ++j) { const unsigned c = xb_ld(&bar[XB_XCNT(j)]); sum += c; cnt += (c > 0u) ? 1u : 0u; mine = (j == x) ? c : mine; }
        if (sum == G) break;
        __builtin_amdgcn_s_sleep(1);
        if ((++sp & 255u) == 0u) { if (xb_ld(&bar[XB_TMO])) break; if (sp > XB_SPIN_CAP) { atomicAdd(&bar[XB_TMO], 1u); break; } }
    }
    nloc = mine > 0u ? mine : 1u; nx = cnt > 0u ? cnt : 1u;
}
DI void xcd_barrier(const XcdBarrier& b) {
    asm volatile("s_waitcnt vmcnt(0)" ::: "memory");
    __syncthreads();
    if (threadIdx.x == 0) {
        unsigned* bar = b.bar;
        __builtin_amdgcn_s_waitcnt(0);
        unsigned nloc = b.st[0], nx = b.st[1];
        if (nloc == 0u) { xcd_barrier_complete(bar, b.x, nloc, nx); b.st[0] = nloc; b.st[1] = nx; }
        const unsigned old = xb_add(&bar[XB_XSUB(b.x)], 1u);
        const unsigned gen = old / nloc;
        if (old + 1u == (gen + 1u) * nloc) {
            __builtin_amdgcn_fence(__ATOMIC_RELEASE, "agent");
            asm volatile("s_waitcnt vmcnt(0)" ::: "memory");
            const unsigned og = xb_add(&bar[XB_TOP], 1u);
            const unsigned tg = og / nx;
            if (og + 1u == (tg + 1u) * nx) xb_add(&bar[XB_TOPGEN], 1u);
            else XB_SPIN(xb_ld(&bar[XB_TOPGEN]) == tg, bar);
            __builtin_amdgcn_fence(__ATOMIC_ACQUIRE, "agent");
            xb_add(&bar[XB_XGEN(b.x)], 1u);
            asm volatile("s_waitcnt vmcnt(0)" ::: "memory");
        } else {
            XB_SPIN(xb_ld(&bar[XB_XGEN(b.x)]) == gen, bar);
            __builtin_amdgcn_fence(__ATOMIC_ACQUIRE, "agent");
            asm volatile("s_waitcnt vmcnt(0)" ::: "memory");
        }
    }
    __syncthreads();
}

DI void run_phase(const Params& p, unsigned char* lds, int ph) {
    switch (ph) {
        case 0: phase0(p, lds); break;
        case 1: phase1(p, lds); break;
        case 2: phase15(p, lds); break;
        case 3: phase2(p, lds); break;
        case 4: phase25(p, lds); phase3(p, lds); break;
        case 5: phase4(p, lds); break;
        default: phase5(p, lds); break;
    }
}

__global__ void __launch_bounds__(512) hybrid_fwd(Params p) {
    extern __shared__ __attribute__((aligned(16))) unsigned char lds[];
#if MULTI_LAUNCH
    run_phase(p, lds, p.phase_lo);
#else
    cg::grid_group grid = cg::this_grid();
    if (p.phase_lo == 77) grid.sync();
    {
        volatile LAS unsigned* st = (volatile LAS unsigned*)(lds + LDS_ITEM + 16);
        if (threadIdx.x == 0) { st[0] = 0u; st[1] = 0u; }
        __syncthreads();
        (void)xcd_barrier_post((unsigned*)(p.ws + OFF_XBAR), st);
    }
#define GRID_BARRIER() { XcdBarrier xb_; xb_.bar = (unsigned*)(p.ws + OFF_XBAR); xb_.x = xb_xcc_id(); xb_.st = (volatile LAS unsigned*)(lds + LDS_ITEM + 16); xcd_barrier(xb_); }
    phase0(p, lds); GRID_BARRIER();
    phase1(p, lds); GRID_BARRIER();
    phase15(p, lds); GRID_BARRIER();
    phase2(p, lds); GRID_BARRIER();
    phase25(p, lds); GRID_BARRIER();
    phase3(p, lds); GRID_BARRIER();
    phase4(p, lds);
#endif
}

extern "C" void kernel_launch(void* const* d_in, const int* in_sizes, int n_in, void* d_out, int out_size, void* d_ws, size_t ws_size, hipStream_t stream) {
    static int grid = 0;
    if (grid == 0) {
        int dev = 0, cus = 0, per_cu = 0;
        hipGetDevice(&dev);
        hipDeviceGetAttribute(&cus, hipDeviceAttributeMultiprocessorCount, dev);
        hipFuncSetAttribute((const void*)hybrid_fwd, hipFuncAttributeMaxDynamicSharedMemorySize, LDS_BYTES);
        hipOccupancyMaxActiveBlocksPerMultiprocessor(&per_cu, (const void*)hybrid_fwd, 512, LDS_BYTES);
        if (per_cu < 1) per_cu = 1;
        if (per_cu > 1) per_cu = 1;
        if (cus <= 0) cus = 256;
        grid = cus * per_cu;
    }
    hipMemsetAsync((unsigned char*)d_ws + OFF_CTR, 0, 256, stream);
    hipMemsetAsync((unsigned char*)d_ws + OFF_XBAR, 0, 16384, stream);
    Params p{};
    p.x = (const float*)d_in[0]; p.meta = (const float*)d_in[1]; p.norm_w = (const float*)d_in[2]; p.w_in = (const float*)d_in[3];
    p.lq1 = (const float*)d_in[4]; p.lk1 = (const float*)d_in[5]; p.lq2 = (const float*)d_in[6]; p.lk2 = (const float*)d_in[7];
    p.subln_w = (const float*)d_in[8]; p.gate_w2 = (const float*)d_in[9]; p.gate_b = (const float*)d_in[10]; p.gla_norm_w = (const float*)d_in[11];
    p.wa = (const float*)d_in[12]; p.wb = (const float*)d_in[13]; p.wo = (const float*)d_in[14]; p.final_w = (const float*)d_in[15];
    p.out = (float*)d_out; p.ws = (unsigned char*)d_ws;
#if MULTI_LAUNCH
    for (int ph = 0; ph < 7; ++ph) {
        p.phase_lo = ph; p.phase_hi = ph + 1;
        hipLaunchKernelGGL(hybrid_fwd, dim3(grid), dim3(512), LDS_BYTES, stream, p);
    }
#else
    p.phase_lo = 0; p.phase_hi = 7;
    void* args[] = {&p};
    hipError_t e = hipLaunchCooperativeKernel((const void*)hybrid_fwd, dim3(grid), dim3(512), args, LDS_BYTES, stream);
    if (e != hipSuccess) fprintf(stderr, "cooperative launch failed: %s (grid %d)\n", hipGetErrorString(e), grid);
#endif
}
```

```cpp
#include <hip/hip_runtime.h>
#include <hip/hip_cooperative_groups.h>
#include <cstdio>
#include <cstdint>
namespace cg = cooperative_groups;

#ifndef MULTI_LAUNCH
#define MULTI_LAUNCH 0
#endif
#ifndef PROBE_REP
#define PROBE_REP 0
#endif

typedef unsigned short bf16_t;
typedef short bf16x8 __attribute__((ext_vector_type(8)));
typedef float f32x4 __attribute__((ext_vector_type(4)));
typedef float f32x2 __attribute__((ext_vector_type(2)));
typedef float f32x16 __attribute__((ext_vector_type(16)));
typedef unsigned u32x4 __attribute__((ext_vector_type(4)));
typedef unsigned u32x2 __attribute__((ext_vector_type(2)));
typedef __bf16 bfv2 __attribute__((ext_vector_type(2)));

#define DI __device__ __forceinline__
#define MFMA32(a, b, c) __builtin_amdgcn_mfma_f32_32x32x16_bf16((a), (b), (c), 0, 0, 0)
#define MFMA16(a, b, c) __builtin_amdgcn_mfma_f32_16x16x32_bf16((a), (b), (c), 0, 0, 0)

DI unsigned pk2(float a, float b) { f32x2 v = {a, b}; return __builtin_bit_cast(unsigned, __builtin_convertvector(v, bfv2)); }
DI float bf2f(bf16_t v) { return __uint_as_float(((unsigned)v) << 16); }
DI float bflo(unsigned u) { return __uint_as_float(u << 16); }
DI float bfhi(unsigned u) { return __uint_as_float(u & 0xffff0000u); }
DI bf16_t f2bf(float a) { return (bf16_t)(pk2(a, 0.f) & 0xffffu); }
DI float wave_sum(float v) {
#pragma unroll
    for (int o = 32; o; o >>= 1) v += __shfl_xor(v, o);
    return v;
}
DI int opaque_tid() { int t = threadIdx.x; asm volatile("" : "+v"(t)); return t; }
DI float sigmoidf_(float z) { return 1.f / (1.f + __expf(-z)); }
DI float siluf_(float z) { return z / (1.f + __expf(-z)); }

constexpr int D = 1024, NB = 4, SEQ = 4096, MROWS = NB * SEQ;
constexpr int NIN = 9232, NINP = 9344;
constexpr float EPS = 1e-5f;

constexpr size_t SZ_ACT = (size_t)MROWS * 1024 * 2;
constexpr size_t OFF_WIN_T = 0;
constexpr size_t OFF_WA_T = OFF_WIN_T + (size_t)NINP * 1024 * 2;
constexpr size_t OFF_WB_T = OFF_WA_T + 2097152;
constexpr size_t OFF_WO_T = OFF_WB_T + 2097152;
constexpr size_t OFF_AK = OFF_WO_T + 2097152;
constexpr size_t OFF_AVT = OFF_AK + SZ_ACT;
constexpr size_t OFF_AZ = OFF_AVT + SZ_ACT;
constexpr size_t OFF_GVT = OFF_AZ + SZ_ACT;
constexpr size_t OFF_GZ = OFF_GVT + SZ_ACT;
constexpr size_t OFF_GA = OFF_GZ + SZ_ACT;
constexpr size_t OFF_GB = OFF_GA + SZ_ACT;
constexpr size_t OFF_GLR = OFF_GB + SZ_ACT;
constexpr size_t OFF_RSTD = OFF_GLR + (size_t)MROWS * 16 * 2;
constexpr size_t OFF_ROPE = OFF_RSTD + 65792;
constexpr size_t OFF_AKM = OFF_ROPE + 263168;
constexpr size_t OFF_AVTM = OFF_AKM + 131072;
constexpr size_t OFF_GVTM = OFF_AVTM + 131072;
constexpr size_t OFF_GKM = OFF_GVTM + 131072;
constexpr size_t OFF_GLRM = OFF_GKM + 16384;
constexpr size_t OFF_KTM = OFF_GLRM + 512;
constexpr size_t OFF_KTTM = OFF_KTM + 65536;
constexpr size_t OFF_DEC = OFF_KTTM + 65536;
constexpr size_t OFF_DECM = OFF_DEC + 524288;
constexpr size_t OFF_SSQB = OFF_DECM + 2048;
constexpr size_t OFF_SSQH = OFF_SSQB + 4194304;
constexpr size_t OFF_CTR = OFF_SSQH + 1048576;
constexpr size_t OFF_XBM = OFF_CTR + 256;
constexpr size_t OFF_XBAR = OFF_XBM + 32768;
constexpr size_t WS_END = OFF_XBAR + 16384;
constexpr size_t OFF_XB = OFF_GA;
constexpr size_t OFF_SGA = OFF_GB;
constexpr size_t OFF_SGB = OFF_GB + (size_t)MROWS * 1024;
static_assert(WS_END <= 268435456ull, "workspace over 256 MiB");
constexpr size_t DO_AQ = 0, DO_GQ = SZ_ACT, DO_GK = SZ_ACT + SZ_ACT / 2;

constexpr int G_ROWB = 144;
constexpr int G_SW = 128 * G_ROWB, G_SX = 256 * G_ROWB, G_STAGE = G_SW + G_SX;
constexpr int G_SW4 = 256 * G_ROWB, G_STAGE4 = G_SW4 + G_SX;
constexpr int LDS_SCALE = 2 * G_STAGE4;
constexpr int LDS_ITEM = LDS_SCALE + 4096;
constexpr int LDS_BYTES = LDS_ITEM + 64;

struct Params {
    const float *x, *meta, *norm_w, *w_in, *lq1, *lk1, *lq2, *lk2, *subln_w, *gate_w2, *gate_b, *gla_norm_w, *wa, *wb, *wo, *final_w;
    float* out;
    unsigned char* ws;
    int phase_lo, phase_hi;
};

template <int MODE>
DI void p0_transpose_item(const Params& p, int item, float* tile) {
    const int tid = opaque_tid();
    const float* W = MODE == 0 ? p.w_in : MODE == 1 ? p.wa : MODE == 2 ? p.wb : p.wo;
    const int ldw = MODE == 0 ? NIN : 1024;
    const int nbc = MODE == 0 ? NINP / 64 : 16;
    bf16_t* WT = (bf16_t*)(p.ws + (MODE == 0 ? OFF_WIN_T : MODE == 1 ? OFF_WA_T : MODE == 2 ? OFF_WB_T : OFF_WO_T));
    const int kb = item / nbc, nb = item % nbc, k0 = kb * 64, n0 = nb * 64;
#pragma unroll
    for (int i = 0; i < 8; ++i) {
        const int kk = (tid >> 6) + 8 * i, nn = tid & 63, n = n0 + nn, k = k0 + kk;
        int src = n;
        if (MODE == 0) { src = n < 7168 ? n : (n < 9216 ? n + 16 : (n < 9232 ? n - 2048 : -1)); }
        float sc = 1.f;
        if (MODE == 0) sc = p.norm_w[k];
        if (MODE == 1) sc = 0.8f * p.subln_w[k & 127];
        if (MODE == 2) sc = p.gla_norm_w[k & 255];
        float v = 0.f;
        if (src >= 0) v = W[(size_t)k * ldw + src] * sc;
        tile[kk * 65 + nn] = v;
    }
    __syncthreads();
    {
        const int nn = tid >> 3, c = tid & 7;
        const float* s = tile + (8 * c) * 65 + nn;
        u32x4 o;
        o.x = pk2(s[0 * 65], s[1 * 65]); o.y = pk2(s[2 * 65], s[3 * 65]); o.z = pk2(s[4 * 65], s[5 * 65]); o.w = pk2(s[6 * 65], s[7 * 65]);
        *(u32x4*)(WT + (size_t)(n0 + nn) * 1024 + k0 + 8 * c) = o;
    }
    __syncthreads();
}

DI void phase0(const Params& p, unsigned char* lds) {
    const int tid = opaque_tid(), lane = tid & 63, wave = tid >> 6;
    float* tile = (float*)lds;
    constexpr int I_WIN = 16 * (NINP / 64), I_SQ = 256;
    constexpr int I_T = I_WIN + 3 * I_SQ;
    constexpr int I_RSTD = (MROWS + 16 + 7) / 8;
    constexpr int I_ROPE = (4112 * 8 + 511) / 512;
    constexpr int I_ZERO = 393216 / 8192;
    constexpr int I_ALL = I_T + I_RSTD + I_ROPE + I_ZERO;
    for (int it = blockIdx.x; it < I_ALL; it += gridDim.x) {
        int r = it;
        if (r < I_WIN) { p0_transpose_item<0>(p, r, tile); continue; } r -= I_WIN;
        if (r < I_SQ) { p0_transpose_item<1>(p, r, tile); continue; } r -= I_SQ;
        if (r < I_SQ) { p0_transpose_item<2>(p, r, tile); continue; } r -= I_SQ;
        if (r < I_SQ) { p0_transpose_item<3>(p, r, tile); continue; } r -= I_SQ;
        if (r < I_RSTD) {
            const int row = r * 8 + wave;
            if (row < MROWS + 16) {
                const float* src = row < MROWS ? p.x + (size_t)row * 1024 : p.meta + (size_t)(row - MROWS) * 1024;
                const f32x4* xr = (const f32x4*)src + lane;
                float s = 0.f;
#pragma unroll
                for (int j = 0; j < 4; ++j) { const f32x4 v = xr[64 * j]; s += (v.x * v.x + v.y * v.y) + (v.z * v.z + v.w * v.w); }
                s = wave_sum(s);
                if (lane == 0) ((float*)(p.ws + OFF_RSTD))[row] = 1.0f / sqrtf(s * (1.0f / 1024.0f) + EPS);
                bf16_t* xbrow = row < MROWS ? (bf16_t*)(p.ws + OFF_XB) + (size_t)row * 1024 : (bf16_t*)(p.ws + OFF_XBM) + (size_t)(row - MROWS) * 1024;
#pragma unroll
                for (int j = 0; j < 4; ++j) { const f32x4 v = xr[64 * j]; u32x2 o; o.x = pk2(v.x, v.y); o.y = pk2(v.z, v.w); *(u32x2*)(xbrow + 256 * j + 4 * lane) = o; }
            }
            continue;
        }
        r -= I_RSTD;
        if (r < I_ROPE) {
            const int e = r * 512 + tid;
            if (e < 4112 * 8) {
                const int pos = e >> 3, i = e & 7;
                const float inv = powf(500000.0f, -(float)i / 8.0f);
                const float ang = (float)pos * inv;
                float* t = (float*)(p.ws + OFF_ROPE) + (size_t)e * 2;
                t[0] = cosf(ang); t[1] = sinf(ang);
            }
            continue;
        }
        r -= I_ROPE;
        { u32x4 z = {0u, 0u, 0u, 0u}; *(u32x4*)(p.ws + OFF_AKM + (size_t)r * 8192 + tid * 16) = z; }
    }
}

template <int NI, bool HS>
DI void gemm_tile(f32x16 (&acc)[NI][2], const bf16_t* __restrict__ Wt, const bf16_t* __restrict__ X, unsigned char* lds, const float (&hs)[2][3]) {
    const int tid = opaque_tid(), lane = tid & 63, wave = tid >> 6, l31 = lane & 31, h = lane >> 5;
    const int wn = wave & 1, wm = wave >> 1;
    constexpr int SW = NI * 64 * G_ROWB, STAGE = SW + G_SX;
    u32x4 wreg[NI];
    u32x4 xreg[4];
    const int prow = tid >> 3, pc = tid & 7;
    const bf16_t* wp = Wt + (size_t)prow * 1024 + pc * 8;
    const bf16_t* xp = X + (size_t)prow * 1024 + pc * 8;
#define G_LOAD(kt_)                                                                                                  \
    {                                                                                                                \
        _Pragma("unroll") for (int i = 0; i < NI; ++i) wreg[i] = *(const u32x4*)(wp + (size_t)i * 64 * 1024 + (kt_) * 64); \
        _Pragma("unroll") for (int i = 0; i < 4; ++i) xreg[i] = *(const u32x4*)(xp + (size_t)i * 64 * 1024 + (kt_) * 64);  \
    }
#define G_STORE(buf_)                                                                                                \
    {                                                                                                                \
        unsigned char* sW_ = lds + (buf_) * STAGE + prow * G_ROWB + pc * 16; unsigned char* sX_ = sW_ + SW;          \
        _Pragma("unroll") for (int i = 0; i < NI; ++i) *(u32x4*)(sW_ + i * 64 * G_ROWB) = wreg[i];                   \
        _Pragma("unroll") for (int i = 0; i < 4; ++i) *(u32x4*)(sX_ + i * 64 * G_ROWB) = xreg[i];                    \
    }
    G_LOAD(0);
    G_STORE(0);
    __syncthreads();
    for (int kt = 0; kt < 16; ++kt) {
        if (kt + 1 < 16) G_LOAD(kt + 1);
        if (HS) {
            if (kt == 4 || kt == 8 || kt == 12) {
                const float s0 = kt == 4 ? hs[0][0] : (kt == 8 ? hs[0][1] : hs[0][2]);
                const float s1 = kt == 4 ? hs[1][0] : (kt == 8 ? hs[1][1] : hs[1][2]);
#pragma unroll
                for (int n = 0; n < NI; ++n)
#pragma unroll
                    for (int i = 0; i < 16; ++i) { acc[n][0][i] *= s0; acc[n][1][i] *= s1; }
            }
        }
        {
            const unsigned char* sW = lds + (kt & 1) * STAGE + (wn * NI * 32 + l31) * G_ROWB + h * 16;
            const unsigned char* sX = lds + (kt & 1) * STAGE + SW + (wm * 64 + l31) * G_ROWB + h * 16;
#pragma unroll
            for (int ks = 0; ks < 4; ++ks) {
                const bf16x8 x0 = *(const bf16x8*)(sX + ks * 32), x1 = *(const bf16x8*)(sX + 32 * G_ROWB + ks * 32);
#pragma unroll
                for (int n = 0; n < NI; ++n) {
                    const bf16x8 w = *(const bf16x8*)(sW + n * 32 * G_ROWB + ks * 32);
                    acc[n][0] = MFMA32(w, x0, acc[n][0]); acc[n][1] = MFMA32(w, x1, acc[n][1]);
                }
            }
        }
        if (kt + 1 < 16) G_STORE((kt + 1) & 1);
        __syncthreads();
    }
#undef G_LOAD
#undef G_STORE
}

template <int NI>
DI void zero_acc(f32x16 (&acc)[NI][2]) {
#pragma unroll
    for (int a = 0; a < NI; ++a)
#pragma unroll
        for (int b = 0; b < 2; ++b)
#pragma unroll
            for (int i = 0; i < 16; ++i) acc[a][b][i] = 0.f;
}

namespace pg8 {
#define PG8_LAS __attribute__((address_space(3)))
typedef unsigned short bf16_t;
typedef short bf16x8 __attribute__((ext_vector_type(8)));
typedef float f32x4 __attribute__((ext_vector_type(4)));
typedef unsigned u32x4 __attribute__((ext_vector_type(4)));
constexpr int BM = 256, BK = 64, HALF = 128, HTB = HALF * BK * 2  , STAGE_BYTES = 8 * HTB, NXCD = 8, WGM = 8;

__host__ __device__ __forceinline__ int lds_byte(int r, int c) { const int st = (r >> 4) * 2 + (c >> 5), rr = r & 15, cc = c & 31, ob = rr * 64 + cc * 2; return st * 1024 + (ob ^ (((ob >> 9) & 1) << 5)); }
__host__ __device__ __forceinline__ void stage_rc(int b, int& R, int& C) { const int st = b / 1024, sb = b % 1024, swz = sb ^ (((sb >> 9) & 1) << 5); R = (st >> 1) * 16 + swz / 64; C = (st & 1) * 32 + (swz % 64) / 2; }
__host__ __device__ __forceinline__ int perm32(int rho) { const int n = rho >> 4, i = rho & 15; return 8 * (i >> 2) + 4 * n + (i & 3); }

struct Unit { int pm, pn; };
struct Gemm { const bf16_t* A; const bf16_t* Bt; int M, N, K; };

template <class Epi, class Sched, bool ALIGN_EPI = false, bool SP2 = false>
__device__ __forceinline__ void gemm_phase(PG8_LAS unsigned char* lds, const Gemm g, const Sched& S, const Epi& E) {
    const int tid = opaque_tid(), wid = __builtin_amdgcn_readfirstlane(tid >> 6), lane = tid & 63, wr = wid >> 2, wc = wid & 3, fr = lane & 15, fq = lane >> 4;
    const int K = g.K, nt = K / BK;
    unsigned voffA[2], voffB[2];
#pragma unroll
    for (int i = 0; i < 2; ++i) { int R, C; stage_rc(tid * 16 + i * 8192, R, C); const int Rb = Epi::PERM ? ((R & ~31) + perm32(R & 31)) : R;
        voffA[i] = (unsigned)(R * K + C) * 2u; voffB[i] = (unsigned)(Rb * K + C) * 2u; }
    const size_t kstep = (size_t)(BK * 2);
    const size_t hstep = (size_t)HALF * K * 2;
    const size_t tstep = 2 * hstep;
    const unsigned ldsw = (unsigned)wid * 1024u;
    const int aoff = lds_byte(wr * 64 + fr, fq * 8), boff = lds_byte(wc * 32 + fr, fq * 8);
#define PG8_SA(b, h) (((b) * 2 + (h)) * HTB)
#define PG8_SB(b, h) ((4 + (b) * 2 + (h)) * HTB)
#define PG8_STAGE(bufoff, gbase, voff) do { _Pragma("unroll") for (int _i = 0; _i < 2; ++_i) \
        __builtin_amdgcn_global_load_lds((const unsigned*)((const char*)(gbase) + (voff)[_i]), (PG8_LAS unsigned*)(lds + (bufoff) + ldsw + _i * 8192), 16, 0, 0); } while (0)
#define PG8_LDA(dst, b, h) do { _Pragma("unroll") for (int m = 0; m < 4; ++m) _Pragma("unroll") for (int k = 0; k < 2; ++k) dst[m][k] = *(const PG8_LAS bf16x8*)(lds + PG8_SA(b, h) + aoff + m * 2048 + k * 1024); } while (0)
#define PG8_LDB(dst, b, h) do { _Pragma("unroll") for (int n = 0; n < 2; ++n) _Pragma("unroll") for (int k = 0; k < 2; ++k) dst[n][k] = *(const PG8_LAS bf16x8*)(lds + PG8_SB(b, h) + boff + n * 2048 + k * 1024); } while (0)
#define PG8_MMA(ai, bj, At, Bt) do { __builtin_amdgcn_s_setprio(1); _Pragma("unroll") for (int m = 0; m < 4; ++m) _Pragma("unroll") for (int n = 0; n < 2; ++n) _Pragma("unroll") for (int k = 0; k < 2; ++k) \
        acc[ai][bj][m][n] = __builtin_amdgcn_mfma_f32_16x16x32_bf16(Bt[n][k], At[m][k], acc[ai][bj][m][n], 0, 0, 0); __builtin_amdgcn_s_setprio(0); } while (0)
#define PG8_WAIT_V(n) asm volatile("s_waitcnt vmcnt(" #n ")" ::: "memory")
#define PG8_WAIT_L(n) asm volatile("s_waitcnt lgkmcnt(" #n ")" ::: "memory")
#define PG8_BAR __builtin_amdgcn_s_barrier()
#define PG8_SCHED __builtin_amdgcn_sched_barrier(0)
    Unit cur, nxt; int ui = 0;
    if (!S.next(0, cur)) return;
    f32x4 acc[2][2][4][2];
#pragma unroll
    for (int a = 0; a < 2; ++a)
#pragma unroll
        for (int b = 0; b < 2; ++b)
#pragma unroll
            for (int m = 0; m < 4; ++m)
#pragma unroll
                for (int n = 0; n < 2; ++n) acc[a][b][m][n] = (f32x4){0.f, 0.f, 0.f, 0.f};
    bf16x8 At[4][2], B0[2][2], B1[2][2];
    const char* cA = (const char*)g.A + (size_t)cur.pm * tstep; const char* cB = (const char*)g.Bt + (size_t)cur.pn * tstep;
    S.a_ready(cur);
    if constexpr (SP2) {
        PG8_STAGE(PG8_SB(0, 0), cB, voffB); PG8_STAGE(PG8_SB(0, 1), cB + hstep, voffB); PG8_STAGE(PG8_SA(0, 0), cA, voffA); PG8_STAGE(PG8_SA(0, 1), cA + hstep, voffA);
        if (wr == 1) PG8_BAR;
        PG8_WAIT_V(2); PG8_BAR;
        PG8_STAGE(PG8_SB(1, 0), cB + kstep, voffB); PG8_STAGE(PG8_SA(1, 0), cA + kstep, voffA); PG8_STAGE(PG8_SB(1, 1), cB + hstep + kstep, voffB);
        PG8_WAIT_V(6); PG8_BAR;
    } else {
        PG8_STAGE(PG8_SB(0, 0), cB, voffB); PG8_STAGE(PG8_SA(0, 0), cA, voffA); PG8_STAGE(PG8_SB(0, 1), cB + hstep, voffB); PG8_STAGE(PG8_SA(0, 1), cA + hstep, voffA);
        if (wr == 1) PG8_BAR;
        PG8_WAIT_V(4); PG8_BAR;
        PG8_STAGE(PG8_SB(1, 0), cB + kstep, voffB); PG8_STAGE(PG8_SA(1, 0), cA + kstep, voffA); PG8_STAGE(PG8_SB(1, 1), cB + hstep + kstep, voffB);
        PG8_WAIT_V(6); PG8_BAR;
    }
    for (;;) {
        const bool has_next = S.next(ui + 1, nxt);
        const char* nA = has_next ? (const char*)g.A + (size_t)nxt.pm * tstep : cA; const char* nB = has_next ? (const char*)g.Bt + (size_t)nxt.pn * tstep : cB;
        for (int t = 0; t < nt; t += 2) {
            const bool last = (t == nt - 2);
            const char* a1 = cA + (size_t)(t + 1) * kstep;
            const char* a2 = last ? nA : cA + (size_t)(t + 2) * kstep; const char* b2 = last ? nB : cB + (size_t)(t + 2) * kstep;
            const char* a3 = a2 + kstep; const char* b3 = b2 + kstep;
            if (last && has_next) S.a_ready(nxt);
            if constexpr (SP2) {
            PG8_LDB(B0, 0, 0); PG8_LDB(B1, 0, 1); PG8_SCHED; PG8_LDA(At, 0, 0); PG8_STAGE(PG8_SA(1, 1), a1 + hstep, voffA);
            PG8_WAIT_V(8); PG8_WAIT_L(0); PG8_BAR; PG8_MMA(0, 0, At, B0); PG8_MMA(0, 1, At, B1); PG8_BAR; PG8_SCHED;
            PG8_LDA(At, 0, 1); PG8_STAGE(PG8_SB(0, 0), b2, voffB); PG8_STAGE(PG8_SB(0, 1), b2 + hstep, voffB); PG8_STAGE(PG8_SA(0, 0), a2, voffA);
            PG8_WAIT_V(8); PG8_WAIT_L(0); PG8_BAR; PG8_MMA(1, 0, At, B0); PG8_MMA(1, 1, At, B1); PG8_BAR; PG8_SCHED;
            PG8_LDB(B0, 1, 0); PG8_LDB(B1, 1, 1); PG8_SCHED; PG8_LDA(At, 1, 0); PG8_STAGE(PG8_SA(0, 1), a2 + hstep, voffA);
            PG8_WAIT_V(8); PG8_WAIT_L(0); PG8_BAR; PG8_MMA(0, 0, At, B0); PG8_MMA(0, 1, At, B1); PG8_BAR; PG8_SCHED;
            PG8_LDA(At, 1, 1); PG8_STAGE(PG8_SB(1, 0), b3, voffB); PG8_STAGE(PG8_SB(1, 1), b3 + hstep, voffB); PG8_STAGE(PG8_SA(1, 0), a3, voffA);
            PG8_WAIT_V(8); PG8_WAIT_L(0); PG8_BAR; PG8_MMA(1, 0, At, B0); PG8_MMA(1, 1, At, B1); PG8_BAR; PG8_SCHED;
            } else {
            PG8_LDB(B0, 0, 0); PG8_SCHED; PG8_LDA(At, 0, 0); PG8_STAGE(PG8_SA(1, 1), a1 + hstep, voffA);
            PG8_WAIT_L(8); PG8_BAR; PG8_WAIT_L(0); PG8_MMA(0, 0, At, B0); PG8_BAR; PG8_SCHED;
            PG8_LDB(B1, 0, 1); PG8_STAGE(PG8_SB(0, 0), b2, voffB);
            PG8_BAR; PG8_WAIT_L(0); PG8_MMA(0, 1, At, B1); PG8_BAR;
            PG8_LDA(At, 0, 1); PG8_STAGE(PG8_SA(0, 0), a2, voffA);
            PG8_BAR; PG8_WAIT_L(0); PG8_MMA(1, 0, At, B0); PG8_BAR; PG8_SCHED;
            PG8_STAGE(PG8_SB(0, 1), b2 + hstep, voffB);
            PG8_WAIT_V(6); PG8_BAR; PG8_MMA(1, 1, At, B1); PG8_BAR;
            PG8_LDB(B0, 1, 0); PG8_SCHED; PG8_LDA(At, 1, 0); PG8_STAGE(PG8_SA(0, 1), a2 + hstep, voffA);
            PG8_WAIT_L(8); PG8_BAR; PG8_WAIT_L(0); PG8_MMA(0, 0, At, B0); PG8_BAR; PG8_SCHED;
            PG8_LDB(B1, 1, 1); PG8_STAGE(PG8_SB(1, 0), b3, voffB);
            PG8_BAR; PG8_WAIT_L(0); PG8_MMA(0, 1, At, B1); PG8_BAR;
            PG8_LDA(At, 1, 1); PG8_STAGE(PG8_SA(1, 0), a3, voffA);
            PG8_BAR; PG8_WAIT_L(0); PG8_MMA(1, 0, At, B0); PG8_BAR; PG8_SCHED;
            PG8_STAGE(PG8_SB(1, 1), b3 + hstep, voffB);
            PG8_WAIT_V(6); PG8_BAR; PG8_MMA(1, 1, At, B1); PG8_BAR;
            }
        }
        if constexpr (ALIGN_EPI) { if (wr == 0) PG8_BAR; }
        if constexpr (!Epi::AFTER_DRAIN) { E(acc, cur, wr, wc, fr, fq); S.done(cur); }
        if (!has_next) break;
#pragma unroll
        for (int a = 0; a < 2; ++a)
#pragma unroll
            for (int b = 0; b < 2; ++b)
#pragma unroll
                for (int m = 0; m < 4; ++m)
#pragma unroll
                    for (int n = 0; n < 2; ++n) acc[a][b][m][n] = (f32x4){0.f, 0.f, 0.f, 0.f};
        cur = nxt; cA = nA; cB = nB; ++ui;
        if constexpr (ALIGN_EPI) { if (wr == 1) PG8_BAR; }
    }
    PG8_WAIT_V(0);
    if constexpr (!ALIGN_EPI) { if (wr == 0) PG8_BAR; }
    PG8_BAR;
    if constexpr (Epi::AFTER_DRAIN) { E.fused(acc, cur, wr, wc, fr, fq, lds, wid, lane); S.done(cur); }
#undef PG8_SA
#undef PG8_SB
#undef PG8_STAGE
#undef PG8_LDA
#undef PG8_LDB
#undef PG8_MMA
#undef PG8_WAIT_V
#undef PG8_WAIT_L
#undef PG8_BAR
#undef PG8_SCHED
}
}

DI unsigned sig_u8(float z) { return (unsigned)(255.0f / (1.0f + __expf(-z)) + 0.5f); }
struct SchedP1 {
    DI bool next(int i, pg8::Unit& u) const {
        constexpr int NT = 36;
        const int id = (int)blockIdx.x + i * (int)gridDim.x;
        if (id >= 64 * NT) return false;
        const int g = id / (16 * NT), rem = id % (16 * NT), reg = rem >> 8, w = rem & 255, x = w & 7, j = w >> 3;
        int mt = g * 16 + 4 * (x & 3) + (j & 3), nt = reg * 16 + 8 * (x >> 2) + (j >> 2);
        if (reg == 2) { const int e = rem - 512; nt = 32 + (e >> 4); mt = g * 16 + (e & 15); }
        u.pm = mt; u.pn = nt; return true;
    }
    DI void a_ready(const pg8::Unit&) const {}
    DI void done(const pg8::Unit&) const {}
};
struct SchedSq {
    DI bool next(int i, pg8::Unit& u) const {
        const int id = (int)blockIdx.x + i * (int)gridDim.x;
        if (id >= 256) return false;
        u.pm = 8 * (id & 7) + ((id >> 3) & 7); u.pn = id >> 6; return true;
    }
    DI void a_ready(const pg8::Unit&) const {}
    DI void done(const pg8::Unit&) const {}
};
struct EpiInProj {
    static constexpr bool PERM = false, AFTER_DRAIN = false;
    unsigned char* ws; unsigned char* dout;
    DI void operator()(const pg8::f32x4 (&acc)[2][2][4][2], const pg8::Unit& u, int wr, int wc, int fr, int fq) const {
        const int nt = u.pn;
        int split, nc0;
        if (nt < 4) { split = 0; nc0 = nt * 256; }
        else if (nt < 8) { split = 1; nc0 = (nt - 4) * 256; }
        else if (nt < 12) { split = 2; nc0 = (nt - 8) * 256; }
        else if (nt < 16) { split = 3; nc0 = (nt - 12) * 256; }
        else if (nt < 18) { split = 4; nc0 = (nt - 16) * 256; }
        else if (nt < 20) { split = 5; nc0 = (nt - 18) * 256; }
        else if (nt < 24) { split = 6; nc0 = (nt - 20) * 256; }
        else if (nt < 28) { split = 7; nc0 = (nt - 24) * 256; }
        else if (nt < 32) { split = 9; nc0 = (nt - 28) * 256; }
        else { split = 10; nc0 = (nt - 32) * 256; }
        const float* rstd = (const float*)(ws + OFF_RSTD);
        const float* rope = (const float*)(ws + OFF_ROPE);
        const bool do_rope = split <= 1 && (wc & 1) == 0;
#pragma unroll
        for (int ai = 0; ai < 2; ++ai)
#pragma unroll
            for (int m = 0; m < 4; ++m) {
                const int tok = u.pm * 256 + ai * 128 + wr * 64 + m * 16 + fr;
                const float rs = rstd[tok];
                const int pos = 16 + (tok & 4095), b = tok >> 12, s = tok & 4095;
#pragma unroll
                for (int bj = 0; bj < 2; ++bj)
#pragma unroll
                    for (int n = 0; n < 2; ++n) {
                        const int nb = nc0 + bj * 128 + wc * 32 + n * 16 + 4 * fq;
                        float v[4];
#pragma unroll
                        for (int j = 0; j < 4; ++j) v[j] = acc[ai][bj][m][n][j] * rs;
                        if (n == 0 && do_rope) {
                            const float* cs = rope + ((size_t)pos * 8 + 4 * (fq & 1)) * 2;
#pragma unroll
                            for (int j = 0; j < 4; ++j) {
                                const float other = __shfl_xor(v[j], 32);
                                const float c = cs[2 * j], sn = cs[2 * j + 1];
                                v[j] = fq < 2 ? (v[j] * c - other * sn) : (v[j] * c + other * sn);
                            }
                        }
                        if (split == 2 || split == 6) {
                            const int hshift = split == 2 ? 7 : 8, nheads = split == 2 ? 8 : 4, dvn = 1 << hshift;
                            bf16_t* base = (bf16_t*)(ws + (split == 2 ? OFF_AVT : OFF_GVT));
#pragma unroll
                            for (int j = 0; j < 4; ++j) {
                                const int nn = nb + j, hd = nn >> hshift, dv = nn & (dvn - 1);
                                base[((size_t)(b * nheads + hd) * dvn + dv) * 4096 + s] = f2bf(v[j]);
                            }
                        } else if (split >= 9) {
                            const unsigned o = sig_u8(v[0]) | (sig_u8(v[1]) << 8) | (sig_u8(v[2]) << 16) | (sig_u8(v[3]) << 24);
                            *(unsigned*)(ws + (split == 9 ? OFF_SGA : OFF_SGB) + (size_t)tok * 1024 + nb) = o;
                        } else {
                            bf16_t* dst; int ld;
                            switch (split) {
                                case 0: dst = (bf16_t*)(dout + DO_AQ); ld = 1024; break;
                                case 1: dst = (bf16_t*)(ws + OFF_AK); ld = 1024; break;
                                case 3: dst = (bf16_t*)(ws + OFF_AZ); ld = 1024; break;
                                case 4: dst = (bf16_t*)(dout + DO_GQ); ld = 512; break;
                                case 5: dst = (bf16_t*)(dout + DO_GK); ld = 512; break;
                                default: dst = (bf16_t*)(ws + OFF_GZ); ld = 1024; break;
                            }
                            u32x2 o; o.x = pk2(v[0], v[1]); o.y = pk2(v[2], v[3]);
                            *(u32x2*)(dst + (size_t)tok * ld + nb) = o;
                        }
                    }
            }
    }
};

DI void p1_glr_job(const Params& p, unsigned char* lds, int job) {
    const int tid = opaque_tid(), lane = tid & 63, wave = tid >> 6, l15 = lane & 15, g = lane >> 4;
    const int rtile = wave & 3, khalf = wave >> 2;
    const bf16_t* xb = (const bf16_t*)(p.ws + OFF_XB);
    const bf16_t* wt = (const bf16_t*)(p.ws + OFF_WIN_T) + (size_t)9216 * 1024;
    const size_t row0 = (size_t)job * 64 + rtile * 16;
    const bf16_t* ap = xb + (row0 + l15) * 1024 + khalf * 512 + 8 * g;
    const bf16_t* bp = wt + (size_t)l15 * 1024 + khalf * 512 + 8 * g;
    f32x4 acc = (f32x4){0.f, 0.f, 0.f, 0.f};
#pragma unroll 4
    for (int ks = 0; ks < 16; ++ks) {
        const bf16x8 a = *(const bf16x8*)(ap + ks * 32), bb = *(const bf16x8*)(bp + ks * 32);
        acc = MFMA16(a, bb, acc);
    }
    f32x4* red = (f32x4*)lds;
    __syncthreads();
    if (khalf == 1) red[rtile * 64 + lane] = acc;
    __syncthreads();
    if (khalf == 0) {
        const f32x4 o = red[rtile * 64 + lane];
        const float* rstd = (const float*)(p.ws + OFF_RSTD);
        bf16_t* glr = (bf16_t*)(p.ws + OFF_GLR);
#pragma unroll
        for (int i = 0; i < 4; ++i) {
            const size_t row = row0 + 4 * g + i;
            glr[row * 16 + l15] = f2bf((acc[i] + o[i]) * rstd[row]);
        }
    }
    __syncthreads();
}

DI void p1_meta_job(const Params& p, unsigned char* lds, int job) {
    const int tid = opaque_tid(), lane = tid & 63, wave = tid >> 6, l15 = lane & 15, g = lane >> 4;
    int c0;
    if (job < 64) c0 = 1024 + job * 16;
    else if (job < 128) c0 = 2048 + (job - 64) * 16;
    else if (job < 160) c0 = 4608 + (job - 128) * 16;
    else if (job < 224) c0 = 5120 + (job - 160) * 16;
    else c0 = 9216;
    const bf16_t* xbm = (const bf16_t*)(p.ws + OFF_XBM);
    const bf16_t* wt = (const bf16_t*)(p.ws + OFF_WIN_T);
    const bf16_t* ap = xbm + (size_t)l15 * 1024 + wave * 128 + 8 * g;
    const bf16_t* bp = wt + (size_t)(c0 + l15) * 1024 + wave * 128 + 8 * g;
    f32x4 acc = (f32x4){0.f, 0.f, 0.f, 0.f};
#pragma unroll
    for (int ks = 0; ks < 4; ++ks) {
        const bf16x8 a = *(const bf16x8*)(ap + ks * 32), bb = *(const bf16x8*)(bp + ks * 32);
        acc = MFMA16(a, bb, acc);
    }
    f32x4* red = (f32x4*)lds;
    __syncthreads();
    red[wave * 64 + lane] = acc;
    __syncthreads();
    if (wave == 0) {
        f32x4 s = red[lane];
#pragma unroll
        for (int w = 1; w < 8; ++w) { const f32x4 t = red[w * 64 + lane]; s.x += t.x; s.y += t.y; s.z += t.z; s.w += t.w; }
        const float* rstd = (const float*)(p.ws + OFF_RSTD) + MROWS;
        const float* rope = (const float*)(p.ws + OFF_ROPE);
        unsigned char* ws = p.ws;
        const int col = c0 + l15;
#pragma unroll
        for (int i = 0; i < 4; ++i) {
            const int row = 4 * g + i;
            float v = s[i] * rstd[row];
            if (job < 64 && (c0 & 63) == 0) {
                const float other = __shfl_xor(v, 8);
                const float* cs = rope + ((size_t)row * 8 + (l15 & 7)) * 2;
                const float c = cs[0], sn = cs[1];
                v = (l15 < 8) ? (v * c - other * sn) : (v * c + other * sn);
            }
            const bf16_t val = f2bf(v);
            if (job < 64) ((bf16_t*)(ws + OFF_AKM))[(size_t)(48 + row) * 1024 + (col - 1024)] = val;
            else if (job < 128) { const int n = col - 2048; ((bf16_t*)(ws + OFF_AVTM))[(size_t)n * 64 + 48 + row] = val; }
            else if (job < 160) ((bf16_t*)(ws + OFF_GKM))[(size_t)row * 512 + (col - 4608)] = val;
            else if (job < 224) { const int n = col - 5120; ((bf16_t*)(ws + OFF_GVTM))[(size_t)n * 64 + 48 + row] = val; }
            else ((bf16_t*)(ws + OFF_GLRM))[row * 16 + l15] = val;
        }
    }
    __syncthreads();
}

DI void phase1(const Params& p, unsigned char* lds) {
    for (int j = blockIdx.x; j < 256; j += gridDim.x) p1_glr_job(p, lds, j);
    for (int j = blockIdx.x; j < 225; j += gridDim.x) p1_meta_job(p, lds, j);
    pg8::Gemm g; g.A = (const bf16_t*)(p.ws + OFF_XB); g.Bt = (const bf16_t*)(p.ws + OFF_WIN_T); g.M = MROWS; g.N = 9216; g.K = 1024;
    SchedP1 S; EpiInProj E; E.ws = p.ws; E.dout = (unsigned char*)p.out;
    pg8::gemm_phase<EpiInProj, SchedP1, true, true>((PG8_LAS unsigned char*)lds, g, S, E);
}

DI void phase15(const Params& p, unsigned char* lds) {
    const int tid = opaque_tid(), col = tid;
    float w2[16];
#pragma unroll
    for (int j = 0; j < 16; ++j) w2[j] = p.gate_w2[j * 512 + col];
    const float bias = p.gate_b[col];
    unsigned char* ws = p.ws;
    unsigned char* dout = (unsigned char*)p.out;
    for (int item = blockIdx.x; item < 257; item += gridDim.x) {
        const bool meta = item == 256;
        const int b = item >> 6, c = item & 63;
        const size_t row0 = (size_t)b * 4096 + c * 64;
        const bf16_t* glr = meta ? (const bf16_t*)(ws + OFF_GLRM) : (const bf16_t*)(ws + OFF_GLR) + row0 * 16;
        const int nrows = meta ? 16 : 64;
        bf16_t* qp = (bf16_t*)(dout + DO_GQ) + row0 * 512 + col;
        const bf16_t* kin = meta ? (const bf16_t*)(ws + OFF_GKM) + col : (const bf16_t*)(dout + DO_GK) + row0 * 512 + col;
        bf16_t* kout = meta ? (bf16_t*)(ws + OFF_KTM) + 48 * 512 + col : (bf16_t*)(dout + DO_GK) + row0 * 512 + col;
        bf16_t* ktt = meta ? (bf16_t*)(ws + OFF_KTTM) + (size_t)col * 64 + 48 : (bf16_t*)(ws + OFF_WIN_T) + ((size_t)b * 512 + col) * 4096 + c * 64;
        __syncthreads();
        if (tid < nrows * 2) ((u32x4*)lds)[tid] = ((const u32x4*)glr)[tid];
        __syncthreads();
        float bsum = 0.f;
        bf16_t kc[8], qc[8], kn[8], qn[8];
#pragma unroll
        for (int rr = 0; rr < 8; ++rr) { kc[rr] = kin[(size_t)rr * 512]; qc[rr] = meta ? (bf16_t)0 : qp[(size_t)rr * 512]; }
        for (int r0 = 0; r0 < nrows; r0 += 8) {
            if (r0 + 8 < nrows) {
#pragma unroll
                for (int rr = 0; rr < 8; ++rr) { kn[rr] = kin[(size_t)(r0 + 8 + rr) * 512]; qn[rr] = meta ? (bf16_t)0 : qp[(size_t)(r0 + 8 + rr) * 512]; }
            }
            float kt8[8];
#pragma unroll
            for (int rr = 0; rr < 8; ++rr) {
                const int r = r0 + rr;
                const u32x4* g4 = (const u32x4*)(lds + r * 32);
                const u32x4 ga = g4[0], gb = g4[1];
                float gk = bias;
                gk += bflo(ga.x) * w2[0] + bfhi(ga.x) * w2[1] + bflo(ga.y) * w2[2] + bfhi(ga.y) * w2[3];
                gk += bflo(ga.z) * w2[4] + bfhi(ga.z) * w2[5] + bflo(ga.w) * w2[6] + bfhi(ga.w) * w2[7];
                gk += bflo(gb.x) * w2[8] + bfhi(gb.x) * w2[9] + bflo(gb.y) * w2[10] + bfhi(gb.y) * w2[11];
                gk += bflo(gb.z) * w2[12] + bfhi(gb.z) * w2[13] + bflo(gb.w) * w2[14] + bfhi(gb.w) * w2[15];
                const float lg = (fminf(gk, 0.f) - __logf(1.0f + __expf(-fabsf(gk)))) * (1.0f / 16.0f);
                bsum += lg;
                const float eb = __expf(bsum);
                const float kt = bf2f(kc[rr]) * __builtin_amdgcn_rcpf(eb);
                kt8[rr] = kt;
                kout[(size_t)r * 512] = f2bf(kt);
                if (!meta) qp[(size_t)r * 512] = f2bf(bf2f(qc[rr]) * 0.08838834764831845f * eb);
            }
            u32x4 o; o.x = pk2(kt8[0], kt8[1]); o.y = pk2(kt8[2], kt8[3]); o.z = pk2(kt8[4], kt8[5]); o.w = pk2(kt8[6], kt8[7]);
            *(u32x4*)(ktt + r0) = o;
#pragma unroll
            for (int rr = 0; rr < 8; ++rr) { kc[rr] = kn[rr]; qc[rr] = qn[rr]; }
        }
        if (meta) {
            ((float*)(ws + OFF_DECM))[col] = expf(bsum);
            bf16_t* km = (bf16_t*)(ws + OFF_KTM);
            for (int r = 0; r < 48; ++r) km[r * 512 + col] = 0;
            u32x4 z = {0u, 0u, 0u, 0u};
            u32x4* kz = (u32x4*)((bf16_t*)(ws + OFF_KTTM) + (size_t)col * 64);
#pragma unroll
            for (int j = 0; j < 6; ++j) kz[j] = z;
        } else {
            ((float*)(ws + OFF_DEC))[((size_t)b * 64 + c) * 512 + col] = expf(bsum);
        }
    }
}

constexpr int A_KROWB = 272, A_VROWB = 144, A_KB = 64 * A_KROWB, A_VB = 128 * A_VROWB, A_STAGE = A_KB + A_VB;
DI void attn_s(const unsigned char* sK, int tt, int qb, int qs, int sub, int l31, int h,
               const bf16x8 (&qf)[4], f32x16 (&O)[4], float& m, float& l, bf16x8 (&pb)[4]) {
    const float SC = 0.125f * 1.4426950408889634f;
    f32x16 st[2];
#pragma unroll
    for (int k2 = 0; k2 < 2; ++k2)
#pragma unroll
        for (int i = 0; i < 16; ++i) st[k2][i] = 0.f;
    {
        const unsigned char* kb = sK + l31 * A_KROWB + (sub * 64 + 8 * h) * 2;
        bf16x8 ka[4], kc[4];
#pragma unroll
        for (int i = 0; i < 4; ++i) ka[i] = *(const bf16x8*)(kb + (i & 1) * 32 * A_KROWB + (i >> 1) * 32);
        __builtin_amdgcn_sched_barrier(0);
#pragma unroll
        for (int i = 0; i < 4; ++i) kc[i] = *(const bf16x8*)(kb + (i & 1) * 32 * A_KROWB + (2 + (i >> 1)) * 32);
        __builtin_amdgcn_sched_barrier(0);
#pragma unroll
        for (int i = 0; i < 4; ++i) st[i & 1] = MFMA32(ka[i], qf[i >> 1], st[i & 1]);
        __builtin_amdgcn_sched_barrier(0);
#pragma unroll
        for (int i = 0; i < 4; ++i) st[i & 1] = MFMA32(kc[i], qf[2 + (i >> 1)], st[i & 1]);
    }
    if (tt == 0) {
#pragma unroll
        for (int i = 0; i < 16; ++i) { st[0][i] = -INFINITY; if (i < 8) st[1][i] = -INFINITY; }
    } else if (tt >= 2 * qb + 1) {
        const int kbase = (tt - 1) * 64 + 4 * h;
#pragma unroll
        for (int k2 = 0; k2 < 2; ++k2)
#pragma unroll
            for (int i = 0; i < 16; ++i) {
                const int key = kbase + k2 * 32 + (i & 3) + 8 * (i >> 2);
                if (key > qs) st[k2][i] = -INFINITY;
            }
    }
    f32x16 mv;
#pragma unroll
    for (int i = 0; i < 16; ++i) mv[i] = fmaxf(st[0][i], st[1][i]);
    float mx = fmaxf(fmaxf(fmaxf(fmaxf(mv[0], mv[1]), mv[2]), fmaxf(fmaxf(mv[3], mv[4]), mv[5])), fmaxf(fmaxf(mv[6], mv[7]), mv[8]));
    mx = fmaxf(mx, fmaxf(fmaxf(fmaxf(mv[9], mv[10]), mv[11]), fmaxf(fmaxf(mv[12], mv[13]), mv[14])));
    mx = fmaxf(mx, mv[15]);
    mx = fmaxf(mx, __shfl_xor(mx, 32));
    const float mcand = fmaxf(m, mx);
    if (__builtin_amdgcn_ballot_w64((mcand - m) * SC > 8.0f) != 0ull) {
        const float alpha = __builtin_amdgcn_exp2f((m - mcand) * SC);
        m = mcand;
        l *= alpha;
#pragma unroll
        for (int d = 0; d < 4; ++d) O[d] = O[d] * alpha;
    }
    const float mc = m * SC;
#pragma unroll
    for (int k2 = 0; k2 < 2; ++k2) {
        st[k2] = st[k2] * SC - mc;
#pragma unroll
        for (int i = 0; i < 16; ++i) st[k2][i] = __builtin_amdgcn_exp2f(st[k2][i]);
    }
    {
        const f32x16 sv = st[0] + st[1];
        const float ps = (((sv[0] + sv[1]) + (sv[2] + sv[3])) + ((sv[4] + sv[5]) + (sv[6] + sv[7]))) + (((sv[8] + sv[9]) + (sv[10] + sv[11])) + ((sv[12] + sv[13]) + (sv[14] + sv[15])));
        l += ps;
    }
#pragma unroll
    for (int k4 = 0; k4 < 4; ++k4) {
        const int k2 = k4 >> 1, o8 = 8 * (k4 & 1);
        u32x4 pk;
        pk.x = pk2(st[k2][o8 + 0], st[k2][o8 + 1]); pk.y = pk2(st[k2][o8 + 2], st[k2][o8 + 3]);
        pk.z = pk2(st[k2][o8 + 4], st[k2][o8 + 5]); pk.w = pk2(st[k2][o8 + 6], st[k2][o8 + 7]);
        pb[k4] = __builtin_bit_cast(bf16x8, pk);
    }
}
DI void attn_pv(const unsigned char* sV, int l31, int h, const bf16x8 (&pb)[4], f32x16 (&O)[4]) {
    {
        const unsigned char* vb = sV + l31 * A_VROWB + 16 * h;
        bf16x8 va[4], vc[4];
#pragma unroll
        for (int d = 0; d < 4; ++d) va[d] = *(const bf16x8*)(vb + d * 32 * A_VROWB);
        __builtin_amdgcn_sched_barrier(0);
#pragma unroll
        for (int d = 0; d < 4; ++d) vc[d] = *(const bf16x8*)(vb + d * 32 * A_VROWB + 32);
        __builtin_amdgcn_sched_barrier(0);
#pragma unroll
        for (int d = 0; d < 4; ++d) O[d] = MFMA32(va[d], pb[0], O[d]);
        __builtin_amdgcn_sched_barrier(0);
#pragma unroll
        for (int d = 0; d < 4; ++d) va[d] = *(const bf16x8*)(vb + d * 32 * A_VROWB + 64);
        __builtin_amdgcn_sched_barrier(0);
#pragma unroll
        for (int d = 0; d < 4; ++d) O[d] = MFMA32(vc[d], pb[1], O[d]);
        __builtin_amdgcn_sched_barrier(0);
#pragma unroll
        for (int d = 0; d < 4; ++d) vc[d] = *(const bf16x8*)(vb + d * 32 * A_VROWB + 96);
        __builtin_amdgcn_sched_barrier(0);
#pragma unroll
        for (int d = 0; d < 4; ++d) O[d] = MFMA32(va[d], pb[2], O[d]);
        __builtin_amdgcn_sched_barrier(0);
#pragma unroll
        for (int d = 0; d < 4; ++d) O[d] = MFMA32(vc[d], pb[3], O[d]);
    }
}

DI void attn_item(const Params& p, unsigned char* lds, int b, int hd, int qb) {
    const int tid = opaque_tid(), lane = tid & 63, wave = tid >> 6, l31 = lane & 31, h = lane >> 5;
    const int sub = wave >> 2, rt = wave & 3;
    const bf16_t* aq = (const bf16_t*)((unsigned char*)p.out + DO_AQ);
    const bf16_t* ak = (const bf16_t*)(p.ws + OFF_AK);
    const bf16_t* avT = (const bf16_t*)(p.ws + OFF_AVT);
    const bf16_t* akm = (const bf16_t*)(p.ws + OFF_AKM);
    const bf16_t* avTm = (const bf16_t*)(p.ws + OFF_AVTM);
    bf16_t* az = (bf16_t*)(p.ws + OFF_AZ);
    const int qs = qb * 128 + rt * 32 + l31;
    const size_t grow = (size_t)b * 4096 + qs;
    bf16x8 qf[4];
#pragma unroll
    for (int ks = 0; ks < 4; ++ks) qf[ks] = *(const bf16x8*)(aq + grow * 1024 + hd * 128 + sub * 64 + ks * 16 + 8 * h);
    f32x16 O[4];
#pragma unroll
    for (int d = 0; d < 4; ++d)
#pragma unroll
        for (int i = 0; i < 16; ++i) O[d][i] = 0.f;
    float m = -INFINITY, l = 0.f;
    const int T = 2 * qb + 3;
    u32x4 k0r[2], v0r[2];
    const int krow_ = tid >> 4, kc_ = tid & 15, vdv_ = tid >> 3, vc_ = tid & 7;
    const bf16_t* kp = ak + ((size_t)b * 4096 + krow_) * 1024 + hd * 128 + kc_ * 8;
    const bf16_t* vp_ = avT + ((size_t)(b * 8 + hd) * 128 + vdv_) * 4096 + vc_ * 8;
#define A_LOAD_REAL(KR, VR)                                                                                                   \
    {                                                                                                                         \
        KR[0] = *(const u32x4*)kp; KR[1] = *(const u32x4*)(kp + 32 * 1024); kp += 64 * 1024;                                  \
        VR[0] = *(const u32x4*)vp_; VR[1] = *(const u32x4*)(vp_ + (size_t)64 * 4096); vp_ += 64;                              \
    }
#define A_STORE(KR, VR, buf_)                                                                                                 \
    {                                                                                                                         \
        unsigned char* sK_ = lds + (buf_) * A_STAGE; unsigned char* sV_ = sK_ + A_KB;                                         \
        _Pragma("unroll") for (int i = 0; i < 2; ++i) { const int pi = tid + 512 * i, row = pi >> 4, c = pi & 15;              \
            *(u32x4*)(sK_ + row * A_KROWB + c * 16) = KR[i]; }                                                                \
        _Pragma("unroll") for (int i = 0; i < 2; ++i) { const int pi = tid + 512 * i, dv = pi >> 3, c = pi & 7;                \
            unsigned char* d_ = sV_ + dv * A_VROWB + (c >> 1) * 32 + 8 * (c & 1); u32x2 a_, b_; a_.x = VR[i].x; a_.y = VR[i].y; b_.x = VR[i].z; b_.y = VR[i].w; \
            *(u32x2*)d_ = a_; *(u32x2*)(d_ + 16) = b_; }                                                                      \
    }
    {
        const bf16_t* km_ = akm + (size_t)krow_ * 1024 + hd * 128 + kc_ * 8;
        k0r[0] = *(const u32x4*)km_; k0r[1] = *(const u32x4*)(km_ + 32 * 1024);
        const bf16_t* vm_ = avTm + (size_t)(hd * 128 + vdv_) * 64 + vc_ * 8;
        v0r[0] = *(const u32x4*)vm_; v0r[1] = *(const u32x4*)(vm_ + 64 * 64);
    }
    A_STORE(k0r, v0r, 0);
    __syncthreads();
    bf16x8 pb[4];
    int bc = 0, bp = 2, bn = 1;
    for (int tt = 0; tt < T; ++tt) {
        if (tt + 1 < T) A_LOAD_REAL(k0r, v0r);
        if (sub == 0) {
            attn_s(lds + bc * A_STAGE, tt, qb, qs, sub, l31, h, qf, O, m, l, pb);
            attn_pv(lds + bc * A_STAGE + A_KB, l31, h, pb, O);
        } else {
            if (tt > 0) attn_pv(lds + bp * A_STAGE + A_KB, l31, h, pb, O);
            attn_s(lds + bc * A_STAGE, tt, qb, qs, sub, l31, h, qf, O, m, l, pb);
        }
        if (tt + 1 < T) A_STORE(k0r, v0r, bn);
        __syncthreads();
        bp = bc; bc = bn; bn = (bn == 2) ? 0 : bn + 1;
    }
    if (sub == 1) attn_pv(lds + bp * A_STAGE + A_KB, l31, h, pb, O);
    __syncthreads();
#undef A_LOAD_REAL
#undef A_STORE
    float lam;
    {
        const float a_ = wave_sum(p.lq1[lane] * p.lk1[lane]);
        const float b_ = wave_sum(p.lq2[lane] * p.lk2[lane]);
        lam = expf(a_) - expf(b_) + 0.2f;
    }
    const float ltot = l + __shfl_xor(l, 32);
    const float linv = 1.0f / ltot;
    float* ex = (float*)lds;
    if (sub == 1) {
#pragma unroll
        for (int d = 0; d < 4; ++d)
#pragma unroll
            for (int i = 0; i < 16; ++i) { ex[(rt * 32 + l31) * 129 + d * 32 + (i & 3) + 8 * (i >> 2) + 4 * h] = O[d][i] * linv; if (i == 15) __builtin_amdgcn_sched_barrier(0); }
    }
    __syncthreads();
    if (sub == 0) {
        float ss = 0.f;
#pragma unroll
        for (int d = 0; d < 4; ++d)
#pragma unroll
            for (int i = 0; i < 16; ++i) {
                const float o2 = ex[(rt * 32 + l31) * 129 + d * 32 + (i & 3) + 8 * (i >> 2) + 4 * h];
                const float o = O[d][i] * linv - lam * o2;
                O[d][i] = o; ss += o * o;
                if (i == 15) __builtin_amdgcn_sched_barrier(0);
            }
        ss += __shfl_xor(ss, 32);
        const float rstd = 1.0f / sqrtf(ss * (1.0f / 128.0f) + EPS);
#pragma unroll
        for (int d = 0; d < 4; ++d)
#pragma unroll
            for (int g = 0; g < 4; ++g) {
                bf16_t* zp = az + grow * 1024 + hd * 128 + d * 32 + 8 * g + 4 * h;
                const u32x2 zz = *(const u32x2*)zp;
                u32x2 o;
                o.x = pk2(O[d][4 * g] * rstd * siluf_(bflo(zz.x)), O[d][4 * g + 1] * rstd * siluf_(bfhi(zz.x)));
                o.y = pk2(O[d][4 * g + 2] * rstd * siluf_(bflo(zz.y)), O[d][4 * g + 3] * rstd * siluf_(bfhi(zz.y)));
                *(u32x2*)zp = o;
                if (g == 3) __builtin_amdgcn_sched_barrier(0);
            }
    }
    __syncthreads();
}

constexpr int L_KROWB = 272, L_VROWB = 144, L_SROWB = 272;
constexpr int GLA_DL = 4;
#define L_BAR() { asm volatile("s_waitcnt lgkmcnt(0)" ::: "memory"); __builtin_amdgcn_s_barrier(); asm volatile("" ::: "memory"); }
template <int DL>
DI void gla_item(const Params& p, unsigned char* lds, int b, int hh, int sl) {
    constexpr int SLW = 32 * DL, NVP = SLW / 64;
    constexpr int L_K = 0, L_V = 64 * L_KROWB, L_S = L_V + SLW * L_VROWB;
    const int tid = opaque_tid(), lane = tid & 63, wave = tid >> 6, l15 = lane & 15, g = lane >> 4;
    const int tt = wave & 3, dvt = wave >> 2;
    unsigned char* ws = p.ws;
    unsigned char* dout = (unsigned char*)p.out;
    const bf16_t* gq = (const bf16_t*)(dout + DO_GQ);
    const bf16_t* gk = (const bf16_t*)(dout + DO_GK);
    const bf16_t* gvT = (const bf16_t*)(ws + OFF_GVT);
    const bf16_t* ktt = (const bf16_t*)(ws + OFF_WIN_T);
    const float* dec = (const float*)(ws + OFF_DEC);
    bf16_t* gz = (bf16_t*)(ws + OFF_GZ);
    float* ssqb = (float*)(ws + OFF_SSQB);
    unsigned char* sK = lds + L_K; unsigned char* sV = lds + L_V; unsigned char* sS = lds + L_S;
    for (int i = tid; i < SLW * L_SROWB / 4; i += 512) ((unsigned*)sS)[i] = 0u;
    f32x4 sacc[DL][2];
#pragma unroll
    for (int dl = 0; dl < DL; ++dl)
#pragma unroll
        for (int c = 0; c < 2; ++c) sacc[dl][c] = (f32x4){0.f, 0.f, 0.f, 0.f};
    u32x4 nk[2]; u32x4 nv[NVP]; bf16x8 nq[4]; bf16x8 nkt[2][2]; float nd[2]; u32x2 ngz[DL];
    const int cc0 = 16 * (2 * tt) + l15;
    const int dv0 = 16 * (dvt * DL);
    const int krow_ = tid >> 4, kc_ = tid & 15, vdv_ = tid >> 3, vc_ = tid & 7;
    const bf16_t* kp = gk + ((size_t)b * 4096 + krow_) * 512 + hh * 128 + kc_ * 8;
    const bf16_t* vp_ = gvT + ((size_t)(b * 4 + hh) * 256 + sl * SLW + vdv_) * 4096 + vc_ * 8;
    const bf16_t* ktp = ktt + ((size_t)(b * 4 + hh) * 128 + cc0) * 4096 + 8 * g;
    const float* dp = dec + (size_t)b * 64 * 512 + hh * 128 + cc0;
    const bf16_t* qp = gq + ((size_t)b * 4096 + 16 * tt + l15) * 512 + hh * 128 + 8 * g;
    bf16_t* gzp = gz + ((size_t)b * 4096 + 16 * tt + l15) * 1024 + hh * 256 + sl * SLW + dv0 + 4 * g;
#define L_LOAD_META()                                                                                                         \
    {                                                                                                                         \
        const bf16_t* km_ = (const bf16_t*)(ws + OFF_KTM) + (size_t)krow_ * 512 + hh * 128 + kc_ * 8;                         \
        nk[0] = *(const u32x4*)km_; nk[1] = *(const u32x4*)(km_ + 32 * 512);                                                  \
        _Pragma("unroll") for (int i = 0; i < NVP; ++i)                                                                       \
            nv[i] = *(const u32x4*)((const bf16_t*)(ws + OFF_GVTM) + (size_t)(hh * 256 + sl * SLW + vdv_ + 64 * i) * 64 + vc_ * 8); \
        _Pragma("unroll") for (int ct = 0; ct < 2; ++ct) _Pragma("unroll") for (int ks = 0; ks < 2; ++ks)                     \
            nkt[ct][ks] = *(const bf16x8*)((const bf16_t*)(ws + OFF_KTTM) + (size_t)(hh * 128 + cc0 + 16 * ct) * 64 + 32 * ks + 8 * g); \
        _Pragma("unroll") for (int ct = 0; ct < 2; ++ct) nd[ct] = ((const float*)(ws + OFF_DECM))[hh * 128 + cc0 + 16 * ct];  \
        _Pragma("unroll") for (int ks = 0; ks < 4; ++ks) nq[ks] = (bf16x8){0, 0, 0, 0, 0, 0, 0, 0};                           \
        _Pragma("unroll") for (int dl = 0; dl < DL; ++dl) ngz[dl] = (u32x2){0u, 0u};                                          \
    }
#define L_LOAD_REAL()                                                                                                         \
    {                                                                                                                         \
        nk[0] = *(const u32x4*)kp; nk[1] = *(const u32x4*)(kp + 32 * 512); kp += 64 * 512;                                    \
        _Pragma("unroll") for (int i = 0; i < NVP; ++i) nv[i] = *(const u32x4*)(vp_ + (size_t)(64 * i) * 4096);               \
        vp_ += 64;                                                                                                            \
        _Pragma("unroll") for (int ct = 0; ct < 2; ++ct) _Pragma("unroll") for (int ks = 0; ks < 2; ++ks)                     \
            nkt[ct][ks] = *(const bf16x8*)(ktp + (size_t)(16 * ct) * 4096 + 32 * ks);                                         \
        ktp += 64;                                                                                                            \
        nd[0] = dp[0]; nd[1] = dp[16]; dp += 512;                                                                             \
        _Pragma("unroll") for (int ks = 0; ks < 4; ++ks) nq[ks] = *(const bf16x8*)(qp + 32 * ks);                             \
        qp += 64 * 512;                                                                                                       \
        _Pragma("unroll") for (int dl = 0; dl < DL; ++dl) ngz[dl] = *(const u32x2*)(gzp + 16 * dl);                           \
        gzp += 64 * 1024;                                                                                                     \
    }
#define L_STORE()                                                                                                             \
    {                                                                                                                         \
        _Pragma("unroll") for (int i = 0; i < 2; ++i) { const int pi = tid + 512 * i, row = pi >> 4, c = pi & 15;              \
            *(u32x4*)(sK + row * L_KROWB + c * 16) = nk[i]; }                                                                 \
        _Pragma("unroll") for (int i = 0; i < NVP; ++i) *(u32x4*)(sV + (vdv_ + 64 * i) * L_VROWB + vc_ * 16) = nv[i];          \
    }
    L_LOAD_META();
    L_STORE();
    for (int n = 0; n <= 64; ++n) {
        bf16x8 cq[4], ckt[2][2]; float cd[2]; u32x2 cgz[DL];
#pragma unroll
        for (int ks = 0; ks < 4; ++ks) cq[ks] = nq[ks];
#pragma unroll
        for (int ct = 0; ct < 2; ++ct) { cd[ct] = nd[ct]; ckt[ct][0] = nkt[ct][0]; ckt[ct][1] = nkt[ct][1]; }
#pragma unroll
        for (int dl = 0; dl < DL; ++dl) cgz[dl] = ngz[dl];
        L_BAR();
        if (n + 1 <= 64) L_LOAD_REAL();
        if (n > 0) {
            f32x4 at[4];
#pragma unroll
            for (int jt = 0; jt < 4; ++jt) at[jt] = (f32x4){0.f, 0.f, 0.f, 0.f};
            {
                const unsigned char* kb = sK + l15 * L_KROWB + 16 * g;
                bf16x8 ka[8], kc[8];
#pragma unroll
                for (int i = 0; i < 8; ++i) ka[i] = *(const bf16x8*)(kb + (i & 3) * 16 * L_KROWB + (i >> 2) * 64);
                __builtin_amdgcn_sched_barrier(0);
#pragma unroll
                for (int i = 0; i < 8; ++i) kc[i] = *(const bf16x8*)(kb + (i & 3) * 16 * L_KROWB + (2 + (i >> 2)) * 64);
                __builtin_amdgcn_sched_barrier(0);
#pragma unroll
                for (int i = 0; i < 8; ++i) at[i & 3] = MFMA16(ka[i], cq[i >> 2], at[i & 3]);
                __builtin_amdgcn_sched_barrier(0);
#pragma unroll
                for (int i = 0; i < 8; ++i) at[i & 3] = MFMA16(kc[i], cq[2 + (i >> 2)], at[i & 3]);
            }
            const int tl = 16 * tt + l15;
#pragma unroll
            for (int jt = 0; jt < 4; ++jt)
#pragma unroll
                for (int i = 0; i < 4; ++i) if (16 * jt + 4 * g + i > tl) at[jt][i] = 0.f;
            bf16x8 pa[2];
#pragma unroll
            for (int s2 = 0; s2 < 2; ++s2) {
                u32x4 t;
                t.x = pk2(at[2 * s2][0], at[2 * s2][1]); t.y = pk2(at[2 * s2][2], at[2 * s2][3]);
                t.z = pk2(at[2 * s2 + 1][0], at[2 * s2 + 1][1]); t.w = pk2(at[2 * s2 + 1][2], at[2 * s2 + 1][3]);
                pa[s2] = __builtin_bit_cast(bf16x8, t);
            }
            const size_t row = (size_t)b * 4096 + (n - 1) * 64 + 16 * tt + l15;
#pragma unroll
            for (int dl = 0; dl < DL; ++dl) {
                const int dvr = dv0 + 16 * dl + l15;
                f32x4 o = (f32x4){0.f, 0.f, 0.f, 0.f};
                {
                    u32x4 vv[2]; bf16x8 sf[4];
#pragma unroll
                    for (int s2 = 0; s2 < 2; ++s2) {
                        const unsigned char* vp = sV + dvr * L_VROWB + (32 * s2 + 4 * g) * 2;
                        const u32x2 lo = *(const u32x2*)vp, hi = *(const u32x2*)(vp + 32);
                        vv[s2].x = lo.x; vv[s2].y = lo.y; vv[s2].z = hi.x; vv[s2].w = hi.y;
                    }
#pragma unroll
                    for (int ks = 0; ks < 4; ++ks) sf[ks] = *(const bf16x8*)(sS + dvr * L_SROWB + (ks * 32 + 8 * g) * 2);
                    __builtin_amdgcn_sched_barrier(0);
                    f32x4 o2 = (f32x4){0.f, 0.f, 0.f, 0.f};
                    o = MFMA16(__builtin_bit_cast(bf16x8, vv[0]), pa[0], o);
                    o2 = MFMA16(sf[0], cq[0], o2);
                    o = MFMA16(__builtin_bit_cast(bf16x8, vv[1]), pa[1], o);
                    o2 = MFMA16(sf[1], cq[1], o2);
                    o = MFMA16(sf[2], cq[2], o);
                    o2 = MFMA16(sf[3], cq[3], o2);
                    o = o + o2;
                }
                float ss = (o[0] * o[0] + o[1] * o[1]) + (o[2] * o[2] + o[3] * o[3]);
                ss += __shfl_xor(ss, 16); ss += __shfl_xor(ss, 32);
                u32x2 ov;
                ov.x = pk2(o[0] * siluf_(bflo(cgz[dl].x)), o[1] * siluf_(bfhi(cgz[dl].x)));
                ov.y = pk2(o[2] * siluf_(bflo(cgz[dl].y)), o[3] * siluf_(bfhi(cgz[dl].y)));
                *(u32x2*)(gz + row * 1024 + hh * 256 + sl * SLW + dv0 + 16 * dl + 4 * g) = ov;
                if (g == 0) ssqb[(row * 4 + hh) * 16 + sl * 2 * DL + dvt * DL + dl] = ss;
            }
        }
        bf16x8 vfs[DL][2];
#pragma unroll
        for (int dl = 0; dl < DL; ++dl)
#pragma unroll
            for (int ks = 0; ks < 2; ++ks) vfs[dl][ks] = *(const bf16x8*)(sV + (dv0 + 16 * dl + l15) * L_VROWB + (32 * ks + 8 * g) * 2);
        __builtin_amdgcn_sched_barrier(0);
#pragma unroll
        for (int dl = 0; dl < DL; ++dl) {
#pragma unroll
            for (int ks = 0; ks < 2; ++ks) {
                sacc[dl][0] = MFMA16(vfs[dl][ks], ckt[0][ks], sacc[dl][0]);
                sacc[dl][1] = MFMA16(vfs[dl][ks], ckt[1][ks], sacc[dl][1]);
            }
#pragma unroll
            for (int ct = 0; ct < 2; ++ct)
#pragma unroll
                for (int i = 0; i < 4; ++i) sacc[dl][ct][i] *= cd[ct];
        }
        L_BAR();
#pragma unroll
        for (int dl = 0; dl < DL; ++dl)
#pragma unroll
            for (int ct = 0; ct < 2; ++ct)
#pragma unroll
                for (int i = 0; i < 4; ++i)
                    *(bf16_t*)(sS + (dv0 + 16 * dl + 4 * g + i) * L_SROWB + (cc0 + 16 * ct) * 2) = f2bf(sacc[dl][ct][i]);
        if (n + 1 <= 64) L_STORE();
    }
#undef L_LOAD_META
#undef L_LOAD_REAL
#undef L_STORE
    __syncthreads();
}

DI void phase2(const Params& p, unsigned char* lds) {
    const int tid = opaque_tid();
    volatile unsigned* sItem = (volatile unsigned*)(lds + LDS_ITEM);
    constexpr unsigned NSL = 8 / GLA_DL, N_GLA = 2 * NSL, N_ATT = 128;
    if (tid == 0) sItem[1] = 0u;
    for (;;) {
        if (tid == 0) {
            unsigned* heads = (unsigned*)(p.ws + OFF_CTR);
            const unsigned x0 = (unsigned)__builtin_amdgcn_s_getreg((3 << 11) | 20) & 7u;
            unsigned k = sItem[1], it = 0xffffffffu;
            while (k < 8u) {
                const unsigned x = (x0 + k) & 7u;
                const unsigned got = atomicAdd(heads + x, 1u);
                if (got < N_GLA + N_ATT) { it = got | (x << 16); break; }
                ++k;
            }
            sItem[1] = k; sItem[0] = it;
        }
        __syncthreads();
        const unsigned item = (unsigned)__builtin_amdgcn_readfirstlane((int)sItem[0]);
        __syncthreads();
        if (item == 0xffffffffu) break;
        const unsigned x = item >> 16, idx = item & 0xffffu;
        if (idx < N_GLA) { const unsigned gi = x * N_GLA + idx; gla_item<GLA_DL>(p, lds, gi / (4 * NSL), (gi / NSL) & 3, gi % NSL); }
        else { const unsigned a = idx - N_GLA, pair = 4 * x + (a >> 5); attn_item(p, lds, pair & 3, pair >> 2, 31 - (int)(a & 31)); }
    }
}

DI void phase25(const Params& p, unsigned char* lds) {
    const int tid = opaque_tid(), lane = tid & 63, wave = tid >> 6;
    const float* ssqb = (const float*)(p.ws + OFF_SSQB);
    bf16_t* gz = (bf16_t*)(p.ws + OFF_GZ);
    for (int it = blockIdx.x; it < MROWS / 8; it += gridDim.x) {
        const size_t row = (size_t)it * 8 + wave;
        float s = ssqb[(row * 4 + (lane >> 4)) * 16 + (lane & 15)];
        s += __shfl_xor(s, 1); s += __shfl_xor(s, 2); s += __shfl_xor(s, 4); s += __shfl_xor(s, 8);
        const float r = 1.0f / sqrtf(s * (1.0f / 256.0f) + EPS);
        u32x4* ptr = (u32x4*)(gz + row * 1024 + lane * 16);
#pragma unroll
        for (int j = 0; j < 2; ++j) {
            u32x4 u = ptr[j], o;
            o.x = pk2(bflo(u.x) * r, bfhi(u.x) * r); o.y = pk2(bflo(u.y) * r, bfhi(u.y) * r);
            o.z = pk2(bflo(u.z) * r, bfhi(u.z) * r); o.w = pk2(bflo(u.w) * r, bfhi(u.w) * r);
            ptr[j] = o;
        }
    }
}

template <int PASS>
struct EpiMerge {
    static constexpr bool PERM = false, AFTER_DRAIN = false;
    unsigned char* ws;
    DI void operator()(const pg8::f32x4 (&acc)[2][2][4][2], const pg8::Unit& u, int wr, int wc, int fr, int fq) const {
        const unsigned char* sg = ws + (PASS == 0 ? OFF_SGB : OFF_SGA);
        bf16_t* merged = (bf16_t*)(ws + OFF_AK);
#pragma unroll
        for (int ai = 0; ai < 2; ++ai)
#pragma unroll
            for (int m = 0; m < 4; ++m) {
                const size_t tok = (size_t)u.pm * 256 + ai * 128 + wr * 64 + m * 16 + fr;
#pragma unroll
                for (int bj = 0; bj < 2; ++bj)
#pragma unroll
                    for (int n = 0; n < 2; ++n) {
                        const size_t off = tok * 1024 + u.pn * 256 + bj * 128 + wc * 32 + n * 16 + 4 * fq;
                        const unsigned ug = *(const unsigned*)(sg + off);
                        const float q = 1.0f / 255.0f;
                        float m0 = (float)(ug & 255u) * q * acc[ai][bj][m][n][0], m1 = (float)((ug >> 8) & 255u) * q * acc[ai][bj][m][n][1];
                        float m2 = (float)((ug >> 16) & 255u) * q * acc[ai][bj][m][n][2], m3 = (float)(ug >> 24) * q * acc[ai][bj][m][n][3];
                        if (PASS == 1) { const u32x2 t = *(const u32x2*)(merged + off); m0 += bflo(t.x); m1 += bfhi(t.x); m2 += bflo(t.y); m3 += bfhi(t.y); }
                        u32x2 o; o.x = pk2(m0, m1); o.y = pk2(m2, m3);
                        *(u32x2*)(merged + off) = o;
                    }
            }
    }
};
struct EpiOut {
    static constexpr bool PERM = false, AFTER_DRAIN = true;
    unsigned char* ws; const float* x; float* out; const float* fw;
    DI void fused(pg8::f32x4 (&acc)[2][2][4][2], const pg8::Unit& u, int wr, int wc, int fr, int fq, PG8_LAS unsigned char* lds, int wid, int lane) const {
        float* ssqh = (float*)(ws + OFF_SSQH);
        unsigned* pcnt = (unsigned*)(ws + OFF_XBAR + 14336) + u.pm;
#pragma unroll
        for (int ai = 0; ai < 2; ++ai)
#pragma unroll
            for (int m = 0; m < 4; ++m) {
                const size_t tok = (size_t)u.pm * 256 + ai * 128 + wr * 64 + m * 16 + fr;
                float ss = 0.f;
#pragma unroll
                for (int bj = 0; bj < 2; ++bj)
#pragma unroll
                    for (int n = 0; n < 2; ++n) {
                        const size_t off = tok * 1024 + u.pn * 256 + bj * 128 + wc * 32 + n * 16 + 4 * fq;
                        const f32x4 xv = *(const f32x4*)(x + off);
                        f32x4 o = acc[ai][bj][m][n];
                        o.x += xv.x; o.y += xv.y; o.z += xv.z; o.w += xv.w;
                        acc[ai][bj][m][n] = o;
                        ss += (o.x * o.x + o.y * o.y) + (o.z * o.z + o.w * o.w);
                    }
                ss += __shfl_xor(ss, 16); ss += __shfl_xor(ss, 32);
                if (fq == 0) ssqh[tok * 16 + u.pn * 4 + wc] = ss;
            }
        asm volatile("s_waitcnt vmcnt(0)" ::: "memory");
        __syncthreads();
        if (threadIdx.x == 0) {
            __builtin_amdgcn_fence(__ATOMIC_RELEASE, "agent");
            asm volatile("s_waitcnt vmcnt(0)" ::: "memory");
            __hip_atomic_fetch_add(pcnt, 1u, __ATOMIC_RELAXED, __HIP_MEMORY_SCOPE_AGENT);
            unsigned spins = 0u;
            while (__hip_atomic_load(pcnt, __ATOMIC_RELAXED, __HIP_MEMORY_SCOPE_AGENT) < 4u && ++spins < (1u << 22)) __builtin_amdgcn_s_sleep(1);
            __builtin_amdgcn_fence(__ATOMIC_ACQUIRE, "agent");
            asm volatile("s_waitcnt vmcnt(0)" ::: "memory");
        }
        __syncthreads();
#pragma unroll
        for (int ai = 0; ai < 2; ++ai)
#pragma unroll
            for (int m = 0; m < 4; ++m) {
                const size_t tok = (size_t)u.pm * 256 + ai * 128 + wr * 64 + m * 16 + fr;
                const f32x4* sp = (const f32x4*)(ssqh + tok * 16);
                const f32x4 a = sp[0], b2 = sp[1], c = sp[2], d = sp[3];
                const float s = ((a.x + a.y) + (a.z + a.w)) + ((b2.x + b2.y) + (b2.z + b2.w)) + ((c.x + c.y) + (c.z + c.w)) + ((d.x + d.y) + (d.z + d.w));
                const float rstd = 1.0f / sqrtf(s * (1.0f / 1024.0f) + EPS);
#pragma unroll
                for (int bj = 0; bj < 2; ++bj)
#pragma unroll
                    for (int n = 0; n < 2; ++n) {
                        const int col = u.pn * 256 + bj * 128 + wc * 32 + n * 16 + 4 * fq;
                        const f32x4 w = *(const f32x4*)(fw + col);
                        f32x4 o = acc[ai][bj][m][n];
                        o.x = o.x * rstd * w.x; o.y = o.y * rstd * w.y; o.z = o.z * rstd * w.z; o.w = o.w * rstd * w.w;
                        *(f32x4*)(out + tok * 1024 + col) = o;
                    }
            }
    }
};
DI void phase3(const Params& p, unsigned char* lds) {
    SchedSq S;
    {
        pg8::Gemm g; g.A = (const bf16_t*)(p.ws + OFF_GZ); g.Bt = (const bf16_t*)(p.ws + OFF_WB_T); g.M = MROWS; g.N = 1024; g.K = 1024;
        EpiMerge<0> E; E.ws = p.ws;
        pg8::gemm_phase<EpiMerge<0>, SchedSq, true, true>((PG8_LAS unsigned char*)lds, g, S, E);
    }
    {
        pg8::Gemm g; g.A = (const bf16_t*)(p.ws + OFF_AZ); g.Bt = (const bf16_t*)(p.ws + OFF_WA_T); g.M = MROWS; g.N = 1024; g.K = 1024;
        EpiMerge<1> E; E.ws = p.ws;
        pg8::gemm_phase<EpiMerge<1>, SchedSq, true, true>((PG8_LAS unsigned char*)lds, g, S, E);
    }
}
DI void phase4(const Params& p, unsigned char* lds) {
    SchedSq S;
    pg8::Gemm g; g.A = (const bf16_t*)(p.ws + OFF_AK); g.Bt = (const bf16_t*)(p.ws + OFF_WO_T); g.M = MROWS; g.N = 1024; g.K = 1024;
    EpiOut E; E.ws = p.ws; E.x = p.x; E.out = p.out; E.fw = p.final_w;
    pg8::gemm_phase<EpiOut, SchedSq, false, true>((PG8_LAS unsigned char*)lds, g, S, E);
}

DI void phase5(const Params& p, unsigned char* lds) {
    const int tid = opaque_tid(), lane = tid & 63, wave = tid >> 6;
    const float* ssqh = (const float*)(p.ws + OFF_SSQH);
    for (int it = blockIdx.x; it < MROWS / 8; it += gridDim.x) {
        const size_t row = (size_t)it * 8 + wave;
        float s = lane < 16 ? ssqh[row * 16 + lane] : 0.f;
        s = wave_sum(s);
        const float rstd = 1.0f / sqrtf(s * (1.0f / 1024.0f) + EPS);
        f32x4* orow = (f32x4*)(p.out + row * 1024) + lane;
        const f32x4* wrow = (const f32x4*)p.final_w + lane;
#pragma unroll
        for (int j = 0; j < 4; ++j) {
            f32x4 v = orow[64 * j]; const f32x4 w = wrow[64 * j];
            v.x = v.x * rstd * w.x; v.y = v.y * rstd * w.y; v.z = v.z * rstd * w.z; v.w = v.w * rstd * w.w;
            orow[64 * j] = v;
        }
    }
}

#define XB_TMO      128
#define XB_XCNT(j)  (256  + 64 * (j))
#define XB_XSUB(j)  (1280 + 64 * (j))
#define XB_XGEN(j)  (2304 + 64 * (j))
#define XB_TOP      3328
#define XB_TOPGEN   3392
#define XCD_BAR_WORDS 3456
#define XB_SPIN_CAP (1u << 18)
#define LAS __attribute__((address_space(3)))
DI unsigned xb_ld(unsigned* p)              { return __hip_atomic_load(p, __ATOMIC_RELAXED, __HIP_MEMORY_SCOPE_AGENT); }
DI unsigned xb_add(unsigned* p, unsigned v) { return __hip_atomic_fetch_add(p, v, __ATOMIC_RELAXED, __HIP_MEMORY_SCOPE_AGENT); }
DI unsigned xb_xcc_id() { return (unsigned)__builtin_amdgcn_s_getreg((3 << 11) | 20) & 0xFu; }
#define XB_SPIN(cond, bar) do { unsigned _sp = 0; while (cond) { __builtin_amdgcn_s_sleep(1); \
    if ((++_sp & 255u) == 0u) { if (xb_ld(&(bar)[XB_TMO])) break; if (_sp > XB_SPIN_CAP) { atomicAdd(&(bar)[XB_TMO], 1u); break; } } } } while (0)
struct XcdBarrier { unsigned* bar; unsigned x; volatile LAS unsigned* st; };
DI XcdBarrier xcd_barrier_post(unsigned* bar, volatile LAS unsigned* st) {
    XcdBarrier b; b.bar = bar; b.x = xb_xcc_id(); b.st = st;
    if (threadIdx.x == 0) (void)xb_add(&bar[XB_XCNT(b.x)], 1u);
    return b;
}
DI void xcd_barrier_complete(unsigned* bar, unsigned x, unsigned& nloc, unsigned& nx) {
    const unsigned G = gridDim.x * gridDim.y * gridDim.z;
    unsigned sum, cnt, mine, sp = 0u;
    for (;;) {
        sum = 0u; cnt = 0u; mine = 0u;
#pragma unroll
        for (unsigned j = 0; j < 16; ++j) { const unsigned c = xb_ld(&bar[XB_XCNT(j)]); sum += c; cnt += (c > 0u) ? 1u : 0u; mine = (j == x) ? c : mine; }
        if (sum == G) break;
        __builtin_amdgcn_s_sleep(1);
        if ((++sp & 255u) == 0u) { if (xb_ld(&bar[XB_TMO])) break; if (sp > XB_SPIN_CAP) { atomicAdd(&bar[XB_TMO], 1u); break; } }
    }
    nloc = mine > 0u ? mine : 1u; nx = cnt > 0u ? cnt : 1u;
}
DI void xcd_barrier(const XcdBarrier& b) {
    asm volatile("s_waitcnt vmcnt(0)" ::: "memory");
    __syncthreads();
    if (threadIdx.x == 0) {
        unsigned* bar = b.bar;
        __builtin_amdgcn_s_waitcnt(0);
        unsigned nloc = b.st[0], nx = b.st[1];
        if (nloc == 0u) { xcd_barrier_complete(bar, b.x, nloc, nx); b.st[0] = nloc; b.st[1] = nx; }
        const unsigned old = xb_add(&bar[XB_XSUB(b.x)], 1u);
        const unsigned gen = old / nloc;
        if (old + 1u == (gen + 1u) * nloc) {
            __builtin_amdgcn_fence(__ATOMIC_RELEASE, "agent");
            asm volatile("s_waitcnt vmcnt(0)" ::: "memory");
            const unsigned og = xb_add(&bar[XB_TOP], 1u);
            const unsigned tg = og / nx;
            if (og + 1u == (tg + 1u) * nx) xb_add(&bar[XB_TOPGEN], 1u);
            else XB_SPIN(xb_ld(&bar[XB_TOPGEN]) == tg, bar);
            __builtin_amdgcn_fence(__ATOMIC_ACQUIRE, "agent");
            xb_add(&bar[XB_XGEN(b.x)], 1u);
            asm volatile("s_waitcnt vmcnt(0)" ::: "memory");
        } else {
            XB_SPIN(xb_ld(&bar[XB_XGEN(b.x)]) == gen, bar);
            __builtin_amdgcn_fence(__ATOMIC_ACQUIRE, "agent");
            asm volatile("s_waitcnt vmcnt(0)" ::: "memory");
        }
    }
    __syncthreads();
}

DI void run_phase(const Params& p, unsigned char* lds, int ph) {
    switch (ph) {
        case 0: phase0(p, lds); break;
        case 1: phase1(p, lds); break;
        case 2: phase15(p, lds); break;
        case 3: phase2(p, lds); break;
        case 4: phase25(p, lds); phase3(p, lds); break;
        case 5: phase4(p, lds); break;
        default: phase5(p, lds); break;
    }
}

__global__ void __launch_bounds__(512) hybrid_fwd(Params p) {
    extern __shared__ __attribute__((aligned(16))) unsigned char lds[];
#if MULTI_LAUNCH
    run_phase(p, lds, p.phase_lo);
#else
    cg::grid_group grid = cg::this_grid();
    if (p.phase_lo == 77) grid.sync();
    {
        volatile LAS unsigned* st = (volatile LAS unsigned*)(lds + LDS_ITEM + 16);
        if (threadIdx.x == 0) { st[0] = 0u; st[1] = 0u; }
        __syncthreads();
        (void)xcd_barrier_post((unsigned*)(p.ws + OFF_XBAR), st);
    }
#define GRID_BARRIER() { XcdBarrier xb_; xb_.bar = (unsigned*)(p.ws + OFF_XBAR); xb_.x = xb_xcc_id(); xb_.st = (volatile LAS unsigned*)(lds + LDS_ITEM + 16); xcd_barrier(xb_); }
    phase0(p, lds); GRID_BARRIER();
    phase1(p, lds); GRID_BARRIER();
    phase15(p, lds); GRID_BARRIER();
    phase2(p, lds); GRID_BARRIER();
    phase25(p, lds); GRID_BARRIER();
    phase3(p, lds); GRID_BARRIER();
    phase4(p, lds);
#endif
}

extern "C" void kernel_launch(void* const* d_in, const int* in_sizes, int n_in, void* d_out, int out_size, void* d_ws, size_t ws_size, hipStream_t stream) {
    static int grid = 0;
    if (grid == 0) {
        int dev = 0, cus = 0, per_cu = 0;
        hipGetDevice(&dev);
        hipDeviceGetAttribute(&cus, hipDeviceAttributeMultiprocessorCount, dev);
        hipFuncSetAttribute((const void*)hybrid_fwd, hipFuncAttributeMaxDynamicSharedMemorySize, LDS_BYTES);
        hipOccupancyMaxActiveBlocksPerMultiprocessor(&per_cu, (const void*)hybrid_fwd, 512, LDS_BYTES);
        if (per_cu < 1) per_cu = 1;
        if (per_cu > 1) per_cu = 1;
        if (cus <= 0) cus = 256;
        grid = cus * per_cu;
    }
    hipMemsetAsync((unsigned char*)d_ws + OFF_CTR, 0, 256, stream);
    hipMemsetAsync((unsigned char*)d_ws + OFF_XBAR, 0, 16384, stream);
    Params p{};
    p.x = (const float*)d_in[0]; p.meta = (const float*)d_in[1]; p.norm_w = (const float*)d_in[2]; p.w_in = (const float*)d_in[3];
    p.lq1 = (const float*)d_in[4]; p.lk1 = (const float*)d_in[5]; p.lq2 = (const float*)d_in[6]; p.lk2 = (const float*)d_in[7];
    p.subln_w = (const float*)d_in[8]; p.gate_w2 = (const float*)d_in[9]; p.gate_b = (const float*)d_in[10]; p.gla_norm_w = (const float*)d_in[11];
    p.wa = (const float*)d_in[12]; p.wb = (const float*)d_in[13]; p.wo = (const float*)d_in[14]; p.final_w = (const float*)d_in[15];
    p.out = (float*)d_out; p.ws = (unsigned char*)d_ws;
#if MULTI_LAUNCH
    for (int ph = 0; ph < 7; ++ph) {
        p.phase_lo = ph; p.phase_hi = ph + 1;
        hipLaunchKernelGGL(hybrid_fwd, dim3(grid), dim3(512), LDS_BYTES, stream, p);
    }
#else
    p.phase_lo = 0; p.phase_hi = 7;
    void* args[] = {&p};
    hipError_t e = hipLaunchCooperativeKernel((const void*)hybrid_fwd, dim3(grid), dim3(512), args, LDS_BYTES, stream);
    if (e != hipSuccess) fprintf(stderr, "cooperative launch failed: %s (grid %d)\n", hipGetErrorString(e), grid);
#endif
}
```

```cpp
#include <hip/hip_runtime.h>
#include <hip/hip_cooperative_groups.h>
#include <cstdio>
#include <cstdint>
namespace cg = cooperative_groups;

#ifndef MULTI_LAUNCH
#define MULTI_LAUNCH 0
#endif
#ifndef PROBE_REP
#define PROBE_REP 0
#endif

typedef unsigned short bf16_t;
typedef short bf16x8 __attribute__((ext_vector_type(8)));
typedef float f32x4 __attribute__((ext_vector_type(4)));
typedef float f32x2 __attribute__((ext_vector_type(2)));
typedef float f32x16 __attribute__((ext_vector_type(16)));
typedef unsigned u32x4 __attribute__((ext_vector_type(4)));
typedef unsigned u32x2 __attribute__((ext_vector_type(2)));
typedef __bf16 bfv2 __attribute__((ext_vector_type(2)));

#define DI __device__ __forceinline__
#define MFMA32(a, b, c) __builtin_amdgcn_mfma_f32_32x32x16_bf16((a), (b), (c), 0, 0, 0)
#define MFMA16(a, b, c) __builtin_amdgcn_mfma_f32_16x16x32_bf16((a), (b), (c), 0, 0, 0)

DI unsigned pk2(float a, float b) { f32x2 v = {a, b}; return __builtin_bit_cast(unsigned, __builtin_convertvector(v, bfv2)); }
DI float bf2f(bf16_t v) { return __uint_as_float(((unsigned)v) << 16); }
DI float bflo(unsigned u) { return __uint_as_float(u << 16); }
DI float bfhi(unsigned u) { return __uint_as_float(u & 0xffff0000u); }
DI bf16_t f2bf(float a) { return (bf16_t)(pk2(a, 0.f) & 0xffffu); }
DI float wave_sum(float v) {
#pragma unroll
    for (int o = 32; o; o >>= 1) v += __shfl_xor(v, o);
    return v;
}
DI int opaque_tid() { int t = threadIdx.x; asm volatile("" : "+v"(t)); return t; }
DI float xor32_sum(float x) { auto r = __builtin_amdgcn_permlane32_swap(__float_as_uint(x), __float_as_uint(x), false, false); return __uint_as_float(r[0]) + __uint_as_float(r[1]); }
DI float xor16_sum(float x) { auto r = __builtin_amdgcn_permlane16_swap(__float_as_uint(x), __float_as_uint(x), false, false); return __uint_as_float(r[0]) + __uint_as_float(r[1]); }
DI float xor32_max(float x) { auto r = __builtin_amdgcn_permlane32_swap(__float_as_uint(x), __float_as_uint(x), false, false); return fmaxf(__uint_as_float(r[0]), __uint_as_float(r[1])); }
DI float sigmoidf_(float z) { return __builtin_amdgcn_rcpf(1.f + __expf(-z)); }
DI float siluf_(float z) { return z * __builtin_amdgcn_rcpf(1.f + __expf(-z)); }

constexpr int D = 1024, NB = 4, SEQ = 4096, MROWS = NB * SEQ;
constexpr int NIN = 9232, NINP = 9344;
constexpr float EPS = 1e-5f;

constexpr size_t SZ_ACT = (size_t)MROWS * 1024 * 2;
constexpr size_t OFF_WIN_T = 0;
constexpr size_t OFF_WA_T = OFF_WIN_T + (size_t)NINP * 1024 * 2;
constexpr size_t OFF_WB_T = OFF_WA_T + 2097152;
constexpr size_t OFF_WO_T = OFF_WB_T + 2097152;
constexpr size_t OFF_AK = OFF_WO_T + 2097152;
constexpr size_t OFF_AVT = OFF_AK + SZ_ACT;
constexpr size_t OFF_AZ = OFF_AVT + SZ_ACT;
constexpr size_t OFF_GVT = OFF_AZ + SZ_ACT;
constexpr size_t OFF_GZ = OFF_GVT + SZ_ACT;
constexpr size_t OFF_GA = OFF_GZ + SZ_ACT;
constexpr size_t OFF_GB = OFF_GA + SZ_ACT;
constexpr size_t OFF_GLR = OFF_GB + SZ_ACT;
constexpr size_t OFF_RSTD = OFF_GLR + (size_t)MROWS * 16 * 2;
constexpr size_t OFF_ROPE = OFF_RSTD + 65792;
constexpr size_t OFF_AKM = OFF_ROPE + 263168;
constexpr size_t OFF_AVTM = OFF_AKM + 131072;
constexpr size_t OFF_GVTM = OFF_AVTM + 131072;
constexpr size_t OFF_GKM = OFF_GVTM + 131072;
constexpr size_t OFF_GLRM = OFF_GKM + 16384;
constexpr size_t OFF_KTM = OFF_GLRM + 512;
constexpr size_t OFF_KTTM = OFF_KTM + 65536;
constexpr size_t OFF_DEC = OFF_KTTM + 65536;
constexpr size_t OFF_DECM = OFF_DEC + 524288;
constexpr size_t OFF_SSQB = OFF_DECM + 2048;
constexpr size_t OFF_SSQH = OFF_SSQB + 4194304;
constexpr size_t OFF_CTR = OFF_SSQH + 1048576;
constexpr size_t OFF_XBM = OFF_CTR + 256;
constexpr size_t OFF_XBAR = OFF_XBM + 32768;
constexpr size_t WS_END = OFF_XBAR + 16384;
constexpr size_t OFF_XB = OFF_GA;
constexpr size_t OFF_SGA = OFF_GB;
constexpr size_t OFF_SGB = OFF_GB + (size_t)MROWS * 1024;
static_assert(WS_END <= 268435456ull, "workspace over 256 MiB");
constexpr size_t DO_AQ = 0, DO_GQ = SZ_ACT, DO_GK = SZ_ACT + SZ_ACT / 2;

constexpr int G_ROWB = 144;
constexpr int G_SW = 128 * G_ROWB, G_SX = 256 * G_ROWB, G_STAGE = G_SW + G_SX;
constexpr int G_SW4 = 256 * G_ROWB, G_STAGE4 = G_SW4 + G_SX;
constexpr int LDS_SCALE = 2 * G_STAGE4;
constexpr int LDS_ITEM = LDS_SCALE + 4096;
constexpr int LDS_BYTES = LDS_ITEM + 64;

struct Params {
    const float *x, *meta, *norm_w, *w_in, *lq1, *lk1, *lq2, *lk2, *subln_w, *gate_w2, *gate_b, *gla_norm_w, *wa, *wb, *wo, *final_w;
    float* out;
    unsigned char* ws;
    int phase_lo, phase_hi;
};

template <int MODE>
DI void p0_transpose_item(const Params& p, int item, float* tile) {
    const int tid = opaque_tid();
    const float* W = MODE == 0 ? p.w_in : MODE == 1 ? p.wa : MODE == 2 ? p.wb : p.wo;
    const int ldw = MODE == 0 ? NIN : 1024;
    const int nbc = MODE == 0 ? NINP / 128 : 8;
    bf16_t* WT = (bf16_t*)(p.ws + (MODE == 0 ? OFF_WIN_T : MODE == 1 ? OFF_WA_T : MODE == 2 ? OFF_WB_T : OFF_WO_T));
    const int kb = item / nbc, nb = item % nbc, k0 = kb * 64, n0 = nb * 128;
    const int nn = tid & 127, n = n0 + nn;
    int src = n;
    if (MODE == 0) { src = n < 7168 ? n : (n < 9216 ? n + 16 : (n < 9232 ? n - 2048 : -1)); }
    float v[16];
#pragma unroll
    for (int i = 0; i < 16; ++i) {
        const int k = k0 + (tid >> 7) + 4 * i;
        v[i] = src >= 0 ? W[(size_t)k * ldw + src] : 0.f;
    }
#pragma unroll
    for (int i = 0; i < 16; ++i) {
        const int kk = (tid >> 7) + 4 * i, k = k0 + kk;
        float sc = 1.f;
        if (MODE == 0) sc = p.norm_w[k];
        if (MODE == 1) sc = 0.8f * p.subln_w[k & 127];
        if (MODE == 2) sc = p.gla_norm_w[k & 255];
        tile[kk * 129 + nn] = v[i] * sc;
    }
    __syncthreads();
    {
        const int on = tid >> 2, c = tid & 3;
        const float* s = tile + (16 * c) * 129 + on;
        u32x4 o0, o1;
        o0.x = pk2(s[0 * 129], s[1 * 129]); o0.y = pk2(s[2 * 129], s[3 * 129]); o0.z = pk2(s[4 * 129], s[5 * 129]); o0.w = pk2(s[6 * 129], s[7 * 129]);
        o1.x = pk2(s[8 * 129], s[9 * 129]); o1.y = pk2(s[10 * 129], s[11 * 129]); o1.z = pk2(s[12 * 129], s[13 * 129]); o1.w = pk2(s[14 * 129], s[15 * 129]);
        u32x4* dst = (u32x4*)(WT + (size_t)(n0 + on) * 1024 + k0 + 16 * c);
        dst[0] = o0; dst[1] = o1;
    }
    __syncthreads();
}

DI void phase0(const Params& p, unsigned char* lds) {
    const int tid = opaque_tid(), lane = tid & 63, wave = tid >> 6;
    float* tile = (float*)lds;
    constexpr int I_WIN = 16 * (NINP / 128), I_SQ = 128;
    constexpr int I_T = I_WIN + 3 * I_SQ;
    constexpr int I_RSTD = (MROWS + 16 + 15) / 16;
    constexpr int I_ROPE = (4112 * 8 + 511) / 512;
    constexpr int I_ZERO = 393216 / 8192;
    constexpr int I_ALL = I_T + I_RSTD + I_ROPE + I_ZERO;
    for (int it = blockIdx.x; it < I_ALL; it += gridDim.x) {
        int r = it;
        if (r < I_WIN) { p0_transpose_item<0>(p, r, tile); continue; } r -= I_WIN;
        if (r < I_SQ) { p0_transpose_item<1>(p, r, tile); continue; } r -= I_SQ;
        if (r < I_SQ) { p0_transpose_item<2>(p, r, tile); continue; } r -= I_SQ;
        if (r < I_SQ) { p0_transpose_item<3>(p, r, tile); continue; } r -= I_SQ;
        if (r < I_RSTD) {
            const int row0 = r * 16 + wave * 2;
            f32x4 v[2][4];
#pragma unroll
            for (int q = 0; q < 2; ++q) {
                const int row = row0 + q < MROWS + 16 ? row0 + q : MROWS + 15;
                const float* srcp = row < MROWS ? p.x + (size_t)row * 1024 : p.meta + (size_t)(row - MROWS) * 1024;
                const f32x4* xr = (const f32x4*)srcp + lane;
#pragma unroll
                for (int j = 0; j < 4; ++j) v[q][j] = xr[64 * j];
            }
#pragma unroll
            for (int q = 0; q < 2; ++q) {
                const int row = row0 + q;
                float s = 0.f;
#pragma unroll
                for (int j = 0; j < 4; ++j) s += (v[q][j].x * v[q][j].x + v[q][j].y * v[q][j].y) + (v[q][j].z * v[q][j].z + v[q][j].w * v[q][j].w);
                s = wave_sum(s);
                if (row < MROWS + 16) {
                    if (lane == 0) ((float*)(p.ws + OFF_RSTD))[row] = 1.0f / sqrtf(s * (1.0f / 1024.0f) + EPS);
                    bf16_t* xbrow = row < MROWS ? (bf16_t*)(p.ws + OFF_XB) + (size_t)row * 1024 : (bf16_t*)(p.ws + OFF_XBM) + (size_t)(row - MROWS) * 1024;
#pragma unroll
                    for (int j = 0; j < 4; ++j) { u32x2 o; o.x = pk2(v[q][j].x, v[q][j].y); o.y = pk2(v[q][j].z, v[q][j].w); *(u32x2*)(xbrow + 256 * j + 4 * lane) = o; }
                }
            }
            continue;
        }
        r -= I_RSTD;
        if (r < I_ROPE) {
            const int e = r * 512 + tid;
            if (e < 4112 * 8) {
                const int pos = e >> 3, i = e & 7;
                const float inv = powf(500000.0f, -(float)i / 8.0f);
                const float ang = (float)pos * inv;
                float* t = (float*)(p.ws + OFF_ROPE) + (size_t)e * 2;
                t[0] = cosf(ang); t[1] = sinf(ang);
            }
            continue;
        }
        r -= I_ROPE;
        { u32x4 z = {0u, 0u, 0u, 0u}; *(u32x4*)(p.ws + OFF_AKM + (size_t)r * 8192 + tid * 16) = z; }
    }
}

namespace pg8 {
#define PG8_LAS __attribute__((address_space(3)))
typedef unsigned short bf16_t;
typedef short bf16x8 __attribute__((ext_vector_type(8)));
typedef float f32x4 __attribute__((ext_vector_type(4)));
typedef unsigned u32x4 __attribute__((ext_vector_type(4)));
constexpr int BM = 256, BK = 64, HALF = 128, HTB = HALF * BK * 2  , STAGE_BYTES = 8 * HTB, NXCD = 8, WGM = 8;

__host__ __device__ __forceinline__ int lds_byte(int r, int c) { const int st = (r >> 4) * 2 + (c >> 5), rr = r & 15, cc = c & 31, ob = rr * 64 + cc * 2; return st * 1024 + (ob ^ (((ob >> 9) & 1) << 5)); }
__host__ __device__ __forceinline__ void stage_rc(int b, int& R, int& C) { const int st = b / 1024, sb = b % 1024, swz = sb ^ (((sb >> 9) & 1) << 5); R = (st >> 1) * 16 + swz / 64; C = (st & 1) * 32 + (swz % 64) / 2; }
__host__ __device__ __forceinline__ int perm32(int rho) { const int n = rho >> 4, i = rho & 15; return 8 * (i >> 2) + 4 * n + (i & 3); }

struct Unit { int pm, pn; };
struct Gemm { const bf16_t* A; const bf16_t* Bt; int M, N, K; };

template <class Epi, class Sched, bool ALIGN_EPI = false, bool SP2 = false, bool HS = false>
__device__ __forceinline__ void gemm_phase(PG8_LAS unsigned char* lds, const Gemm g, const Sched& S, const Epi& E) {
    const int tid = opaque_tid(), wid = __builtin_amdgcn_readfirstlane(tid >> 6), lane = tid & 63, wr = wid >> 2, wc = wid & 3, fr = lane & 15, fq = lane >> 4;
    const int K = g.K, nt = K / BK;
    unsigned voffA[2], voffB[2];
#pragma unroll
    for (int i = 0; i < 2; ++i) { int R, C; stage_rc(tid * 16 + i * 8192, R, C); const int Rb = Epi::PERM ? ((R & ~31) + perm32(R & 31)) : R;
        voffA[i] = (unsigned)(R * K + C) * 2u; voffB[i] = (unsigned)(Rb * K + C) * 2u; }
    const size_t kstep = (size_t)(BK * 2);
    const size_t hstep = (size_t)HALF * K * 2;
    const size_t tstep = 2 * hstep;
    const unsigned ldsw = (unsigned)wid * 1024u;
    const int aoff = lds_byte(wr * 64 + fr, fq * 8), boff = lds_byte(wc * 32 + fr, fq * 8);
#define PG8_SA(b, h) (((b) * 2 + (h)) * HTB)
#define PG8_SB(b, h) ((4 + (b) * 2 + (h)) * HTB)
#define PG8_STAGE(bufoff, gbase, voff) do { _Pragma("unroll") for (int _i = 0; _i < 2; ++_i) \
        __builtin_amdgcn_global_load_lds((const unsigned*)((const char*)(gbase) + (voff)[_i]), (PG8_LAS unsigned*)(lds + (bufoff) + ldsw + _i * 8192), 16, 0, 0); } while (0)
#define PG8_LDA(dst, b, h) do { _Pragma("unroll") for (int m = 0; m < 4; ++m) _Pragma("unroll") for (int k = 0; k < 2; ++k) dst[m][k] = *(const PG8_LAS bf16x8*)(lds + PG8_SA(b, h) + aoff + m * 2048 + k * 1024); } while (0)
#define PG8_LDB(dst, b, h) do { _Pragma("unroll") for (int n = 0; n < 2; ++n) _Pragma("unroll") for (int k = 0; k < 2; ++k) dst[n][k] = *(const PG8_LAS bf16x8*)(lds + PG8_SB(b, h) + boff + n * 2048 + k * 1024); } while (0)
#define PG8_MMA(ai, bj, At, Bt) do { __builtin_amdgcn_s_setprio(1); _Pragma("unroll") for (int m = 0; m < 4; ++m) _Pragma("unroll") for (int n = 0; n < 2; ++n) _Pragma("unroll") for (int k = 0; k < 2; ++k) \
        acc[ai][bj][m][n] = __builtin_amdgcn_mfma_f32_16x16x32_bf16(Bt[n][k], At[m][k], acc[ai][bj][m][n], 0, 0, 0); __builtin_amdgcn_s_setprio(0); } while (0)
#define PG8_WAIT_V(n) asm volatile("s_waitcnt vmcnt(" #n ")" ::: "memory")
#define PG8_WAIT_L(n) asm volatile("s_waitcnt lgkmcnt(" #n ")" ::: "memory")
#define PG8_BAR __builtin_amdgcn_s_barrier()
#define PG8_SCHED __builtin_amdgcn_sched_barrier(0)
    Unit cur, nxt; int ui = 0;
    if (!S.next(0, cur)) return;
    f32x4 acc[2][2][4][2];
#pragma unroll
    for (int a = 0; a < 2; ++a)
#pragma unroll
        for (int b = 0; b < 2; ++b)
#pragma unroll
            for (int m = 0; m < 4; ++m)
#pragma unroll
                for (int n = 0; n < 2; ++n) acc[a][b][m][n] = (f32x4){0.f, 0.f, 0.f, 0.f};
    bf16x8 At[4][2], B0[2][2], B1[2][2];
    const char* cA = (const char*)g.A + (size_t)cur.pm * tstep; const char* cB = (const char*)g.Bt + (size_t)cur.pn * tstep;
    S.a_ready(cur);
    if constexpr (SP2) {
        PG8_STAGE(PG8_SB(0, 0), cB, voffB); PG8_STAGE(PG8_SB(0, 1), cB + hstep, voffB); PG8_STAGE(PG8_SA(0, 0), cA, voffA); PG8_STAGE(PG8_SA(0, 1), cA + hstep, voffA);
        if (wr == 1) PG8_BAR;
        PG8_WAIT_V(2); PG8_BAR;
        PG8_STAGE(PG8_SB(1, 0), cB + kstep, voffB); PG8_STAGE(PG8_SA(1, 0), cA + kstep, voffA); PG8_STAGE(PG8_SB(1, 1), cB + hstep + kstep, voffB);
        PG8_WAIT_V(6); PG8_BAR;
    } else {
        PG8_STAGE(PG8_SB(0, 0), cB, voffB); PG8_STAGE(PG8_SA(0, 0), cA, voffA); PG8_STAGE(PG8_SB(0, 1), cB + hstep, voffB); PG8_STAGE(PG8_SA(0, 1), cA + hstep, voffA);
        if (wr == 1) PG8_BAR;
        PG8_WAIT_V(4); PG8_BAR;
        PG8_STAGE(PG8_SB(1, 0), cB + kstep, voffB); PG8_STAGE(PG8_SA(1, 0), cA + kstep, voffA); PG8_STAGE(PG8_SB(1, 1), cB + hstep + kstep, voffB);
        PG8_WAIT_V(6); PG8_BAR;
    }
    for (;;) {
        const bool has_next = S.next(ui + 1, nxt);
        const char* nA = has_next ? (const char*)g.A + (size_t)nxt.pm * tstep : cA; const char* nB = has_next ? (const char*)g.Bt + (size_t)nxt.pn * tstep : cB;
        for (int t = 0; t < nt; t += 2) {
            if constexpr (HS) {
                if (t == 4 || t == 8 || t == 12) {
                    const PG8_LAS float* tab = (const PG8_LAS float*)(lds + 147456);
                    const int hj = (t >> 2) - 1;
#pragma unroll
                    for (int a = 0; a < 2; ++a)
#pragma unroll
                        for (int m = 0; m < 4; ++m) {
                            const float s = tab[(a * 128 + wr * 64 + m * 16 + fr) * 4 + hj];
#pragma unroll
                            for (int b = 0; b < 2; ++b)
#pragma unroll
                                for (int n = 0; n < 2; ++n) acc[a][b][m][n] = acc[a][b][m][n] * s;
                        }
                }
            }
            const bool last = (t == nt - 2);
            const char* a1 = cA + (size_t)(t + 1) * kstep;
            const char* a2 = last ? nA : cA + (size_t)(t + 2) * kstep; const char* b2 = last ? nB : cB + (size_t)(t + 2) * kstep;
            const char* a3 = a2 + kstep; const char* b3 = b2 + kstep;
            if (last && has_next) S.a_ready(nxt);
            if constexpr (SP2) {
            PG8_LDB(B0, 0, 0); PG8_LDB(B1, 0, 1); PG8_SCHED; PG8_LDA(At, 0, 0); PG8_STAGE(PG8_SA(1, 1), a1 + hstep, voffA);
            PG8_WAIT_V(8); PG8_WAIT_L(0); PG8_BAR; PG8_MMA(0, 0, At, B0); PG8_MMA(0, 1, At, B1); PG8_BAR; PG8_SCHED;
            PG8_LDA(At, 0, 1); PG8_STAGE(PG8_SB(0, 0), b2, voffB); PG8_STAGE(PG8_SB(0, 1), b2 + hstep, voffB); PG8_STAGE(PG8_SA(0, 0), a2, voffA);
            PG8_WAIT_V(8); PG8_WAIT_L(0); PG8_BAR; PG8_MMA(1, 0, At, B0); PG8_MMA(1, 1, At, B1); PG8_BAR; PG8_SCHED;
            PG8_LDB(B0, 1, 0); PG8_LDB(B1, 1, 1); PG8_SCHED; PG8_LDA(At, 1, 0); PG8_STAGE(PG8_SA(0, 1), a2 + hstep, voffA);
            PG8_WAIT_V(8); PG8_WAIT_L(0); PG8_BAR; PG8_MMA(0, 0, At, B0); PG8_MMA(0, 1, At, B1); PG8_BAR; PG8_SCHED;
            PG8_LDA(At, 1, 1); PG8_STAGE(PG8_SB(1, 0), b3, voffB); PG8_STAGE(PG8_SB(1, 1), b3 + hstep, voffB); PG8_STAGE(PG8_SA(1, 0), a3, voffA);
            PG8_WAIT_V(8); PG8_WAIT_L(0); PG8_BAR; PG8_MMA(1, 0, At, B0); PG8_MMA(1, 1, At, B1); PG8_BAR; PG8_SCHED;
            } else {
            PG8_LDB(B0, 0, 0); PG8_SCHED; PG8_LDA(At, 0, 0); PG8_STAGE(PG8_SA(1, 1), a1 + hstep, voffA);
            PG8_WAIT_L(8); PG8_BAR; PG8_WAIT_L(0); PG8_MMA(0, 0, At, B0); PG8_BAR; PG8_SCHED;
            PG8_LDB(B1, 0, 1); PG8_STAGE(PG8_SB(0, 0), b2, voffB);
            PG8_BAR; PG8_WAIT_L(0); PG8_MMA(0, 1, At, B1); PG8_BAR;
            PG8_LDA(At, 0, 1); PG8_STAGE(PG8_SA(0, 0), a2, voffA);
            PG8_BAR; PG8_WAIT_L(0); PG8_MMA(1, 0, At, B0); PG8_BAR; PG8_SCHED;
            PG8_STAGE(PG8_SB(0, 1), b2 + hstep, voffB);
            PG8_WAIT_V(6); PG8_BAR; PG8_MMA(1, 1, At, B1); PG8_BAR;
            PG8_LDB(B0, 1, 0); PG8_SCHED; PG8_LDA(At, 1, 0); PG8_STAGE(PG8_SA(0, 1), a2 + hstep, voffA);
            PG8_WAIT_L(8); PG8_BAR; PG8_WAIT_L(0); PG8_MMA(0, 0, At, B0); PG8_BAR; PG8_SCHED;
            PG8_LDB(B1, 1, 1); PG8_STAGE(PG8_SB(1, 0), b3, voffB);
            PG8_BAR; PG8_WAIT_L(0); PG8_MMA(0, 1, At, B1); PG8_BAR;
            PG8_LDA(At, 1, 1); PG8_STAGE(PG8_SA(1, 0), a3, voffA);
            PG8_BAR; PG8_WAIT_L(0); PG8_MMA(1, 0, At, B0); PG8_BAR; PG8_SCHED;
            PG8_STAGE(PG8_SB(1, 1), b3 + hstep, voffB);
            PG8_WAIT_V(6); PG8_BAR; PG8_MMA(1, 1, At, B1); PG8_BAR;
            }
        }
        if constexpr (ALIGN_EPI) { if (wr == 0) PG8_BAR; }
        if constexpr (!Epi::AFTER_DRAIN) { E(acc, cur, wr, wc, fr, fq); S.done(cur); }
        if (!has_next) break;
#pragma unroll
        for (int a = 0; a < 2; ++a)
#pragma unroll
            for (int b = 0; b < 2; ++b)
#pragma unroll
                for (int m = 0; m < 4; ++m)
#pragma unroll
                    for (int n = 0; n < 2; ++n) acc[a][b][m][n] = (f32x4){0.f, 0.f, 0.f, 0.f};
        cur = nxt; cA = nA; cB = nB; ++ui;
        if constexpr (ALIGN_EPI) { if (wr == 1) PG8_BAR; }
    }
    PG8_WAIT_V(0);
    if constexpr (!ALIGN_EPI) { if (wr == 0) PG8_BAR; }
    PG8_BAR;
    if constexpr (Epi::AFTER_DRAIN) { E.fused(acc, cur, wr, wc, fr, fq, lds, wid, lane); S.done(cur); }
#undef PG8_SA
#undef PG8_SB
#undef PG8_STAGE
#undef PG8_LDA
#undef PG8_LDB
#undef PG8_MMA
#undef PG8_WAIT_V
#undef PG8_WAIT_L
#undef PG8_BAR
#undef PG8_SCHED
}
}

DI unsigned sig_u8(float z) { return (unsigned)(255.0f * __builtin_amdgcn_rcpf(1.0f + __expf(-z)) + 0.5f); }
struct SchedP1 {
    DI bool next(int i, pg8::Unit& u) const {
        constexpr int NT = 36;
        const int id = (int)blockIdx.x + i * (int)gridDim.x;
        if (id >= 64 * NT) return false;
        const int g = id / (16 * NT), rem = id % (16 * NT), reg = rem >> 8, w = rem & 255, x = w & 7, j = w >> 3;
        int mt = g * 16 + 4 * (x & 3) + (j & 3), nt = reg * 16 + 8 * (x >> 2) + (j >> 2);
        if (reg == 2) { const int e = rem - 512; nt = 32 + (e >> 4); mt = g * 16 + (e & 15); }
        u.pm = mt; u.pn = nt; return true;
    }
    DI void a_ready(const pg8::Unit&) const {}
    DI void done(const pg8::Unit&) const {}
};
struct SchedSq {
    DI bool next(int i, pg8::Unit& u) const {
        const int id = (int)blockIdx.x + i * (int)gridDim.x;
        if (id >= 256) return false;
        u.pm = 8 * (id & 7) + ((id >> 3) & 7); u.pn = id >> 6; return true;
    }
    DI void a_ready(const pg8::Unit&) const {}
    DI void done(const pg8::Unit&) const {}
};
DI unsigned sig_u8x4(float a, float b, float c, float d) {
    unsigned r = 0u;
    r = __builtin_amdgcn_cvt_pk_u8_f32(255.0f * __builtin_amdgcn_rcpf(1.0f + __expf(-a)), 0, r);
    r = __builtin_amdgcn_cvt_pk_u8_f32(255.0f * __builtin_amdgcn_rcpf(1.0f + __expf(-b)), 1, r);
    r = __builtin_amdgcn_cvt_pk_u8_f32(255.0f * __builtin_amdgcn_rcpf(1.0f + __expf(-c)), 2, r);
    r = __builtin_amdgcn_cvt_pk_u8_f32(255.0f * __builtin_amdgcn_rcpf(1.0f + __expf(-d)), 3, r);
    return r;
}
struct EpiInProj {
    static constexpr bool PERM = true, AFTER_DRAIN = false;
    unsigned char* ws; unsigned char* dout;
    DI void operator()(const pg8::f32x4 (&acc)[2][2][4][2], const pg8::Unit& u, int wr, int wc, int fr, int fq) const {
        const int nt = u.pn;
        int split, nc0;
        if (nt < 4) { split = 0; nc0 = nt * 256; }
        else if (nt < 8) { split = 1; nc0 = (nt - 4) * 256; }
        else if (nt < 12) { split = 2; nc0 = (nt - 8) * 256; }
        else if (nt < 16) { split = 3; nc0 = (nt - 12) * 256; }
        else if (nt < 18) { split = 4; nc0 = (nt - 16) * 256; }
        else if (nt < 20) { split = 5; nc0 = (nt - 18) * 256; }
        else if (nt < 24) { split = 6; nc0 = (nt - 20) * 256; }
        else if (nt < 28) { split = 7; nc0 = (nt - 24) * 256; }
        else if (nt < 32) { split = 9; nc0 = (nt - 28) * 256; }
        else { split = 10; nc0 = (nt - 32) * 256; }
        const float* rstd = (const float*)(ws + OFF_RSTD);
        const float* rope = (const float*)(ws + OFF_ROPE);
        const bool do_rope = split <= 1 && (wc & 1) == 0;
#pragma unroll
        for (int ai = 0; ai < 2; ++ai)
#pragma unroll
            for (int m = 0; m < 4; ++m) {
                const int tok = u.pm * 256 + ai * 128 + wr * 64 + m * 16 + fr;
                const float rs = rstd[tok];
                const float rsq = split == 0 ? rs * (0.125f * 1.4426950408889634f) : rs;
                const int pos = 16 + (tok & 4095), b = tok >> 12, s = tok & 4095;
#pragma unroll
                for (int bj = 0; bj < 2; ++bj) {
                    const int nb = nc0 + bj * 128 + wc * 32 + 8 * fq;
                    float v[8];
#pragma unroll
                    for (int j = 0; j < 4; ++j) { v[j] = acc[ai][bj][m][0][j] * rsq; v[4 + j] = acc[ai][bj][m][1][j] * rsq; }
                    if (do_rope) {
                        const f32x4* cs = (const f32x4*)(rope + (size_t)pos * 16);
                        const f32x4 c01 = cs[0], c23 = cs[1], c45 = cs[2], c67 = cs[3];
                        const float cc[8] = {c01.x, c01.z, c23.x, c23.z, c45.x, c45.z, c67.x, c67.z};
                        const float sn[8] = {c01.y, c01.w, c23.y, c23.w, c45.y, c45.w, c67.y, c67.w};
#pragma unroll
                        for (int j = 0; j < 8; ++j) {
                            const float other = __shfl_xor(v[j], 16);
                            const float r0 = v[j] * cc[j] - other * sn[j], r1 = v[j] * cc[j] + other * sn[j];
                            v[j] = fq == 0 ? r0 : (fq == 1 ? r1 : v[j]);
                        }
                    }
                    if (split == 2 || split == 6) {
                        const int hshift = split == 2 ? 7 : 8, nheads = split == 2 ? 8 : 4, dvn = 1 << hshift;
                        bf16_t* base = (bf16_t*)(ws + (split == 2 ? OFF_AVT : OFF_GVT));
                        const int hd = nb >> hshift, dv0 = nb & (dvn - 1);
                        bf16_t* dst = base + ((size_t)(b * nheads + hd) * dvn + dv0) * 4096 + s;
#pragma unroll
                        for (int j = 0; j < 8; ++j) dst[(size_t)j * 4096] = f2bf(v[j]);
                    } else if (split >= 9) {
                        u32x2 o; o.x = sig_u8x4(v[0], v[1], v[2], v[3]); o.y = sig_u8x4(v[4], v[5], v[6], v[7]);
                        *(u32x2*)(ws + (split == 9 ? OFF_SGA : OFF_SGB) + (size_t)tok * 1024 + nb) = o;
                    } else {
                        bf16_t* dst; int ld;
                        switch (split) {
                            case 0: dst = (bf16_t*)(dout + DO_AQ); ld = 1024; break;
                            case 1: dst = (bf16_t*)(ws + OFF_AK); ld = 1024; break;
                            case 3: dst = (bf16_t*)(ws + OFF_AZ); ld = 1024; break;
                            case 4: dst = (bf16_t*)(dout + DO_GQ); ld = 512; break;
                            case 5: dst = (bf16_t*)(dout + DO_GK); ld = 512; break;
                            default: dst = (bf16_t*)(ws + OFF_GZ); ld = 1024; break;
                        }
                        u32x4 o; o.x = pk2(v[0], v[1]); o.y = pk2(v[2], v[3]); o.z = pk2(v[4], v[5]); o.w = pk2(v[6], v[7]);
                        *(u32x4*)(dst + (size_t)tok * ld + nb) = o;
                    }
                }
            }
    }
};

DI void p1_glr_job(const Params& p, unsigned char* lds, int job) {
    const int tid = opaque_tid(), lane = tid & 63, wave = tid >> 6, l15 = lane & 15, g = lane >> 4;
    const int rtile = wave & 3, khalf = wave >> 2;
    const bf16_t* xb = (const bf16_t*)(p.ws + OFF_XB);
    const bf16_t* wt = (const bf16_t*)(p.ws + OFF_WIN_T) + (size_t)9216 * 1024;
    const size_t row0 = (size_t)job * 64 + rtile * 16;
    const bf16_t* ap = xb + (row0 + l15) * 1024 + khalf * 512 + 8 * g;
    const bf16_t* bp = wt + (size_t)l15 * 1024 + khalf * 512 + 8 * g;
    f32x4 acc = (f32x4){0.f, 0.f, 0.f, 0.f};
    {
        bf16x8 av[16], bv[16];
#pragma unroll
        for (int ks = 0; ks < 16; ++ks) { av[ks] = *(const bf16x8*)(ap + ks * 32); bv[ks] = *(const bf16x8*)(bp + ks * 32); }
        f32x4 acc2 = (f32x4){0.f, 0.f, 0.f, 0.f};
#pragma unroll
        for (int ks = 0; ks < 16; ks += 2) { acc = MFMA16(av[ks], bv[ks], acc); acc2 = MFMA16(av[ks + 1], bv[ks + 1], acc2); }
        acc = acc + acc2;
    }
    f32x4* red = (f32x4*)lds;
    __syncthreads();
    if (khalf == 1) red[rtile * 64 + lane] = acc;
    __syncthreads();
    if (khalf == 0) {
        const f32x4 o = red[rtile * 64 + lane];
        const float* rstd = (const float*)(p.ws + OFF_RSTD);
        bf16_t* glr = (bf16_t*)(p.ws + OFF_GLR);
#pragma unroll
        for (int i = 0; i < 4; ++i) {
            const size_t row = row0 + 4 * g + i;
            glr[row * 16 + l15] = f2bf((acc[i] + o[i]) * rstd[row]);
        }
    }
    __syncthreads();
}

DI void p1_meta_job(const Params& p, unsigned char* lds, int job) {
    const int tid = opaque_tid(), lane = tid & 63, wave = tid >> 6, l15 = lane & 15, g = lane >> 4;
    int c0;
    if (job < 64) c0 = 1024 + job * 16;
    else if (job < 128) c0 = 2048 + (job - 64) * 16;
    else if (job < 160) c0 = 4608 + (job - 128) * 16;
    else if (job < 224) c0 = 5120 + (job - 160) * 16;
    else c0 = 9216;
    const bf16_t* xbm = (const bf16_t*)(p.ws + OFF_XBM);
    const bf16_t* wt = (const bf16_t*)(p.ws + OFF_WIN_T);
    const bf16_t* ap = xbm + (size_t)l15 * 1024 + wave * 128 + 8 * g;
    const bf16_t* bp = wt + (size_t)(c0 + l15) * 1024 + wave * 128 + 8 * g;
    f32x4 acc = (f32x4){0.f, 0.f, 0.f, 0.f};
#pragma unroll
    for (int ks = 0; ks < 4; ++ks) {
        const bf16x8 a = *(const bf16x8*)(ap + ks * 32), bb = *(const bf16x8*)(bp + ks * 32);
        acc = MFMA16(a, bb, acc);
    }
    f32x4* red = (f32x4*)lds;
    __syncthreads();
    red[wave * 64 + lane] = acc;
    __syncthreads();
    if (wave == 0) {
        f32x4 s = red[lane];
#pragma unroll
        for (int w = 1; w < 8; ++w) { const f32x4 t = red[w * 64 + lane]; s.x += t.x; s.y += t.y; s.z += t.z; s.w += t.w; }
        const float* rstd = (const float*)(p.ws + OFF_RSTD) + MROWS;
        const float* rope = (const float*)(p.ws + OFF_ROPE);
        unsigned char* ws = p.ws;
        const int col = c0 + l15;
#pragma unroll
        for (int i = 0; i < 4; ++i) {
            const int row = 4 * g + i;
            float v = s[i] * rstd[row];
            if (job < 64 && (c0 & 63) == 0) {
                const float other = __shfl_xor(v, 8);
                const float* cs = rope + ((size_t)row * 8 + (l15 & 7)) * 2;
                const float c = cs[0], sn = cs[1];
                v = (l15 < 8) ? (v * c - other * sn) : (v * c + other * sn);
            }
            const bf16_t val = f2bf(v);
            if (job < 64) ((bf16_t*)(ws + OFF_AKM))[(size_t)(48 + row) * 1024 + (col - 1024)] = val;
            else if (job < 128) { const int n = col - 2048; ((bf16_t*)(ws + OFF_AVTM))[(size_t)n * 64 + 48 + row] = val; }
            else if (job < 160) ((bf16_t*)(ws + OFF_GKM))[(size_t)row * 512 + (col - 4608)] = val;
            else if (job < 224) { const int n = col - 5120; ((bf16_t*)(ws + OFF_GVTM))[(size_t)n * 64 + 48 + row] = val; }
            else ((bf16_t*)(ws + OFF_GLRM))[row * 16 + l15] = val;
        }
    }
    __syncthreads();
}

DI void phase1(const Params& p, unsigned char* lds) {
    for (int j = blockIdx.x; j < 256; j += gridDim.x) p1_glr_job(p, lds, j);
    for (int j = blockIdx.x; j < 225; j += gridDim.x) p1_meta_job(p, lds, j);
    pg8::Gemm g; g.A = (const bf16_t*)(p.ws + OFF_XB); g.Bt = (const bf16_t*)(p.ws + OFF_WIN_T); g.M = MROWS; g.N = 9216; g.K = 1024;
    SchedP1 S; EpiInProj E; E.ws = p.ws; E.dout = (unsigned char*)p.out;
    pg8::gemm_phase<EpiInProj, SchedP1, true, true>((PG8_LAS unsigned char*)lds, g, S, E);
}

DI void phase15(const Params& p, unsigned char* lds) {
    const int tid = opaque_tid(), col = tid;
    float w2[16];
#pragma unroll
    for (int j = 0; j < 16; ++j) w2[j] = p.gate_w2[j * 512 + col];
    const float bias = p.gate_b[col];
    unsigned char* ws = p.ws;
    unsigned char* dout = (unsigned char*)p.out;
    for (int item = blockIdx.x; item < 257; item += gridDim.x) {
        const bool meta = item == 256;
        const int b = item >> 6, c = item & 63;
        const size_t row0 = (size_t)b * 4096 + c * 64;
        const bf16_t* glr = meta ? (const bf16_t*)(ws + OFF_GLRM) : (const bf16_t*)(ws + OFF_GLR) + row0 * 16;
        const int nrows = meta ? 16 : 64;
        bf16_t* qp = (bf16_t*)(dout + DO_GQ) + row0 * 512 + col;
        const bf16_t* kin = meta ? (const bf16_t*)(ws + OFF_GKM) + col : (const bf16_t*)(dout + DO_GK) + row0 * 512 + col;
        bf16_t* kout = meta ? (bf16_t*)(ws + OFF_KTM) + 48 * 512 + col : (bf16_t*)(dout + DO_GK) + row0 * 512 + col;
        bf16_t* ktt = meta ? (bf16_t*)(ws + OFF_KTTM) + (size_t)col * 64 + 48 : (bf16_t*)(ws + OFF_WIN_T) + ((size_t)b * 512 + col) * 4096 + c * 64;
        __syncthreads();
        if (tid < nrows * 2) ((u32x4*)lds)[tid] = ((const u32x4*)glr)[tid];
        __syncthreads();
        float bsum = 0.f;
        constexpr int GR = 16;
        bf16_t kc[GR], qc[GR], kn[GR], qn[GR];
#pragma unroll
        for (int rr = 0; rr < GR; ++rr) { kc[rr] = kin[(size_t)rr * 512]; qc[rr] = meta ? (bf16_t)0 : qp[(size_t)rr * 512]; }
        for (int r0 = 0; r0 < nrows; r0 += GR) {
            if (r0 + GR < nrows) {
#pragma unroll
                for (int rr = 0; rr < GR; ++rr) { kn[rr] = kin[(size_t)(r0 + GR + rr) * 512]; qn[rr] = meta ? (bf16_t)0 : qp[(size_t)(r0 + GR + rr) * 512]; }
            }
            float kt8[GR];
#pragma unroll
            for (int rr = 0; rr < GR; ++rr) {
                const int r = r0 + rr;
                const u32x4* g4 = (const u32x4*)(lds + r * 32);
                const u32x4 ga = g4[0], gb = g4[1];
                float gk = bias;
                gk += bflo(ga.x) * w2[0] + bfhi(ga.x) * w2[1] + bflo(ga.y) * w2[2] + bfhi(ga.y) * w2[3];
                gk += bflo(ga.z) * w2[4] + bfhi(ga.z) * w2[5] + bflo(ga.w) * w2[6] + bfhi(ga.w) * w2[7];
                gk += bflo(gb.x) * w2[8] + bfhi(gb.x) * w2[9] + bflo(gb.y) * w2[10] + bfhi(gb.y) * w2[11];
                gk += bflo(gb.z) * w2[12] + bfhi(gb.z) * w2[13] + bflo(gb.w) * w2[14] + bfhi(gb.w) * w2[15];
                const float lg = (fminf(gk, 0.f) - __logf(1.0f + __expf(-fabsf(gk)))) * (1.0f / 16.0f);
                bsum += lg;
                const float eb = __expf(bsum);
                const float kt = bf2f(kc[rr]) * __builtin_amdgcn_rcpf(eb);
                kt8[rr] = kt;
                kout[(size_t)r * 512] = f2bf(kt);
                if (!meta) qp[(size_t)r * 512] = f2bf(bf2f(qc[rr]) * 0.08838834764831845f * eb);
            }
#pragma unroll
            for (int hh8 = 0; hh8 < GR / 8; ++hh8) {
                u32x4 o; o.x = pk2(kt8[8 * hh8 + 0], kt8[8 * hh8 + 1]); o.y = pk2(kt8[8 * hh8 + 2], kt8[8 * hh8 + 3]);
                o.z = pk2(kt8[8 * hh8 + 4], kt8[8 * hh8 + 5]); o.w = pk2(kt8[8 * hh8 + 6], kt8[8 * hh8 + 7]);
                *(u32x4*)(ktt + r0 + 8 * hh8) = o;
            }
#pragma unroll
            for (int rr = 0; rr < GR; ++rr) { kc[rr] = kn[rr]; qc[rr] = qn[rr]; }
        }
        if (meta) {
            ((float*)(ws + OFF_DECM))[col] = expf(bsum);
            bf16_t* km = (bf16_t*)(ws + OFF_KTM);
            for (int r = 0; r < 48; ++r) km[r * 512 + col] = 0;
            u32x4 z = {0u, 0u, 0u, 0u};
            u32x4* kz = (u32x4*)((bf16_t*)(ws + OFF_KTTM) + (size_t)col * 64);
#pragma unroll
            for (int j = 0; j < 6; ++j) kz[j] = z;
        } else {
            ((float*)(ws + OFF_DEC))[((size_t)b * 64 + c) * 512 + col] = expf(bsum);
        }
    }
}

constexpr int A_KROWB = 272, A_VROWB = 144, A_KB = 64 * A_KROWB, A_VB = 128 * A_VROWB, A_STAGE = A_KB + A_VB;
DI float max3f(float a, float b, float c) { float r; asm("v_max3_f32 %0, %1, %2, %3" : "=v"(r) : "v"(a), "v"(b), "v"(c)); return r; }
DI void attn_s(const unsigned char* sK, int tt, int qb, int qs, int sub, int l31, int h,
               const bf16x8 (&qf)[4], f32x16 (&O)[4], float& m, float& l, bf16x8 (&pb)[4]) {
    f32x16 st[2];
#pragma unroll
    for (int k2 = 0; k2 < 2; ++k2)
#pragma unroll
        for (int i = 0; i < 16; ++i) st[k2][i] = -m;
    {
        const unsigned char* kb = sK + l31 * A_KROWB + (sub * 64 + 8 * h) * 2;
        bf16x8 ka[4], kc[4];
#pragma unroll
        for (int i = 0; i < 4; ++i) ka[i] = *(const bf16x8*)(kb + (i & 1) * 32 * A_KROWB + (i >> 1) * 32);
        __builtin_amdgcn_sched_barrier(0);
#pragma unroll
        for (int i = 0; i < 4; ++i) kc[i] = *(const bf16x8*)(kb + (i & 1) * 32 * A_KROWB + (2 + (i >> 1)) * 32);
        __builtin_amdgcn_sched_barrier(0);
#pragma unroll
        for (int i = 0; i < 4; ++i) st[i & 1] = MFMA32(ka[i], qf[i >> 1], st[i & 1]);
        __builtin_amdgcn_sched_barrier(0);
#pragma unroll
        for (int i = 0; i < 4; ++i) st[i & 1] = MFMA32(kc[i], qf[2 + (i >> 1)], st[i & 1]);
    }
    if (tt == 0) {
#pragma unroll
        for (int i = 0; i < 16; ++i) { st[0][i] = -INFINITY; if (i < 8) st[1][i] = -INFINITY; }
    } else if (tt >= 2 * qb + 1) {
        const int kbase = (tt - 1) * 64 + 4 * h;
#pragma unroll
        for (int k2 = 0; k2 < 2; ++k2)
#pragma unroll
            for (int i = 0; i < 16; ++i) {
                const int key = kbase + k2 * 32 + (i & 3) + 8 * (i >> 2);
                if (key > qs) st[k2][i] = -INFINITY;
            }
    }
    float mx;
    {
        float t[11];
#pragma unroll
        for (int i = 0; i < 5; ++i) t[i] = max3f(st[0][3 * i], st[0][3 * i + 1], st[0][3 * i + 2]);
#pragma unroll
        for (int i = 0; i < 5; ++i) t[5 + i] = max3f(st[1][3 * i], st[1][3 * i + 1], st[1][3 * i + 2]);
        t[10] = fmaxf(st[0][15], st[1][15]);
        const float u0 = max3f(t[0], t[1], t[2]), u1 = max3f(t[3], t[4], t[5]), u2 = max3f(t[6], t[7], t[8]);
        mx = max3f(max3f(u0, u1, u2), t[9], t[10]);
    }
    mx = xor32_max(mx);
    if (tt == 0 || __builtin_amdgcn_ballot_w64(mx > 8.0f) != 0ull) {
        const float delta = tt == 0 ? mx : fmaxf(mx, 0.f);
        const float alpha = __builtin_amdgcn_exp2f(-delta);
        m += delta;
        l *= alpha;
#pragma unroll
        for (int d = 0; d < 4; ++d) O[d] = O[d] * alpha;
#pragma unroll
        for (int k2 = 0; k2 < 2; ++k2) st[k2] = st[k2] - delta;
    }
#pragma unroll
    for (int k2 = 0; k2 < 2; ++k2)
#pragma unroll
        for (int i = 0; i < 16; ++i) st[k2][i] = __builtin_amdgcn_exp2f(st[k2][i]);
    {
        const f32x16 sv = st[0] + st[1];
        const float ps = (((sv[0] + sv[1]) + (sv[2] + sv[3])) + ((sv[4] + sv[5]) + (sv[6] + sv[7]))) + (((sv[8] + sv[9]) + (sv[10] + sv[11])) + ((sv[12] + sv[13]) + (sv[14] + sv[15])));
        l += ps;
    }
#pragma unroll
    for (int k4 = 0; k4 < 4; ++k4) {
        const int k2 = k4 >> 1, o8 = 8 * (k4 & 1);
        u32x4 pk;
        pk.x = pk2(st[k2][o8 + 0], st[k2][o8 + 1]); pk.y = pk2(st[k2][o8 + 2], st[k2][o8 + 3]);
        pk.z = pk2(st[k2][o8 + 4], st[k2][o8 + 5]); pk.w = pk2(st[k2][o8 + 6], st[k2][o8 + 7]);
        pb[k4] = __builtin_bit_cast(bf16x8, pk);
    }
}
DI void attn_pv(const unsigned char* sV, int l31, int h, const bf16x8 (&pb)[4], f32x16 (&O)[4]) {
    {
        const unsigned char* vb = sV + l31 * A_VROWB + 16 * h;
        bf16x8 va[4], vc[4];
#pragma unroll
        for (int d = 0; d < 4; ++d) va[d] = *(const bf16x8*)(vb + d * 32 * A_VROWB);
        __builtin_amdgcn_sched_barrier(0);
#pragma unroll
        for (int d = 0; d < 4; ++d) vc[d] = *(const bf16x8*)(vb + d * 32 * A_VROWB + 32);
        __builtin_amdgcn_sched_barrier(0);
#pragma unroll
        for (int d = 0; d < 4; ++d) O[d] = MFMA32(va[d], pb[0], O[d]);
        __builtin_amdgcn_sched_barrier(0);
#pragma unroll
        for (int d = 0; d < 4; ++d) va[d] = *(const bf16x8*)(vb + d * 32 * A_VROWB + 64);
        __builtin_amdgcn_sched_barrier(0);
#pragma unroll
        for (int d = 0; d < 4; ++d) O[d] = MFMA32(vc[d], pb[1], O[d]);
        __builtin_amdgcn_sched_barrier(0);
#pragma unroll
        for (int d = 0; d < 4; ++d) vc[d] = *(const bf16x8*)(vb + d * 32 * A_VROWB + 96);
        __builtin_amdgcn_sched_barrier(0);
#pragma unroll
        for (int d = 0; d < 4; ++d) O[d] = MFMA32(va[d], pb[2], O[d]);
        __builtin_amdgcn_sched_barrier(0);
#pragma unroll
        for (int d = 0; d < 4; ++d) O[d] = MFMA32(vc[d], pb[3], O[d]);
    }
}

DI void attn_item(const Params& p, unsigned char* lds, int b, int hd, int qb, float lam) {
    const int tid = opaque_tid(), lane = tid & 63, wave = tid >> 6, l31 = lane & 31, h = lane >> 5;
    const int sub = wave >> 2, rt = wave & 3;
    const bf16_t* aq = (const bf16_t*)((unsigned char*)p.out + DO_AQ);
    const bf16_t* ak = (const bf16_t*)(p.ws + OFF_AK);
    const bf16_t* avT = (const bf16_t*)(p.ws + OFF_AVT);
    const bf16_t* akm = (const bf16_t*)(p.ws + OFF_AKM);
    const bf16_t* avTm = (const bf16_t*)(p.ws + OFF_AVTM);
    bf16_t* az = (bf16_t*)(p.ws + OFF_AZ);
    const int qs = qb * 128 + rt * 32 + l31;
    const size_t grow = (size_t)b * 4096 + qs;
    bf16x8 qf[4];
#pragma unroll
    for (int ks = 0; ks < 4; ++ks) qf[ks] = *(const bf16x8*)(aq + grow * 1024 + hd * 128 + sub * 64 + ks * 16 + 8 * h);
    f32x16 O[4];
#pragma unroll
    for (int d = 0; d < 4; ++d)
#pragma unroll
        for (int i = 0; i < 16; ++i) O[d][i] = 0.f;
    float m = 0.f, l = 0.f;
    const int T = 2 * qb + 3;
    u32x4 k0r[2], v0r[2];
    const int krow_ = tid >> 4, kc_ = tid & 15, vdv_ = tid >> 3, vc_ = tid & 7;
    const bf16_t* kp = ak + ((size_t)b * 4096 + krow_) * 1024 + hd * 128 + kc_ * 8;
    const bf16_t* vp_ = avT + ((size_t)(b * 8 + hd) * 128 + vdv_) * 4096 + vc_ * 8;
#define A_LOAD_REAL(KR, VR)                                                                                                   \
    {                                                                                                                         \
        KR[0] = *(const u32x4*)kp; KR[1] = *(const u32x4*)(kp + 32 * 1024); kp += 64 * 1024;                                  \
        VR[0] = *(const u32x4*)vp_; VR[1] = *(const u32x4*)(vp_ + (size_t)64 * 4096); vp_ += 64;                              \
    }
#define A_STORE(KR, VR, buf_)                                                                                                 \
    {                                                                                                                         \
        unsigned char* sK_ = lds + (buf_) * A_STAGE; unsigned char* sV_ = sK_ + A_KB;                                         \
        _Pragma("unroll") for (int i = 0; i < 2; ++i) { const int pi = tid + 512 * i, row = pi >> 4, c = pi & 15;              \
            *(u32x4*)(sK_ + row * A_KROWB + c * 16) = KR[i]; }                                                                \
        _Pragma("unroll") for (int i = 0; i < 2; ++i) { const int pi = tid + 512 * i, dv = pi >> 3, c = pi & 7;                \
            unsigned char* d_ = sV_ + dv * A_VROWB + (c >> 1) * 32 + 8 * (c & 1); u32x2 a_, b_; a_.x = VR[i].x; a_.y = VR[i].y; b_.x = VR[i].z; b_.y = VR[i].w; \
            *(u32x2*)d_ = a_; *(u32x2*)(d_ + 16) = b_; }                                                                      \
    }
    {
        const bf16_t* km_ = akm + (size_t)krow_ * 1024 + hd * 128 + kc_ * 8;
        k0r[0] = *(const u32x4*)km_; k0r[1] = *(const u32x4*)(km_ + 32 * 1024);
        const bf16_t* vm_ = avTm + (size_t)(hd * 128 + vdv_) * 64 + vc_ * 8;
        v0r[0] = *(const u32x4*)vm_; v0r[1] = *(const u32x4*)(vm_ + 64 * 64);
    }
    u32x4 k1r[2], v1r[2];
    A_LOAD_REAL(k1r, v1r);
#pragma unroll
    for (int ks = 0; ks < 4; ++ks) asm volatile("" : "+v"(qf[ks]));
    A_STORE(k0r, v0r, 0);
    __syncthreads();
    bf16x8 pb[4];
    int bc = 0, bp = 2, bn = 1;
    {
        attn_s(lds + bc * A_STAGE, 0, qb, qs, sub, l31, h, qf, O, m, l, pb);
        attn_pv(lds + bc * A_STAGE + A_KB, l31, h, pb, O);
        A_STORE(k1r, v1r, bn);
        __syncthreads();
        bp = bc; bc = bn; bn = (bn == 2) ? 0 : bn + 1;
    }
    for (int tt = 1; tt < T; ++tt) {
        if (tt + 1 < T) A_LOAD_REAL(k0r, v0r);
        attn_s(lds + bc * A_STAGE, tt, qb, qs, sub, l31, h, qf, O, m, l, pb);
        attn_pv(lds + bc * A_STAGE + A_KB, l31, h, pb, O);
        if (tt + 1 < T) A_STORE(k0r, v0r, bn);
        __syncthreads();
        bp = bc; bc = bn; bn = (bn == 2) ? 0 : bn + 1;
    }

#undef A_LOAD_REAL
#undef A_STORE
    const float ltot = xor32_sum(l);
    const float linv = 1.0f / ltot;
    float* ex = (float*)lds;
    if (sub == 1) {
#pragma unroll
        for (int d = 0; d < 4; ++d) {
#pragma unroll
            for (int g = 0; g < 4; ++g) {
                f32x4 t; t.x = O[d][4 * g] * linv; t.y = O[d][4 * g + 1] * linv; t.z = O[d][4 * g + 2] * linv; t.w = O[d][4 * g + 3] * linv;
                *(f32x4*)(ex + (rt * 32 + l31) * 132 + d * 32 + 8 * g + 4 * h) = t;
            }
            __builtin_amdgcn_sched_barrier(0);
        }
    }
    __syncthreads();
    if (sub == 0) {
        float ss = 0.f;
#pragma unroll
        for (int d = 0; d < 4; ++d) {
#pragma unroll
            for (int g = 0; g < 4; ++g) {
                const f32x4 t = *(const f32x4*)(ex + (rt * 32 + l31) * 132 + d * 32 + 8 * g + 4 * h);
                const float o0 = O[d][4 * g] * linv - lam * t.x, o1 = O[d][4 * g + 1] * linv - lam * t.y;
                const float o2 = O[d][4 * g + 2] * linv - lam * t.z, o3 = O[d][4 * g + 3] * linv - lam * t.w;
                O[d][4 * g] = o0; O[d][4 * g + 1] = o1; O[d][4 * g + 2] = o2; O[d][4 * g + 3] = o3;
                ss += (o0 * o0 + o1 * o1) + (o2 * o2 + o3 * o3);
            }
            __builtin_amdgcn_sched_barrier(0);
        }
        ss = xor32_sum(ss);
        const float rstd = 1.0f / sqrtf(ss * (1.0f / 128.0f) + EPS);
#pragma unroll
        for (int d = 0; d < 4; ++d)
#pragma unroll
            for (int g = 0; g < 4; ++g) {
                bf16_t* zp = az + grow * 1024 + hd * 128 + d * 32 + 8 * g + 4 * h;
                const u32x2 zz = *(const u32x2*)zp;
                u32x2 o;
                o.x = pk2(O[d][4 * g] * rstd * siluf_(bflo(zz.x)), O[d][4 * g + 1] * rstd * siluf_(bfhi(zz.x)));
                o.y = pk2(O[d][4 * g + 2] * rstd * siluf_(bflo(zz.y)), O[d][4 * g + 3] * rstd * siluf_(bfhi(zz.y)));
                *(u32x2*)zp = o;
                if (g == 3) __builtin_amdgcn_sched_barrier(0);
            }
    }
    __syncthreads();
}

constexpr int L_KROWB = 272, L_VROWB = 144, L_SROWB = 272;
constexpr int GLA_DL = 2;
#define L_BAR() { asm volatile("s_waitcnt lgkmcnt(0)" ::: "memory"); __builtin_amdgcn_s_barrier(); asm volatile("" ::: "memory"); }
template <int DL>
DI void gla_item(const Params& p, unsigned char* lds, int b, int hh, int sl) {
    constexpr int SLW = 32 * DL, NVP = SLW / 64;
    constexpr int L_K = 0, L_V = 64 * L_KROWB, L_S = L_V + SLW * L_VROWB, L_KT = L_S + SLW * L_SROWB;
    const int tid = opaque_tid(), lane = tid & 63, wave = tid >> 6, l15 = lane & 15, g = lane >> 4;
    const int tt = wave & 3, dvt = wave >> 2;
    unsigned char* ws = p.ws;
    unsigned char* dout = (unsigned char*)p.out;
    const bf16_t* gq = (const bf16_t*)(dout + DO_GQ);
    const bf16_t* gk = (const bf16_t*)(dout + DO_GK);
    const bf16_t* gvT = (const bf16_t*)(ws + OFF_GVT);
    const bf16_t* ktt = (const bf16_t*)(ws + OFF_WIN_T);
    const float* dec = (const float*)(ws + OFF_DEC);
    bf16_t* gz = (bf16_t*)(ws + OFF_GZ);
    float* ssqb = (float*)(ws + OFF_SSQB);
    unsigned char* sK = lds + L_K; unsigned char* sV = lds + L_V; unsigned char* sS = lds + L_S; unsigned char* sKT = lds + L_KT;
    for (int i = tid; i < SLW * L_SROWB / 4; i += 512) ((unsigned*)sS)[i] = 0u;
    f32x4 sacc[DL][2];
#pragma unroll
    for (int dl = 0; dl < DL; ++dl)
#pragma unroll
        for (int c = 0; c < 2; ++c) sacc[dl][c] = (f32x4){0.f, 0.f, 0.f, 0.f};
    u32x4 nkA[2]; u32x4 nvA[NVP]; bf16x8 nqA[4]; u32x4 nktA[2]; float ndA[2]; u32x2 ngzA[DL];
    u32x4 nkB[2]; u32x4 nvB[NVP]; bf16x8 nqB[4]; u32x4 nktB[2]; float ndB[2]; u32x2 ngzB[DL];
    const int cc0 = 16 * (2 * tt) + l15;
    const int dv0 = 16 * (dvt * DL);
    const int krow_ = tid >> 4, kc_ = tid & 15, vdv_ = tid >> 3, vc_ = tid & 7;
    const bf16_t* kp = gk + ((size_t)b * 4096 + krow_) * 512 + hh * 128 + kc_ * 8;
    const bf16_t* vp_ = gvT + ((size_t)(b * 4 + hh) * 256 + sl * SLW + vdv_) * 4096 + vc_ * 8;
    const bf16_t* ktp = ktt + ((size_t)(b * 4 + hh) * 128 + vdv_) * 4096 + vc_ * 8;
    const float* dp = dec + (size_t)b * 64 * 512 + hh * 128 + cc0;
    const bf16_t* qp = gq + ((size_t)b * 4096 + 16 * tt + l15) * 512 + hh * 128 + 8 * g;
    bf16_t* gzp = gz + ((size_t)b * 4096 + 16 * tt + l15) * 1024 + hh * 256 + sl * SLW + dv0 + 4 * g;
#define L_LOAD_META(S)                                                                                                         \
    {                                                                                                                         \
        const bf16_t* km_ = (const bf16_t*)(ws + OFF_KTM) + (size_t)krow_ * 512 + hh * 128 + kc_ * 8;                         \
        nk##S[0] = *(const u32x4*)km_; nk##S[1] = *(const u32x4*)(km_ + 32 * 512);                                                  \
        _Pragma("unroll") for (int i = 0; i < NVP; ++i)                                                                       \
            nv##S[i] = *(const u32x4*)((const bf16_t*)(ws + OFF_GVTM) + (size_t)(hh * 256 + sl * SLW + vdv_ + 64 * i) * 64 + vc_ * 8); \
        _Pragma("unroll") for (int i = 0; i < 2; ++i)                                                                         \
            nkt##S[i] = *(const u32x4*)((const bf16_t*)(ws + OFF_KTTM) + (size_t)(hh * 128 + vdv_ + 64 * i) * 64 + vc_ * 8);     \
        _Pragma("unroll") for (int ct = 0; ct < 2; ++ct) nd##S[ct] = ((const float*)(ws + OFF_DECM))[hh * 128 + cc0 + 16 * ct];  \
        _Pragma("unroll") for (int ks = 0; ks < 4; ++ks) nq##S[ks] = (bf16x8){0, 0, 0, 0, 0, 0, 0, 0};                           \
        _Pragma("unroll") for (int dl = 0; dl < DL; ++dl) ngz##S[dl] = (u32x2){0u, 0u};                                          \
    }
#define L_LOAD_REAL(S)                                                                                                         \
    {                                                                                                                         \
        nk##S[0] = *(const u32x4*)kp; nk##S[1] = *(const u32x4*)(kp + 32 * 512); kp += 64 * 512;                                    \
        _Pragma("unroll") for (int i = 0; i < NVP; ++i) nv##S[i] = *(const u32x4*)(vp_ + (size_t)(64 * i) * 4096);               \
        vp_ += 64;                                                                                                            \
        _Pragma("unroll") for (int i = 0; i < 2; ++i) nkt##S[i] = *(const u32x4*)(ktp + (size_t)(64 * i) * 4096);              \
        ktp += 64;                                                                                                            \
        nd##S[0] = dp[0]; nd##S[1] = dp[16]; dp += 512;                                                                             \
        _Pragma("unroll") for (int ks = 0; ks < 4; ++ks) nq##S[ks] = *(const bf16x8*)(qp + 32 * ks);                             \
        qp += 64 * 512;                                                                                                       \
        _Pragma("unroll") for (int dl = 0; dl < DL; ++dl) ngz##S[dl] = *(const u32x2*)(gzp + 16 * dl);                           \
        gzp += 64 * 1024;                                                                                                     \
    }
#define L_STORE(S)                                                                                                             \
    {                                                                                                                         \
        _Pragma("unroll") for (int i = 0; i < 2; ++i) { const int pi = tid + 512 * i, row = pi >> 4, c = pi & 15;              \
            *(u32x4*)(sK + row * L_KROWB + c * 16) = nk##S[i]; }                                                                 \
        _Pragma("unroll") for (int i = 0; i < NVP; ++i) *(u32x4*)(sV + (vdv_ + 64 * i) * L_VROWB + vc_ * 16) = nv##S[i];          \
        _Pragma("unroll") for (int i = 0; i < 2; ++i) *(u32x4*)(sKT + (vdv_ + 64 * i) * L_VROWB + vc_ * 16) = nkt##S[i];          \
    }
    L_LOAD_META(A);
    L_LOAD_REAL(B);
    L_STORE(A);
#define GLA_STEP(n_, C, O) {                                                                                         \
        bf16x8 cq[4]; float cd[2]; u32x2 cgz[DL]; \
_Pragma("unroll") \
        for (int ks = 0; ks < 4; ++ks) cq[ks] = nq##C[ks]; \
_Pragma("unroll") \
        for (int ct = 0; ct < 2; ++ct) { cd[ct] = nd##C[ct]; } \
_Pragma("unroll") \
        for (int dl = 0; dl < DL; ++dl) cgz[dl] = ngz##C[dl]; \
_Pragma("unroll") \
        for (int ks = 0; ks < 4; ++ks) asm volatile("" : "+v"(cq[ks])); \
_Pragma("unroll") \
        for (int ct = 0; ct < 2; ++ct) { asm volatile("" : "+v"(cd[ct])); } \
_Pragma("unroll") \
        for (int dl = 0; dl < DL; ++dl) asm volatile("" : "+v"(cgz[dl])); \
        L_BAR(); \
        if ((n_) + 2 <= 64) L_LOAD_REAL(C); \
        if ((n_) > 0) { \
            f32x4 at[4]; \
_Pragma("unroll") \
            for (int jt = 0; jt < 4; ++jt) at[jt] = (f32x4){0.f, 0.f, 0.f, 0.f}; \
            { \
                const unsigned char* kb = sK + l15 * L_KROWB + 16 * g; \
                bf16x8 ka[8], kc[8]; \
_Pragma("unroll") \
                for (int i = 0; i < 8; ++i) ka[i] = *(const bf16x8*)(kb + (i & 3) * 16 * L_KROWB + (i >> 2) * 64); \
                __builtin_amdgcn_sched_barrier(0); \
_Pragma("unroll") \
                for (int i = 0; i < 8; ++i) kc[i] = *(const bf16x8*)(kb + (i & 3) * 16 * L_KROWB + (2 + (i >> 2)) * 64); \
                __builtin_amdgcn_sched_barrier(0); \
_Pragma("unroll") \
                for (int i = 0; i < 8; ++i) at[i & 3] = MFMA16(ka[i], cq[i >> 2], at[i & 3]); \
                __builtin_amdgcn_sched_barrier(0); \
_Pragma("unroll") \
                for (int i = 0; i < 8; ++i) at[i & 3] = MFMA16(kc[i], cq[2 + (i >> 2)], at[i & 3]); \
            } \
            const int tl = 16 * tt + l15; \
_Pragma("unroll") \
            for (int jt = 0; jt < 4; ++jt) \
_Pragma("unroll") \
                for (int i = 0; i < 4; ++i) if (16 * jt + 4 * g + i > tl) at[jt][i] = 0.f; \
            bf16x8 pa[2]; \
_Pragma("unroll") \
            for (int s2 = 0; s2 < 2; ++s2) { \
                u32x4 t; \
                t.x = pk2(at[2 * s2][0], at[2 * s2][1]); t.y = pk2(at[2 * s2][2], at[2 * s2][3]); \
                t.z = pk2(at[2 * s2 + 1][0], at[2 * s2 + 1][1]); t.w = pk2(at[2 * s2 + 1][2], at[2 * s2 + 1][3]); \
                pa[s2] = __builtin_bit_cast(bf16x8, t); \
            } \
            const size_t row = (size_t)b * 4096 + ((n_) - 1) * 64 + 16 * tt + l15; \
_Pragma("unroll") \
            for (int dl = 0; dl < DL; ++dl) { \
                const int dvr = dv0 + 16 * dl + l15; \
                f32x4 o = (f32x4){0.f, 0.f, 0.f, 0.f}; \
                { \
                    u32x4 vv[2]; bf16x8 sf[4]; \
_Pragma("unroll") \
                    for (int s2 = 0; s2 < 2; ++s2) { \
                        const unsigned char* vp = sV + dvr * L_VROWB + (32 * s2 + 4 * g) * 2; \
                        const u32x2 lo = *(const u32x2*)vp, hi = *(const u32x2*)(vp + 32); \
                        vv[s2].x = lo.x; vv[s2].y = lo.y; vv[s2].z = hi.x; vv[s2].w = hi.y; \
                    } \
_Pragma("unroll") \
                    for (int ks = 0; ks < 4; ++ks) sf[ks] = *(const bf16x8*)(sS + dvr * L_SROWB + (ks * 32 + 8 * g) * 2); \
                    __builtin_amdgcn_sched_barrier(0); \
                    f32x4 o2 = (f32x4){0.f, 0.f, 0.f, 0.f}; \
                    o = MFMA16(__builtin_bit_cast(bf16x8, vv[0]), pa[0], o); \
                    o2 = MFMA16(sf[0], cq[0], o2); \
                    o = MFMA16(__builtin_bit_cast(bf16x8, vv[1]), pa[1], o); \
                    o2 = MFMA16(sf[1], cq[1], o2); \
                    o = MFMA16(sf[2], cq[2], o); \
                    o2 = MFMA16(sf[3], cq[3], o2); \
                    o = o + o2; \
                } \
                float ss = (o[0] * o[0] + o[1] * o[1]) + (o[2] * o[2] + o[3] * o[3]); \
                ss = xor16_sum(ss); ss = xor32_sum(ss); \
                u32x2 ov; \
                ov.x = pk2(o[0] * siluf_(bflo(cgz[dl].x)), o[1] * siluf_(bfhi(cgz[dl].x))); \
                ov.y = pk2(o[2] * siluf_(bflo(cgz[dl].y)), o[3] * siluf_(bfhi(cgz[dl].y))); \
                *(u32x2*)(gz + row * 1024 + hh * 256 + sl * SLW + dv0 + 16 * dl + 4 * g) = ov; \
                if (g == 0) ssqb[(row * 4 + hh) * 16 + sl * 2 * DL + dvt * DL + dl] = ss; \
            } \
        } \
        bf16x8 vfs[DL][2]; \
_Pragma("unroll") \
        for (int dl = 0; dl < DL; ++dl) \
_Pragma("unroll") \
            for (int ks = 0; ks < 2; ++ks) vfs[dl][ks] = *(const bf16x8*)(sV + (dv0 + 16 * dl + l15) * L_VROWB + (32 * ks + 8 * g) * 2); \
        bf16x8 ckt[2][2]; \
        _Pragma("unroll") \
        for (int ct = 0; ct < 2; ++ct) \
        _Pragma("unroll") \
            for (int ks = 0; ks < 2; ++ks) ckt[ct][ks] = *(const bf16x8*)(sKT + (cc0 + 16 * ct) * L_VROWB + (32 * ks + 8 * g) * 2); \
        __builtin_amdgcn_sched_barrier(0); \
_Pragma("unroll") \
        for (int dl = 0; dl < DL; ++dl) { \
_Pragma("unroll") \
            for (int ks = 0; ks < 2; ++ks) { \
                sacc[dl][0] = MFMA16(vfs[dl][ks], ckt[0][ks], sacc[dl][0]); \
                sacc[dl][1] = MFMA16(vfs[dl][ks], ckt[1][ks], sacc[dl][1]); \
            } \
_Pragma("unroll") \
            for (int ct = 0; ct < 2; ++ct) \
_Pragma("unroll") \
                for (int i = 0; i < 4; ++i) sacc[dl][ct][i] *= cd[ct]; \
        } \
        L_BAR(); \
_Pragma("unroll") \
        for (int dl = 0; dl < DL; ++dl) \
_Pragma("unroll") \
            for (int ct = 0; ct < 2; ++ct) \
_Pragma("unroll") \
                for (int i = 0; i < 4; ++i) \
                    *(bf16_t*)(sS + (dv0 + 16 * dl + 4 * g + i) * L_SROWB + (cc0 + 16 * ct) * 2) = f2bf(sacc[dl][ct][i]); \
        if ((n_) + 1 <= 64) L_STORE(O); \
    }
    for (int n2 = 0; n2 <= 64; n2 += 2) {
        GLA_STEP(n2, A, B);
        if (n2 + 1 > 64) break;
        GLA_STEP(n2 + 1, B, A);
    }
#undef GLA_STEP
#undef L_LOAD_META
#undef L_LOAD_REAL
#undef L_STORE
    __syncthreads();
}

DI void phase2(const Params& p, unsigned char* lds) {
    const int tid = opaque_tid();
    float lam;
    {
        const int lane = tid & 63;
        const float a_ = wave_sum(p.lq1[lane] * p.lk1[lane]);
        const float b_ = wave_sum(p.lq2[lane] * p.lk2[lane]);
        lam = __uint_as_float((unsigned)__builtin_amdgcn_readfirstlane((int)__float_as_uint(expf(a_) - expf(b_) + 0.2f)));
    }
    volatile unsigned* sItem = (volatile unsigned*)(lds + LDS_ITEM);
    constexpr unsigned NSL = 8 / GLA_DL, N_GLA = 2 * NSL, N_ATT = 128;
    if (tid == 0) sItem[1] = 0u;
    for (;;) {
        if (tid == 0) {
            unsigned* heads = (unsigned*)(p.ws + OFF_XBAR + 15360);
            const unsigned x0 = (unsigned)__builtin_amdgcn_s_getreg((3 << 11) | 20) & 7u;
            unsigned k = sItem[1], it = 0xffffffffu;
            while (k < 8u) {
                const unsigned x = (x0 + k) & 7u;
                const unsigned got = atomicAdd(heads + x, 1u);
                if (got < N_GLA + N_ATT) { it = got | (x << 16); break; }
                ++k;
            }
            sItem[1] = k; sItem[0] = it;
        }
        __syncthreads();
        const unsigned item = (unsigned)__builtin_amdgcn_readfirstlane((int)sItem[0]);
        __syncthreads();
        if (item == 0xffffffffu) break;
        const unsigned x = item >> 16, idx = item & 0xffffu;
        if (idx < N_GLA) { const unsigned gi = x * N_GLA + idx; gla_item<GLA_DL>(p, lds, gi / (4 * NSL), (gi / NSL) & 3, gi % NSL); }
        else { const unsigned a = idx - N_GLA, pair = 4 * x + (a >> 5); attn_item(p, lds, pair & 3, pair >> 2, 31 - (int)(a & 31), lam); }
    }
}

DI void phase25(const Params& p, unsigned char* lds) {
    const int tid = opaque_tid(), lane = tid & 63, wave = tid >> 6;
    const float* ssqb = (const float*)(p.ws + OFF_SSQB);
    bf16_t* gz = (bf16_t*)(p.ws + OFF_GZ);
    for (int it = blockIdx.x; it < MROWS / 32; it += gridDim.x) {
        const size_t row0 = (size_t)it * 32 + wave * 4;
        u32x4 u[4][2]; float s[4];
#pragma unroll
        for (int q = 0; q < 4; ++q) {
            const u32x4* ptr = (const u32x4*)(gz + (row0 + q) * 1024 + lane * 16);
            u[q][0] = ptr[0]; u[q][1] = ptr[1];
            s[q] = ssqb[((row0 + q) * 4 + (lane >> 4)) * 16 + (lane & 15)];
        }
#pragma unroll
        for (int q = 0; q < 4; ++q) {
            float t = s[q];
            t += __shfl_xor(t, 1); t += __shfl_xor(t, 2); t += __shfl_xor(t, 4); t += __shfl_xor(t, 8);
            const float r = 1.0f / sqrtf(t * (1.0f / 256.0f) + EPS);
            u32x4* ptr = (u32x4*)(gz + (row0 + q) * 1024 + lane * 16);
#pragma unroll
            for (int j = 0; j < 2; ++j) {
                const u32x4 a = u[q][j]; u32x4 o;
                o.x = pk2(bflo(a.x) * r, bfhi(a.x) * r); o.y = pk2(bflo(a.y) * r, bfhi(a.y) * r);
                o.z = pk2(bflo(a.z) * r, bfhi(a.z) * r); o.w = pk2(bflo(a.w) * r, bfhi(a.w) * r);
                ptr[j] = o;
            }
        }
    }
}

template <int PASS>
struct EpiMerge {
    static constexpr bool PERM = false, AFTER_DRAIN = false;
    unsigned char* ws; const PG8_LAS float* tab;
    DI void operator()(const pg8::f32x4 (&acc)[2][2][4][2], const pg8::Unit& u, int wr, int wc, int fr, int fq) const {
        const unsigned char* sg = ws + (PASS == 0 ? OFF_SGB : OFF_SGA);
        bf16_t* merged = (bf16_t*)(ws + OFF_AK);
#pragma unroll
        for (int ai = 0; ai < 2; ++ai)
#pragma unroll
            for (int m = 0; m < 4; ++m) {
                const size_t tok = (size_t)u.pm * 256 + ai * 128 + wr * 64 + m * 16 + fr;
#pragma unroll
                for (int bj = 0; bj < 2; ++bj)
#pragma unroll
                    for (int n = 0; n < 2; ++n) {
                        const size_t off = tok * 1024 + u.pn * 256 + bj * 128 + wc * 32 + n * 16 + 4 * fq;
                        const unsigned ug = *(const unsigned*)(sg + off);
                        const float q = (PASS == 0 ? tab[(ai * 128 + wr * 64 + m * 16 + fr) * 4 + 3] : 1.0f) * (1.0f / 255.0f);
                        float m0 = (float)(ug & 255u) * q * acc[ai][bj][m][n][0], m1 = (float)((ug >> 8) & 255u) * q * acc[ai][bj][m][n][1];
                        float m2 = (float)((ug >> 16) & 255u) * q * acc[ai][bj][m][n][2], m3 = (float)(ug >> 24) * q * acc[ai][bj][m][n][3];
                        if (PASS == 1) { const u32x2 t = *(const u32x2*)(merged + off); m0 += bflo(t.x); m1 += bfhi(t.x); m2 += bflo(t.y); m3 += bfhi(t.y); }
                        u32x2 o; o.x = pk2(m0, m1); o.y = pk2(m2, m3);
                        *(u32x2*)(merged + off) = o;
                    }
            }
    }
};
struct EpiOut {
    static constexpr bool PERM = false, AFTER_DRAIN = true;
    unsigned char* ws; const float* x; float* out; const float* fw;
    DI void fused(pg8::f32x4 (&acc)[2][2][4][2], const pg8::Unit& u, int wr, int wc, int fr, int fq, PG8_LAS unsigned char* lds, int wid, int lane) const {
        float* ssqh = (float*)(ws + OFF_SSQH);
        unsigned* pcnt = (unsigned*)(ws + OFF_XBAR + 14336) + u.pm;
#pragma unroll
        for (int ai = 0; ai < 2; ++ai)
#pragma unroll
            for (int m = 0; m < 4; ++m) {
                const size_t tok = (size_t)u.pm * 256 + ai * 128 + wr * 64 + m * 16 + fr;
                float ss = 0.f;
#pragma unroll
                for (int bj = 0; bj < 2; ++bj)
#pragma unroll
                    for (int n = 0; n < 2; ++n) {
                        const size_t off = tok * 1024 + u.pn * 256 + bj * 128 + wc * 32 + n * 16 + 4 * fq;
                        const f32x4 xv = *(const f32x4*)(x + off);
                        f32x4 o = acc[ai][bj][m][n];
                        o.x += xv.x; o.y += xv.y; o.z += xv.z; o.w += xv.w;
                        acc[ai][bj][m][n] = o;
                        ss += (o.x * o.x + o.y * o.y) + (o.z * o.z + o.w * o.w);
                    }
                ss = xor16_sum(ss); ss = xor32_sum(ss);
                if (fq == 0) ssqh[tok * 16 + u.pn * 4 + wc] = ss;
            }
        asm volatile("s_waitcnt vmcnt(0)" ::: "memory");
        __syncthreads();
        if (threadIdx.x == 0) {
            __builtin_amdgcn_fence(__ATOMIC_RELEASE, "agent");
            asm volatile("s_waitcnt vmcnt(0)" ::: "memory");
            __hip_atomic_fetch_add(pcnt, 1u, __ATOMIC_RELAXED, __HIP_MEMORY_SCOPE_AGENT);
            unsigned spins = 0u;
            while (__hip_atomic_load(pcnt, __ATOMIC_RELAXED, __HIP_MEMORY_SCOPE_AGENT) < 4u && ++spins < (1u << 22)) __builtin_amdgcn_s_sleep(1);
            __builtin_amdgcn_fence(__ATOMIC_ACQUIRE, "agent");
            asm volatile("s_waitcnt vmcnt(0)" ::: "memory");
        }
        __syncthreads();
#pragma unroll
        for (int ai = 0; ai < 2; ++ai)
#pragma unroll
            for (int m = 0; m < 4; ++m) {
                const size_t tok = (size_t)u.pm * 256 + ai * 128 + wr * 64 + m * 16 + fr;
                const f32x4* sp = (const f32x4*)(ssqh + tok * 16);
                const f32x4 a = sp[0], b2 = sp[1], c = sp[2], d = sp[3];
                const float s = ((a.x + a.y) + (a.z + a.w)) + ((b2.x + b2.y) + (b2.z + b2.w)) + ((c.x + c.y) + (c.z + c.w)) + ((d.x + d.y) + (d.z + d.w));
                const float rstd = 1.0f / sqrtf(s * (1.0f / 1024.0f) + EPS);
#pragma unroll
                for (int bj = 0; bj < 2; ++bj)
#pragma unroll
                    for (int n = 0; n < 2; ++n) {
                        const int col = u.pn * 256 + bj * 128 + wc * 32 + n * 16 + 4 * fq;
                        const f32x4 w = *(const f32x4*)(fw + col);
                        f32x4 o = acc[ai][bj][m][n];
                        o.x = o.x * rstd * w.x; o.y = o.y * rstd * w.y; o.z = o.z * rstd * w.z; o.w = o.w * rstd * w.w;
                        *(f32x4*)(out + tok * 1024 + col) = o;
                    }
            }
    }
};
DI void phase3(const Params& p, unsigned char* lds) {
    SchedSq S;
    {
        pg8::Unit u0; S.next(0, u0);
        const int tid = opaque_tid();
        float* tabw = (float*)(lds + 147456);
        if (tid < 256) {
            const float* sp = (const float*)(p.ws + OFF_SSQB) + ((size_t)u0.pm * 256 + tid) * 64;
            float r[4];
#pragma unroll
            for (int hh = 0; hh < 4; ++hh) {
                const f32x4 a = *(const f32x4*)(sp + hh * 16), b2 = *(const f32x4*)(sp + hh * 16 + 4), c = *(const f32x4*)(sp + hh * 16 + 8), d = *(const f32x4*)(sp + hh * 16 + 12);
                const float s = ((a.x + a.y) + (a.z + a.w)) + ((b2.x + b2.y) + (b2.z + b2.w)) + ((c.x + c.y) + (c.z + c.w)) + ((d.x + d.y) + (d.z + d.w));
                r[hh] = 1.0f / sqrtf(s * (1.0f / 256.0f) + EPS);
            }
            f32x4 o; o.x = r[0] / r[1]; o.y = r[1] / r[2]; o.z = r[2] / r[3]; o.w = r[3];
            *(f32x4*)(tabw + tid * 4) = o;
        }
        __syncthreads();
    }
    {
        pg8::Gemm g; g.A = (const bf16_t*)(p.ws + OFF_GZ); g.Bt = (const bf16_t*)(p.ws + OFF_WB_T); g.M = MROWS; g.N = 1024; g.K = 1024;
        EpiMerge<0> E; E.ws = p.ws; E.tab = (const PG8_LAS float*)(lds + 147456);
        pg8::gemm_phase<EpiMerge<0>, SchedSq, true, true, true>((PG8_LAS unsigned char*)lds, g, S, E);
    }
    {
        pg8::Gemm g; g.A = (const bf16_t*)(p.ws + OFF_AZ); g.Bt = (const bf16_t*)(p.ws + OFF_WA_T); g.M = MROWS; g.N = 1024; g.K = 1024;
        EpiMerge<1> E; E.ws = p.ws; E.tab = (const PG8_LAS float*)(lds + 147456);
        pg8::gemm_phase<EpiMerge<1>, SchedSq, true, true>((PG8_LAS unsigned char*)lds, g, S, E);
    }
}
DI void phase4(const Params& p, unsigned char* lds) {
    SchedSq S;
    pg8::Gemm g; g.A = (const bf16_t*)(p.ws + OFF_AK); g.Bt = (const bf16_t*)(p.ws + OFF_WO_T); g.M = MROWS; g.N = 1024; g.K = 1024;
    EpiOut E; E.ws = p.ws; E.x = p.x; E.out = p.out; E.fw = p.final_w;
    pg8::gemm_phase<EpiOut, SchedSq, false, true>((PG8_LAS unsigned char*)lds, g, S, E);
}

DI void phase5(const Params& p, unsigned char* lds) {
    const int tid = opaque_tid(), lane = tid & 63, wave = tid >> 6;
    const float* ssqh = (const float*)(p.ws + OFF_SSQH);
    for (int it = blockIdx.x; it < MROWS / 8; it += gridDim.x) {
        const size_t row = (size_t)it * 8 + wave;
        float s = lane < 16 ? ssqh[row * 16 + lane] : 0.f;
        s = wave_sum(s);
        const float rstd = 1.0f / sqrtf(s * (1.0f / 1024.0f) + EPS);
        f32x4* orow = (f32x4*)(p.out + row * 1024) + lane;
        const f32x4* wrow = (const f32x4*)p.final_w + lane;
#pragma unroll
        for (int j = 0; j < 4; ++j) {
            f32x4 v = orow[64 * j]; const f32x4 w = wrow[64 * j];
            v.x = v.x * rstd * w.x; v.y = v.y * rstd * w.y; v.z = v.z * rstd * w.z; v.w = v.w * rstd * w.w;
            orow[64 * j] = v;
        }
    }
}

#define XB_TMO      128
#define XB_XCNT(j)  (256  + 64 * (j))
#define XB_XSUB(j)  (1280 + 64 * (j))
#define XB_XGEN(j)  (2304 + 64 * (j))
#define XB_TOP      3328
#define XB_TOPGEN   3392
#define XCD_BAR_WORDS 3456
#define XB_SPIN_CAP (1u << 18)
#define LAS __attribute__((address_space(3)))
DI unsigned xb_ld(unsigned* p)              { return __hip_atomic_load(p, __ATOMIC_RELAXED, __HIP_MEMORY_SCOPE_AGENT); }
DI unsigned xb_add(unsigned* p, unsigned v) { return __hip_atomic_fetch_add(p, v, __ATOMIC_RELAXED, __HIP_MEMORY_SCOPE_AGENT); }
DI unsigned xb_xcc_id() { return (unsigned)__builtin_amdgcn_s_getreg((3 << 11) | 20) & 0xFu; }
#define XB_SPIN(cond, bar) do { unsigned _sp = 0; while (cond) { __builtin_amdgcn_s_sleep(1); \
    if ((++_sp & 255u) == 0u) { if (xb_ld(&(bar)[XB_TMO])) break; if (_sp > XB_SPIN_CAP) { atomicAdd(&(bar)[XB_TMO], 1u); break; } } } } while (0)
struct XcdBarrier { unsigned* bar; unsigned x; volatile LAS unsigned* st; };
DI XcdBarrier xcd_barrier_post(unsigned* bar, volatile LAS unsigned* st) {
    XcdBarrier b; b.bar = bar; b.x = xb_xcc_id(); b.st = st;
    if (threadIdx.x == 0) (void)xb_add(&bar[XB_XCNT(b.x)], 1u);
    return b;
}
DI void xcd_barrier_complete(unsigned* bar, unsigned x, unsigned& nloc, unsigned& nx) {
    const unsigned G = gridDim.x * gridDim.y * gridDim.z;
    unsigned sum, cnt, mine, sp = 0u;
    for (;;) {
        sum = 0u; cnt = 0u; mine = 0u;
#pragma unroll
        for (unsigned j = 0; j < 16; ++j) { const unsigned c = xb_ld(&bar[XB_XCNT(j)]); sum += c; cnt += (c > 0u) ? 1u : 0u; mine = (j == x) ? c : mine; }
        if (sum == G) break;
        __builtin_amdgcn_s_sleep(1);
        if ((++sp & 255u) == 0u) { if (xb_ld(&bar[XB_TMO])) break; if (sp > XB_SPIN_CAP) { atomicAdd(&bar[XB_TMO], 1u); break; } }
    }
    nloc = mine > 0u ? mine : 1u; nx = cnt > 0u ? cnt : 1u;
}
DI void xcd_barrier(const XcdBarrier& b) {
    asm volatile("s_waitcnt vmcnt(0)" ::: "memory");
    __syncthreads();
    if (threadIdx.x == 0) {
        unsigned* bar = b.bar;
        __builtin_amdgcn_s_waitcnt(0);
        unsigned nloc = b.st[0], nx = b.st[1];
        if (nloc == 0u) { xcd_barrier_complete(bar, b.x, nloc, nx); b.st[0] = nloc; b.st[1] = nx; }
        const unsigned old = xb_add(&bar[XB_XSUB(b.x)], 1u);
        const unsigned gen = old / nloc;
        if (old + 1u == (gen + 1u) * nloc) {
            __builtin_amdgcn_fence(__ATOMIC_RELEASE, "agent");
            asm volatile("s_waitcnt vmcnt(0)" ::: "memory");
            const unsigned og = xb_add(&bar[XB_TOP], 1u);
            const unsigned tg = og / nx;
            if (og + 1u == (tg + 1u) * nx) xb_add(&bar[XB_TOPGEN], 1u);
            else XB_SPIN(xb_ld(&bar[XB_TOPGEN]) == tg, bar);
            __builtin_amdgcn_fence(__ATOMIC_ACQUIRE, "agent");
            xb_add(&bar[XB_XGEN(b.x)], 1u);
            asm volatile("s_waitcnt vmcnt(0)" ::: "memory");
        } else {
            XB_SPIN(xb_ld(&bar[XB_XGEN(b.x)]) == gen, bar);
            __builtin_amdgcn_fence(__ATOMIC_ACQUIRE, "agent");
            asm volatile("s_waitcnt vmcnt(0)" ::: "memory");
        }
    }
    __syncthreads();
}

DI void run_phase(const Params& p, unsigned char* lds, int ph) {
    switch (ph) {
        case 0: phase0(p, lds); break;
        case 1: phase1(p, lds); break;
        case 2: phase15(p, lds); break;
        case 3: phase2(p, lds); break;
        case 4: phase25(p, lds); phase3(p, lds); break;
        case 5: phase4(p, lds); break;
        default: phase5(p, lds); break;
    }
}

__global__ void __launch_bounds__(512) hybrid_fwd(Params p) {
    extern __shared__ __attribute__((aligned(16))) unsigned char lds[];
#if MULTI_LAUNCH
    run_phase(p, lds, p.phase_lo);
#else
    cg::grid_group grid = cg::this_grid();
    if (p.phase_lo == 77) grid.sync();
    {
        volatile LAS unsigned* st = (volatile LAS unsigned*)(lds + LDS_ITEM + 16);
        if (threadIdx.x == 0) { st[0] = 0u; st[1] = 0u; }
        __syncthreads();
        (void)xcd_barrier_post((unsigned*)(p.ws + OFF_XBAR), st);
    }
#define GRID_BARRIER() { XcdBarrier xb_; xb_.bar = (unsigned*)(p.ws + OFF_XBAR); xb_.x = xb_xcc_id(); xb_.st = (volatile LAS unsigned*)(lds + LDS_ITEM + 16); xcd_barrier(xb_); }
    phase0(p, lds); GRID_BARRIER();
    phase1(p, lds); GRID_BARRIER();
    phase15(p, lds); GRID_BARRIER();
    phase2(p, lds); GRID_BARRIER();
    phase3(p, lds); GRID_BARRIER();
    phase4(p, lds);
#endif
}

extern "C" void kernel_launch(void* const* d_in, const int* in_sizes, int n_in, void* d_out, int out_size, void* d_ws, size_t ws_size, hipStream_t stream) {
    static int grid = 0;
    if (grid == 0) {
        int dev = 0, cus = 0, per_cu = 0;
        hipGetDevice(&dev);
        hipDeviceGetAttribute(&cus, hipDeviceAttributeMultiprocessorCount, dev);
        hipFuncSetAttribute((const void*)hybrid_fwd, hipFuncAttributeMaxDynamicSharedMemorySize, LDS_BYTES);
        hipOccupancyMaxActiveBlocksPerMultiprocessor(&per_cu, (const void*)hybrid_fwd, 512, LDS_BYTES);
        if (per_cu < 1) per_cu = 1;
        if (per_cu > 1) per_cu = 1;
        if (cus <= 0) cus = 256;
        grid = cus * per_cu;
    }
    hipMemsetAsync((unsigned char*)d_ws + OFF_XBAR, 0, 16384, stream);
    Params p{};
    p.x = (const float*)d_in[0]; p.meta = (const float*)d_in[1]; p.norm_w = (const float*)d_in[2]; p.w_in = (const float*)d_in[3];
    p.lq1 = (const float*)d_in[4]; p.lk1 = (const float*)d_in[5]; p.lq2 = (const float*)d_in[6]; p.lk2 = (const float*)d_in[7];
    p.subln_w = (const float*)d_in[8]; p.gate_w2 = (const float*)d_in[9]; p.gate_b = (const float*)d_in[10]; p.gla_norm_w = (const float*)d_in[11];
    p.wa = (const float*)d_in[12]; p.wb = (const float*)d_in[13]; p.wo = (const float*)d_in[14]; p.final_w = (const float*)d_in[15];
    p.out = (float*)d_out; p.ws = (unsigned char*)d_ws;
#if MULTI_LAUNCH
    for (int ph = 0; ph < 7; ++ph) {
        p.phase_lo = ph; p.phase_hi = ph + 1;
        hipLaunchKernelGGL(hybrid_fwd, dim3(grid), dim3(512), LDS_BYTES, stream, p);
    }
#else
    p.phase_lo = 0; p.phase_hi = 7;
    void* args[] = {&p};
    hipError_t e = hipLaunchCooperativeKernel((const void*)hybrid_fwd, dim3(grid), dim3(512), args, LDS_BYTES, stream);
    if (e != hipSuccess) fprintf(stderr, "cooperative launch failed: %s (grid %d)\n", hipGetErrorString(e), grid);
#endif
}
```

```cpp
#include <hip/hip_runtime.h>
#include <hip/hip_cooperative_groups.h>
#include <cstdio>
#include <cstdint>
namespace cg = cooperative_groups;

#ifndef MULTI_LAUNCH
#define MULTI_LAUNCH 0
#endif
#ifndef PROBE_REP
#define PROBE_REP 0
#endif

typedef unsigned short bf16_t;
typedef short bf16x8 __attribute__((ext_vector_type(8)));
typedef float f32x4 __attribute__((ext_vector_type(4)));
typedef float f32x2 __attribute__((ext_vector_type(2)));
typedef float f32x16 __attribute__((ext_vector_type(16)));
typedef unsigned u32x4 __attribute__((ext_vector_type(4)));
typedef unsigned u32x2 __attribute__((ext_vector_type(2)));
typedef __bf16 bfv2 __attribute__((ext_vector_type(2)));

#define DI __device__ __forceinline__
#define MFMA32(a, b, c) __builtin_amdgcn_mfma_f32_32x32x16_bf16((a), (b), (c), 0, 0, 0)
#define MFMA16(a, b, c) __builtin_amdgcn_mfma_f32_16x16x32_bf16((a), (b), (c), 0, 0, 0)

DI unsigned pk2(float a, float b) { f32x2 v = {a, b}; return __builtin_bit_cast(unsigned, __builtin_convertvector(v, bfv2)); }
DI float bf2f(bf16_t v) { return __uint_as_float(((unsigned)v) << 16); }
DI float bflo(unsigned u) { return __uint_as_float(u << 16); }
DI float bfhi(unsigned u) { return __uint_as_float(u & 0xffff0000u); }
DI bf16_t f2bf(float a) { return (bf16_t)(pk2(a, 0.f) & 0xffffu); }
DI float wave_sum(float v) {
#pragma unroll
    for (int o = 32; o; o >>= 1) v += __shfl_xor(v, o);
    return v;
}
DI int opaque_tid() { int t = threadIdx.x; asm volatile("" : "+v"(t)); return t; }
DI float xor32_sum(float x) { auto r = __builtin_amdgcn_permlane32_swap(__float_as_uint(x), __float_as_uint(x), false, false); return __uint_as_float(r[0]) + __uint_as_float(r[1]); }
DI float xor16_sum(float x) { auto r = __builtin_amdgcn_permlane16_swap(__float_as_uint(x), __float_as_uint(x), false, false); return __uint_as_float(r[0]) + __uint_as_float(r[1]); }
DI float xor32_max(float x) { auto r = __builtin_amdgcn_permlane32_swap(__float_as_uint(x), __float_as_uint(x), false, false); return fmaxf(__uint_as_float(r[0]), __uint_as_float(r[1])); }
DI float sigmoidf_(float z) { return __builtin_amdgcn_rcpf(1.f + __expf(-z)); }
DI float siluf_(float z) { return z * __builtin_amdgcn_rcpf(1.f + __expf(-z)); }

constexpr int D = 1024, NB = 4, SEQ = 4096, MROWS = NB * SEQ;
constexpr int NIN = 9232, NINP = 9344;
constexpr float EPS = 1e-5f;

constexpr size_t SZ_ACT = (size_t)MROWS * 1024 * 2;
constexpr size_t OFF_WIN_T = 0;
constexpr size_t OFF_WA_T = OFF_WIN_T + (size_t)NINP * 1024 * 2;
constexpr size_t OFF_WB_T = OFF_WA_T + 2097152;
constexpr size_t OFF_WO_T = OFF_WB_T + 2097152;
constexpr size_t OFF_AK = OFF_WO_T + 2097152;
constexpr size_t OFF_AVT = OFF_AK + SZ_ACT;
constexpr size_t OFF_AZ = OFF_AVT + SZ_ACT;
constexpr size_t OFF_GVT = OFF_AZ + SZ_ACT;
constexpr size_t OFF_GZ = OFF_GVT + SZ_ACT;
constexpr size_t OFF_GA = OFF_GZ + SZ_ACT;
constexpr size_t OFF_GB = OFF_GA + SZ_ACT;
constexpr size_t OFF_GLR = OFF_GB + SZ_ACT;
constexpr size_t OFF_RSTD = OFF_GLR + (size_t)MROWS * 16 * 2;
constexpr size_t OFF_ROPE = OFF_RSTD + 65792;
constexpr size_t OFF_AKM = OFF_ROPE + 263168;
constexpr size_t OFF_AVTM = OFF_AKM + 131072;
constexpr size_t OFF_GVTM = OFF_AVTM + 131072;
constexpr size_t OFF_GKM = OFF_GVTM + 131072;
constexpr size_t OFF_GLRM = OFF_GKM + 16384;
constexpr size_t OFF_KTM = OFF_GLRM + 512;
constexpr size_t OFF_KTTM = OFF_KTM + 65536;
constexpr size_t OFF_DEC = OFF_KTTM + 65536;
constexpr size_t OFF_DECM = OFF_DEC + 524288;
constexpr size_t OFF_SSQB = OFF_DECM + 2048;
constexpr size_t OFF_SSQH = OFF_SSQB + 4194304;
constexpr size_t OFF_CTR = OFF_SSQH + 1048576;
constexpr size_t OFF_XBM = OFF_CTR + 256;
constexpr size_t OFF_XBAR = OFF_XBM + 32768;
constexpr size_t WS_END = OFF_XBAR + 16384;
constexpr size_t OFF_XB = OFF_GA;
constexpr size_t OFF_SGA = OFF_GB;
constexpr size_t OFF_SGB = OFF_GB + (size_t)MROWS * 1024;
static_assert(WS_END <= 268435456ull, "workspace over 256 MiB");
constexpr size_t DO_AQ = 0, DO_GQ = SZ_ACT, DO_GK = SZ_ACT + SZ_ACT / 2;

constexpr int G_ROWB = 144;
constexpr int G_SW = 128 * G_ROWB, G_SX = 256 * G_ROWB, G_STAGE = G_SW + G_SX;
constexpr int G_SW4 = 256 * G_ROWB, G_STAGE4 = G_SW4 + G_SX;
constexpr int LDS_SCALE = 2 * G_STAGE4;
constexpr int LDS_ITEM = LDS_SCALE + 4096;
constexpr int LDS_BYTES = LDS_ITEM + 64;

struct Params {
    const float *x, *meta, *norm_w, *w_in, *lq1, *lk1, *lq2, *lk2, *subln_w, *gate_w2, *gate_b, *gla_norm_w, *wa, *wb, *wo, *final_w;
    float* out;
    unsigned char* ws;
    int phase_lo, phase_hi;
};

template <int MODE>
DI void p0_transpose_item(const Params& p, int item, float* tile) {
    const int tid = opaque_tid();
    const float* W = MODE == 0 ? p.w_in : MODE == 1 ? p.wa : MODE == 2 ? p.wb : p.wo;
    const int ldw = MODE == 0 ? NIN : 1024;
    const int nbc = MODE == 0 ? NINP / 128 : 8;
    bf16_t* WT = (bf16_t*)(p.ws + (MODE == 0 ? OFF_WIN_T : MODE == 1 ? OFF_WA_T : MODE == 2 ? OFF_WB_T : OFF_WO_T));
    const int kb = item / nbc, nb = item % nbc, k0 = kb * 64, n0 = nb * 128;
    const int nn = tid & 127, n = n0 + nn;
    int src = n;
    if (MODE == 0) { src = n < 7168 ? n : (n < 9216 ? n + 16 : (n < 9232 ? n - 2048 : -1)); }
    float v[16];
#pragma unroll
    for (int i = 0; i < 16; ++i) {
        const int k = k0 + (tid >> 7) + 4 * i;
        v[i] = src >= 0 ? W[(size_t)k * ldw + src] : 0.f;
    }
#pragma unroll
    for (int i = 0; i < 16; ++i) {
        const int kk = (tid >> 7) + 4 * i, k = k0 + kk;
        float sc = 1.f;
        if (MODE == 0) sc = p.norm_w[k];
        if (MODE == 1) sc = 0.8f * p.subln_w[k & 127];
        if (MODE == 2) sc = p.gla_norm_w[k & 255];
        tile[kk * 129 + nn] = v[i] * sc;
    }
    __syncthreads();
    {
        const int on = tid >> 2, c = tid & 3;
        const float* s = tile + (16 * c) * 129 + on;
        u32x4 o0, o1;
        o0.x = pk2(s[0 * 129], s[1 * 129]); o0.y = pk2(s[2 * 129], s[3 * 129]); o0.z = pk2(s[4 * 129], s[5 * 129]); o0.w = pk2(s[6 * 129], s[7 * 129]);
        o1.x = pk2(s[8 * 129], s[9 * 129]); o1.y = pk2(s[10 * 129], s[11 * 129]); o1.z = pk2(s[12 * 129], s[13 * 129]); o1.w = pk2(s[14 * 129], s[15 * 129]);
        u32x4* dst = (u32x4*)(WT + (size_t)(n0 + on) * 1024 + k0 + 16 * c);
        dst[0] = o0; dst[1] = o1;
    }
    __syncthreads();
}

DI void phase0(const Params& p, unsigned char* lds) {
    const int tid = opaque_tid(), lane = tid & 63, wave = tid >> 6;
    float* tile = (float*)lds;
    constexpr int I_WIN = 16 * (NINP / 128), I_SQ = 128;
    constexpr int I_T = I_WIN + 3 * I_SQ;
    constexpr int I_RSTD = (MROWS + 16 + 15) / 16;
    constexpr int I_ROPE = (4112 * 8 + 511) / 512;
    constexpr int I_ZERO = 393216 / 8192;
    constexpr int I_ALL = I_T + I_RSTD + I_ROPE + I_ZERO;
    for (int it = blockIdx.x; it < I_ALL; it += gridDim.x) {
        int r = it;
        if (r < I_WIN) { p0_transpose_item<0>(p, r, tile); continue; } r -= I_WIN;
        if (r < I_SQ) { p0_transpose_item<1>(p, r, tile); continue; } r -= I_SQ;
        if (r < I_SQ) { p0_transpose_item<2>(p, r, tile); continue; } r -= I_SQ;
        if (r < I_SQ) { p0_transpose_item<3>(p, r, tile); continue; } r -= I_SQ;
        if (r < I_RSTD) {
            const int row0 = r * 16 + wave * 2;
            f32x4 v[2][4];
#pragma unroll
            for (int q = 0; q < 2; ++q) {
                const int row = row0 + q < MROWS + 16 ? row0 + q : MROWS + 15;
                const float* srcp = row < MROWS ? p.x + (size_t)row * 1024 : p.meta + (size_t)(row - MROWS) * 1024;
                const f32x4* xr = (const f32x4*)srcp + lane;
#pragma unroll
                for (int j = 0; j < 4; ++j) v[q][j] = xr[64 * j];
            }
#pragma unroll
            for (int q = 0; q < 2; ++q) {
                const int row = row0 + q;
                float s = 0.f;
#pragma unroll
                for (int j = 0; j < 4; ++j) s += (v[q][j].x * v[q][j].x + v[q][j].y * v[q][j].y) + (v[q][j].z * v[q][j].z + v[q][j].w * v[q][j].w);
                s = wave_sum(s);
                if (row < MROWS + 16) {
                    if (lane == 0) ((float*)(p.ws + OFF_RSTD))[row] = 1.0f / sqrtf(s * (1.0f / 1024.0f) + EPS);
                    bf16_t* xbrow = row < MROWS ? (bf16_t*)(p.ws + OFF_XB) + (size_t)row * 1024 : (bf16_t*)(p.ws + OFF_XBM) + (size_t)(row - MROWS) * 1024;
#pragma unroll
                    for (int j = 0; j < 4; ++j) { u32x2 o; o.x = pk2(v[q][j].x, v[q][j].y); o.y = pk2(v[q][j].z, v[q][j].w); *(u32x2*)(xbrow + 256 * j + 4 * lane) = o; }
                }
            }
            continue;
        }
        r -= I_RSTD;
        if (r < I_ROPE) {
            const int e = r * 512 + tid;
            if (e < 4112 * 8) {
                const int pos = e >> 3, i = e & 7;
                const float inv = powf(500000.0f, -(float)i / 8.0f);
                const float ang = (float)pos * inv;
                float* t = (float*)(p.ws + OFF_ROPE) + (size_t)e * 2;
                t[0] = cosf(ang); t[1] = sinf(ang);
            }
            continue;
        }
        r -= I_ROPE;
        { u32x4 z = {0u, 0u, 0u, 0u}; *(u32x4*)(p.ws + OFF_AKM + (size_t)r * 8192 + tid * 16) = z; }
    }
}

namespace pg8 {
#define PG8_LAS __attribute__((address_space(3)))
typedef unsigned short bf16_t;
typedef short bf16x8 __attribute__((ext_vector_type(8)));
typedef float f32x4 __attribute__((ext_vector_type(4)));
typedef unsigned u32x4 __attribute__((ext_vector_type(4)));
constexpr int BM = 256, BK = 64, HALF = 128, HTB = HALF * BK * 2  , STAGE_BYTES = 8 * HTB, NXCD = 8, WGM = 8;

__host__ __device__ __forceinline__ int lds_byte(int r, int c) { const int st = (r >> 4) * 2 + (c >> 5), rr = r & 15, cc = c & 31, ob = rr * 64 + cc * 2; return st * 1024 + (ob ^ (((ob >> 9) & 1) << 5)); }
__host__ __device__ __forceinline__ void stage_rc(int b, int& R, int& C) { const int st = b / 1024, sb = b % 1024, swz = sb ^ (((sb >> 9) & 1) << 5); R = (st >> 1) * 16 + swz / 64; C = (st & 1) * 32 + (swz % 64) / 2; }
__host__ __device__ __forceinline__ int perm32(int rho) { const int n = rho >> 4, i = rho & 15; return 8 * (i >> 2) + 4 * n + (i & 3); }

struct Unit { int pm, pn; };
struct Gemm { const bf16_t* A; const bf16_t* Bt; int M, N, K; };

template <class Epi, class Sched, bool ALIGN_EPI = false, bool SP2 = false, bool HS = false>
__device__ __forceinline__ void gemm_phase(PG8_LAS unsigned char* lds, const Gemm g, const Sched& S, const Epi& E) {
    const int tid = opaque_tid(), wid = __builtin_amdgcn_readfirstlane(tid >> 6), lane = tid & 63, wr = wid >> 2, wc = wid & 3, fr = lane & 15, fq = lane >> 4;
    const int K = g.K, nt = K / BK;
    unsigned voffA[2], voffB[2];
#pragma unroll
    for (int i = 0; i < 2; ++i) { int R, C; stage_rc(tid * 16 + i * 8192, R, C); const int Rb = Epi::PERM ? ((R & ~31) + perm32(R & 31)) : R;
        voffA[i] = (unsigned)(R * K + C) * 2u; voffB[i] = (unsigned)(Rb * K + C) * 2u; }
    const size_t kstep = (size_t)(BK * 2);
    const size_t hstep = (size_t)HALF * K * 2;
    const size_t tstep = 2 * hstep;
    const unsigned ldsw = (unsigned)wid * 1024u;
    const int aoff = lds_byte(wr * 64 + fr, fq * 8), boff = lds_byte(wc * 32 + fr, fq * 8);
#define PG8_SA(b, h) (((b) * 2 + (h)) * HTB)
#define PG8_SB(b, h) ((4 + (b) * 2 + (h)) * HTB)
#define PG8_STAGE(bufoff, gbase, voff) do { _Pragma("unroll") for (int _i = 0; _i < 2; ++_i) \
        __builtin_amdgcn_global_load_lds((const unsigned*)((const char*)(gbase) + (voff)[_i]), (PG8_LAS unsigned*)(lds + (bufoff) + ldsw + _i * 8192), 16, 0, 0); } while (0)
#define PG8_LDA(dst, b, h) do { _Pragma("unroll") for (int m = 0; m < 4; ++m) _Pragma("unroll") for (int k = 0; k < 2; ++k) dst[m][k] = *(const PG8_LAS bf16x8*)(lds + PG8_SA(b, h) + aoff + m * 2048 + k * 1024); } while (0)
#define PG8_LDB(dst, b, h) do { _Pragma("unroll") for (int n = 0; n < 2; ++n) _Pragma("unroll") for (int k = 0; k < 2; ++k) dst[n][k] = *(const PG8_LAS bf16x8*)(lds + PG8_SB(b, h) + boff + n * 2048 + k * 1024); } while (0)
#define PG8_MMA(ai, bj, At, Bt) do { __builtin_amdgcn_s_setprio(1); _Pragma("unroll") for (int m = 0; m < 4; ++m) _Pragma("unroll") for (int n = 0; n < 2; ++n) _Pragma("unroll") for (int k = 0; k < 2; ++k) \
        acc[ai][bj][m][n] = __builtin_amdgcn_mfma_f32_16x16x32_bf16(Bt[n][k], At[m][k], acc[ai][bj][m][n], 0, 0, 0); __builtin_amdgcn_s_setprio(0); } while (0)
#define PG8_WAIT_V(n) asm volatile("s_waitcnt vmcnt(" #n ")" ::: "memory")
#define PG8_WAIT_L(n) asm volatile("s_waitcnt lgkmcnt(" #n ")" ::: "memory")
#define PG8_BAR __builtin_amdgcn_s_barrier()
#define PG8_SCHED __builtin_amdgcn_sched_barrier(0)
    Unit cur, nxt; int ui = 0;
    if (!S.next(0, cur)) return;
    f32x4 acc[2][2][4][2];
#pragma unroll
    for (int a = 0; a < 2; ++a)
#pragma unroll
        for (int b = 0; b < 2; ++b)
#pragma unroll
            for (int m = 0; m < 4; ++m)
#pragma unroll
                for (int n = 0; n < 2; ++n) acc[a][b][m][n] = (f32x4){0.f, 0.f, 0.f, 0.f};
    bf16x8 At[4][2], B0[2][2], B1[2][2];
    const char* cA = (const char*)g.A + (size_t)cur.pm * tstep; const char* cB = (const char*)g.Bt + (size_t)cur.pn * tstep;
    S.a_ready(cur);
    if constexpr (SP2) {
        PG8_STAGE(PG8_SB(0, 0), cB, voffB); PG8_STAGE(PG8_SB(0, 1), cB + hstep, voffB); PG8_STAGE(PG8_SA(0, 0), cA, voffA); PG8_STAGE(PG8_SA(0, 1), cA + hstep, voffA);
        if (wr == 1) PG8_BAR;
        PG8_WAIT_V(2); PG8_BAR;
        PG8_STAGE(PG8_SB(1, 0), cB + kstep, voffB); PG8_STAGE(PG8_SA(1, 0), cA + kstep, voffA); PG8_STAGE(PG8_SB(1, 1), cB + hstep + kstep, voffB);
        PG8_WAIT_V(6); PG8_BAR;
    } else {
        PG8_STAGE(PG8_SB(0, 0), cB, voffB); PG8_STAGE(PG8_SA(0, 0), cA, voffA); PG8_STAGE(PG8_SB(0, 1), cB + hstep, voffB); PG8_STAGE(PG8_SA(0, 1), cA + hstep, voffA);
        if (wr == 1) PG8_BAR;
        PG8_WAIT_V(4); PG8_BAR;
        PG8_STAGE(PG8_SB(1, 0), cB + kstep, voffB); PG8_STAGE(PG8_SA(1, 0), cA + kstep, voffA); PG8_STAGE(PG8_SB(1, 1), cB + hstep + kstep, voffB);
        PG8_WAIT_V(6); PG8_BAR;
    }
    for (;;) {
        const bool has_next = S.next(ui + 1, nxt);
        const char* nA = has_next ? (const char*)g.A + (size_t)nxt.pm * tstep : cA; const char* nB = has_next ? (const char*)g.Bt + (size_t)nxt.pn * tstep : cB;
        for (int t = 0; t < nt; t += 2) {
            if constexpr (HS) {
                if (t == 4 || t == 8 || t == 12) {
                    const PG8_LAS float* tab = (const PG8_LAS float*)(lds + 147456);
                    const int hj = (t >> 2) - 1;
#pragma unroll
                    for (int a = 0; a < 2; ++a)
#pragma unroll
                        for (int m = 0; m < 4; ++m) {
                            const float s = tab[(a * 128 + wr * 64 + m * 16 + fr) * 4 + hj];
#pragma unroll
                            for (int b = 0; b < 2; ++b)
#pragma unroll
                                for (int n = 0; n < 2; ++n) acc[a][b][m][n] = acc[a][b][m][n] * s;
                        }
                }
            }
            const bool last = (t == nt - 2);
            const char* a1 = cA + (size_t)(t + 1) * kstep;
            const char* a2 = last ? nA : cA + (size_t)(t + 2) * kstep; const char* b2 = last ? nB : cB + (size_t)(t + 2) * kstep;
            const char* a3 = a2 + kstep; const char* b3 = b2 + kstep;
            if (last && has_next) S.a_ready(nxt);
            if constexpr (SP2) {
            PG8_LDB(B0, 0, 0); PG8_LDB(B1, 0, 1); PG8_SCHED; PG8_LDA(At, 0, 0); PG8_STAGE(PG8_SA(1, 1), a1 + hstep, voffA);
            PG8_WAIT_V(8); PG8_WAIT_L(0); PG8_BAR; PG8_MMA(0, 0, At, B0); PG8_MMA(0, 1, At, B1); PG8_BAR; PG8_SCHED;
            PG8_LDA(At, 0, 1); PG8_STAGE(PG8_SB(0, 0), b2, voffB); PG8_STAGE(PG8_SB(0, 1), b2 + hstep, voffB); PG8_STAGE(PG8_SA(0, 0), a2, voffA);
            PG8_WAIT_V(8); PG8_WAIT_L(0); PG8_BAR; PG8_MMA(1, 0, At, B0); PG8_MMA(1, 1, At, B1); PG8_BAR; PG8_SCHED;
            PG8_LDB(B0, 1, 0); PG8_LDB(B1, 1, 1); PG8_SCHED; PG8_LDA(At, 1, 0); PG8_STAGE(PG8_SA(0, 1), a2 + hstep, voffA);
            PG8_WAIT_V(8); PG8_WAIT_L(0); PG8_BAR; PG8_MMA(0, 0, At, B0); PG8_MMA(0, 1, At, B1); PG8_BAR; PG8_SCHED;
            PG8_LDA(At, 1, 1); PG8_STAGE(PG8_SB(1, 0), b3, voffB); PG8_STAGE(PG8_SB(1, 1), b3 + hstep, voffB); PG8_STAGE(PG8_SA(1, 0), a3, voffA);
            PG8_WAIT_V(8); PG8_WAIT_L(0); PG8_BAR; PG8_MMA(1, 0, At, B0); PG8_MMA(1, 1, At, B1); PG8_BAR; PG8_SCHED;
            } else {
            PG8_LDB(B0, 0, 0); PG8_SCHED; PG8_LDA(At, 0, 0); PG8_STAGE(PG8_SA(1, 1), a1 + hstep, voffA);
            PG8_WAIT_L(8); PG8_BAR; PG8_WAIT_L(0); PG8_MMA(0, 0, At, B0); PG8_BAR; PG8_SCHED;
            PG8_LDB(B1, 0, 1); PG8_STAGE(PG8_SB(0, 0), b2, voffB);
            PG8_BAR; PG8_WAIT_L(0); PG8_MMA(0, 1, At, B1); PG8_BAR;
            PG8_LDA(At, 0, 1); PG8_STAGE(PG8_SA(0, 0), a2, voffA);
            PG8_BAR; PG8_WAIT_L(0); PG8_MMA(1, 0, At, B0); PG8_BAR; PG8_SCHED;
            PG8_STAGE(PG8_SB(0, 1), b2 + hstep, voffB);
            PG8_WAIT_V(6); PG8_BAR; PG8_MMA(1, 1, At, B1); PG8_BAR;
            PG8_LDB(B0, 1, 0); PG8_SCHED; PG8_LDA(At, 1, 0); PG8_STAGE(PG8_SA(0, 1), a2 + hstep, voffA);
            PG8_WAIT_L(8); PG8_BAR; PG8_WAIT_L(0); PG8_MMA(0, 0, At, B0); PG8_BAR; PG8_SCHED;
            PG8_LDB(B1, 1, 1); PG8_STAGE(PG8_SB(1, 0), b3, voffB);
            PG8_BAR; PG8_WAIT_L(0); PG8_MMA(0, 1, At, B1); PG8_BAR;
            PG8_LDA(At, 1, 1); PG8_STAGE(PG8_SA(1, 0), a3, voffA);
            PG8_BAR; PG8_WAIT_L(0); PG8_MMA(1, 0, At, B0); PG8_BAR; PG8_SCHED;
            PG8_STAGE(PG8_SB(1, 1), b3 + hstep, voffB);
            PG8_WAIT_V(6); PG8_BAR; PG8_MMA(1, 1, At, B1); PG8_BAR;
            }
        }
        if constexpr (ALIGN_EPI) { if (wr == 0) PG8_BAR; }
        if constexpr (!Epi::AFTER_DRAIN) { E(acc, cur, wr, wc, fr, fq); S.done(cur); }
        if (!has_next) break;
#pragma unroll
        for (int a = 0; a < 2; ++a)
#pragma unroll
            for (int b = 0; b < 2; ++b)
#pragma unroll
                for (int m = 0; m < 4; ++m)
#pragma unroll
                    for (int n = 0; n < 2; ++n) acc[a][b][m][n] = (f32x4){0.f, 0.f, 0.f, 0.f};
        cur = nxt; cA = nA; cB = nB; ++ui;
        if constexpr (ALIGN_EPI) { if (wr == 1) PG8_BAR; }
    }
    PG8_WAIT_V(0);
    if constexpr (!ALIGN_EPI) { if (wr == 0) PG8_BAR; }
    PG8_BAR;
    if constexpr (Epi::AFTER_DRAIN) { E.fused(acc, cur, wr, wc, fr, fq, lds, wid, lane); S.done(cur); }
#undef PG8_SA
#undef PG8_SB
#undef PG8_STAGE
#undef PG8_LDA
#undef PG8_LDB
#undef PG8_MMA
#undef PG8_WAIT_V
#undef PG8_WAIT_L
#undef PG8_BAR
#undef PG8_SCHED
}
}

DI unsigned sig_u8(float z) { return (unsigned)(255.0f * __builtin_amdgcn_rcpf(1.0f + __expf(-z)) + 0.5f); }
struct SchedP1 {
    DI bool next(int i, pg8::Unit& u) const {
        constexpr int NT = 36;
        const int id = (int)blockIdx.x + i * (int)gridDim.x;
        if (id >= 64 * NT) return false;
        const int g = id / (16 * NT), rem = id % (16 * NT), reg = rem >> 8, w = rem & 255, x = w & 7, j = w >> 3;
        int mt = g * 16 + 4 * (x & 3) + (j & 3), nt = reg * 16 + 8 * (x >> 2) + (j >> 2);
        if (reg == 2) { const int e = rem - 512; nt = 32 + (e >> 4); mt = g * 16 + (e & 15); }
        u.pm = mt; u.pn = nt; return true;
    }
    DI void a_ready(const pg8::Unit&) const {}
    DI void done(const pg8::Unit&) const {}
};
struct SchedSq {
    DI bool next(int i, pg8::Unit& u) const {
        const int id = (int)blockIdx.x + i * (int)gridDim.x;
        if (id >= 256) return false;
        u.pm = 8 * (id & 7) + ((id >> 3) & 7); u.pn = id >> 6; return true;
    }
    DI void a_ready(const pg8::Unit&) const {}
    DI void done(const pg8::Unit&) const {}
};
DI unsigned sig_u8x4(float a, float b, float c, float d) {
    unsigned r = 0u;
    r = __builtin_amdgcn_cvt_pk_u8_f32(255.0f * __builtin_amdgcn_rcpf(1.0f + __expf(-a)), 0, r);
    r = __builtin_amdgcn_cvt_pk_u8_f32(255.0f * __builtin_amdgcn_rcpf(1.0f + __expf(-b)), 1, r);
    r = __builtin_amdgcn_cvt_pk_u8_f32(255.0f * __builtin_amdgcn_rcpf(1.0f + __expf(-c)), 2, r);
    r = __builtin_amdgcn_cvt_pk_u8_f32(255.0f * __builtin_amdgcn_rcpf(1.0f + __expf(-d)), 3, r);
    return r;
}
struct EpiInProj {
    static constexpr bool PERM = true, AFTER_DRAIN = false;
    unsigned char* ws; unsigned char* dout;
    DI void operator()(const pg8::f32x4 (&acc)[2][2][4][2], const pg8::Unit& u, int wr, int wc, int fr, int fq) const {
        const int nt = u.pn;
        int split, nc0;
        if (nt < 4) { split = 0; nc0 = nt * 256; }
        else if (nt < 8) { split = 1; nc0 = (nt - 4) * 256; }
        else if (nt < 12) { split = 2; nc0 = (nt - 8) * 256; }
        else if (nt < 16) { split = 3; nc0 = (nt - 12) * 256; }
        else if (nt < 18) { split = 4; nc0 = (nt - 16) * 256; }
        else if (nt < 20) { split = 5; nc0 = (nt - 18) * 256; }
        else if (nt < 24) { split = 6; nc0 = (nt - 20) * 256; }
        else if (nt < 28) { split = 7; nc0 = (nt - 24) * 256; }
        else if (nt < 32) { split = 9; nc0 = (nt - 28) * 256; }
        else { split = 10; nc0 = (nt - 32) * 256; }
        const float* rstd = (const float*)(ws + OFF_RSTD);
        const float* rope = (const float*)(ws + OFF_ROPE);
        const bool do_rope = split <= 1 && (wc & 1) == 0;
#pragma unroll
        for (int ai = 0; ai < 2; ++ai)
#pragma unroll
            for (int m = 0; m < 4; ++m) {
                const int tok = u.pm * 256 + ai * 128 + wr * 64 + m * 16 + fr;
                const float rs = rstd[tok];
                const float rsq = split == 0 ? rs * (0.125f * 1.4426950408889634f) : rs;
                const int pos = 16 + (tok & 4095), b = tok >> 12, s = tok & 4095;
#pragma unroll
                for (int bj = 0; bj < 2; ++bj) {
                    const int nb = nc0 + bj * 128 + wc * 32 + 8 * fq;
                    float v[8];
#pragma unroll
                    for (int j = 0; j < 4; ++j) { v[j] = acc[ai][bj][m][0][j] * rsq; v[4 + j] = acc[ai][bj][m][1][j] * rsq; }
                    if (do_rope) {
                        const f32x4* cs = (const f32x4*)(rope + (size_t)pos * 16);
                        const f32x4 c01 = cs[0], c23 = cs[1], c45 = cs[2], c67 = cs[3];
                        const float cc[8] = {c01.x, c01.z, c23.x, c23.z, c45.x, c45.z, c67.x, c67.z};
                        const float sn[8] = {c01.y, c01.w, c23.y, c23.w, c45.y, c45.w, c67.y, c67.w};
#pragma unroll
                        for (int j = 0; j < 8; ++j) {
                            const float other = __shfl_xor(v[j], 16);
                            const float r0 = v[j] * cc[j] - other * sn[j], r1 = v[j] * cc[j] + other * sn[j];
                            v[j] = fq == 0 ? r0 : (fq == 1 ? r1 : v[j]);
                        }
                    }
                    if (split == 2 || split == 6) {
                        const int hshift = split == 2 ? 7 : 8, nheads = split == 2 ? 8 : 4, dvn = 1 << hshift;
                        bf16_t* base = (bf16_t*)(ws + (split == 2 ? OFF_AVT : OFF_GVT));
                        const int hd = nb >> hshift, dv0 = nb & (dvn - 1);
                        bf16_t* dst = base + ((size_t)(b * nheads + hd) * dvn + dv0) * 4096 + s;
#pragma unroll
                        for (int j = 0; j < 8; ++j) dst[(size_t)j * 4096] = f2bf(v[j]);
                    } else if (split >= 9) {
                        u32x2 o; o.x = sig_u8x4(v[0], v[1], v[2], v[3]); o.y = sig_u8x4(v[4], v[5], v[6], v[7]);
                        *(u32x2*)(ws + (split == 9 ? OFF_SGA : OFF_SGB) + (size_t)tok * 1024 + nb) = o;
                    } else {
                        bf16_t* dst; int ld;
                        switch (split) {
                            case 0: dst = (bf16_t*)(dout + DO_AQ); ld = 1024; break;
                            case 1: dst = (bf16_t*)(ws + OFF_AK); ld = 1024; break;
                            case 3: dst = (bf16_t*)(ws + OFF_AZ); ld = 1024; break;
                            case 4: dst = (bf16_t*)(dout + DO_GQ); ld = 512; break;
                            case 5: dst = (bf16_t*)(dout + DO_GK); ld = 512; break;
                            default: dst = (bf16_t*)(ws + OFF_GZ); ld = 1024; break;
                        }
                        u32x4 o; o.x = pk2(v[0], v[1]); o.y = pk2(v[2], v[3]); o.z = pk2(v[4], v[5]); o.w = pk2(v[6], v[7]);
                        *(u32x4*)(dst + (size_t)tok * ld + nb) = o;
                    }
                }
            }
    }
};

DI void p1_glr_job(const Params& p, unsigned char* lds, int job) {
    const int tid = opaque_tid(), lane = tid & 63, wave = tid >> 6, l15 = lane & 15, g = lane >> 4;
    const int rtile = wave & 3, khalf = wave >> 2;
    const bf16_t* xb = (const bf16_t*)(p.ws + OFF_XB);
    const bf16_t* wt = (const bf16_t*)(p.ws + OFF_WIN_T) + (size_t)9216 * 1024;
    const size_t row0 = (size_t)job * 64 + rtile * 16;
    const bf16_t* ap = xb + (row0 + l15) * 1024 + khalf * 512 + 8 * g;
    const bf16_t* bp = wt + (size_t)l15 * 1024 + khalf * 512 + 8 * g;
    f32x4 acc = (f32x4){0.f, 0.f, 0.f, 0.f};
    {
        bf16x8 av[16], bv[16];
#pragma unroll
        for (int ks = 0; ks < 16; ++ks) { av[ks] = *(const bf16x8*)(ap + ks * 32); bv[ks] = *(const bf16x8*)(bp + ks * 32); }
        f32x4 acc2 = (f32x4){0.f, 0.f, 0.f, 0.f};
#pragma unroll
        for (int ks = 0; ks < 16; ks += 2) { acc = MFMA16(av[ks], bv[ks], acc); acc2 = MFMA16(av[ks + 1], bv[ks + 1], acc2); }
        acc = acc + acc2;
    }
    f32x4* red = (f32x4*)lds;
    __syncthreads();
    if (khalf == 1) red[rtile * 64 + lane] = acc;
    __syncthreads();
    if (khalf == 0) {
        const f32x4 o = red[rtile * 64 + lane];
        const float* rstd = (const float*)(p.ws + OFF_RSTD);
        bf16_t* glr = (bf16_t*)(p.ws + OFF_GLR);
#pragma unroll
        for (int i = 0; i < 4; ++i) {
            const size_t row = row0 + 4 * g + i;
            glr[row * 16 + l15] = f2bf((acc[i] + o[i]) * rstd[row]);
        }
    }
    __syncthreads();
}

DI void p1_meta_job(const Params& p, unsigned char* lds, int job) {
    const int tid = opaque_tid(), lane = tid & 63, wave = tid >> 6, l15 = lane & 15, g = lane >> 4;
    int c0;
    if (job < 64) c0 = 1024 + job * 16;
    else if (job < 128) c0 = 2048 + (job - 64) * 16;
    else if (job < 160) c0 = 4608 + (job - 128) * 16;
    else if (job < 224) c0 = 5120 + (job - 160) * 16;
    else c0 = 9216;
    const bf16_t* xbm = (const bf16_t*)(p.ws + OFF_XBM);
    const bf16_t* wt = (const bf16_t*)(p.ws + OFF_WIN_T);
    const bf16_t* ap = xbm + (size_t)l15 * 1024 + wave * 128 + 8 * g;
    const bf16_t* bp = wt + (size_t)(c0 + l15) * 1024 + wave * 128 + 8 * g;
    f32x4 acc = (f32x4){0.f, 0.f, 0.f, 0.f};
#pragma unroll
    for (int ks = 0; ks < 4; ++ks) {
        const bf16x8 a = *(const bf16x8*)(ap + ks * 32), bb = *(const bf16x8*)(bp + ks * 32);
        acc = MFMA16(a, bb, acc);
    }
    f32x4* red = (f32x4*)lds;
    __syncthreads();
    red[wave * 64 + lane] = acc;
    __syncthreads();
    if (wave == 0) {
        f32x4 s = red[lane];
#pragma unroll
        for (int w = 1; w < 8; ++w) { const f32x4 t = red[w * 64 + lane]; s.x += t.x; s.y += t.y; s.z += t.z; s.w += t.w; }
        const float* rstd = (const float*)(p.ws + OFF_RSTD) + MROWS;
        const float* rope = (const float*)(p.ws + OFF_ROPE);
        unsigned char* ws = p.ws;
        const int col = c0 + l15;
#pragma unroll
        for (int i = 0; i < 4; ++i) {
            const int row = 4 * g + i;
            float v = s[i] * rstd[row];
            if (job < 64 && (c0 & 63) == 0) {
                const float other = __shfl_xor(v, 8);
                const float* cs = rope + ((size_t)row * 8 + (l15 & 7)) * 2;
                const float c = cs[0], sn = cs[1];
                v = (l15 < 8) ? (v * c - other * sn) : (v * c + other * sn);
            }
            const bf16_t val = f2bf(v);
            if (job < 64) ((bf16_t*)(ws + OFF_AKM))[(size_t)(48 + row) * 1024 + (col - 1024)] = val;
            else if (job < 128) { const int n = col - 2048; ((bf16_t*)(ws + OFF_AVTM))[(size_t)n * 64 + 48 + row] = val; }
            else if (job < 160) ((bf16_t*)(ws + OFF_GKM))[(size_t)row * 512 + (col - 4608)] = val;
            else if (job < 224) { const int n = col - 5120; ((bf16_t*)(ws + OFF_GVTM))[(size_t)n * 64 + 48 + row] = val; }
            else ((bf16_t*)(ws + OFF_GLRM))[row * 16 + l15] = val;
        }
    }
    __syncthreads();
}

DI void phase1(const Params& p, unsigned char* lds) {
    for (int j = blockIdx.x; j < 256; j += gridDim.x) p1_glr_job(p, lds, j);
    for (int j = blockIdx.x; j < 225; j += gridDim.x) p1_meta_job(p, lds, j);
    pg8::Gemm g; g.A = (const bf16_t*)(p.ws + OFF_XB); g.Bt = (const bf16_t*)(p.ws + OFF_WIN_T); g.M = MROWS; g.N = 9216; g.K = 1024;
    SchedP1 S; EpiInProj E; E.ws = p.ws; E.dout = (unsigned char*)p.out;
    pg8::gemm_phase<EpiInProj, SchedP1, true, true>((PG8_LAS unsigned char*)lds, g, S, E);
}

DI void phase15(const Params& p, unsigned char* lds) {
    const int tid = opaque_tid(), col = tid;
    float w2[16];
#pragma unroll
    for (int j = 0; j < 16; ++j) w2[j] = p.gate_w2[j * 512 + col];
    const float bias = p.gate_b[col];
    unsigned char* ws = p.ws;
    unsigned char* dout = (unsigned char*)p.out;
    for (int item = blockIdx.x; item < 257; item += gridDim.x) {
        const bool meta = item == 256;
        const int b = item >> 6, c = item & 63;
        const size_t row0 = (size_t)b * 4096 + c * 64;
        const bf16_t* glr = meta ? (const bf16_t*)(ws + OFF_GLRM) : (const bf16_t*)(ws + OFF_GLR) + row0 * 16;
        const int nrows = meta ? 16 : 64;
        bf16_t* qp = (bf16_t*)(dout + DO_GQ) + row0 * 512 + col;
        const bf16_t* kin = meta ? (const bf16_t*)(ws + OFF_GKM) + col : (const bf16_t*)(dout + DO_GK) + row0 * 512 + col;
        bf16_t* kout = meta ? (bf16_t*)(ws + OFF_KTM) + 48 * 512 + col : (bf16_t*)(dout + DO_GK) + row0 * 512 + col;
        bf16_t* ktt = meta ? (bf16_t*)(ws + OFF_KTTM) + (size_t)col * 64 + 48 : (bf16_t*)(ws + OFF_WIN_T) + ((size_t)b * 512 + col) * 4096 + c * 64;
        __syncthreads();
        if (tid < nrows * 2) ((u32x4*)lds)[tid] = ((const u32x4*)glr)[tid];
        __syncthreads();
        float bsum = 0.f;
        constexpr int GR = 16;
        bf16_t kc[GR], qc[GR], kn[GR], qn[GR];
#pragma unroll
        for (int rr = 0; rr < GR; ++rr) { kc[rr] = kin[(size_t)rr * 512]; qc[rr] = meta ? (bf16_t)0 : qp[(size_t)rr * 512]; }
        for (int r0 = 0; r0 < nrows; r0 += GR) {
            if (r0 + GR < nrows) {
#pragma unroll
                for (int rr = 0; rr < GR; ++rr) { kn[rr] = kin[(size_t)(r0 + GR + rr) * 512]; qn[rr] = meta ? (bf16_t)0 : qp[(size_t)(r0 + GR + rr) * 512]; }
            }
            float kt8[GR];
#pragma unroll
            for (int rr = 0; rr < GR; ++rr) {
                const int r = r0 + rr;
                const u32x4* g4 = (const u32x4*)(lds + r * 32);
                const u32x4 ga = g4[0], gb = g4[1];
                float gk = bias;
                gk += bflo(ga.x) * w2[0] + bfhi(ga.x) * w2[1] + bflo(ga.y) * w2[2] + bfhi(ga.y) * w2[3];
                gk += bflo(ga.z) * w2[4] + bfhi(ga.z) * w2[5] + bflo(ga.w) * w2[6] + bfhi(ga.w) * w2[7];
                gk += bflo(gb.x) * w2[8] + bfhi(gb.x) * w2[9] + bflo(gb.y) * w2[10] + bfhi(gb.y) * w2[11];
                gk += bflo(gb.z) * w2[12] + bfhi(gb.z) * w2[13] + bflo(gb.w) * w2[14] + bfhi(gb.w) * w2[15];
                const float lg = (fminf(gk, 0.f) - __logf(1.0f + __expf(-fabsf(gk)))) * (1.0f / 16.0f);
                bsum += lg;
                const float eb = __expf(bsum);
                const float kt = bf2f(kc[rr]) * __builtin_amdgcn_rcpf(eb);
                kt8[rr] = kt;
                kout[(size_t)r * 512] = f2bf(kt);
                if (!meta) qp[(size_t)r * 512] = f2bf(bf2f(qc[rr]) * 0.08838834764831845f * eb);
            }
#pragma unroll
            for (int hh8 = 0; hh8 < GR / 8; ++hh8) {
                u32x4 o; o.x = pk2(kt8[8 * hh8 + 0], kt8[8 * hh8 + 1]); o.y = pk2(kt8[8 * hh8 + 2], kt8[8 * hh8 + 3]);
                o.z = pk2(kt8[8 * hh8 + 4], kt8[8 * hh8 + 5]); o.w = pk2(kt8[8 * hh8 + 6], kt8[8 * hh8 + 7]);
                *(u32x4*)(ktt + r0 + 8 * hh8) = o;
            }
#pragma unroll
            for (int rr = 0; rr < GR; ++rr) { kc[rr] = kn[rr]; qc[rr] = qn[rr]; }
        }
        if (meta) {
            ((float*)(ws + OFF_DECM))[col] = expf(bsum);
            bf16_t* km = (bf16_t*)(ws + OFF_KTM);
            for (int r = 0; r < 48; ++r) km[r * 512 + col] = 0;
            u32x4 z = {0u, 0u, 0u, 0u};
            u32x4* kz = (u32x4*)((bf16_t*)(ws + OFF_KTTM) + (size_t)col * 64);
#pragma unroll
            for (int j = 0; j < 6; ++j) kz[j] = z;
        } else {
            ((float*)(ws + OFF_DEC))[((size_t)b * 64 + c) * 512 + col] = expf(bsum);
        }
    }
}

constexpr int A_KROWB = 272, A_VROWB = 144, A_KB = 64 * A_KROWB, A_VB = 128 * A_VROWB, A_STAGE = A_KB + A_VB;
DI float max3f(float a, float b, float c) { float r; asm("v_max3_f32 %0, %1, %2, %3" : "=v"(r) : "v"(a), "v"(b), "v"(c)); return r; }
DI void attn_s(const unsigned char* sK, int tt, int qb, int qs, int sub, int l31, int h,
               const bf16x8 (&qf)[4], f32x16 (&O)[4], float& m, float& l, bf16x8 (&pb)[4]) {
    f32x16 st[2];
#pragma unroll
    for (int k2 = 0; k2 < 2; ++k2)
#pragma unroll
        for (int i = 0; i < 16; ++i) st[k2][i] = -m;
    {
        const unsigned char* kb = sK + l31 * A_KROWB + (sub * 64 + 8 * h) * 2;
        bf16x8 ka[4], kc[4];
#pragma unroll
        for (int i = 0; i < 4; ++i) ka[i] = *(const bf16x8*)(kb + (i & 1) * 32 * A_KROWB + (i >> 1) * 32);
        __builtin_amdgcn_sched_barrier(0);
#pragma unroll
        for (int i = 0; i < 4; ++i) kc[i] = *(const bf16x8*)(kb + (i & 1) * 32 * A_KROWB + (2 + (i >> 1)) * 32);
        __builtin_amdgcn_sched_barrier(0);
#pragma unroll
        for (int i = 0; i < 4; ++i) st[i & 1] = MFMA32(ka[i], qf[i >> 1], st[i & 1]);
        __builtin_amdgcn_sched_barrier(0);
#pragma unroll
        for (int i = 0; i < 4; ++i) st[i & 1] = MFMA32(kc[i], qf[2 + (i >> 1)], st[i & 1]);
    }
    if (tt == 0) {
#pragma unroll
        for (int i = 0; i < 16; ++i) { st[0][i] = -INFINITY; if (i < 8) st[1][i] = -INFINITY; }
    } else if (tt >= 2 * qb + 1) {
        const int kbase = (tt - 1) * 64 + 4 * h;
#pragma unroll
        for (int k2 = 0; k2 < 2; ++k2)
#pragma unroll
            for (int i = 0; i < 16; ++i) {
                const int key = kbase + k2 * 32 + (i & 3) + 8 * (i >> 2);
                if (key > qs) st[k2][i] = -INFINITY;
            }
    }
    float mx;
    {
        float t[11];
#pragma unroll
        for (int i = 0; i < 5; ++i) t[i] = max3f(st[0][3 * i], st[0][3 * i + 1], st[0][3 * i + 2]);
#pragma unroll
        for (int i = 0; i < 5; ++i) t[5 + i] = max3f(st[1][3 * i], st[1][3 * i + 1], st[1][3 * i + 2]);
        t[10] = fmaxf(st[0][15], st[1][15]);
        const float u0 = max3f(t[0], t[1], t[2]), u1 = max3f(t[3], t[4], t[5]), u2 = max3f(t[6], t[7], t[8]);
        mx = max3f(max3f(u0, u1, u2), t[9], t[10]);
    }
    mx = xor32_max(mx);
    if (tt == 0 || __builtin_amdgcn_ballot_w64(mx > 8.0f) != 0ull) {
        const float delta = tt == 0 ? mx : fmaxf(mx, 0.f);
        const float alpha = __builtin_amdgcn_exp2f(-delta);
        m += delta;
        l *= alpha;
#pragma unroll
        for (int d = 0; d < 4; ++d) O[d] = O[d] * alpha;
#pragma unroll
        for (int k2 = 0; k2 < 2; ++k2) st[k2] = st[k2] - delta;
    }
#pragma unroll
    for (int k2 = 0; k2 < 2; ++k2)
#pragma unroll
        for (int i = 0; i < 16; ++i) st[k2][i] = __builtin_amdgcn_exp2f(st[k2][i]);
    {
        const f32x16 sv = st[0] + st[1];
        const float ps = (((sv[0] + sv[1]) + (sv[2] + sv[3])) + ((sv[4] + sv[5]) + (sv[6] + sv[7]))) + (((sv[8] + sv[9]) + (sv[10] + sv[11])) + ((sv[12] + sv[13]) + (sv[14] + sv[15])));
        l += ps;
    }
#pragma unroll
    for (int k4 = 0; k4 < 4; ++k4) {
        const int k2 = k4 >> 1, o8 = 8 * (k4 & 1);
        u32x4 pk;
        pk.x = pk2(st[k2][o8 + 0], st[k2][o8 + 1]); pk.y = pk2(st[k2][o8 + 2], st[k2][o8 + 3]);
        pk.z = pk2(st[k2][o8 + 4], st[k2][o8 + 5]); pk.w = pk2(st[k2][o8 + 6], st[k2][o8 + 7]);
        pb[k4] = __builtin_bit_cast(bf16x8, pk);
    }
}
DI void attn_pv(const unsigned char* sV, int l31, int h, const bf16x8 (&pb)[4], f32x16 (&O)[4]) {
    {
        const unsigned char* vb = sV + l31 * A_VROWB + 16 * h;
        bf16x8 va[4], vc[4];
#pragma unroll
        for (int d = 0; d < 4; ++d) va[d] = *(const bf16x8*)(vb + d * 32 * A_VROWB);
        __builtin_amdgcn_sched_barrier(0);
#pragma unroll
        for (int d = 0; d < 4; ++d) vc[d] = *(const bf16x8*)(vb + d * 32 * A_VROWB + 32);
        __builtin_amdgcn_sched_barrier(0);
#pragma unroll
        for (int d = 0; d < 4; ++d) O[d] = MFMA32(va[d], pb[0], O[d]);
        __builtin_amdgcn_sched_barrier(0);
#pragma unroll
        for (int d = 0; d < 4; ++d) va[d] = *(const bf16x8*)(vb + d * 32 * A_VROWB + 64);
        __builtin_amdgcn_sched_barrier(0);
#pragma unroll
        for (int d = 0; d < 4; ++d) O[d] = MFMA32(vc[d], pb[1], O[d]);
        __builtin_amdgcn_sched_barrier(0);
#pragma unroll
        for (int d = 0; d < 4; ++d) vc[d] = *(const bf16x8*)(vb + d * 32 * A_VROWB + 96);
        __builtin_amdgcn_sched_barrier(0);
#pragma unroll
        for (int d = 0; d < 4; ++d) O[d] = MFMA32(va[d], pb[2], O[d]);
        __builtin_amdgcn_sched_barrier(0);
#pragma unroll
        for (int d = 0; d < 4; ++d) O[d] = MFMA32(vc[d], pb[3], O[d]);
    }
}

DI void attn_item(const Params& p, unsigned char* lds, int b, int hd, int qb, float lam) {
    const int tid = opaque_tid(), lane = tid & 63, wave = tid >> 6, l31 = lane & 31, h = lane >> 5;
    const int sub = wave >> 2, rt = wave & 3;
    const bf16_t* aq = (const bf16_t*)((unsigned char*)p.out + DO_AQ);
    const bf16_t* ak = (const bf16_t*)(p.ws + OFF_AK);
    const bf16_t* avT = (const bf16_t*)(p.ws + OFF_AVT);
    const bf16_t* akm = (const bf16_t*)(p.ws + OFF_AKM);
    const bf16_t* avTm = (const bf16_t*)(p.ws + OFF_AVTM);
    bf16_t* az = (bf16_t*)(p.ws + OFF_AZ);
    const int qs = qb * 128 + rt * 32 + l31;
    const size_t grow = (size_t)b * 4096 + qs;
    bf16x8 qf[4];
#pragma unroll
    for (int ks = 0; ks < 4; ++ks) qf[ks] = *(const bf16x8*)(aq + grow * 1024 + hd * 128 + sub * 64 + ks * 16 + 8 * h);
    f32x16 O[4];
#pragma unroll
    for (int d = 0; d < 4; ++d)
#pragma unroll
        for (int i = 0; i < 16; ++i) O[d][i] = 0.f;
    float m = 0.f, l = 0.f;
    const int T = 2 * qb + 3;
    u32x4 k0r[2], v0r[2];
    const int krow_ = tid >> 4, kc_ = tid & 15, vdv_ = tid >> 3, vc_ = tid & 7;
    const bf16_t* kp = ak + ((size_t)b * 4096 + krow_) * 1024 + hd * 128 + kc_ * 8;
    const bf16_t* vp_ = avT + ((size_t)(b * 8 + hd) * 128 + vdv_) * 4096 + vc_ * 8;
#define A_LOAD_REAL(KR, VR)                                                                                                   \
    {                                                                                                                         \
        KR[0] = *(const u32x4*)kp; KR[1] = *(const u32x4*)(kp + 32 * 1024); kp += 64 * 1024;                                  \
        VR[0] = *(const u32x4*)vp_; VR[1] = *(const u32x4*)(vp_ + (size_t)64 * 4096); vp_ += 64;                              \
    }
#define A_STORE(KR, VR, buf_)                                                                                                 \
    {                                                                                                                         \
        unsigned char* sK_ = lds + (buf_) * A_STAGE; unsigned char* sV_ = sK_ + A_KB;                                         \
        _Pragma("unroll") for (int i = 0; i < 2; ++i) { const int pi = tid + 512 * i, row = pi >> 4, c = pi & 15;              \
            *(u32x4*)(sK_ + row * A_KROWB + c * 16) = KR[i]; }                                                                \
        _Pragma("unroll") for (int i = 0; i < 2; ++i) { const int pi = tid + 512 * i, dv = pi >> 3, c = pi & 7;                \
            unsigned char* d_ = sV_ + dv * A_VROWB + (c >> 1) * 32 + 8 * (c & 1); u32x2 a_, b_; a_.x = VR[i].x; a_.y = VR[i].y; b_.x = VR[i].z; b_.y = VR[i].w; \
            *(u32x2*)d_ = a_; *(u32x2*)(d_ + 16) = b_; }                                                                      \
    }
    {
        const bf16_t* km_ = akm + (size_t)krow_ * 1024 + hd * 128 + kc_ * 8;
        k0r[0] = *(const u32x4*)km_; k0r[1] = *(const u32x4*)(km_ + 32 * 1024);
        const bf16_t* vm_ = avTm + (size_t)(hd * 128 + vdv_) * 64 + vc_ * 8;
        v0r[0] = *(const u32x4*)vm_; v0r[1] = *(const u32x4*)(vm_ + 64 * 64);
    }
    u32x4 k1r[2], v1r[2];
    A_LOAD_REAL(k1r, v1r);
#pragma unroll
    for (int ks = 0; ks < 4; ++ks) asm volatile("" : "+v"(qf[ks]));
    A_STORE(k0r, v0r, 0);
    __syncthreads();
    bf16x8 pb[4];
    int bc = 0, bp = 2, bn = 1;
    {
        attn_s(lds + bc * A_STAGE, 0, qb, qs, sub, l31, h, qf, O, m, l, pb);
        attn_pv(lds + bc * A_STAGE + A_KB, l31, h, pb, O);
        A_STORE(k1r, v1r, bn);
        __syncthreads();
        bp = bc; bc = bn; bn = (bn == 2) ? 0 : bn + 1;
    }
    for (int tt = 1; tt < T; ++tt) {
        if (tt + 1 < T) A_LOAD_REAL(k0r, v0r);
        attn_s(lds + bc * A_STAGE, tt, qb, qs, sub, l31, h, qf, O, m, l, pb);
        attn_pv(lds + bc * A_STAGE + A_KB, l31, h, pb, O);
        if (tt + 1 < T) A_STORE(k0r, v0r, bn);
        __syncthreads();
        bp = bc; bc = bn; bn = (bn == 2) ? 0 : bn + 1;
    }

#undef A_LOAD_REAL
#undef A_STORE
    const float ltot = xor32_sum(l);
    const float linv = 1.0f / ltot;
    u32x2 zz[4][4];
    if (sub == 0) {
#pragma unroll
        for (int d = 0; d < 4; ++d)
#pragma unroll
            for (int g = 0; g < 4; ++g) zz[d][g] = *(const u32x2*)(az + grow * 1024 + hd * 128 + d * 32 + 8 * g + 4 * h);
    }
    float* ex = (float*)lds;
    if (sub == 1) {
#pragma unroll
        for (int d = 0; d < 4; ++d) {
#pragma unroll
            for (int g = 0; g < 4; ++g) {
                f32x4 t; t.x = O[d][4 * g] * linv; t.y = O[d][4 * g + 1] * linv; t.z = O[d][4 * g + 2] * linv; t.w = O[d][4 * g + 3] * linv;
                *(f32x4*)(ex + (rt * 32 + l31) * 132 + d * 32 + 8 * g + 4 * h) = t;
            }
            __builtin_amdgcn_sched_barrier(0);
        }
    }
    __syncthreads();
    if (sub == 0) {
        float ss = 0.f;
#pragma unroll
        for (int d = 0; d < 4; ++d) {
#pragma unroll
            for (int g = 0; g < 4; ++g) {
                const f32x4 t = *(const f32x4*)(ex + (rt * 32 + l31) * 132 + d * 32 + 8 * g + 4 * h);
                const float o0 = O[d][4 * g] * linv - lam * t.x, o1 = O[d][4 * g + 1] * linv - lam * t.y;
                const float o2 = O[d][4 * g + 2] * linv - lam * t.z, o3 = O[d][4 * g + 3] * linv - lam * t.w;
                O[d][4 * g] = o0; O[d][4 * g + 1] = o1; O[d][4 * g + 2] = o2; O[d][4 * g + 3] = o3;
                ss += (o0 * o0 + o1 * o1) + (o2 * o2 + o3 * o3);
            }
            __builtin_amdgcn_sched_barrier(0);
        }
        ss = xor32_sum(ss);
        const float rstd = 1.0f / sqrtf(ss * (1.0f / 128.0f) + EPS);
#pragma unroll
        for (int d = 0; d < 4; ++d)
#pragma unroll
            for (int g = 0; g < 4; ++g) {
                bf16_t* zp = az + grow * 1024 + hd * 128 + d * 32 + 8 * g + 4 * h;
                const u32x2 z2 = zz[d][g];
                u32x2 o;
                o.x = pk2(O[d][4 * g] * rstd * siluf_(bflo(z2.x)), O[d][4 * g + 1] * rstd * siluf_(bfhi(z2.x)));
                o.y = pk2(O[d][4 * g + 2] * rstd * siluf_(bflo(z2.y)), O[d][4 * g + 3] * rstd * siluf_(bfhi(z2.y)));
                *(u32x2*)zp = o;
                if (g == 3) __builtin_amdgcn_sched_barrier(0);
            }
    }
    __syncthreads();
}

constexpr int L_KROWB = 272, L_VROWB = 144, L_SROWB = 272;
constexpr int GLA_DL = 2;
#define L_BAR() { asm volatile("s_waitcnt lgkmcnt(0)" ::: "memory"); __builtin_amdgcn_s_barrier(); asm volatile("" ::: "memory"); }
template <int DL>
DI void gla_item(const Params& p, unsigned char* lds, int b, int hh, int sl) {
    constexpr int SLW = 32 * DL, NVP = SLW / 64;
    constexpr int L_K = 0, L_V = 64 * L_KROWB, L_S = L_V + SLW * L_VROWB, L_KT = L_S + SLW * L_SROWB;
    const int tid = opaque_tid(), lane = tid & 63, wave = tid >> 6, l15 = lane & 15, g = lane >> 4;
    const int tt = wave & 3, dvt = wave >> 2;
    unsigned char* ws = p.ws;
    unsigned char* dout = (unsigned char*)p.out;
    const bf16_t* gq = (const bf16_t*)(dout + DO_GQ);
    const bf16_t* gk = (const bf16_t*)(dout + DO_GK);
    const bf16_t* gvT = (const bf16_t*)(ws + OFF_GVT);
    const bf16_t* ktt = (const bf16_t*)(ws + OFF_WIN_T);
    const float* dec = (const float*)(ws + OFF_DEC);
    bf16_t* gz = (bf16_t*)(ws + OFF_GZ);
    float* ssqb = (float*)(ws + OFF_SSQB);
    unsigned char* sK = lds + L_K; unsigned char* sV = lds + L_V; unsigned char* sS = lds + L_S; unsigned char* sKT = lds + L_KT;
    for (int i = tid; i < SLW * L_SROWB / 4; i += 512) ((unsigned*)sS)[i] = 0u;
    f32x4 sacc[DL][2];
#pragma unroll
    for (int dl = 0; dl < DL; ++dl)
#pragma unroll
        for (int c = 0; c < 2; ++c) sacc[dl][c] = (f32x4){0.f, 0.f, 0.f, 0.f};
    u32x4 nkA[2]; u32x4 nvA[NVP]; bf16x8 nqA[4]; u32x4 nktA[2]; float ndA[2]; u32x2 ngzA[DL];
    u32x4 nkB[2]; u32x4 nvB[NVP]; bf16x8 nqB[4]; u32x4 nktB[2]; float ndB[2]; u32x2 ngzB[DL];
    const int cc0 = 16 * (2 * tt) + l15;
    const int dv0 = 16 * (dvt * DL);
    const int krow_ = tid >> 4, kc_ = tid & 15, vdv_ = tid >> 3, vc_ = tid & 7;
    const bf16_t* kp = gk + ((size_t)b * 4096 + krow_) * 512 + hh * 128 + kc_ * 8;
    const bf16_t* vp_ = gvT + ((size_t)(b * 4 + hh) * 256 + sl * SLW + vdv_) * 4096 + vc_ * 8;
    const bf16_t* ktp = ktt + ((size_t)(b * 4 + hh) * 128 + vdv_) * 4096 + vc_ * 8;
    const float* dp = dec + (size_t)b * 64 * 512 + hh * 128 + cc0;
    const bf16_t* qp = gq + ((size_t)b * 4096 + 16 * tt + l15) * 512 + hh * 128 + 8 * g;
    bf16_t* gzp = gz + ((size_t)b * 4096 + 16 * tt + l15) * 1024 + hh * 256 + sl * SLW + dv0 + 4 * g;
#define L_LOAD_META(S)                                                                                                         \
    {                                                                                                                         \
        const bf16_t* km_ = (const bf16_t*)(ws + OFF_KTM) + (size_t)krow_ * 512 + hh * 128 + kc_ * 8;                         \
        nk##S[0] = *(const u32x4*)km_; nk##S[1] = *(const u32x4*)(km_ + 32 * 512);                                                  \
        _Pragma("unroll") for (int i = 0; i < NVP; ++i)                                                                       \
            nv##S[i] = *(const u32x4*)((const bf16_t*)(ws + OFF_GVTM) + (size_t)(hh * 256 + sl * SLW + vdv_ + 64 * i) * 64 + vc_ * 8); \
        _Pragma("unroll") for (int i = 0; i < 2; ++i)                                                                         \
            nkt##S[i] = *(const u32x4*)((const bf16_t*)(ws + OFF_KTTM) + (size_t)(hh * 128 + vdv_ + 64 * i) * 64 + vc_ * 8);     \
        _Pragma("unroll") for (int ct = 0; ct < 2; ++ct) nd##S[ct] = ((const float*)(ws + OFF_DECM))[hh * 128 + cc0 + 16 * ct];  \
        _Pragma("unroll") for (int ks = 0; ks < 4; ++ks) nq##S[ks] = (bf16x8){0, 0, 0, 0, 0, 0, 0, 0};                           \
        _Pragma("unroll") for (int dl = 0; dl < DL; ++dl) ngz##S[dl] = (u32x2){0u, 0u};                                          \
    }
#define L_LOAD_REAL(S)                                                                                                         \
    {                                                                                                                         \
        nk##S[0] = *(const u32x4*)kp; nk##S[1] = *(const u32x4*)(kp + 32 * 512); kp += 64 * 512;                                    \
        _Pragma("unroll") for (int i = 0; i < NVP; ++i) nv##S[i] = *(const u32x4*)(vp_ + (size_t)(64 * i) * 4096);               \
        vp_ += 64;                                                                                                            \
        _Pragma("unroll") for (int i = 0; i < 2; ++i) nkt##S[i] = *(const u32x4*)(ktp + (size_t)(64 * i) * 4096);              \
        ktp += 64;                                                                                                            \
        nd##S[0] = dp[0]; nd##S[1] = dp[16]; dp += 512;                                                                             \
        _Pragma("unroll") for (int ks = 0; ks < 4; ++ks) nq##S[ks] = *(const bf16x8*)(qp + 32 * ks);                             \
        qp += 64 * 512;                                                                                                       \
        _Pragma("unroll") for (int dl = 0; dl < DL; ++dl) ngz##S[dl] = *(const u32x2*)(gzp + 16 * dl);                           \
        gzp += 64 * 1024;                                                                                                     \
    }
#define L_STORE(S)                                                                                                             \
    {                                                                                                                         \
        _Pragma("unroll") for (int i = 0; i < 2; ++i) { const int pi = tid + 512 * i, row = pi >> 4, c = pi & 15;              \
            *(u32x4*)(sK + row * L_KROWB + c * 16) = nk##S[i]; }                                                                 \
        _Pragma("unroll") for (int i = 0; i < NVP; ++i) *(u32x4*)(sV + (vdv_ + 64 * i) * L_VROWB + vc_ * 16) = nv##S[i];          \
        _Pragma("unroll") for (int i = 0; i < 2; ++i) *(u32x4*)(sKT + (vdv_ + 64 * i) * L_VROWB + vc_ * 16) = nkt##S[i];          \
    }
    L_LOAD_META(A);
    L_LOAD_REAL(B);
    L_STORE(A);
#define GLA_STEP(n_, C, O) {                                                                                         \
        bf16x8 cq[4]; float cd[2]; u32x2 cgz[DL]; \
_Pragma("unroll") \
        for (int ks = 0; ks < 4; ++ks) cq[ks] = nq##C[ks]; \
_Pragma("unroll") \
        for (int ct = 0; ct < 2; ++ct) { cd[ct] = nd##C[ct]; } \
_Pragma("unroll") \
        for (int dl = 0; dl < DL; ++dl) cgz[dl] = ngz##C[dl]; \
_Pragma("unroll") \
        for (int ks = 0; ks < 4; ++ks) asm volatile("" : "+v"(cq[ks])); \
_Pragma("unroll") \
        for (int ct = 0; ct < 2; ++ct) { asm volatile("" : "+v"(cd[ct])); } \
_Pragma("unroll") \
        for (int dl = 0; dl < DL; ++dl) asm volatile("" : "+v"(cgz[dl])); \
        L_BAR(); \
        if ((n_) + 2 <= 64) L_LOAD_REAL(C); \
        if ((n_) > 0) { \
            f32x4 at[4]; \
_Pragma("unroll") \
            for (int jt = 0; jt < 4; ++jt) at[jt] = (f32x4){0.f, 0.f, 0.f, 0.f}; \
            { \
                const unsigned char* kb = sK + l15 * L_KROWB + 16 * g; \
                bf16x8 ka[8], kc[8]; \
_Pragma("unroll") \
                for (int i = 0; i < 8; ++i) ka[i] = *(const bf16x8*)(kb + (i & 3) * 16 * L_KROWB + (i >> 2) * 64); \
                __builtin_amdgcn_sched_barrier(0); \
_Pragma("unroll") \
                for (int i = 0; i < 8; ++i) kc[i] = *(const bf16x8*)(kb + (i & 3) * 16 * L_KROWB + (2 + (i >> 2)) * 64); \
                __builtin_amdgcn_sched_barrier(0); \
_Pragma("unroll") \
                for (int i = 0; i < 8; ++i) at[i & 3] = MFMA16(ka[i], cq[i >> 2], at[i & 3]); \
                __builtin_amdgcn_sched_barrier(0); \
_Pragma("unroll") \
                for (int i = 0; i < 8; ++i) at[i & 3] = MFMA16(kc[i], cq[2 + (i >> 2)], at[i & 3]); \
            } \
            const int tl = 16 * tt + l15; \
_Pragma("unroll") \
            for (int jt = 0; jt < 4; ++jt) \
_Pragma("unroll") \
                for (int i = 0; i < 4; ++i) if (16 * jt + 4 * g + i > tl) at[jt][i] = 0.f; \
            bf16x8 pa[2]; \
_Pragma("unroll") \
            for (int s2 = 0; s2 < 2; ++s2) { \
                u32x4 t; \
                t.x = pk2(at[2 * s2][0], at[2 * s2][1]); t.y = pk2(at[2 * s2][2], at[2 * s2][3]); \
                t.z = pk2(at[2 * s2 + 1][0], at[2 * s2 + 1][1]); t.w = pk2(at[2 * s2 + 1][2], at[2 * s2 + 1][3]); \
                pa[s2] = __builtin_bit_cast(bf16x8, t); \
            } \
            const size_t row = (size_t)b * 4096 + ((n_) - 1) * 64 + 16 * tt + l15; \
_Pragma("unroll") \
            for (int dl = 0; dl < DL; ++dl) { \
                const int dvr = dv0 + 16 * dl + l15; \
                f32x4 o = (f32x4){0.f, 0.f, 0.f, 0.f}; \
                { \
                    u32x4 vv[2]; bf16x8 sf[4]; \
_Pragma("unroll") \
                    for (int s2 = 0; s2 < 2; ++s2) { \
                        const unsigned char* vp = sV + dvr * L_VROWB + (32 * s2 + 4 * g) * 2; \
                        const u32x2 lo = *(const u32x2*)vp, hi = *(const u32x2*)(vp + 32); \
                        vv[s2].x = lo.x; vv[s2].y = lo.y; vv[s2].z = hi.x; vv[s2].w = hi.y; \
                    } \
_Pragma("unroll") \
                    for (int ks = 0; ks < 4; ++ks) sf[ks] = *(const bf16x8*)(sS + dvr * L_SROWB + (ks * 32 + 8 * g) * 2); \
                    __builtin_amdgcn_sched_barrier(0); \
                    f32x4 o2 = (f32x4){0.f, 0.f, 0.f, 0.f}; \
                    o = MFMA16(__builtin_bit_cast(bf16x8, vv[0]), pa[0], o); \
                    o2 = MFMA16(sf[0], cq[0], o2); \
                    o = MFMA16(__builtin_bit_cast(bf16x8, vv[1]), pa[1], o); \
                    o2 = MFMA16(sf[1], cq[1], o2); \
                    o = MFMA16(sf[2], cq[2], o); \
                    o2 = MFMA16(sf[3], cq[3], o2); \
                    o = o + o2; \
                } \
                float ss = (o[0] * o[0] + o[1] * o[1]) + (o[2] * o[2] + o[3] * o[3]); \
                ss = xor16_sum(ss); ss = xor32_sum(ss); \
                u32x2 ov; \
                ov.x = pk2(o[0] * siluf_(bflo(cgz[dl].x)), o[1] * siluf_(bfhi(cgz[dl].x))); \
                ov.y = pk2(o[2] * siluf_(bflo(cgz[dl].y)), o[3] * siluf_(bfhi(cgz[dl].y))); \
                *(u32x2*)(gz + row * 1024 + hh * 256 + sl * SLW + dv0 + 16 * dl + 4 * g) = ov; \
                if (g == 0) ssqb[(row * 4 + hh) * 16 + sl * 2 * DL + dvt * DL + dl] = ss; \
            } \
        } \
        bf16x8 vfs[DL][2]; \
_Pragma("unroll") \
        for (int dl = 0; dl < DL; ++dl) \
_Pragma("unroll") \
            for (int ks = 0; ks < 2; ++ks) vfs[dl][ks] = *(const bf16x8*)(sV + (dv0 + 16 * dl + l15) * L_VROWB + (32 * ks + 8 * g) * 2); \
        bf16x8 ckt[2][2]; \
        _Pragma("unroll") \
        for (int ct = 0; ct < 2; ++ct) \
        _Pragma("unroll") \
            for (int ks = 0; ks < 2; ++ks) ckt[ct][ks] = *(const bf16x8*)(sKT + (cc0 + 16 * ct) * L_VROWB + (32 * ks + 8 * g) * 2); \
        __builtin_amdgcn_sched_barrier(0); \
_Pragma("unroll") \
        for (int dl = 0; dl < DL; ++dl) { \
_Pragma("unroll") \
            for (int ks = 0; ks < 2; ++ks) { \
                sacc[dl][0] = MFMA16(vfs[dl][ks], ckt[0][ks], sacc[dl][0]); \
                sacc[dl][1] = MFMA16(vfs[dl][ks], ckt[1][ks], sacc[dl][1]); \
            } \
_Pragma("unroll") \
            for (int ct = 0; ct < 2; ++ct) \
_Pragma("unroll") \
                for (int i = 0; i < 4; ++i) sacc[dl][ct][i] *= cd[ct]; \
        } \
        L_BAR(); \
_Pragma("unroll") \
        for (int dl = 0; dl < DL; ++dl) \
_Pragma("unroll") \
            for (int ct = 0; ct < 2; ++ct) \
_Pragma("unroll") \
                for (int i = 0; i < 4; ++i) \
                    *(bf16_t*)(sS + (dv0 + 16 * dl + 4 * g + i) * L_SROWB + (cc0 + 16 * ct) * 2) = f2bf(sacc[dl][ct][i]); \
        if ((n_) + 1 <= 64) L_STORE(O); \
    }
    for (int n2 = 0; n2 <= 64; n2 += 2) {
        GLA_STEP(n2, A, B);
        if (n2 + 1 > 64) break;
        GLA_STEP(n2 + 1, B, A);
    }
#undef GLA_STEP
#undef L_LOAD_META
#undef L_LOAD_REAL
#undef L_STORE
    __syncthreads();
}

DI void phase2(const Params& p, unsigned char* lds) {
    const int tid = opaque_tid();
    float lam;
    {
        const int lane = tid & 63;
        const float a_ = wave_sum(p.lq1[lane] * p.lk1[lane]);
        const float b_ = wave_sum(p.lq2[lane] * p.lk2[lane]);
        lam = __uint_as_float((unsigned)__builtin_amdgcn_readfirstlane((int)__float_as_uint(expf(a_) - expf(b_) + 0.2f)));
    }
    volatile unsigned* sItem = (volatile unsigned*)(lds + LDS_ITEM);
    constexpr unsigned NSL = 8 / GLA_DL, N_GLA = 2 * NSL, N_ATT = 128;
    if (tid == 0) sItem[1] = 0u;
    for (;;) {
        if (tid == 0) {
            unsigned* heads = (unsigned*)(p.ws + OFF_XBAR + 15360);
            const unsigned x0 = (unsigned)__builtin_amdgcn_s_getreg((3 << 11) | 20) & 7u;
            unsigned k = sItem[1], it = 0xffffffffu;
            while (k < 8u) {
                const unsigned x = (x0 + k) & 7u;
                const unsigned got = atomicAdd(heads + x, 1u);
                if (got < N_GLA + N_ATT) { it = got | (x << 16); break; }
                ++k;
            }
            sItem[1] = k; sItem[0] = it;
        }
        __syncthreads();
        const unsigned item = (unsigned)__builtin_amdgcn_readfirstlane((int)sItem[0]);
        __syncthreads();
        if (item == 0xffffffffu) break;
        const unsigned x = item >> 16, idx = item & 0xffffu;
        if (idx < N_GLA) { const unsigned gi = x * N_GLA + idx; gla_item<GLA_DL>(p, lds, gi / (4 * NSL), (gi / NSL) & 3, gi % NSL); }
        else { const unsigned a = idx - N_GLA, pair = 4 * x + (a >> 5); attn_item(p, lds, pair & 3, pair >> 2, 31 - (int)(a & 31), lam); }
    }
}

DI void phase25(const Params& p, unsigned char* lds) {
    const int tid = opaque_tid(), lane = tid & 63, wave = tid >> 6;
    const float* ssqb = (const float*)(p.ws + OFF_SSQB);
    bf16_t* gz = (bf16_t*)(p.ws + OFF_GZ);
    for (int it = blockIdx.x; it < MROWS / 32; it += gridDim.x) {
        const size_t row0 = (size_t)it * 32 + wave * 4;
        u32x4 u[4][2]; float s[4];
#pragma unroll
        for (int q = 0; q < 4; ++q) {
            const u32x4* ptr = (const u32x4*)(gz + (row0 + q) * 1024 + lane * 16);
            u[q][0] = ptr[0]; u[q][1] = ptr[1];
            s[q] = ssqb[((row0 + q) * 4 + (lane >> 4)) * 16 + (lane & 15)];
        }
#pragma unroll
        for (int q = 0; q < 4; ++q) {
            float t = s[q];
            t += __shfl_xor(t, 1); t += __shfl_xor(t, 2); t += __shfl_xor(t, 4); t += __shfl_xor(t, 8);
            const float r = 1.0f / sqrtf(t * (1.0f / 256.0f) + EPS);
            u32x4* ptr = (u32x4*)(gz + (row0 + q) * 1024 + lane * 16);
#pragma unroll
            for (int j = 0; j < 2; ++j) {
                const u32x4 a = u[q][j]; u32x4 o;
                o.x = pk2(bflo(a.x) * r, bfhi(a.x) * r); o.y = pk2(bflo(a.y) * r, bfhi(a.y) * r);
                o.z = pk2(bflo(a.z) * r, bfhi(a.z) * r); o.w = pk2(bflo(a.w) * r, bfhi(a.w) * r);
                ptr[j] = o;
            }
        }
    }
}

template <int PASS>
struct EpiMerge {
    static constexpr bool PERM = false, AFTER_DRAIN = false;
    unsigned char* ws; const PG8_LAS float* tab;
    DI void operator()(const pg8::f32x4 (&acc)[2][2][4][2], const pg8::Unit& u, int wr, int wc, int fr, int fq) const {
        const unsigned char* sg = ws + (PASS == 0 ? OFF_SGB : OFF_SGA);
        bf16_t* merged = (bf16_t*)(ws + OFF_AK);
#pragma unroll
        for (int ai = 0; ai < 2; ++ai)
#pragma unroll
            for (int m = 0; m < 4; ++m) {
                const size_t tok = (size_t)u.pm * 256 + ai * 128 + wr * 64 + m * 16 + fr;
#pragma unroll
                for (int bj = 0; bj < 2; ++bj)
#pragma unroll
                    for (int n = 0; n < 2; ++n) {
                        const size_t off = tok * 1024 + u.pn * 256 + bj * 128 + wc * 32 + n * 16 + 4 * fq;
                        const unsigned ug = *(const unsigned*)(sg + off);
                        const float q = (PASS == 0 ? tab[(ai * 128 + wr * 64 + m * 16 + fr) * 4 + 3] : 1.0f) * (1.0f / 255.0f);
                        float m0 = (float)(ug & 255u) * q * acc[ai][bj][m][n][0], m1 = (float)((ug >> 8) & 255u) * q * acc[ai][bj][m][n][1];
                        float m2 = (float)((ug >> 16) & 255u) * q * acc[ai][bj][m][n][2], m3 = (float)(ug >> 24) * q * acc[ai][bj][m][n][3];
                        if (PASS == 1) { const u32x2 t = *(const u32x2*)(merged + off); m0 += bflo(t.x); m1 += bfhi(t.x); m2 += bflo(t.y); m3 += bfhi(t.y); }
                        u32x2 o; o.x = pk2(m0, m1); o.y = pk2(m2, m3);
                        *(u32x2*)(merged + off) = o;
                    }
            }
    }
};
struct EpiOut {
    static constexpr bool PERM = false, AFTER_DRAIN = true;
    unsigned char* ws; const float* x; float* out; const float* fw;
    DI void fused(pg8::f32x4 (&acc)[2][2][4][2], const pg8::Unit& u, int wr, int wc, int fr, int fq, PG8_LAS unsigned char* lds, int wid, int lane) const {
        float* ssqh = (float*)(ws + OFF_SSQH);
        unsigned* pcnt = (unsigned*)(ws + OFF_XBAR + 14336) + u.pm;
#pragma unroll
        for (int ai = 0; ai < 2; ++ai)
#pragma unroll
            for (int m = 0; m < 4; ++m) {
                const size_t tok = (size_t)u.pm * 256 + ai * 128 + wr * 64 + m * 16 + fr;
                float ss = 0.f;
#pragma unroll
                for (int bj = 0; bj < 2; ++bj)
#pragma unroll
                    for (int n = 0; n < 2; ++n) {
                        const size_t off = tok * 1024 + u.pn * 256 + bj * 128 + wc * 32 + n * 16 + 4 * fq;
                        const f32x4 xv = *(const f32x4*)(x + off);
                        f32x4 o = acc[ai][bj][m][n];
                        o.x += xv.x; o.y += xv.y; o.z += xv.z; o.w += xv.w;
                        acc[ai][bj][m][n] = o;
                        ss += (o.x * o.x + o.y * o.y) + (o.z * o.z + o.w * o.w);
                    }
                ss = xor16_sum(ss); ss = xor32_sum(ss);
                if (fq == 0) ssqh[tok * 16 + u.pn * 4 + wc] = ss;
            }
        asm volatile("s_waitcnt vmcnt(0)" ::: "memory");
        __syncthreads();
        if (threadIdx.x == 0) {
            __builtin_amdgcn_fence(__ATOMIC_RELEASE, "agent");
            asm volatile("s_waitcnt vmcnt(0)" ::: "memory");
            __hip_atomic_fetch_add(pcnt, 1u, __ATOMIC_RELAXED, __HIP_MEMORY_SCOPE_AGENT);
            unsigned spins = 0u;
            while (__hip_atomic_load(pcnt, __ATOMIC_RELAXED, __HIP_MEMORY_SCOPE_AGENT) < 4u && ++spins < (1u << 22)) __builtin_amdgcn_s_sleep(1);
            __builtin_amdgcn_fence(__ATOMIC_ACQUIRE, "agent");
            asm volatile("s_waitcnt vmcnt(0)" ::: "memory");
        }
        __syncthreads();
#pragma unroll
        for (int ai = 0; ai < 2; ++ai)
#pragma unroll
            for (int m = 0; m < 4; ++m) {
                const size_t tok = (size_t)u.pm * 256 + ai * 128 + wr * 64 + m * 16 + fr;
                const f32x4* sp = (const f32x4*)(ssqh + tok * 16);
                const f32x4 a = sp[0], b2 = sp[1], c = sp[2], d = sp[3];
                const float s = ((a.x + a.y) + (a.z + a.w)) + ((b2.x + b2.y) + (b2.z + b2.w)) + ((c.x + c.y) + (c.z + c.w)) + ((d.x + d.y) + (d.z + d.w));
                const float rstd = 1.0f / sqrtf(s * (1.0f / 1024.0f) + EPS);
#pragma unroll
                for (int bj = 0; bj < 2; ++bj)
#pragma unroll
                    for (int n = 0; n < 2; ++n) {
                        const int col = u.pn * 256 + bj * 128 + wc * 32 + n * 16 + 4 * fq;
                        const f32x4 w = *(const f32x4*)(fw + col);
                        f32x4 o = acc[ai][bj][m][n];
                        o.x = o.x * rstd * w.x; o.y = o.y * rstd * w.y; o.z = o.z * rstd * w.z; o.w = o.w * rstd * w.w;
                        *(f32x4*)(out + tok * 1024 + col) = o;
                    }
            }
    }
};
DI void phase3(const Params& p, unsigned char* lds) {
    SchedSq S;
    {
        pg8::Unit u0; S.next(0, u0);
        const int tid = opaque_tid();
        float* tabw = (float*)(lds + 147456);
        if (tid < 256) {
            const float* sp = (const float*)(p.ws + OFF_SSQB) + ((size_t)u0.pm * 256 + tid) * 64;
            float r[4];
#pragma unroll
            for (int hh = 0; hh < 4; ++hh) {
                const f32x4 a = *(const f32x4*)(sp + hh * 16), b2 = *(const f32x4*)(sp + hh * 16 + 4), c = *(const f32x4*)(sp + hh * 16 + 8), d = *(const f32x4*)(sp + hh * 16 + 12);
                const float s = ((a.x + a.y) + (a.z + a.w)) + ((b2.x + b2.y) + (b2.z + b2.w)) + ((c.x + c.y) + (c.z + c.w)) + ((d.x + d.y) + (d.z + d.w));
                r[hh] = 1.0f / sqrtf(s * (1.0f / 256.0f) + EPS);
            }
            f32x4 o; o.x = r[0] / r[1]; o.y = r[1] / r[2]; o.z = r[2] / r[3]; o.w = r[3];
            *(f32x4*)(tabw + tid * 4) = o;
        }
        __syncthreads();
    }
    {
        pg8::Gemm g; g.A = (const bf16_t*)(p.ws + OFF_GZ); g.Bt = (const bf16_t*)(p.ws + OFF_WB_T); g.M = MROWS; g.N = 1024; g.K = 1024;
        EpiMerge<0> E; E.ws = p.ws; E.tab = (const PG8_LAS float*)(lds + 147456);
        pg8::gemm_phase<EpiMerge<0>, SchedSq, true, true, true>((PG8_LAS unsigned char*)lds, g, S, E);
    }
    {
        pg8::Gemm g; g.A = (const bf16_t*)(p.ws + OFF_AZ); g.Bt = (const bf16_t*)(p.ws + OFF_WA_T); g.M = MROWS; g.N = 1024; g.K = 1024;
        EpiMerge<1> E; E.ws = p.ws; E.tab = (const PG8_LAS float*)(lds + 147456);
        pg8::gemm_phase<EpiMerge<1>, SchedSq, true, true>((PG8_LAS unsigned char*)lds, g, S, E);
    }
}
DI void phase4(const Params& p, unsigned char* lds) {
    SchedSq S;
    pg8::Gemm g; g.A = (const bf16_t*)(p.ws + OFF_AK); g.Bt = (const bf16_t*)(p.ws + OFF_WO_T); g.M = MROWS; g.N = 1024; g.K = 1024;
    EpiOut E; E.ws = p.ws; E.x = p.x; E.out = p.out; E.fw = p.final_w;
    pg8::gemm_phase<EpiOut, SchedSq, false, true>((PG8_LAS unsigned char*)lds, g, S, E);
}

DI void phase5(const Params& p, unsigned char* lds) {
    const int tid = opaque_tid(), lane = tid & 63, wave = tid >> 6;
    const float* ssqh = (const float*)(p.ws + OFF_SSQH);
    for (int it = blockIdx.x; it < MROWS / 8; it += gridDim.x) {
        const size_t row = (size_t)it * 8 + wave;
        float s = lane < 16 ? ssqh[row * 16 + lane] : 0.f;
        s = wave_sum(s);
        const float rstd = 1.0f / sqrtf(s * (1.0f / 1024.0f) + EPS);
        f32x4* orow = (f32x4*)(p.out + row * 1024) + lane;
        const f32x4* wrow = (const f32x4*)p.final_w + lane;
#pragma unroll
        for (int j = 0; j < 4; ++j) {
            f32x4 v = orow[64 * j]; const f32x4 w = wrow[64 * j];
            v.x = v.x * rstd * w.x; v.y = v.y * rstd * w.y; v.z = v.z * rstd * w.z; v.w = v.w * rstd * w.w;
            orow[64 * j] = v;
        }
    }
}

#define XB_TMO      128
#define XB_XCNT(j)  (256  + 64 * (j))
#define XB_XSUB(j)  (1280 + 64 * (j))
#define XB_XGEN(j)  (2304 + 64 * (j))
#define XB_TOP      3328
#define XB_TOPGEN   3392
#define XCD_BAR_WORDS 3456
#define XB_SPIN_CAP (1u << 18)
#define LAS __attribute__((address_space(3)))
DI unsigned xb_ld(unsigned* p)              { return __hip_atomic_load(p, __ATOMIC_RELAXED, __HIP_MEMORY_SCOPE_AGENT); }
DI unsigned xb_add(unsigned* p, unsigned v) { return __hip_atomic_fetch_add(p, v, __ATOMIC_RELAXED, __HIP_MEMORY_SCOPE_AGENT); }
DI unsigned xb_xcc_id() { return (unsigned)__builtin_amdgcn_s_getreg((3 << 11) | 20) & 0xFu; }
#define XB_SPIN(cond, bar) do { unsigned _sp = 0; while (cond) { __builtin_amdgcn_s_sleep(1); \
    if ((++_sp & 255u) == 0u) { if (xb_ld(&(bar)[XB_TMO])) break; if (_sp > XB_SPIN_CAP) { atomicAdd(&(bar)[XB_TMO], 1u); break; } } } } while (0)
struct XcdBarrier { unsigned* bar; unsigned x; volatile LAS unsigned* st; };
DI XcdBarrier xcd_barrier_post(unsigned* bar, volatile LAS unsigned* st) {
    XcdBarrier b; b.bar = bar; b.x = xb_xcc_id(); b.st = st;
    if (threadIdx.x == 0) (void)xb_add(&bar[XB_XCNT(b.x)], 1u);
    return b;
}
DI void xcd_barrier_complete(unsigned* bar, unsigned x, unsigned& nloc, unsigned& nx) {
    const unsigned G = gridDim.x * gridDim.y * gridDim.z;
    unsigned sum, cnt, mine, sp = 0u;
    for (;;) {
        sum = 0u; cnt = 0u; mine = 0u;
#pragma unroll
        for (unsigned j = 0; j < 16; ++j) { const unsigned c = xb_ld(&bar[XB_XCNT(j)]); sum += c; cnt += (c > 0u) ? 1u : 0u; mine = (j == x) ? c : mine; }
        if (sum == G) break;
        __builtin_amdgcn_s_sleep(1);
        if ((++sp & 255u) == 0u) { if (xb_ld(&bar[XB_TMO])) break; if (sp > XB_SPIN_CAP) { atomicAdd(&bar[XB_TMO], 1u); break; } }
    }
    nloc = mine > 0u ? mine : 1u; nx = cnt > 0u ? cnt : 1u;
}
DI void xcd_barrier(const XcdBarrier& b) {
    asm volatile("s_waitcnt vmcnt(0)" ::: "memory");
    __syncthreads();
    if (threadIdx.x == 0) {
        unsigned* bar = b.bar;
        __builtin_amdgcn_s_waitcnt(0);
        unsigned nloc = b.st[0], nx = b.st[1];
        if (nloc == 0u) { xcd_barrier_complete(bar, b.x, nloc, nx); b.st[0] = nloc; b.st[1] = nx; }
        const unsigned old = xb_add(&bar[XB_XSUB(b.x)], 1u);
        const unsigned gen = old / nloc;
        if (old + 1u == (gen + 1u) * nloc) {
            __builtin_amdgcn_fence(__ATOMIC_RELEASE, "agent");
            asm volatile("s_waitcnt vmcnt(0)" ::: "memory");
            const unsigned og = xb_add(&bar[XB_TOP], 1u);
            const unsigned tg = og / nx;
            if (og + 1u == (tg + 1u) * nx) xb_add(&bar[XB_TOPGEN], 1u);
            else XB_SPIN(xb_ld(&bar[XB_TOPGEN]) == tg, bar);
            __builtin_amdgcn_fence(__ATOMIC_ACQUIRE, "agent");
            xb_add(&bar[XB_XGEN(b.x)], 1u);
            asm volatile("s_waitcnt vmcnt(0)" ::: "memory");
        } else {
            XB_SPIN(xb_ld(&bar[XB_XGEN(b.x)]) == gen, bar);
            __builtin_amdgcn_fence(__ATOMIC_ACQUIRE, "agent");
            asm volatile("s_waitcnt vmcnt(0)" ::: "memory");
        }
    }
    __syncthreads();
}

DI void run_phase(const Params& p, unsigned char* lds, int ph) {
    switch (ph) {
        case 0: phase0(p, lds); break;
        case 1: phase1(p, lds); break;
        case 2: phase15(p, lds); break;
        case 3: phase2(p, lds); break;
        case 4: phase25(p, lds); phase3(p, lds); break;
        case 5: phase4(p, lds); break;
        default: phase5(p, lds); break;
    }
}

__global__ void __launch_bounds__(512) hybrid_fwd(Params p) {
    extern __shared__ __attribute__((aligned(16))) unsigned char lds[];
#if MULTI_LAUNCH
    run_phase(p, lds, p.phase_lo);
#else
    cg::grid_group grid = cg::this_grid();
    if (p.phase_lo == 77) grid.sync();
    {
        volatile LAS unsigned* st = (volatile LAS unsigned*)(lds + LDS_ITEM + 16);
        if (threadIdx.x == 0) { st[0] = 0u; st[1] = 0u; }
        __syncthreads();
        (void)xcd_barrier_post((unsigned*)(p.ws + OFF_XBAR), st);
    }
#define GRID_BARRIER() { XcdBarrier xb_; xb_.bar = (unsigned*)(p.ws + OFF_XBAR); xb_.x = xb_xcc_id(); xb_.st = (volatile LAS unsigned*)(lds + LDS_ITEM + 16); xcd_barrier(xb_); }
    phase0(p, lds); GRID_BARRIER();
    phase1(p, lds); GRID_BARRIER();
    phase15(p, lds); GRID_BARRIER();
    phase2(p, lds); GRID_BARRIER();
    phase3(p, lds); GRID_BARRIER();
    phase4(p, lds);
#endif
}

extern "C" void kernel_launch(void* const* d_in, const int* in_sizes, int n_in, void* d_out, int out_size, void* d_ws, size_t ws_size, hipStream_t stream) {
    static int grid = 0;
    if (grid == 0) {
        int dev = 0, cus = 0, per_cu = 0;
        hipGetDevice(&dev);
        hipDeviceGetAttribute(&cus, hipDeviceAttributeMultiprocessorCount, dev);
        hipFuncSetAttribute((const void*)hybrid_fwd, hipFuncAttributeMaxDynamicSharedMemorySize, LDS_BYTES);
        hipOccupancyMaxActiveBlocksPerMultiprocessor(&per_cu, (const void*)hybrid_fwd, 512, LDS_BYTES);
        if (per_cu < 1) per_cu = 1;
        if (per_cu > 1) per_cu = 1;
        if (cus <= 0) cus = 256;
        grid = cus * per_cu;
    }
    hipMemsetAsync((unsigned char*)d_ws + OFF_XBAR, 0, 16384, stream);
    Params p{};
    p.x = (const float*)d_in[0]; p.meta = (const float*)d_in[1]; p.norm_w = (const float*)d_in[2]; p.w_in = (const float*)d_in[3];
    p.lq1 = (const float*)d_in[4]; p.lk1 = (const float*)d_in[5]; p.lq2 = (const float*)d_in[6]; p.lk2 = (const float*)d_in[7];
    p.subln_w = (const float*)d_in[8]; p.gate_w2 = (const float*)d_in[9]; p.gate_b = (const float*)d_in[10]; p.gla_norm_w = (const float*)d_in[11];
    p.wa = (const float*)d_in[12]; p.wb = (const float*)d_in[13]; p.wo = (const float*)d_in[14]; p.final_w = (const float*)d_in[15];
    p.out = (float*)d_out; p.ws = (unsigned char*)d_ws;
#if MULTI_LAUNCH
    for (int ph = 0; ph < 7; ++ph) {
        p.phase_lo = ph; p.phase_hi = ph + 1;
        hipLaunchKernelGGL(hybrid_fwd, dim3(grid), dim3(512), LDS_BYTES, stream, p);
    }
#else
    p.phase_lo = 0; p.phase_hi = 7;
    void* args[] = {&p};
    hipError_t e = hipLaunchCooperativeKernel((const void*)hybrid_fwd, dim3(grid), dim3(512), args, LDS_BYTES, stream);
    if (e != hipSuccess) fprintf(stderr, "cooperative launch failed: %s (grid %d)\n", hipGetErrorString(e), grid);
#endif
}
```

```cpp
#include <hip/hip_runtime.h>
#include <hip/hip_cooperative_groups.h>
#include <cstdio>
#include <cstdint>
namespace cg = cooperative_groups;

#ifndef MULTI_LAUNCH
#define MULTI_LAUNCH 0
#endif
#ifndef PROBE_REP
#define PROBE_REP 0
#endif

typedef unsigned short bf16_t;
typedef short bf16x8 __attribute__((ext_vector_type(8)));
typedef float f32x4 __attribute__((ext_vector_type(4)));
typedef float f32x2 __attribute__((ext_vector_type(2)));
typedef float f32x16 __attribute__((ext_vector_type(16)));
typedef unsigned u32x4 __attribute__((ext_vector_type(4)));
typedef unsigned u32x2 __attribute__((ext_vector_type(2)));
typedef __bf16 bfv2 __attribute__((ext_vector_type(2)));

#define DI __device__ __forceinline__
#define MFMA32(a, b, c) __builtin_amdgcn_mfma_f32_32x32x16_bf16((a), (b), (c), 0, 0, 0)
#define MFMA16(a, b, c) __builtin_amdgcn_mfma_f32_16x16x32_bf16((a), (b), (c), 0, 0, 0)

DI unsigned pk2(float a, float b) { f32x2 v = {a, b}; return __builtin_bit_cast(unsigned, __builtin_convertvector(v, bfv2)); }
DI float bf2f(bf16_t v) { return __uint_as_float(((unsigned)v) << 16); }
DI float bflo(unsigned u) { return __uint_as_float(u << 16); }
DI float bfhi(unsigned u) { return __uint_as_float(u & 0xffff0000u); }
DI bf16_t f2bf(float a) { return (bf16_t)(pk2(a, 0.f) & 0xffffu); }
DI float wave_sum(float v) {
#pragma unroll
    for (int o = 32; o; o >>= 1) v += __shfl_xor(v, o);
    return v;
}
DI int opaque_tid() { int t = threadIdx.x; asm volatile("" : "+v"(t)); return t; }
DI float xor32_sum(float x) { auto r = __builtin_amdgcn_permlane32_swap(__float_as_uint(x), __float_as_uint(x), false, false); return __uint_as_float(r[0]) + __uint_as_float(r[1]); }
DI float xor16_sum(float x) { auto r = __builtin_amdgcn_permlane16_swap(__float_as_uint(x), __float_as_uint(x), false, false); return __uint_as_float(r[0]) + __uint_as_float(r[1]); }
DI float xor32_max(float x) { auto r = __builtin_amdgcn_permlane32_swap(__float_as_uint(x), __float_as_uint(x), false, false); return fmaxf(__uint_as_float(r[0]), __uint_as_float(r[1])); }
DI float sigmoidf_(float z) { return __builtin_amdgcn_rcpf(1.f + __expf(-z)); }
DI float siluf_(float z) { return z * __builtin_amdgcn_rcpf(1.f + __expf(-z)); }

constexpr int D = 1024, NB = 4, SEQ = 4096, MROWS = NB * SEQ;
constexpr int NIN = 9232, NINP = 9344;
constexpr float EPS = 1e-5f;

constexpr size_t SZ_ACT = (size_t)MROWS * 1024 * 2;
constexpr size_t OFF_WIN_T = 0;
constexpr size_t OFF_WA_T = OFF_WIN_T + (size_t)NINP * 1024 * 2;
constexpr size_t OFF_WB_T = OFF_WA_T + 2097152;
constexpr size_t OFF_WO_T = OFF_WB_T + 2097152;
constexpr size_t OFF_AK = OFF_WO_T + 2097152;
constexpr size_t OFF_AVT = OFF_AK + SZ_ACT;
constexpr size_t OFF_AZ = OFF_AVT + SZ_ACT;
constexpr size_t OFF_GVT = OFF_AZ + SZ_ACT;
constexpr size_t OFF_GZ = OFF_GVT + SZ_ACT;
constexpr size_t OFF_GA = OFF_GZ + SZ_ACT;
constexpr size_t OFF_GB = OFF_GA + SZ_ACT;
constexpr size_t OFF_GLR = OFF_GB + SZ_ACT;
constexpr size_t OFF_RSTD = OFF_GLR + (size_t)MROWS * 16 * 2;
constexpr size_t OFF_ROPE = OFF_RSTD + 65792;
constexpr size_t OFF_AKM = OFF_ROPE + 263168;
constexpr size_t OFF_AVTM = OFF_AKM + 131072;
constexpr size_t OFF_GVTM = OFF_AVTM + 131072;
constexpr size_t OFF_GKM = OFF_GVTM + 131072;
constexpr size_t OFF_GLRM = OFF_GKM + 16384;
constexpr size_t OFF_KTM = OFF_GLRM + 512;
constexpr size_t OFF_KTTM = OFF_KTM + 65536;
constexpr size_t OFF_DEC = OFF_KTTM + 65536;
constexpr size_t OFF_DECM = OFF_DEC + 524288;
constexpr size_t OFF_SSQB = OFF_DECM + 2048;
constexpr size_t OFF_SSQH = OFF_SSQB + 4194304;
constexpr size_t OFF_CTR = OFF_SSQH + 1048576;
constexpr size_t OFF_XBM = OFF_CTR + 256;
constexpr size_t OFF_XBAR = OFF_XBM + 32768;
constexpr size_t WS_END = OFF_XBAR + 16384;
constexpr size_t OFF_XB = OFF_GA;
constexpr size_t OFF_SGA = OFF_GB;
constexpr size_t OFF_SGB = OFF_GB + (size_t)MROWS * 1024;
static_assert(WS_END <= 268435456ull, "workspace over 256 MiB");
constexpr size_t DO_AQ = 0, DO_GQ = SZ_ACT, DO_GK = SZ_ACT + SZ_ACT / 2;

constexpr int G_ROWB = 144;
constexpr int G_SW = 128 * G_ROWB, G_SX = 256 * G_ROWB, G_STAGE = G_SW + G_SX;
constexpr int G_SW4 = 256 * G_ROWB, G_STAGE4 = G_SW4 + G_SX;
constexpr int LDS_SCALE = 2 * G_STAGE4;
constexpr int LDS_ITEM = LDS_SCALE + 4096;
constexpr int LDS_BYTES = LDS_ITEM + 64;

struct Params {
    const float *x, *meta, *norm_w, *w_in, *lq1, *lk1, *lq2, *lk2, *subln_w, *gate_w2, *gate_b, *gla_norm_w, *wa, *wb, *wo, *final_w;
    float* out;
    unsigned char* ws;
    int phase_lo, phase_hi;
};

template <int MODE>
DI void p0_transpose_item(const Params& p, int item, float* tile) {
    const int tid = opaque_tid();
    const float* W = MODE == 0 ? p.w_in : MODE == 1 ? p.wa : MODE == 2 ? p.wb : p.wo;
    const int ldw = MODE == 0 ? NIN : 1024;
    const int nbc = MODE == 0 ? NINP / 128 : 8;
    bf16_t* WT = (bf16_t*)(p.ws + (MODE == 0 ? OFF_WIN_T : MODE == 1 ? OFF_WA_T : MODE == 2 ? OFF_WB_T : OFF_WO_T));
    const int kb = item / nbc, nb = item % nbc, k0 = kb * 64, n0 = nb * 128;
    const int nn = tid & 127, n = n0 + nn;
    int src = n;
    if (MODE == 0) { src = n < 7168 ? n : (n < 9216 ? n + 16 : (n < 9232 ? n - 2048 : -1)); }
    float v[16];
#pragma unroll
    for (int i = 0; i < 16; ++i) {
        const int k = k0 + (tid >> 7) + 4 * i;
        v[i] = src >= 0 ? W[(size_t)k * ldw + src] : 0.f;
    }
#pragma unroll
    for (int i = 0; i < 16; ++i) {
        const int kk = (tid >> 7) + 4 * i, k = k0 + kk;
        float sc = 1.f;
        if (MODE == 0) sc = p.norm_w[k];
        if (MODE == 1) sc = 0.8f * p.subln_w[k & 127];
        if (MODE == 2) sc = p.gla_norm_w[k & 255];
        tile[kk * 129 + nn] = v[i] * sc;
    }
    __syncthreads();
    {
        const int on = tid >> 2, c = tid & 3;
        const float* s = tile + (16 * c) * 129 + on;
        u32x4 o0, o1;
        o0.x = pk2(s[0 * 129], s[1 * 129]); o0.y = pk2(s[2 * 129], s[3 * 129]); o0.z = pk2(s[4 * 129], s[5 * 129]); o0.w = pk2(s[6 * 129], s[7 * 129]);
        o1.x = pk2(s[8 * 129], s[9 * 129]); o1.y = pk2(s[10 * 129], s[11 * 129]); o1.z = pk2(s[12 * 129], s[13 * 129]); o1.w = pk2(s[14 * 129], s[15 * 129]);
        u32x4* dst = (u32x4*)(WT + (size_t)(n0 + on) * 1024 + k0 + 16 * c);
        dst[0] = o0; dst[1] = o1;
    }
    __syncthreads();
}

DI void phase0(const Params& p, unsigned char* lds) {
    const int tid = opaque_tid(), lane = tid & 63, wave = tid >> 6;
    float* tile = (float*)lds;
    constexpr int I_WIN = 16 * (NINP / 128), I_SQ = 128;
    constexpr int I_T = I_WIN + 3 * I_SQ;
    constexpr int I_RSTD = (MROWS + 16 + 15) / 16;
    constexpr int I_ROPE = (4112 * 8 + 511) / 512;
    constexpr int I_ZERO = 393216 / 8192;
    constexpr int I_ALL = I_T + I_RSTD + I_ROPE + I_ZERO;
    for (int it = blockIdx.x; it < I_ALL; it += gridDim.x) {
        int r = it;
        if (r < I_WIN) { p0_transpose_item<0>(p, r, tile); continue; } r -= I_WIN;
        if (r < I_SQ) { p0_transpose_item<1>(p, r, tile); continue; } r -= I_SQ;
        if (r < I_SQ) { p0_transpose_item<2>(p, r, tile); continue; } r -= I_SQ;
        if (r < I_SQ) { p0_transpose_item<3>(p, r, tile); continue; } r -= I_SQ;
        if (r < I_RSTD) {
            const int row0 = r * 16 + wave * 2;
            f32x4 v[2][4];
#pragma unroll
            for (int q = 0; q < 2; ++q) {
                const int row = row0 + q < MROWS + 16 ? row0 + q : MROWS + 15;
                const float* srcp = row < MROWS ? p.x + (size_t)row * 1024 : p.meta + (size_t)(row - MROWS) * 1024;
                const f32x4* xr = (const f32x4*)srcp + lane;
#pragma unroll
                for (int j = 0; j < 4; ++j) v[q][j] = xr[64 * j];
            }
#pragma unroll
            for (int q = 0; q < 2; ++q) {
                const int row = row0 + q;
                float s = 0.f;
#pragma unroll
                for (int j = 0; j < 4; ++j) s += (v[q][j].x * v[q][j].x + v[q][j].y * v[q][j].y) + (v[q][j].z * v[q][j].z + v[q][j].w * v[q][j].w);
                s = wave_sum(s);
                if (row < MROWS + 16) {
                    if (lane == 0) ((float*)(p.ws + OFF_RSTD))[row] = 1.0f / sqrtf(s * (1.0f / 1024.0f) + EPS);
                    bf16_t* xbrow = row < MROWS ? (bf16_t*)(p.ws + OFF_XB) + (size_t)row * 1024 : (bf16_t*)(p.ws + OFF_XBM) + (size_t)(row - MROWS) * 1024;
#pragma unroll
                    for (int j = 0; j < 4; ++j) { u32x2 o; o.x = pk2(v[q][j].x, v[q][j].y); o.y = pk2(v[q][j].z, v[q][j].w); *(u32x2*)(xbrow + 256 * j + 4 * lane) = o; }
                }
            }
            continue;
        }
        r -= I_RSTD;
        if (r < I_ROPE) {
            const int e = r * 512 + tid;
            if (e < 4112 * 8) {
                const int pos = e >> 3, i = e & 7;
                const float inv = powf(500000.0f, -(float)i / 8.0f);
                const float ang = (float)pos * inv;
                float* t = (float*)(p.ws + OFF_ROPE) + (size_t)e * 2;
                t[0] = cosf(ang); t[1] = sinf(ang);
            }
            continue;
        }
        r -= I_ROPE;
        { u32x4 z = {0u, 0u, 0u, 0u}; *(u32x4*)(p.ws + OFF_AKM + (size_t)r * 8192 + tid * 16) = z; }
    }
}

namespace pg8 {
#define PG8_LAS __attribute__((address_space(3)))
typedef unsigned short bf16_t;
typedef short bf16x8 __attribute__((ext_vector_type(8)));
typedef float f32x4 __attribute__((ext_vector_type(4)));
typedef unsigned u32x4 __attribute__((ext_vector_type(4)));
constexpr int BM = 256, BK = 64, HALF = 128, HTB = HALF * BK * 2  , STAGE_BYTES = 8 * HTB, NXCD = 8, WGM = 8;

__host__ __device__ __forceinline__ int lds_byte(int r, int c) { const int st = (r >> 4) * 2 + (c >> 5), rr = r & 15, cc = c & 31, ob = rr * 64 + cc * 2; return st * 1024 + (ob ^ (((ob >> 9) & 1) << 5)); }
__host__ __device__ __forceinline__ void stage_rc(int b, int& R, int& C) { const int st = b / 1024, sb = b % 1024, swz = sb ^ (((sb >> 9) & 1) << 5); R = (st >> 1) * 16 + swz / 64; C = (st & 1) * 32 + (swz % 64) / 2; }
__host__ __device__ __forceinline__ int perm32(int rho) { const int n = rho >> 4, i = rho & 15; return 8 * (i >> 2) + 4 * n + (i & 3); }

struct Unit { int pm, pn; };
struct Gemm { const bf16_t* A; const bf16_t* Bt; int M, N, K; };

template <class Epi, class Sched, bool ALIGN_EPI = false, bool SP2 = false, bool HS = false>
__device__ __forceinline__ void gemm_phase(PG8_LAS unsigned char* lds, const Gemm g, const Sched& S, const Epi& E) {
    const int tid = opaque_tid(), wid = __builtin_amdgcn_readfirstlane(tid >> 6), lane = tid & 63, wr = wid >> 2, wc = wid & 3, fr = lane & 15, fq = lane >> 4;
    const int K = g.K, nt = K / BK;
    unsigned voffA[2], voffB[2];
#pragma unroll
    for (int i = 0; i < 2; ++i) { int R, C; stage_rc(tid * 16 + i * 8192, R, C); const int Rb = Epi::PERM ? ((R & ~31) + perm32(R & 31)) : R;
        voffA[i] = (unsigned)(R * K + C) * 2u; voffB[i] = (unsigned)(Rb * K + C) * 2u; }
    const size_t kstep = (size_t)(BK * 2);
    const size_t hstep = (size_t)HALF * K * 2;
    const size_t tstep = 2 * hstep;
    const unsigned ldsw = (unsigned)wid * 1024u;
    const int aoff = lds_byte(wr * 64 + fr, fq * 8), boff = lds_byte(wc * 32 + fr, fq * 8);
#define PG8_SA(b, h) (((b) * 2 + (h)) * HTB)
#define PG8_SB(b, h) ((4 + (b) * 2 + (h)) * HTB)
#define PG8_STAGE(bufoff, gbase, voff) do { _Pragma("unroll") for (int _i = 0; _i < 2; ++_i) \
        __builtin_amdgcn_global_load_lds((const unsigned*)((const char*)(gbase) + (voff)[_i]), (PG8_LAS unsigned*)(lds + (bufoff) + ldsw + _i * 8192), 16, 0, 0); } while (0)
#define PG8_LDA(dst, b, h) do { _Pragma("unroll") for (int m = 0; m < 4; ++m) _Pragma("unroll") for (int k = 0; k < 2; ++k) dst[m][k] = *(const PG8_LAS bf16x8*)(lds + PG8_SA(b, h) + aoff + m * 2048 + k * 1024); } while (0)
#define PG8_LDB(dst, b, h) do { _Pragma("unroll") for (int n = 0; n < 2; ++n) _Pragma("unroll") for (int k = 0; k < 2; ++k) dst[n][k] = *(const PG8_LAS bf16x8*)(lds + PG8_SB(b, h) + boff + n * 2048 + k * 1024); } while (0)
#define PG8_MMA(ai, bj, At, Bt) do { __builtin_amdgcn_s_setprio(1); _Pragma("unroll") for (int m = 0; m < 4; ++m) _Pragma("unroll") for (int n = 0; n < 2; ++n) _Pragma("unroll") for (int k = 0; k < 2; ++k) \
        acc[ai][bj][m][n] = __builtin_amdgcn_mfma_f32_16x16x32_bf16(Bt[n][k], At[m][k], acc[ai][bj][m][n], 0, 0, 0); __builtin_amdgcn_s_setprio(0); } while (0)
#define PG8_WAIT_V(n) asm volatile("s_waitcnt vmcnt(" #n ")" ::: "memory")
#define PG8_WAIT_L(n) asm volatile("s_waitcnt lgkmcnt(" #n ")" ::: "memory")
#define PG8_BAR __builtin_amdgcn_s_barrier()
#define PG8_SCHED __builtin_amdgcn_sched_barrier(0)
    Unit cur, nxt; int ui = 0;
    if (!S.next(0, cur)) return;
    f32x4 acc[2][2][4][2];
#pragma unroll
    for (int a = 0; a < 2; ++a)
#pragma unroll
        for (int b = 0; b < 2; ++b)
#pragma unroll
            for (int m = 0; m < 4; ++m)
#pragma unroll
                for (int n = 0; n < 2; ++n) acc[a][b][m][n] = (f32x4){0.f, 0.f, 0.f, 0.f};
    bf16x8 At[4][2], B0[2][2], B1[2][2];
    const char* cA = (const char*)g.A + (size_t)cur.pm * tstep; const char* cB = (const char*)g.Bt + (size_t)cur.pn * tstep;
    S.a_ready(cur);
    if constexpr (SP2) {
        PG8_STAGE(PG8_SB(0, 0), cB, voffB); PG8_STAGE(PG8_SB(0, 1), cB + hstep, voffB); PG8_STAGE(PG8_SA(0, 0), cA, voffA); PG8_STAGE(PG8_SA(0, 1), cA + hstep, voffA);
        if (wr == 1) PG8_BAR;
        PG8_WAIT_V(2); PG8_BAR;
        PG8_STAGE(PG8_SB(1, 0), cB + kstep, voffB); PG8_STAGE(PG8_SA(1, 0), cA + kstep, voffA); PG8_STAGE(PG8_SB(1, 1), cB + hstep + kstep, voffB);
        PG8_WAIT_V(6); PG8_BAR;
    } else {
        PG8_STAGE(PG8_SB(0, 0), cB, voffB); PG8_STAGE(PG8_SA(0, 0), cA, voffA); PG8_STAGE(PG8_SB(0, 1), cB + hstep, voffB); PG8_STAGE(PG8_SA(0, 1), cA + hstep, voffA);
        if (wr == 1) PG8_BAR;
        PG8_WAIT_V(4); PG8_BAR;
        PG8_STAGE(PG8_SB(1, 0), cB + kstep, voffB); PG8_STAGE(PG8_SA(1, 0), cA + kstep, voffA); PG8_STAGE(PG8_SB(1, 1), cB + hstep + kstep, voffB);
        PG8_WAIT_V(6); PG8_BAR;
    }
    for (;;) {
        const bool has_next = S.next(ui + 1, nxt);
        const char* nA = has_next ? (const char*)g.A + (size_t)nxt.pm * tstep : cA; const char* nB = has_next ? (const char*)g.Bt + (size_t)nxt.pn * tstep : cB;
        for (int t = 0; t < nt; t += 2) {
            if constexpr (HS) {
                if (t == 4 || t == 8 || t == 12) {
                    const PG8_LAS float* tab = (const PG8_LAS float*)(lds + 147456);
                    const int hj = (t >> 2) - 1;
#pragma unroll
                    for (int a = 0; a < 2; ++a)
#pragma unroll
                        for (int m = 0; m < 4; ++m) {
                            const float s = tab[(a * 128 + wr * 64 + m * 16 + fr) * 4 + hj];
#pragma unroll
                            for (int b = 0; b < 2; ++b)
#pragma unroll
                                for (int n = 0; n < 2; ++n) acc[a][b][m][n] = acc[a][b][m][n] * s;
                        }
                }
            }
            const bool last = (t == nt - 2);
            const char* a1 = cA + (size_t)(t + 1) * kstep;
            const char* a2 = last ? nA : cA + (size_t)(t + 2) * kstep; const char* b2 = last ? nB : cB + (size_t)(t + 2) * kstep;
            const char* a3 = a2 + kstep; const char* b3 = b2 + kstep;
            if (last && has_next) S.a_ready(nxt);
            if constexpr (SP2) {
            PG8_LDB(B0, 0, 0); PG8_LDB(B1, 0, 1); PG8_SCHED; PG8_LDA(At, 0, 0); PG8_STAGE(PG8_SA(1, 1), a1 + hstep, voffA);
            PG8_WAIT_V(8); PG8_WAIT_L(0); PG8_BAR; PG8_MMA(0, 0, At, B0); PG8_MMA(0, 1, At, B1); PG8_BAR; PG8_SCHED;
            PG8_LDA(At, 0, 1); PG8_STAGE(PG8_SB(0, 0), b2, voffB); PG8_STAGE(PG8_SB(0, 1), b2 + hstep, voffB); PG8_STAGE(PG8_SA(0, 0), a2, voffA);
            PG8_WAIT_V(8); PG8_WAIT_L(0); PG8_BAR; PG8_MMA(1, 0, At, B0); PG8_MMA(1, 1, At, B1); PG8_BAR; PG8_SCHED;
            PG8_LDB(B0, 1, 0); PG8_LDB(B1, 1, 1); PG8_SCHED; PG8_LDA(At, 1, 0); PG8_STAGE(PG8_SA(0, 1), a2 + hstep, voffA);
            PG8_WAIT_V(8); PG8_WAIT_L(0); PG8_BAR; PG8_MMA(0, 0, At, B0); PG8_MMA(0, 1, At, B1); PG8_BAR; PG8_SCHED;
            PG8_LDA(At, 1, 1); PG8_STAGE(PG8_SB(1, 0), b3, voffB); PG8_STAGE(PG8_SB(1, 1), b3 + hstep, voffB); PG8_STAGE(PG8_SA(1, 0), a3, voffA);
            PG8_WAIT_V(8); PG8_WAIT_L(0); PG8_BAR; PG8_MMA(1, 0, At, B0); PG8_MMA(1, 1, At, B1); PG8_BAR; PG8_SCHED;
            } else {
            PG8_LDB(B0, 0, 0); PG8_SCHED; PG8_LDA(At, 0, 0); PG8_STAGE(PG8_SA(1, 1), a1 + hstep, voffA);
            PG8_WAIT_L(8); PG8_BAR; PG8_WAIT_L(0); PG8_MMA(0, 0, At, B0); PG8_BAR; PG8_SCHED;
            PG8_LDB(B1, 0, 1); PG8_STAGE(PG8_SB(0, 0), b2, voffB);
            PG8_BAR; PG8_WAIT_L(0); PG8_MMA(0, 1, At, B1); PG8_BAR;
            PG8_LDA(At, 0, 1); PG8_STAGE(PG8_SA(0, 0), a2, voffA);
            PG8_BAR; PG8_WAIT_L(0); PG8_MMA(1, 0, At, B0); PG8_BAR; PG8_SCHED;
            PG8_STAGE(PG8_SB(0, 1), b2 + hstep, voffB);
            PG8_WAIT_V(6); PG8_BAR; PG8_MMA(1, 1, At, B1); PG8_BAR;
            PG8_LDB(B0, 1, 0); PG8_SCHED; PG8_LDA(At, 1, 0); PG8_STAGE(PG8_SA(0, 1), a2 + hstep, voffA);
            PG8_WAIT_L(8); PG8_BAR; PG8_WAIT_L(0); PG8_MMA(0, 0, At, B0); PG8_BAR; PG8_SCHED;
            PG8_LDB(B1, 1, 1); PG8_STAGE(PG8_SB(1, 0), b3, voffB);
            PG8_BAR; PG8_WAIT_L(0); PG8_MMA(0, 1, At, B1); PG8_BAR;
            PG8_LDA(At, 1, 1); PG8_STAGE(PG8_SA(1, 0), a3, voffA);
            PG8_BAR; PG8_WAIT_L(0); PG8_MMA(1, 0, At, B0); PG8_BAR; PG8_SCHED;
            PG8_STAGE(PG8_SB(1, 1), b3 + hstep, voffB);
            PG8_WAIT_V(6); PG8_BAR; PG8_MMA(1, 1, At, B1); PG8_BAR;
            }
        }
        if constexpr (ALIGN_EPI) { if (wr == 0) PG8_BAR; }
        if constexpr (!Epi::AFTER_DRAIN) { E(acc, cur, wr, wc, fr, fq); S.done(cur); }
        if (!has_next) break;
#pragma unroll
        for (int a = 0; a < 2; ++a)
#pragma unroll
            for (int b = 0; b < 2; ++b)
#pragma unroll
                for (int m = 0; m < 4; ++m)
#pragma unroll
                    for (int n = 0; n < 2; ++n) acc[a][b][m][n] = (f32x4){0.f, 0.f, 0.f, 0.f};
        cur = nxt; cA = nA; cB = nB; ++ui;
        if constexpr (ALIGN_EPI) { if (wr == 1) PG8_BAR; }
    }
    PG8_WAIT_V(0);
    if constexpr (!ALIGN_EPI) { if (wr == 0) PG8_BAR; }
    PG8_BAR;
    if constexpr (Epi::AFTER_DRAIN) { E.fused(acc, cur, wr, wc, fr, fq, lds, wid, lane); S.done(cur); }
#undef PG8_SA
#undef PG8_SB
#undef PG8_STAGE
#undef PG8_LDA
#undef PG8_LDB
#undef PG8_MMA
#undef PG8_WAIT_V
#undef PG8_WAIT_L
#undef PG8_BAR
#undef PG8_SCHED
}
}

DI unsigned sig_u8(float z) { return (unsigned)(255.0f * __builtin_amdgcn_rcpf(1.0f + __expf(-z)) + 0.5f); }
struct SchedP1 {
    DI bool next(int i, pg8::Unit& u) const {
        constexpr int NT = 36;
        const int id = (int)blockIdx.x + i * (int)gridDim.x;
        if (id >= 64 * NT) return false;
        const int g = id / (16 * NT), rem = id % (16 * NT), reg = rem >> 8, w = rem & 255, x = w & 7, j = w >> 3;
        int mt = g * 16 + 4 * (x & 3) + (j & 3), nt = reg * 16 + 8 * (x >> 2) + (j >> 2);
        if (reg == 2) { const int e = rem - 512; nt = 32 + (e >> 4); mt = g * 16 + (e & 15); }
        u.pm = mt; u.pn = nt; return true;
    }
    DI void a_ready(const pg8::Unit&) const {}
    DI void done(const pg8::Unit&) const {}
};
struct SchedSq {
    DI bool next(int i, pg8::Unit& u) const {
        const int id = (int)blockIdx.x + i * (int)gridDim.x;
        if (id >= 256) return false;
        u.pm = 8 * (id & 7) + ((id >> 3) & 7); u.pn = id >> 6; return true;
    }
    DI void a_ready(const pg8::Unit&) const {}
    DI void done(const pg8::Unit&) const {}
};
DI unsigned sig_u8x4(float a, float b, float c, float d) {
    unsigned r = 0u;
    r = __builtin_amdgcn_cvt_pk_u8_f32(255.0f * __builtin_amdgcn_rcpf(1.0f + __expf(-a)), 0, r);
    r = __builtin_amdgcn_cvt_pk_u8_f32(255.0f * __builtin_amdgcn_rcpf(1.0f + __expf(-b)), 1, r);
    r = __builtin_amdgcn_cvt_pk_u8_f32(255.0f * __builtin_amdgcn_rcpf(1.0f + __expf(-c)), 2, r);
    r = __builtin_amdgcn_cvt_pk_u8_f32(255.0f * __builtin_amdgcn_rcpf(1.0f + __expf(-d)), 3, r);
    return r;
}
struct EpiInProj {
    static constexpr bool PERM = true, AFTER_DRAIN = false;
    unsigned char* ws; unsigned char* dout;
    DI void operator()(const pg8::f32x4 (&acc)[2][2][4][2], const pg8::Unit& u, int wr, int wc, int fr, int fq) const {
        const int nt = u.pn;
        int split, nc0;
        if (nt < 4) { split = 0; nc0 = nt * 256; }
        else if (nt < 8) { split = 1; nc0 = (nt - 4) * 256; }
        else if (nt < 12) { split = 2; nc0 = (nt - 8) * 256; }
        else if (nt < 16) { split = 3; nc0 = (nt - 12) * 256; }
        else if (nt < 18) { split = 4; nc0 = (nt - 16) * 256; }
        else if (nt < 20) { split = 5; nc0 = (nt - 18) * 256; }
        else if (nt < 24) { split = 6; nc0 = (nt - 20) * 256; }
        else if (nt < 28) { split = 7; nc0 = (nt - 24) * 256; }
        else if (nt < 32) { split = 9; nc0 = (nt - 28) * 256; }
        else { split = 10; nc0 = (nt - 32) * 256; }
        const float* rstd = (const float*)(ws + OFF_RSTD);
        const float* rope = (const float*)(ws + OFF_ROPE);
        const bool do_rope = split <= 1 && (wc & 1) == 0;
#pragma unroll
        for (int ai = 0; ai < 2; ++ai)
#pragma unroll
            for (int m = 0; m < 4; ++m) {
                const int tok = u.pm * 256 + ai * 128 + wr * 64 + m * 16 + fr;
                const float rs = rstd[tok];
                const float rsq = split == 0 ? rs * (0.125f * 1.4426950408889634f) : rs;
                const int pos = 16 + (tok & 4095), b = tok >> 12, s = tok & 4095;
#pragma unroll
                for (int bj = 0; bj < 2; ++bj) {
                    const int nb = nc0 + bj * 128 + wc * 32 + 8 * fq;
                    float v[8];
#pragma unroll
                    for (int j = 0; j < 4; ++j) { v[j] = acc[ai][bj][m][0][j] * rsq; v[4 + j] = acc[ai][bj][m][1][j] * rsq; }
                    if (do_rope) {
                        const f32x4* cs = (const f32x4*)(rope + (size_t)pos * 16);
                        const f32x4 c01 = cs[0], c23 = cs[1], c45 = cs[2], c67 = cs[3];
                        const float cc[8] = {c01.x, c01.z, c23.x, c23.z, c45.x, c45.z, c67.x, c67.z};
                        const float sn[8] = {c01.y, c01.w, c23.y, c23.w, c45.y, c45.w, c67.y, c67.w};
#pragma unroll
                        for (int j = 0; j < 8; ++j) {
                            const float other = __shfl_xor(v[j], 16);
                            const float r0 = v[j] * cc[j] - other * sn[j], r1 = v[j] * cc[j] + other * sn[j];
                            v[j] = fq == 0 ? r0 : (fq == 1 ? r1 : v[j]);
                        }
                    }
                    if (split == 2 || split == 6) {
                        const int hshift = split == 2 ? 7 : 8, nheads = split == 2 ? 8 : 4, dvn = 1 << hshift;
                        bf16_t* base = (bf16_t*)(ws + (split == 2 ? OFF_AVT : OFF_GVT));
                        const int hd = nb >> hshift, dv0 = nb & (dvn - 1);
                        bf16_t* dst = base + ((size_t)(b * nheads + hd) * dvn + dv0) * 4096 + s;
#pragma unroll
                        for (int j = 0; j < 8; ++j) dst[(size_t)j * 4096] = f2bf(v[j]);
                    } else if (split >= 9) {
                        u32x2 o; o.x = sig_u8x4(v[0], v[1], v[2], v[3]); o.y = sig_u8x4(v[4], v[5], v[6], v[7]);
                        *(u32x2*)(ws + (split == 9 ? OFF_SGA : OFF_SGB) + (size_t)tok * 1024 + nb) = o;
                    } else {
                        bf16_t* dst; int ld;
                        switch (split) {
                            case 0: dst = (bf16_t*)(dout + DO_AQ); ld = 1024; break;
                            case 1: dst = (bf16_t*)(ws + OFF_AK); ld = 1024; break;
                            case 3: dst = (bf16_t*)(ws + OFF_AZ); ld = 1024; break;
                            case 4: dst = (bf16_t*)(dout + DO_GQ); ld = 512; break;
                            case 5: dst = (bf16_t*)(dout + DO_GK); ld = 512; break;
                            default: dst = (bf16_t*)(ws + OFF_GZ); ld = 1024; break;
                        }
                        u32x4 o; o.x = pk2(v[0], v[1]); o.y = pk2(v[2], v[3]); o.z = pk2(v[4], v[5]); o.w = pk2(v[6], v[7]);
                        *(u32x4*)(dst + (size_t)tok * ld + nb) = o;
                    }
                }
            }
    }
};

DI void p1_glr_job(const Params& p, unsigned char* lds, int job) {
    const int tid = opaque_tid(), lane = tid & 63, wave = tid >> 6, l15 = lane & 15, g = lane >> 4;
    const int rtile = wave & 3, khalf = wave >> 2;
    const bf16_t* xb = (const bf16_t*)(p.ws + OFF_XB);
    const bf16_t* wt = (const bf16_t*)(p.ws + OFF_WIN_T) + (size_t)9216 * 1024;
    const size_t row0 = (size_t)job * 64 + rtile * 16;
    const bf16_t* ap = xb + (row0 + l15) * 1024 + khalf * 512 + 8 * g;
    const bf16_t* bp = wt + (size_t)l15 * 1024 + khalf * 512 + 8 * g;
    f32x4 acc = (f32x4){0.f, 0.f, 0.f, 0.f};
    {
        bf16x8 av[16], bv[16];
#pragma unroll
        for (int ks = 0; ks < 16; ++ks) { av[ks] = *(const bf16x8*)(ap + ks * 32); bv[ks] = *(const bf16x8*)(bp + ks * 32); }
        f32x4 acc2 = (f32x4){0.f, 0.f, 0.f, 0.f};
#pragma unroll
        for (int ks = 0; ks < 16; ks += 2) { acc = MFMA16(av[ks], bv[ks], acc); acc2 = MFMA16(av[ks + 1], bv[ks + 1], acc2); }
        acc = acc + acc2;
    }
    f32x4* red = (f32x4*)lds;
    __syncthreads();
    if (khalf == 1) red[rtile * 64 + lane] = acc;
    __syncthreads();
    if (khalf == 0) {
        const f32x4 o = red[rtile * 64 + lane];
        const float* rstd = (const float*)(p.ws + OFF_RSTD);
        bf16_t* glr = (bf16_t*)(p.ws + OFF_GLR);
#pragma unroll
        for (int i = 0; i < 4; ++i) {
            const size_t row = row0 + 4 * g + i;
            glr[row * 16 + l15] = f2bf((acc[i] + o[i]) * rstd[row]);
        }
    }
    __syncthreads();
}

DI void p1_meta_job(const Params& p, unsigned char* lds, int job) {
    const int tid = opaque_tid(), lane = tid & 63, wave = tid >> 6, l15 = lane & 15, g = lane >> 4;
    int c0;
    if (job < 64) c0 = 1024 + job * 16;
    else if (job < 128) c0 = 2048 + (job - 64) * 16;
    else if (job < 160) c0 = 4608 + (job - 128) * 16;
    else if (job < 224) c0 = 5120 + (job - 160) * 16;
    else c0 = 9216;
    const bf16_t* xbm = (const bf16_t*)(p.ws + OFF_XBM);
    const bf16_t* wt = (const bf16_t*)(p.ws + OFF_WIN_T);
    const bf16_t* ap = xbm + (size_t)l15 * 1024 + wave * 128 + 8 * g;
    const bf16_t* bp = wt + (size_t)(c0 + l15) * 1024 + wave * 128 + 8 * g;
    f32x4 acc = (f32x4){0.f, 0.f, 0.f, 0.f};
#pragma unroll
    for (int ks = 0; ks < 4; ++ks) {
        const bf16x8 a = *(const bf16x8*)(ap + ks * 32), bb = *(const bf16x8*)(bp + ks * 32);
        acc = MFMA16(a, bb, acc);
    }
    f32x4* red = (f32x4*)lds;
    __syncthreads();
    red[wave * 64 + lane] = acc;
    __syncthreads();
    if (wave == 0) {
        f32x4 s = red[lane];
#pragma unroll
        for (int w = 1; w < 8; ++w) { const f32x4 t = red[w * 64 + lane]; s.x += t.x; s.y += t.y; s.z += t.z; s.w += t.w; }
        const float* rstd = (const float*)(p.ws + OFF_RSTD) + MROWS;
        const float* rope = (const float*)(p.ws + OFF_ROPE);
        unsigned char* ws = p.ws;
        const int col = c0 + l15;
#pragma unroll
        for (int i = 0; i < 4; ++i) {
            const int row = 4 * g + i;
            float v = s[i] * rstd[row];
            if (job < 64 && (c0 & 63) == 0) {
                const float other = __shfl_xor(v, 8);
                const float* cs = rope + ((size_t)row * 8 + (l15 & 7)) * 2;
                const float c = cs[0], sn = cs[1];
                v = (l15 < 8) ? (v * c - other * sn) : (v * c + other * sn);
            }
            const bf16_t val = f2bf(v);
            if (job < 64) ((bf16_t*)(ws + OFF_AKM))[(size_t)(48 + row) * 1024 + (col - 1024)] = val;
            else if (job < 128) { const int n = col - 2048; ((bf16_t*)(ws + OFF_AVTM))[(size_t)n * 64 + 48 + row] = val; }
            else if (job < 160) ((bf16_t*)(ws + OFF_GKM))[(size_t)row * 512 + (col - 4608)] = val;
            else if (job < 224) { const int n = col - 5120; ((bf16_t*)(ws + OFF_GVTM))[(size_t)n * 64 + 48 + row] = val; }
            else ((bf16_t*)(ws + OFF_GLRM))[row * 16 + l15] = val;
        }
    }
    __syncthreads();
}

DI void phase1(const Params& p, unsigned char* lds) {
    for (int j = blockIdx.x; j < 256; j += gridDim.x) p1_glr_job(p, lds, j);
    for (int j = blockIdx.x; j < 225; j += gridDim.x) p1_meta_job(p, lds, j);
    pg8::Gemm g; g.A = (const bf16_t*)(p.ws + OFF_XB); g.Bt = (const bf16_t*)(p.ws + OFF_WIN_T); g.M = MROWS; g.N = 9216; g.K = 1024;
    SchedP1 S; EpiInProj E; E.ws = p.ws; E.dout = (unsigned char*)p.out;
    pg8::gemm_phase<EpiInProj, SchedP1, true, true>((PG8_LAS unsigned char*)lds, g, S, E);
}

DI void phase15(const Params& p, unsigned char* lds) {
    const int tid = opaque_tid(), col = tid;
    float w2[16];
#pragma unroll
    for (int j = 0; j < 16; ++j) w2[j] = p.gate_w2[j * 512 + col];
    const float bias = p.gate_b[col];
    unsigned char* ws = p.ws;
    unsigned char* dout = (unsigned char*)p.out;
    for (int item = blockIdx.x; item < 257; item += gridDim.x) {
        const bool meta = item == 256;
        const int b = item >> 6, c = item & 63;
        const size_t row0 = (size_t)b * 4096 + c * 64;
        const bf16_t* glr = meta ? (const bf16_t*)(ws + OFF_GLRM) : (const bf16_t*)(ws + OFF_GLR) + row0 * 16;
        const int nrows = meta ? 16 : 64;
        bf16_t* qp = (bf16_t*)(dout + DO_GQ) + row0 * 512 + col;
        const bf16_t* kin = meta ? (const bf16_t*)(ws + OFF_GKM) + col : (const bf16_t*)(dout + DO_GK) + row0 * 512 + col;
        bf16_t* kout = meta ? (bf16_t*)(ws + OFF_KTM) + 48 * 512 + col : (bf16_t*)(dout + DO_GK) + row0 * 512 + col;
        bf16_t* ktt = meta ? (bf16_t*)(ws + OFF_KTTM) + (size_t)col * 64 + 48 : (bf16_t*)(ws + OFF_WIN_T) + ((size_t)b * 512 + col) * 4096 + c * 64;
        __syncthreads();
        if (tid < nrows * 2) ((u32x4*)lds)[tid] = ((const u32x4*)glr)[tid];
        __syncthreads();
        float bsum = 0.f;
        constexpr int GR = 16;
        bf16_t kc[GR], qc[GR], kn[GR], qn[GR];
#pragma unroll
        for (int rr = 0; rr < GR; ++rr) { kc[rr] = kin[(size_t)rr * 512]; qc[rr] = meta ? (bf16_t)0 : qp[(size_t)rr * 512]; }
        for (int r0 = 0; r0 < nrows; r0 += GR) {
            if (r0 + GR < nrows) {
#pragma unroll
                for (int rr = 0; rr < GR; ++rr) { kn[rr] = kin[(size_t)(r0 + GR + rr) * 512]; qn[rr] = meta ? (bf16_t)0 : qp[(size_t)(r0 + GR + rr) * 512]; }
            }
            float kt8[GR];
#pragma unroll
            for (int rr = 0; rr < GR; ++rr) {
                const int r = r0 + rr;
                const u32x4* g4 = (const u32x4*)(lds + r * 32);
                const u32x4 ga = g4[0], gb = g4[1];
                float gk = bias;
                gk += bflo(ga.x) * w2[0] + bfhi(ga.x) * w2[1] + bflo(ga.y) * w2[2] + bfhi(ga.y) * w2[3];
                gk += bflo(ga.z) * w2[4] + bfhi(ga.z) * w2[5] + bflo(ga.w) * w2[6] + bfhi(ga.w) * w2[7];
                gk += bflo(gb.x) * w2[8] + bfhi(gb.x) * w2[9] + bflo(gb.y) * w2[10] + bfhi(gb.y) * w2[11];
                gk += bflo(gb.z) * w2[12] + bfhi(gb.z) * w2[13] + bflo(gb.w) * w2[14] + bfhi(gb.w) * w2[15];
                const float lg = (fminf(gk, 0.f) - __logf(1.0f + __expf(-fabsf(gk)))) * (1.0f / 16.0f);
                bsum += lg;
                const float eb = __expf(bsum);
                const float kt = bf2f(kc[rr]) * __builtin_amdgcn_rcpf(eb);
                kt8[rr] = kt;
                kout[(size_t)r * 512] = f2bf(kt);
                if (!meta) qp[(size_t)r * 512] = f2bf(bf2f(qc[rr]) * 0.08838834764831845f * eb);
            }
#pragma unroll
            for (int hh8 = 0; hh8 < GR / 8; ++hh8) {
                u32x4 o; o.x = pk2(kt8[8 * hh8 + 0], kt8[8 * hh8 + 1]); o.y = pk2(kt8[8 * hh8 + 2], kt8[8 * hh8 + 3]);
                o.z = pk2(kt8[8 * hh8 + 4], kt8[8 * hh8 + 5]); o.w = pk2(kt8[8 * hh8 + 6], kt8[8 * hh8 + 7]);
                *(u32x4*)(ktt + r0 + 8 * hh8) = o;
            }
#pragma unroll
            for (int rr = 0; rr < GR; ++rr) { kc[rr] = kn[rr]; qc[rr] = qn[rr]; }
        }
        if (meta) {
            ((float*)(ws + OFF_DECM))[col] = expf(bsum);
            bf16_t* km = (bf16_t*)(ws + OFF_KTM);
            for (int r = 0; r < 48; ++r) km[r * 512 + col] = 0;
            u32x4 z = {0u, 0u, 0u, 0u};
            u32x4* kz = (u32x4*)((bf16_t*)(ws + OFF_KTTM) + (size_t)col * 64);
#pragma unroll
            for (int j = 0; j < 6; ++j) kz[j] = z;
        } else {
            ((float*)(ws + OFF_DEC))[((size_t)b * 64 + c) * 512 + col] = expf(bsum);
        }
    }
}

constexpr int A_KROWB = 272, A_VROWB = 144, A_KB = 64 * A_KROWB, A_VB = 128 * A_VROWB, A_STAGE = A_KB + A_VB;
DI float max3f(float a, float b, float c) { float r; asm("v_max3_f32 %0, %1, %2, %3" : "=v"(r) : "v"(a), "v"(b), "v"(c)); return r; }
DI void attn_s(const unsigned char* sK, int tt, int qb, int qs, int sub, int l31, int h,
               const bf16x8 (&qf)[4], f32x16 (&O)[4], float& m, float& l, bf16x8 (&pb)[4]) {
    f32x16 st[2];
#pragma unroll
    for (int k2 = 0; k2 < 2; ++k2)
#pragma unroll
        for (int i = 0; i < 16; ++i) st[k2][i] = -m;
    {
        const unsigned char* kb = sK + l31 * A_KROWB + (sub * 64 + 8 * h) * 2;
        bf16x8 ka[4], kc[4];
#pragma unroll
        for (int i = 0; i < 4; ++i) ka[i] = *(const bf16x8*)(kb + (i & 1) * 32 * A_KROWB + (i >> 1) * 32);
        __builtin_amdgcn_sched_barrier(0);
#pragma unroll
        for (int i = 0; i < 4; ++i) kc[i] = *(const bf16x8*)(kb + (i & 1) * 32 * A_KROWB + (2 + (i >> 1)) * 32);
        __builtin_amdgcn_sched_barrier(0);
#pragma unroll
        for (int i = 0; i < 4; ++i) st[i & 1] = MFMA32(ka[i], qf[i >> 1], st[i & 1]);
        __builtin_amdgcn_sched_barrier(0);
#pragma unroll
        for (int i = 0; i < 4; ++i) st[i & 1] = MFMA32(kc[i], qf[2 + (i >> 1)], st[i & 1]);
    }
    if (tt == 0) {
#pragma unroll
        for (int i = 0; i < 16; ++i) { st[0][i] = -INFINITY; if (i < 8) st[1][i] = -INFINITY; }
    } else if (tt >= 2 * qb + 1) {
        const int kbase = (tt - 1) * 64 + 4 * h;
#pragma unroll
        for (int k2 = 0; k2 < 2; ++k2)
#pragma unroll
            for (int i = 0; i < 16; ++i) {
                const int key = kbase + k2 * 32 + (i & 3) + 8 * (i >> 2);
                if (key > qs) st[k2][i] = -INFINITY;
            }
    }
    float mx;
    {
        float t[11];
#pragma unroll
        for (int i = 0; i < 5; ++i) t[i] = max3f(st[0][3 * i], st[0][3 * i + 1], st[0][3 * i + 2]);
#pragma unroll
        for (int i = 0; i < 5; ++i) t[5 + i] = max3f(st[1][3 * i], st[1][3 * i + 1], st[1][3 * i + 2]);
        t[10] = fmaxf(st[0][15], st[1][15]);
        const float u0 = max3f(t[0], t[1], t[2]), u1 = max3f(t[3], t[4], t[5]), u2 = max3f(t[6], t[7], t[8]);
        mx = max3f(max3f(u0, u1, u2), t[9], t[10]);
    }
    mx = xor32_max(mx);
    if (tt == 0 || __builtin_amdgcn_ballot_w64(mx > 8.0f) != 0ull) {
        const float delta = tt == 0 ? mx : fmaxf(mx, 0.f);
        const float alpha = __builtin_amdgcn_exp2f(-delta);
        m += delta;
        l *= alpha;
#pragma unroll
        for (int d = 0; d < 4; ++d) O[d] = O[d] * alpha;
#pragma unroll
        for (int k2 = 0; k2 < 2; ++k2) st[k2] = st[k2] - delta;
    }
#pragma unroll
    for (int k2 = 0; k2 < 2; ++k2)
#pragma unroll
        for (int i = 0; i < 16; ++i) st[k2][i] = __builtin_amdgcn_exp2f(st[k2][i]);
    {
        const f32x16 sv = st[0] + st[1];
        const float ps = (((sv[0] + sv[1]) + (sv[2] + sv[3])) + ((sv[4] + sv[5]) + (sv[6] + sv[7]))) + (((sv[8] + sv[9]) + (sv[10] + sv[11])) + ((sv[12] + sv[13]) + (sv[14] + sv[15])));
        l += ps;
    }
#pragma unroll
    for (int k4 = 0; k4 < 4; ++k4) {
        const int k2 = k4 >> 1, o8 = 8 * (k4 & 1);
        u32x4 pk;
        pk.x = pk2(st[k2][o8 + 0], st[k2][o8 + 1]); pk.y = pk2(st[k2][o8 + 2], st[k2][o8 + 3]);
        pk.z = pk2(st[k2][o8 + 4], st[k2][o8 + 5]); pk.w = pk2(st[k2][o8 + 6], st[k2][o8 + 7]);
        pb[k4] = __builtin_bit_cast(bf16x8, pk);
    }
}
DI void attn_pv(const unsigned char* sV, int l31, int h, const bf16x8 (&pb)[4], f32x16 (&O)[4]) {
    {
        const unsigned char* vb = sV + l31 * A_VROWB + 16 * h;
        bf16x8 va[4], vc[4];
#pragma unroll
        for (int d = 0; d < 4; ++d) va[d] = *(const bf16x8*)(vb + d * 32 * A_VROWB);
        __builtin_amdgcn_sched_barrier(0);
#pragma unroll
        for (int d = 0; d < 4; ++d) vc[d] = *(const bf16x8*)(vb + d * 32 * A_VROWB + 32);
        __builtin_amdgcn_sched_barrier(0);
#pragma unroll
        for (int d = 0; d < 4; ++d) O[d] = MFMA32(va[d], pb[0], O[d]);
        __builtin_amdgcn_sched_barrier(0);
#pragma unroll
        for (int d = 0; d < 4; ++d) va[d] = *(const bf16x8*)(vb + d * 32 * A_VROWB + 64);
        __builtin_amdgcn_sched_barrier(0);
#pragma unroll
        for (int d = 0; d < 4; ++d) O[d] = MFMA32(vc[d], pb[1], O[d]);
        __builtin_amdgcn_sched_barrier(0);
#pragma unroll
        for (int d = 0; d < 4; ++d) vc[d] = *(const bf16x8*)(vb + d * 32 * A_VROWB + 96);
        __builtin_amdgcn_sched_barrier(0);
#pragma unroll
        for (int d = 0; d < 4; ++d) O[d] = MFMA32(va[d], pb[2], O[d]);
        __builtin_amdgcn_sched_barrier(0);
#pragma unroll
        for (int d = 0; d < 4; ++d) O[d] = MFMA32(vc[d], pb[3], O[d]);
    }
}

DI void attn_item(const Params& p, unsigned char* lds, int b, int hd, int qb, float lam) {
    const int tid = opaque_tid(), lane = tid & 63, wave = tid >> 6, l31 = lane & 31, h = lane >> 5;
    const int sub = wave >> 2, rt = wave & 3;
    const bf16_t* aq = (const bf16_t*)((unsigned char*)p.out + DO_AQ);
    const bf16_t* ak = (const bf16_t*)(p.ws + OFF_AK);
    const bf16_t* avT = (const bf16_t*)(p.ws + OFF_AVT);
    const bf16_t* akm = (const bf16_t*)(p.ws + OFF_AKM);
    const bf16_t* avTm = (const bf16_t*)(p.ws + OFF_AVTM);
    bf16_t* az = (bf16_t*)(p.ws + OFF_AZ);
    const int qs = qb * 128 + rt * 32 + l31;
    const size_t grow = (size_t)b * 4096 + qs;
    bf16x8 qf[4];
#pragma unroll
    for (int ks = 0; ks < 4; ++ks) qf[ks] = *(const bf16x8*)(aq + grow * 1024 + hd * 128 + sub * 64 + ks * 16 + 8 * h);
    f32x16 O[4];
#pragma unroll
    for (int d = 0; d < 4; ++d)
#pragma unroll
        for (int i = 0; i < 16; ++i) O[d][i] = 0.f;
    float m = 0.f, l = 0.f;
    const int T = 2 * qb + 3;
    u32x4 k0r[2], v0r[2];
    const int krow_ = tid >> 4, kc_ = tid & 15, vdv_ = tid >> 3, vc_ = tid & 7;
    const bf16_t* kp = ak + ((size_t)b * 4096 + krow_) * 1024 + hd * 128 + kc_ * 8;
    const bf16_t* vp_ = avT + ((size_t)(b * 8 + hd) * 128 + vdv_) * 4096 + vc_ * 8;
#define A_LOAD_REAL(KR, VR)                                                                                                   \
    {                                                                                                                         \
        KR[0] = *(const u32x4*)kp; KR[1] = *(const u32x4*)(kp + 32 * 1024); kp += 64 * 1024;                                  \
        VR[0] = *(const u32x4*)vp_; VR[1] = *(const u32x4*)(vp_ + (size_t)64 * 4096); vp_ += 64;                              \
    }
#define A_STORE(KR, VR, buf_)                                                                                                 \
    {                                                                                                                         \
        unsigned char* sK_ = lds + (buf_) * A_STAGE; unsigned char* sV_ = sK_ + A_KB;                                         \
        _Pragma("unroll") for (int i = 0; i < 2; ++i) { const int pi = tid + 512 * i, row = pi >> 4, c = pi & 15;              \
            *(u32x4*)(sK_ + row * A_KROWB + c * 16) = KR[i]; }                                                                \
        _Pragma("unroll") for (int i = 0; i < 2; ++i) { const int pi = tid + 512 * i, dv = pi >> 3, c = pi & 7;                \
            unsigned char* d_ = sV_ + dv * A_VROWB + (c >> 1) * 32 + 8 * (c & 1); u32x2 a_, b_; a_.x = VR[i].x; a_.y = VR[i].y; b_.x = VR[i].z; b_.y = VR[i].w; \
            *(u32x2*)d_ = a_; *(u32x2*)(d_ + 16) = b_; }                                                                      \
    }
    {
        const bf16_t* km_ = akm + (size_t)krow_ * 1024 + hd * 128 + kc_ * 8;
        k0r[0] = *(const u32x4*)km_; k0r[1] = *(const u32x4*)(km_ + 32 * 1024);
        const bf16_t* vm_ = avTm + (size_t)(hd * 128 + vdv_) * 64 + vc_ * 8;
        v0r[0] = *(const u32x4*)vm_; v0r[1] = *(const u32x4*)(vm_ + 64 * 64);
    }
    u32x4 k1r[2], v1r[2];
    A_LOAD_REAL(k1r, v1r);
#pragma unroll
    for (int ks = 0; ks < 4; ++ks) asm volatile("" : "+v"(qf[ks]));
    A_STORE(k0r, v0r, 0);
    __syncthreads();
    bf16x8 pb[4];
    int bc = 0, bp = 2, bn = 1;
    {
        attn_s(lds + bc * A_STAGE, 0, qb, qs, sub, l31, h, qf, O, m, l, pb);
        attn_pv(lds + bc * A_STAGE + A_KB, l31, h, pb, O);
        A_STORE(k1r, v1r, bn);
        __syncthreads();
        bp = bc; bc = bn; bn = (bn == 2) ? 0 : bn + 1;
    }
    for (int tt = 1; tt < T; ++tt) {
        if (tt + 1 < T) A_LOAD_REAL(k0r, v0r);
        attn_s(lds + bc * A_STAGE, tt, qb, qs, sub, l31, h, qf, O, m, l, pb);
        attn_pv(lds + bc * A_STAGE + A_KB, l31, h, pb, O);
        if (tt + 1 < T) A_STORE(k0r, v0r, bn);
        __syncthreads();
        bp = bc; bc = bn; bn = (bn == 2) ? 0 : bn + 1;
    }

#undef A_LOAD_REAL
#undef A_STORE
    const float ltot = xor32_sum(l);
    const float linv = 1.0f / ltot;
    u32x2 zz[4][4];
    if (sub == 0) {
#pragma unroll
        for (int d = 0; d < 4; ++d)
#pragma unroll
            for (int g = 0; g < 4; ++g) zz[d][g] = *(const u32x2*)(az + grow * 1024 + hd * 128 + d * 32 + 8 * g + 4 * h);
    }
    float* ex = (float*)lds;
    if (sub == 1) {
#pragma unroll
        for (int d = 0; d < 4; ++d) {
#pragma unroll
            for (int g = 0; g < 4; ++g) {
                f32x4 t; t.x = O[d][4 * g] * linv; t.y = O[d][4 * g + 1] * linv; t.z = O[d][4 * g + 2] * linv; t.w = O[d][4 * g + 3] * linv;
                *(f32x4*)(ex + (rt * 32 + l31) * 132 + d * 32 + 8 * g + 4 * h) = t;
            }
            __builtin_amdgcn_sched_barrier(0);
        }
    }
    __syncthreads();
    if (sub == 0) {
        float ss = 0.f;
#pragma unroll
        for (int d = 0; d < 4; ++d) {
#pragma unroll
            for (int g = 0; g < 4; ++g) {
                const f32x4 t = *(const f32x4*)(ex + (rt * 32 + l31) * 132 + d * 32 + 8 * g + 4 * h);
                const float o0 = O[d][4 * g] * linv - lam * t.x, o1 = O[d][4 * g + 1] * linv - lam * t.y;
                const float o2 = O[d][4 * g + 2] * linv - lam * t.z, o3 = O[d][4 * g + 3] * linv - lam * t.w;
                O[d][4 * g] = o0; O[d][4 * g + 1] = o1; O[d][4 * g + 2] = o2; O[d][4 * g + 3] = o3;
                ss += (o0 * o0 + o1 * o1) + (o2 * o2 + o3 * o3);
            }
            __builtin_amdgcn_sched_barrier(0);
        }
        ss = xor32_sum(ss);
        const float rstd = 1.0f / sqrtf(ss * (1.0f / 128.0f) + EPS);
#pragma unroll
        for (int d = 0; d < 4; ++d)
#pragma unroll
            for (int g = 0; g < 4; ++g) {
                bf16_t* zp = az + grow * 1024 + hd * 128 + d * 32 + 8 * g + 4 * h;
                const u32x2 z2 = zz[d][g];
                u32x2 o;
                o.x = pk2(O[d][4 * g] * rstd * siluf_(bflo(z2.x)), O[d][4 * g + 1] * rstd * siluf_(bfhi(z2.x)));
                o.y = pk2(O[d][4 * g + 2] * rstd * siluf_(bflo(z2.y)), O[d][4 * g + 3] * rstd * siluf_(bfhi(z2.y)));
                *(u32x2*)zp = o;
                if (g == 3) __builtin_amdgcn_sched_barrier(0);
            }
    }
    __syncthreads();
}

constexpr int L_KROWB = 272, L_VROWB = 144, L_SROWB = 272;
constexpr int GLA_DL = 2;
#define L_BAR() { asm volatile("s_waitcnt lgkmcnt(0)" ::: "memory"); __builtin_amdgcn_s_barrier(); asm volatile("" ::: "memory"); }
template <int DL>
DI void gla_item(const Params& p, unsigned char* lds, int b, int hh, int sl) {
    constexpr int SLW = 32 * DL, NVP = SLW / 64;
    constexpr int L_K = 0, L_V = 64 * L_KROWB, L_S = L_V + SLW * L_VROWB, L_KT = L_S + SLW * L_SROWB;
    const int tid = opaque_tid(), lane = tid & 63, wave = tid >> 6, l15 = lane & 15, g = lane >> 4;
    const int tt = wave & 3, dvt = wave >> 2;
    unsigned char* ws = p.ws;
    unsigned char* dout = (unsigned char*)p.out;
    const bf16_t* gq = (const bf16_t*)(dout + DO_GQ);
    const bf16_t* gk = (const bf16_t*)(dout + DO_GK);
    const bf16_t* gvT = (const bf16_t*)(ws + OFF_GVT);
    const bf16_t* ktt = (const bf16_t*)(ws + OFF_WIN_T);
    const float* dec = (const float*)(ws + OFF_DEC);
    bf16_t* gz = (bf16_t*)(ws + OFF_GZ);
    float* ssqb = (float*)(ws + OFF_SSQB);
    unsigned char* sK = lds + L_K; unsigned char* sV = lds + L_V; unsigned char* sS = lds + L_S; unsigned char* sKT = lds + L_KT;
    for (int i = tid; i < SLW * L_SROWB / 4; i += 512) ((unsigned*)sS)[i] = 0u;
    f32x4 sacc[DL][2];
#pragma unroll
    for (int dl = 0; dl < DL; ++dl)
#pragma unroll
        for (int c = 0; c < 2; ++c) sacc[dl][c] = (f32x4){0.f, 0.f, 0.f, 0.f};
    u32x4 nkA[2]; u32x4 nvA[NVP]; bf16x8 nqA[4]; u32x4 nktA[2]; float ndA[2]; u32x2 ngzA[DL];
    u32x4 nkB[2]; u32x4 nvB[NVP]; bf16x8 nqB[4]; u32x4 nktB[2]; float ndB[2]; u32x2 ngzB[DL];
    const int cc0 = 16 * (2 * tt) + l15;
    const int dv0 = 16 * (dvt * DL);
    const int krow_ = tid >> 4, kc_ = tid & 15, vdv_ = tid >> 3, vc_ = tid & 7;
    const bf16_t* kp = gk + ((size_t)b * 4096 + krow_) * 512 + hh * 128 + kc_ * 8;
    const bf16_t* vp_ = gvT + ((size_t)(b * 4 + hh) * 256 + sl * SLW + vdv_) * 4096 + vc_ * 8;
    const bf16_t* ktp = ktt + ((size_t)(b * 4 + hh) * 128 + vdv_) * 4096 + vc_ * 8;
    const float* dp = dec + (size_t)b * 64 * 512 + hh * 128 + cc0;
    const bf16_t* qp = gq + ((size_t)b * 4096 + 16 * tt + l15) * 512 + hh * 128 + 8 * g;
    bf16_t* gzp = gz + ((size_t)b * 4096 + 16 * tt + l15) * 1024 + hh * 256 + sl * SLW + dv0 + 4 * g;
#define L_LOAD_META(S)                                                                                                         \
    {                                                                                                                         \
        const bf16_t* km_ = (const bf16_t*)(ws + OFF_KTM) + (size_t)krow_ * 512 + hh * 128 + kc_ * 8;                         \
        nk##S[0] = *(const u32x4*)km_; nk##S[1] = *(const u32x4*)(km_ + 32 * 512);                                                  \
        _Pragma("unroll") for (int i = 0; i < NVP; ++i)                                                                       \
            nv##S[i] = *(const u32x4*)((const bf16_t*)(ws + OFF_GVTM) + (size_t)(hh * 256 + sl * SLW + vdv_ + 64 * i) * 64 + vc_ * 8); \
        _Pragma("unroll") for (int i = 0; i < 2; ++i)                                                                         \
            nkt##S[i] = *(const u32x4*)((const bf16_t*)(ws + OFF_KTTM) + (size_t)(hh * 128 + vdv_ + 64 * i) * 64 + vc_ * 8);     \
        _Pragma("unroll") for (int ct = 0; ct < 2; ++ct) nd##S[ct] = ((const float*)(ws + OFF_DECM))[hh * 128 + cc0 + 16 * ct];  \
        _Pragma("unroll") for (int ks = 0; ks < 4; ++ks) nq##S[ks] = (bf16x8){0, 0, 0, 0, 0, 0, 0, 0};                           \
        _Pragma("unroll") for (int dl = 0; dl < DL; ++dl) ngz##S[dl] = (u32x2){0u, 0u};                                          \
    }
#define L_LOAD_REAL(S)                                                                                                         \
    {                                                                                                                         \
        nk##S[0] = *(const u32x4*)kp; nk##S[1] = *(const u32x4*)(kp + 32 * 512); kp += 64 * 512;                                    \
        _Pragma("unroll") for (int i = 0; i < NVP; ++i) nv##S[i] = *(const u32x4*)(vp_ + (size_t)(64 * i) * 4096);               \
        vp_ += 64;                                                                                                            \
        _Pragma("unroll") for (int i = 0; i < 2; ++i) nkt##S[i] = *(const u32x4*)(ktp + (size_t)(64 * i) * 4096);              \
        ktp += 64;                                                                                                            \
        nd##S[0] = dp[0]; nd##S[1] = dp[16]; dp += 512;                                                                             \
        _Pragma("unroll") for (int ks = 0; ks < 4; ++ks) nq##S[ks] = *(const bf16x8*)(qp + 32 * ks);                             \
        qp += 64 * 512;                                                                                                       \
        _Pragma("unroll") for (int dl = 0; dl < DL; ++dl) ngz##S[dl] = *(const u32x2*)(gzp + 16 * dl);                           \
        gzp += 64 * 1024;                                                                                                     \
    }
#define L_STORE(S)                                                                                                             \
    {                                                                                                                         \
        _Pragma("unroll") for (int i = 0; i < 2; ++i) { const int pi = tid + 512 * i, row = pi >> 4, c = pi & 15;              \
            *(u32x4*)(sK + row * L_KROWB + c * 16) = nk##S[i]; }                                                                 \
        _Pragma("unroll") for (int i = 0; i < NVP; ++i) *(u32x4*)(sV + (vdv_ + 64 * i) * L_VROWB + vc_ * 16) = nv##S[i];          \
        _Pragma("unroll") for (int i = 0; i < 2; ++i) *(u32x4*)(sKT + (vdv_ + 64 * i) * L_VROWB + vc_ * 16) = nkt##S[i];          \
    }
    L_LOAD_META(A);
    L_LOAD_REAL(B);
    L_STORE(A);
#define GLA_STEP(n_, C, O) {                                                                                         \
        bf16x8 cq[4]; float cd[2]; u32x2 cgz[DL]; \
_Pragma("unroll") \
        for (int ks = 0; ks < 4; ++ks) cq[ks] = nq##C[ks]; \
_Pragma("unroll") \
        for (int ct = 0; ct < 2; ++ct) { cd[ct] = nd##C[ct]; } \
_Pragma("unroll") \
        for (int dl = 0; dl < DL; ++dl) cgz[dl] = ngz##C[dl]; \
_Pragma("unroll") \
        for (int ks = 0; ks < 4; ++ks) asm volatile("" : "+v"(cq[ks])); \
_Pragma("unroll") \
        for (int ct = 0; ct < 2; ++ct) { asm volatile("" : "+v"(cd[ct])); } \
_Pragma("unroll") \
        for (int dl = 0; dl < DL; ++dl) asm volatile("" : "+v"(cgz[dl])); \
        L_BAR(); \
        if ((n_) + 2 <= 64) L_LOAD_REAL(C); \
        if ((n_) > 0) { \
            f32x4 at[4]; \
_Pragma("unroll") \
            for (int jt = 0; jt < 4; ++jt) at[jt] = (f32x4){0.f, 0.f, 0.f, 0.f}; \
            { \
                const unsigned char* kb = sK + l15 * L_KROWB + 16 * g; \
                bf16x8 ka[8], kc[8]; \
_Pragma("unroll") \
                for (int i = 0; i < 8; ++i) ka[i] = *(const bf16x8*)(kb + (i & 3) * 16 * L_KROWB + (i >> 2) * 64); \
                __builtin_amdgcn_sched_barrier(0); \
_Pragma("unroll") \
                for (int i = 0; i < 8; ++i) kc[i] = *(const bf16x8*)(kb + (i & 3) * 16 * L_KROWB + (2 + (i >> 2)) * 64); \
                __builtin_amdgcn_sched_barrier(0); \
_Pragma("unroll") \
                for (int i = 0; i < 8; ++i) at[i & 3] = MFMA16(ka[i], cq[i >> 2], at[i & 3]); \
                __builtin_amdgcn_sched_barrier(0); \
_Pragma("unroll") \
                for (int i = 0; i < 8; ++i) at[i & 3] = MFMA16(kc[i], cq[2 + (i >> 2)], at[i & 3]); \
            } \
            const int tl = 16 * tt + l15; \
_Pragma("unroll") \
            for (int jt = 0; jt < 4; ++jt) \
_Pragma("unroll") \
                for (int i = 0; i < 4; ++i) if (16 * jt + 4 * g + i > tl) at[jt][i] = 0.f; \
            bf16x8 pa[2]; \
_Pragma("unroll") \
            for (int s2 = 0; s2 < 2; ++s2) { \
                u32x4 t; \
                t.x = pk2(at[2 * s2][0], at[2 * s2][1]); t.y = pk2(at[2 * s2][2], at[2 * s2][3]); \
                t.z = pk2(at[2 * s2 + 1][0], at[2 * s2 + 1][1]); t.w = pk2(at[2 * s2 + 1][2], at[2 * s2 + 1][3]); \
                pa[s2] = __builtin_bit_cast(bf16x8, t); \
            } \
            const size_t row = (size_t)b * 4096 + ((n_) - 1) * 64 + 16 * tt + l15; \
_Pragma("unroll") \
            for (int dl = 0; dl < DL; ++dl) { \
                const int dvr = dv0 + 16 * dl + l15; \
                f32x4 o = (f32x4){0.f, 0.f, 0.f, 0.f}; \
                { \
                    u32x4 vv[2]; bf16x8 sf[4]; \
_Pragma("unroll") \
                    for (int s2 = 0; s2 < 2; ++s2) { \
                        const unsigned char* vp = sV + dvr * L_VROWB + (32 * s2 + 4 * g) * 2; \
                        const u32x2 lo = *(const u32x2*)vp, hi = *(const u32x2*)(vp + 32); \
                        vv[s2].x = lo.x; vv[s2].y = lo.y; vv[s2].z = hi.x; vv[s2].w = hi.y; \
                    } \
_Pragma("unroll") \
                    for (int ks = 0; ks < 4; ++ks) sf[ks] = *(const bf16x8*)(sS + dvr * L_SROWB + (ks * 32 + 8 * g) * 2); \
                    __builtin_amdgcn_sched_barrier(0); \
                    f32x4 o2 = (f32x4){0.f, 0.f, 0.f, 0.f}; \
                    o = MFMA16(__builtin_bit_cast(bf16x8, vv[0]), pa[0], o); \
                    o2 = MFMA16(sf[0], cq[0], o2); \
                    o = MFMA16(__builtin_bit_cast(bf16x8, vv[1]), pa[1], o); \
                    o2 = MFMA16(sf[1], cq[1], o2); \
                    o = MFMA16(sf[2], cq[2], o); \
                    o2 = MFMA16(sf[3], cq[3], o2); \
                    o = o + o2; \
                } \
                float ss = (o[0] * o[0] + o[1] * o[1]) + (o[2] * o[2] + o[3] * o[3]); \
                ss = xor16_sum(ss); ss = xor32_sum(ss); \
                u32x2 ov; \
                ov.x = pk2(o[0] * siluf_(bflo(cgz[dl].x)), o[1] * siluf_(bfhi(cgz[dl].x))); \
                ov.y = pk2(o[2] * siluf_(bflo(cgz[dl].y)), o[3] * siluf_(bfhi(cgz[dl].y))); \
                *(u32x2*)(gz + row * 1024 + hh * 256 + sl * SLW + dv0 + 16 * dl + 4 * g) = ov; \
                if (g == 0) ssqb[(row * 4 + hh) * 16 + sl * 2 * DL + dvt * DL + dl] = ss; \
            } \
        } \
        bf16x8 vfs[DL][2]; \
_Pragma("unroll") \
        for (int dl = 0; dl < DL; ++dl) \
_Pragma("unroll") \
            for (int ks = 0; ks < 2; ++ks) vfs[dl][ks] = *(const bf16x8*)(sV + (dv0 + 16 * dl + l15) * L_VROWB + (32 * ks + 8 * g) * 2); \
        bf16x8 ckt[2][2]; \
        _Pragma("unroll") \
        for (int ct = 0; ct < 2; ++ct) \
        _Pragma("unroll") \
            for (int ks = 0; ks < 2; ++ks) ckt[ct][ks] = *(const bf16x8*)(sKT + (cc0 + 16 * ct) * L_VROWB + (32 * ks + 8 * g) * 2); \
        __builtin_amdgcn_sched_barrier(0); \
_Pragma("unroll") \
        for (int dl = 0; dl < DL; ++dl) { \
_Pragma("unroll") \
            for (int ks = 0; ks < 2; ++ks) { \
                sacc[dl][0] = MFMA16(vfs[dl][ks], ckt[0][ks], sacc[dl][0]); \
                sacc[dl][1] = MFMA16(vfs[dl][ks], ckt[1][ks], sacc[dl][1]); \
            } \
_Pragma("unroll") \
            for (int ct = 0; ct < 2; ++ct) \
_Pragma("unroll") \
                for (int i = 0; i < 4; ++i) sacc[dl][ct][i] *= cd[ct]; \
        } \
        L_BAR(); \
_Pragma("unroll") \
        for (int dl = 0; dl < DL; ++dl) \
_Pragma("unroll") \
            for (int ct = 0; ct < 2; ++ct) \
_Pragma("unroll") \
                for (int i = 0; i < 4; ++i) \
                    *(bf16_t*)(sS + (dv0 + 16 * dl + 4 * g + i) * L_SROWB + (cc0 + 16 * ct) * 2) = f2bf(sacc[dl][ct][i]); \
        if ((n_) + 1 <= 64) L_STORE(O); \
    }
    for (int n2 = 0; n2 <= 64; n2 += 2) {
        GLA_STEP(n2, A, B);
        if (n2 + 1 > 64) break;
        GLA_STEP(n2 + 1, B, A);
    }
#undef GLA_STEP
#undef L_LOAD_META
#undef L_LOAD_REAL
#undef L_STORE
    __syncthreads();
}

DI void phase2(const Params& p, unsigned char* lds) {
    const int tid = opaque_tid();
    float lam;
    {
        const int lane = tid & 63;
        const float a_ = wave_sum(p.lq1[lane] * p.lk1[lane]);
        const float b_ = wave_sum(p.lq2[lane] * p.lk2[lane]);
        lam = __uint_as_float((unsigned)__builtin_amdgcn_readfirstlane((int)__float_as_uint(expf(a_) - expf(b_) + 0.2f)));
    }
    volatile unsigned* sItem = (volatile unsigned*)(lds + LDS_ITEM);
    constexpr unsigned NSL = 8 / GLA_DL, N_GLA = 2 * NSL, N_ATT = 128;
    if (tid == 0) sItem[1] = 0u;
    for (;;) {
        if (tid == 0) {
            unsigned* heads = (unsigned*)(p.ws + OFF_XBAR + 15360);
            const unsigned x0 = (unsigned)__builtin_amdgcn_s_getreg((3 << 11) | 20) & 7u;
            unsigned k = sItem[1], it = 0xffffffffu;
            while (k < 8u) {
                const unsigned x = (x0 + k) & 7u;
                const unsigned got = atomicAdd(heads + x, 1u);
                if (got < N_GLA + N_ATT) { it = got | (x << 16); break; }
                ++k;
            }
            sItem[1] = k; sItem[0] = it;
        }
        __syncthreads();
        const unsigned item = (unsigned)__builtin_amdgcn_readfirstlane((int)sItem[0]);
        __syncthreads();
        if (item == 0xffffffffu) break;
        const unsigned x = item >> 16, idx = item & 0xffffu;
        if (idx < N_GLA) { const unsigned gi = x * N_GLA + idx; gla_item<GLA_DL>(p, lds, gi / (4 * NSL), (gi / NSL) & 3, gi % NSL); }
        else { const unsigned a = idx - N_GLA, pair = 4 * x + ((a >> 2) & 3); attn_item(p, lds, pair & 3, pair >> 2, 31 - (int)(((a >> 4) << 2) + (a & 3)), lam); }
    }
}

DI void phase25(const Params& p, unsigned char* lds) {
    const int tid = opaque_tid(), lane = tid & 63, wave = tid >> 6;
    const float* ssqb = (const float*)(p.ws + OFF_SSQB);
    bf16_t* gz = (bf16_t*)(p.ws + OFF_GZ);
    for (int it = blockIdx.x; it < MROWS / 32; it += gridDim.x) {
        const size_t row0 = (size_t)it * 32 + wave * 4;
        u32x4 u[4][2]; float s[4];
#pragma unroll
        for (int q = 0; q < 4; ++q) {
            const u32x4* ptr = (const u32x4*)(gz + (row0 + q) * 1024 + lane * 16);
            u[q][0] = ptr[0]; u[q][1] = ptr[1];
            s[q] = ssqb[((row0 + q) * 4 + (lane >> 4)) * 16 + (lane & 15)];
        }
#pragma unroll
        for (int q = 0; q < 4; ++q) {
            float t = s[q];
            t += __shfl_xor(t, 1); t += __shfl_xor(t, 2); t += __shfl_xor(t, 4); t += __shfl_xor(t, 8);
            const float r = 1.0f / sqrtf(t * (1.0f / 256.0f) + EPS);
            u32x4* ptr = (u32x4*)(gz + (row0 + q) * 1024 + lane * 16);
#pragma unroll
            for (int j = 0; j < 2; ++j) {
                const u32x4 a = u[q][j]; u32x4 o;
                o.x = pk2(bflo(a.x) * r, bfhi(a.x) * r); o.y = pk2(bflo(a.y) * r, bfhi(a.y) * r);
                o.z = pk2(bflo(a.z) * r, bfhi(a.z) * r); o.w = pk2(bflo(a.w) * r, bfhi(a.w) * r);
                ptr[j] = o;
            }
        }
    }
}

template <int PASS>
struct EpiMerge {
    static constexpr bool PERM = false, AFTER_DRAIN = false;
    unsigned char* ws; const PG8_LAS float* tab;
    DI void operator()(const pg8::f32x4 (&acc)[2][2][4][2], const pg8::Unit& u, int wr, int wc, int fr, int fq) const {
        const unsigned char* sg = ws + (PASS == 0 ? OFF_SGB : OFF_SGA);
        bf16_t* merged = (bf16_t*)(ws + OFF_AK);
#pragma unroll
        for (int ai = 0; ai < 2; ++ai)
#pragma unroll
            for (int m = 0; m < 4; ++m) {
                const size_t tok = (size_t)u.pm * 256 + ai * 128 + wr * 64 + m * 16 + fr;
#pragma unroll
                for (int bj = 0; bj < 2; ++bj)
#pragma unroll
                    for (int n = 0; n < 2; ++n) {
                        const size_t off = tok * 1024 + u.pn * 256 + bj * 128 + wc * 32 + n * 16 + 4 * fq;
                        const unsigned ug = *(const unsigned*)(sg + off);
                        const float q = (PASS == 0 ? tab[(ai * 128 + wr * 64 + m * 16 + fr) * 4 + 3] : 1.0f) * (1.0f / 255.0f);
                        float m0 = (float)(ug & 255u) * q * acc[ai][bj][m][n][0], m1 = (float)((ug >> 8) & 255u) * q * acc[ai][bj][m][n][1];
                        float m2 = (float)((ug >> 16) & 255u) * q * acc[ai][bj][m][n][2], m3 = (float)(ug >> 24) * q * acc[ai][bj][m][n][3];
                        if (PASS == 1) { const u32x2 t = *(const u32x2*)(merged + off); m0 += bflo(t.x); m1 += bfhi(t.x); m2 += bflo(t.y); m3 += bfhi(t.y); }
                        u32x2 o; o.x = pk2(m0, m1); o.y = pk2(m2, m3);
                        *(u32x2*)(merged + off) = o;
                    }
            }
    }
};
struct EpiOut {
    static constexpr bool PERM = false, AFTER_DRAIN = true;
    unsigned char* ws; const float* x; float* out; const float* fw;
    DI void fused(pg8::f32x4 (&acc)[2][2][4][2], const pg8::Unit& u, int wr, int wc, int fr, int fq, PG8_LAS unsigned char* lds, int wid, int lane) const {
        float* ssqh = (float*)(ws + OFF_SSQH);
        unsigned* pcnt = (unsigned*)(ws + OFF_XBAR + 14336) + u.pm;
#pragma unroll
        for (int ai = 0; ai < 2; ++ai)
#pragma unroll
            for (int m = 0; m < 4; ++m) {
                const size_t tok = (size_t)u.pm * 256 + ai * 128 + wr * 64 + m * 16 + fr;
                float ss = 0.f;
#pragma unroll
                for (int bj = 0; bj < 2; ++bj)
#pragma unroll
                    for (int n = 0; n < 2; ++n) {
                        const size_t off = tok * 1024 + u.pn * 256 + bj * 128 + wc * 32 + n * 16 + 4 * fq;
                        const f32x4 xv = *(const f32x4*)(x + off);
                        f32x4 o = acc[ai][bj][m][n];
                        o.x += xv.x; o.y += xv.y; o.z += xv.z; o.w += xv.w;
                        acc[ai][bj][m][n] = o;
                        ss += (o.x * o.x + o.y * o.y) + (o.z * o.z + o.w * o.w);
                    }
                ss = xor16_sum(ss); ss = xor32_sum(ss);
                if (fq == 0) ssqh[tok * 16 + u.pn * 4 + wc] = ss;
            }
        asm volatile("s_waitcnt vmcnt(0)" ::: "memory");
        __syncthreads();
        if (threadIdx.x == 0) {
            __builtin_amdgcn_fence(__ATOMIC_RELEASE, "agent");
            asm volatile("s_waitcnt vmcnt(0)" ::: "memory");
            __hip_atomic_fetch_add(pcnt, 1u, __ATOMIC_RELAXED, __HIP_MEMORY_SCOPE_AGENT);
            unsigned spins = 0u;
            while (__hip_atomic_load(pcnt, __ATOMIC_RELAXED, __HIP_MEMORY_SCOPE_AGENT) < 4u && ++spins < (1u << 22)) __builtin_amdgcn_s_sleep(1);
            __builtin_amdgcn_fence(__ATOMIC_ACQUIRE, "agent");
            asm volatile("s_waitcnt vmcnt(0)" ::: "memory");
        }
        __syncthreads();
#pragma unroll
        for (int ai = 0; ai < 2; ++ai)
#pragma unroll
            for (int m = 0; m < 4; ++m) {
                const size_t tok = (size_t)u.pm * 256 + ai * 128 + wr * 64 + m * 16 + fr;
                const f32x4* sp = (const f32x4*)(ssqh + tok * 16);
                const f32x4 a = sp[0], b2 = sp[1], c = sp[2], d = sp[3];
                const float s = ((a.x + a.y) + (a.z + a.w)) + ((b2.x + b2.y) + (b2.z + b2.w)) + ((c.x + c.y) + (c.z + c.w)) + ((d.x + d.y) + (d.z + d.w));
                const float rstd = 1.0f / sqrtf(s * (1.0f / 1024.0f) + EPS);
#pragma unroll
                for (int bj = 0; bj < 2; ++bj)
#pragma unroll
                    for (int n = 0; n < 2; ++n) {
                        const int col = u.pn * 256 + bj * 128 + wc * 32 + n * 16 + 4 * fq;
                        const f32x4 w = *(const f32x4*)(fw + col);
                        f32x4 o = acc[ai][bj][m][n];
                        o.x = o.x * rstd * w.x; o.y = o.y * rstd * w.y; o.z = o.z * rstd * w.z; o.w = o.w * rstd * w.w;
                        *(f32x4*)(out + tok * 1024 + col) = o;
                    }
            }
    }
};
DI void phase3(const Params& p, unsigned char* lds) {
    SchedSq S;
    {
        pg8::Unit u0; S.next(0, u0);
        const int tid = opaque_tid();
        float* tabw = (float*)(lds + 147456);
        if (tid < 256) {
            const float* sp = (const float*)(p.ws + OFF_SSQB) + ((size_t)u0.pm * 256 + tid) * 64;
            float r[4];
#pragma unroll
            for (int hh = 0; hh < 4; ++hh) {
                const f32x4 a = *(const f32x4*)(sp + hh * 16), b2 = *(const f32x4*)(sp + hh * 16 + 4), c = *(const f32x4*)(sp + hh * 16 + 8), d = *(const f32x4*)(sp + hh * 16 + 12);
                const float s = ((a.x + a.y) + (a.z + a.w)) + ((b2.x + b2.y) + (b2.z + b2.w)) + ((c.x + c.y) + (c.z + c.w)) + ((d.x + d.y) + (d.z + d.w));
                r[hh] = 1.0f / sqrtf(s * (1.0f / 256.0f) + EPS);
            }
            f32x4 o; o.x = r[0] / r[1]; o.y = r[1] / r[2]; o.z = r[2] / r[3]; o.w = r[3];
            *(f32x4*)(tabw + tid * 4) = o;
        }
        __syncthreads();
    }
    {
        pg8::Gemm g; g.A = (const bf16_t*)(p.ws + OFF_GZ); g.Bt = (const bf16_t*)(p.ws + OFF_WB_T); g.M = MROWS; g.N = 1024; g.K = 1024;
        EpiMerge<0> E; E.ws = p.ws; E.tab = (const PG8_LAS float*)(lds + 147456);
        pg8::gemm_phase<EpiMerge<0>, SchedSq, true, true, true>((PG8_LAS unsigned char*)lds, g, S, E);
    }
    {
        pg8::Gemm g; g.A = (const bf16_t*)(p.ws + OFF_AZ); g.Bt = (const bf16_t*)(p.ws + OFF_WA_T); g.M = MROWS; g.N = 1024; g.K = 1024;
        EpiMerge<1> E; E.ws = p.ws; E.tab = (const PG8_LAS float*)(lds + 147456);
        pg8::gemm_phase<EpiMerge<1>, SchedSq, true, true>((PG8_LAS unsigned char*)lds, g, S, E);
    }
}
DI void phase4(const Params& p, unsigned char* lds) {
    SchedSq S;
    pg8::Gemm g; g.A = (const bf16_t*)(p.ws + OFF_AK); g.Bt = (const bf16_t*)(p.ws + OFF_WO_T); g.M = MROWS; g.N = 1024; g.K = 1024;
    EpiOut E; E.ws = p.ws; E.x = p.x; E.out = p.out; E.fw = p.final_w;
    pg8::gemm_phase<EpiOut, SchedSq, false, true>((PG8_LAS unsigned char*)lds, g, S, E);
}

DI void phase5(const Params& p, unsigned char* lds) {
    const int tid = opaque_tid(), lane = tid & 63, wave = tid >> 6;
    const float* ssqh = (const float*)(p.ws + OFF_SSQH);
    for (int it = blockIdx.x; it < MROWS / 8; it += gridDim.x) {
        const size_t row = (size_t)it * 8 + wave;
        float s = lane < 16 ? ssqh[row * 16 + lane] : 0.f;
        s = wave_sum(s);
        const float rstd = 1.0f / sqrtf(s * (1.0f / 1024.0f) + EPS);
        f32x4* orow = (f32x4*)(p.out + row * 1024) + lane;
        const f32x4* wrow = (const f32x4*)p.final_w + lane;
#pragma unroll
        for (int j = 0; j < 4; ++j) {
            f32x4 v = orow[64 * j]; const f32x4 w = wrow[64 * j];
            v.x = v.x * rstd * w.x; v.y = v.y * rstd * w.y; v.z = v.z * rstd * w.z; v.w = v.w * rstd * w.w;
            orow[64 * j] = v;
        }
    }
}

#define XB_TMO      128
#define XB_XCNT(j)  (256  + 64 * (j))
#define XB_XSUB(j)  (1280 + 64 * (j))
#define XB_XGEN(j)  (2304 + 64 * (j))
#define XB_TOP      3328
#define XB_TOPGEN   3392
#define XCD_BAR_WORDS 3456
#define XB_SPIN_CAP (1u << 18)
#define LAS __attribute__((address_space(3)))
DI unsigned xb_ld(unsigned* p)              { return __hip_atomic_load(p, __ATOMIC_RELAXED, __HIP_MEMORY_SCOPE_AGENT); }
DI unsigned xb_add(unsigned* p, unsigned v) { return __hip_atomic_fetch_add(p, v, __ATOMIC_RELAXED, __HIP_MEMORY_SCOPE_AGENT); }
DI unsigned xb_xcc_id() { return (unsigned)__builtin_amdgcn_s_getreg((3 << 11) | 20) & 0xFu; }
#define XB_SPIN(cond, bar) do { unsigned _sp = 0; while (cond) { __builtin_amdgcn_s_sleep(1); \
    if ((++_sp & 255u) == 0u) { if (xb_ld(&(bar)[XB_TMO])) break; if (_sp > XB_SPIN_CAP) { atomicAdd(&(bar)[XB_TMO], 1u); break; } } } } while (0)
struct XcdBarrier { unsigned* bar; unsigned x; volatile LAS unsigned* st; };
DI XcdBarrier xcd_barrier_post(unsigned* bar, volatile LAS unsigned* st) {
    XcdBarrier b; b.bar = bar; b.x = xb_xcc_id(); b.st = st;
    if (threadIdx.x == 0) (void)xb_add(&bar[XB_XCNT(b.x)], 1u);
    return b;
}
DI void xcd_barrier_complete(unsigned* bar, unsigned x, unsigned& nloc, unsigned& nx) {
    const unsigned G = gridDim.x * gridDim.y * gridDim.z;
    unsigned sum, cnt, mine, sp = 0u;
    for (;;) {
        sum = 0u; cnt = 0u; mine = 0u;
#pragma unroll
        for (unsigned j = 0; j < 16; ++j) { const unsigned c = xb_ld(&bar[XB_XCNT(j)]); sum += c; cnt += (c > 0u) ? 1u : 0u; mine = (j == x) ? c : mine; }
        if (sum == G) break;
        __builtin_amdgcn_s_sleep(1);
        if ((++sp & 255u) == 0u) { if (xb_ld(&bar[XB_TMO])) break; if (sp > XB_SPIN_CAP) { atomicAdd(&bar[XB_TMO], 1u); break; } }
    }
    nloc = mine > 0u ? mine : 1u; nx = cnt > 0u ? cnt : 1u;
}
DI void xcd_barrier(const XcdBarrier& b) {
    asm volatile("s_waitcnt vmcnt(0)" ::: "memory");
    __syncthreads();
    if (threadIdx.x == 0) {
        unsigned* bar = b.bar;
        __builtin_amdgcn_s_waitcnt(0);
        unsigned nloc = b.st[0], nx = b.st[1];
        if (nloc == 0u) { xcd_barrier_complete(bar, b.x, nloc, nx); b.st[0] = nloc; b.st[1] = nx; }
        const unsigned old = xb_add(&bar[XB_XSUB(b.x)], 1u);
        const unsigned gen = old / nloc;
        if (old + 1u == (gen + 1u) * nloc) {
            __builtin_amdgcn_fence(__ATOMIC_RELEASE, "agent");
            asm volatile("s_waitcnt vmcnt(0)" ::: "memory");
            const unsigned og = xb_add(&bar[XB_TOP], 1u);
            const unsigned tg = og / nx;
            if (og + 1u == (tg + 1u) * nx) xb_add(&bar[XB_TOPGEN], 1u);
            else XB_SPIN(xb_ld(&bar[XB_TOPGEN]) == tg, bar);
            __builtin_amdgcn_fence(__ATOMIC_ACQUIRE, "agent");
            xb_add(&bar[XB_XGEN(b.x)], 1u);
            asm volatile("s_waitcnt vmcnt(0)" ::: "memory");
        } else {
            XB_SPIN(xb_ld(&bar[XB_XGEN(b.x)]) == gen, bar);
            __builtin_amdgcn_fence(__ATOMIC_ACQUIRE, "agent");
            asm volatile("s_waitcnt vmcnt(0)" ::: "memory");
        }
    }
    __syncthreads();
}

DI void run_phase(const Params& p, unsigned char* lds, int ph) {
    switch (ph) {
        case 0: phase0(p, lds); break;
        case 1: phase1(p, lds); break;
        case 2: phase15(p, lds); break;
        case 3: phase2(p, lds); break;
        case 4: phase25(p, lds); phase3(p, lds); break;
        case 5: phase4(p, lds); break;
        default: phase5(p, lds); break;
    }
}

__global__ void __launch_bounds__(512) hybrid_fwd(Params p) {
    extern __shared__ __attribute__((aligned(16))) unsigned char lds[];
#if MULTI_LAUNCH
    run_phase(p, lds, p.phase_lo);
#else
    cg::grid_group grid = cg::this_grid();
    if (p.phase_lo == 77) grid.sync();
    {
        volatile LAS unsigned* st = (volatile LAS unsigned*)(lds + LDS_ITEM + 16);
        if (threadIdx.x == 0) { st[0] = 0u; st[1] = 0u; }
        __syncthreads();
        (void)xcd_barrier_post((unsigned*)(p.ws + OFF_XBAR), st);
    }
#define GRID_BARRIER() { XcdBarrier xb_; xb_.bar = (unsigned*)(p.ws + OFF_XBAR); xb_.x = xb_xcc_id(); xb_.st = (volatile LAS unsigned*)(lds + LDS_ITEM + 16); xcd_barrier(xb_); }
    phase0(p, lds); GRID_BARRIER();
    phase1(p, lds); GRID_BARRIER();
    phase15(p, lds); GRID_BARRIER();
    phase2(p, lds); GRID_BARRIER();
    phase3(p, lds); GRID_BARRIER();
    phase4(p, lds);
#endif
}

extern "C" void kernel_launch(void* const* d_in, const int* in_sizes, int n_in, void* d_out, int out_size, void* d_ws, size_t ws_size, hipStream_t stream) {
    static int grid = 0;
    if (grid == 0) {
        int dev = 0, cus = 0, per_cu = 0;
        hipGetDevice(&dev);
        hipDeviceGetAttribute(&cus, hipDeviceAttributeMultiprocessorCount, dev);
        hipFuncSetAttribute((const void*)hybrid_fwd, hipFuncAttributeMaxDynamicSharedMemorySize, LDS_BYTES);
        hipOccupancyMaxActiveBlocksPerMultiprocessor(&per_cu, (const void*)hybrid_fwd, 512, LDS_BYTES);
        if (per_cu < 1) per_cu = 1;
        if (per_cu > 1) per_cu = 1;
        if (cus <= 0) cus = 256;
        grid = cus * per_cu;
    }
    hipMemsetAsync((unsigned char*)d_ws + OFF_XBAR, 0, 16384, stream);
    Params p{};
    p.x = (const float*)d_in[0]; p.meta = (const float*)d_in[1]; p.norm_w = (const float*)d_in[2]; p.w_in = (const float*)d_in[3];
    p.lq1 = (const float*)d_in[4]; p.lk1 = (const float*)d_in[5]; p.lq2 = (const float*)d_in[6]; p.lk2 = (const float*)d_in[7];
    p.subln_w = (const float*)d_in[8]; p.gate_w2 = (const float*)d_in[9]; p.gate_b = (const float*)d_in[10]; p.gla_norm_w = (const float*)d_in[11];
    p.wa = (const float*)d_in[12]; p.wb = (const float*)d_in[13]; p.wo = (const float*)d_in[14]; p.final_w = (const float*)d_in[15];
    p.out = (float*)d_out; p.ws = (unsigned char*)d_ws;
#if MULTI_LAUNCH
    for (int ph = 0; ph < 7; ++ph) {
        p.phase_lo = ph; p.phase_hi = ph + 1;
        hipLaunchKernelGGL(hybrid_fwd, dim3(grid), dim3(512), LDS_BYTES, stream, p);
    }
#else
    p.phase_lo = 0; p.phase_hi = 7;
    void* args[] = {&p};
    hipError_t e = hipLaunchCooperativeKernel((const void*)hybrid_fwd, dim3(grid), dim3(512), args, LDS_BYTES, stream);
    if (e != hipSuccess) fprintf(stderr, "cooperative launch failed: %s (grid %d)\n", hipGetErrorString(e), grid);
#endif
}
```

```cpp
#include <hip/hip_runtime.h>
#include <hip/hip_cooperative_groups.h>
#include <cstdio>
#include <cstdint>
namespace cg = cooperative_groups;

#ifndef MULTI_LAUNCH
#define MULTI_LAUNCH 0
#endif
#ifndef PROBE_REP
#define PROBE_REP 0
#endif

typedef unsigned short bf16_t;
typedef short bf16x8 __attribute__((ext_vector_type(8)));
typedef float f32x4 __attribute__((ext_vector_type(4)));
typedef float f32x2 __attribute__((ext_vector_type(2)));
typedef float f32x16 __attribute__((ext_vector_type(16)));
typedef unsigned u32x4 __attribute__((ext_vector_type(4)));
typedef unsigned u32x2 __attribute__((ext_vector_type(2)));
typedef __bf16 bfv2 __attribute__((ext_vector_type(2)));

#define DI __device__ __forceinline__
#define MFMA32(a, b, c) __builtin_amdgcn_mfma_f32_32x32x16_bf16((a), (b), (c), 0, 0, 0)
#define MFMA16(a, b, c) __builtin_amdgcn_mfma_f32_16x16x32_bf16((a), (b), (c), 0, 0, 0)

DI unsigned pk2(float a, float b) { f32x2 v = {a, b}; return __builtin_bit_cast(unsigned, __builtin_convertvector(v, bfv2)); }
DI float bf2f(bf16_t v) { return __uint_as_float(((unsigned)v) << 16); }
DI float bflo(unsigned u) { return __uint_as_float(u << 16); }
DI float bfhi(unsigned u) { return __uint_as_float(u & 0xffff0000u); }
DI bf16_t f2bf(float a) { return (bf16_t)(pk2(a, 0.f) & 0xffffu); }
DI float wave_sum(float v) {
#pragma unroll
    for (int o = 32; o; o >>= 1) v += __shfl_xor(v, o);
    return v;
}
DI int opaque_tid() { int t = threadIdx.x; asm volatile("" : "+v"(t)); return t; }
DI float xor32_sum(float x) { auto r = __builtin_amdgcn_permlane32_swap(__float_as_uint(x), __float_as_uint(x), false, false); return __uint_as_float(r[0]) + __uint_as_float(r[1]); }
DI float xor16_sum(float x) { auto r = __builtin_amdgcn_permlane16_swap(__float_as_uint(x), __float_as_uint(x), false, false); return __uint_as_float(r[0]) + __uint_as_float(r[1]); }
DI float xor32_max(float x) { auto r = __builtin_amdgcn_permlane32_swap(__float_as_uint(x), __float_as_uint(x), false, false); return fmaxf(__uint_as_float(r[0]), __uint_as_float(r[1])); }
DI float sigmoidf_(float z) { return __builtin_amdgcn_rcpf(1.f + __expf(-z)); }
DI float siluf_(float z) { return z * __builtin_amdgcn_rcpf(1.f + __expf(-z)); }

constexpr int D = 1024, NB = 4, SEQ = 4096, MROWS = NB * SEQ;
constexpr int NIN = 9232, NINP = 9344;
constexpr float EPS = 1e-5f;

constexpr size_t SZ_ACT = (size_t)MROWS * 1024 * 2;
constexpr size_t OFF_WIN_T = 0;
constexpr size_t OFF_WA_T = OFF_WIN_T + (size_t)NINP * 1024 * 2;
constexpr size_t OFF_WB_T = OFF_WA_T + 2097152;
constexpr size_t OFF_WO_T = OFF_WB_T + 2097152;
constexpr size_t OFF_AK = OFF_WO_T + 2097152;
constexpr size_t OFF_AVT = OFF_AK + SZ_ACT;
constexpr size_t OFF_AZ = OFF_AVT + SZ_ACT;
constexpr size_t OFF_GVT = OFF_AZ + SZ_ACT;
constexpr size_t OFF_GZ = OFF_GVT + SZ_ACT;
constexpr size_t OFF_GA = OFF_GZ + SZ_ACT;
constexpr size_t OFF_GB = OFF_GA + SZ_ACT;
constexpr size_t OFF_GLR = OFF_GB + SZ_ACT;
constexpr size_t OFF_RSTD = OFF_GLR + (size_t)MROWS * 16 * 2;
constexpr size_t OFF_ROPE = OFF_RSTD + 65792;
constexpr size_t OFF_AKM = OFF_ROPE + 263168;
constexpr size_t OFF_AVTM = OFF_AKM + 131072;
constexpr size_t OFF_GVTM = OFF_AVTM + 131072;
constexpr size_t OFF_GKM = OFF_GVTM + 131072;
constexpr size_t OFF_GLRM = OFF_GKM + 16384;
constexpr size_t OFF_KTM = OFF_GLRM + 512;
constexpr size_t OFF_KTTM = OFF_KTM + 65536;
constexpr size_t OFF_DEC = OFF_KTTM + 65536;
constexpr size_t OFF_DECM = OFF_DEC + 524288;
constexpr size_t OFF_SSQB = OFF_DECM + 2048;
constexpr size_t OFF_SSQH = OFF_SSQB + 4194304;
constexpr size_t OFF_CTR = OFF_SSQH + 1048576;
constexpr size_t OFF_XBM = OFF_CTR + 256;
constexpr size_t OFF_XBAR = OFF_XBM + 32768;
constexpr size_t WS_END = OFF_XBAR + 16384;
constexpr size_t OFF_XB = OFF_GA;
constexpr size_t OFF_SGA = OFF_GB;
constexpr size_t OFF_SGB = OFF_GB + (size_t)MROWS * 1024;
static_assert(WS_END <= 268435456ull, "workspace over 256 MiB");
constexpr size_t DO_AQ = 0, DO_GQ = SZ_ACT, DO_GK = SZ_ACT + SZ_ACT / 2;

constexpr int G_ROWB = 144;
constexpr int G_SW = 128 * G_ROWB, G_SX = 256 * G_ROWB, G_STAGE = G_SW + G_SX;
constexpr int G_SW4 = 256 * G_ROWB, G_STAGE4 = G_SW4 + G_SX;
constexpr int LDS_SCALE = 2 * G_STAGE4;
constexpr int LDS_ITEM = LDS_SCALE + 4096;
constexpr int LDS_BYTES = LDS_ITEM + 64;

struct Params {
    const float *x, *meta, *norm_w, *w_in, *lq1, *lk1, *lq2, *lk2, *subln_w, *gate_w2, *gate_b, *gla_norm_w, *wa, *wb, *wo, *final_w;
    float* out;
    unsigned char* ws;
    int phase_lo, phase_hi;
};

template <int MODE>
DI void p0_transpose_item(const Params& p, int item, float* tile) {
    const int tid = opaque_tid();
    const float* W = MODE == 0 ? p.w_in : MODE == 1 ? p.wa : MODE == 2 ? p.wb : p.wo;
    const int ldw = MODE == 0 ? NIN : 1024;
    const int nbc = MODE == 0 ? NINP / 128 : 8;
    bf16_t* WT = (bf16_t*)(p.ws + (MODE == 0 ? OFF_WIN_T : MODE == 1 ? OFF_WA_T : MODE == 2 ? OFF_WB_T : OFF_WO_T));
    const int kb = item / nbc, nb = item % nbc, k0 = kb * 64, n0 = nb * 128;
    const int nn = tid & 127, n = n0 + nn;
    int src = n;
    if (MODE == 0) { src = n < 7168 ? n : (n < 9216 ? n + 16 : (n < 9232 ? n - 2048 : -1)); }
    float v[16];
#pragma unroll
    for (int i = 0; i < 16; ++i) {
        const int k = k0 + (tid >> 7) + 4 * i;
        v[i] = src >= 0 ? W[(size_t)k * ldw + src] : 0.f;
    }
#pragma unroll
    for (int i = 0; i < 16; ++i) {
        const int kk = (tid >> 7) + 4 * i, k = k0 + kk;
        float sc = 1.f;
        if (MODE == 0) sc = p.norm_w[k];
        if (MODE == 1) sc = 0.8f * p.subln_w[k & 127];
        if (MODE == 2) sc = p.gla_norm_w[k & 255];
        tile[kk * 129 + nn] = v[i] * sc;
    }
    __syncthreads();
    {
        const int on = tid >> 2, c = tid & 3;
        const float* s = tile + (16 * c) * 129 + on;
        u32x4 o0, o1;
        o0.x = pk2(s[0 * 129], s[1 * 129]); o0.y = pk2(s[2 * 129], s[3 * 129]); o0.z = pk2(s[4 * 129], s[5 * 129]); o0.w = pk2(s[6 * 129], s[7 * 129]);
        o1.x = pk2(s[8 * 129], s[9 * 129]); o1.y = pk2(s[10 * 129], s[11 * 129]); o1.z = pk2(s[12 * 129], s[13 * 129]); o1.w = pk2(s[14 * 129], s[15 * 129]);
        u32x4* dst = (u32x4*)(WT + (size_t)(n0 + on) * 1024 + k0 + 16 * c);
        dst[0] = o0; dst[1] = o1;
    }
    __syncthreads();
}

DI void phase0(const Params& p, unsigned char* lds) {
    const int tid = opaque_tid(), lane = tid & 63, wave = tid >> 6;
    float* tile = (float*)lds;
    constexpr int I_WIN = 16 * (NINP / 128), I_SQ = 128;
    constexpr int I_T = I_WIN + 3 * I_SQ;
    constexpr int I_RSTD = (MROWS + 16 + 15) / 16;
    constexpr int I_ROPE = (4112 * 8 + 511) / 512;
    constexpr int I_ZERO = 393216 / 8192;
    constexpr int I_ALL = I_T + I_RSTD + I_ROPE + I_ZERO;
    for (int it = blockIdx.x; it < I_ALL; it += gridDim.x) {
        int r = it;
        if (r < I_WIN) { p0_transpose_item<0>(p, r, tile); continue; } r -= I_WIN;
        if (r < I_SQ) { p0_transpose_item<1>(p, r, tile); continue; } r -= I_SQ;
        if (r < I_SQ) { p0_transpose_item<2>(p, r, tile); continue; } r -= I_SQ;
        if (r < I_SQ) { p0_transpose_item<3>(p, r, tile); continue; } r -= I_SQ;
        if (r < I_RSTD) {
            const int row0 = r * 16 + wave * 2;
            f32x4 v[2][4];
#pragma unroll
            for (int q = 0; q < 2; ++q) {
                const int row = row0 + q < MROWS + 16 ? row0 + q : MROWS + 15;
                const float* srcp = row < MROWS ? p.x + (size_t)row * 1024 : p.meta + (size_t)(row - MROWS) * 1024;
                const f32x4* xr = (const f32x4*)srcp + lane;
#pragma unroll
                for (int j = 0; j < 4; ++j) v[q][j] = xr[64 * j];
            }
#pragma unroll
            for (int q = 0; q < 2; ++q) {
                const int row = row0 + q;
                float s = 0.f;
#pragma unroll
                for (int j = 0; j < 4; ++j) s += (v[q][j].x * v[q][j].x + v[q][j].y * v[q][j].y) + (v[q][j].z * v[q][j].z + v[q][j].w * v[q][j].w);
                s = wave_sum(s);
                if (row < MROWS + 16) {
                    if (lane == 0) ((float*)(p.ws + OFF_RSTD))[row] = 1.0f / sqrtf(s * (1.0f / 1024.0f) + EPS);
                    bf16_t* xbrow = row < MROWS ? (bf16_t*)(p.ws + OFF_XB) + (size_t)row * 1024 : (bf16_t*)(p.ws + OFF_XBM) + (size_t)(row - MROWS) * 1024;
#pragma unroll
                    for (int j = 0; j < 4; ++j) { u32x2 o; o.x = pk2(v[q][j].x, v[q][j].y); o.y = pk2(v[q][j].z, v[q][j].w); *(u32x2*)(xbrow + 256 * j + 4 * lane) = o; }
                }
            }
            continue;
        }
        r -= I_RSTD;
        if (r < I_ROPE) {
            const int e = r * 512 + tid;
            if (e < 4112 * 8) {
                const int pos = e >> 3, i = e & 7;
                const float inv = powf(500000.0f, -(float)i / 8.0f);
                const float ang = (float)pos * inv;
                float* t = (float*)(p.ws + OFF_ROPE) + (size_t)e * 2;
                t[0] = cosf(ang); t[1] = sinf(ang);
            }
            continue;
        }
        r -= I_ROPE;
        { u32x4 z = {0u, 0u, 0u, 0u}; *(u32x4*)(p.ws + OFF_AKM + (size_t)r * 8192 + tid * 16) = z; }
    }
}

namespace pg8 {
#define PG8_LAS __attribute__((address_space(3)))
typedef unsigned short bf16_t;
typedef short bf16x8 __attribute__((ext_vector_type(8)));
typedef float f32x4 __attribute__((ext_vector_type(4)));
typedef unsigned u32x4 __attribute__((ext_vector_type(4)));
constexpr int BM = 256, BK = 64, HALF = 128, HTB = HALF * BK * 2  , STAGE_BYTES = 8 * HTB, NXCD = 8, WGM = 8;

__host__ __device__ __forceinline__ int lds_byte(int r, int c) { const int st = (r >> 4) * 2 + (c >> 5), rr = r & 15, cc = c & 31, ob = rr * 64 + cc * 2; return st * 1024 + (ob ^ (((ob >> 9) & 1) << 5)); }
__host__ __device__ __forceinline__ void stage_rc(int b, int& R, int& C) { const int st = b / 1024, sb = b % 1024, swz = sb ^ (((sb >> 9) & 1) << 5); R = (st >> 1) * 16 + swz / 64; C = (st & 1) * 32 + (swz % 64) / 2; }
__host__ __device__ __forceinline__ int perm32(int rho) { const int n = rho >> 4, i = rho & 15; return 8 * (i >> 2) + 4 * n + (i & 3); }

struct Unit { int pm, pn; };
struct Gemm { const bf16_t* A; const bf16_t* Bt; int M, N, K; };

template <class Epi, class Sched, bool ALIGN_EPI = false, bool SP2 = false, bool HS = false>
__device__ __forceinline__ void gemm_phase(PG8_LAS unsigned char* lds, const Gemm g, const Sched& S, const Epi& E) {
    const int tid = opaque_tid(), wid = __builtin_amdgcn_readfirstlane(tid >> 6), lane = tid & 63, wr = wid >> 2, wc = wid & 3, fr = lane & 15, fq = lane >> 4;
    const int K = g.K, nt = K / BK;
    unsigned voffA[2], voffB[2];
#pragma unroll
    for (int i = 0; i < 2; ++i) { int R, C; stage_rc(tid * 16 + i * 8192, R, C); const int Rb = Epi::PERM ? ((R & ~31) + perm32(R & 31)) : R;
        voffA[i] = (unsigned)(R * K + C) * 2u; voffB[i] = (unsigned)(Rb * K + C) * 2u; }
    const size_t kstep = (size_t)(BK * 2);
    const size_t hstep = (size_t)HALF * K * 2;
    const size_t tstep = 2 * hstep;
    const unsigned ldsw = (unsigned)wid * 1024u;
    const int aoff = lds_byte(wr * 64 + fr, fq * 8), boff = lds_byte(wc * 32 + fr, fq * 8);
#define PG8_SA(b, h) (((b) * 2 + (h)) * HTB)
#define PG8_SB(b, h) ((4 + (b) * 2 + (h)) * HTB)
#define PG8_STAGE(bufoff, gbase, voff) do { _Pragma("unroll") for (int _i = 0; _i < 2; ++_i) \
        __builtin_amdgcn_global_load_lds((const unsigned*)((const char*)(gbase) + (voff)[_i]), (PG8_LAS unsigned*)(lds + (bufoff) + ldsw + _i * 8192), 16, 0, 0); } while (0)
#define PG8_LDA(dst, b, h) do { _Pragma("unroll") for (int m = 0; m < 4; ++m) _Pragma("unroll") for (int k = 0; k < 2; ++k) dst[m][k] = *(const PG8_LAS bf16x8*)(lds + PG8_SA(b, h) + aoff + m * 2048 + k * 1024); } while (0)
#define PG8_LDB(dst, b, h) do { _Pragma("unroll") for (int n = 0; n < 2; ++n) _Pragma("unroll") for (int k = 0; k < 2; ++k) dst[n][k] = *(const PG8_LAS bf16x8*)(lds + PG8_SB(b, h) + boff + n * 2048 + k * 1024); } while (0)
#define PG8_MMA(ai, bj, At, Bt) do { __builtin_amdgcn_s_setprio(1); _Pragma("unroll") for (int m = 0; m < 4; ++m) _Pragma("unroll") for (int n = 0; n < 2; ++n) _Pragma("unroll") for (int k = 0; k < 2; ++k) \
        acc[ai][bj][m][n] = __builtin_amdgcn_mfma_f32_16x16x32_bf16(Bt[n][k], At[m][k], acc[ai][bj][m][n], 0, 0, 0); __builtin_amdgcn_s_setprio(0); } while (0)
#define PG8_WAIT_V(n) asm volatile("s_waitcnt vmcnt(" #n ")" ::: "memory")
#define PG8_WAIT_L(n) asm volatile("s_waitcnt lgkmcnt(" #n ")" ::: "memory")
#define PG8_BAR __builtin_amdgcn_s_barrier()
#define PG8_SCHED __builtin_amdgcn_sched_barrier(0)
    Unit cur, nxt; int ui = 0;
    if (!S.next(0, cur)) return;
    f32x4 acc[2][2][4][2];
#pragma unroll
    for (int a = 0; a < 2; ++a)
#pragma unroll
        for (int b = 0; b < 2; ++b)
#pragma unroll
            for (int m = 0; m < 4; ++m)
#pragma unroll
                for (int n = 0; n < 2; ++n) acc[a][b][m][n] = (f32x4){0.f, 0.f, 0.f, 0.f};
    bf16x8 At[4][2], B0[2][2], B1[2][2];
    const char* cA = (const char*)g.A + (size_t)cur.pm * tstep; const char* cB = (const char*)g.Bt + (size_t)cur.pn * tstep;
    S.a_ready(cur);
    if constexpr (SP2) {
        PG8_STAGE(PG8_SB(0, 0), cB, voffB); PG8_STAGE(PG8_SB(0, 1), cB + hstep, voffB); PG8_STAGE(PG8_SA(0, 0), cA, voffA); PG8_STAGE(PG8_SA(0, 1), cA + hstep, voffA);
        if (wr == 1) PG8_BAR;
        PG8_WAIT_V(2); PG8_BAR;
        PG8_STAGE(PG8_SB(1, 0), cB + kstep, voffB); PG8_STAGE(PG8_SA(1, 0), cA + kstep, voffA); PG8_STAGE(PG8_SB(1, 1), cB + hstep + kstep, voffB);
        PG8_WAIT_V(6); PG8_BAR;
    } else {
        PG8_STAGE(PG8_SB(0, 0), cB, voffB); PG8_STAGE(PG8_SA(0, 0), cA, voffA); PG8_STAGE(PG8_SB(0, 1), cB + hstep, voffB); PG8_STAGE(PG8_SA(0, 1), cA + hstep, voffA);
        if (wr == 1) PG8_BAR;
        PG8_WAIT_V(4); PG8_BAR;
        PG8_STAGE(PG8_SB(1, 0), cB + kstep, voffB); PG8_STAGE(PG8_SA(1, 0), cA + kstep, voffA); PG8_STAGE(PG8_SB(1, 1), cB + hstep + kstep, voffB);
        PG8_WAIT_V(6); PG8_BAR;
    }
    for (;;) {
        const bool has_next = S.next(ui + 1, nxt);
        const char* nA = has_next ? (const char*)g.A + (size_t)nxt.pm * tstep : cA; const char* nB = has_next ? (const char*)g.Bt + (size_t)nxt.pn * tstep : cB;
        for (int t = 0; t < nt; t += 2) {
            if constexpr (HS) {
                if (t == 4 || t == 8 || t == 12) {
                    const PG8_LAS float* tab = (const PG8_LAS float*)(lds + 147456);
                    const int hj = (t >> 2) - 1;
#pragma unroll
                    for (int a = 0; a < 2; ++a)
#pragma unroll
                        for (int m = 0; m < 4; ++m) {
                            const float s = tab[(a * 128 + wr * 64 + m * 16 + fr) * 4 + hj];
#pragma unroll
                            for (int b = 0; b < 2; ++b)
#pragma unroll
                                for (int n = 0; n < 2; ++n) acc[a][b][m][n] = acc[a][b][m][n] * s;
                        }
                }
            }
            const bool last = (t == nt - 2);
            const char* a1 = cA + (size_t)(t + 1) * kstep;
            const char* a2 = last ? nA : cA + (size_t)(t + 2) * kstep; const char* b2 = last ? nB : cB + (size_t)(t + 2) * kstep;
            const char* a3 = a2 + kstep; const char* b3 = b2 + kstep;
            if (last && has_next) S.a_ready(nxt);
            if constexpr (SP2) {
            PG8_LDB(B0, 0, 0); PG8_LDB(B1, 0, 1); PG8_SCHED; PG8_LDA(At, 0, 0); PG8_STAGE(PG8_SA(1, 1), a1 + hstep, voffA);
            PG8_WAIT_V(8); PG8_WAIT_L(0); PG8_BAR; PG8_MMA(0, 0, At, B0); PG8_MMA(0, 1, At, B1); PG8_BAR; PG8_SCHED;
            PG8_LDA(At, 0, 1); PG8_STAGE(PG8_SB(0, 0), b2, voffB); PG8_STAGE(PG8_SB(0, 1), b2 + hstep, voffB); PG8_STAGE(PG8_SA(0, 0), a2, voffA);
            PG8_WAIT_V(8); PG8_WAIT_L(0); PG8_BAR; PG8_MMA(1, 0, At, B0); PG8_MMA(1, 1, At, B1); PG8_BAR; PG8_SCHED;
            PG8_LDB(B0, 1, 0); PG8_LDB(B1, 1, 1); PG8_SCHED; PG8_LDA(At, 1, 0); PG8_STAGE(PG8_SA(0, 1), a2 + hstep, voffA);
            PG8_WAIT_V(8); PG8_WAIT_L(0); PG8_BAR; PG8_MMA(0, 0, At, B0); PG8_MMA(0, 1, At, B1); PG8_BAR; PG8_SCHED;
            PG8_LDA(At, 1, 1); PG8_STAGE(PG8_SB(1, 0), b3, voffB); PG8_STAGE(PG8_SB(1, 1), b3 + hstep, voffB); PG8_STAGE(PG8_SA(1, 0), a3, voffA);
            PG8_WAIT_V(8); PG8_WAIT_L(0); PG8_BAR; PG8_MMA(1, 0, At, B0); PG8_MMA(1, 1, At, B1); PG8_BAR; PG8_SCHED;
            } else {
            PG8_LDB(B0, 0, 0); PG8_SCHED; PG8_LDA(At, 0, 0); PG8_STAGE(PG8_SA(1, 1), a1 + hstep, voffA);
            PG8_WAIT_L(8); PG8_BAR; PG8_WAIT_L(0); PG8_MMA(0, 0, At, B0); PG8_BAR; PG8_SCHED;
            PG8_LDB(B1, 0, 1); PG8_STAGE(PG8_SB(0, 0), b2, voffB);
            PG8_BAR; PG8_WAIT_L(0); PG8_MMA(0, 1, At, B1); PG8_BAR;
            PG8_LDA(At, 0, 1); PG8_STAGE(PG8_SA(0, 0), a2, voffA);
            PG8_BAR; PG8_WAIT_L(0); PG8_MMA(1, 0, At, B0); PG8_BAR; PG8_SCHED;
            PG8_STAGE(PG8_SB(0, 1), b2 + hstep, voffB);
            PG8_WAIT_V(6); PG8_BAR; PG8_MMA(1, 1, At, B1); PG8_BAR;
            PG8_LDB(B0, 1, 0); PG8_SCHED; PG8_LDA(At, 1, 0); PG8_STAGE(PG8_SA(0, 1), a2 + hstep, voffA);
            PG8_WAIT_L(8); PG8_BAR; PG8_WAIT_L(0); PG8_MMA(0, 0, At, B0); PG8_BAR; PG8_SCHED;
            PG8_LDB(B1, 1, 1); PG8_STAGE(PG8_SB(1, 0), b3, voffB);
            PG8_BAR; PG8_WAIT_L(0); PG8_MMA(0, 1, At, B1); PG8_BAR;
            PG8_LDA(At, 1, 1); PG8_STAGE(PG8_SA(1, 0), a3, voffA);
            PG8_BAR; PG8_WAIT_L(0); PG8_MMA(1, 0, At, B0); PG8_BAR; PG8_SCHED;
            PG8_STAGE(PG8_SB(1, 1), b3 + hstep, voffB);
            PG8_WAIT_V(6); PG8_BAR; PG8_MMA(1, 1, At, B1); PG8_BAR;
            }
        }
        if constexpr (ALIGN_EPI) { if (wr == 0) PG8_BAR; }
        if constexpr (!Epi::AFTER_DRAIN) { E(acc, cur, wr, wc, fr, fq); S.done(cur); }
        if (!has_next) break;
#pragma unroll
        for (int a = 0; a < 2; ++a)
#pragma unroll
            for (int b = 0; b < 2; ++b)
#pragma unroll
                for (int m = 0; m < 4; ++m)
#pragma unroll
                    for (int n = 0; n < 2; ++n) acc[a][b][m][n] = (f32x4){0.f, 0.f, 0.f, 0.f};
        cur = nxt; cA = nA; cB = nB; ++ui;
        if constexpr (ALIGN_EPI) { if (wr == 1) PG8_BAR; }
    }
    PG8_WAIT_V(0);
    if constexpr (!ALIGN_EPI) { if (wr == 0) PG8_BAR; }
    PG8_BAR;
    if constexpr (Epi::AFTER_DRAIN) { E.fused(acc, cur, wr, wc, fr, fq, lds, wid, lane); S.done(cur); }
#undef PG8_SA
#undef PG8_SB
#undef PG8_STAGE
#undef PG8_LDA
#undef PG8_LDB
#undef PG8_MMA
#undef PG8_WAIT_V
#undef PG8_WAIT_L
#undef PG8_BAR
#undef PG8_SCHED
}
}

DI unsigned sig_u8(float z) { return (unsigned)(255.0f * __builtin_amdgcn_rcpf(1.0f + __expf(-z)) + 0.5f); }
struct SchedP1 {
    DI bool next(int i, pg8::Unit& u) const {
        constexpr int NT = 36;
        const int id = (int)blockIdx.x + i * (int)gridDim.x;
        if (id >= 64 * NT) return false;
        const int g = id / (16 * NT), rem = id % (16 * NT), reg = rem >> 8, w = rem & 255, x = w & 7, j = w >> 3;
        int mt = g * 16 + 4 * (x & 3) + (j & 3), nt = reg * 16 + 8 * (x >> 2) + (j >> 2);
        if (reg == 2) { const int e = rem - 512; nt = 32 + (e >> 4); mt = g * 16 + (e & 15); }
        u.pm = mt; u.pn = nt; return true;
    }
    DI void a_ready(const pg8::Unit&) const {}
    DI void done(const pg8::Unit&) const {}
};
struct SchedSq {
    DI bool next(int i, pg8::Unit& u) const {
        const int id = (int)blockIdx.x + i * (int)gridDim.x;
        if (id >= 256) return false;
        u.pm = 8 * (id & 7) + ((id >> 3) & 7); u.pn = id >> 6; return true;
    }
    DI void a_ready(const pg8::Unit&) const {}
    DI void done(const pg8::Unit&) const {}
};
DI unsigned sig_u8x4(float a, float b, float c, float d) {
    unsigned r = 0u;
    r = __builtin_amdgcn_cvt_pk_u8_f32(255.0f * __builtin_amdgcn_rcpf(1.0f + __expf(-a)), 0, r);
    r = __builtin_amdgcn_cvt_pk_u8_f32(255.0f * __builtin_amdgcn_rcpf(1.0f + __expf(-b)), 1, r);
    r = __builtin_amdgcn_cvt_pk_u8_f32(255.0f * __builtin_amdgcn_rcpf(1.0f + __expf(-c)), 2, r);
    r = __builtin_amdgcn_cvt_pk_u8_f32(255.0f * __builtin_amdgcn_rcpf(1.0f + __expf(-d)), 3, r);
    return r;
}
struct EpiInProj {
    static constexpr bool PERM = true, AFTER_DRAIN = false;
    unsigned char* ws; unsigned char* dout;
    DI void operator()(const pg8::f32x4 (&acc)[2][2][4][2], const pg8::Unit& u, int wr, int wc, int fr, int fq) const {
        const int nt = u.pn;
        int split, nc0;
        if (nt < 4) { split = 0; nc0 = nt * 256; }
        else if (nt < 8) { split = 1; nc0 = (nt - 4) * 256; }
        else if (nt < 12) { split = 2; nc0 = (nt - 8) * 256; }
        else if (nt < 16) { split = 3; nc0 = (nt - 12) * 256; }
        else if (nt < 18) { split = 4; nc0 = (nt - 16) * 256; }
        else if (nt < 20) { split = 5; nc0 = (nt - 18) * 256; }
        else if (nt < 24) { split = 6; nc0 = (nt - 20) * 256; }
        else if (nt < 28) { split = 7; nc0 = (nt - 24) * 256; }
        else if (nt < 32) { split = 9; nc0 = (nt - 28) * 256; }
        else { split = 10; nc0 = (nt - 32) * 256; }
        const float* rstd = (const float*)(ws + OFF_RSTD);
        const float* rope = (const float*)(ws + OFF_ROPE);
        const bool do_rope = split <= 1 && (wc & 1) == 0;
#pragma unroll
        for (int ai = 0; ai < 2; ++ai)
#pragma unroll
            for (int m = 0; m < 4; ++m) {
                const int tok = u.pm * 256 + ai * 128 + wr * 64 + m * 16 + fr;
                const float rs = rstd[tok];
                const float rsq = split == 0 ? rs * (0.125f * 1.4426950408889634f) : rs;
                const int pos = 16 + (tok & 4095), b = tok >> 12, s = tok & 4095;
#pragma unroll
                for (int bj = 0; bj < 2; ++bj) {
                    const int nb = nc0 + bj * 128 + wc * 32 + 8 * fq;
                    float v[8];
#pragma unroll
                    for (int j = 0; j < 4; ++j) { v[j] = acc[ai][bj][m][0][j] * rsq; v[4 + j] = acc[ai][bj][m][1][j] * rsq; }
                    if (do_rope) {
                        const f32x4* cs = (const f32x4*)(rope + (size_t)pos * 16);
                        const f32x4 c01 = cs[0], c23 = cs[1], c45 = cs[2], c67 = cs[3];
                        const float cc[8] = {c01.x, c01.z, c23.x, c23.z, c45.x, c45.z, c67.x, c67.z};
                        const float sn[8] = {c01.y, c01.w, c23.y, c23.w, c45.y, c45.w, c67.y, c67.w};
#pragma unroll
                        for (int j = 0; j < 8; ++j) {
                            const float other = __shfl_xor(v[j], 16);
                            const float r0 = v[j] * cc[j] - other * sn[j], r1 = v[j] * cc[j] + other * sn[j];
                            v[j] = fq == 0 ? r0 : (fq == 1 ? r1 : v[j]);
                        }
                    }
                    if (split == 2 || split == 6) {
                        const int hshift = split == 2 ? 7 : 8, nheads = split == 2 ? 8 : 4, dvn = 1 << hshift;
                        bf16_t* base = (bf16_t*)(ws + (split == 2 ? OFF_AVT : OFF_GVT));
                        const int hd = nb >> hshift, dv0 = nb & (dvn - 1);
                        bf16_t* dst = base + ((size_t)(b * nheads + hd) * dvn + dv0) * 4096 + s;
#pragma unroll
                        for (int j = 0; j < 8; ++j) dst[(size_t)j * 4096] = f2bf(v[j]);
                    } else if (split >= 9) {
                        u32x2 o; o.x = sig_u8x4(v[0], v[1], v[2], v[3]); o.y = sig_u8x4(v[4], v[5], v[6], v[7]);
                        *(u32x2*)(ws + (split == 9 ? OFF_SGA : OFF_SGB) + (size_t)tok * 1024 + nb) = o;
                    } else {
                        bf16_t* dst; int ld;
                        switch (split) {
                            case 0: dst = (bf16_t*)(dout + DO_AQ); ld = 1024; break;
                            case 1: dst = (bf16_t*)(ws + OFF_AK); ld = 1024; break;
                            case 3: dst = (bf16_t*)(ws + OFF_AZ); ld = 1024; break;
                            case 4: dst = (bf16_t*)(dout + DO_GQ); ld = 512; break;
                            case 5: dst = (bf16_t*)(dout + DO_GK); ld = 512; break;
                            default: dst = (bf16_t*)(ws + OFF_GZ); ld = 1024; break;
                        }
                        u32x4 o; o.x = pk2(v[0], v[1]); o.y = pk2(v[2], v[3]); o.z = pk2(v[4], v[5]); o.w = pk2(v[6], v[7]);
                        *(u32x4*)(dst + (size_t)tok * ld + nb) = o;
                    }
                }
            }
    }
};

DI void p1_glr_job(const Params& p, unsigned char* lds, int job) {
    const int tid = opaque_tid(), lane = tid & 63, wave = tid >> 6, l15 = lane & 15, g = lane >> 4;
    const int rtile = wave & 3, khalf = wave >> 2;
    const bf16_t* xb = (const bf16_t*)(p.ws + OFF_XB);
    const bf16_t* wt = (const bf16_t*)(p.ws + OFF_WIN_T) + (size_t)9216 * 1024;
    const size_t row0 = (size_t)job * 64 + rtile * 16;
    const bf16_t* ap = xb + (row0 + l15) * 1024 + khalf * 512 + 8 * g;
    const bf16_t* bp = wt + (size_t)l15 * 1024 + khalf * 512 + 8 * g;
    f32x4 acc = (f32x4){0.f, 0.f, 0.f, 0.f};
    {
        bf16x8 av[16], bv[16];
#pragma unroll
        for (int ks = 0; ks < 16; ++ks) { av[ks] = *(const bf16x8*)(ap + ks * 32); bv[ks] = *(const bf16x8*)(bp + ks * 32); }
        f32x4 acc2 = (f32x4){0.f, 0.f, 0.f, 0.f};
#pragma unroll
        for (int ks = 0; ks < 16; ks += 2) { acc = MFMA16(av[ks], bv[ks], acc); acc2 = MFMA16(av[ks + 1], bv[ks + 1], acc2); }
        acc = acc + acc2;
    }
    f32x4* red = (f32x4*)lds;
    __syncthreads();
    if (khalf == 1) red[rtile * 64 + lane] = acc;
    __syncthreads();
    if (khalf == 0) {
        const f32x4 o = red[rtile * 64 + lane];
        const float* rstd = (const float*)(p.ws + OFF_RSTD);
        bf16_t* glr = (bf16_t*)(p.ws + OFF_GLR);
#pragma unroll
        for (int i = 0; i < 4; ++i) {
            const size_t row = row0 + 4 * g + i;
            glr[row * 16 + l15] = f2bf((acc[i] + o[i]) * rstd[row]);
        }
    }
    __syncthreads();
}

DI void p1_meta_job(const Params& p, unsigned char* lds, int job) {
    const int tid = opaque_tid(), lane = tid & 63, wave = tid >> 6, l15 = lane & 15, g = lane >> 4;
    int c0;
    if (job < 64) c0 = 1024 + job * 16;
    else if (job < 128) c0 = 2048 + (job - 64) * 16;
    else if (job < 160) c0 = 4608 + (job - 128) * 16;
    else if (job < 224) c0 = 5120 + (job - 160) * 16;
    else c0 = 9216;
    const bf16_t* xbm = (const bf16_t*)(p.ws + OFF_XBM);
    const bf16_t* wt = (const bf16_t*)(p.ws + OFF_WIN_T);
    const bf16_t* ap = xbm + (size_t)l15 * 1024 + wave * 128 + 8 * g;
    const bf16_t* bp = wt + (size_t)(c0 + l15) * 1024 + wave * 128 + 8 * g;
    f32x4 acc = (f32x4){0.f, 0.f, 0.f, 0.f};
#pragma unroll
    for (int ks = 0; ks < 4; ++ks) {
        const bf16x8 a = *(const bf16x8*)(ap + ks * 32), bb = *(const bf16x8*)(bp + ks * 32);
        acc = MFMA16(a, bb, acc);
    }
    f32x4* red = (f32x4*)lds;
    __syncthreads();
    red[wave * 64 + lane] = acc;
    __syncthreads();
    if (wave == 0) {
        f32x4 s = red[lane];
#pragma unroll
        for (int w = 1; w < 8; ++w) { const f32x4 t = red[w * 64 + lane]; s.x += t.x; s.y += t.y; s.z += t.z; s.w += t.w; }
        const float* rstd = (const float*)(p.ws + OFF_RSTD) + MROWS;
        const float* rope = (const float*)(p.ws + OFF_ROPE);
        unsigned char* ws = p.ws;
        const int col = c0 + l15;
#pragma unroll
        for (int i = 0; i < 4; ++i) {
            const int row = 4 * g + i;
            float v = s[i] * rstd[row];
            if (job < 64 && (c0 & 63) == 0) {
                const float other = __shfl_xor(v, 8);
                const float* cs = rope + ((size_t)row * 8 + (l15 & 7)) * 2;
                const float c = cs[0], sn = cs[1];
                v = (l15 < 8) ? (v * c - other * sn) : (v * c + other * sn);
            }
            const bf16_t val = f2bf(v);
            if (job < 64) ((bf16_t*)(ws + OFF_AKM))[(size_t)(48 + row) * 1024 + (col - 1024)] = val;
            else if (job < 128) { const int n = col - 2048; ((bf16_t*)(ws + OFF_AVTM))[(size_t)n * 64 + 48 + row] = val; }
            else if (job < 160) ((bf16_t*)(ws + OFF_GKM))[(size_t)row * 512 + (col - 4608)] = val;
            else if (job < 224) { const int n = col - 5120; ((bf16_t*)(ws + OFF_GVTM))[(size_t)n * 64 + 48 + row] = val; }
            else ((bf16_t*)(ws + OFF_GLRM))[row * 16 + l15] = val;
        }
    }
    __syncthreads();
}

DI void phase1(const Params& p, unsigned char* lds) {
    for (int j = blockIdx.x; j < 256; j += gridDim.x) p1_glr_job(p, lds, j);
    for (int j = blockIdx.x; j < 225; j += gridDim.x) p1_meta_job(p, lds, j);
    pg8::Gemm g; g.A = (const bf16_t*)(p.ws + OFF_XB); g.Bt = (const bf16_t*)(p.ws + OFF_WIN_T); g.M = MROWS; g.N = 9216; g.K = 1024;
    SchedP1 S; EpiInProj E; E.ws = p.ws; E.dout = (unsigned char*)p.out;
    pg8::gemm_phase<EpiInProj, SchedP1, true, true>((PG8_LAS unsigned char*)lds, g, S, E);
}

DI void phase15(const Params& p, unsigned char* lds) {
    const int tid = opaque_tid(), col = tid;
    float w2[16];
#pragma unroll
    for (int j = 0; j < 16; ++j) w2[j] = p.gate_w2[j * 512 + col];
    const float bias = p.gate_b[col];
    unsigned char* ws = p.ws;
    unsigned char* dout = (unsigned char*)p.out;
    for (int item = blockIdx.x; item < 257; item += gridDim.x) {
        const bool meta = item == 256;
        const int b = item >> 6, c = item & 63;
        const size_t row0 = (size_t)b * 4096 + c * 64;
        const bf16_t* glr = meta ? (const bf16_t*)(ws + OFF_GLRM) : (const bf16_t*)(ws + OFF_GLR) + row0 * 16;
        const int nrows = meta ? 16 : 64;
        bf16_t* qp = (bf16_t*)(dout + DO_GQ) + row0 * 512 + col;
        const bf16_t* kin = meta ? (const bf16_t*)(ws + OFF_GKM) + col : (const bf16_t*)(dout + DO_GK) + row0 * 512 + col;
        bf16_t* kout = meta ? (bf16_t*)(ws + OFF_KTM) + 48 * 512 + col : (bf16_t*)(dout + DO_GK) + row0 * 512 + col;
        bf16_t* ktt = meta ? (bf16_t*)(ws + OFF_KTTM) + (size_t)col * 64 + 48 : (bf16_t*)(ws + OFF_WIN_T) + ((size_t)b * 512 + col) * 4096 + c * 64;
        __syncthreads();
        if (tid < nrows * 2) ((u32x4*)lds)[tid] = ((const u32x4*)glr)[tid];
        __syncthreads();
        float bsum = 0.f;
        constexpr int GR = 16;
        bf16_t kc[GR], qc[GR], kn[GR], qn[GR];
#pragma unroll
        for (int rr = 0; rr < GR; ++rr) { kc[rr] = kin[(size_t)rr * 512]; qc[rr] = meta ? (bf16_t)0 : qp[(size_t)rr * 512]; }
        for (int r0 = 0; r0 < nrows; r0 += GR) {
            if (r0 + GR < nrows) {
#pragma unroll
                for (int rr = 0; rr < GR; ++rr) { kn[rr] = kin[(size_t)(r0 + GR + rr) * 512]; qn[rr] = meta ? (bf16_t)0 : qp[(size_t)(r0 + GR + rr) * 512]; }
            }
            float kt8[GR];
#pragma unroll
            for (int rr = 0; rr < GR; ++rr) {
                const int r = r0 + rr;
                const u32x4* g4 = (const u32x4*)(lds + r * 32);
                const u32x4 ga = g4[0], gb = g4[1];
                float gk = bias;
                gk += bflo(ga.x) * w2[0] + bfhi(ga.x) * w2[1] + bflo(ga.y) * w2[2] + bfhi(ga.y) * w2[3];
                gk += bflo(ga.z) * w2[4] + bfhi(ga.z) * w2[5] + bflo(ga.w) * w2[6] + bfhi(ga.w) * w2[7];
                gk += bflo(gb.x) * w2[8] + bfhi(gb.x) * w2[9] + bflo(gb.y) * w2[10] + bfhi(gb.y) * w2[11];
                gk += bflo(gb.z) * w2[12] + bfhi(gb.z) * w2[13] + bflo(gb.w) * w2[14] + bfhi(gb.w) * w2[15];
                const float lg = (fminf(gk, 0.f) - __logf(1.0f + __expf(-fabsf(gk)))) * (1.0f / 16.0f);
                bsum += lg;
                const float eb = __expf(bsum);
                const float kt = bf2f(kc[rr]) * __builtin_amdgcn_rcpf(eb);
                kt8[rr] = kt;
                kout[(size_t)r * 512] = f2bf(kt);
                if (!meta) qp[(size_t)r * 512] = f2bf(bf2f(qc[rr]) * 0.08838834764831845f * eb);
            }
#pragma unroll
            for (int hh8 = 0; hh8 < GR / 8; ++hh8) {
                u32x4 o; o.x = pk2(kt8[8 * hh8 + 0], kt8[8 * hh8 + 1]); o.y = pk2(kt8[8 * hh8 + 2], kt8[8 * hh8 + 3]);
                o.z = pk2(kt8[8 * hh8 + 4], kt8[8 * hh8 + 5]); o.w = pk2(kt8[8 * hh8 + 6], kt8[8 * hh8 + 7]);
                *(u32x4*)(ktt + r0 + 8 * hh8) = o;
            }
#pragma unroll
            for (int rr = 0; rr < GR; ++rr) { kc[rr] = kn[rr]; qc[rr] = qn[rr]; }
        }
        if (meta) {
            ((float*)(ws + OFF_DECM))[col] = expf(bsum);
            bf16_t* km = (bf16_t*)(ws + OFF_KTM);
            for (int r = 0; r < 48; ++r) km[r * 512 + col] = 0;
            u32x4 z = {0u, 0u, 0u, 0u};
            u32x4* kz = (u32x4*)((bf16_t*)(ws + OFF_KTTM) + (size_t)col * 64);
#pragma unroll
            for (int j = 0; j < 6; ++j) kz[j] = z;
        } else {
            ((float*)(ws + OFF_DEC))[((size_t)b * 64 + c) * 512 + col] = expf(bsum);
        }
    }
}

constexpr int A_KROWB = 272, A_VROWB = 144, A_KB = 64 * A_KROWB, A_VB = 128 * A_VROWB, A_STAGE = A_KB + A_VB;
DI float max3f(float a, float b, float c) { float r; asm("v_max3_f32 %0, %1, %2, %3" : "=v"(r) : "v"(a), "v"(b), "v"(c)); return r; }
DI void attn_s(const unsigned char* sK, int tt, int qb, int qs, int sub, int l31, int h,
               const bf16x8 (&qf)[4], f32x16 (&O)[4], float& m, float& l, bf16x8 (&pb)[4]) {
    f32x16 st[2];
#pragma unroll
    for (int k2 = 0; k2 < 2; ++k2)
#pragma unroll
        for (int i = 0; i < 16; ++i) st[k2][i] = -m;
    {
        const unsigned char* kb = sK + l31 * A_KROWB + (sub * 64 + 8 * h) * 2;
        bf16x8 ka[4], kc[4];
#pragma unroll
        for (int i = 0; i < 4; ++i) ka[i] = *(const bf16x8*)(kb + (i & 1) * 32 * A_KROWB + (i >> 1) * 32);
        __builtin_amdgcn_sched_barrier(0);
#pragma unroll
        for (int i = 0; i < 4; ++i) kc[i] = *(const bf16x8*)(kb + (i & 1) * 32 * A_KROWB + (2 + (i >> 1)) * 32);
        __builtin_amdgcn_sched_barrier(0);
#pragma unroll
        for (int i = 0; i < 4; ++i) st[i & 1] = MFMA32(ka[i], qf[i >> 1], st[i & 1]);
        __builtin_amdgcn_sched_barrier(0);
#pragma unroll
        for (int i = 0; i < 4; ++i) st[i & 1] = MFMA32(kc[i], qf[2 + (i >> 1)], st[i & 1]);
    }
    if (tt == 0) {
#pragma unroll
        for (int i = 0; i < 16; ++i) { st[0][i] = -INFINITY; if (i < 8) st[1][i] = -INFINITY; }
    } else if (tt >= 2 * qb + 1) {
        const int kbase = (tt - 1) * 64 + 4 * h;
#pragma unroll
        for (int k2 = 0; k2 < 2; ++k2)
#pragma unroll
            for (int i = 0; i < 16; ++i) {
                const int key = kbase + k2 * 32 + (i & 3) + 8 * (i >> 2);
                if (key > qs) st[k2][i] = -INFINITY;
            }
    }
    float mx;
    {
        float t[11];
#pragma unroll
        for (int i = 0; i < 5; ++i) t[i] = max3f(st[0][3 * i], st[0][3 * i + 1], st[0][3 * i + 2]);
#pragma unroll
        for (int i = 0; i < 5; ++i) t[5 + i] = max3f(st[1][3 * i], st[1][3 * i + 1], st[1][3 * i + 2]);
        t[10] = fmaxf(st[0][15], st[1][15]);
        const float u0 = max3f(t[0], t[1], t[2]), u1 = max3f(t[3], t[4], t[5]), u2 = max3f(t[6], t[7], t[8]);
        mx = max3f(max3f(u0, u1, u2), t[9], t[10]);
    }
    mx = xor32_max(mx);
    if (tt == 0 || __builtin_amdgcn_ballot_w64(mx > 8.0f) != 0ull) {
        const float delta = tt == 0 ? mx : fmaxf(mx, 0.f);
        const float alpha = __builtin_amdgcn_exp2f(-delta);
        m += delta;
        l *= alpha;
#pragma unroll
        for (int d = 0; d < 4; ++d) O[d] = O[d] * alpha;
#pragma unroll
        for (int k2 = 0; k2 < 2; ++k2) st[k2] = st[k2] - delta;
    }
#pragma unroll
    for (int k2 = 0; k2 < 2; ++k2)
#pragma unroll
        for (int i = 0; i < 16; ++i) st[k2][i] = __builtin_amdgcn_exp2f(st[k2][i]);
    {
        const f32x16 sv = st[0] + st[1];
        const float ps = (((sv[0] + sv[1]) + (sv[2] + sv[3])) + ((sv[4] + sv[5]) + (sv[6] + sv[7]))) + (((sv[8] + sv[9]) + (sv[10] + sv[11])) + ((sv[12] + sv[13]) + (sv[14] + sv[15])));
        l += ps;
    }
#pragma unroll
    for (int k4 = 0; k4 < 4; ++k4) {
        const int k2 = k4 >> 1, o8 = 8 * (k4 & 1);
        u32x4 pk;
        pk.x = pk2(st[k2][o8 + 0], st[k2][o8 + 1]); pk.y = pk2(st[k2][o8 + 2], st[k2][o8 + 3]);
        pk.z = pk2(st[k2][o8 + 4], st[k2][o8 + 5]); pk.w = pk2(st[k2][o8 + 6], st[k2][o8 + 7]);
        pb[k4] = __builtin_bit_cast(bf16x8, pk);
    }
}
DI void attn_pv(const unsigned char* sV, int l31, int h, const bf16x8 (&pb)[4], f32x16 (&O)[4]) {
    {
        const unsigned char* vb = sV + l31 * A_VROWB + 16 * h;
        bf16x8 va[4], vc[4];
#pragma unroll
        for (int d = 0; d < 4; ++d) va[d] = *(const bf16x8*)(vb + d * 32 * A_VROWB);
        __builtin_amdgcn_sched_barrier(0);
#pragma unroll
        for (int d = 0; d < 4; ++d) vc[d] = *(const bf16x8*)(vb + d * 32 * A_VROWB + 32);
        __builtin_amdgcn_sched_barrier(0);
#pragma unroll
        for (int d = 0; d < 4; ++d) O[d] = MFMA32(va[d], pb[0], O[d]);
        __builtin_amdgcn_sched_barrier(0);
#pragma unroll
        for (int d = 0; d < 4; ++d) va[d] = *(const bf16x8*)(vb + d * 32 * A_VROWB + 64);
        __builtin_amdgcn_sched_barrier(0);
#pragma unroll
        for (int d = 0; d < 4; ++d) O[d] = MFMA32(vc[d], pb[1], O[d]);
        __builtin_amdgcn_sched_barrier(0);
#pragma unroll
        for (int d = 0; d < 4; ++d) vc[d] = *(const bf16x8*)(vb + d * 32 * A_VROWB + 96);
        __builtin_amdgcn_sched_barrier(0);
#pragma unroll
        for (int d = 0; d < 4; ++d) O[d] = MFMA32(va[d], pb[2], O[d]);
        __builtin_amdgcn_sched_barrier(0);
#pragma unroll
        for (int d = 0; d < 4; ++d) O[d] = MFMA32(vc[d], pb[3], O[d]);
    }
}

DI void attn_item(const Params& p, unsigned char* lds, int b, int hd, int qb, float lam) {
    const int tid = opaque_tid(), lane = tid & 63, wave = tid >> 6, l31 = lane & 31, h = lane >> 5;
    const int sub = wave >> 2, rt = wave & 3;
    const bf16_t* aq = (const bf16_t*)((unsigned char*)p.out + DO_AQ);
    const bf16_t* ak = (const bf16_t*)(p.ws + OFF_AK);
    const bf16_t* avT = (const bf16_t*)(p.ws + OFF_AVT);
    const bf16_t* akm = (const bf16_t*)(p.ws + OFF_AKM);
    const bf16_t* avTm = (const bf16_t*)(p.ws + OFF_AVTM);
    bf16_t* az = (bf16_t*)(p.ws + OFF_AZ);
    const int qs = qb * 128 + rt * 32 + l31;
    const size_t grow = (size_t)b * 4096 + qs;
    bf16x8 qf[4];
#pragma unroll
    for (int ks = 0; ks < 4; ++ks) qf[ks] = *(const bf16x8*)(aq + grow * 1024 + hd * 128 + sub * 64 + ks * 16 + 8 * h);
    f32x16 O[4];
#pragma unroll
    for (int d = 0; d < 4; ++d)
#pragma unroll
        for (int i = 0; i < 16; ++i) O[d][i] = 0.f;
    float m = 0.f, l = 0.f;
    const int T = 2 * qb + 3;
    u32x4 k0r[2], v0r[2];
    const int krow_ = tid >> 4, kc_ = tid & 15, vdv_ = tid >> 3, vc_ = tid & 7;
    const bf16_t* kp = ak + ((size_t)b * 4096 + krow_) * 1024 + hd * 128 + kc_ * 8;
    const bf16_t* vp_ = avT + ((size_t)(b * 8 + hd) * 128 + vdv_) * 4096 + vc_ * 8;
#define A_LOAD_REAL(KR, VR)                                                                                                   \
    {                                                                                                                         \
        KR[0] = *(const u32x4*)kp; KR[1] = *(const u32x4*)(kp + 32 * 1024); kp += 64 * 1024;                                  \
        VR[0] = *(const u32x4*)vp_; VR[1] = *(const u32x4*)(vp_ + (size_t)64 * 4096); vp_ += 64;                              \
    }
#define A_STORE(KR, VR, buf_)                                                                                                 \
    {                                                                                                                         \
        unsigned char* sK_ = lds + (buf_) * A_STAGE; unsigned char* sV_ = sK_ + A_KB;                                         \
        _Pragma("unroll") for (int i = 0; i < 2; ++i) { const int pi = tid + 512 * i, row = pi >> 4, c = pi & 15;              \
            *(u32x4*)(sK_ + row * A_KROWB + c * 16) = KR[i]; }                                                                \
        _Pragma("unroll") for (int i = 0; i < 2; ++i) { const int pi = tid + 512 * i, dv = pi >> 3, c = pi & 7;                \
            unsigned char* d_ = sV_ + dv * A_VROWB + (c >> 1) * 32 + 8 * (c & 1); u32x2 a_, b_; a_.x = VR[i].x; a_.y = VR[i].y; b_.x = VR[i].z; b_.y = VR[i].w; \
            *(u32x2*)d_ = a_; *(u32x2*)(d_ + 16) = b_; }                                                                      \
    }
    {
        const bf16_t* km_ = akm + (size_t)krow_ * 1024 + hd * 128 + kc_ * 8;
        k0r[0] = *(const u32x4*)km_; k0r[1] = *(const u32x4*)(km_ + 32 * 1024);
        const bf16_t* vm_ = avTm + (size_t)(hd * 128 + vdv_) * 64 + vc_ * 8;
        v0r[0] = *(const u32x4*)vm_; v0r[1] = *(const u32x4*)(vm_ + 64 * 64);
    }
    u32x4 k1r[2], v1r[2];
    A_LOAD_REAL(k1r, v1r);
#pragma unroll
    for (int ks = 0; ks < 4; ++ks) asm volatile("" : "+v"(qf[ks]));
    A_STORE(k0r, v0r, 0);
    __syncthreads();
    bf16x8 pb[4];
    int bc = 0, bp = 2, bn = 1;
    {
        attn_s(lds + bc * A_STAGE, 0, qb, qs, sub, l31, h, qf, O, m, l, pb);
        attn_pv(lds + bc * A_STAGE + A_KB, l31, h, pb, O);
        A_STORE(k1r, v1r, bn);
        __syncthreads();
        bp = bc; bc = bn; bn = (bn == 2) ? 0 : bn + 1;
    }
    for (int tt = 1; tt < T; ++tt) {
        if (tt + 1 < T) A_LOAD_REAL(k0r, v0r);
        attn_s(lds + bc * A_STAGE, tt, qb, qs, sub, l31, h, qf, O, m, l, pb);
        attn_pv(lds + bc * A_STAGE + A_KB, l31, h, pb, O);
        if (tt + 1 < T) A_STORE(k0r, v0r, bn);
        __syncthreads();
        bp = bc; bc = bn; bn = (bn == 2) ? 0 : bn + 1;
    }

#undef A_LOAD_REAL
#undef A_STORE
    const float ltot = xor32_sum(l);
    const float linv = 1.0f / ltot;
    u32x2 zz[4][4];
    if (sub == 0) {
#pragma unroll
        for (int d = 0; d < 4; ++d)
#pragma unroll
            for (int g = 0; g < 4; ++g) zz[d][g] = *(const u32x2*)(az + grow * 1024 + hd * 128 + d * 32 + 8 * g + 4 * h);
    }
    float* ex = (float*)lds;
    if (sub == 1) {
#pragma unroll
        for (int d = 0; d < 4; ++d) {
#pragma unroll
            for (int g = 0; g < 4; ++g) {
                f32x4 t; t.x = O[d][4 * g] * linv; t.y = O[d][4 * g + 1] * linv; t.z = O[d][4 * g + 2] * linv; t.w = O[d][4 * g + 3] * linv;
                *(f32x4*)(ex + (rt * 32 + l31) * 132 + d * 32 + 8 * g + 4 * h) = t;
            }
            __builtin_amdgcn_sched_barrier(0);
        }
    }
    __syncthreads();
    if (sub == 0) {
        float ss = 0.f;
#pragma unroll
        for (int d = 0; d < 4; ++d) {
#pragma unroll
            for (int g = 0; g < 4; ++g) {
                const f32x4 t = *(const f32x4*)(ex + (rt * 32 + l31) * 132 + d * 32 + 8 * g + 4 * h);
                const float o0 = O[d][4 * g] * linv - lam * t.x, o1 = O[d][4 * g + 1] * linv - lam * t.y;
                const float o2 = O[d][4 * g + 2] * linv - lam * t.z, o3 = O[d][4 * g + 3] * linv - lam * t.w;
                O[d][4 * g] = o0; O[d][4 * g + 1] = o1; O[d][4 * g + 2] = o2; O[d][4 * g + 3] = o3;
                ss += (o0 * o0 + o1 * o1) + (o2 * o2 + o3 * o3);
            }
            __builtin_amdgcn_sched_barrier(0);
        }
        ss = xor32_sum(ss);
        const float rstd = 1.0f / sqrtf(ss * (1.0f / 128.0f) + EPS);
#pragma unroll
        for (int d = 0; d < 4; ++d)
#pragma unroll
            for (int g = 0; g < 4; ++g) {
                bf16_t* zp = az + grow * 1024 + hd * 128 + d * 32 + 8 * g + 4 * h;
                const u32x2 z2 = zz[d][g];
                u32x2 o;
                o.x = pk2(O[d][4 * g] * rstd * siluf_(bflo(z2.x)), O[d][4 * g + 1] * rstd * siluf_(bfhi(z2.x)));
                o.y = pk2(O[d][4 * g + 2] * rstd * siluf_(bflo(z2.y)), O[d][4 * g + 3] * rstd * siluf_(bfhi(z2.y)));
                *(u32x2*)zp = o;
                if (g == 3) __builtin_amdgcn_sched_barrier(0);
            }
    }
    __syncthreads();
}

constexpr int L_KROWB = 272, L_VROWB = 144, L_SROWB = 272;
constexpr int GLA_DL = 2;
#define L_BAR() { asm volatile("s_waitcnt lgkmcnt(0)" ::: "memory"); __builtin_amdgcn_s_barrier(); asm volatile("" ::: "memory"); }
template <int DL>
DI void gla_item(const Params& p, unsigned char* lds, int b, int hh, int sl) {
    constexpr int SLW = 32 * DL, NVP = SLW / 64;
    constexpr int L_K = 0, L_V = 64 * L_KROWB, L_S = L_V + SLW * L_VROWB, L_KT = L_S + SLW * L_SROWB;
    const int tid = opaque_tid(), lane = tid & 63, wave = tid >> 6, l15 = lane & 15, g = lane >> 4;
    const int tt = wave & 3, dvt = wave >> 2;
    unsigned char* ws = p.ws;
    unsigned char* dout = (unsigned char*)p.out;
    const bf16_t* gq = (const bf16_t*)(dout + DO_GQ);
    const bf16_t* gk = (const bf16_t*)(dout + DO_GK);
    const bf16_t* gvT = (const bf16_t*)(ws + OFF_GVT);
    const bf16_t* ktt = (const bf16_t*)(ws + OFF_WIN_T);
    const float* dec = (const float*)(ws + OFF_DEC);
    bf16_t* gz = (bf16_t*)(ws + OFF_GZ);
    float* ssqb = (float*)(ws + OFF_SSQB);
    unsigned char* sK = lds + L_K; unsigned char* sV = lds + L_V; unsigned char* sS = lds + L_S; unsigned char* sKT = lds + L_KT;
    for (int i = tid; i < SLW * L_SROWB / 4; i += 512) ((unsigned*)sS)[i] = 0u;
    f32x4 sacc[DL][2];
#pragma unroll
    for (int dl = 0; dl < DL; ++dl)
#pragma unroll
        for (int c = 0; c < 2; ++c) sacc[dl][c] = (f32x4){0.f, 0.f, 0.f, 0.f};
    u32x4 nkA[2]; u32x4 nvA[NVP]; bf16x8 nqA[4]; u32x4 nktA[2]; float ndA[2]; u32x2 ngzA[DL];
    u32x4 nkB[2]; u32x4 nvB[NVP]; bf16x8 nqB[4]; u32x4 nktB[2]; float ndB[2]; u32x2 ngzB[DL];
    const int cc0 = 16 * (2 * tt) + l15;
    const int dv0 = 16 * (dvt * DL);
    const int krow_ = tid >> 4, kc_ = tid & 15, vdv_ = tid >> 3, vc_ = tid & 7;
    const bf16_t* kp = gk + ((size_t)b * 4096 + krow_) * 512 + hh * 128 + kc_ * 8;
    const bf16_t* vp_ = gvT + ((size_t)(b * 4 + hh) * 256 + sl * SLW + vdv_) * 4096 + vc_ * 8;
    const bf16_t* ktp = ktt + ((size_t)(b * 4 + hh) * 128 + vdv_) * 4096 + vc_ * 8;
    const float* dp = dec + (size_t)b * 64 * 512 + hh * 128 + cc0;
    const bf16_t* qp = gq + ((size_t)b * 4096 + 16 * tt + l15) * 512 + hh * 128 + 8 * g;
    bf16_t* gzp = gz + ((size_t)b * 4096 + 16 * tt + l15) * 1024 + hh * 256 + sl * SLW + dv0 + 4 * g;
#define L_LOAD_META(S)                                                                                                         \
    {                                                                                                                         \
        const bf16_t* km_ = (const bf16_t*)(ws + OFF_KTM) + (size_t)krow_ * 512 + hh * 128 + kc_ * 8;                         \
        nk##S[0] = *(const u32x4*)km_; nk##S[1] = *(const u32x4*)(km_ + 32 * 512);                                                  \
        _Pragma("unroll") for (int i = 0; i < NVP; ++i)                                                                       \
            nv##S[i] = *(const u32x4*)((const bf16_t*)(ws + OFF_GVTM) + (size_t)(hh * 256 + sl * SLW + vdv_ + 64 * i) * 64 + vc_ * 8); \
        _Pragma("unroll") for (int i = 0; i < 2; ++i)                                                                         \
            nkt##S[i] = *(const u32x4*)((const bf16_t*)(ws + OFF_KTTM) + (size_t)(hh * 128 + vdv_ + 64 * i) * 64 + vc_ * 8);     \
        _Pragma("unroll") for (int ct = 0; ct < 2; ++ct) nd##S[ct] = ((const float*)(ws + OFF_DECM))[hh * 128 + cc0 + 16 * ct];  \
        _Pragma("unroll") for (int ks = 0; ks < 4; ++ks) nq##S[ks] = (bf16x8){0, 0, 0, 0, 0, 0, 0, 0};                           \
        _Pragma("unroll") for (int dl = 0; dl < DL; ++dl) ngz##S[dl] = (u32x2){0u, 0u};                                          \
    }
#define L_LOAD_REAL(S)                                                                                                         \
    {                                                                                                                         \
        nk##S[0] = *(const u32x4*)kp; nk##S[1] = *(const u32x4*)(kp + 32 * 512); kp += 64 * 512;                                    \
        _Pragma("unroll") for (int i = 0; i < NVP; ++i) nv##S[i] = *(const u32x4*)(vp_ + (size_t)(64 * i) * 4096);               \
        vp_ += 64;                                                                                                            \
        _Pragma("unroll") for (int i = 0; i < 2; ++i) nkt##S[i] = *(const u32x4*)(ktp + (size_t)(64 * i) * 4096);              \
        ktp += 64;                                                                                                            \
        nd##S[0] = dp[0]; nd##S[1] = dp[16]; dp += 512;                                                                             \
        _Pragma("unroll") for (int ks = 0; ks < 4; ++ks) nq##S[ks] = *(const bf16x8*)(qp + 32 * ks);                             \
        qp += 64 * 512;                                                                                                       \
        _Pragma("unroll") for (int dl = 0; dl < DL; ++dl) ngz##S[dl] = *(const u32x2*)(gzp + 16 * dl);                           \
        gzp += 64 * 1024;                                                                                                     \
    }
#define L_STORE(S)                                                                                                             \
    {                                                                                                                         \
        _Pragma("unroll") for (int i = 0; i < 2; ++i) { const int pi = tid + 512 * i, row = pi >> 4, c = pi & 15;              \
            *(u32x4*)(sK + row * L_KROWB + c * 16) = nk##S[i]; }                                                                 \
        _Pragma("unroll") for (int i = 0; i < NVP; ++i) *(u32x4*)(sV + (vdv_ + 64 * i) * L_VROWB + vc_ * 16) = nv##S[i];          \
        _Pragma("unroll") for (int i = 0; i < 2; ++i) *(u32x4*)(sKT + (vdv_ + 64 * i) * L_VROWB + vc_ * 16) = nkt##S[i];          \
    }
    L_LOAD_META(A);
    L_LOAD_REAL(B);
    L_STORE(A);
#define GLA_STEP(n_, C, O) {                                                                                         \
        bf16x8 cq[4]; float cd[2]; u32x2 cgz[DL]; \
_Pragma("unroll") \
        for (int ks = 0; ks < 4; ++ks) cq[ks] = nq##C[ks]; \
_Pragma("unroll") \
        for (int ct = 0; ct < 2; ++ct) { cd[ct] = nd##C[ct]; } \
_Pragma("unroll") \
        for (int dl = 0; dl < DL; ++dl) cgz[dl] = ngz##C[dl]; \
_Pragma("unroll") \
        for (int ks = 0; ks < 4; ++ks) asm volatile("" : "+v"(cq[ks])); \
_Pragma("unroll") \
        for (int ct = 0; ct < 2; ++ct) { asm volatile("" : "+v"(cd[ct])); } \
_Pragma("unroll") \
        for (int dl = 0; dl < DL; ++dl) asm volatile("" : "+v"(cgz[dl])); \
        L_BAR(); \
        if ((n_) + 2 <= 64) L_LOAD_REAL(C); \
        if ((n_) > 0) { \
            f32x4 at[4]; \
_Pragma("unroll") \
            for (int jt = 0; jt < 4; ++jt) at[jt] = (f32x4){0.f, 0.f, 0.f, 0.f}; \
            { \
                const unsigned char* kb = sK + l15 * L_KROWB + 16 * g; \
                bf16x8 ka[8], kc[8]; \
_Pragma("unroll") \
                for (int i = 0; i < 8; ++i) ka[i] = *(const bf16x8*)(kb + (i & 3) * 16 * L_KROWB + (i >> 2) * 64); \
                __builtin_amdgcn_sched_barrier(0); \
_Pragma("unroll") \
                for (int i = 0; i < 8; ++i) kc[i] = *(const bf16x8*)(kb + (i & 3) * 16 * L_KROWB + (2 + (i >> 2)) * 64); \
                __builtin_amdgcn_sched_barrier(0); \
_Pragma("unroll") \
                for (int i = 0; i < 8; ++i) at[i & 3] = MFMA16(ka[i], cq[i >> 2], at[i & 3]); \
                __builtin_amdgcn_sched_barrier(0); \
_Pragma("unroll") \
                for (int i = 0; i < 8; ++i) at[i & 3] = MFMA16(kc[i], cq[2 + (i >> 2)], at[i & 3]); \
            } \
            const int tl = 16 * tt + l15; \
_Pragma("unroll") \
            for (int jt = 0; jt < 4; ++jt) \
_Pragma("unroll") \
                for (int i = 0; i < 4; ++i) if (16 * jt + 4 * g + i > tl) at[jt][i] = 0.f; \
            bf16x8 pa[2]; \
_Pragma("unroll") \
            for (int s2 = 0; s2 < 2; ++s2) { \
                u32x4 t; \
                t.x = pk2(at[2 * s2][0], at[2 * s2][1]); t.y = pk2(at[2 * s2][2], at[2 * s2][3]); \
                t.z = pk2(at[2 * s2 + 1][0], at[2 * s2 + 1][1]); t.w = pk2(at[2 * s2 + 1][2], at[2 * s2 + 1][3]); \
                pa[s2] = __builtin_bit_cast(bf16x8, t); \
            } \
            const size_t row = (size_t)b * 4096 + ((n_) - 1) * 64 + 16 * tt + l15; \
_Pragma("unroll") \
            for (int dl = 0; dl < DL; ++dl) { \
                const int dvr = dv0 + 16 * dl + l15; \
                f32x4 o = (f32x4){0.f, 0.f, 0.f, 0.f}; \
                { \
                    u32x4 vv[2]; bf16x8 sf[4]; \
_Pragma("unroll") \
                    for (int s2 = 0; s2 < 2; ++s2) { \
                        const unsigned char* vp = sV + dvr * L_VROWB + (32 * s2 + 4 * g) * 2; \
                        const u32x2 lo = *(const u32x2*)vp, hi = *(const u32x2*)(vp + 32); \
                        vv[s2].x = lo.x; vv[s2].y = lo.y; vv[s2].z = hi.x; vv[s2].w = hi.y; \
                    } \
_Pragma("unroll") \
                    for (int ks = 0; ks < 4; ++ks) sf[ks] = *(const bf16x8*)(sS + dvr * L_SROWB + (ks * 32 + 8 * g) * 2); \
                    __builtin_amdgcn_sched_barrier(0); \
                    f32x4 o2 = (f32x4){0.f, 0.f, 0.f, 0.f}; \
                    o = MFMA16(__builtin_bit_cast(bf16x8, vv[0]), pa[0], o); \
                    o2 = MFMA16(sf[0], cq[0], o2); \
                    o = MFMA16(__builtin_bit_cast(bf16x8, vv[1]), pa[1], o); \
                    o2 = MFMA16(sf[1], cq[1], o2); \
                    o = MFMA16(sf[2], cq[2], o); \
                    o2 = MFMA16(sf[3], cq[3], o2); \
                    o = o + o2; \
                } \
                float ss = (o[0] * o[0] + o[1] * o[1]) + (o[2] * o[2] + o[3] * o[3]); \
                ss = xor16_sum(ss); ss = xor32_sum(ss); \
                u32x2 ov; \
                ov.x = pk2(o[0] * siluf_(bflo(cgz[dl].x)), o[1] * siluf_(bfhi(cgz[dl].x))); \
                ov.y = pk2(o[2] * siluf_(bflo(cgz[dl].y)), o[3] * siluf_(bfhi(cgz[dl].y))); \
                *(u32x2*)(gz + row * 1024 + hh * 256 + sl * SLW + dv0 + 16 * dl + 4 * g) = ov; \
                if (g == 0) ssqb[(row * 4 + hh) * 16 + sl * 2 * DL + dvt * DL + dl] = ss; \
            } \
        } \
        bf16x8 vfs[DL][2]; \
_Pragma("unroll") \
        for (int dl = 0; dl < DL; ++dl) \
_Pragma("unroll") \
            for (int ks = 0; ks < 2; ++ks) vfs[dl][ks] = *(const bf16x8*)(sV + (dv0 + 16 * dl + l15) * L_VROWB + (32 * ks + 8 * g) * 2); \
        bf16x8 ckt[2][2]; \
        _Pragma("unroll") \
        for (int ct = 0; ct < 2; ++ct) \
        _Pragma("unroll") \
            for (int ks = 0; ks < 2; ++ks) ckt[ct][ks] = *(const bf16x8*)(sKT + (cc0 + 16 * ct) * L_VROWB + (32 * ks + 8 * g) * 2); \
        __builtin_amdgcn_sched_barrier(0); \
_Pragma("unroll") \
        for (int dl = 0; dl < DL; ++dl) { \
_Pragma("unroll") \
            for (int ks = 0; ks < 2; ++ks) { \
                sacc[dl][0] = MFMA16(vfs[dl][ks], ckt[0][ks], sacc[dl][0]); \
                sacc[dl][1] = MFMA16(vfs[dl][ks], ckt[1][ks], sacc[dl][1]); \
            } \
_Pragma("unroll") \
            for (int ct = 0; ct < 2; ++ct) \
_Pragma("unroll") \
                for (int i = 0; i < 4; ++i) sacc[dl][ct][i] *= cd[ct]; \
        } \
        L_BAR(); \
_Pragma("unroll") \
        for (int dl = 0; dl < DL; ++dl) \
_Pragma("unroll") \
            for (int ct = 0; ct < 2; ++ct) \
_Pragma("unroll") \
                for (int i = 0; i < 4; ++i) \
                    *(bf16_t*)(sS + (dv0 + 16 * dl + 4 * g + i) * L_SROWB + (cc0 + 16 * ct) * 2) = f2bf(sacc[dl][ct][i]); \
        if ((n_) + 1 <= 64) L_STORE(O); \
    }
    for (int n2 = 0; n2 <= 64; n2 += 2) {
        GLA_STEP(n2, A, B);
        if (n2 + 1 > 64) break;
        GLA_STEP(n2 + 1, B, A);
    }
#undef GLA_STEP
#undef L_LOAD_META
#undef L_LOAD_REAL
#undef L_STORE
    __syncthreads();
}

DI void phase2(const Params& p, unsigned char* lds) {
    const int tid = opaque_tid();
    float lam;
    {
        const int lane = tid & 63;
        const float a_ = wave_sum(p.lq1[lane] * p.lk1[lane]);
        const float b_ = wave_sum(p.lq2[lane] * p.lk2[lane]);
        lam = __uint_as_float((unsigned)__builtin_amdgcn_readfirstlane((int)__float_as_uint(expf(a_) - expf(b_) + 0.2f)));
    }
    volatile unsigned* sItem = (volatile unsigned*)(lds + LDS_ITEM);
    constexpr unsigned NSL = 8 / GLA_DL, N_GLA = 2 * NSL, N_ATT = 128;
    if (tid == 0) sItem[1] = 0u;
    for (;;) {
        if (tid == 0) {
            unsigned* heads = (unsigned*)(p.ws + OFF_XBAR + 15360);
            const unsigned x0 = (unsigned)__builtin_amdgcn_s_getreg((3 << 11) | 20) & 7u;
            unsigned k = sItem[1], it = 0xffffffffu;
            while (k < 8u) {
                const unsigned x = (x0 + k) & 7u;
                const unsigned got = atomicAdd(heads + x, 1u);
                if (got < N_GLA + N_ATT) { it = got | (x << 16); break; }
                ++k;
            }
            sItem[1] = k; sItem[0] = it;
        }
        __syncthreads();
        const unsigned item = (unsigned)__builtin_amdgcn_readfirstlane((int)sItem[0]);
        __syncthreads();
        if (item == 0xffffffffu) break;
        const unsigned x = item >> 16, idx = item & 0xffffu;
        if (idx < N_GLA) { const unsigned gi = x * N_GLA + idx; gla_item<GLA_DL>(p, lds, gi / (4 * NSL), (gi / NSL) & 3, gi % NSL); }
        else { const unsigned a = idx - N_GLA, pair = 4 * x + ((a >> 2) & 3); attn_item(p, lds, pair & 3, pair >> 2, 31 - (int)(((a >> 4) << 2) + (a & 3)), lam); }
    }
}

DI void phase25(const Params& p, unsigned char* lds) {
    const int tid = opaque_tid(), lane = tid & 63, wave = tid >> 6;
    const float* ssqb = (const float*)(p.ws + OFF_SSQB);
    bf16_t* gz = (bf16_t*)(p.ws + OFF_GZ);
    for (int it = blockIdx.x; it < MROWS / 32; it += gridDim.x) {
        const size_t row0 = (size_t)it * 32 + wave * 4;
        u32x4 u[4][2]; float s[4];
#pragma unroll
        for (int q = 0; q < 4; ++q) {
            const u32x4* ptr = (const u32x4*)(gz + (row0 + q) * 1024 + lane * 16);
            u[q][0] = ptr[0]; u[q][1] = ptr[1];
            s[q] = ssqb[((row0 + q) * 4 + (lane >> 4)) * 16 + (lane & 15)];
        }
#pragma unroll
        for (int q = 0; q < 4; ++q) {
            float t = s[q];
            t += __shfl_xor(t, 1); t += __shfl_xor(t, 2); t += __shfl_xor(t, 4); t += __shfl_xor(t, 8);
            const float r = 1.0f / sqrtf(t * (1.0f / 256.0f) + EPS);
            u32x4* ptr = (u32x4*)(gz + (row0 + q) * 1024 + lane * 16);
#pragma unroll
            for (int j = 0; j < 2; ++j) {
                const u32x4 a = u[q][j]; u32x4 o;
                o.x = pk2(bflo(a.x) * r, bfhi(a.x) * r); o.y = pk2(bflo(a.y) * r, bfhi(a.y) * r);
                o.z = pk2(bflo(a.z) * r, bfhi(a.z) * r); o.w = pk2(bflo(a.w) * r, bfhi(a.w) * r);
                ptr[j] = o;
            }
        }
    }
}

template <int PASS>
struct EpiMerge {
    static constexpr bool PERM = false, AFTER_DRAIN = false;
    unsigned char* ws; const PG8_LAS float* tab;
    DI void operator()(const pg8::f32x4 (&acc)[2][2][4][2], const pg8::Unit& u, int wr, int wc, int fr, int fq) const {
        const unsigned char* sg = ws + (PASS == 0 ? OFF_SGB : OFF_SGA);
        bf16_t* merged = (bf16_t*)(ws + OFF_AK);
#pragma unroll
        for (int ai = 0; ai < 2; ++ai)
#pragma unroll
            for (int m = 0; m < 4; ++m) {
                const size_t tok = (size_t)u.pm * 256 + ai * 128 + wr * 64 + m * 16 + fr;
#pragma unroll
                for (int bj = 0; bj < 2; ++bj)
#pragma unroll
                    for (int n = 0; n < 2; ++n) {
                        const size_t off = tok * 1024 + u.pn * 256 + bj * 128 + wc * 32 + n * 16 + 4 * fq;
                        const unsigned ug = *(const unsigned*)(sg + off);
                        const float q = (PASS == 0 ? tab[(ai * 128 + wr * 64 + m * 16 + fr) * 4 + 3] : 1.0f) * (1.0f / 255.0f);
                        float m0 = (float)(ug & 255u) * q * acc[ai][bj][m][n][0], m1 = (float)((ug >> 8) & 255u) * q * acc[ai][bj][m][n][1];
                        float m2 = (float)((ug >> 16) & 255u) * q * acc[ai][bj][m][n][2], m3 = (float)(ug >> 24) * q * acc[ai][bj][m][n][3];
                        if (PASS == 1) { const u32x2 t = *(const u32x2*)(merged + off); m0 += bflo(t.x); m1 += bfhi(t.x); m2 += bflo(t.y); m3 += bfhi(t.y); }
                        u32x2 o; o.x = pk2(m0, m1); o.y = pk2(m2, m3);
                        *(u32x2*)(merged + off) = o;
                    }
            }
    }
};
struct EpiOut {
    static constexpr bool PERM = false, AFTER_DRAIN = true;
    unsigned char* ws; const float* x; float* out; const float* fw;
    DI void fused(pg8::f32x4 (&acc)[2][2][4][2], const pg8::Unit& u, int wr, int wc, int fr, int fq, PG8_LAS unsigned char* lds, int wid, int lane) const {
        float* ssqh = (float*)(ws + OFF_SSQH);
        unsigned* pcnt = (unsigned*)(ws + OFF_XBAR + 14336) + u.pm;
#pragma unroll
        for (int ai = 0; ai < 2; ++ai)
#pragma unroll
            for (int m = 0; m < 4; ++m) {
                const size_t tok = (size_t)u.pm * 256 + ai * 128 + wr * 64 + m * 16 + fr;
                float ss = 0.f;
#pragma unroll
                for (int bj = 0; bj < 2; ++bj)
#pragma unroll
                    for (int n = 0; n < 2; ++n) {
                        const size_t off = tok * 1024 + u.pn * 256 + bj * 128 + wc * 32 + n * 16 + 4 * fq;
                        const f32x4 xv = *(const f32x4*)(x + off);
                        f32x4 o = acc[ai][bj][m][n];
                        o.x += xv.x; o.y += xv.y; o.z += xv.z; o.w += xv.w;
                        acc[ai][bj][m][n] = o;
                        ss += (o.x * o.x + o.y * o.y) + (o.z * o.z + o.w * o.w);
                    }
                ss = xor16_sum(ss); ss = xor32_sum(ss);
                if (fq == 0) ssqh[tok * 16 + u.pn * 4 + wc] = ss;
            }
        asm volatile("s_waitcnt vmcnt(0)" ::: "memory");
        __syncthreads();
        if (threadIdx.x == 0) {
            __builtin_amdgcn_fence(__ATOMIC_RELEASE, "agent");
            asm volatile("s_waitcnt vmcnt(0)" ::: "memory");
            __hip_atomic_fetch_add(pcnt, 1u, __ATOMIC_RELAXED, __HIP_MEMORY_SCOPE_AGENT);
            unsigned spins = 0u;
            while (__hip_atomic_load(pcnt, __ATOMIC_RELAXED, __HIP_MEMORY_SCOPE_AGENT) < 4u && ++spins < (1u << 22)) __builtin_amdgcn_s_sleep(1);
            __builtin_amdgcn_fence(__ATOMIC_ACQUIRE, "agent");
            asm volatile("s_waitcnt vmcnt(0)" ::: "memory");
        }
        __syncthreads();
#pragma unroll
        for (int ai = 0; ai < 2; ++ai)
#pragma unroll
            for (int m = 0; m < 4; ++m) {
                const size_t tok = (size_t)u.pm * 256 + ai * 128 + wr * 64 + m * 16 + fr;
                const f32x4* sp = (const f32x4*)(ssqh + tok * 16);
                const f32x4 a = sp[0], b2 = sp[1], c = sp[2], d = sp[3];
                const float s = ((a.x + a.y) + (a.z + a.w)) + ((b2.x + b2.y) + (b2.z + b2.w)) + ((c.x + c.y) + (c.z + c.w)) + ((d.x + d.y) + (d.z + d.w));
                const float rstd = 1.0f / sqrtf(s * (1.0f / 1024.0f) + EPS);
#pragma unroll
                for (int bj = 0; bj < 2; ++bj)
#pragma unroll
                    for (int n = 0; n < 2; ++n) {
                        const int col = u.pn * 256 + bj * 128 + wc * 32 + n * 16 + 4 * fq;
                        const f32x4 w = *(const f32x4*)(fw + col);
                        f32x4 o = acc[ai][bj][m][n];
                        o.x = o.x * rstd * w.x; o.y = o.y * rstd * w.y; o.z = o.z * rstd * w.z; o.w = o.w * rstd * w.w;
                        __builtin_nontemporal_store(o, (f32x4*)(out + tok * 1024 + col));
                    }
            }
    }
};
DI void phase3(const Params& p, unsigned char* lds) {
    SchedSq S;
    {
        pg8::Unit u0; S.next(0, u0);
        const int tid = opaque_tid();
        float* tabw = (float*)(lds + 147456);
        if (tid < 256) {
            const float* sp = (const float*)(p.ws + OFF_SSQB) + ((size_t)u0.pm * 256 + tid) * 64;
            float r[4];
#pragma unroll
            for (int hh = 0; hh < 4; ++hh) {
                const f32x4 a = *(const f32x4*)(sp + hh * 16), b2 = *(const f32x4*)(sp + hh * 16 + 4), c = *(const f32x4*)(sp + hh * 16 + 8), d = *(const f32x4*)(sp + hh * 16 + 12);
                const float s = ((a.x + a.y) + (a.z + a.w)) + ((b2.x + b2.y) + (b2.z + b2.w)) + ((c.x + c.y) + (c.z + c.w)) + ((d.x + d.y) + (d.z + d.w));
                r[hh] = 1.0f / sqrtf(s * (1.0f / 256.0f) + EPS);
            }
            f32x4 o; o.x = r[0] / r[1]; o.y = r[1] / r[2]; o.z = r[2] / r[3]; o.w = r[3];
            *(f32x4*)(tabw + tid * 4) = o;
        }
        __syncthreads();
    }
    {
        pg8::Gemm g; g.A = (const bf16_t*)(p.ws + OFF_GZ); g.Bt = (const bf16_t*)(p.ws + OFF_WB_T); g.M = MROWS; g.N = 1024; g.K = 1024;
        EpiMerge<0> E; E.ws = p.ws; E.tab = (const PG8_LAS float*)(lds + 147456);
        pg8::gemm_phase<EpiMerge<0>, SchedSq, true, true, true>((PG8_LAS unsigned char*)lds, g, S, E);
    }
    {
        pg8::Gemm g; g.A = (const bf16_t*)(p.ws + OFF_AZ); g.Bt = (const bf16_t*)(p.ws + OFF_WA_T); g.M = MROWS; g.N = 1024; g.K = 1024;
        EpiMerge<1> E; E.ws = p.ws; E.tab = (const PG8_LAS float*)(lds + 147456);
        pg8::gemm_phase<EpiMerge<1>, SchedSq, true, true>((PG8_LAS unsigned char*)lds, g, S, E);
    }
}
DI void phase4(const Params& p, unsigned char* lds) {
    SchedSq S;
    pg8::Gemm g; g.A = (const bf16_t*)(p.ws + OFF_AK); g.Bt = (const bf16_t*)(p.ws + OFF_WO_T); g.M = MROWS; g.N = 1024; g.K = 1024;
    EpiOut E; E.ws = p.ws; E.x = p.x; E.out = p.out; E.fw = p.final_w;
    pg8::gemm_phase<EpiOut, SchedSq, false, true>((PG8_LAS unsigned char*)lds, g, S, E);
}

DI void phase5(const Params& p, unsigned char* lds) {
    const int tid = opaque_tid(), lane = tid & 63, wave = tid >> 6;
    const float* ssqh = (const float*)(p.ws + OFF_SSQH);
    for (int it = blockIdx.x; it < MROWS / 8; it += gridDim.x) {
        const size_t row = (size_t)it * 8 + wave;
        float s = lane < 16 ? ssqh[row * 16 + lane] : 0.f;
        s = wave_sum(s);
        const float rstd = 1.0f / sqrtf(s * (1.0f / 1024.0f) + EPS);
        f32x4* orow = (f32x4*)(p.out + row * 1024) + lane;
        const f32x4* wrow = (const f32x4*)p.final_w + lane;
#pragma unroll
        for (int j = 0; j < 4; ++j) {
            f32x4 v = orow[64 * j]; const f32x4 w = wrow[64 * j];
            v.x = v.x * rstd * w.x; v.y = v.y * rstd * w.y; v.z = v.z * rstd * w.z; v.w = v.w * rstd * w.w;
            orow[64 * j] = v;
        }
    }
}

#define XB_TMO      128
#define XB_XCNT(j)  (256  + 64 * (j))
#define XB_XSUB(j)  (1280 + 64 * (j))
#define XB_XGEN(j)  (2304 + 64 * (j))
#define XB_TOP      3328
#define XB_TOPGEN   3392
#define XCD_BAR_WORDS 3456
#define XB_SPIN_CAP (1u << 18)
#define LAS __attribute__((address_space(3)))
DI unsigned xb_ld(unsigned* p)              { return __hip_atomic_load(p, __ATOMIC_RELAXED, __HIP_MEMORY_SCOPE_AGENT); }
DI unsigned xb_add(unsigned* p, unsigned v) { return __hip_atomic_fetch_add(p, v, __ATOMIC_RELAXED, __HIP_MEMORY_SCOPE_AGENT); }
DI unsigned xb_xcc_id() { return (unsigned)__builtin_amdgcn_s_getreg((3 << 11) | 20) & 0xFu; }
#define XB_SPIN(cond, bar) do { unsigned _sp = 0; while (cond) { __builtin_amdgcn_s_sleep(1); \
    if ((++_sp & 255u) == 0u) { if (xb_ld(&(bar)[XB_TMO])) break; if (_sp > XB_SPIN_CAP) { atomicAdd(&(bar)[XB_TMO], 1u); break; } } } } while (0)
struct XcdBarrier { unsigned* bar; unsigned x; volatile LAS unsigned* st; };
DI XcdBarrier xcd_barrier_post(unsigned* bar, volatile LAS unsigned* st) {
    XcdBarrier b; b.bar = bar; b.x = xb_xcc_id(); b.st = st;
    if (threadIdx.x == 0) (void)xb_add(&bar[XB_XCNT(b.x)], 1u);
    return b;
}
DI void xcd_barrier_complete(unsigned* bar, unsigned x, unsigned& nloc, unsigned& nx) {
    const unsigned G = gridDim.x * gridDim.y * gridDim.z;
    unsigned sum, cnt, mine, sp = 0u;
    for (;;) {
        sum = 0u; cnt = 0u; mine = 0u;
#pragma unroll
        for (unsigned j = 0; j < 16; ++j) { const unsigned c = xb_ld(&bar[XB_XCNT(j)]); sum += c; cnt += (c > 0u) ? 1u : 0u; mine = (j == x) ? c : mine; }
        if (sum == G) break;
        __builtin_amdgcn_s_sleep(1);
        if ((++sp & 255u) == 0u) { if (xb_ld(&bar[XB_TMO])) break; if (sp > XB_SPIN_CAP) { atomicAdd(&bar[XB_TMO], 1u); break; } }
    }
    nloc = mine > 0u ? mine : 1u; nx = cnt > 0u ? cnt : 1u;
}
DI void xcd_barrier(const XcdBarrier& b) {
    asm volatile("s_waitcnt vmcnt(0)" ::: "memory");
    __syncthreads();
    if (threadIdx.x == 0) {
        unsigned* bar = b.bar;
        __builtin_amdgcn_s_waitcnt(0);
        unsigned nloc = b.st[0], nx = b.st[1];
        if (nloc == 0u) { xcd_barrier_complete(bar, b.x, nloc, nx); b.st[0] = nloc; b.st[1] = nx; }
        const unsigned old = xb_add(&bar[XB_XSUB(b.x)], 1u);
        const unsigned gen = old / nloc;
        if (old + 1u == (gen + 1u) * nloc) {
            __builtin_amdgcn_fence(__ATOMIC_RELEASE, "agent");
            asm volatile("s_waitcnt vmcnt(0)" ::: "memory");
            const unsigned og = xb_add(&bar[XB_TOP], 1u);
            const unsigned tg = og / nx;
            if (og + 1u == (tg + 1u) * nx) xb_add(&bar[XB_TOPGEN], 1u);
            else XB_SPIN(xb_ld(&bar[XB_TOPGEN]) == tg, bar);
            __builtin_amdgcn_fence(__ATOMIC_ACQUIRE, "agent");
            xb_add(&bar[XB_XGEN(b.x)], 1u);
            asm volatile("s_waitcnt vmcnt(0)" ::: "memory");
        } else {
            XB_SPIN(xb_ld(&bar[XB_XGEN(b.x)]) == gen, bar);
            __builtin_amdgcn_fence(__ATOMIC_ACQUIRE, "agent");
            asm volatile("s_waitcnt vmcnt(0)" ::: "memory");
        }
    }
    __syncthreads();
}

DI void run_phase(const Params& p, unsigned char* lds, int ph) {
    switch (ph) {
        case 0: phase0(p, lds); break;
        case 1: phase1(p, lds); break;
        case 2: phase15(p, lds); break;
        case 3: phase2(p, lds); break;
        case 4: phase25(p, lds); phase3(p, lds); break;
        case 5: phase4(p, lds); break;
        default: phase5(p, lds); break;
    }
}

__global__ void __launch_bounds__(512) hybrid_fwd(Params p) {
    extern __shared__ __attribute__((aligned(16))) unsigned char lds[];
#if MULTI_LAUNCH
    run_phase(p, lds, p.phase_lo);
#else
    cg::grid_group grid = cg::this_grid();
    if (p.phase_lo == 77) grid.sync();
    {
        volatile LAS unsigned* st = (volatile LAS unsigned*)(lds + LDS_ITEM + 16);
        if (threadIdx.x == 0) { st[0] = 0u; st[1] = 0u; }
        __syncthreads();
        (void)xcd_barrier_post((unsigned*)(p.ws + OFF_XBAR), st);
    }
#define GRID_BARRIER() { XcdBarrier xb_; xb_.bar = (unsigned*)(p.ws + OFF_XBAR); xb_.x = xb_xcc_id(); xb_.st = (volatile LAS unsigned*)(lds + LDS_ITEM + 16); xcd_barrier(xb_); }
    phase0(p, lds); GRID_BARRIER();
    phase1(p, lds); GRID_BARRIER();
    phase15(p, lds); GRID_BARRIER();
    phase2(p, lds); GRID_BARRIER();
    phase3(p, lds); GRID_BARRIER();
    phase4(p, lds);
#endif
}

extern "C" void kernel_launch(void* const* d_in, const int* in_sizes, int n_in, void* d_out, int out_size, void* d_ws, size_t ws_size, hipStream_t stream) {
    static int grid = 0;
    if (grid == 0) {
        int dev = 0, cus = 0, per_cu = 0;
        hipGetDevice(&dev);
        hipDeviceGetAttribute(&cus, hipDeviceAttributeMultiprocessorCount, dev);
        hipFuncSetAttribute((const void*)hybrid_fwd, hipFuncAttributeMaxDynamicSharedMemorySize, LDS_BYTES);
        hipOccupancyMaxActiveBlocksPerMultiprocessor(&per_cu, (const void*)hybrid_fwd, 512, LDS_BYTES);
        if (per_cu < 1) per_cu = 1;
        if (per_cu > 1) per_cu = 1;
        if (cus <= 0) cus = 256;
        grid = cus * per_cu;
    }
    hipMemsetAsync((unsigned char*)d_ws + OFF_XBAR, 0, 16384, stream);
    Params p{};
    p.x = (const float*)d_in[0]; p.meta = (const float*)d_in[1]; p.norm_w = (const float*)d_in[2]; p.w_in = (const float*)d_in[3];
    p.lq1 = (const float*)d_in[4]; p.lk1 = (const float*)d_in[5]; p.lq2 = (const float*)d_in[6]; p.lk2 = (const float*)d_in[7];
    p.subln_w = (const float*)d_in[8]; p.gate_w2 = (const float*)d_in[9]; p.gate_b = (const float*)d_in[10]; p.gla_norm_w = (const float*)d_in[11];
    p.wa = (const float*)d_in[12]; p.wb = (const float*)d_in[13]; p.wo = (const float*)d_in[14]; p.final_w = (const float*)d_in[15];
    p.out = (float*)d_out; p.ws = (unsigned char*)d_ws;
#if MULTI_LAUNCH
    for (int ph = 0; ph < 7; ++ph) {
        p.phase_lo = ph; p.phase_hi = ph + 1;
        hipLaunchKernelGGL(hybrid_fwd, dim3(grid), dim3(512), LDS_BYTES, stream, p);
    }
#else
    p.phase_lo = 0; p.phase_hi = 7;
    void* args[] = {&p};
    hipError_t e = hipLaunchCooperativeKernel((const void*)hybrid_fwd, dim3(grid), dim3(512), args, LDS_BYTES, stream);
    if (e != hipSuccess) fprintf(stderr, "cooperative launch failed: %s (grid %d)\n", hipGetErrorString(e), grid);
#endif
}
```

```cpp
#include <hip/hip_runtime.h>
#include <hip/hip_cooperative_groups.h>
#include <cstdio>
#include <cstdint>
namespace cg = cooperative_groups;

#ifndef MULTI_LAUNCH
#define MULTI_LAUNCH 0
#endif
#ifndef PROBE_REP
#define PROBE_REP 0
#endif

typedef unsigned short bf16_t;
typedef short bf16x8 __attribute__((ext_vector_type(8)));
typedef float f32x4 __attribute__((ext_vector_type(4)));
typedef float f32x2 __attribute__((ext_vector_type(2)));
typedef float f32x16 __attribute__((ext_vector_type(16)));
typedef unsigned u32x4 __attribute__((ext_vector_type(4)));
typedef unsigned u32x2 __attribute__((ext_vector_type(2)));
typedef __bf16 bfv2 __attribute__((ext_vector_type(2)));

#define DI __device__ __forceinline__
#define MFMA32(a, b, c) __builtin_amdgcn_mfma_f32_32x32x16_bf16((a), (b), (c), 0, 0, 0)
#define MFMA16(a, b, c) __builtin_amdgcn_mfma_f32_16x16x32_bf16((a), (b), (c), 0, 0, 0)

DI unsigned pk2(float a, float b) { f32x2 v = {a, b}; return __builtin_bit_cast(unsigned, __builtin_convertvector(v, bfv2)); }
DI float bf2f(bf16_t v) { return __uint_as_float(((unsigned)v) << 16); }
DI float bflo(unsigned u) { return __uint_as_float(u << 16); }
DI float bfhi(unsigned u) { return __uint_as_float(u & 0xffff0000u); }
DI bf16_t f2bf(float a) { return (bf16_t)(pk2(a, 0.f) & 0xffffu); }
DI float wave_sum(float v) {
#pragma unroll
    for (int o = 32; o; o >>= 1) v += __shfl_xor(v, o);
    return v;
}
DI int opaque_tid() { int t = threadIdx.x; asm volatile("" : "+v"(t)); return t; }
DI float xor32_sum(float x) { auto r = __builtin_amdgcn_permlane32_swap(__float_as_uint(x), __float_as_uint(x), false, false); return __uint_as_float(r[0]) + __uint_as_float(r[1]); }
DI float xor16_sum(float x) { auto r = __builtin_amdgcn_permlane16_swap(__float_as_uint(x), __float_as_uint(x), false, false); return __uint_as_float(r[0]) + __uint_as_float(r[1]); }
DI float xor32_max(float x) { auto r = __builtin_amdgcn_permlane32_swap(__float_as_uint(x), __float_as_uint(x), false, false); return fmaxf(__uint_as_float(r[0]), __uint_as_float(r[1])); }
DI float sigmoidf_(float z) { return __builtin_amdgcn_rcpf(1.f + __expf(-z)); }
DI float siluf_(float z) { return z * __builtin_amdgcn_rcpf(1.f + __expf(-z)); }

constexpr int D = 1024, NB = 4, SEQ = 4096, MROWS = NB * SEQ;
constexpr int NIN = 9232, NINP = 9344;
constexpr float EPS = 1e-5f;

constexpr size_t SZ_ACT = (size_t)MROWS * 1024 * 2;
constexpr size_t OFF_WIN_T = 0;
constexpr size_t OFF_WA_T = OFF_WIN_T + (size_t)NINP * 1024 * 2;
constexpr size_t OFF_WB_T = OFF_WA_T + 2097152;
constexpr size_t OFF_WO_T = OFF_WB_T + 2097152;
constexpr size_t OFF_AK = OFF_WO_T + 2097152;
constexpr size_t OFF_AVT = OFF_AK + SZ_ACT;
constexpr size_t OFF_AZ = OFF_AVT + SZ_ACT;
constexpr size_t OFF_GVT = OFF_AZ + SZ_ACT;
constexpr size_t OFF_GZ = OFF_GVT + SZ_ACT;
constexpr size_t OFF_GA = OFF_GZ + SZ_ACT;
constexpr size_t OFF_GB = OFF_GA + SZ_ACT;
constexpr size_t OFF_GLR = OFF_GB + SZ_ACT;
constexpr size_t OFF_RSTD = OFF_GLR + (size_t)MROWS * 16 * 2;
constexpr size_t OFF_ROPE = OFF_RSTD + 65792;
constexpr size_t OFF_AKM = OFF_ROPE + 263168;
constexpr size_t OFF_AVTM = OFF_AKM + 131072;
constexpr size_t OFF_GVTM = OFF_AVTM + 131072;
constexpr size_t OFF_GKM = OFF_GVTM + 131072;
constexpr size_t OFF_GLRM = OFF_GKM + 16384;
constexpr size_t OFF_KTM = OFF_GLRM + 512;
constexpr size_t OFF_KTTM = OFF_KTM + 65536;
constexpr size_t OFF_DEC = OFF_KTTM + 65536;
constexpr size_t OFF_DECM = OFF_DEC + 524288;
constexpr size_t OFF_SSQB = OFF_DECM + 2048;
constexpr size_t OFF_SSQH = OFF_SSQB + 4194304;
constexpr size_t OFF_CTR = OFF_SSQH + 1048576;
constexpr size_t OFF_XBM = OFF_CTR + 256;
constexpr size_t OFF_XBAR = OFF_XBM + 32768;
constexpr size_t WS_END = OFF_XBAR + 16384;
constexpr size_t OFF_XB = OFF_GA;
constexpr size_t OFF_SGA = OFF_GB;
constexpr size_t OFF_SGB = OFF_GB + (size_t)MROWS * 1024;
static_assert(WS_END <= 268435456ull, "workspace over 256 MiB");
constexpr size_t DO_AQ = 0, DO_GQ = SZ_ACT, DO_GK = SZ_ACT + SZ_ACT / 2;

constexpr int G_ROWB = 144;
constexpr int G_SW = 128 * G_ROWB, G_SX = 256 * G_ROWB, G_STAGE = G_SW + G_SX;
constexpr int G_SW4 = 256 * G_ROWB, G_STAGE4 = G_SW4 + G_SX;
constexpr int LDS_SCALE = 2 * G_STAGE4;
constexpr int LDS_ITEM = LDS_SCALE + 4096;
constexpr int LDS_BYTES = LDS_ITEM + 64;

struct Params {
    const float *x, *meta, *norm_w, *w_in, *lq1, *lk1, *lq2, *lk2, *subln_w, *gate_w2, *gate_b, *gla_norm_w, *wa, *wb, *wo, *final_w;
    float* out;
    unsigned char* ws;
    int phase_lo, phase_hi;
};

template <int MODE>
DI void p0_transpose_item(const Params& p, int item, float* tile) {
    const int tid = opaque_tid();
    const float* W = MODE == 0 ? p.w_in : MODE == 1 ? p.wa : MODE == 2 ? p.wb : p.wo;
    const int ldw = MODE == 0 ? NIN : 1024;
    const int nbc = MODE == 0 ? NINP / 128 : 8;
    bf16_t* WT = (bf16_t*)(p.ws + (MODE == 0 ? OFF_WIN_T : MODE == 1 ? OFF_WA_T : MODE == 2 ? OFF_WB_T : OFF_WO_T));
    const int kb = item / nbc, nb = item % nbc, k0 = kb * 64, n0 = nb * 128;
    const int nn = tid & 127, n = n0 + nn;
    int src = n;
    if (MODE == 0) { src = n < 7168 ? n : (n < 9216 ? n + 16 : (n < 9232 ? n - 2048 : -1)); }
    float v[16];
#pragma unroll
    for (int i = 0; i < 16; ++i) {
        const int k = k0 + (tid >> 7) + 4 * i;
        v[i] = src >= 0 ? __builtin_nontemporal_load(W + (size_t)k * ldw + src) : 0.f;
    }
#pragma unroll
    for (int i = 0; i < 16; ++i) {
        const int kk = (tid >> 7) + 4 * i, k = k0 + kk;
        float sc = 1.f;
        if (MODE == 0) sc = p.norm_w[k];
        if (MODE == 1) sc = 0.8f * p.subln_w[k & 127];
        if (MODE == 2) sc = p.gla_norm_w[k & 255];
        tile[kk * 129 + nn] = v[i] * sc;
    }
    __syncthreads();
    {
        const int on = tid >> 2, c = tid & 3;
        const float* s = tile + (16 * c) * 129 + on;
        u32x4 o0, o1;
        o0.x = pk2(s[0 * 129], s[1 * 129]); o0.y = pk2(s[2 * 129], s[3 * 129]); o0.z = pk2(s[4 * 129], s[5 * 129]); o0.w = pk2(s[6 * 129], s[7 * 129]);
        o1.x = pk2(s[8 * 129], s[9 * 129]); o1.y = pk2(s[10 * 129], s[11 * 129]); o1.z = pk2(s[12 * 129], s[13 * 129]); o1.w = pk2(s[14 * 129], s[15 * 129]);
        u32x4* dst = (u32x4*)(WT + (size_t)(n0 + on) * 1024 + k0 + 16 * c);
        dst[0] = o0; dst[1] = o1;
    }
    __syncthreads();
}

DI void phase0(const Params& p, unsigned char* lds) {
    const int tid = opaque_tid(), lane = tid & 63, wave = tid >> 6;
    float* tile = (float*)lds;
    constexpr int I_WIN = 16 * (NINP / 128), I_SQ = 128;
    constexpr int I_T = I_WIN + 3 * I_SQ;
    constexpr int I_RSTD = (MROWS + 16 + 15) / 16;
    constexpr int I_ROPE = (4112 * 8 + 511) / 512;
    constexpr int I_ZERO = 393216 / 8192;
    constexpr int I_ALL = I_T + I_RSTD + I_ROPE + I_ZERO;
    for (int it = blockIdx.x; it < I_ALL; it += gridDim.x) {
        int r = it;
        if (r < I_WIN) { p0_transpose_item<0>(p, r, tile); continue; } r -= I_WIN;
        if (r < I_SQ) { p0_transpose_item<1>(p, r, tile); continue; } r -= I_SQ;
        if (r < I_SQ) { p0_transpose_item<2>(p, r, tile); continue; } r -= I_SQ;
        if (r < I_SQ) { p0_transpose_item<3>(p, r, tile); continue; } r -= I_SQ;
        if (r < I_RSTD) {
            const int row0 = r * 16 + wave * 2;
            f32x4 v[2][4];
#pragma unroll
            for (int q = 0; q < 2; ++q) {
                const int row = row0 + q < MROWS + 16 ? row0 + q : MROWS + 15;
                const float* srcp = row < MROWS ? p.x + (size_t)row * 1024 : p.meta + (size_t)(row - MROWS) * 1024;
                const f32x4* xr = (const f32x4*)srcp + lane;
#pragma unroll
                for (int j = 0; j < 4; ++j) v[q][j] = xr[64 * j];
            }
#pragma unroll
            for (int q = 0; q < 2; ++q) {
                const int row = row0 + q;
                float s = 0.f;
#pragma unroll
                for (int j = 0; j < 4; ++j) s += (v[q][j].x * v[q][j].x + v[q][j].y * v[q][j].y) + (v[q][j].z * v[q][j].z + v[q][j].w * v[q][j].w);
                s = wave_sum(s);
                if (row < MROWS + 16) {
                    if (lane == 0) ((float*)(p.ws + OFF_RSTD))[row] = 1.0f / sqrtf(s * (1.0f / 1024.0f) + EPS);
                    bf16_t* xbrow = row < MROWS ? (bf16_t*)(p.ws + OFF_XB) + (size_t)row * 1024 : (bf16_t*)(p.ws + OFF_XBM) + (size_t)(row - MROWS) * 1024;
#pragma unroll
                    for (int j = 0; j < 4; ++j) { u32x2 o; o.x = pk2(v[q][j].x, v[q][j].y); o.y = pk2(v[q][j].z, v[q][j].w); *(u32x2*)(xbrow + 256 * j + 4 * lane) = o; }
                }
            }
            continue;
        }
        r -= I_RSTD;
        if (r < I_ROPE) {
            const int e = r * 512 + tid;
            if (e < 4112 * 8) {
                const int pos = e >> 3, i = e & 7;
                const float inv = powf(500000.0f, -(float)i / 8.0f);
                const float ang = (float)pos * inv;
                float* t = (float*)(p.ws + OFF_ROPE) + (size_t)e * 2;
                t[0] = cosf(ang); t[1] = sinf(ang);
            }
            continue;
        }
        r -= I_ROPE;
        { u32x4 z = {0u, 0u, 0u, 0u}; *(u32x4*)(p.ws + OFF_AKM + (size_t)r * 8192 + tid * 16) = z; }
    }
}

namespace pg8 {
#define PG8_LAS __attribute__((address_space(3)))
typedef unsigned short bf16_t;
typedef short bf16x8 __attribute__((ext_vector_type(8)));
typedef float f32x4 __attribute__((ext_vector_type(4)));
typedef unsigned u32x4 __attribute__((ext_vector_type(4)));
constexpr int BM = 256, BK = 64, HALF = 128, HTB = HALF * BK * 2  , STAGE_BYTES = 8 * HTB, NXCD = 8, WGM = 8;

__host__ __device__ __forceinline__ int lds_byte(int r, int c) { const int st = (r >> 4) * 2 + (c >> 5), rr = r & 15, cc = c & 31, ob = rr * 64 + cc * 2; return st * 1024 + (ob ^ (((ob >> 9) & 1) << 5)); }
__host__ __device__ __forceinline__ void stage_rc(int b, int& R, int& C) { const int st = b / 1024, sb = b % 1024, swz = sb ^ (((sb >> 9) & 1) << 5); R = (st >> 1) * 16 + swz / 64; C = (st & 1) * 32 + (swz % 64) / 2; }
__host__ __device__ __forceinline__ int perm32(int rho) { const int n = rho >> 4, i = rho & 15; return 8 * (i >> 2) + 4 * n + (i & 3); }

struct Unit { int pm, pn; };
struct Gemm { const bf16_t* A; const bf16_t* Bt; int M, N, K; };

template <class Epi, class Sched, bool ALIGN_EPI = false, bool SP2 = false, bool HS = false>
__device__ __forceinline__ void gemm_phase(PG8_LAS unsigned char* lds, const Gemm g, const Sched& S, const Epi& E) {
    const int tid = opaque_tid(), wid = __builtin_amdgcn_readfirstlane(tid >> 6), lane = tid & 63, wr = wid >> 2, wc = wid & 3, fr = lane & 15, fq = lane >> 4;
    const int K = g.K, nt = K / BK;
    unsigned voffA[2], voffB[2];
#pragma unroll
    for (int i = 0; i < 2; ++i) { int R, C; stage_rc(tid * 16 + i * 8192, R, C); const int Rb = Epi::PERM ? ((R & ~31) + perm32(R & 31)) : R;
        voffA[i] = (unsigned)(R * K + C) * 2u; voffB[i] = (unsigned)(Rb * K + C) * 2u; }
    const size_t kstep = (size_t)(BK * 2);
    const size_t hstep = (size_t)HALF * K * 2;
    const size_t tstep = 2 * hstep;
    const unsigned ldsw = (unsigned)wid * 1024u;
    const int aoff = lds_byte(wr * 64 + fr, fq * 8), boff = lds_byte(wc * 32 + fr, fq * 8);
#define PG8_SA(b, h) (((b) * 2 + (h)) * HTB)
#define PG8_SB(b, h) ((4 + (b) * 2 + (h)) * HTB)
#define PG8_STAGE(bufoff, gbase, voff) do { _Pragma("unroll") for (int _i = 0; _i < 2; ++_i) \
        __builtin_amdgcn_global_load_lds((const unsigned*)((const char*)(gbase) + (voff)[_i]), (PG8_LAS unsigned*)(lds + (bufoff) + ldsw + _i * 8192), 16, 0, 0); } while (0)
#define PG8_LDA(dst, b, h) do { _Pragma("unroll") for (int m = 0; m < 4; ++m) _Pragma("unroll") for (int k = 0; k < 2; ++k) dst[m][k] = *(const PG8_LAS bf16x8*)(lds + PG8_SA(b, h) + aoff + m * 2048 + k * 1024); } while (0)
#define PG8_LDB(dst, b, h) do { _Pragma("unroll") for (int n = 0; n < 2; ++n) _Pragma("unroll") for (int k = 0; k < 2; ++k) dst[n][k] = *(const PG8_LAS bf16x8*)(lds + PG8_SB(b, h) + boff + n * 2048 + k * 1024); } while (0)
#define PG8_MMA(ai, bj, At, Bt) do { __builtin_amdgcn_s_setprio(1); _Pragma("unroll") for (int m = 0; m < 4; ++m) _Pragma("unroll") for (int n = 0; n < 2; ++n) _Pragma("unroll") for (int k = 0; k < 2; ++k) \
        acc[ai][bj][m][n] = __builtin_amdgcn_mfma_f32_16x16x32_bf16(Bt[n][k], At[m][k], acc[ai][bj][m][n], 0, 0, 0); __builtin_amdgcn_s_setprio(0); } while (0)
#define PG8_WAIT_V(n) asm volatile("s_waitcnt vmcnt(" #n ")" ::: "memory")
#define PG8_WAIT_L(n) asm volatile("s_waitcnt lgkmcnt(" #n ")" ::: "memory")
#define PG8_BAR __builtin_amdgcn_s_barrier()
#define PG8_SCHED __builtin_amdgcn_sched_barrier(0)
    Unit cur, nxt; int ui = 0;
    if (!S.next(0, cur)) return;
    f32x4 acc[2][2][4][2];
#pragma unroll
    for (int a = 0; a < 2; ++a)
#pragma unroll
        for (int b = 0; b < 2; ++b)
#pragma unroll
            for (int m = 0; m < 4; ++m)
#pragma unroll
                for (int n = 0; n < 2; ++n) acc[a][b][m][n] = (f32x4){0.f, 0.f, 0.f, 0.f};
    bf16x8 At[4][2], B0[2][2], B1[2][2];
    const char* cA = (const char*)g.A + (size_t)cur.pm * tstep; const char* cB = (const char*)g.Bt + (size_t)cur.pn * tstep;
    S.a_ready(cur);
    if constexpr (SP2) {
        PG8_STAGE(PG8_SB(0, 0), cB, voffB); PG8_STAGE(PG8_SB(0, 1), cB + hstep, voffB); PG8_STAGE(PG8_SA(0, 0), cA, voffA); PG8_STAGE(PG8_SA(0, 1), cA + hstep, voffA);
        if (wr == 1) PG8_BAR;
        PG8_WAIT_V(2); PG8_BAR;
        PG8_STAGE(PG8_SB(1, 0), cB + kstep, voffB); PG8_STAGE(PG8_SA(1, 0), cA + kstep, voffA); PG8_STAGE(PG8_SB(1, 1), cB + hstep + kstep, voffB);
        PG8_WAIT_V(6); PG8_BAR;
    } else {
        PG8_STAGE(PG8_SB(0, 0), cB, voffB); PG8_STAGE(PG8_SA(0, 0), cA, voffA); PG8_STAGE(PG8_SB(0, 1), cB + hstep, voffB); PG8_STAGE(PG8_SA(0, 1), cA + hstep, voffA);
        if (wr == 1) PG8_BAR;
        PG8_WAIT_V(4); PG8_BAR;
        PG8_STAGE(PG8_SB(1, 0), cB + kstep, voffB); PG8_STAGE(PG8_SA(1, 0), cA + kstep, voffA); PG8_STAGE(PG8_SB(1, 1), cB + hstep + kstep, voffB);
        PG8_WAIT_V(6); PG8_BAR;
    }
    for (;;) {
        const bool has_next = S.next(ui + 1, nxt);
        const char* nA = has_next ? (const char*)g.A + (size_t)nxt.pm * tstep : cA; const char* nB = has_next ? (const char*)g.Bt + (size_t)nxt.pn * tstep : cB;
        for (int t = 0; t < nt; t += 2) {
            if constexpr (HS) {
                if (t == 4 || t == 8 || t == 12) {
                    const PG8_LAS float* tab = (const PG8_LAS float*)(lds + 147456);
                    const int hj = (t >> 2) - 1;
#pragma unroll
                    for (int a = 0; a < 2; ++a)
#pragma unroll
                        for (int m = 0; m < 4; ++m) {
                            const float s = tab[(a * 128 + wr * 64 + m * 16 + fr) * 4 + hj];
#pragma unroll
                            for (int b = 0; b < 2; ++b)
#pragma unroll
                                for (int n = 0; n < 2; ++n) acc[a][b][m][n] = acc[a][b][m][n] * s;
                        }
                }
            }
            const bool last = (t == nt - 2);
            const char* a1 = cA + (size_t)(t + 1) * kstep;
            const char* a2 = last ? nA : cA + (size_t)(t + 2) * kstep; const char* b2 = last ? nB : cB + (size_t)(t + 2) * kstep;
            const char* a3 = a2 + kstep; const char* b3 = b2 + kstep;
            if (last && has_next) S.a_ready(nxt);
            if constexpr (SP2) {
            PG8_LDB(B0, 0, 0); PG8_LDB(B1, 0, 1); PG8_SCHED; PG8_LDA(At, 0, 0); PG8_STAGE(PG8_SA(1, 1), a1 + hstep, voffA);
            PG8_WAIT_V(8); PG8_WAIT_L(0); PG8_BAR; PG8_MMA(0, 0, At, B0); PG8_MMA(0, 1, At, B1); PG8_BAR; PG8_SCHED;
            PG8_LDA(At, 0, 1); PG8_STAGE(PG8_SB(0, 0), b2, voffB); PG8_STAGE(PG8_SB(0, 1), b2 + hstep, voffB); PG8_STAGE(PG8_SA(0, 0), a2, voffA);
            PG8_WAIT_V(8); PG8_WAIT_L(0); PG8_BAR; PG8_MMA(1, 0, At, B0); PG8_MMA(1, 1, At, B1); PG8_BAR; PG8_SCHED;
            PG8_LDB(B0, 1, 0); PG8_LDB(B1, 1, 1); PG8_SCHED; PG8_LDA(At, 1, 0); PG8_STAGE(PG8_SA(0, 1), a2 + hstep, voffA);
            PG8_WAIT_V(8); PG8_WAIT_L(0); PG8_BAR; PG8_MMA(0, 0, At, B0); PG8_MMA(0, 1, At, B1); PG8_BAR; PG8_SCHED;
            PG8_LDA(At, 1, 1); PG8_STAGE(PG8_SB(1, 0), b3, voffB); PG8_STAGE(PG8_SB(1, 1), b3 + hstep, voffB); PG8_STAGE(PG8_SA(1, 0), a3, voffA);
            PG8_WAIT_V(8); PG8_WAIT_L(0); PG8_BAR; PG8_MMA(1, 0, At, B0); PG8_MMA(1, 1, At, B1); PG8_BAR; PG8_SCHED;
            } else {
            PG8_LDB(B0, 0, 0); PG8_SCHED; PG8_LDA(At, 0, 0); PG8_STAGE(PG8_SA(1, 1), a1 + hstep, voffA);
            PG8_WAIT_L(8); PG8_BAR; PG8_WAIT_L(0); PG8_MMA(0, 0, At, B0); PG8_BAR; PG8_SCHED;
            PG8_LDB(B1, 0, 1); PG8_STAGE(PG8_SB(0, 0), b2, voffB);
            PG8_BAR; PG8_WAIT_L(0); PG8_MMA(0, 1, At, B1); PG8_BAR;
            PG8_LDA(At, 0, 1); PG8_STAGE(PG8_SA(0, 0), a2, voffA);
            PG8_BAR; PG8_WAIT_L(0); PG8_MMA(1, 0, At, B0); PG8_BAR; PG8_SCHED;
            PG8_STAGE(PG8_SB(0, 1), b2 + hstep, voffB);
            PG8_WAIT_V(6); PG8_BAR; PG8_MMA(1, 1, At, B1); PG8_BAR;
            PG8_LDB(B0, 1, 0); PG8_SCHED; PG8_LDA(At, 1, 0); PG8_STAGE(PG8_SA(0, 1), a2 + hstep, voffA);
            PG8_WAIT_L(8); PG8_BAR; PG8_WAIT_L(0); PG8_MMA(0, 0, At, B0); PG8_BAR; PG8_SCHED;
            PG8_LDB(B1, 1, 1); PG8_STAGE(PG8_SB(1, 0), b3, voffB);
            PG8_BAR; PG8_WAIT_L(0); PG8_MMA(0, 1, At, B1); PG8_BAR;
            PG8_LDA(At, 1, 1); PG8_STAGE(PG8_SA(1, 0), a3, voffA);
            PG8_BAR; PG8_WAIT_L(0); PG8_MMA(1, 0, At, B0); PG8_BAR; PG8_SCHED;
            PG8_STAGE(PG8_SB(1, 1), b3 + hstep, voffB);
            PG8_WAIT_V(6); PG8_BAR; PG8_MMA(1, 1, At, B1); PG8_BAR;
            }
        }
        if constexpr (ALIGN_EPI) { if (wr == 0) PG8_BAR; }
        if constexpr (!Epi::AFTER_DRAIN) { E(acc, cur, wr, wc, fr, fq); S.done(cur); }
        if (!has_next) break;
#pragma unroll
        for (int a = 0; a < 2; ++a)
#pragma unroll
            for (int b = 0; b < 2; ++b)
#pragma unroll
                for (int m = 0; m < 4; ++m)
#pragma unroll
                    for (int n = 0; n < 2; ++n) acc[a][b][m][n] = (f32x4){0.f, 0.f, 0.f, 0.f};
        cur = nxt; cA = nA; cB = nB; ++ui;
        if constexpr (ALIGN_EPI) { if (wr == 1) PG8_BAR; }
    }
    PG8_WAIT_V(0);
    if constexpr (!ALIGN_EPI) { if (wr == 0) PG8_BAR; }
    PG8_BAR;
    if constexpr (Epi::AFTER_DRAIN) { E.fused(acc, cur, wr, wc, fr, fq, lds, wid, lane); S.done(cur); }
#undef PG8_SA
#undef PG8_SB
#undef PG8_STAGE
#undef PG8_LDA
#undef PG8_LDB
#undef PG8_MMA
#undef PG8_WAIT_V
#undef PG8_WAIT_L
#undef PG8_BAR
#undef PG8_SCHED
}
}

DI unsigned sig_u8(float z) { return (unsigned)(255.0f * __builtin_amdgcn_rcpf(1.0f + __expf(-z)) + 0.5f); }
struct SchedP1 {
    DI bool next(int i, pg8::Unit& u) const {
        constexpr int NT = 36;
        const int id = (int)blockIdx.x + i * (int)gridDim.x;
        if (id >= 64 * NT) return false;
        const int g = id / (16 * NT), rem = id % (16 * NT), reg = rem >> 8, w = rem & 255, x = w & 7, j = w >> 3;
        int mt = g * 16 + 4 * (x & 3) + (j & 3), nt = reg * 16 + 8 * (x >> 2) + (j >> 2);
        if (reg == 2) { const int e = rem - 512; nt = 32 + (e >> 4); mt = g * 16 + (e & 15); }
        u.pm = mt; u.pn = nt; return true;
    }
    DI void a_ready(const pg8::Unit&) const {}
    DI void done(const pg8::Unit&) const {}
};
struct SchedSq {
    DI bool next(int i, pg8::Unit& u) const {
        const int id = (int)blockIdx.x + i * (int)gridDim.x;
        if (id >= 256) return false;
        u.pm = 8 * (id & 7) + ((id >> 3) & 7); u.pn = id >> 6; return true;
    }
    DI void a_ready(const pg8::Unit&) const {}
    DI void done(const pg8::Unit&) const {}
};
DI unsigned sig_u8x4(float a, float b, float c, float d) {
    unsigned r = 0u;
    r = __builtin_amdgcn_cvt_pk_u8_f32(255.0f * __builtin_amdgcn_rcpf(1.0f + __expf(-a)), 0, r);
    r = __builtin_amdgcn_cvt_pk_u8_f32(255.0f * __builtin_amdgcn_rcpf(1.0f + __expf(-b)), 1, r);
    r = __builtin_amdgcn_cvt_pk_u8_f32(255.0f * __builtin_amdgcn_rcpf(1.0f + __expf(-c)), 2, r);
    r = __builtin_amdgcn_cvt_pk_u8_f32(255.0f * __builtin_amdgcn_rcpf(1.0f + __expf(-d)), 3, r);
    return r;
}
struct EpiInProj {
    static constexpr bool PERM = true, AFTER_DRAIN = false;
    unsigned char* ws; unsigned char* dout;
    DI void operator()(const pg8::f32x4 (&acc)[2][2][4][2], const pg8::Unit& u, int wr, int wc, int fr, int fq) const {
        const int nt = u.pn;
        int split, nc0;
        if (nt < 4) { split = 0; nc0 = nt * 256; }
        else if (nt < 8) { split = 1; nc0 = (nt - 4) * 256; }
        else if (nt < 12) { split = 2; nc0 = (nt - 8) * 256; }
        else if (nt < 16) { split = 3; nc0 = (nt - 12) * 256; }
        else if (nt < 18) { split = 4; nc0 = (nt - 16) * 256; }
        else if (nt < 20) { split = 5; nc0 = (nt - 18) * 256; }
        else if (nt < 24) { split = 6; nc0 = (nt - 20) * 256; }
        else if (nt < 28) { split = 7; nc0 = (nt - 24) * 256; }
        else if (nt < 32) { split = 9; nc0 = (nt - 28) * 256; }
        else { split = 10; nc0 = (nt - 32) * 256; }
        const float* rstd = (const float*)(ws + OFF_RSTD);
        const float* rope = (const float*)(ws + OFF_ROPE);
        const bool do_rope = split <= 1 && (wc & 1) == 0;
#pragma unroll
        for (int ai = 0; ai < 2; ++ai)
#pragma unroll
            for (int m = 0; m < 4; ++m) {
                const int tok = u.pm * 256 + ai * 128 + wr * 64 + m * 16 + fr;
                const float rs = rstd[tok];
                const float rsq = split == 0 ? rs * (0.125f * 1.4426950408889634f) : rs;
                const int pos = 16 + (tok & 4095), b = tok >> 12, s = tok & 4095;
#pragma unroll
                for (int bj = 0; bj < 2; ++bj) {
                    const int nb = nc0 + bj * 128 + wc * 32 + 8 * fq;
                    float v[8];
#pragma unroll
                    for (int j = 0; j < 4; ++j) { v[j] = acc[ai][bj][m][0][j] * rsq; v[4 + j] = acc[ai][bj][m][1][j] * rsq; }
                    if (do_rope) {
                        const f32x4* cs = (const f32x4*)(rope + (size_t)pos * 16);
                        const f32x4 c01 = cs[0], c23 = cs[1], c45 = cs[2], c67 = cs[3];
                        const float cc[8] = {c01.x, c01.z, c23.x, c23.z, c45.x, c45.z, c67.x, c67.z};
                        const float sn[8] = {c01.y, c01.w, c23.y, c23.w, c45.y, c45.w, c67.y, c67.w};
#pragma unroll
                        for (int j = 0; j < 8; ++j) {
                            const float other = __shfl_xor(v[j], 16);
                            const float r0 = v[j] * cc[j] - other * sn[j], r1 = v[j] * cc[j] + other * sn[j];
                            v[j] = fq == 0 ? r0 : (fq == 1 ? r1 : v[j]);
                        }
                    }
                    if (split == 2 || split == 6) {
                        const int hshift = split == 2 ? 7 : 8, nheads = split == 2 ? 8 : 4, dvn = 1 << hshift;
                        bf16_t* base = (bf16_t*)(ws + (split == 2 ? OFF_AVT : OFF_GVT));
                        const int hd = nb >> hshift, dv0 = nb & (dvn - 1);
                        bf16_t* dst = base + ((size_t)(b * nheads + hd) * dvn + dv0) * 4096 + s;
#pragma unroll
                        for (int j = 0; j < 8; ++j) dst[(size_t)j * 4096] = f2bf(v[j]);
                    } else if (split >= 9) {
                        u32x2 o; o.x = sig_u8x4(v[0], v[1], v[2], v[3]); o.y = sig_u8x4(v[4], v[5], v[6], v[7]);
                        *(u32x2*)(ws + (split == 9 ? OFF_SGA : OFF_SGB) + (size_t)tok * 1024 + nb) = o;
                    } else {
                        bf16_t* dst; int ld;
                        switch (split) {
                            case 0: dst = (bf16_t*)(dout + DO_AQ); ld = 1024; break;
                            case 1: dst = (bf16_t*)(ws + OFF_AK); ld = 1024; break;
                            case 3: dst = (bf16_t*)(ws + OFF_AZ); ld = 1024; break;
                            case 4: dst = (bf16_t*)(dout + DO_GQ); ld = 512; break;
                            case 5: dst = (bf16_t*)(dout + DO_GK); ld = 512; break;
                            default: dst = (bf16_t*)(ws + OFF_GZ); ld = 1024; break;
                        }
                        u32x4 o; o.x = pk2(v[0], v[1]); o.y = pk2(v[2], v[3]); o.z = pk2(v[4], v[5]); o.w = pk2(v[6], v[7]);
                        *(u32x4*)(dst + (size_t)tok * ld + nb) = o;
                    }
                }
            }
    }
};

DI void p1_glr_job(const Params& p, unsigned char* lds, int job) {
    const int tid = opaque_tid(), lane = tid & 63, wave = tid >> 6, l15 = lane & 15, g = lane >> 4;
    const int rtile = wave & 3, khalf = wave >> 2;
    const bf16_t* xb = (const bf16_t*)(p.ws + OFF_XB);
    const bf16_t* wt = (const bf16_t*)(p.ws + OFF_WIN_T) + (size_t)9216 * 1024;
    const size_t row0 = (size_t)job * 64 + rtile * 16;
    const bf16_t* ap = xb + (row0 + l15) * 1024 + khalf * 512 + 8 * g;
    const bf16_t* bp = wt + (size_t)l15 * 1024 + khalf * 512 + 8 * g;
    f32x4 acc = (f32x4){0.f, 0.f, 0.f, 0.f};
    {
        bf16x8 av[16], bv[16];
#pragma unroll
        for (int ks = 0; ks < 16; ++ks) { av[ks] = *(const bf16x8*)(ap + ks * 32); bv[ks] = *(const bf16x8*)(bp + ks * 32); }
        f32x4 acc2 = (f32x4){0.f, 0.f, 0.f, 0.f};
#pragma unroll
        for (int ks = 0; ks < 16; ks += 2) { acc = MFMA16(av[ks], bv[ks], acc); acc2 = MFMA16(av[ks + 1], bv[ks + 1], acc2); }
        acc = acc + acc2;
    }
    f32x4* red = (f32x4*)lds;
    __syncthreads();
    if (khalf == 1) red[rtile * 64 + lane] = acc;
    __syncthreads();
    if (khalf == 0) {
        const f32x4 o = red[rtile * 64 + lane];
        const float* rstd = (const float*)(p.ws + OFF_RSTD);
        bf16_t* glr = (bf16_t*)(p.ws + OFF_GLR);
#pragma unroll
        for (int i = 0; i < 4; ++i) {
            const size_t row = row0 + 4 * g + i;
            glr[row * 16 + l15] = f2bf((acc[i] + o[i]) * rstd[row]);
        }
    }
    __syncthreads();
}

DI void p1_meta_job(const Params& p, unsigned char* lds, int job) {
    const int tid = opaque_tid(), lane = tid & 63, wave = tid >> 6, l15 = lane & 15, g = lane >> 4;
    int c0;
    if (job < 64) c0 = 1024 + job * 16;
    else if (job < 128) c0 = 2048 + (job - 64) * 16;
    else if (job < 160) c0 = 4608 + (job - 128) * 16;
    else if (job < 224) c0 = 5120 + (job - 160) * 16;
    else c0 = 9216;
    const bf16_t* xbm = (const bf16_t*)(p.ws + OFF_XBM);
    const bf16_t* wt = (const bf16_t*)(p.ws + OFF_WIN_T);
    const bf16_t* ap = xbm + (size_t)l15 * 1024 + wave * 128 + 8 * g;
    const bf16_t* bp = wt + (size_t)(c0 + l15) * 1024 + wave * 128 + 8 * g;
    f32x4 acc = (f32x4){0.f, 0.f, 0.f, 0.f};
#pragma unroll
    for (int ks = 0; ks < 4; ++ks) {
        const bf16x8 a = *(const bf16x8*)(ap + ks * 32), bb = *(const bf16x8*)(bp + ks * 32);
        acc = MFMA16(a, bb, acc);
    }
    f32x4* red = (f32x4*)lds;
    __syncthreads();
    red[wave * 64 + lane] = acc;
    __syncthreads();
    if (wave == 0) {
        f32x4 s = red[lane];
#pragma unroll
        for (int w = 1; w < 8; ++w) { const f32x4 t = red[w * 64 + lane]; s.x += t.x; s.y += t.y; s.z += t.z; s.w += t.w; }
        const float* rstd = (const float*)(p.ws + OFF_RSTD) + MROWS;
        const float* rope = (const float*)(p.ws + OFF_ROPE);
        unsigned char* ws = p.ws;
        const int col = c0 + l15;
#pragma unroll
        for (int i = 0; i < 4; ++i) {
            const int row = 4 * g + i;
            float v = s[i] * rstd[row];
            if (job < 64 && (c0 & 63) == 0) {
                const float other = __shfl_xor(v, 8);
                const float* cs = rope + ((size_t)row * 8 + (l15 & 7)) * 2;
                const float c = cs[0], sn = cs[1];
                v = (l15 < 8) ? (v * c - other * sn) : (v * c + other * sn);
            }
            const bf16_t val = f2bf(v);
            if (job < 64) ((bf16_t*)(ws + OFF_AKM))[(size_t)(48 + row) * 1024 + (col - 1024)] = val;
            else if (job < 128) { const int n = col - 2048; ((bf16_t*)(ws + OFF_AVTM))[(size_t)n * 64 + 48 + row] = val; }
            else if (job < 160) ((bf16_t*)(ws + OFF_GKM))[(size_t)row * 512 + (col - 4608)] = val;
            else if (job < 224) { const int n = col - 5120; ((bf16_t*)(ws + OFF_GVTM))[(size_t)n * 64 + 48 + row] = val; }
            else ((bf16_t*)(ws + OFF_GLRM))[row * 16 + l15] = val;
        }
    }
    __syncthreads();
}

DI void phase1(const Params& p, unsigned char* lds) {
    for (int j = blockIdx.x; j < 256; j += gridDim.x) p1_glr_job(p, lds, j);
    for (int j = blockIdx.x; j < 225; j += gridDim.x) p1_meta_job(p, lds, j);
    pg8::Gemm g; g.A = (const bf16_t*)(p.ws + OFF_XB); g.Bt = (const bf16_t*)(p.ws + OFF_WIN_T); g.M = MROWS; g.N = 9216; g.K = 1024;
    SchedP1 S; EpiInProj E; E.ws = p.ws; E.dout = (unsigned char*)p.out;
    pg8::gemm_phase<EpiInProj, SchedP1, true, true>((PG8_LAS unsigned char*)lds, g, S, E);
}

DI void phase15(const Params& p, unsigned char* lds) {
    const int tid = opaque_tid(), col = tid;
    float w2[16];
#pragma unroll
    for (int j = 0; j < 16; ++j) w2[j] = p.gate_w2[j * 512 + col];
    const float bias = p.gate_b[col];
    unsigned char* ws = p.ws;
    unsigned char* dout = (unsigned char*)p.out;
    for (int item = blockIdx.x; item < 257; item += gridDim.x) {
        const bool meta = item == 256;
        const int b = item >> 6, c = item & 63;
        const size_t row0 = (size_t)b * 4096 + c * 64;
        const bf16_t* glr = meta ? (const bf16_t*)(ws + OFF_GLRM) : (const bf16_t*)(ws + OFF_GLR) + row0 * 16;
        const int nrows = meta ? 16 : 64;
        bf16_t* qp = (bf16_t*)(dout + DO_GQ) + row0 * 512 + col;
        const bf16_t* kin = meta ? (const bf16_t*)(ws + OFF_GKM) + col : (const bf16_t*)(dout + DO_GK) + row0 * 512 + col;
        bf16_t* kout = meta ? (bf16_t*)(ws + OFF_KTM) + 48 * 512 + col : (bf16_t*)(dout + DO_GK) + row0 * 512 + col;
        bf16_t* ktt = meta ? (bf16_t*)(ws + OFF_KTTM) + (size_t)col * 64 + 48 : (bf16_t*)(ws + OFF_WIN_T) + ((size_t)b * 512 + col) * 4096 + c * 64;
        __syncthreads();
        if (tid < nrows * 2) ((u32x4*)lds)[tid] = ((const u32x4*)glr)[tid];
        __syncthreads();
        float bsum = 0.f;
        constexpr int GR = 16;
        bf16_t kc[GR], qc[GR], kn[GR], qn[GR];
#pragma unroll
        for (int rr = 0; rr < GR; ++rr) { kc[rr] = kin[(size_t)rr * 512]; qc[rr] = meta ? (bf16_t)0 : qp[(size_t)rr * 512]; }
        for (int r0 = 0; r0 < nrows; r0 += GR) {
            if (r0 + GR < nrows) {
#pragma unroll
                for (int rr = 0; rr < GR; ++rr) { kn[rr] = kin[(size_t)(r0 + GR + rr) * 512]; qn[rr] = meta ? (bf16_t)0 : qp[(size_t)(r0 + GR + rr) * 512]; }
            }
            float kt8[GR];
#pragma unroll
            for (int rr = 0; rr < GR; ++rr) {
                const int r = r0 + rr;
                const u32x4* g4 = (const u32x4*)(lds + r * 32);
                const u32x4 ga = g4[0], gb = g4[1];
                float gk = bias;
                gk += bflo(ga.x) * w2[0] + bfhi(ga.x) * w2[1] + bflo(ga.y) * w2[2] + bfhi(ga.y) * w2[3];
                gk += bflo(ga.z) * w2[4] + bfhi(ga.z) * w2[5] + bflo(ga.w) * w2[6] + bfhi(ga.w) * w2[7];
                gk += bflo(gb.x) * w2[8] + bfhi(gb.x) * w2[9] + bflo(gb.y) * w2[10] + bfhi(gb.y) * w2[11];
                gk += bflo(gb.z) * w2[12] + bfhi(gb.z) * w2[13] + bflo(gb.w) * w2[14] + bfhi(gb.w) * w2[15];
                const float lg = (fminf(gk, 0.f) - __logf(1.0f + __expf(-fabsf(gk)))) * (1.0f / 16.0f);
                bsum += lg;
                const float eb = __expf(bsum);
                const float kt = bf2f(kc[rr]) * __builtin_amdgcn_rcpf(eb);
                kt8[rr] = kt;
                kout[(size_t)r * 512] = f2bf(kt);
                if (!meta) qp[(size_t)r * 512] = f2bf(bf2f(qc[rr]) * 0.08838834764831845f * eb);
            }
#pragma unroll
            for (int hh8 = 0; hh8 < GR / 8; ++hh8) {
                u32x4 o; o.x = pk2(kt8[8 * hh8 + 0], kt8[8 * hh8 + 1]); o.y = pk2(kt8[8 * hh8 + 2], kt8[8 * hh8 + 3]);
                o.z = pk2(kt8[8 * hh8 + 4], kt8[8 * hh8 + 5]); o.w = pk2(kt8[8 * hh8 + 6], kt8[8 * hh8 + 7]);
                *(u32x4*)(ktt + r0 + 8 * hh8) = o;
            }
#pragma unroll
            for (int rr = 0; rr < GR; ++rr) { kc[rr] = kn[rr]; qc[rr] = qn[rr]; }
        }
        if (meta) {
            ((float*)(ws + OFF_DECM))[col] = expf(bsum);
            bf16_t* km = (bf16_t*)(ws + OFF_KTM);
            for (int r = 0; r < 48; ++r) km[r * 512 + col] = 0;
            u32x4 z = {0u, 0u, 0u, 0u};
            u32x4* kz = (u32x4*)((bf16_t*)(ws + OFF_KTTM) + (size_t)col * 64);
#pragma unroll
            for (int j = 0; j < 6; ++j) kz[j] = z;
        } else {
            ((float*)(ws + OFF_DEC))[((size_t)b * 64 + c) * 512 + col] = expf(bsum);
        }
    }
}

constexpr int A_KROWB = 272, A_VROWB = 144, A_KB = 64 * A_KROWB, A_VB = 128 * A_VROWB, A_STAGE = A_KB + A_VB;
DI float max3f(float a, float b, float c) { float r; asm("v_max3_f32 %0, %1, %2, %3" : "=v"(r) : "v"(a), "v"(b), "v"(c)); return r; }
DI void attn_s(const unsigned char* sK, int tt, int qb, int qs, int sub, int l31, int h,
               const bf16x8 (&qf)[4], f32x16 (&O)[4], float& m, float& l, bf16x8 (&pb)[4]) {
    f32x16 st[2];
#pragma unroll
    for (int k2 = 0; k2 < 2; ++k2)
#pragma unroll
        for (int i = 0; i < 16; ++i) st[k2][i] = -m;
    {
        const unsigned char* kb = sK + l31 * A_KROWB + (sub * 64 + 8 * h) * 2;
        bf16x8 ka[4], kc[4];
#pragma unroll
        for (int i = 0; i < 4; ++i) ka[i] = *(const bf16x8*)(kb + (i & 1) * 32 * A_KROWB + (i >> 1) * 32);
        __builtin_amdgcn_sched_barrier(0);
#pragma unroll
        for (int i = 0; i < 4; ++i) kc[i] = *(const bf16x8*)(kb + (i & 1) * 32 * A_KROWB + (2 + (i >> 1)) * 32);
        __builtin_amdgcn_sched_barrier(0);
#pragma unroll
        for (int i = 0; i < 4; ++i) st[i & 1] = MFMA32(ka[i], qf[i >> 1], st[i & 1]);
        __builtin_amdgcn_sched_barrier(0);
#pragma unroll
        for (int i = 0; i < 4; ++i) st[i & 1] = MFMA32(kc[i], qf[2 + (i >> 1)], st[i & 1]);
    }
    if (tt == 0) {
#pragma unroll
        for (int i = 0; i < 16; ++i) { st[0][i] = -INFINITY; if (i < 8) st[1][i] = -INFINITY; }
    } else if (tt >= 2 * qb + 1) {
        const int kbase = (tt - 1) * 64 + 4 * h;
#pragma unroll
        for (int k2 = 0; k2 < 2; ++k2)
#pragma unroll
            for (int i = 0; i < 16; ++i) {
                const int key = kbase + k2 * 32 + (i & 3) + 8 * (i >> 2);
                if (key > qs) st[k2][i] = -INFINITY;
            }
    }
    float mx;
    {
        float t[11];
#pragma unroll
        for (int i = 0; i < 5; ++i) t[i] = max3f(st[0][3 * i], st[0][3 * i + 1], st[0][3 * i + 2]);
#pragma unroll
        for (int i = 0; i < 5; ++i) t[5 + i] = max3f(st[1][3 * i], st[1][3 * i + 1], st[1][3 * i + 2]);
        t[10] = fmaxf(st[0][15], st[1][15]);
        const float u0 = max3f(t[0], t[1], t[2]), u1 = max3f(t[3], t[4], t[5]), u2 = max3f(t[6], t[7], t[8]);
        mx = max3f(max3f(u0, u1, u2), t[9], t[10]);
    }
    mx = xor32_max(mx);
    if (tt == 0 || __builtin_amdgcn_ballot_w64(mx > 8.0f) != 0ull) {
        const float delta = tt == 0 ? mx : fmaxf(mx, 0.f);
        const float alpha = __builtin_amdgcn_exp2f(-delta);
        m += delta;
        l *= alpha;
#pragma unroll
        for (int d = 0; d < 4; ++d) O[d] = O[d] * alpha;
#pragma unroll
        for (int k2 = 0; k2 < 2; ++k2) st[k2] = st[k2] - delta;
    }
#pragma unroll
    for (int k2 = 0; k2 < 2; ++k2)
#pragma unroll
        for (int i = 0; i < 16; ++i) st[k2][i] = __builtin_amdgcn_exp2f(st[k2][i]);
    {
        const f32x16 sv = st[0] + st[1];
        const float ps = (((sv[0] + sv[1]) + (sv[2] + sv[3])) + ((sv[4] + sv[5]) + (sv[6] + sv[7]))) + (((sv[8] + sv[9]) + (sv[10] + sv[11])) + ((sv[12] + sv[13]) + (sv[14] + sv[15])));
        l += ps;
    }
#pragma unroll
    for (int k4 = 0; k4 < 4; ++k4) {
        const int k2 = k4 >> 1, o8 = 8 * (k4 & 1);
        u32x4 pk;
        pk.x = pk2(st[k2][o8 + 0], st[k2][o8 + 1]); pk.y = pk2(st[k2][o8 + 2], st[k2][o8 + 3]);
        pk.z = pk2(st[k2][o8 + 4], st[k2][o8 + 5]); pk.w = pk2(st[k2][o8 + 6], st[k2][o8 + 7]);
        pb[k4] = __builtin_bit_cast(bf16x8, pk);
    }
}
DI void attn_pv(const unsigned char* sV, int l31, int h, const bf16x8 (&pb)[4], f32x16 (&O)[4]) {
    {
        const unsigned char* vb = sV + l31 * A_VROWB + 16 * h;
        bf16x8 va[4], vc[4];
#pragma unroll
        for (int d = 0; d < 4; ++d) va[d] = *(const bf16x8*)(vb + d * 32 * A_VROWB);
        __builtin_amdgcn_sched_barrier(0);
#pragma unroll
        for (int d = 0; d < 4; ++d) vc[d] = *(const bf16x8*)(vb + d * 32 * A_VROWB + 32);
        __builtin_amdgcn_sched_barrier(0);
#pragma unroll
        for (int d = 0; d < 4; ++d) O[d] = MFMA32(va[d], pb[0], O[d]);
        __builtin_amdgcn_sched_barrier(0);
#pragma unroll
        for (int d = 0; d < 4; ++d) va[d] = *(const bf16x8*)(vb + d * 32 * A_VROWB + 64);
        __builtin_amdgcn_sched_barrier(0);
#pragma unroll
        for (int d = 0; d < 4; ++d) O[d] = MFMA32(vc[d], pb[1], O[d]);
        __builtin_amdgcn_sched_barrier(0);
#pragma unroll
        for (int d = 0; d < 4; ++d) vc[d] = *(const bf16x8*)(vb + d * 32 * A_VROWB + 96);
        __builtin_amdgcn_sched_barrier(0);
#pragma unroll
        for (int d = 0; d < 4; ++d) O[d] = MFMA32(va[d], pb[2], O[d]);
        __builtin_amdgcn_sched_barrier(0);
#pragma unroll
        for (int d = 0; d < 4; ++d) O[d] = MFMA32(vc[d], pb[3], O[d]);
    }
}

DI void attn_item(const Params& p, unsigned char* lds, int b, int hd, int qb, float lam) {
    const int tid = opaque_tid(), lane = tid & 63, wave = tid >> 6, l31 = lane & 31, h = lane >> 5;
    const int sub = wave >> 2, rt = wave & 3;
    const bf16_t* aq = (const bf16_t*)((unsigned char*)p.out + DO_AQ);
    const bf16_t* ak = (const bf16_t*)(p.ws + OFF_AK);
    const bf16_t* avT = (const bf16_t*)(p.ws + OFF_AVT);
    const bf16_t* akm = (const bf16_t*)(p.ws + OFF_AKM);
    const bf16_t* avTm = (const bf16_t*)(p.ws + OFF_AVTM);
    bf16_t* az = (bf16_t*)(p.ws + OFF_AZ);
    const int qs = qb * 128 + rt * 32 + l31;
    const size_t grow = (size_t)b * 4096 + qs;
    bf16x8 qf[4];
#pragma unroll
    for (int ks = 0; ks < 4; ++ks) qf[ks] = *(const bf16x8*)(aq + grow * 1024 + hd * 128 + sub * 64 + ks * 16 + 8 * h);
    f32x16 O[4];
#pragma unroll
    for (int d = 0; d < 4; ++d)
#pragma unroll
        for (int i = 0; i < 16; ++i) O[d][i] = 0.f;
    float m = 0.f, l = 0.f;
    const int T = 2 * qb + 3;
    u32x4 k0r[2], v0r[2];
    const int krow_ = tid >> 4, kc_ = tid & 15, vdv_ = tid >> 3, vc_ = tid & 7;
    const bf16_t* kp = ak + ((size_t)b * 4096 + krow_) * 1024 + hd * 128 + kc_ * 8;
    const bf16_t* vp_ = avT + ((size_t)(b * 8 + hd) * 128 + vdv_) * 4096 + vc_ * 8;
#define A_LOAD_REAL(KR, VR)                                                                                                   \
    {                                                                                                                         \
        KR[0] = *(const u32x4*)kp; KR[1] = *(const u32x4*)(kp + 32 * 1024); kp += 64 * 1024;                                  \
        VR[0] = *(const u32x4*)vp_; VR[1] = *(const u32x4*)(vp_ + (size_t)64 * 4096); vp_ += 64;                              \
    }
#define A_STORE(KR, VR, buf_)                                                                                                 \
    {                                                                                                                         \
        unsigned char* sK_ = lds + (buf_) * A_STAGE; unsigned char* sV_ = sK_ + A_KB;                                         \
        _Pragma("unroll") for (int i = 0; i < 2; ++i) { const int pi = tid + 512 * i, row = pi >> 4, c = pi & 15;              \
            *(u32x4*)(sK_ + row * A_KROWB + c * 16) = KR[i]; }                                                                \
        _Pragma("unroll") for (int i = 0; i < 2; ++i) { const int pi = tid + 512 * i, dv = pi >> 3, c = pi & 7;                \
            unsigned char* d_ = sV_ + dv * A_VROWB + (c >> 1) * 32 + 8 * (c & 1); u32x2 a_, b_; a_.x = VR[i].x; a_.y = VR[i].y; b_.x = VR[i].z; b_.y = VR[i].w; \
            *(u32x2*)d_ = a_; *(u32x2*)(d_ + 16) = b_; }                                                                      \
    }
    {
        const bf16_t* km_ = akm + (size_t)krow_ * 1024 + hd * 128 + kc_ * 8;
        k0r[0] = *(const u32x4*)km_; k0r[1] = *(const u32x4*)(km_ + 32 * 1024);
        const bf16_t* vm_ = avTm + (size_t)(hd * 128 + vdv_) * 64 + vc_ * 8;
        v0r[0] = *(const u32x4*)vm_; v0r[1] = *(const u32x4*)(vm_ + 64 * 64);
    }
    u32x4 k1r[2], v1r[2];
    A_LOAD_REAL(k1r, v1r);
#pragma unroll
    for (int ks = 0; ks < 4; ++ks) asm volatile("" : "+v"(qf[ks]));
    A_STORE(k0r, v0r, 0);
    __syncthreads();
    bf16x8 pb[4];
    int bc = 0, bp = 2, bn = 1;
    {
        attn_s(lds + bc * A_STAGE, 0, qb, qs, sub, l31, h, qf, O, m, l, pb);
        attn_pv(lds + bc * A_STAGE + A_KB, l31, h, pb, O);
        A_STORE(k1r, v1r, bn);
        __syncthreads();
        bp = bc; bc = bn; bn = (bn == 2) ? 0 : bn + 1;
    }
    for (int tt = 1; tt < T; ++tt) {
        if (tt + 1 < T) A_LOAD_REAL(k0r, v0r);
        attn_s(lds + bc * A_STAGE, tt, qb, qs, sub, l31, h, qf, O, m, l, pb);
        attn_pv(lds + bc * A_STAGE + A_KB, l31, h, pb, O);
        if (tt + 1 < T) A_STORE(k0r, v0r, bn);
        __syncthreads();
        bp = bc; bc = bn; bn = (bn == 2) ? 0 : bn + 1;
    }

#undef A_LOAD_REAL
#undef A_STORE
    const float ltot = xor32_sum(l);
    const float linv = 1.0f / ltot;
    u32x2 zz[4][4];
    if (sub == 0) {
#pragma unroll
        for (int d = 0; d < 4; ++d)
#pragma unroll
            for (int g = 0; g < 4; ++g) zz[d][g] = *(const u32x2*)(az + grow * 1024 + hd * 128 + d * 32 + 8 * g + 4 * h);
    }
    float* ex = (float*)lds;
    if (sub == 1) {
#pragma unroll
        for (int d = 0; d < 4; ++d) {
#pragma unroll
            for (int g = 0; g < 4; ++g) {
                f32x4 t; t.x = O[d][4 * g] * linv; t.y = O[d][4 * g + 1] * linv; t.z = O[d][4 * g + 2] * linv; t.w = O[d][4 * g + 3] * linv;
                *(f32x4*)(ex + (rt * 32 + l31) * 132 + d * 32 + 8 * g + 4 * h) = t;
            }
            __builtin_amdgcn_sched_barrier(0);
        }
    }
    __syncthreads();
    if (sub == 0) {
        float ss = 0.f;
#pragma unroll
        for (int d = 0; d < 4; ++d) {
#pragma unroll
            for (int g = 0; g < 4; ++g) {
                const f32x4 t = *(const f32x4*)(ex + (rt * 32 + l31) * 132 + d * 32 + 8 * g + 4 * h);
                const float o0 = O[d][4 * g] * linv - lam * t.x, o1 = O[d][4 * g + 1] * linv - lam * t.y;
                const float o2 = O[d][4 * g + 2] * linv - lam * t.z, o3 = O[d][4 * g + 3] * linv - lam * t.w;
                O[d][4 * g] = o0; O[d][4 * g + 1] = o1; O[d][4 * g + 2] = o2; O[d][4 * g + 3] = o3;
                ss += (o0 * o0 + o1 * o1) + (o2 * o2 + o3 * o3);
            }
            __builtin_amdgcn_sched_barrier(0);
        }
        ss = xor32_sum(ss);
        const float rstd = 1.0f / sqrtf(ss * (1.0f / 128.0f) + EPS);
#pragma unroll
        for (int d = 0; d < 4; ++d)
#pragma unroll
            for (int g = 0; g < 4; ++g) {
                bf16_t* zp = az + grow * 1024 + hd * 128 + d * 32 + 8 * g + 4 * h;
                const u32x2 z2 = zz[d][g];
                u32x2 o;
                o.x = pk2(O[d][4 * g] * rstd * siluf_(bflo(z2.x)), O[d][4 * g + 1] * rstd * siluf_(bfhi(z2.x)));
                o.y = pk2(O[d][4 * g + 2] * rstd * siluf_(bflo(z2.y)), O[d][4 * g + 3] * rstd * siluf_(bfhi(z2.y)));
                *(u32x2*)zp = o;
                if (g == 3) __builtin_amdgcn_sched_barrier(0);
            }
    }
    __syncthreads();
}

constexpr int L_KROWB = 272, L_VROWB = 144, L_SROWB = 272;
constexpr int GLA_DL = 2;
#define L_BAR() { asm volatile("s_waitcnt lgkmcnt(0)" ::: "memory"); __builtin_amdgcn_s_barrier(); asm volatile("" ::: "memory"); }
template <int DL>
DI void gla_item(const Params& p, unsigned char* lds, int b, int hh, int sl) {
    constexpr int SLW = 32 * DL, NVP = SLW / 64;
    constexpr int L_K = 0, L_V = 64 * L_KROWB, L_S = L_V + SLW * L_VROWB, L_KT = L_S + SLW * L_SROWB;
    const int tid = opaque_tid(), lane = tid & 63, wave = tid >> 6, l15 = lane & 15, g = lane >> 4;
    const int tt = wave & 3, dvt = wave >> 2;
    unsigned char* ws = p.ws;
    unsigned char* dout = (unsigned char*)p.out;
    const bf16_t* gq = (const bf16_t*)(dout + DO_GQ);
    const bf16_t* gk = (const bf16_t*)(dout + DO_GK);
    const bf16_t* gvT = (const bf16_t*)(ws + OFF_GVT);
    const bf16_t* ktt = (const bf16_t*)(ws + OFF_WIN_T);
    const float* dec = (const float*)(ws + OFF_DEC);
    bf16_t* gz = (bf16_t*)(ws + OFF_GZ);
    float* ssqb = (float*)(ws + OFF_SSQB);
    unsigned char* sK = lds + L_K; unsigned char* sV = lds + L_V; unsigned char* sS = lds + L_S; unsigned char* sKT = lds + L_KT;
    for (int i = tid; i < SLW * L_SROWB / 4; i += 512) ((unsigned*)sS)[i] = 0u;
    f32x4 sacc[DL][2];
#pragma unroll
    for (int dl = 0; dl < DL; ++dl)
#pragma unroll
        for (int c = 0; c < 2; ++c) sacc[dl][c] = (f32x4){0.f, 0.f, 0.f, 0.f};
    u32x4 nkA[2]; u32x4 nvA[NVP]; bf16x8 nqA[4]; u32x4 nktA[2]; float ndA[2]; u32x2 ngzA[DL];
    u32x4 nkB[2]; u32x4 nvB[NVP]; bf16x8 nqB[4]; u32x4 nktB[2]; float ndB[2]; u32x2 ngzB[DL];
    const int cc0 = 16 * (2 * tt) + l15;
    const int dv0 = 16 * (dvt * DL);
    const int krow_ = tid >> 4, kc_ = tid & 15, vdv_ = tid >> 3, vc_ = tid & 7;
    const bf16_t* kp = gk + ((size_t)b * 4096 + krow_) * 512 + hh * 128 + kc_ * 8;
    const bf16_t* vp_ = gvT + ((size_t)(b * 4 + hh) * 256 + sl * SLW + vdv_) * 4096 + vc_ * 8;
    const bf16_t* ktp = ktt + ((size_t)(b * 4 + hh) * 128 + vdv_) * 4096 + vc_ * 8;
    const float* dp = dec + (size_t)b * 64 * 512 + hh * 128 + cc0;
    const bf16_t* qp = gq + ((size_t)b * 4096 + 16 * tt + l15) * 512 + hh * 128 + 8 * g;
    bf16_t* gzp = gz + ((size_t)b * 4096 + 16 * tt + l15) * 1024 + hh * 256 + sl * SLW + dv0 + 4 * g;
#define L_LOAD_META(S)                                                                                                         \
    {                                                                                                                         \
        const bf16_t* km_ = (const bf16_t*)(ws + OFF_KTM) + (size_t)krow_ * 512 + hh * 128 + kc_ * 8;                         \
        nk##S[0] = *(const u32x4*)km_; nk##S[1] = *(const u32x4*)(km_ + 32 * 512);                                                  \
        _Pragma("unroll") for (int i = 0; i < NVP; ++i)                                                                       \
            nv##S[i] = *(const u32x4*)((const bf16_t*)(ws + OFF_GVTM) + (size_t)(hh * 256 + sl * SLW + vdv_ + 64 * i) * 64 + vc_ * 8); \
        _Pragma("unroll") for (int i = 0; i < 2; ++i)                                                                         \
            nkt##S[i] = *(const u32x4*)((const bf16_t*)(ws + OFF_KTTM) + (size_t)(hh * 128 + vdv_ + 64 * i) * 64 + vc_ * 8);     \
        _Pragma("unroll") for (int ct = 0; ct < 2; ++ct) nd##S[ct] = ((const float*)(ws + OFF_DECM))[hh * 128 + cc0 + 16 * ct];  \
        _Pragma("unroll") for (int ks = 0; ks < 4; ++ks) nq##S[ks] = (bf16x8){0, 0, 0, 0, 0, 0, 0, 0};                           \
        _Pragma("unroll") for (int dl = 0; dl < DL; ++dl) ngz##S[dl] = (u32x2){0u, 0u};                                          \
    }
#define L_LOAD_REAL(S)                                                                                                         \
    {                                                                                                                         \
        nk##S[0] = *(const u32x4*)kp; nk##S[1] = *(const u32x4*)(kp + 32 * 512); kp += 64 * 512;                                    \
        _Pragma("unroll") for (int i = 0; i < NVP; ++i) nv##S[i] = *(const u32x4*)(vp_ + (size_t)(64 * i) * 4096);               \
        vp_ += 64;                                                                                                            \
        _Pragma("unroll") for (int i = 0; i < 2; ++i) nkt##S[i] = *(const u32x4*)(ktp + (size_t)(64 * i) * 4096);              \
        ktp += 64;                                                                                                            \
        nd##S[0] = dp[0]; nd##S[1] = dp[16]; dp += 512;                                                                             \
        _Pragma("unroll") for (int ks = 0; ks < 4; ++ks) nq##S[ks] = *(const bf16x8*)(qp + 32 * ks);                             \
        qp += 64 * 512;                                                                                                       \
        _Pragma("unroll") for (int dl = 0; dl < DL; ++dl) ngz##S[dl] = *(const u32x2*)(gzp + 16 * dl);                           \
        gzp += 64 * 1024;                                                                                                     \
    }
#define L_STORE(S)                                                                                                             \
    {                                                                                                                         \
        _Pragma("unroll") for (int i = 0; i < 2; ++i) { const int pi = tid + 512 * i, row = pi >> 4, c = pi & 15;              \
            *(u32x4*)(sK + row * L_KROWB + c * 16) = nk##S[i]; }                                                                 \
        _Pragma("unroll") for (int i = 0; i < NVP; ++i) *(u32x4*)(sV + (vdv_ + 64 * i) * L_VROWB + vc_ * 16) = nv##S[i];          \
        _Pragma("unroll") for (int i = 0; i < 2; ++i) *(u32x4*)(sKT + (vdv_ + 64 * i) * L_VROWB + vc_ * 16) = nkt##S[i];          \
    }
    L_LOAD_META(A);
    L_LOAD_REAL(B);
    L_STORE(A);
#define GLA_STEP(n_, C, O) {                                                                                         \
        bf16x8 cq[4]; float cd[2]; u32x2 cgz[DL]; \
_Pragma("unroll") \
        for (int ks = 0; ks < 4; ++ks) cq[ks] = nq##C[ks]; \
_Pragma("unroll") \
        for (int ct = 0; ct < 2; ++ct) { cd[ct] = nd##C[ct]; } \
_Pragma("unroll") \
        for (int dl = 0; dl < DL; ++dl) cgz[dl] = ngz##C[dl]; \
_Pragma("unroll") \
        for (int ks = 0; ks < 4; ++ks) asm volatile("" : "+v"(cq[ks])); \
_Pragma("unroll") \
        for (int ct = 0; ct < 2; ++ct) { asm volatile("" : "+v"(cd[ct])); } \
_Pragma("unroll") \
        for (int dl = 0; dl < DL; ++dl) asm volatile("" : "+v"(cgz[dl])); \
        L_BAR(); \
        if ((n_) + 2 <= 64) L_LOAD_REAL(C); \
        if ((n_) > 0) { \
            f32x4 at[4]; \
_Pragma("unroll") \
            for (int jt = 0; jt < 4; ++jt) at[jt] = (f32x4){0.f, 0.f, 0.f, 0.f}; \
            { \
                const unsigned char* kb = sK + l15 * L_KROWB + 16 * g; \
                bf16x8 ka[8], kc[8]; \
_Pragma("unroll") \
                for (int i = 0; i < 8; ++i) ka[i] = *(const bf16x8*)(kb + (i & 3) * 16 * L_KROWB + (i >> 2) * 64); \
                __builtin_amdgcn_sched_barrier(0); \
_Pragma("unroll") \
                for (int i = 0; i < 8; ++i) kc[i] = *(const bf16x8*)(kb + (i & 3) * 16 * L_KROWB + (2 + (i >> 2)) * 64); \
                __builtin_amdgcn_sched_barrier(0); \
_Pragma("unroll") \
                for (int i = 0; i < 8; ++i) at[i & 3] = MFMA16(ka[i], cq[i >> 2], at[i & 3]); \
                __builtin_amdgcn_sched_barrier(0); \
_Pragma("unroll") \
                for (int i = 0; i < 8; ++i) at[i & 3] = MFMA16(kc[i], cq[2 + (i >> 2)], at[i & 3]); \
            } \
            const int tl = 16 * tt + l15; \
_Pragma("unroll") \
            for (int jt = 0; jt < 4; ++jt) \
_Pragma("unroll") \
                for (int i = 0; i < 4; ++i) if (16 * jt + 4 * g + i > tl) at[jt][i] = 0.f; \
            bf16x8 pa[2]; \
_Pragma("unroll") \
            for (int s2 = 0; s2 < 2; ++s2) { \
                u32x4 t; \
                t.x = pk2(at[2 * s2][0], at[2 * s2][1]); t.y = pk2(at[2 * s2][2], at[2 * s2][3]); \
                t.z = pk2(at[2 * s2 + 1][0], at[2 * s2 + 1][1]); t.w = pk2(at[2 * s2 + 1][2], at[2 * s2 + 1][3]); \
                pa[s2] = __builtin_bit_cast(bf16x8, t); \
            } \
            const size_t row = (size_t)b * 4096 + ((n_) - 1) * 64 + 16 * tt + l15; \
_Pragma("unroll") \
            for (int dl = 0; dl < DL; ++dl) { \
                const int dvr = dv0 + 16 * dl + l15; \
                f32x4 o = (f32x4){0.f, 0.f, 0.f, 0.f}; \
                { \
                    u32x4 vv[2]; bf16x8 sf[4]; \
_Pragma("unroll") \
                    for (int s2 = 0; s2 < 2; ++s2) { \
                        const unsigned char* vp = sV + dvr * L_VROWB + (32 * s2 + 4 * g) * 2; \
                        const u32x2 lo = *(const u32x2*)vp, hi = *(const u32x2*)(vp + 32); \
                        vv[s2].x = lo.x; vv[s2].y = lo.y; vv[s2].z = hi.x; vv[s2].w = hi.y; \
                    } \
_Pragma("unroll") \
                    for (int ks = 0; ks < 4; ++ks) sf[ks] = *(const bf16x8*)(sS + dvr * L_SROWB + (ks * 32 + 8 * g) * 2); \
                    __builtin_amdgcn_sched_barrier(0); \
                    f32x4 o2 = (f32x4){0.f, 0.f, 0.f, 0.f}; \
                    o = MFMA16(__builtin_bit_cast(bf16x8, vv[0]), pa[0], o); \
                    o2 = MFMA16(sf[0], cq[0], o2); \
                    o = MFMA16(__builtin_bit_cast(bf16x8, vv[1]), pa[1], o); \
                    o2 = MFMA16(sf[1], cq[1], o2); \
                    o = MFMA16(sf[2], cq[2], o); \
                    o2 = MFMA16(sf[3], cq[3], o2); \
                    o = o + o2; \
                } \
                float ss = (o[0] * o[0] + o[1] * o[1]) + (o[2] * o[2] + o[3] * o[3]); \
                ss = xor16_sum(ss); ss = xor32_sum(ss); \
                u32x2 ov; \
                ov.x = pk2(o[0] * siluf_(bflo(cgz[dl].x)), o[1] * siluf_(bfhi(cgz[dl].x))); \
                ov.y = pk2(o[2] * siluf_(bflo(cgz[dl].y)), o[3] * siluf_(bfhi(cgz[dl].y))); \
                *(u32x2*)(gz + row * 1024 + hh * 256 + sl * SLW + dv0 + 16 * dl + 4 * g) = ov; \
                if (g == 0) ssqb[(row * 4 + hh) * 16 + sl * 2 * DL + dvt * DL + dl] = ss; \
            } \
        } \
        bf16x8 vfs[DL][2]; \
_Pragma("unroll") \
        for (int dl = 0; dl < DL; ++dl) \
_Pragma("unroll") \
            for (int ks = 0; ks < 2; ++ks) vfs[dl][ks] = *(const bf16x8*)(sV + (dv0 + 16 * dl + l15) * L_VROWB + (32 * ks + 8 * g) * 2); \
        bf16x8 ckt[2][2]; \
        _Pragma("unroll") \
        for (int ct = 0; ct < 2; ++ct) \
        _Pragma("unroll") \
            for (int ks = 0; ks < 2; ++ks) ckt[ct][ks] = *(const bf16x8*)(sKT + (cc0 + 16 * ct) * L_VROWB + (32 * ks + 8 * g) * 2); \
        __builtin_amdgcn_sched_barrier(0); \
_Pragma("unroll") \
        for (int dl = 0; dl < DL; ++dl) { \
_Pragma("unroll") \
            for (int ks = 0; ks < 2; ++ks) { \
                sacc[dl][0] = MFMA16(vfs[dl][ks], ckt[0][ks], sacc[dl][0]); \
                sacc[dl][1] = MFMA16(vfs[dl][ks], ckt[1][ks], sacc[dl][1]); \
            } \
_Pragma("unroll") \
            for (int ct = 0; ct < 2; ++ct) \
_Pragma("unroll") \
                for (int i = 0; i < 4; ++i) sacc[dl][ct][i] *= cd[ct]; \
        } \
        L_BAR(); \
_Pragma("unroll") \
        for (int dl = 0; dl < DL; ++dl) \
_Pragma("unroll") \
            for (int ct = 0; ct < 2; ++ct) \
_Pragma("unroll") \
                for (int i = 0; i < 4; ++i) \
                    *(bf16_t*)(sS + (dv0 + 16 * dl + 4 * g + i) * L_SROWB + (cc0 + 16 * ct) * 2) = f2bf(sacc[dl][ct][i]); \
        if ((n_) + 1 <= 64) L_STORE(O); \
    }
    for (int n2 = 0; n2 <= 64; n2 += 2) {
        GLA_STEP(n2, A, B);
        if (n2 + 1 > 64) break;
        GLA_STEP(n2 + 1, B, A);
    }
#undef GLA_STEP
#undef L_LOAD_META
#undef L_LOAD_REAL
#undef L_STORE
    __syncthreads();
}

DI void phase2(const Params& p, unsigned char* lds) {
    const int tid = opaque_tid();
    float lam;
    {
        const int lane = tid & 63;
        const float a_ = wave_sum(p.lq1[lane] * p.lk1[lane]);
        const float b_ = wave_sum(p.lq2[lane] * p.lk2[lane]);
        lam = __uint_as_float((unsigned)__builtin_amdgcn_readfirstlane((int)__float_as_uint(expf(a_) - expf(b_) + 0.2f)));
    }
    volatile unsigned* sItem = (volatile unsigned*)(lds + LDS_ITEM);
    constexpr unsigned NSL = 8 / GLA_DL, N_GLA = 2 * NSL, N_ATT = 128;
    if (tid == 0) sItem[1] = 0u;
    for (;;) {
        if (tid == 0) {
            unsigned* heads = (unsigned*)(p.ws + OFF_XBAR + 15360);
            const unsigned x0 = (unsigned)__builtin_amdgcn_s_getreg((3 << 11) | 20) & 7u;
            unsigned k = sItem[1], it = 0xffffffffu;
            while (k < 8u) {
                const unsigned x = (x0 + k) & 7u;
                const unsigned got = atomicAdd(heads + x, 1u);
                if (got < N_GLA + N_ATT) { it = got | (x << 16); break; }
                ++k;
            }
            sItem[1] = k; sItem[0] = it;
        }
        __syncthreads();
        const unsigned item = (unsigned)__builtin_amdgcn_readfirstlane((int)sItem[0]);
        __syncthreads();
        if (item == 0xffffffffu) break;
        const unsigned x = item >> 16, idx = item & 0xffffu;
        if (idx < N_GLA) { const unsigned gi = x * N_GLA + idx; gla_item<GLA_DL>(p, lds, gi / (4 * NSL), (gi / NSL) & 3, gi % NSL); }
        else { const unsigned a = idx - N_GLA, pair = 4 * x + ((a >> 2) & 3); attn_item(p, lds, pair & 3, pair >> 2, 31 - (int)(((a >> 4) << 2) + (a & 3)), lam); }
    }
}

DI void phase25(const Params& p, unsigned char* lds) {
    const int tid = opaque_tid(), lane = tid & 63, wave = tid >> 6;
    const float* ssqb = (const float*)(p.ws + OFF_SSQB);
    bf16_t* gz = (bf16_t*)(p.ws + OFF_GZ);
    for (int it = blockIdx.x; it < MROWS / 32; it += gridDim.x) {
        const size_t row0 = (size_t)it * 32 + wave * 4;
        u32x4 u[4][2]; float s[4];
#pragma unroll
        for (int q = 0; q < 4; ++q) {
            const u32x4* ptr = (const u32x4*)(gz + (row0 + q) * 1024 + lane * 16);
            u[q][0] = ptr[0]; u[q][1] = ptr[1];
            s[q] = ssqb[((row0 + q) * 4 + (lane >> 4)) * 16 + (lane & 15)];
        }
#pragma unroll
        for (int q = 0; q < 4; ++q) {
            float t = s[q];
            t += __shfl_xor(t, 1); t += __shfl_xor(t, 2); t += __shfl_xor(t, 4); t += __shfl_xor(t, 8);
            const float r = 1.0f / sqrtf(t * (1.0f / 256.0f) + EPS);
            u32x4* ptr = (u32x4*)(gz + (row0 + q) * 1024 + lane * 16);
#pragma unroll
            for (int j = 0; j < 2; ++j) {
                const u32x4 a = u[q][j]; u32x4 o;
                o.x = pk2(bflo(a.x) * r, bfhi(a.x) * r); o.y = pk2(bflo(a.y) * r, bfhi(a.y) * r);
                o.z = pk2(bflo(a.z) * r, bfhi(a.z) * r); o.w = pk2(bflo(a.w) * r, bfhi(a.w) * r);
                ptr[j] = o;
            }
        }
    }
}

template <int PASS>
struct EpiMerge {
    static constexpr bool PERM = false, AFTER_DRAIN = false;
    unsigned char* ws; const PG8_LAS float* tab;
    DI void operator()(const pg8::f32x4 (&acc)[2][2][4][2], const pg8::Unit& u, int wr, int wc, int fr, int fq) const {
        const unsigned char* sg = ws + (PASS == 0 ? OFF_SGB : OFF_SGA);
        bf16_t* merged = (bf16_t*)(ws + OFF_AK);
#pragma unroll
        for (int ai = 0; ai < 2; ++ai)
#pragma unroll
            for (int m = 0; m < 4; ++m) {
                const size_t tok = (size_t)u.pm * 256 + ai * 128 + wr * 64 + m * 16 + fr;
#pragma unroll
                for (int bj = 0; bj < 2; ++bj)
#pragma unroll
                    for (int n = 0; n < 2; ++n) {
                        const size_t off = tok * 1024 + u.pn * 256 + bj * 128 + wc * 32 + n * 16 + 4 * fq;
                        const unsigned ug = *(const unsigned*)(sg + off);
                        const float q = (PASS == 0 ? tab[(ai * 128 + wr * 64 + m * 16 + fr) * 4 + 3] : 1.0f) * (1.0f / 255.0f);
                        float m0 = (float)(ug & 255u) * q * acc[ai][bj][m][n][0], m1 = (float)((ug >> 8) & 255u) * q * acc[ai][bj][m][n][1];
                        float m2 = (float)((ug >> 16) & 255u) * q * acc[ai][bj][m][n][2], m3 = (float)(ug >> 24) * q * acc[ai][bj][m][n][3];
                        if (PASS == 1) { const u32x2 t = *(const u32x2*)(merged + off); m0 += bflo(t.x); m1 += bfhi(t.x); m2 += bflo(t.y); m3 += bfhi(t.y); }
                        u32x2 o; o.x = pk2(m0, m1); o.y = pk2(m2, m3);
                        *(u32x2*)(merged + off) = o;
                    }
            }
    }
};
struct EpiOut {
    static constexpr bool PERM = false, AFTER_DRAIN = true;
    unsigned char* ws; const float* x; float* out; const float* fw;
    DI void fused(pg8::f32x4 (&acc)[2][2][4][2], const pg8::Unit& u, int wr, int wc, int fr, int fq, PG8_LAS unsigned char* lds, int wid, int lane) const {
        float* ssqh = (float*)(ws + OFF_SSQH);
        unsigned* pcnt = (unsigned*)(ws + OFF_XBAR + 14336) + u.pm;
#pragma unroll
        for (int ai = 0; ai < 2; ++ai)
#pragma unroll
            for (int m = 0; m < 4; ++m) {
                const size_t tok = (size_t)u.pm * 256 + ai * 128 + wr * 64 + m * 16 + fr;
                float ss = 0.f;
#pragma unroll
                for (int bj = 0; bj < 2; ++bj)
#pragma unroll
                    for (int n = 0; n < 2; ++n) {
                        const size_t off = tok * 1024 + u.pn * 256 + bj * 128 + wc * 32 + n * 16 + 4 * fq;
                        const f32x4 xv = *(const f32x4*)(x + off);
                        f32x4 o = acc[ai][bj][m][n];
                        o.x += xv.x; o.y += xv.y; o.z += xv.z; o.w += xv.w;
                        acc[ai][bj][m][n] = o;
                        ss += (o.x * o.x + o.y * o.y) + (o.z * o.z + o.w * o.w);
                    }
                ss = xor16_sum(ss); ss = xor32_sum(ss);
                if (fq == 0) ssqh[tok * 16 + u.pn * 4 + wc] = ss;
            }
        asm volatile("s_waitcnt vmcnt(0)" ::: "memory");
        __syncthreads();
        if (threadIdx.x == 0) {
            __builtin_amdgcn_fence(__ATOMIC_RELEASE, "agent");
            asm volatile("s_waitcnt vmcnt(0)" ::: "memory");
            __hip_atomic_fetch_add(pcnt, 1u, __ATOMIC_RELAXED, __HIP_MEMORY_SCOPE_AGENT);
            unsigned spins = 0u;
            while (__hip_atomic_load(pcnt, __ATOMIC_RELAXED, __HIP_MEMORY_SCOPE_AGENT) < 4u && ++spins < (1u << 22)) __builtin_amdgcn_s_sleep(1);
            __builtin_amdgcn_fence(__ATOMIC_ACQUIRE, "agent");
            asm volatile("s_waitcnt vmcnt(0)" ::: "memory");
        }
        __syncthreads();
#pragma unroll
        for (int ai = 0; ai < 2; ++ai)
#pragma unroll
            for (int m = 0; m < 4; ++m) {
                const size_t tok = (size_t)u.pm * 256 + ai * 128 + wr * 64 + m * 16 + fr;
                const f32x4* sp = (const f32x4*)(ssqh + tok * 16);
                const f32x4 a = sp[0], b2 = sp[1], c = sp[2], d = sp[3];
                const float s = ((a.x + a.y) + (a.z + a.w)) + ((b2.x + b2.y) + (b2.z + b2.w)) + ((c.x + c.y) + (c.z + c.w)) + ((d.x + d.y) + (d.z + d.w));
                const float rstd = 1.0f / sqrtf(s * (1.0f / 1024.0f) + EPS);
#pragma unroll
                for (int bj = 0; bj < 2; ++bj)
#pragma unroll
                    for (int n = 0; n < 2; ++n) {
                        const int col = u.pn * 256 + bj * 128 + wc * 32 + n * 16 + 4 * fq;
                        const f32x4 w = *(const f32x4*)(fw + col);
                        f32x4 o = acc[ai][bj][m][n];
                        o.x = o.x * rstd * w.x; o.y = o.y * rstd * w.y; o.z = o.z * rstd * w.z; o.w = o.w * rstd * w.w;
                        __builtin_nontemporal_store(o, (f32x4*)(out + tok * 1024 + col));
                    }
            }
    }
};
DI void phase3(const Params& p, unsigned char* lds) {
    SchedSq S;
    {
        pg8::Unit u0; S.next(0, u0);
        const int tid = opaque_tid();
        float* tabw = (float*)(lds + 147456);
        if (tid < 256) {
            const float* sp = (const float*)(p.ws + OFF_SSQB) + ((size_t)u0.pm * 256 + tid) * 64;
            float r[4];
#pragma unroll
            for (int hh = 0; hh < 4; ++hh) {
                const f32x4 a = *(const f32x4*)(sp + hh * 16), b2 = *(const f32x4*)(sp + hh * 16 + 4), c = *(const f32x4*)(sp + hh * 16 + 8), d = *(const f32x4*)(sp + hh * 16 + 12);
                const float s = ((a.x + a.y) + (a.z + a.w)) + ((b2.x + b2.y) + (b2.z + b2.w)) + ((c.x + c.y) + (c.z + c.w)) + ((d.x + d.y) + (d.z + d.w));
                r[hh] = 1.0f / sqrtf(s * (1.0f / 256.0f) + EPS);
            }
            f32x4 o; o.x = r[0] / r[1]; o.y = r[1] / r[2]; o.z = r[2] / r[3]; o.w = r[3];
            *(f32x4*)(tabw + tid * 4) = o;
        }
        __syncthreads();
    }
    {
        pg8::Gemm g; g.A = (const bf16_t*)(p.ws + OFF_GZ); g.Bt = (const bf16_t*)(p.ws + OFF_WB_T); g.M = MROWS; g.N = 1024; g.K = 1024;
        EpiMerge<0> E; E.ws = p.ws; E.tab = (const PG8_LAS float*)(lds + 147456);
        pg8::gemm_phase<EpiMerge<0>, SchedSq, true, true, true>((PG8_LAS unsigned char*)lds, g, S, E);
    }
    {
        pg8::Gemm g; g.A = (const bf16_t*)(p.ws + OFF_AZ); g.Bt = (const bf16_t*)(p.ws + OFF_WA_T); g.M = MROWS; g.N = 1024; g.K = 1024;
        EpiMerge<1> E; E.ws = p.ws; E.tab = (const PG8_LAS float*)(lds + 147456);
        pg8::gemm_phase<EpiMerge<1>, SchedSq, true, true>((PG8_LAS unsigned char*)lds, g, S, E);
    }
}
DI void phase4(const Params& p, unsigned char* lds) {
    SchedSq S;
    pg8::Gemm g; g.A = (const bf16_t*)(p.ws + OFF_AK); g.Bt = (const bf16_t*)(p.ws + OFF_WO_T); g.M = MROWS; g.N = 1024; g.K = 1024;
    EpiOut E; E.ws = p.ws; E.x = p.x; E.out = p.out; E.fw = p.final_w;
    pg8::gemm_phase<EpiOut, SchedSq, false, true>((PG8_LAS unsigned char*)lds, g, S, E);
}

DI void phase5(const Params& p, unsigned char* lds) {
    const int tid = opaque_tid(), lane = tid & 63, wave = tid >> 6;
    const float* ssqh = (const float*)(p.ws + OFF_SSQH);
    for (int it = blockIdx.x; it < MROWS / 8; it += gridDim.x) {
        const size_t row = (size_t)it * 8 + wave;
        float s = lane < 16 ? ssqh[row * 16 + lane] : 0.f;
        s = wave_sum(s);
        const float rstd = 1.0f / sqrtf(s * (1.0f / 1024.0f) + EPS);
        f32x4* orow = (f32x4*)(p.out + row * 1024) + lane;
        const f32x4* wrow = (const f32x4*)p.final_w + lane;
#pragma unroll
        for (int j = 0; j < 4; ++j) {
            f32x4 v = orow[64 * j]; const f32x4 w = wrow[64 * j];
            v.x = v.x * rstd * w.x; v.y = v.y * rstd * w.y; v.z = v.z * rstd * w.z; v.w = v.w * rstd * w.w;
            orow[64 * j] = v;
        }
    }
}

#define XB_TMO      128
#define XB_XCNT(j)  (256  + 64 * (j))
#define XB_XSUB(j)  (1280 + 64 * (j))
#define XB_XGEN(j)  (2304 + 64 * (j))
#define XB_TOP      3328
#define XB_TOPGEN   3392
#define XCD_BAR_WORDS 3456
#define XB_SPIN_CAP (1u << 18)
#define LAS __attribute__((address_space(3)))
DI unsigned xb_ld(unsigned* p)              { return __hip_atomic_load(p, __ATOMIC_RELAXED, __HIP_MEMORY_SCOPE_AGENT); }
DI unsigned xb_add(unsigned* p, unsigned v) { return __hip_atomic_fetch_add(p, v, __ATOMIC_RELAXED, __HIP_MEMORY_SCOPE_AGENT); }
DI unsigned xb_xcc_id() { return (unsigned)__builtin_amdgcn_s_getreg((3 << 11) | 20) & 0xFu; }
#define XB_SPIN(cond, bar) do { unsigned _sp = 0; while (cond) { __builtin_amdgcn_s_sleep(1); \
    if ((++_sp & 255u) == 0u) { if (xb_ld(&(bar)[XB_TMO])) break; if (_sp > XB_SPIN_CAP) { atomicAdd(&(bar)[XB_TMO], 1u); break; } } } } while (0)
struct XcdBarrier { unsigned* bar; unsigned x; volatile LAS unsigned* st; };
DI XcdBarrier xcd_barrier_post(unsigned* bar, volatile LAS unsigned* st) {
    XcdBarrier b; b.bar = bar; b.x = xb_xcc_id(); b.st = st;
    if (threadIdx.x == 0) (void)xb_add(&bar[XB_XCNT(b.x)], 1u);
    return b;
}
DI void xcd_barrier_complete(unsigned* bar, unsigned x, unsigned& nloc, unsigned& nx) {
    const unsigned G = gridDim.x * gridDim.y * gridDim.z;
    unsigned sum, cnt, mine, sp = 0u;
    for (;;) {
        sum = 0u; cnt = 0u; mine = 0u;
#pragma unroll
        for (unsigned j = 0; j < 16; ++j) { const unsigned c = xb_ld(&bar[XB_XCNT(j)]); sum += c; cnt += (c > 0u) ? 1u : 0u; mine = (j == x) ? c : mine; }
        if (sum == G) break;
        __builtin_amdgcn_s_sleep(1);
        if ((++sp & 255u) == 0u) { if (xb_ld(&bar[XB_TMO])) break; if (sp > XB_SPIN_CAP) { atomicAdd(&bar[XB_TMO], 1u); break; } }
    }
    nloc = mine > 0u ? mine : 1u; nx = cnt > 0u ? cnt : 1u;
}
DI void xcd_barrier(const XcdBarrier& b) {
    asm volatile("s_waitcnt vmcnt(0)" ::: "memory");
    __syncthreads();
    if (threadIdx.x == 0) {
        unsigned* bar = b.bar;
        __builtin_amdgcn_s_waitcnt(0);
        unsigned nloc = b.st[0], nx = b.st[1];
        if (nloc == 0u) { xcd_barrier_complete(bar, b.x, nloc, nx); b.st[0] = nloc; b.st[1] = nx; }
        const unsigned old = xb_add(&bar[XB_XSUB(b.x)], 1u);
        const unsigned gen = old / nloc;
        if (old + 1u == (gen + 1u) * nloc) {
            __builtin_amdgcn_fence(__ATOMIC_RELEASE, "agent");
            asm volatile("s_waitcnt vmcnt(0)" ::: "memory");
            const unsigned og = xb_add(&bar[XB_TOP], 1u);
            const unsigned tg = og / nx;
            if (og + 1u == (tg + 1u) * nx) xb_add(&bar[XB_TOPGEN], 1u);
            else XB_SPIN(xb_ld(&bar[XB_TOPGEN]) == tg, bar);
            __builtin_amdgcn_fence(__ATOMIC_ACQUIRE, "agent");
            xb_add(&bar[XB_XGEN(b.x)], 1u);
            asm volatile("s_waitcnt vmcnt(0)" ::: "memory");
        } else {
            XB_SPIN(xb_ld(&bar[XB_XGEN(b.x)]) == gen, bar);
            __builtin_amdgcn_fence(__ATOMIC_ACQUIRE, "agent");
            asm volatile("s_waitcnt vmcnt(0)" ::: "memory");
        }
    }
    __syncthreads();
}

DI void run_phase(const Params& p, unsigned char* lds, int ph) {
    switch (ph) {
        case 0: phase0(p, lds); break;
        case 1: phase1(p, lds); break;
        case 2: phase15(p, lds); break;
        case 3: phase2(p, lds); break;
        case 4: phase25(p, lds); phase3(p, lds); break;
        case 5: phase4(p, lds); break;
        default: phase5(p, lds); break;
    }
}

__global__ void __launch_bounds__(512) hybrid_fwd(Params p) {
    extern __shared__ __attribute__((aligned(16))) unsigned char lds[];
#if MULTI_LAUNCH
    run_phase(p, lds, p.phase_lo);
#else
    cg::grid_group grid = cg::this_grid();
    if (p.phase_lo == 77) grid.sync();
    {
        volatile LAS unsigned* st = (volatile LAS unsigned*)(lds + LDS_ITEM + 16);
        if (threadIdx.x == 0) { st[0] = 0u; st[1] = 0u; }
        __syncthreads();
        (void)xcd_barrier_post((unsigned*)(p.ws + OFF_XBAR), st);
    }
#define GRID_BARRIER() { XcdBarrier xb_; xb_.bar = (unsigned*)(p.ws + OFF_XBAR); xb_.x = xb_xcc_id(); xb_.st = (volatile LAS unsigned*)(lds + LDS_ITEM + 16); xcd_barrier(xb_); }
    phase0(p, lds); GRID_BARRIER();
    phase1(p, lds); GRID_BARRIER();
    phase15(p, lds); GRID_BARRIER();
    phase2(p, lds); GRID_BARRIER();
    phase3(p, lds); GRID_BARRIER();
    phase4(p, lds);
#endif
}

extern "C" void kernel_launch(void* const* d_in, const int* in_sizes, int n_in, void* d_out, int out_size, void* d_ws, size_t ws_size, hipStream_t stream) {
    static int grid = 0;
    if (grid == 0) {
        int dev = 0, cus = 0, per_cu = 0;
        hipGetDevice(&dev);
        hipDeviceGetAttribute(&cus, hipDeviceAttributeMultiprocessorCount, dev);
        hipFuncSetAttribute((const void*)hybrid_fwd, hipFuncAttributeMaxDynamicSharedMemorySize, LDS_BYTES);
        hipOccupancyMaxActiveBlocksPerMultiprocessor(&per_cu, (const void*)hybrid_fwd, 512, LDS_BYTES);
        if (per_cu < 1) per_cu = 1;
        if (per_cu > 1) per_cu = 1;
        if (cus <= 0) cus = 256;
        grid = cus * per_cu;
    }
    hipMemsetAsync((unsigned char*)d_ws + OFF_XBAR, 0, 16384, stream);
    Params p{};
    p.x = (const float*)d_in[0]; p.meta = (const float*)d_in[1]; p.norm_w = (const float*)d_in[2]; p.w_in = (const float*)d_in[3];
    p.lq1 = (const float*)d_in[4]; p.lk1 = (const float*)d_in[5]; p.lq2 = (const float*)d_in[6]; p.lk2 = (const float*)d_in[7];
    p.subln_w = (const float*)d_in[8]; p.gate_w2 = (const float*)d_in[9]; p.gate_b = (const float*)d_in[10]; p.gla_norm_w = (const float*)d_in[11];
    p.wa = (const float*)d_in[12]; p.wb = (const float*)d_in[13]; p.wo = (const float*)d_in[14]; p.final_w = (const float*)d_in[15];
    p.out = (float*)d_out; p.ws = (unsigned char*)d_ws;
#if MULTI_LAUNCH
    for (int ph = 0; ph < 7; ++ph) {
        p.phase_lo = ph; p.phase_hi = ph + 1;
        hipLaunchKernelGGL(hybrid_fwd, dim3(grid), dim3(512), LDS_BYTES, stream, p);
    }
#else
    p.phase_lo = 0; p.phase_hi = 7;
    void* args[] = {&p};
    hipError_t e = hipLaunchCooperativeKernel((const void*)hybrid_fwd, dim3(grid), dim3(512), args, LDS_BYTES, stream);
    if (e != hipSuccess) fprintf(stderr, "cooperative launch failed: %s (grid %d)\n", hipGetErrorString(e), grid);
#endif
}
```

```cpp
#include <hip/hip_runtime.h>
#include <hip/hip_cooperative_groups.h>
#include <cstdio>
#include <cstdint>
namespace cg = cooperative_groups;

#ifndef MULTI_LAUNCH
#define MULTI_LAUNCH 0
#endif
#ifndef PROBE_REP
#define PROBE_REP 0
#endif

typedef unsigned short bf16_t;
typedef short bf16x8 __attribute__((ext_vector_type(8)));
typedef float f32x4 __attribute__((ext_vector_type(4)));
typedef float f32x2 __attribute__((ext_vector_type(2)));
typedef float f32x16 __attribute__((ext_vector_type(16)));
typedef unsigned u32x4 __attribute__((ext_vector_type(4)));
typedef unsigned u32x2 __attribute__((ext_vector_type(2)));
typedef __bf16 bfv2 __attribute__((ext_vector_type(2)));

#define DI __device__ __forceinline__
#define MFMA32(a, b, c) __builtin_amdgcn_mfma_f32_32x32x16_bf16((a), (b), (c), 0, 0, 0)
#define MFMA16(a, b, c) __builtin_amdgcn_mfma_f32_16x16x32_bf16((a), (b), (c), 0, 0, 0)

DI unsigned pk2(float a, float b) { f32x2 v = {a, b}; return __builtin_bit_cast(unsigned, __builtin_convertvector(v, bfv2)); }
DI float bf2f(bf16_t v) { return __uint_as_float(((unsigned)v) << 16); }
DI float bflo(unsigned u) { return __uint_as_float(u << 16); }
DI float bfhi(unsigned u) { return __uint_as_float(u & 0xffff0000u); }
DI bf16_t f2bf(float a) { return (bf16_t)(pk2(a, 0.f) & 0xffffu); }
DI float wave_sum(float v) {
#pragma unroll
    for (int o = 32; o; o >>= 1) v += __shfl_xor(v, o);
    return v;
}
DI int opaque_tid() { int t = threadIdx.x; asm volatile("" : "+v"(t)); return t; }
DI float xor32_sum(float x) { auto r = __builtin_amdgcn_permlane32_swap(__float_as_uint(x), __float_as_uint(x), false, false); return __uint_as_float(r[0]) + __uint_as_float(r[1]); }
DI float xor16_sum(float x) { auto r = __builtin_amdgcn_permlane16_swap(__float_as_uint(x), __float_as_uint(x), false, false); return __uint_as_float(r[0]) + __uint_as_float(r[1]); }
DI float xor32_max(float x) { auto r = __builtin_amdgcn_permlane32_swap(__float_as_uint(x), __float_as_uint(x), false, false); return fmaxf(__uint_as_float(r[0]), __uint_as_float(r[1])); }
DI float sigmoidf_(float z) { return __builtin_amdgcn_rcpf(1.f + __expf(-z)); }
DI float siluf_(float z) { return z * __builtin_amdgcn_rcpf(1.f + __expf(-z)); }

constexpr int D = 1024, NB = 4, SEQ = 4096, MROWS = NB * SEQ;
constexpr int NIN = 9232, NINP = 9344;
constexpr float EPS = 1e-5f;

constexpr size_t SZ_ACT = (size_t)MROWS * 1024 * 2;
constexpr size_t OFF_WIN_T = 0;
constexpr size_t OFF_WA_T = OFF_WIN_T + (size_t)NINP * 1024 * 2;
constexpr size_t OFF_WB_T = OFF_WA_T + 2097152;
constexpr size_t OFF_WO_T = OFF_WB_T + 2097152;
constexpr size_t OFF_AK = OFF_WO_T + 2097152;
constexpr size_t OFF_AVT = OFF_AK + SZ_ACT;
constexpr size_t OFF_AZ = OFF_AVT + SZ_ACT;
constexpr size_t OFF_GVT = OFF_AZ + SZ_ACT;
constexpr size_t OFF_GZ = OFF_GVT + SZ_ACT;
constexpr size_t OFF_GA = OFF_GZ + SZ_ACT;
constexpr size_t OFF_GB = OFF_GA + SZ_ACT;
constexpr size_t OFF_GLR = OFF_GB + SZ_ACT;
constexpr size_t OFF_RSTD = OFF_GLR + (size_t)MROWS * 16 * 2;
constexpr size_t OFF_ROPE = OFF_RSTD + 65792;
constexpr size_t OFF_AKM = OFF_ROPE + 263168;
constexpr size_t OFF_AVTM = OFF_AKM + 131072;
constexpr size_t OFF_GVTM = OFF_AVTM + 131072;
constexpr size_t OFF_GKM = OFF_GVTM + 131072;
constexpr size_t OFF_GLRM = OFF_GKM + 16384;
constexpr size_t OFF_KTM = OFF_GLRM + 512;
constexpr size_t OFF_KTTM = OFF_KTM + 65536;
constexpr size_t OFF_DEC = OFF_KTTM + 65536;
constexpr size_t OFF_DECM = OFF_DEC + 524288;
constexpr size_t OFF_SSQB = OFF_DECM + 2048;
constexpr size_t OFF_SSQH = OFF_SSQB + 4194304;
constexpr size_t OFF_CTR = OFF_SSQH + 1048576;
constexpr size_t OFF_XBM = OFF_CTR + 256;
constexpr size_t OFF_XBAR = OFF_XBM + 32768;
constexpr size_t WS_END = OFF_XBAR + 16384;
constexpr size_t OFF_XB = OFF_GA;
constexpr size_t OFF_SGA = OFF_GB;
constexpr size_t OFF_SGB = OFF_GB + (size_t)MROWS * 1024;
static_assert(WS_END <= 268435456ull, "workspace over 256 MiB");
constexpr size_t DO_AQ = 0, DO_GQ = SZ_ACT, DO_GK = SZ_ACT + SZ_ACT / 2;

constexpr int G_ROWB = 144;
constexpr int G_SW = 128 * G_ROWB, G_SX = 256 * G_ROWB, G_STAGE = G_SW + G_SX;
constexpr int G_SW4 = 256 * G_ROWB, G_STAGE4 = G_SW4 + G_SX;
constexpr int LDS_SCALE = 2 * G_STAGE4;
constexpr int LDS_ITEM = LDS_SCALE + 4096;
constexpr int LDS_BYTES = LDS_ITEM + 64;

struct Params {
    const float *x, *meta, *norm_w, *w_in, *lq1, *lk1, *lq2, *lk2, *subln_w, *gate_w2, *gate_b, *gla_norm_w, *wa, *wb, *wo, *final_w;
    float* out;
    unsigned char* ws;
    int phase_lo, phase_hi;
};

template <int MODE>
DI void p0_transpose_item(const Params& p, int item, float* tile) {
    const int tid = opaque_tid();
    const float* W = MODE == 0 ? p.w_in : MODE == 1 ? p.wa : MODE == 2 ? p.wb : p.wo;
    const int ldw = MODE == 0 ? NIN : 1024;
    const int nbc = MODE == 0 ? NINP / 128 : 8;
    bf16_t* WT = (bf16_t*)(p.ws + (MODE == 0 ? OFF_WIN_T : MODE == 1 ? OFF_WA_T : MODE == 2 ? OFF_WB_T : OFF_WO_T));
    const int kb = item / nbc, nb = item % nbc, k0 = kb * 64, n0 = nb * 128;
    const int nn = tid & 127, n = n0 + nn;
    int src = n;
    if (MODE == 0) { src = n < 7168 ? n : (n < 9216 ? n + 16 : (n < 9232 ? n - 2048 : -1)); }
    float v[16];
#pragma unroll
    for (int i = 0; i < 16; ++i) {
        const int k = k0 + (tid >> 7) + 4 * i;
        v[i] = src >= 0 ? __builtin_nontemporal_load(W + (size_t)k * ldw + src) : 0.f;
    }
#pragma unroll
    for (int i = 0; i < 16; ++i) {
        const int kk = (tid >> 7) + 4 * i, k = k0 + kk;
        float sc = 1.f;
        if (MODE == 0) sc = p.norm_w[k];
        if (MODE == 1) sc = 0.8f * p.subln_w[k & 127];
        if (MODE == 2) sc = p.gla_norm_w[k & 255];
        tile[kk * 129 + nn] = v[i] * sc;
    }
    __syncthreads();
    {
        const int on = tid >> 2, c = tid & 3;
        const float* s = tile + (16 * c) * 129 + on;
        u32x4 o0, o1;
        o0.x = pk2(s[0 * 129], s[1 * 129]); o0.y = pk2(s[2 * 129], s[3 * 129]); o0.z = pk2(s[4 * 129], s[5 * 129]); o0.w = pk2(s[6 * 129], s[7 * 129]);
        o1.x = pk2(s[8 * 129], s[9 * 129]); o1.y = pk2(s[10 * 129], s[11 * 129]); o1.z = pk2(s[12 * 129], s[13 * 129]); o1.w = pk2(s[14 * 129], s[15 * 129]);
        u32x4* dst = (u32x4*)(WT + (size_t)(n0 + on) * 1024 + k0 + 16 * c);
        dst[0] = o0; dst[1] = o1;
    }
    __syncthreads();
}

DI void phase0(const Params& p, unsigned char* lds) {
    const int tid = opaque_tid(), lane = tid & 63, wave = tid >> 6;
    float* tile = (float*)lds;
    constexpr int I_WIN = 16 * (NINP / 128), I_SQ = 128;
    constexpr int I_T = I_WIN + 3 * I_SQ;
    constexpr int I_RSTD = (MROWS + 16 + 15) / 16;
    constexpr int I_ROPE = (4112 * 8 + 511) / 512;
    constexpr int I_ZERO = 393216 / 8192;
    constexpr int I_ALL = I_T + I_RSTD + I_ROPE + I_ZERO;
    for (int it = blockIdx.x; it < I_ALL; it += gridDim.x) {
        int r = it;
        if (r < I_WIN) { p0_transpose_item<0>(p, r, tile); continue; } r -= I_WIN;
        if (r < I_SQ) { p0_transpose_item<1>(p, r, tile); continue; } r -= I_SQ;
        if (r < I_SQ) { p0_transpose_item<2>(p, r, tile); continue; } r -= I_SQ;
        if (r < I_SQ) { p0_transpose_item<3>(p, r, tile); continue; } r -= I_SQ;
        if (r < I_RSTD) {
            const int row0 = r * 16 + wave * 2;
            f32x4 v[2][4];
#pragma unroll
            for (int q = 0; q < 2; ++q) {
                const int row = row0 + q < MROWS + 16 ? row0 + q : MROWS + 15;
                const float* srcp = row < MROWS ? p.x + (size_t)row * 1024 : p.meta + (size_t)(row - MROWS) * 1024;
                const f32x4* xr = (const f32x4*)srcp + lane;
#pragma unroll
                for (int j = 0; j < 4; ++j) v[q][j] = __builtin_nontemporal_load(xr + 64 * j);
            }
#pragma unroll
            for (int q = 0; q < 2; ++q) {
                const int row = row0 + q;
                float s = 0.f;
#pragma unroll
                for (int j = 0; j < 4; ++j) s += (v[q][j].x * v[q][j].x + v[q][j].y * v[q][j].y) + (v[q][j].z * v[q][j].z + v[q][j].w * v[q][j].w);
                s = wave_sum(s);
                if (row < MROWS + 16) {
                    if (lane == 0) ((float*)(p.ws + OFF_RSTD))[row] = 1.0f / sqrtf(s * (1.0f / 1024.0f) + EPS);
                    bf16_t* xbrow = row < MROWS ? (bf16_t*)(p.ws + OFF_XB) + (size_t)row * 1024 : (bf16_t*)(p.ws + OFF_XBM) + (size_t)(row - MROWS) * 1024;
#pragma unroll
                    for (int j = 0; j < 4; ++j) { u32x2 o; o.x = pk2(v[q][j].x, v[q][j].y); o.y = pk2(v[q][j].z, v[q][j].w); *(u32x2*)(xbrow + 256 * j + 4 * lane) = o; }
                }
            }
            continue;
        }
        r -= I_RSTD;
        if (r < I_ROPE) {
            const int e = r * 512 + tid;
            if (e < 4112 * 8) {
                const int pos = e >> 3, i = e & 7;
                const float inv = powf(500000.0f, -(float)i / 8.0f);
                const float ang = (float)pos * inv;
                float* t = (float*)(p.ws + OFF_ROPE) + (size_t)e * 2;
                t[0] = cosf(ang); t[1] = sinf(ang);
            }
            continue;
        }
        r -= I_ROPE;
        { u32x4 z = {0u, 0u, 0u, 0u}; *(u32x4*)(p.ws + OFF_AKM + (size_t)r * 8192 + tid * 16) = z; }
    }
}

namespace pg8 {
#define PG8_LAS __attribute__((address_space(3)))
typedef unsigned short bf16_t;
typedef short bf16x8 __attribute__((ext_vector_type(8)));
typedef float f32x4 __attribute__((ext_vector_type(4)));
typedef unsigned u32x4 __attribute__((ext_vector_type(4)));
constexpr int BM = 256, BK = 64, HALF = 128, HTB = HALF * BK * 2  , STAGE_BYTES = 8 * HTB, NXCD = 8, WGM = 8;

__host__ __device__ __forceinline__ int lds_byte(int r, int c) { const int st = (r >> 4) * 2 + (c >> 5), rr = r & 15, cc = c & 31, ob = rr * 64 + cc * 2; return st * 1024 + (ob ^ (((ob >> 9) & 1) << 5)); }
__host__ __device__ __forceinline__ void stage_rc(int b, int& R, int& C) { const int st = b / 1024, sb = b % 1024, swz = sb ^ (((sb >> 9) & 1) << 5); R = (st >> 1) * 16 + swz / 64; C = (st & 1) * 32 + (swz % 64) / 2; }
__host__ __device__ __forceinline__ int perm32(int rho) { const int n = rho >> 4, i = rho & 15; return 8 * (i >> 2) + 4 * n + (i & 3); }

struct Unit { int pm, pn; };
struct Gemm { const bf16_t* A; const bf16_t* Bt; int M, N, K; };

template <class Epi, class Sched, bool ALIGN_EPI = false, bool SP2 = false, bool HS = false>
__device__ __forceinline__ void gemm_phase(PG8_LAS unsigned char* lds, const Gemm g, const Sched& S, const Epi& E) {
    const int tid = opaque_tid(), wid = __builtin_amdgcn_readfirstlane(tid >> 6), lane = tid & 63, wr = wid >> 2, wc = wid & 3, fr = lane & 15, fq = lane >> 4;
    const int K = g.K, nt = K / BK;
    unsigned voffA[2], voffB[2];
#pragma unroll
    for (int i = 0; i < 2; ++i) { int R, C; stage_rc(tid * 16 + i * 8192, R, C); const int Rb = Epi::PERM ? ((R & ~31) + perm32(R & 31)) : R;
        voffA[i] = (unsigned)(R * K + C) * 2u; voffB[i] = (unsigned)(Rb * K + C) * 2u; }
    const size_t kstep = (size_t)(BK * 2);
    const size_t hstep = (size_t)HALF * K * 2;
    const size_t tstep = 2 * hstep;
    const unsigned ldsw = (unsigned)wid * 1024u;
    const int aoff = lds_byte(wr * 64 + fr, fq * 8), boff = lds_byte(wc * 32 + fr, fq * 8);
#define PG8_SA(b, h) (((b) * 2 + (h)) * HTB)
#define PG8_SB(b, h) ((4 + (b) * 2 + (h)) * HTB)
#define PG8_STAGE(bufoff, gbase, voff) do { _Pragma("unroll") for (int _i = 0; _i < 2; ++_i) \
        __builtin_amdgcn_global_load_lds((const unsigned*)((const char*)(gbase) + (voff)[_i]), (PG8_LAS unsigned*)(lds + (bufoff) + ldsw + _i * 8192), 16, 0, 0); } while (0)
#define PG8_LDA(dst, b, h) do { _Pragma("unroll") for (int m = 0; m < 4; ++m) _Pragma("unroll") for (int k = 0; k < 2; ++k) dst[m][k] = *(const PG8_LAS bf16x8*)(lds + PG8_SA(b, h) + aoff + m * 2048 + k * 1024); } while (0)
#define PG8_LDB(dst, b, h) do { _Pragma("unroll") for (int n = 0; n < 2; ++n) _Pragma("unroll") for (int k = 0; k < 2; ++k) dst[n][k] = *(const PG8_LAS bf16x8*)(lds + PG8_SB(b, h) + boff + n * 2048 + k * 1024); } while (0)
#define PG8_MMA(ai, bj, At, Bt) do { __builtin_amdgcn_s_setprio(1); _Pragma("unroll") for (int m = 0; m < 4; ++m) _Pragma("unroll") for (int n = 0; n < 2; ++n) _Pragma("unroll") for (int k = 0; k < 2; ++k) \
        acc[ai][bj][m][n] = __builtin_amdgcn_mfma_f32_16x16x32_bf16(Bt[n][k], At[m][k], acc[ai][bj][m][n], 0, 0, 0); __builtin_amdgcn_s_setprio(0); } while (0)
#define PG8_WAIT_V(n) asm volatile("s_waitcnt vmcnt(" #n ")" ::: "memory")
#define PG8_WAIT_L(n) asm volatile("s_waitcnt lgkmcnt(" #n ")" ::: "memory")
#define PG8_BAR __builtin_amdgcn_s_barrier()
#define PG8_SCHED __builtin_amdgcn_sched_barrier(0)
    Unit cur, nxt; int ui = 0;
    if (!S.next(0, cur)) return;
    f32x4 acc[2][2][4][2];
#pragma unroll
    for (int a = 0; a < 2; ++a)
#pragma unroll
        for (int b = 0; b < 2; ++b)
#pragma unroll
            for (int m = 0; m < 4; ++m)
#pragma unroll
                for (int n = 0; n < 2; ++n) acc[a][b][m][n] = (f32x4){0.f, 0.f, 0.f, 0.f};
    bf16x8 At[4][2], B0[2][2], B1[2][2];
    const char* cA = (const char*)g.A + (size_t)cur.pm * tstep; const char* cB = (const char*)g.Bt + (size_t)cur.pn * tstep;
    S.a_ready(cur);
    if constexpr (SP2) {
        PG8_STAGE(PG8_SB(0, 0), cB, voffB); PG8_STAGE(PG8_SB(0, 1), cB + hstep, voffB); PG8_STAGE(PG8_SA(0, 0), cA, voffA); PG8_STAGE(PG8_SA(0, 1), cA + hstep, voffA);
        if (wr == 1) PG8_BAR;
        PG8_WAIT_V(2); PG8_BAR;
        PG8_STAGE(PG8_SB(1, 0), cB + kstep, voffB); PG8_STAGE(PG8_SA(1, 0), cA + kstep, voffA); PG8_STAGE(PG8_SB(1, 1), cB + hstep + kstep, voffB);
        PG8_WAIT_V(6); PG8_BAR;
    } else {
        PG8_STAGE(PG8_SB(0, 0), cB, voffB); PG8_STAGE(PG8_SA(0, 0), cA, voffA); PG8_STAGE(PG8_SB(0, 1), cB + hstep, voffB); PG8_STAGE(PG8_SA(0, 1), cA + hstep, voffA);
        if (wr == 1) PG8_BAR;
        PG8_WAIT_V(4); PG8_BAR;
        PG8_STAGE(PG8_SB(1, 0), cB + kstep, voffB); PG8_STAGE(PG8_SA(1, 0), cA + kstep, voffA); PG8_STAGE(PG8_SB(1, 1), cB + hstep + kstep, voffB);
        PG8_WAIT_V(6); PG8_BAR;
    }
    for (;;) {
        const bool has_next = S.next(ui + 1, nxt);
        const char* nA = has_next ? (const char*)g.A + (size_t)nxt.pm * tstep : cA; const char* nB = has_next ? (const char*)g.Bt + (size_t)nxt.pn * tstep : cB;
        for (int t = 0; t < nt; t += 2) {
            if constexpr (HS) {
                if (t == 4 || t == 8 || t == 12) {
                    const PG8_LAS float* tab = (const PG8_LAS float*)(lds + 147456);
                    const int hj = (t >> 2) - 1;
#pragma unroll
                    for (int a = 0; a < 2; ++a)
#pragma unroll
                        for (int m = 0; m < 4; ++m) {
                            const float s = tab[(a * 128 + wr * 64 + m * 16 + fr) * 4 + hj];
#pragma unroll
                            for (int b = 0; b < 2; ++b)
#pragma unroll
                                for (int n = 0; n < 2; ++n) acc[a][b][m][n] = acc[a][b][m][n] * s;
                        }
                }
            }
            const bool last = (t == nt - 2);
            const char* a1 = cA + (size_t)(t + 1) * kstep;
            const char* a2 = last ? nA : cA + (size_t)(t + 2) * kstep; const char* b2 = last ? nB : cB + (size_t)(t + 2) * kstep;
            const char* a3 = a2 + kstep; const char* b3 = b2 + kstep;
            if (last && has_next) S.a_ready(nxt);
            if constexpr (SP2) {
            PG8_LDB(B0, 0, 0); PG8_LDB(B1, 0, 1); PG8_SCHED; PG8_LDA(At, 0, 0); PG8_STAGE(PG8_SA(1, 1), a1 + hstep, voffA);
            PG8_WAIT_V(8); PG8_WAIT_L(0); PG8_BAR; PG8_MMA(0, 0, At, B0); PG8_MMA(0, 1, At, B1); PG8_BAR; PG8_SCHED;
            PG8_LDA(At, 0, 1); PG8_STAGE(PG8_SB(0, 0), b2, voffB); PG8_STAGE(PG8_SB(0, 1), b2 + hstep, voffB); PG8_STAGE(PG8_SA(0, 0), a2, voffA);
            PG8_WAIT_V(8); PG8_WAIT_L(0); PG8_BAR; PG8_MMA(1, 0, At, B0); PG8_MMA(1, 1, At, B1); PG8_BAR; PG8_SCHED;
            PG8_LDB(B0, 1, 0); PG8_LDB(B1, 1, 1); PG8_SCHED; PG8_LDA(At, 1, 0); PG8_STAGE(PG8_SA(0, 1), a2 + hstep, voffA);
            PG8_WAIT_V(8); PG8_WAIT_L(0); PG8_BAR; PG8_MMA(0, 0, At, B0); PG8_MMA(0, 1, At, B1); PG8_BAR; PG8_SCHED;
            PG8_LDA(At, 1, 1); PG8_STAGE(PG8_SB(1, 0), b3, voffB); PG8_STAGE(PG8_SB(1, 1), b3 + hstep, voffB); PG8_STAGE(PG8_SA(1, 0), a3, voffA);
            PG8_WAIT_V(8); PG8_WAIT_L(0); PG8_BAR; PG8_MMA(1, 0, At, B0); PG8_MMA(1, 1, At, B1); PG8_BAR; PG8_SCHED;
            } else {
            PG8_LDB(B0, 0, 0); PG8_SCHED; PG8_LDA(At, 0, 0); PG8_STAGE(PG8_SA(1, 1), a1 + hstep, voffA);
            PG8_WAIT_L(8); PG8_BAR; PG8_WAIT_L(0); PG8_MMA(0, 0, At, B0); PG8_BAR; PG8_SCHED;
            PG8_LDB(B1, 0, 1); PG8_STAGE(PG8_SB(0, 0), b2, voffB);
            PG8_BAR; PG8_WAIT_L(0); PG8_MMA(0, 1, At, B1); PG8_BAR;
            PG8_LDA(At, 0, 1); PG8_STAGE(PG8_SA(0, 0), a2, voffA);
            PG8_BAR; PG8_WAIT_L(0); PG8_MMA(1, 0, At, B0); PG8_BAR; PG8_SCHED;
            PG8_STAGE(PG8_SB(0, 1), b2 + hstep, voffB);
            PG8_WAIT_V(6); PG8_BAR; PG8_MMA(1, 1, At, B1); PG8_BAR;
            PG8_LDB(B0, 1, 0); PG8_SCHED; PG8_LDA(At, 1, 0); PG8_STAGE(PG8_SA(0, 1), a2 + hstep, voffA);
            PG8_WAIT_L(8); PG8_BAR; PG8_WAIT_L(0); PG8_MMA(0, 0, At, B0); PG8_BAR; PG8_SCHED;
            PG8_LDB(B1, 1, 1); PG8_STAGE(PG8_SB(1, 0), b3, voffB);
            PG8_BAR; PG8_WAIT_L(0); PG8_MMA(0, 1, At, B1); PG8_BAR;
            PG8_LDA(At, 1, 1); PG8_STAGE(PG8_SA(1, 0), a3, voffA);
            PG8_BAR; PG8_WAIT_L(0); PG8_MMA(1, 0, At, B0); PG8_BAR; PG8_SCHED;
            PG8_STAGE(PG8_SB(1, 1), b3 + hstep, voffB);
            PG8_WAIT_V(6); PG8_BAR; PG8_MMA(1, 1, At, B1); PG8_BAR;
            }
        }
        if constexpr (ALIGN_EPI) { if (wr == 0) PG8_BAR; }
        if constexpr (!Epi::AFTER_DRAIN) { E(acc, cur, wr, wc, fr, fq); S.done(cur); }
        if (!has_next) break;
#pragma unroll
        for (int a = 0; a < 2; ++a)
#pragma unroll
            for (int b = 0; b < 2; ++b)
#pragma unroll
                for (int m = 0; m < 4; ++m)
#pragma unroll
                    for (int n = 0; n < 2; ++n) acc[a][b][m][n] = (f32x4){0.f, 0.f, 0.f, 0.f};
        cur = nxt; cA = nA; cB = nB; ++ui;
        if constexpr (ALIGN_EPI) { if (wr == 1) PG8_BAR; }
    }
    PG8_WAIT_V(0);
    if constexpr (!ALIGN_EPI) { if (wr == 0) PG8_BAR; }
    PG8_BAR;
    if constexpr (Epi::AFTER_DRAIN) { E.fused(acc, cur, wr, wc, fr, fq, lds, wid, lane); S.done(cur); }
#undef PG8_SA
#undef PG8_SB
#undef PG8_STAGE
#undef PG8_LDA
#undef PG8_LDB
#undef PG8_MMA
#undef PG8_WAIT_V
#undef PG8_WAIT_L
#undef PG8_BAR
#undef PG8_SCHED
}
}

DI unsigned sig_u8(float z) { return (unsigned)(255.0f * __builtin_amdgcn_rcpf(1.0f + __expf(-z)) + 0.5f); }
struct SchedP1 {
    DI bool next(int i, pg8::Unit& u) const {
        constexpr int NT = 36;
        const int id = (int)blockIdx.x + i * (int)gridDim.x;
        if (id >= 64 * NT) return false;
        const int g = id / (16 * NT), rem = id % (16 * NT), reg = rem >> 8, w = rem & 255, x = w & 7, j = w >> 3;
        int mt = g * 16 + 4 * (x & 3) + (j & 3), nt = reg * 16 + 8 * (x >> 2) + (j >> 2);
        if (reg == 2) { const int e = rem - 512; nt = 32 + (e >> 4); mt = g * 16 + (e & 15); }
        u.pm = mt; u.pn = nt; return true;
    }
    DI void a_ready(const pg8::Unit&) const {}
    DI void done(const pg8::Unit&) const {}
};
struct SchedSq {
    DI bool next(int i, pg8::Unit& u) const {
        const int id = (int)blockIdx.x + i * (int)gridDim.x;
        if (id >= 256) return false;
        u.pm = 8 * (id & 7) + ((id >> 3) & 7); u.pn = id >> 6; return true;
    }
    DI void a_ready(const pg8::Unit&) const {}
    DI void done(const pg8::Unit&) const {}
};
DI unsigned sig_u8x4(float a, float b, float c, float d) {
    unsigned r = 0u;
    r = __builtin_amdgcn_cvt_pk_u8_f32(255.0f * __builtin_amdgcn_rcpf(1.0f + __expf(-a)), 0, r);
    r = __builtin_amdgcn_cvt_pk_u8_f32(255.0f * __builtin_amdgcn_rcpf(1.0f + __expf(-b)), 1, r);
    r = __builtin_amdgcn_cvt_pk_u8_f32(255.0f * __builtin_amdgcn_rcpf(1.0f + __expf(-c)), 2, r);
    r = __builtin_amdgcn_cvt_pk_u8_f32(255.0f * __builtin_amdgcn_rcpf(1.0f + __expf(-d)), 3, r);
    return r;
}
struct EpiInProj {
    static constexpr bool PERM = true, AFTER_DRAIN = false;
    unsigned char* ws; unsigned char* dout;
    DI void operator()(const pg8::f32x4 (&acc)[2][2][4][2], const pg8::Unit& u, int wr, int wc, int fr, int fq) const {
        const int nt = u.pn;
        int split, nc0;
        if (nt < 4) { split = 0; nc0 = nt * 256; }
        else if (nt < 8) { split = 1; nc0 = (nt - 4) * 256; }
        else if (nt < 12) { split = 2; nc0 = (nt - 8) * 256; }
        else if (nt < 16) { split = 3; nc0 = (nt - 12) * 256; }
        else if (nt < 18) { split = 4; nc0 = (nt - 16) * 256; }
        else if (nt < 20) { split = 5; nc0 = (nt - 18) * 256; }
        else if (nt < 24) { split = 6; nc0 = (nt - 20) * 256; }
        else if (nt < 28) { split = 7; nc0 = (nt - 24) * 256; }
        else if (nt < 32) { split = 9; nc0 = (nt - 28) * 256; }
        else { split = 10; nc0 = (nt - 32) * 256; }
        const float* rstd = (const float*)(ws + OFF_RSTD);
        const float* rope = (const float*)(ws + OFF_ROPE);
        const bool do_rope = split <= 1 && (wc & 1) == 0;
#pragma unroll
        for (int ai = 0; ai < 2; ++ai)
#pragma unroll
            for (int m = 0; m < 4; ++m) {
                const int tok = u.pm * 256 + ai * 128 + wr * 64 + m * 16 + fr;
                const float rs = rstd[tok];
                const float rsq = split == 0 ? rs * (0.125f * 1.4426950408889634f) : rs;
                const int pos = 16 + (tok & 4095), b = tok >> 12, s = tok & 4095;
#pragma unroll
                for (int bj = 0; bj < 2; ++bj) {
                    const int nb = nc0 + bj * 128 + wc * 32 + 8 * fq;
                    float v[8];
#pragma unroll
                    for (int j = 0; j < 4; ++j) { v[j] = acc[ai][bj][m][0][j] * rsq; v[4 + j] = acc[ai][bj][m][1][j] * rsq; }
                    if (do_rope) {
                        const f32x4* cs = (const f32x4*)(rope + (size_t)pos * 16);
                        const f32x4 c01 = cs[0], c23 = cs[1], c45 = cs[2], c67 = cs[3];
                        const float cc[8] = {c01.x, c01.z, c23.x, c23.z, c45.x, c45.z, c67.x, c67.z};
                        const float sn[8] = {c01.y, c01.w, c23.y, c23.w, c45.y, c45.w, c67.y, c67.w};
#pragma unroll
                        for (int j = 0; j < 8; ++j) {
                            const float other = __shfl_xor(v[j], 16);
                            const float r0 = v[j] * cc[j] - other * sn[j], r1 = v[j] * cc[j] + other * sn[j];
                            v[j] = fq == 0 ? r0 : (fq == 1 ? r1 : v[j]);
                        }
                    }
                    if (split == 2 || split == 6) {
                        const int hshift = split == 2 ? 7 : 8, nheads = split == 2 ? 8 : 4, dvn = 1 << hshift;
                        bf16_t* base = (bf16_t*)(ws + (split == 2 ? OFF_AVT : OFF_GVT));
                        const int hd = nb >> hshift, dv0 = nb & (dvn - 1);
                        bf16_t* dst = base + ((size_t)(b * nheads + hd) * dvn + dv0) * 4096 + s;
#pragma unroll
                        for (int j = 0; j < 8; ++j) dst[(size_t)j * 4096] = f2bf(v[j]);
                    } else if (split >= 9) {
                        u32x2 o; o.x = sig_u8x4(v[0], v[1], v[2], v[3]); o.y = sig_u8x4(v[4], v[5], v[6], v[7]);
                        *(u32x2*)(ws + (split == 9 ? OFF_SGA : OFF_SGB) + (size_t)tok * 1024 + nb) = o;
                    } else {
                        bf16_t* dst; int ld;
                        switch (split) {
                            case 0: dst = (bf16_t*)(dout + DO_AQ); ld = 1024; break;
                            case 1: dst = (bf16_t*)(ws + OFF_AK); ld = 1024; break;
                            case 3: dst = (bf16_t*)(ws + OFF_AZ); ld = 1024; break;
                            case 4: dst = (bf16_t*)(dout + DO_GQ); ld = 512; break;
                            case 5: dst = (bf16_t*)(dout + DO_GK); ld = 512; break;
                            default: dst = (bf16_t*)(ws + OFF_GZ); ld = 1024; break;
                        }
                        u32x4 o; o.x = pk2(v[0], v[1]); o.y = pk2(v[2], v[3]); o.z = pk2(v[4], v[5]); o.w = pk2(v[6], v[7]);
                        *(u32x4*)(dst + (size_t)tok * ld + nb) = o;
                    }
                }
            }
    }
};

DI void p1_glr_job(const Params& p, unsigned char* lds, int job) {
    const int tid = opaque_tid(), lane = tid & 63, wave = tid >> 6, l15 = lane & 15, g = lane >> 4;
    const int rtile = wave & 3, khalf = wave >> 2;
    const bf16_t* xb = (const bf16_t*)(p.ws + OFF_XB);
    const bf16_t* wt = (const bf16_t*)(p.ws + OFF_WIN_T) + (size_t)9216 * 1024;
    const size_t row0 = (size_t)job * 64 + rtile * 16;
    const bf16_t* ap = xb + (row0 + l15) * 1024 + khalf * 512 + 8 * g;
    const bf16_t* bp = wt + (size_t)l15 * 1024 + khalf * 512 + 8 * g;
    f32x4 acc = (f32x4){0.f, 0.f, 0.f, 0.f};
    {
        bf16x8 av[16], bv[16];
#pragma unroll
        for (int ks = 0; ks < 16; ++ks) { av[ks] = *(const bf16x8*)(ap + ks * 32); bv[ks] = *(const bf16x8*)(bp + ks * 32); }
        f32x4 acc2 = (f32x4){0.f, 0.f, 0.f, 0.f};
#pragma unroll
        for (int ks = 0; ks < 16; ks += 2) { acc = MFMA16(av[ks], bv[ks], acc); acc2 = MFMA16(av[ks + 1], bv[ks + 1], acc2); }
        acc = acc + acc2;
    }
    f32x4* red = (f32x4*)lds;
    __syncthreads();
    if (khalf == 1) red[rtile * 64 + lane] = acc;
    __syncthreads();
    if (khalf == 0) {
        const f32x4 o = red[rtile * 64 + lane];
        const float* rstd = (const float*)(p.ws + OFF_RSTD);
        bf16_t* glr = (bf16_t*)(p.ws + OFF_GLR);
#pragma unroll
        for (int i = 0; i < 4; ++i) {
            const size_t row = row0 + 4 * g + i;
            glr[row * 16 + l15] = f2bf((acc[i] + o[i]) * rstd[row]);
        }
    }
    __syncthreads();
}

DI void p1_meta_job(const Params& p, unsigned char* lds, int job) {
    const int tid = opaque_tid(), lane = tid & 63, wave = tid >> 6, l15 = lane & 15, g = lane >> 4;
    int c0;
    if (job < 64) c0 = 1024 + job * 16;
    else if (job < 128) c0 = 2048 + (job - 64) * 16;
    else if (job < 160) c0 = 4608 + (job - 128) * 16;
    else if (job < 224) c0 = 5120 + (job - 160) * 16;
    else c0 = 9216;
    const bf16_t* xbm = (const bf16_t*)(p.ws + OFF_XBM);
    const bf16_t* wt = (const bf16_t*)(p.ws + OFF_WIN_T);
    const bf16_t* ap = xbm + (size_t)l15 * 1024 + wave * 128 + 8 * g;
    const bf16_t* bp = wt + (size_t)(c0 + l15) * 1024 + wave * 128 + 8 * g;
    f32x4 acc = (f32x4){0.f, 0.f, 0.f, 0.f};
#pragma unroll
    for (int ks = 0; ks < 4; ++ks) {
        const bf16x8 a = *(const bf16x8*)(ap + ks * 32), bb = *(const bf16x8*)(bp + ks * 32);
        acc = MFMA16(a, bb, acc);
    }
    f32x4* red = (f32x4*)lds;
    __syncthreads();
    red[wave * 64 + lane] = acc;
    __syncthreads();
    if (wave == 0) {
        f32x4 s = red[lane];
#pragma unroll
        for (int w = 1; w < 8; ++w) { const f32x4 t = red[w * 64 + lane]; s.x += t.x; s.y += t.y; s.z += t.z; s.w += t.w; }
        const float* rstd = (const float*)(p.ws + OFF_RSTD) + MROWS;
        const float* rope = (const float*)(p.ws + OFF_ROPE);
        unsigned char* ws = p.ws;
        const int col = c0 + l15;
#pragma unroll
        for (int i = 0; i < 4; ++i) {
            const int row = 4 * g + i;
            float v = s[i] * rstd[row];
            if (job < 64 && (c0 & 63) == 0) {
                const float other = __shfl_xor(v, 8);
                const float* cs = rope + ((size_t)row * 8 + (l15 & 7)) * 2;
                const float c = cs[0], sn = cs[1];
                v = (l15 < 8) ? (v * c - other * sn) : (v * c + other * sn);
            }
            const bf16_t val = f2bf(v);
            if (job < 64) ((bf16_t*)(ws + OFF_AKM))[(size_t)(48 + row) * 1024 + (col - 1024)] = val;
            else if (job < 128) { const int n = col - 2048; ((bf16_t*)(ws + OFF_AVTM))[(size_t)n * 64 + 48 + row] = val; }
            else if (job < 160) ((bf16_t*)(ws + OFF_GKM))[(size_t)row * 512 + (col - 4608)] = val;
            else if (job < 224) { const int n = col - 5120; ((bf16_t*)(ws + OFF_GVTM))[(size_t)n * 64 + 48 + row] = val; }
            else ((bf16_t*)(ws + OFF_GLRM))[row * 16 + l15] = val;
        }
    }
    __syncthreads();
}

DI void phase1(const Params& p, unsigned char* lds) {
    for (int j = blockIdx.x; j < 256; j += gridDim.x) p1_glr_job(p, lds, j);
    for (int j = blockIdx.x; j < 225; j += gridDim.x) p1_meta_job(p, lds, j);
    pg8::Gemm g; g.A = (const bf16_t*)(p.ws + OFF_XB); g.Bt = (const bf16_t*)(p.ws + OFF_WIN_T); g.M = MROWS; g.N = 9216; g.K = 1024;
    SchedP1 S; EpiInProj E; E.ws = p.ws; E.dout = (unsigned char*)p.out;
    pg8::gemm_phase<EpiInProj, SchedP1, true, true>((PG8_LAS unsigned char*)lds, g, S, E);
}

DI void phase15(const Params& p, unsigned char* lds) {
    const int tid = opaque_tid(), col = tid;
    float w2[16];
#pragma unroll
    for (int j = 0; j < 16; ++j) w2[j] = p.gate_w2[j * 512 + col];
    const float bias = p.gate_b[col];
    unsigned char* ws = p.ws;
    unsigned char* dout = (unsigned char*)p.out;
    for (int item = blockIdx.x; item < 257; item += gridDim.x) {
        const bool meta = item == 256;
        const int b = item >> 6, c = item & 63;
        const size_t row0 = (size_t)b * 4096 + c * 64;
        const bf16_t* glr = meta ? (const bf16_t*)(ws + OFF_GLRM) : (const bf16_t*)(ws + OFF_GLR) + row0 * 16;
        const int nrows = meta ? 16 : 64;
        bf16_t* qp = (bf16_t*)(dout + DO_GQ) + row0 * 512 + col;
        const bf16_t* kin = meta ? (const bf16_t*)(ws + OFF_GKM) + col : (const bf16_t*)(dout + DO_GK) + row0 * 512 + col;
        bf16_t* kout = meta ? (bf16_t*)(ws + OFF_KTM) + 48 * 512 + col : (bf16_t*)(dout + DO_GK) + row0 * 512 + col;
        bf16_t* ktt = meta ? (bf16_t*)(ws + OFF_KTTM) + (size_t)col * 64 + 48 : (bf16_t*)(ws + OFF_WIN_T) + ((size_t)b * 512 + col) * 4096 + c * 64;
        __syncthreads();
        if (tid < nrows * 2) ((u32x4*)lds)[tid] = ((const u32x4*)glr)[tid];
        __syncthreads();
        float bsum = 0.f;
        constexpr int GR = 16;
        bf16_t kc[GR], qc[GR], kn[GR], qn[GR];
#pragma unroll
        for (int rr = 0; rr < GR; ++rr) { kc[rr] = kin[(size_t)rr * 512]; qc[rr] = meta ? (bf16_t)0 : qp[(size_t)rr * 512]; }
        for (int r0 = 0; r0 < nrows; r0 += GR) {
            if (r0 + GR < nrows) {
#pragma unroll
                for (int rr = 0; rr < GR; ++rr) { kn[rr] = kin[(size_t)(r0 + GR + rr) * 512]; qn[rr] = meta ? (bf16_t)0 : qp[(size_t)(r0 + GR + rr) * 512]; }
            }
            float kt8[GR];
#pragma unroll
            for (int rr = 0; rr < GR; ++rr) {
                const int r = r0 + rr;
                const u32x4* g4 = (const u32x4*)(lds + r * 32);
                const u32x4 ga = g4[0], gb = g4[1];
                float gk = bias;
                gk += bflo(ga.x) * w2[0] + bfhi(ga.x) * w2[1] + bflo(ga.y) * w2[2] + bfhi(ga.y) * w2[3];
                gk += bflo(ga.z) * w2[4] + bfhi(ga.z) * w2[5] + bflo(ga.w) * w2[6] + bfhi(ga.w) * w2[7];
                gk += bflo(gb.x) * w2[8] + bfhi(gb.x) * w2[9] + bflo(gb.y) * w2[10] + bfhi(gb.y) * w2[11];
                gk += bflo(gb.z) * w2[12] + bfhi(gb.z) * w2[13] + bflo(gb.w) * w2[14] + bfhi(gb.w) * w2[15];
                const float lg = (fminf(gk, 0.f) - __logf(1.0f + __expf(-fabsf(gk)))) * (1.0f / 16.0f);
                bsum += lg;
                const float eb = __expf(bsum);
                const float kt = bf2f(kc[rr]) * __builtin_amdgcn_rcpf(eb);
                kt8[rr] = kt;
                kout[(size_t)r * 512] = f2bf(kt);
                if (!meta) qp[(size_t)r * 512] = f2bf(bf2f(qc[rr]) * 0.08838834764831845f * eb);
            }
#pragma unroll
            for (int hh8 = 0; hh8 < GR / 8; ++hh8) {
                u32x4 o; o.x = pk2(kt8[8 * hh8 + 0], kt8[8 * hh8 + 1]); o.y = pk2(kt8[8 * hh8 + 2], kt8[8 * hh8 + 3]);
                o.z = pk2(kt8[8 * hh8 + 4], kt8[8 * hh8 + 5]); o.w = pk2(kt8[8 * hh8 + 6], kt8[8 * hh8 + 7]);
                *(u32x4*)(ktt + r0 + 8 * hh8) = o;
            }
#pragma unroll
            for (int rr = 0; rr < GR; ++rr) { kc[rr] = kn[rr]; qc[rr] = qn[rr]; }
        }
        if (meta) {
            ((float*)(ws + OFF_DECM))[col] = expf(bsum);
            bf16_t* km = (bf16_t*)(ws + OFF_KTM);
            for (int r = 0; r < 48; ++r) km[r * 512 + col] = 0;
            u32x4 z = {0u, 0u, 0u, 0u};
            u32x4* kz = (u32x4*)((bf16_t*)(ws + OFF_KTTM) + (size_t)col * 64);
#pragma unroll
            for (int j = 0; j < 6; ++j) kz[j] = z;
        } else {
            ((float*)(ws + OFF_DEC))[((size_t)b * 64 + c) * 512 + col] = expf(bsum);
        }
    }
}

constexpr int A_KROWB = 272, A_VROWB = 144, A_KB = 64 * A_KROWB, A_VB = 128 * A_VROWB, A_STAGE = A_KB + A_VB;
DI float max3f(float a, float b, float c) { float r; asm("v_max3_f32 %0, %1, %2, %3" : "=v"(r) : "v"(a), "v"(b), "v"(c)); return r; }
DI void attn_s(const unsigned char* sK, int tt, int qb, int qs, int sub, int l31, int h,
               const bf16x8 (&qf)[4], f32x16 (&O)[4], float& m, float& l, bf16x8 (&pb)[4]) {
    f32x16 st[2];
#pragma unroll
    for (int k2 = 0; k2 < 2; ++k2)
#pragma unroll
        for (int i = 0; i < 16; ++i) st[k2][i] = -m;
    {
        const unsigned char* kb = sK + l31 * A_KROWB + (sub * 64 + 8 * h) * 2;
        bf16x8 ka[4], kc[4];
#pragma unroll
        for (int i = 0; i < 4; ++i) ka[i] = *(const bf16x8*)(kb + (i & 1) * 32 * A_KROWB + (i >> 1) * 32);
        __builtin_amdgcn_sched_barrier(0);
#pragma unroll
        for (int i = 0; i < 4; ++i) kc[i] = *(const bf16x8*)(kb + (i & 1) * 32 * A_KROWB + (2 + (i >> 1)) * 32);
        __builtin_amdgcn_sched_barrier(0);
#pragma unroll
        for (int i = 0; i < 4; ++i) st[i & 1] = MFMA32(ka[i], qf[i >> 1], st[i & 1]);
        __builtin_amdgcn_sched_barrier(0);
#pragma unroll
        for (int i = 0; i < 4; ++i) st[i & 1] = MFMA32(kc[i], qf[2 + (i >> 1)], st[i & 1]);
    }
    if (tt == 0) {
#pragma unroll
        for (int i = 0; i < 16; ++i) { st[0][i] = -INFINITY; if (i < 8) st[1][i] = -INFINITY; }
    } else if (tt >= 2 * qb + 1) {
        const int kbase = (tt - 1) * 64 + 4 * h;
#pragma unroll
        for (int k2 = 0; k2 < 2; ++k2)
#pragma unroll
            for (int i = 0; i < 16; ++i) {
                const int key = kbase + k2 * 32 + (i & 3) + 8 * (i >> 2);
                if (key > qs) st[k2][i] = -INFINITY;
            }
    }
    float mx;
    {
        float t[11];
#pragma unroll
        for (int i = 0; i < 5; ++i) t[i] = max3f(st[0][3 * i], st[0][3 * i + 1], st[0][3 * i + 2]);
#pragma unroll
        for (int i = 0; i < 5; ++i) t[5 + i] = max3f(st[1][3 * i], st[1][3 * i + 1], st[1][3 * i + 2]);
        t[10] = fmaxf(st[0][15], st[1][15]);
        const float u0 = max3f(t[0], t[1], t[2]), u1 = max3f(t[3], t[4], t[5]), u2 = max3f(t[6], t[7], t[8]);
        mx = max3f(max3f(u0, u1, u2), t[9], t[10]);
    }
    mx = xor32_max(mx);
    if (tt == 0 || __builtin_amdgcn_ballot_w64(mx > 8.0f) != 0ull) {
        const float delta = tt == 0 ? mx : fmaxf(mx, 0.f);
        const float alpha = __builtin_amdgcn_exp2f(-delta);
        m += delta;
        l *= alpha;
#pragma unroll
        for (int d = 0; d < 4; ++d) O[d] = O[d] * alpha;
#pragma unroll
        for (int k2 = 0; k2 < 2; ++k2) st[k2] = st[k2] - delta;
    }
#pragma unroll
    for (int k2 = 0; k2 < 2; ++k2)
#pragma unroll
        for (int i = 0; i < 16; ++i) st[k2][i] = __builtin_amdgcn_exp2f(st[k2][i]);
    {
        const f32x16 sv = st[0] + st[1];
        const float ps = (((sv[0] + sv[1]) + (sv[2] + sv[3])) + ((sv[4] + sv[5]) + (sv[6] + sv[7]))) + (((sv[8] + sv[9]) + (sv[10] + sv[11])) + ((sv[12] + sv[13]) + (sv[14] + sv[15])));
        l += ps;
    }
#pragma unroll
    for (int k4 = 0; k4 < 4; ++k4) {
        const int k2 = k4 >> 1, o8 = 8 * (k4 & 1);
        u32x4 pk;
        pk.x = pk2(st[k2][o8 + 0], st[k2][o8 + 1]); pk.y = pk2(st[k2][o8 + 2], st[k2][o8 + 3]);
        pk.z = pk2(st[k2][o8 + 4], st[k2][o8 + 5]); pk.w = pk2(st[k2][o8 + 6], st[k2][o8 + 7]);
        pb[k4] = __builtin_bit_cast(bf16x8, pk);
    }
}
DI void attn_pv(const unsigned char* sV, int l31, int h, const bf16x8 (&pb)[4], f32x16 (&O)[4]) {
    {
        const unsigned char* vb = sV + l31 * A_VROWB + 16 * h;
        bf16x8 va[4], vc[4];
#pragma unroll
        for (int d = 0; d < 4; ++d) va[d] = *(const bf16x8*)(vb + d * 32 * A_VROWB);
        __builtin_amdgcn_sched_barrier(0);
#pragma unroll
        for (int d = 0; d < 4; ++d) vc[d] = *(const bf16x8*)(vb + d * 32 * A_VROWB + 32);
        __builtin_amdgcn_sched_barrier(0);
#pragma unroll
        for (int d = 0; d < 4; ++d) O[d] = MFMA32(va[d], pb[0], O[d]);
        __builtin_amdgcn_sched_barrier(0);
#pragma unroll
        for (int d = 0; d < 4; ++d) va[d] = *(const bf16x8*)(vb + d * 32 * A_VROWB + 64);
        __builtin_amdgcn_sched_barrier(0);
#pragma unroll
        for (int d = 0; d < 4; ++d) O[d] = MFMA32(vc[d], pb[1], O[d]);
        __builtin_amdgcn_sched_barrier(0);
#pragma unroll
        for (int d = 0; d < 4; ++d) vc[d] = *(const bf16x8*)(vb + d * 32 * A_VROWB + 96);
        __builtin_amdgcn_sched_barrier(0);
#pragma unroll
        for (int d = 0; d < 4; ++d) O[d] = MFMA32(va[d], pb[2], O[d]);
        __builtin_amdgcn_sched_barrier(0);
#pragma unroll
        for (int d = 0; d < 4; ++d) O[d] = MFMA32(vc[d], pb[3], O[d]);
    }
}

DI void attn_item(const Params& p, unsigned char* lds, int b, int hd, int qb, float lam) {
    const int tid = opaque_tid(), lane = tid & 63, wave = tid >> 6, l31 = lane & 31, h = lane >> 5;
    const int sub = wave >> 2, rt = wave & 3;
    const bf16_t* aq = (const bf16_t*)((unsigned char*)p.out + DO_AQ);
    const bf16_t* ak = (const bf16_t*)(p.ws + OFF_AK);
    const bf16_t* avT = (const bf16_t*)(p.ws + OFF_AVT);
    const bf16_t* akm = (const bf16_t*)(p.ws + OFF_AKM);
    const bf16_t* avTm = (const bf16_t*)(p.ws + OFF_AVTM);
    bf16_t* az = (bf16_t*)(p.ws + OFF_AZ);
    const int qs = qb * 128 + rt * 32 + l31;
    const size_t grow = (size_t)b * 4096 + qs;
    bf16x8 qf[4];
#pragma unroll
    for (int ks = 0; ks < 4; ++ks) qf[ks] = *(const bf16x8*)(aq + grow * 1024 + hd * 128 + sub * 64 + ks * 16 + 8 * h);
    f32x16 O[4];
#pragma unroll
    for (int d = 0; d < 4; ++d)
#pragma unroll
        for (int i = 0; i < 16; ++i) O[d][i] = 0.f;
    float m = 0.f, l = 0.f;
    const int T = 2 * qb + 3;
    u32x4 k0r[2], v0r[2];
    const int krow_ = tid >> 4, kc_ = tid & 15, vdv_ = tid >> 3, vc_ = tid & 7;
    const bf16_t* kp = ak + ((size_t)b * 4096 + krow_) * 1024 + hd * 128 + kc_ * 8;
    const bf16_t* vp_ = avT + ((size_t)(b * 8 + hd) * 128 + vdv_) * 4096 + vc_ * 8;
#define A_LOAD_REAL(KR, VR)                                                                                                   \
    {                                                                                                                         \
        KR[0] = *(const u32x4*)kp; KR[1] = *(const u32x4*)(kp + 32 * 1024); kp += 64 * 1024;                                  \
        VR[0] = *(const u32x4*)vp_; VR[1] = *(const u32x4*)(vp_ + (size_t)64 * 4096); vp_ += 64;                              \
    }
#define A_STORE(KR, VR, buf_)                                                                                                 \
    {                                                                                                                         \
        unsigned char* sK_ = lds + (buf_) * A_STAGE; unsigned char* sV_ = sK_ + A_KB;                                         \
        _Pragma("unroll") for (int i = 0; i < 2; ++i) { const int pi = tid + 512 * i, row = pi >> 4, c = pi & 15;              \
            *(u32x4*)(sK_ + row * A_KROWB + c * 16) = KR[i]; }                                                                \
        _Pragma("unroll") for (int i = 0; i < 2; ++i) { const int pi = tid + 512 * i, dv = pi >> 3, c = pi & 7;                \
            unsigned char* d_ = sV_ + dv * A_VROWB + (c >> 1) * 32 + 8 * (c & 1); u32x2 a_, b_; a_.x = VR[i].x; a_.y = VR[i].y; b_.x = VR[i].z; b_.y = VR[i].w; \
            *(u32x2*)d_ = a_; *(u32x2*)(d_ + 16) = b_; }                                                                      \
    }
    {
        const bf16_t* km_ = akm + (size_t)krow_ * 1024 + hd * 128 + kc_ * 8;
        k0r[0] = *(const u32x4*)km_; k0r[1] = *(const u32x4*)(km_ + 32 * 1024);
        const bf16_t* vm_ = avTm + (size_t)(hd * 128 + vdv_) * 64 + vc_ * 8;
        v0r[0] = *(const u32x4*)vm_; v0r[1] = *(const u32x4*)(vm_ + 64 * 64);
    }
    u32x4 k1r[2], v1r[2];
    A_LOAD_REAL(k1r, v1r);
#pragma unroll
    for (int ks = 0; ks < 4; ++ks) asm volatile("" : "+v"(qf[ks]));
    A_STORE(k0r, v0r, 0);
    __syncthreads();
    bf16x8 pb[4];
    int bc = 0, bp = 2, bn = 1;
    {
        attn_s(lds + bc * A_STAGE, 0, qb, qs, sub, l31, h, qf, O, m, l, pb);
        attn_pv(lds + bc * A_STAGE + A_KB, l31, h, pb, O);
        A_STORE(k1r, v1r, bn);
        __syncthreads();
        bp = bc; bc = bn; bn = (bn == 2) ? 0 : bn + 1;
    }
    for (int tt = 1; tt < T; ++tt) {
        if (tt + 1 < T) A_LOAD_REAL(k0r, v0r);
        attn_s(lds + bc * A_STAGE, tt, qb, qs, sub, l31, h, qf, O, m, l, pb);
        attn_pv(lds + bc * A_STAGE + A_KB, l31, h, pb, O);
        if (tt + 1 < T) A_STORE(k0r, v0r, bn);
        __syncthreads();
        bp = bc; bc = bn; bn = (bn == 2) ? 0 : bn + 1;
    }

#undef A_LOAD_REAL
#undef A_STORE
    const float ltot = xor32_sum(l);
    const float linv = 1.0f / ltot;
    u32x2 zz[4][4];
    if (sub == 0) {
#pragma unroll
        for (int d = 0; d < 4; ++d)
#pragma unroll
            for (int g = 0; g < 4; ++g) zz[d][g] = *(const u32x2*)(az + grow * 1024 + hd * 128 + d * 32 + 8 * g + 4 * h);
    }
    float* ex = (float*)lds;
    if (sub == 1) {
#pragma unroll
        for (int d = 0; d < 4; ++d) {
#pragma unroll
            for (int g = 0; g < 4; ++g) {
                f32x4 t; t.x = O[d][4 * g] * linv; t.y = O[d][4 * g + 1] * linv; t.z = O[d][4 * g + 2] * linv; t.w = O[d][4 * g + 3] * linv;
                *(f32x4*)(ex + (rt * 32 + l31) * 132 + d * 32 + 8 * g + 4 * h) = t;
            }
            __builtin_amdgcn_sched_barrier(0);
        }
    }
    __syncthreads();
    if (sub == 0) {
        float ss = 0.f;
#pragma unroll
        for (int d = 0; d < 4; ++d) {
#pragma unroll
            for (int g = 0; g < 4; ++g) {
                const f32x4 t = *(const f32x4*)(ex + (rt * 32 + l31) * 132 + d * 32 + 8 * g + 4 * h);
                const float o0 = O[d][4 * g] * linv - lam * t.x, o1 = O[d][4 * g + 1] * linv - lam * t.y;
                const float o2 = O[d][4 * g + 2] * linv - lam * t.z, o3 = O[d][4 * g + 3] * linv - lam * t.w;
                O[d][4 * g] = o0; O[d][4 * g + 1] = o1; O[d][4 * g + 2] = o2; O[d][4 * g + 3] = o3;
                ss += (o0 * o0 + o1 * o1) + (o2 * o2 + o3 * o3);
            }
            __builtin_amdgcn_sched_barrier(0);
        }
        ss = xor32_sum(ss);
        const float rstd = 1.0f / sqrtf(ss * (1.0f / 128.0f) + EPS);
#pragma unroll
        for (int d = 0; d < 4; ++d)
#pragma unroll
            for (int g = 0; g < 4; ++g) {
                bf16_t* zp = az + grow * 1024 + hd * 128 + d * 32 + 8 * g + 4 * h;
                const u32x2 z2 = zz[d][g];
                u32x2 o;
                o.x = pk2(O[d][4 * g] * rstd * siluf_(bflo(z2.x)), O[d][4 * g + 1] * rstd * siluf_(bfhi(z2.x)));
                o.y = pk2(O[d][4 * g + 2] * rstd * siluf_(bflo(z2.y)), O[d][4 * g + 3] * rstd * siluf_(bfhi(z2.y)));
                *(u32x2*)zp = o;
                if (g == 3) __builtin_amdgcn_sched_barrier(0);
            }
    }
    __syncthreads();
}

constexpr int L_KROWB = 272, L_VROWB = 144, L_SROWB = 272;
constexpr int GLA_DL = 2;
#define L_BAR() { asm volatile("s_waitcnt lgkmcnt(0)" ::: "memory"); __builtin_amdgcn_s_barrier(); asm volatile("" ::: "memory"); }
template <int DL>
DI void gla_item(const Params& p, unsigned char* lds, int b, int hh, int sl) {
    constexpr int SLW = 32 * DL, NVP = SLW / 64;
    constexpr int L_K = 0, L_V = 64 * L_KROWB, L_S = L_V + SLW * L_VROWB, L_KT = L_S + SLW * L_SROWB;
    const int tid = opaque_tid(), lane = tid & 63, wave = tid >> 6, l15 = lane & 15, g = lane >> 4;
    const int tt = wave & 3, dvt = wave >> 2;
    unsigned char* ws = p.ws;
    unsigned char* dout = (unsigned char*)p.out;
    const bf16_t* gq = (const bf16_t*)(dout + DO_GQ);
    const bf16_t* gk = (const bf16_t*)(dout + DO_GK);
    const bf16_t* gvT = (const bf16_t*)(ws + OFF_GVT);
    const bf16_t* ktt = (const bf16_t*)(ws + OFF_WIN_T);
    const float* dec = (const float*)(ws + OFF_DEC);
    bf16_t* gz = (bf16_t*)(ws + OFF_GZ);
    float* ssqb = (float*)(ws + OFF_SSQB);
    unsigned char* sK = lds + L_K; unsigned char* sV = lds + L_V; unsigned char* sS = lds + L_S; unsigned char* sKT = lds + L_KT;
    for (int i = tid; i < SLW * L_SROWB / 4; i += 512) ((unsigned*)sS)[i] = 0u;
    f32x4 sacc[DL][2];
#pragma unroll
    for (int dl = 0; dl < DL; ++dl)
#pragma unroll
        for (int c = 0; c < 2; ++c) sacc[dl][c] = (f32x4){0.f, 0.f, 0.f, 0.f};
    u32x4 nkA[2]; u32x4 nvA[NVP]; bf16x8 nqA[4]; u32x4 nktA[2]; float ndA[2]; u32x2 ngzA[DL];
    u32x4 nkB[2]; u32x4 nvB[NVP]; bf16x8 nqB[4]; u32x4 nktB[2]; float ndB[2]; u32x2 ngzB[DL];
    const int cc0 = 16 * (2 * tt) + l15;
    const int dv0 = 16 * (dvt * DL);
    const int krow_ = tid >> 4, kc_ = tid & 15, vdv_ = tid >> 3, vc_ = tid & 7;
    const bf16_t* kp = gk + ((size_t)b * 4096 + krow_) * 512 + hh * 128 + kc_ * 8;
    const bf16_t* vp_ = gvT + ((size_t)(b * 4 + hh) * 256 + sl * SLW + vdv_) * 4096 + vc_ * 8;
    const bf16_t* ktp = ktt + ((size_t)(b * 4 + hh) * 128 + vdv_) * 4096 + vc_ * 8;
    const float* dp = dec + (size_t)b * 64 * 512 + hh * 128 + cc0;
    const bf16_t* qp = gq + ((size_t)b * 4096 + 16 * tt + l15) * 512 + hh * 128 + 8 * g;
    bf16_t* gzp = gz + ((size_t)b * 4096 + 16 * tt + l15) * 1024 + hh * 256 + sl * SLW + dv0 + 4 * g;
#define L_LOAD_META(S)                                                                                                         \
    {                                                                                                                         \
        const bf16_t* km_ = (const bf16_t*)(ws + OFF_KTM) + (size_t)krow_ * 512 + hh * 128 + kc_ * 8;                         \
        nk##S[0] = *(const u32x4*)km_; nk##S[1] = *(const u32x4*)(km_ + 32 * 512);                                                  \
        _Pragma("unroll") for (int i = 0; i < NVP; ++i)                                                                       \
            nv##S[i] = *(const u32x4*)((const bf16_t*)(ws + OFF_GVTM) + (size_t)(hh * 256 + sl * SLW + vdv_ + 64 * i) * 64 + vc_ * 8); \
        _Pragma("unroll") for (int i = 0; i < 2; ++i)                                                                         \
            nkt##S[i] = *(const u32x4*)((const bf16_t*)(ws + OFF_KTTM) + (size_t)(hh * 128 + vdv_ + 64 * i) * 64 + vc_ * 8);     \
        _Pragma("unroll") for (int ct = 0; ct < 2; ++ct) nd##S[ct] = ((const float*)(ws + OFF_DECM))[hh * 128 + cc0 + 16 * ct];  \
        _Pragma("unroll") for (int ks = 0; ks < 4; ++ks) nq##S[ks] = (bf16x8){0, 0, 0, 0, 0, 0, 0, 0};                           \
        _Pragma("unroll") for (int dl = 0; dl < DL; ++dl) ngz##S[dl] = (u32x2){0u, 0u};                                          \
    }
#define L_LOAD_REAL(S)                                                                                                         \
    {                                                                                                                         \
        nk##S[0] = *(const u32x4*)kp; nk##S[1] = *(const u32x4*)(kp + 32 * 512); kp += 64 * 512;                                    \
        _Pragma("unroll") for (int i = 0; i < NVP; ++i) nv##S[i] = *(const u32x4*)(vp_ + (size_t)(64 * i) * 4096);               \
        vp_ += 64;                                                                                                            \
        _Pragma("unroll") for (int i = 0; i < 2; ++i) nkt##S[i] = *(const u32x4*)(ktp + (size_t)(64 * i) * 4096);              \
        ktp += 64;                                                                                                            \
        nd##S[0] = dp[0]; nd##S[1] = dp[16]; dp += 512;                                                                             \
        _Pragma("unroll") for (int ks = 0; ks < 4; ++ks) nq##S[ks] = *(const bf16x8*)(qp + 32 * ks);                             \
        qp += 64 * 512;                                                                                                       \
        _Pragma("unroll") for (int dl = 0; dl < DL; ++dl) ngz##S[dl] = *(const u32x2*)(gzp + 16 * dl);                           \
        gzp += 64 * 1024;                                                                                                     \
    }
#define L_STORE(S)                                                                                                             \
    {                                                                                                                         \
        _Pragma("unroll") for (int i = 0; i < 2; ++i) { const int pi = tid + 512 * i, row = pi >> 4, c = pi & 15;              \
            *(u32x4*)(sK + row * L_KROWB + c * 16) = nk##S[i]; }                                                                 \
        _Pragma("unroll") for (int i = 0; i < NVP; ++i) *(u32x4*)(sV + (vdv_ + 64 * i) * L_VROWB + vc_ * 16) = nv##S[i];          \
        _Pragma("unroll") for (int i = 0; i < 2; ++i) *(u32x4*)(sKT + (vdv_ + 64 * i) * L_VROWB + vc_ * 16) = nkt##S[i];          \
    }
    L_LOAD_META(A);
    L_LOAD_REAL(B);
    L_STORE(A);
#define GLA_STEP(n_, C, O) {                                                                                         \
        bf16x8 cq[4]; float cd[2]; u32x2 cgz[DL]; \
_Pragma("unroll") \
        for (int ks = 0; ks < 4; ++ks) cq[ks] = nq##C[ks]; \
_Pragma("unroll") \
        for (int ct = 0; ct < 2; ++ct) { cd[ct] = nd##C[ct]; } \
_Pragma("unroll") \
        for (int dl = 0; dl < DL; ++dl) cgz[dl] = ngz##C[dl]; \
_Pragma("unroll") \
        for (int ks = 0; ks < 4; ++ks) asm volatile("" : "+v"(cq[ks])); \
_Pragma("unroll") \
        for (int ct = 0; ct < 2; ++ct) { asm volatile("" : "+v"(cd[ct])); } \
_Pragma("unroll") \
        for (int dl = 0; dl < DL; ++dl) asm volatile("" : "+v"(cgz[dl])); \
        L_BAR(); \
        if ((n_) + 2 <= 64) L_LOAD_REAL(C); \
        if ((n_) > 0) { \
            f32x4 at[4]; \
_Pragma("unroll") \
            for (int jt = 0; jt < 4; ++jt) at[jt] = (f32x4){0.f, 0.f, 0.f, 0.f}; \
            { \
                const unsigned char* kb = sK + l15 * L_KROWB + 16 * g; \
                bf16x8 ka[8], kc[8]; \
_Pragma("unroll") \
                for (int i = 0; i < 8; ++i) ka[i] = *(const bf16x8*)(kb + (i & 3) * 16 * L_KROWB + (i >> 2) * 64); \
                __builtin_amdgcn_sched_barrier(0); \
_Pragma("unroll") \
                for (int i = 0; i < 8; ++i) kc[i] = *(const bf16x8*)(kb + (i & 3) * 16 * L_KROWB + (2 + (i >> 2)) * 64); \
                __builtin_amdgcn_sched_barrier(0); \
_Pragma("unroll") \
                for (int i = 0; i < 8; ++i) at[i & 3] = MFMA16(ka[i], cq[i >> 2], at[i & 3]); \
                __builtin_amdgcn_sched_barrier(0); \
_Pragma("unroll") \
                for (int i = 0; i < 8; ++i) at[i & 3] = MFMA16(kc[i], cq[2 + (i >> 2)], at[i & 3]); \
            } \
            const int tl = 16 * tt + l15; \
_Pragma("unroll") \
            for (int jt = 0; jt < 4; ++jt) \
_Pragma("unroll") \
                for (int i = 0; i < 4; ++i) if (16 * jt + 4 * g + i > tl) at[jt][i] = 0.f; \
            bf16x8 pa[2]; \
_Pragma("unroll") \
            for (int s2 = 0; s2 < 2; ++s2) { \
                u32x4 t; \
                t.x = pk2(at[2 * s2][0], at[2 * s2][1]); t.y = pk2(at[2 * s2][2], at[2 * s2][3]); \
                t.z = pk2(at[2 * s2 + 1][0], at[2 * s2 + 1][1]); t.w = pk2(at[2 * s2 + 1][2], at[2 * s2 + 1][3]); \
                pa[s2] = __builtin_bit_cast(bf16x8, t); \
            } \
            const size_t row = (size_t)b * 4096 + ((n_) - 1) * 64 + 16 * tt + l15; \
_Pragma("unroll") \
            for (int dl = 0; dl < DL; ++dl) { \
                const int dvr = dv0 + 16 * dl + l15; \
                f32x4 o = (f32x4){0.f, 0.f, 0.f, 0.f}; \
                { \
                    u32x4 vv[2]; bf16x8 sf[4]; \
_Pragma("unroll") \
                    for (int s2 = 0; s2 < 2; ++s2) { \
                        const unsigned char* vp = sV + dvr * L_VROWB + (32 * s2 + 4 * g) * 2; \
                        const u32x2 lo = *(const u32x2*)vp, hi = *(const u32x2*)(vp + 32); \
                        vv[s2].x = lo.x; vv[s2].y = lo.y; vv[s2].z = hi.x; vv[s2].w = hi.y; \
                    } \
_Pragma("unroll") \
                    for (int ks = 0; ks < 4; ++ks) sf[ks] = *(const bf16x8*)(sS + dvr * L_SROWB + (ks * 32 + 8 * g) * 2); \
                    __builtin_amdgcn_sched_barrier(0); \
                    f32x4 o2 = (f32x4){0.f, 0.f, 0.f, 0.f}; \
                    o = MFMA16(__builtin_bit_cast(bf16x8, vv[0]), pa[0], o); \
                    o2 = MFMA16(sf[0], cq[0], o2); \
                    o = MFMA16(__builtin_bit_cast(bf16x8, vv[1]), pa[1], o); \
                    o2 = MFMA16(sf[1], cq[1], o2); \
                    o = MFMA16(sf[2], cq[2], o); \
                    o2 = MFMA16(sf[3], cq[3], o2); \
                    o = o + o2; \
                } \
                float ss = (o[0] * o[0] + o[1] * o[1]) + (o[2] * o[2] + o[3] * o[3]); \
                ss = xor16_sum(ss); ss = xor32_sum(ss); \
                u32x2 ov; \
                ov.x = pk2(o[0] * siluf_(bflo(cgz[dl].x)), o[1] * siluf_(bfhi(cgz[dl].x))); \
                ov.y = pk2(o[2] * siluf_(bflo(cgz[dl].y)), o[3] * siluf_(bfhi(cgz[dl].y))); \
                *(u32x2*)(gz + row * 1024 + hh * 256 + sl * SLW + dv0 + 16 * dl + 4 * g) = ov; \
                if (g == 0) ssqb[(row * 4 + hh) * 16 + sl * 2 * DL + dvt * DL + dl] = ss; \
            } \
        } \
        bf16x8 vfs[DL][2]; \
_Pragma("unroll") \
        for (int dl = 0; dl < DL; ++dl) \
_Pragma("unroll") \
            for (int ks = 0; ks < 2; ++ks) vfs[dl][ks] = *(const bf16x8*)(sV + (dv0 + 16 * dl + l15) * L_VROWB + (32 * ks + 8 * g) * 2); \
        bf16x8 ckt[2][2]; \
        _Pragma("unroll") \
        for (int ct = 0; ct < 2; ++ct) \
        _Pragma("unroll") \
            for (int ks = 0; ks < 2; ++ks) ckt[ct][ks] = *(const bf16x8*)(sKT + (cc0 + 16 * ct) * L_VROWB + (32 * ks + 8 * g) * 2); \
        __builtin_amdgcn_sched_barrier(0); \
_Pragma("unroll") \
        for (int dl = 0; dl < DL; ++dl) { \
_Pragma("unroll") \
            for (int ks = 0; ks < 2; ++ks) { \
                sacc[dl][0] = MFMA16(vfs[dl][ks], ckt[0][ks], sacc[dl][0]); \
                sacc[dl][1] = MFMA16(vfs[dl][ks], ckt[1][ks], sacc[dl][1]); \
            } \
_Pragma("unroll") \
            for (int ct = 0; ct < 2; ++ct) \
_Pragma("unroll") \
                for (int i = 0; i < 4; ++i) sacc[dl][ct][i] *= cd[ct]; \
        } \
        L_BAR(); \
_Pragma("unroll") \
        for (int dl = 0; dl < DL; ++dl) \
_Pragma("unroll") \
            for (int ct = 0; ct < 2; ++ct) \
_Pragma("unroll") \
                for (int i = 0; i < 4; ++i) \
                    *(bf16_t*)(sS + (dv0 + 16 * dl + 4 * g + i) * L_SROWB + (cc0 + 16 * ct) * 2) = f2bf(sacc[dl][ct][i]); \
        if ((n_) + 1 <= 64) L_STORE(O); \
    }
    for (int n2 = 0; n2 <= 64; n2 += 2) {
        GLA_STEP(n2, A, B);
        if (n2 + 1 > 64) break;
        GLA_STEP(n2 + 1, B, A);
    }
#undef GLA_STEP
#undef L_LOAD_META
#undef L_LOAD_REAL
#undef L_STORE
    __syncthreads();
}

DI void phase2(const Params& p, unsigned char* lds) {
    const int tid = opaque_tid();
    float lam;
    {
        const int lane = tid & 63;
        const float a_ = wave_sum(p.lq1[lane] * p.lk1[lane]);
        const float b_ = wave_sum(p.lq2[lane] * p.lk2[lane]);
        lam = __uint_as_float((unsigned)__builtin_amdgcn_readfirstlane((int)__float_as_uint(expf(a_) - expf(b_) + 0.2f)));
    }
    volatile unsigned* sItem = (volatile unsigned*)(lds + LDS_ITEM);
    constexpr unsigned NSL = 8 / GLA_DL, N_GLA = 2 * NSL, N_ATT = 128;
    if (tid == 0) sItem[1] = 0u;
    for (;;) {
        if (tid == 0) {
            unsigned* heads = (unsigned*)(p.ws + OFF_XBAR + 15360);
            const unsigned x0 = (unsigned)__builtin_amdgcn_s_getreg((3 << 11) | 20) & 7u;
            unsigned k = sItem[1], it = 0xffffffffu;
            while (k < 8u) {
                const unsigned x = (x0 + k) & 7u;
                const unsigned got = atomicAdd(heads + x, 1u);
                if (got < N_GLA + N_ATT) { it = got | (x << 16); break; }
                ++k;
            }
            sItem[1] = k; sItem[0] = it;
        }
        __syncthreads();
        const unsigned item = (unsigned)__builtin_amdgcn_readfirstlane((int)sItem[0]);
        __syncthreads();
        if (item == 0xffffffffu) break;
        const unsigned x = item >> 16, idx = item & 0xffffu;
        if (idx < N_GLA) { const unsigned gi = x * N_GLA + idx; gla_item<GLA_DL>(p, lds, gi / (4 * NSL), (gi / NSL) & 3, gi % NSL); }
        else { const unsigned a = idx - N_GLA, pair = 4 * x + ((a >> 2) & 3); attn_item(p, lds, pair & 3, pair >> 2, 31 - (int)(((a >> 4) << 2) + (a & 3)), lam); }
    }
}

DI void phase25(const Params& p, unsigned char* lds) {
    const int tid = opaque_tid(), lane = tid & 63, wave = tid >> 6;
    const float* ssqb = (const float*)(p.ws + OFF_SSQB);
    bf16_t* gz = (bf16_t*)(p.ws + OFF_GZ);
    for (int it = blockIdx.x; it < MROWS / 32; it += gridDim.x) {
        const size_t row0 = (size_t)it * 32 + wave * 4;
        u32x4 u[4][2]; float s[4];
#pragma unroll
        for (int q = 0; q < 4; ++q) {
            const u32x4* ptr = (const u32x4*)(gz + (row0 + q) * 1024 + lane * 16);
            u[q][0] = ptr[0]; u[q][1] = ptr[1];
            s[q] = ssqb[((row0 + q) * 4 + (lane >> 4)) * 16 + (lane & 15)];
        }
#pragma unroll
        for (int q = 0; q < 4; ++q) {
            float t = s[q];
            t += __shfl_xor(t, 1); t += __shfl_xor(t, 2); t += __shfl_xor(t, 4); t += __shfl_xor(t, 8);
            const float r = 1.0f / sqrtf(t * (1.0f / 256.0f) + EPS);
            u32x4* ptr = (u32x4*)(gz + (row0 + q) * 1024 + lane * 16);
#pragma unroll
            for (int j = 0; j < 2; ++j) {
                const u32x4 a = u[q][j]; u32x4 o;
                o.x = pk2(bflo(a.x) * r, bfhi(a.x) * r); o.y = pk2(bflo(a.y) * r, bfhi(a.y) * r);
                o.z = pk2(bflo(a.z) * r, bfhi(a.z) * r); o.w = pk2(bflo(a.w) * r, bfhi(a.w) * r);
                ptr[j] = o;
            }
        }
    }
}

template <int PASS>
struct EpiMerge {
    static constexpr bool PERM = false, AFTER_DRAIN = false;
    unsigned char* ws; const PG8_LAS float* tab;
    DI void operator()(const pg8::f32x4 (&acc)[2][2][4][2], const pg8::Unit& u, int wr, int wc, int fr, int fq) const {
        const unsigned char* sg = ws + (PASS == 0 ? OFF_SGB : OFF_SGA);
        bf16_t* merged = (bf16_t*)(ws + OFF_AK);
#pragma unroll
        for (int ai = 0; ai < 2; ++ai)
#pragma unroll
            for (int m = 0; m < 4; ++m) {
                const size_t tok = (size_t)u.pm * 256 + ai * 128 + wr * 64 + m * 16 + fr;
#pragma unroll
                for (int bj = 0; bj < 2; ++bj)
#pragma unroll
                    for (int n = 0; n < 2; ++n) {
                        const size_t off = tok * 1024 + u.pn * 256 + bj * 128 + wc * 32 + n * 16 + 4 * fq;
                        const unsigned ug = *(const unsigned*)(sg + off);
                        const float q = (PASS == 0 ? tab[(ai * 128 + wr * 64 + m * 16 + fr) * 4 + 3] : 1.0f) * (1.0f / 255.0f);
                        float m0 = (float)(ug & 255u) * q * acc[ai][bj][m][n][0], m1 = (float)((ug >> 8) & 255u) * q * acc[ai][bj][m][n][1];
                        float m2 = (float)((ug >> 16) & 255u) * q * acc[ai][bj][m][n][2], m3 = (float)(ug >> 24) * q * acc[ai][bj][m][n][3];
                        if (PASS == 1) { const u32x2 t = *(const u32x2*)(merged + off); m0 += bflo(t.x); m1 += bfhi(t.x); m2 += bflo(t.y); m3 += bfhi(t.y); }
                        u32x2 o; o.x = pk2(m0, m1); o.y = pk2(m2, m3);
                        *(u32x2*)(merged + off) = o;
                    }
            }
    }
};
struct EpiOut {
    static constexpr bool PERM = false, AFTER_DRAIN = true;
    unsigned char* ws; const float* x; float* out; const float* fw;
    DI void fused(pg8::f32x4 (&acc)[2][2][4][2], const pg8::Unit& u, int wr, int wc, int fr, int fq, PG8_LAS unsigned char* lds, int wid, int lane) const {
        float* ssqh = (float*)(ws + OFF_SSQH);
        unsigned* pcnt = (unsigned*)(ws + OFF_XBAR + 14336) + u.pm;
#pragma unroll
        for (int ai = 0; ai < 2; ++ai)
#pragma unroll
            for (int m = 0; m < 4; ++m) {
                const size_t tok = (size_t)u.pm * 256 + ai * 128 + wr * 64 + m * 16 + fr;
                float ss = 0.f;
#pragma unroll
                for (int bj = 0; bj < 2; ++bj)
#pragma unroll
                    for (int n = 0; n < 2; ++n) {
                        const size_t off = tok * 1024 + u.pn * 256 + bj * 128 + wc * 32 + n * 16 + 4 * fq;
                        const f32x4 xv = *(const f32x4*)(x + off);
                        f32x4 o = acc[ai][bj][m][n];
                        o.x += xv.x; o.y += xv.y; o.z += xv.z; o.w += xv.w;
                        acc[ai][bj][m][n] = o;
                        ss += (o.x * o.x + o.y * o.y) + (o.z * o.z + o.w * o.w);
                    }
                ss = xor16_sum(ss); ss = xor32_sum(ss);
                if (fq == 0) ssqh[tok * 16 + u.pn * 4 + wc] = ss;
            }
        asm volatile("s_waitcnt vmcnt(0)" ::: "memory");
        __syncthreads();
        if (threadIdx.x == 0) {
            __builtin_amdgcn_fence(__ATOMIC_RELEASE, "agent");
            asm volatile("s_waitcnt vmcnt(0)" ::: "memory");
            __hip_atomic_fetch_add(pcnt, 1u, __ATOMIC_RELAXED, __HIP_MEMORY_SCOPE_AGENT);
            unsigned spins = 0u;
            while (__hip_atomic_load(pcnt, __ATOMIC_RELAXED, __HIP_MEMORY_SCOPE_AGENT) < 4u && ++spins < (1u << 22)) __builtin_amdgcn_s_sleep(1);
            __builtin_amdgcn_fence(__ATOMIC_ACQUIRE, "agent");
            asm volatile("s_waitcnt vmcnt(0)" ::: "memory");
        }
        __syncthreads();
#pragma unroll
        for (int ai = 0; ai < 2; ++ai)
#pragma unroll
            for (int m = 0; m < 4; ++m) {
                const size_t tok = (size_t)u.pm * 256 + ai * 128 + wr * 64 + m * 16 + fr;
                const f32x4* sp = (const f32x4*)(ssqh + tok * 16);
                const f32x4 a = sp[0], b2 = sp[1], c = sp[2], d = sp[3];
                const float s = ((a.x + a.y) + (a.z + a.w)) + ((b2.x + b2.y) + (b2.z + b2.w)) + ((c.x + c.y) + (c.z + c.w)) + ((d.x + d.y) + (d.z + d.w));
                const float rstd = 1.0f / sqrtf(s * (1.0f / 1024.0f) + EPS);
#pragma unroll
                for (int bj = 0; bj < 2; ++bj)
#pragma unroll
                    for (int n = 0; n < 2; ++n) {
                        const int col = u.pn * 256 + bj * 128 + wc * 32 + n * 16 + 4 * fq;
                        const f32x4 w = *(const f32x4*)(fw + col);
                        f32x4 o = acc[ai][bj][m][n];
                        o.x = o.x * rstd * w.x; o.y = o.y * rstd * w.y; o.z = o.z * rstd * w.z; o.w = o.w * rstd * w.w;
                        __builtin_nontemporal_store(o, (f32x4*)(out + tok * 1024 + col));
                    }
            }
    }
};
DI void phase3(const Params& p, unsigned char* lds) {
    SchedSq S;
    {
        pg8::Unit u0; S.next(0, u0);
        const int tid = opaque_tid();
        float* tabw = (float*)(lds + 147456);
        if (tid < 256) {
            const float* sp = (const float*)(p.ws + OFF_SSQB) + ((size_t)u0.pm * 256 + tid) * 64;
            float r[4];
#pragma unroll
            for (int hh = 0; hh < 4; ++hh) {
                const f32x4 a = *(const f32x4*)(sp + hh * 16), b2 = *(const f32x4*)(sp + hh * 16 + 4), c = *(const f32x4*)(sp + hh * 16 + 8), d = *(const f32x4*)(sp + hh * 16 + 12);
                const float s = ((a.x + a.y) + (a.z + a.w)) + ((b2.x + b2.y) + (b2.z + b2.w)) + ((c.x + c.y) + (c.z + c.w)) + ((d.x + d.y) + (d.z + d.w));
                r[hh] = 1.0f / sqrtf(s * (1.0f / 256.0f) + EPS);
            }
            f32x4 o; o.x = r[0] / r[1]; o.y = r[1] / r[2]; o.z = r[2] / r[3]; o.w = r[3];
            *(f32x4*)(tabw + tid * 4) = o;
        }
        __syncthreads();
    }
    {
        pg8::Gemm g; g.A = (const bf16_t*)(p.ws + OFF_GZ); g.Bt = (const bf16_t*)(p.ws + OFF_WB_T); g.M = MROWS; g.N = 1024; g.K = 1024;
        EpiMerge<0> E; E.ws = p.ws; E.tab = (const PG8_LAS float*)(lds + 147456);
        pg8::gemm_phase<EpiMerge<0>, SchedSq, true, true, true>((PG8_LAS unsigned char*)lds, g, S, E);
    }
    {
        pg8::Gemm g; g.A = (const bf16_t*)(p.ws + OFF_AZ); g.Bt = (const bf16_t*)(p.ws + OFF_WA_T); g.M = MROWS; g.N = 1024; g.K = 1024;
        EpiMerge<1> E; E.ws = p.ws; E.tab = (const PG8_LAS float*)(lds + 147456);
        pg8::gemm_phase<EpiMerge<1>, SchedSq, true, true>((PG8_LAS unsigned char*)lds, g, S, E);
    }
}
DI void phase4(const Params& p, unsigned char* lds) {
    SchedSq S;
    pg8::Gemm g; g.A = (const bf16_t*)(p.ws + OFF_AK); g.Bt = (const bf16_t*)(p.ws + OFF_WO_T); g.M = MROWS; g.N = 1024; g.K = 1024;
    EpiOut E; E.ws = p.ws; E.x = p.x; E.out = p.out; E.fw = p.final_w;
    pg8::gemm_phase<EpiOut, SchedSq, false, true>((PG8_LAS unsigned char*)lds, g, S, E);
}

DI void phase5(const Params& p, unsigned char* lds) {
    const int tid = opaque_tid(), lane = tid & 63, wave = tid >> 6;
    const float* ssqh = (const float*)(p.ws + OFF_SSQH);
    for (int it = blockIdx.x; it < MROWS / 8; it += gridDim.x) {
        const size_t row = (size_t)it * 8 + wave;
        float s = lane < 16 ? ssqh[row * 16 + lane] : 0.f;
        s = wave_sum(s);
        const float rstd = 1.0f / sqrtf(s * (1.0f / 1024.0f) + EPS);
        f32x4* orow = (f32x4*)(p.out + row * 1024) + lane;
        const f32x4* wrow = (const f32x4*)p.final_w + lane;
#pragma unroll
        for (int j = 0; j < 4; ++j) {
            f32x4 v = orow[64 * j]; const f32x4 w = wrow[64 * j];
            v.x = v.x * rstd * w.x; v.y = v.y * rstd * w.y; v.z = v.z * rstd * w.z; v.w = v.w * rstd * w.w;
            orow[64 * j] = v;
        }
    }
}

#define XB_TMO      128
#define XB_XCNT(j)  (256  + 64 * (j))
#define XB_XSUB(j)  (1280 + 64 * (j))
#define XB_XGEN(j)  (2304 + 64 * (j))
#define XB_TOP      3328
#define XB_TOPGEN   3392
#define XCD_BAR_WORDS 3456
#define XB_SPIN_CAP (1u << 18)
#define LAS __attribute__((address_space(3)))
DI unsigned xb_ld(unsigned* p)              { return __hip_atomic_load(p, __ATOMIC_RELAXED, __HIP_MEMORY_SCOPE_AGENT); }
DI unsigned xb_add(unsigned* p, unsigned v) { return __hip_atomic_fetch_add(p, v, __ATOMIC_RELAXED, __HIP_MEMORY_SCOPE_AGENT); }
DI unsigned xb_xcc_id() { return (unsigned)__builtin_amdgcn_s_getreg((3 << 11) | 20) & 0xFu; }
#define XB_SPIN(cond, bar) do { unsigned _sp = 0; while (cond) { __builtin_amdgcn_s_sleep(1); \
    if ((++_sp & 255u) == 0u) { if (xb_ld(&(bar)[XB_TMO])) break; if (_sp > XB_SPIN_CAP) { atomicAdd(&(bar)[XB_TMO], 1u); break; } } } } while (0)
struct XcdBarrier { unsigned* bar; unsigned x; volatile LAS unsigned* st; };
DI XcdBarrier xcd_barrier_post(unsigned* bar, volatile LAS unsigned* st) {
    XcdBarrier b; b.bar = bar; b.x = xb_xcc_id(); b.st = st;
    if (threadIdx.x == 0) (void)xb_add(&bar[XB_XCNT(b.x)], 1u);
    return b;
}
DI void xcd_barrier_complete(unsigned* bar, unsigned x, unsigned& nloc, unsigned& nx) {
    const unsigned G = gridDim.x * gridDim.y * gridDim.z;
    unsigned sum, cnt, mine, sp = 0u;
    for (;;) {
        sum = 0u; cnt = 0u; mine = 0u;
#pragma unroll
        for (unsigned j = 0; j < 16; ++j) { const unsigned c = xb_ld(&bar[XB_XCNT(j)]); sum += c; cnt += (c > 0u) ? 1u : 0u; mine = (j == x) ? c : mine; }
        if (sum == G) break;
        __builtin_amdgcn_s_sleep(1);
        if ((++sp & 255u) == 0u) { if (xb_ld(&bar[XB_TMO])) break; if (sp > XB_SPIN_CAP) { atomicAdd(&bar[XB_TMO], 1u); break; } }
    }
    nloc = mine > 0u ? mine : 1u; nx = cnt > 0u ? cnt : 1u;
}
DI void xcd_barrier(const XcdBarrier& b) {
    asm volatile("s_waitcnt vmcnt(0)" ::: "memory");
    __syncthreads();
    if (threadIdx.x == 0) {
        unsigned* bar = b.bar;
        __builtin_amdgcn_s_waitcnt(0);
        unsigned nloc = b.st[0], nx = b.st[1];
        if (nloc == 0u) { xcd_barrier_complete(bar, b.x, nloc, nx); b.st[0] = nloc; b.st[1] = nx; }
        const unsigned old = xb_add(&bar[XB_XSUB(b.x)], 1u);
        const unsigned gen = old / nloc;
        if (old + 1u == (gen + 1u) * nloc) {
            __builtin_amdgcn_fence(__ATOMIC_RELEASE, "agent");
            asm volatile("s_waitcnt vmcnt(0)" ::: "memory");
            const unsigned og = xb_add(&bar[XB_TOP], 1u);
            const unsigned tg = og / nx;
            if (og + 1u == (tg + 1u) * nx) xb_add(&bar[XB_TOPGEN], 1u);
            else XB_SPIN(xb_ld(&bar[XB_TOPGEN]) == tg, bar);
            __builtin_amdgcn_fence(__ATOMIC_ACQUIRE, "agent");
            xb_add(&bar[XB_XGEN(b.x)], 1u);
            asm volatile("s_waitcnt vmcnt(0)" ::: "memory");
        } else {
            XB_SPIN(xb_ld(&bar[XB_XGEN(b.x)]) == gen, bar);
            __builtin_amdgcn_fence(__ATOMIC_ACQUIRE, "agent");
            asm volatile("s_waitcnt vmcnt(0)" ::: "memory");
        }
    }
    __syncthreads();
}

DI void run_phase(const Params& p, unsigned char* lds, int ph) {
    switch (ph) {
        case 0: phase0(p, lds); break;
        case 1: phase1(p, lds); break;
        case 2: phase15(p, lds); break;
        case 3: phase2(p, lds); break;
        case 4: phase25(p, lds); phase3(p, lds); break;
        case 5: phase4(p, lds); break;
        default: phase5(p, lds); break;
    }
}

__global__ void __launch_bounds__(512) hybrid_fwd(Params p) {
    extern __shared__ __attribute__((aligned(16))) unsigned char lds[];
#if MULTI_LAUNCH
    run_phase(p, lds, p.phase_lo);
#else
    cg::grid_group grid = cg::this_grid();
    if (p.phase_lo == 77) grid.sync();
    {
        volatile LAS unsigned* st = (volatile LAS unsigned*)(lds + LDS_ITEM + 16);
        if (threadIdx.x == 0) { st[0] = 0u; st[1] = 0u; }
        __syncthreads();
        (void)xcd_barrier_post((unsigned*)(p.ws + OFF_XBAR), st);
    }
#define GRID_BARRIER() { XcdBarrier xb_; xb_.bar = (unsigned*)(p.ws + OFF_XBAR); xb_.x = xb_xcc_id(); xb_.st = (volatile LAS unsigned*)(lds + LDS_ITEM + 16); xcd_barrier(xb_); }
    phase0(p, lds); GRID_BARRIER();
    phase1(p, lds); GRID_BARRIER();
    phase15(p, lds); GRID_BARRIER();
    phase2(p, lds); GRID_BARRIER();
    phase3(p, lds); GRID_BARRIER();
    phase4(p, lds);
#endif
}

extern "C" void kernel_launch(void* const* d_in, const int* in_sizes, int n_in, void* d_out, int out_size, void* d_ws, size_t ws_size, hipStream_t stream) {
    static int grid = 0;
    if (grid == 0) {
        int dev = 0, cus = 0, per_cu = 0;
        hipGetDevice(&dev);
        hipDeviceGetAttribute(&cus, hipDeviceAttributeMultiprocessorCount, dev);
        hipFuncSetAttribute((const void*)hybrid_fwd, hipFuncAttributeMaxDynamicSharedMemorySize, LDS_BYTES);
        hipOccupancyMaxActiveBlocksPerMultiprocessor(&per_cu, (const void*)hybrid_fwd, 512, LDS_BYTES);
        if (per_cu < 1) per_cu = 1;
        if (per_cu > 1) per_cu = 1;
        if (cus <= 0) cus = 256;
        grid = cus * per_cu;
    }
    hipMemsetAsync((unsigned char*)d_ws + OFF_XBAR, 0, 16384, stream);
    Params p{};
    p.x = (const float*)d_in[0]; p.meta = (const float*)d_in[1]; p.norm_w = (const float*)d_in[2]; p.w_in = (const float*)d_in[3];
    p.lq1 = (const float*)d_in[4]; p.lk1 = (const float*)d_in[5]; p.lq2 = (const float*)d_in[6]; p.lk2 = (const float*)d_in[7];
    p.subln_w = (const float*)d_in[8]; p.gate_w2 = (const float*)d_in[9]; p.gate_b = (const float*)d_in[10]; p.gla_norm_w = (const float*)d_in[11];
    p.wa = (const float*)d_in[12]; p.wb = (const float*)d_in[13]; p.wo = (const float*)d_in[14]; p.final_w = (const float*)d_in[15];
    p.out = (float*)d_out; p.ws = (unsigned char*)d_ws;
#if MULTI_LAUNCH
    for (int ph = 0; ph < 7; ++ph) {
        p.phase_lo = ph; p.phase_hi = ph + 1;
        hipLaunchKernelGGL(hybrid_fwd, dim3(grid), dim3(512), LDS_BYTES, stream, p);
    }
#else
    p.phase_lo = 0; p.phase_hi = 7;
    void* args[] = {&p};
    hipError_t e = hipLaunchCooperativeKernel((const void*)hybrid_fwd, dim3(grid), dim3(512), args, LDS_BYTES, stream);
    if (e != hipSuccess) fprintf(stderr, "cooperative launch failed: %s (grid %d)\n", hipGetErrorString(e), grid);
#endif
}
```
